# Optimizing an MI355X kernel written in HIP

```python
import math
import jax
import jax.numpy as jnp
from jax import lax
import numpy as np

D_MODEL = 1024
BATCH = 4
SEQ = 4096
DEPTH = 2

GRID_W = 64
CTX_LEN = 256
N_GROUPS = 4
GROUP_W = D_MODEL // N_GROUPS
MIX_W = GROUP_W * N_GROUPS

DIFF_HEADS = 4
DIFF_DV = GROUP_W // DIFF_HEADS
DIFF_DQK = DIFF_DV // 2
Q_BLOCK = 128
ROPE_BASE = 10000.0

HY_CH = GROUP_W
HY_BANDS = 16
HY_EMB = 2 * HY_BANDS + 1
HY_FFN = 64
HY_FAST_DECAY_PCT = 0.3
HY_SLOW_DECAY_PCT = 1.5
HY_DECAY_TARGET = 1e-2

RET_HEADS = 4
RET_DH = GROUP_W // RET_HEADS

GLA_HEADS = 4
GLA_DK = GROUP_W // 2 // GLA_HEADS
GLA_DV = GROUP_W // GLA_HEADS
GLA_RANK = 16
GLA_GATE_NORM = 16.0

CHUNK = 64

N_EXPERTS = 32
TOP_K = 4
D_EXPERT = D_MODEL
SWIGLU_LIMIT = 7.0
SWIGLU_ALPHA = 1.702
EPS = 1e-6

SPLIT_SIZES = (GROUP_W, GROUP_W, GROUP_W,
               3 * HY_CH,
               GROUP_W, GROUP_W, GROUP_W, GROUP_W,
               GLA_HEADS * GLA_DK, GLA_HEADS * GLA_DK,
               GROUP_W, GROUP_W, 2 * GLA_RANK)
IN_W = sum(SPLIT_SIZES)

kernel_name = 'hybrid_diff_hyena_ret_gla_moe_dit'

F32 = jnp.float32


def rms_norm(x, g):
    xf = x.astype(F32)
    return xf * lax.rsqrt(jnp.mean(xf * xf, axis=-1, keepdims=True) + EPS) * g.astype(F32)


def split_heads(t, n):
    b, l, _ = t.shape
    return t.reshape(b, l, n, -1).transpose(0, 2, 1, 3)


def merge_heads(t):
    b, h, l, d = t.shape
    return t.transpose(0, 2, 1, 3).reshape(b, l, h * d)


def axial_rope_tables(n_tok, dim):
    rows = n_tok // GRID_W
    row = jnp.repeat(jnp.arange(rows, dtype=F32), GRID_W)
    col = jnp.tile(jnp.arange(GRID_W, dtype=F32), rows)
    quarter = dim // 4
    inv = ROPE_BASE ** (-jnp.arange(quarter, dtype=F32) / quarter)
    ar = row[:, None] * inv[None]
    ac = col[:, None] * inv[None]
    ang = jnp.concatenate([ar, ar, ac, ac], axis=-1)
    return jnp.cos(ang), jnp.sin(ang)


def apply_rope(x, cos, sin):
    h = x.shape[-1] // 2
    q = h // 2
    xr, xc = x[..., :h], x[..., h:]
    rot = jnp.concatenate([-xr[..., q:], xr[..., :q], -xc[..., q:], xc[..., :q]], axis=-1)
    return x * cos + rot * sin


def _diff_attend(q, k, v, lam):
    s = jnp.einsum('bhmqd,bhmkd->bhmqk', q, k) * (DIFF_DQK ** -0.5)
    p = jax.nn.softmax(s, axis=-1)
    a = p[:, :, 0] - lam * p[:, :, 1]
    return jnp.einsum('bhqk,bhkv->bhqv', a, v)


def diff_attention(q, k, v, qc, kc, vc, lam_p, subln_g, lam_init, need_ctx):
    b, n_lat, _ = q.shape

    def qk_heads(t):
        return t.reshape(b, t.shape[1], DIFF_HEADS, 2, DIFF_DQK).transpose(0, 2, 3, 1, 4).astype(F32)

    cos, sin = axial_rope_tables(n_lat, DIFF_DQK)
    q = apply_rope(qk_heads(q), cos, sin)
    k = apply_rope(qk_heads(k), cos, sin)
    qc = qk_heads(qc)
    kc = qk_heads(kc)
    v = split_heads(v, DIFF_HEADS).astype(F32)
    vc = split_heads(vc, DIFF_HEADS).astype(F32)
    lam_p = lam_p.astype(F32)
    lam = jnp.exp(jnp.sum(lam_p[0] * lam_p[1])) - jnp.exp(jnp.sum(lam_p[2] * lam_p[3])) + lam_init
    k_all = jnp.concatenate([k, kc], axis=3)
    v_all = jnp.concatenate([v, vc], axis=2)
    nb = n_lat // Q_BLOCK
    q_blocks = q.reshape(b, DIFF_HEADS, 2, nb, Q_BLOCK, DIFF_DQK).transpose(3, 0, 1, 2, 4, 5)
    o = lax.map(lambda qb: _diff_attend(qb, k_all, v_all, lam), q_blocks)
    o = o.transpose(1, 2, 0, 3, 4).reshape(b, DIFF_HEADS, n_lat, DIFF_DV)

    def post(t):
        return merge_heads(rms_norm(t, subln_g) * (1.0 - lam_init))

    out_c = post(_diff_attend(qc, kc, vc, lam)) if need_ctx else None
    return post(o), out_c


def hyena_filter(n, w1, b1, w2, b2, w3, freq):
    pos = jnp.arange(n, dtype=F32)
    t = pos / (n - 1)
    w = 2.0 * math.pi * pos / n
    f = jnp.linspace(1e-4, HY_BANDS - 1, HY_BANDS, dtype=F32)
    ang = w[:, None] * f[None]
    z = jnp.concatenate([t[:, None], jnp.cos(ang), -jnp.sin(ang)], axis=-1)
    hdn = jnp.sin(freq[0] * (z @ w1 + b1))
    hdn = jnp.sin(freq[1] * (hdn @ w2 + b2))
    raw = (hdn @ w3).astype(F32)
    max_decay = math.log(HY_DECAY_TARGET) / HY_FAST_DECAY_PCT
    min_decay = math.log(HY_DECAY_TARGET) / HY_SLOW_DECAY_PCT
    deltas = jnp.abs(jnp.linspace(min_decay, max_decay, HY_CH, dtype=F32))
    window = jnp.exp(-t[:, None] * deltas[None])
    h_fwd = raw[:, :HY_CH] * window
    h_bwd = raw[:, HY_CH:] * window
    filt = jnp.concatenate([h_fwd, jnp.zeros((1, HY_CH), F32), h_bwd[:0:-1]], axis=0)
    return filt / jnp.sum(jnp.abs(filt), axis=0, keepdims=True)


def short_conv3(u, w, b):
    up = jnp.pad(u, ((0, 0), (1, 1), (0, 0)))
    return up[:, :-2] * w[0] + up[:, 1:-1] * w[1] + up[:, 2:] * w[2] + b


def hyena_seq(u, short_w, short_b, filt, bias):
    u = short_conv3(u.astype(F32), short_w.astype(F32), short_b.astype(F32))
    x0, x1, v = jnp.split(u, 3, axis=-1)
    z = x1 * v
    n = z.shape[1]
    zf = jnp.fft.rfft(z, n=2 * n, axis=1)
    ff = jnp.fft.rfft(filt, n=2 * n, axis=0)
    y = jnp.fft.irfft(zf * ff[None], n=2 * n, axis=1)[:, :n] + bias.astype(F32) * z
    return x0 * y


def chunk_recurrence(q, k, v, log_a, s0):
    b, h, n_tok, _ = q.shape
    dv = v.shape[-1]
    n_chunks = n_tok // CHUNK

    def to_chunks(t):
        return t.reshape(b, h, n_chunks, CHUNK, t.shape[-1]).transpose(2, 0, 1, 3, 4)

    lower = jnp.tril(jnp.ones((CHUNK, CHUNK), dtype=bool))[:, :, None]

    def step(state, blk):
        qb, kb, vb, lb = blk
        cum = jnp.cumsum(lb, axis=2)
        rel = cum[:, :, :, None, :] - cum[:, :, None, :, :]
        w = jnp.exp(jnp.where(lower, rel, -jnp.inf))
        scores = jnp.sum(qb[:, :, :, None, :] * kb[:, :, None, :, :] * w, axis=-1)
        o = (jnp.einsum('bhts,bhsv->bhtv', scores, vb)
             + jnp.einsum('bhtk,bhkv->bhtv', qb * jnp.exp(cum), state))
        cum_end = cum[:, :, -1:, :]
        k_dec = kb * jnp.exp(cum_end - cum)
        state = (jnp.swapaxes(jnp.exp(cum_end), -1, -2) * state
                 + jnp.einsum('bhsk,bhsv->bhkv', k_dec, vb))
        return state, o

    s_fin, o = lax.scan(step, s0, (to_chunks(q), to_chunks(k), to_chunks(v), to_chunks(log_a)))
    return o.transpose(1, 2, 0, 3, 4).reshape(b, h, n_tok, dv), s_fin


def _orient(t, d):
    return jnp.flip(t, axis=2) if d == 1 else t


def bidir_scan(q, k, v, log_a, qc, kc, vc, log_ac, need_ctx):
    b, h, _, dk = q.shape
    s0 = jnp.zeros((b, h, dk, v.shape[-1]), F32)
    outs, outs_c = [], []
    for d in range(2):
        oc, sc = chunk_recurrence(_orient(qc, d), _orient(kc, d), _orient(vc, d), _orient(log_ac[d], d), s0)
        o, _ = chunk_recurrence(_orient(q, d), _orient(k, d), _orient(v, d), _orient(log_a[d], d), sc)
        outs.append(_orient(o, d))
        outs_c.append(_orient(oc, d))
    out_c = outs_c[0] + outs_c[1] if need_ctx else None
    return outs[0] + outs[1], out_c


def retention(q, k, v, g, qc, kc, vc, gc, decay_p, norm_g, need_ctx):
    b, n_lat, _ = q.shape
    n_ctx = qc.shape[1]
    cos, sin = axial_rope_tables(n_lat, RET_DH)
    scale = RET_DH ** -0.5
    q = apply_rope(split_heads(q, RET_HEADS).astype(F32), cos, sin)
    k = apply_rope(split_heads(k, RET_HEADS).astype(F32), cos, sin) * scale
    v = split_heads(v, RET_HEADS).astype(F32)
    qc = split_heads(qc, RET_HEADS).astype(F32)
    kc = split_heads(kc, RET_HEADS).astype(F32) * scale
    vc = split_heads(vc, RET_HEADS).astype(F32)
    log_gamma = -jnp.exp(decay_p.astype(F32))
    la = [jnp.broadcast_to(log_gamma[d][None, :, None, None], (b, RET_HEADS, n_lat, 1)) for d in range(2)]
    lac = [jnp.broadcast_to(log_gamma[d][None, :, None, None], (b, RET_HEADS, n_ctx, 1)) for d in range(2)]
    o, oc = bidir_scan(q, k, v, la, qc, kc, vc, lac, need_ctx)
    g_norm = norm_g.reshape(RET_HEADS, 1, RET_DH)

    def post(o_, g_):
        return merge_heads(rms_norm(o_, g_norm)) * jax.nn.silu(g_.astype(F32))

    out_c = post(oc, gc) if need_ctx else None
    return post(o, g), out_c


def gla(q, k, v, r, glr, qc, kc, vc, rc, glrc, gate_w, gate_b, norm_g, need_ctx):
    def decays(t):
        b, n, _ = t.shape
        t = t.astype(F32).reshape(b, n, 2, GLA_RANK)
        logit = jnp.einsum('bndr,drk->dbnk', t, gate_w.astype(F32)) + gate_b.astype(F32)[:, None, None, :]
        la = jax.nn.log_sigmoid(logit) / GLA_GATE_NORM
        return [split_heads(la[d], GLA_HEADS) for d in range(2)]

    scale = GLA_DK ** -0.5
    qh = split_heads(q, GLA_HEADS).astype(F32) * scale
    kh = split_heads(k, GLA_HEADS).astype(F32)
    vh = split_heads(v, GLA_HEADS).astype(F32)
    qch = split_heads(qc, GLA_HEADS).astype(F32) * scale
    kch = split_heads(kc, GLA_HEADS).astype(F32)
    vch = split_heads(vc, GLA_HEADS).astype(F32)
    o, oc = bidir_scan(qh, kh, vh, decays(glr), qch, kch, vch, decays(glrc), need_ctx)

    def post(o_, r_):
        return merge_heads(rms_norm(o_, norm_g)) * jax.nn.silu(r_.astype(F32))

    out_c = post(oc, rc) if need_ctx else None
    return post(o, r), out_c


def token_mixer(h, hc, w_in, w_out, diff_lambda, diff_subln_g, lam_init,
                hy_short_w, hy_short_b, hy_w1, hy_b1, hy_w2, hy_b2, hy_w3, hy_freq, hy_bias,
                ret_decay, ret_norm_g, gla_gate_w, gla_gate_b, gla_norm_g, need_ctx):
    n_lat = h.shape[1]
    n_ctx = hc.shape[1]
    cuts = np.cumsum(SPLIT_SIZES)[:-1].tolist()
    p = jnp.split(h @ w_in, cuts, axis=-1)
    pc = jnp.split(hc @ w_in, cuts, axis=-1)
    a, a_c = diff_attention(p[0], p[1], p[2], pc[0], pc[1], pc[2], diff_lambda, diff_subln_g, lam_init, need_ctx)
    hy = hyena_seq(p[3], hy_short_w, hy_short_b,
                   hyena_filter(n_lat, hy_w1, hy_b1, hy_w2, hy_b2, hy_w3, hy_freq), hy_bias)
    rt, rt_c = retention(p[4], p[5], p[6], p[7], pc[4], pc[5], pc[6], pc[7], ret_decay, ret_norm_g, need_ctx)
    gl, gl_c = gla(p[8], p[9], p[10], p[11], p[12], pc[8], pc[9], pc[10], pc[11], pc[12],
                   gla_gate_w, gla_gate_b, gla_norm_g, need_ctx)
    y = jnp.concatenate([a, hy, rt, gl], axis=-1) @ w_out
    y_c = None
    if need_ctx:
        hy_c = hyena_seq(pc[3], hy_short_w, hy_short_b,
                         hyena_filter(n_ctx, hy_w1, hy_b1, hy_w2, hy_b2, hy_w3, hy_freq), hy_bias)
        y_c = jnp.concatenate([a_c, hy_c, rt_c, gl_c], axis=-1) @ w_out
    return y, y_c


def moe_ffn(h, router_w, router_b, w1, b1, w2, b2):
    logits = (h @ router_w + router_b).astype(F32)
    top_val, top_idx = lax.top_k(logits, TOP_K)
    top_w = jax.nn.softmax(top_val, axis=-1)
    combine = jnp.einsum('nk,nke->ne', top_w, jax.nn.one_hot(top_idx, N_EXPERTS, dtype=F32))

    def expert(acc, blk):
        w1e, b1e, w2e, b2e, ce = blk
        u = (h @ w1e + b1e).astype(F32)
        glu = jnp.minimum(u[:, ::2], SWIGLU_LIMIT)
        lin = jnp.clip(u[:, 1::2], -SWIGLU_LIMIT, SWIGLU_LIMIT)
        act = glu * jax.nn.sigmoid(SWIGLU_ALPHA * glu) * (lin + 1.0)
        return acc + ce[:, None] * (act @ w2e + b2e).astype(F32), None

    out, _ = lax.scan(expert, jnp.zeros(h.shape, F32), (w1, b1, w2, b2, combine.T))
    return out


def setup_inputs(seed: int = 0) -> dict:
    key = jax.random.key(seed)
    ks = jax.random.split(key, 32)
    counter = [0]

    def nrm(shape, scale):
        k = ks[counter[0]]
        counter[0] += 1
        return jax.random.normal(k, shape, F32) * scale

    ret_init = jnp.log(-jnp.log(1.0 - 2.0 ** (-5.0 - jnp.arange(RET_HEADS, dtype=F32))))
    return {
        'x': nrm((BATCH, SEQ, D_MODEL), 1.0),
        'c': nrm((BATCH, D_MODEL), 1.0),
        'ctx': nrm((BATCH, CTX_LEN, D_MODEL), 1.0),
        'c_ctx': nrm((D_MODEL,), 1.0),
        'w_mod': nrm((DEPTH, D_MODEL, 6 * D_MODEL), 0.5 * D_MODEL ** -0.5),
        'b_mod': nrm((DEPTH, 6 * D_MODEL), 0.02),
        'norm_g': 1.0 + nrm((DEPTH, 4, D_MODEL), 0.02),
        'w_in': nrm((DEPTH, D_MODEL, IN_W), D_MODEL ** -0.5),
        'w_out': nrm((DEPTH, MIX_W, D_MODEL), MIX_W ** -0.5),
        'diff_lambda': nrm((DEPTH, 4, DIFF_DQK), 0.1),
        'diff_subln_g': 1.0 + nrm((DEPTH, DIFF_DV), 0.02),
        'hy_short_w': nrm((DEPTH, 3, 3 * HY_CH), 3 ** -0.5),
        'hy_short_b': nrm((DEPTH, 3 * HY_CH), 0.02),
        'hy_w1': nrm((DEPTH, HY_EMB, HY_FFN), HY_EMB ** -0.5),
        'hy_b1': nrm((DEPTH, HY_FFN), 0.02),
        'hy_w2': nrm((DEPTH, HY_FFN, HY_FFN), HY_FFN ** -0.5),
        'hy_b2': nrm((DEPTH, HY_FFN), 0.02),
        'hy_w3': nrm((DEPTH, HY_FFN, 2 * HY_CH), HY_FFN ** -0.5),
        'hy_freq': 1.0 + nrm((DEPTH, 2, HY_FFN), 0.02),
        'hy_bias': nrm((DEPTH, HY_CH), 1.0),
        'ret_decay': ret_init[None, None, :] + nrm((DEPTH, 2, RET_HEADS), 0.05),
        'ret_norm_g': 1.0 + nrm((DEPTH, GROUP_W), 0.02),
        'gla_gate_w': nrm((DEPTH, 2, GLA_RANK, GLA_HEADS * GLA_DK), GLA_RANK ** -0.5),
        'gla_gate_b': nrm((DEPTH, 2, GLA_HEADS * GLA_DK), 0.1),
        'gla_norm_g': 1.0 + nrm((DEPTH, GLA_DV), 0.02),
        'router_w': nrm((DEPTH, D_MODEL, N_EXPERTS), D_MODEL ** -0.5),
        'router_b': nrm((DEPTH, N_EXPERTS), 0.01),
        'exp_w1': nrm((DEPTH, N_EXPERTS, D_MODEL, 2 * D_EXPERT), D_MODEL ** -0.5),
        'exp_b1': nrm((DEPTH, N_EXPERTS, 2 * D_EXPERT), 0.01),
        'exp_w2': nrm((DEPTH, N_EXPERTS, D_EXPERT, D_MODEL), D_EXPERT ** -0.5),
        'exp_b2': nrm((DEPTH, N_EXPERTS, D_MODEL), 0.01),
    }


def reference(x, c, ctx, c_ctx, w_mod, b_mod, norm_g, w_in, w_out, diff_lambda, diff_subln_g,
              hy_short_w, hy_short_b, hy_w1, hy_b1, hy_w2, hy_b2, hy_w3, hy_freq, hy_bias,
              ret_decay, ret_norm_g, gla_gate_w, gla_gate_b, gla_norm_g,
              router_w, router_b, exp_w1, exp_b1, exp_w2, exp_b2):
    b, n_lat, d = x.shape
    n_ctx = ctx.shape[1]
    xc = ctx
    for l in range(DEPTH):
        need_ctx = l < DEPTH - 1
        mod = (jax.nn.silu(c) @ w_mod[l] + b_mod[l]).astype(F32)
        mod_c = (jax.nn.silu(c_ctx) @ w_mod[l] + b_mod[l]).astype(F32)
        sh_a, sc_a, gt_a, sh_f, sc_f, gt_f = jnp.split(mod[:, None, :], 6, axis=-1)
        shc_a, scc_a, gtc_a, shc_f, scc_f, gtc_f = jnp.split(mod_c, 6)
        lam_init = 0.8 - 0.6 * math.exp(-0.3 * l)

        h = rms_norm(x, norm_g[l, 0]) * (1.0 + sc_a) + sh_a
        hc = rms_norm(xc, norm_g[l, 0]) * (1.0 + scc_a) + shc_a
        y, y_c = token_mixer(h, hc, w_in[l], w_out[l], diff_lambda[l], diff_subln_g[l], lam_init,
                             hy_short_w[l], hy_short_b[l], hy_w1[l], hy_b1[l], hy_w2[l], hy_b2[l],
                             hy_w3[l], hy_freq[l], hy_bias[l], ret_decay[l], ret_norm_g[l],
                             gla_gate_w[l], gla_gate_b[l], gla_norm_g[l], need_ctx)
        x = x + (gt_a * rms_norm(y, norm_g[l, 1])).astype(x.dtype)
        if need_ctx:
            xc = xc + (gtc_a * rms_norm(y_c, norm_g[l, 1])).astype(xc.dtype)

        h = (rms_norm(x, norm_g[l, 2]) * (1.0 + sc_f) + sh_f).reshape(b * n_lat, d)
        if need_ctx:
            hc = (rms_norm(xc, norm_g[l, 2]) * (1.0 + scc_f) + shc_f).reshape(b * n_ctx, d)
            h = jnp.concatenate([h, hc], axis=0)
        y_all = moe_ffn(h, router_w[l], router_b[l], exp_w1[l], exp_b1[l], exp_w2[l], exp_b2[l])
        y = y_all[:b * n_lat].reshape(b, n_lat, d)
        x = x + (gt_f * rms_norm(y, norm_g[l, 3])).astype(x.dtype)
        if need_ctx:
            y_c = y_all[b * n_lat:].reshape(b, n_ctx, d)
            xc = xc + (gtc_f * rms_norm(y_c, norm_g[l, 3])).astype(xc.dtype)
    return x
```

```cpp
#include <hip/hip_runtime.h>
#include <stdint.h>
#include <stdio.h>
#include <math.h>

constexpr int D = 1024, BATCH = 4, SEQ = 4096, CTXL = 256, DEPTH = 2;
constexpr int NLAT = BATCH * SEQ, NCTX = BATCH * CTXL, MALL = NLAT + NCTX;
constexpr int INW = 3360, PW = 3584;
constexpr int NEXP = 32, TOPK = 4;
constexpr float EPS = 1e-6f;
constexpr int PC_AQ = 0, PC_AK = 256, PC_AV = 512, PC_HY = 768, PC_RQ = 1536, PC_RK = 1792, PC_RV = 2048, PC_RG = 2304,
              PC_GQ = 2560, PC_GK = 2688, PC_GV = 2816, PC_GR = 3072, PC_GD = 3328;
constexpr int ACT_ROWS = MALL * TOPK + NEXP * 256;

typedef unsigned short bf16_t;
__device__ __forceinline__ bf16_t f2bf(float f) { unsigned u = __float_as_uint(f); return (bf16_t)((u + 0x7fffu + ((u >> 16) & 1u)) >> 16); }
__device__ __forceinline__ float bf2f(bf16_t b) { return __uint_as_float(((unsigned)b) << 16); }

constexpr size_t MiB = 1u << 20;
constexpr size_t WS_CTL = 0;
constexpr size_t WS_MOD = 1 * MiB;
constexpr size_t WS_WEFF = 3 * MiB;
constexpr size_t WS_FILT = 6 * MiB;
constexpr size_t WS_FILTC = WS_FILT + 16 * MiB;
constexpr size_t WS_XRES = 24 * MiB;
constexpr size_t WS_HB = WS_XRES + 68 * MiB;
constexpr size_t WS_PBUF = WS_HB + 34 * MiB;
constexpr size_t WS_CONCAT = WS_PBUF + 120 * MiB;
constexpr size_t WS_YBUF = WS_CONCAT + 34 * MiB;
constexpr size_t WS_QA = WS_YBUF + 68 * MiB;
constexpr size_t WS_KA = WS_QA + 17 * MiB;
constexpr size_t WS_QR = WS_KA + 17 * MiB;
constexpr size_t WS_KR = WS_QR + 17 * MiB;
constexpr size_t WS_OA = WS_KR + 17 * MiB;
constexpr size_t WS_Z = WS_OA + 34 * MiB;
constexpr size_t WS_X0 = WS_Z + 17 * MiB;
constexpr size_t WS_LA = WS_X0 + 17 * MiB;
constexpr size_t WS_OD = WS_LA + 17 * MiB;
constexpr size_t WS_TOPI = WS_OD + 68 * MiB;
constexpr size_t WS_TOPW = WS_TOPI + 1 * MiB;
constexpr size_t WS_LIST = WS_TOPW + 1 * MiB;
constexpr size_t WS_ACT = WS_LIST + 3 * MiB;
constexpr size_t WS_YSLOT = WS_ACT + 160 * MiB;
constexpr size_t WS_END = WS_YSLOT + 160 * MiB;
constexpr int CW_CNT = 1024;
constexpr int CW_NORM = 2048;

struct P {
    const float *x, *c, *ctx, *c_ctx, *w_mod, *b_mod, *norm_g, *w_in, *w_out, *diff_lambda, *diff_subln_g, *hy_short_w, *hy_short_b,
        *hy_w1, *hy_b1, *hy_w2, *hy_b2, *hy_w3, *hy_freq, *hy_bias, *ret_decay, *ret_norm_g, *gla_gate_w, *gla_gate_b, *gla_norm_g,
        *router_w, *router_b, *exp_w1, *exp_b1, *exp_w2, *exp_b2;
    float* out; unsigned char* ws;
};
typedef const __attribute__((address_space(4))) P* KP;
#define p (*kp)
#define WSP(T, off) ((T*)(p.ws + (off)))

__device__ __forceinline__ float wave_sum(float v) {
#pragma unroll
    for (int o = 1; o < 64; o <<= 1) v += __shfl_xor(v, o);
    return v;
}
__device__ __forceinline__ float silu_f(float x) { return x / (1.f + expf(-x)); }
__host__ __device__ __forceinline__ int nrows_l(int l) { return l == 0 ? MALL : NLAT; }
__device__ __forceinline__ int mod_r(int row) { return row < NLAT ? row / SEQ : 4; }
__device__ __forceinline__ void seq_info(int row, int& base, int& n, int& t) {
    if (row < NLAT) { base = row & ~(SEQ - 1); n = SEQ; t = row - base; }
    else { int r = row - NLAT; base = NLAT + (r & ~(CTXL - 1)); n = CTXL; t = row - base; }
}

#define XB_TMO      128
#define XB_XCNT(j)  (256  + 64 * (j))
#define XB_XSUB(j)  (1280 + 64 * (j))
#define XB_XGEN(j)  (2304 + 64 * (j))
#define XB_TOP      3328
#define XB_TOPGEN   3392
#define XCD_BAR_WORDS 3456
#define XB_SPIN_CAP (1u << 22)
#define LAS __attribute__((address_space(3)))
__device__ __forceinline__ unsigned xb_ld(unsigned* ptr)            { return __hip_atomic_load(ptr, __ATOMIC_RELAXED, __HIP_MEMORY_SCOPE_AGENT); }
__device__ __forceinline__ unsigned xb_add(unsigned* ptr, unsigned v) { return __hip_atomic_fetch_add(ptr, v, __ATOMIC_RELAXED, __HIP_MEMORY_SCOPE_AGENT); }
__device__ __forceinline__ unsigned xb_xcc_id() { return (unsigned)__builtin_amdgcn_s_getreg((3 << 11) | 20) & 0xFu; }
#define XB_SPIN(cond, bar) do { unsigned _sp = 0; while (cond) { __builtin_amdgcn_s_sleep(1); \
    if ((++_sp & 255u) == 0u) { if (xb_ld(&(bar)[XB_TMO])) break; if (_sp > XB_SPIN_CAP) { atomicAdd(&(bar)[XB_TMO], 1u); break; } } } } while (0)
struct XcdBarrier { unsigned* bar; unsigned x; volatile LAS unsigned* st; };
__device__ __forceinline__ XcdBarrier xcd_barrier_post(unsigned* bar, volatile LAS unsigned* st) {
    XcdBarrier b; b.bar = bar; b.x = xb_xcc_id(); b.st = st;
    if (threadIdx.x == 0) (void)xb_add(&bar[XB_XCNT(b.x)], 1u);
    return b;
}
__device__ __forceinline__ void xcd_barrier_complete(unsigned* bar, unsigned x, unsigned& nloc, unsigned& nx) {
    const unsigned G = gridDim.x * gridDim.y * gridDim.z;
    unsigned sum, cnt, mine, sp = 0u;
    for (;;) {
        sum = 0u; cnt = 0u; mine = 0u;
#pragma unroll
        for (unsigned j = 0; j < 16; ++j) { const unsigned c = xb_ld(&bar[XB_XCNT(j)]); sum += c; cnt += (c > 0u) ? 1u : 0u; mine = (j == x) ? c : mine; }
        if (sum == G) break;
        __builtin_amdgcn_s_sleep(1);
        if ((++sp & 255u) == 0u) { if (xb_ld(&bar[XB_TMO])) break; if (sp > XB_SPIN_CAP) { atomicAdd(&bar[XB_TMO], 1u); break; } }
    }
    nloc = mine > 0u ? mine : 1u; nx = cnt > 0u ? cnt : 1u;
}
__device__ __forceinline__ void xcd_barrier(const XcdBarrier& b) {
    asm volatile("s_waitcnt vmcnt(0)" ::: "memory");
    __syncthreads();
    if (threadIdx.x == 0) {
        unsigned* bar = b.bar;
        __builtin_amdgcn_s_waitcnt(0);
        unsigned nloc = b.st[0], nx = b.st[1];
        if (nloc == 0u) { xcd_barrier_complete(bar, b.x, nloc, nx); b.st[0] = nloc; b.st[1] = nx; }
        const unsigned old = xb_add(&bar[XB_XSUB(b.x)], 1u);
        const unsigned gen = old / nloc;
        if (old + 1u == (gen + 1u) * nloc) {
            __builtin_amdgcn_fence(__ATOMIC_RELEASE, "agent");
            asm volatile("s_waitcnt vmcnt(0)" ::: "memory");
            const unsigned og = xb_add(&bar[XB_TOP], 1u);
            const unsigned tg = og / nx;
            if (og + 1u == (tg + 1u) * nx) xb_add(&bar[XB_TOPGEN], 1u);
            else XB_SPIN(xb_ld(&bar[XB_TOPGEN]) == tg, bar);
            __builtin_amdgcn_fence(__ATOMIC_ACQUIRE, "agent");
            xb_add(&bar[XB_XGEN(b.x)], 1u);
            asm volatile("s_waitcnt vmcnt(0)" ::: "memory");
        } else {
            XB_SPIN(xb_ld(&bar[XB_XGEN(b.x)]) == gen, bar);
            __builtin_amdgcn_fence(__ATOMIC_ACQUIRE, "agent");
            asm volatile("s_waitcnt vmcnt(0)" ::: "memory");
        }
    }
    __syncthreads();
}

constexpr int NT = 512;
#define GT_LOOP(idx, total) for (int idx = blockIdx.x * NT + threadIdx.x; idx < (total); idx += gridDim.x * NT)
#define GW_LOOP(w, total) for (int w = blockIdx.x * (NT / 64) + (threadIdx.x >> 6); w < (total); w += gridDim.x * (NT / 64))

__device__ __forceinline__ void d_init(KP kp) {
    float* xr = WSP(float, WS_XRES);
    GT_LOOP(i, MALL * D) xr[i] = i < NLAT * D ? p.x[i] : p.ctx[i - NLAT * D];
}
__device__ __forceinline__ void d_mod(KP kp) {
    GT_LOOP(idx, 2 * 5 * 6144) {
        int j = idx % 6144, r = (idx / 6144) % 5, l = idx / (6144 * 5);
        const float* cv = r < 4 ? p.c + r * D : p.c_ctx;
        const float* w = p.w_mod + (size_t)l * D * 6144;
        float acc = 0.f;
        for (int i = 0; i < D; ++i) acc += silu_f(cv[i]) * w[(size_t)i * 6144 + j];
        WSP(float, WS_MOD)[idx] = acc + p.b_mod[l * 6144 + j];
    }
}
__device__ __forceinline__ void d_filter(KP kp, int which, float* sm) {
    const int l = which == 1 ? 1 : 0, n = which == 2 ? CTXL : SEQ, tid = threadIdx.x;
    float* filt = which == 2 ? WSP(float, WS_FILTC) : WSP(float, WS_FILT) + (size_t)l * 8192 * 256;
    float* zf = sm; float* h1 = sm + 64; float* h2 = sm + 128;
    for (int pos = blockIdx.x; pos < n; pos += gridDim.x) {
        const float t = (float)pos / (float)(n - 1);
        const float w = (6.2831855f * (float)pos) / (float)n;
        if (tid == 0) zf[0] = t;
        if (tid < 16) { float f = 1e-4f + (15.f - 1e-4f) * ((float)tid / 15.f); float a = w * f; zf[1 + tid] = cosf(a); zf[17 + tid] = -sinf(a); }
        __syncthreads();
        if (tid < 64) { float a = p.hy_b1[l * 64 + tid]; for (int i = 0; i < 33; ++i) a += zf[i] * p.hy_w1[(l * 33 + i) * 64 + tid]; h1[tid] = sinf(p.hy_freq[(l * 2 + 0) * 64 + tid] * a); }
        __syncthreads();
        if (tid < 64) { float a = p.hy_b2[l * 64 + tid]; for (int i = 0; i < 64; ++i) a += h1[i] * p.hy_w2[(l * 64 + i) * 64 + tid]; h2[tid] = sinf(p.hy_freq[(l * 2 + 1) * 64 + tid] * a); }
        __syncthreads();
        float raw = 0.f;
        for (int j = 0; j < 64; ++j) raw += h2[j] * p.hy_w3[(l * 64 + j) * 512 + tid];
        const int c = tid & 255;
        const float mind = logf(1e-2f) / 1.5f, maxd = logf(1e-2f) / 0.3f;
        const float delta = fabsf(mind + (maxd - mind) * ((float)c / 255.f));
        const float v = raw * expf(-t * delta);
        if (tid < 256) { filt[(size_t)pos * 256 + c] = v; if (pos == 0) filt[(size_t)n * 256 + c] = 0.f; }
        else if (pos >= 1) { filt[(size_t)(2 * n - pos) * 256 + c] = v; }
        __syncthreads();
    }
}
__device__ __forceinline__ void d_filter_psum(KP kp) {
    GT_LOOP(idx, 66 * 256) {
        const int vb = idx >> 8, c = idx & 255;
        const int which = vb < 32 ? 0 : vb < 64 ? 1 : 2, blk = vb < 64 ? (vb & 31) : vb - 64, l = which == 1 ? 1 : 0;
        const float* filt = which == 2 ? WSP(float, WS_FILTC) : WSP(float, WS_FILT) + (size_t)l * 8192 * 256;
        float a = 0.f;
        for (int i = 0; i < 256; ++i) a += fabsf(filt[(size_t)(blk * 256 + i) * 256 + c]);
        (WSP(float, WS_CTL) + CW_NORM)[(which * 32 + blk) * 256 + c] = a;
    }
}
__device__ __forceinline__ void d_filter_norm(KP kp) {
    GT_LOOP(gidx, (2 * 8192 + 512) * 256) {
        const int which = gidx < 8192 * 256 ? 0 : gidx < 2 * 8192 * 256 ? 1 : 2, idx = gidx - which * 8192 * 256;
        const int l = which == 1 ? 1 : 0, n = which == 2 ? CTXL : SEQ;
        float* filt = which == 2 ? WSP(float, WS_FILTC) : WSP(float, WS_FILT) + (size_t)l * 8192 * 256;
        const float* ps = WSP(float, WS_CTL) + CW_NORM + which * 32 * 256;
        const int c = idx & 255, tau = idx >> 8;
        float nrm = 0.f;
        for (int j = 0; j < 2 * n / 256; ++j) nrm += ps[j * 256 + c];
        float v = filt[idx] / nrm;
        if (tau == 0) v += p.hy_bias[l * 256 + c];
        filt[idx] = v;
    }
}
__device__ __forceinline__ void d_weff(KP kp) {
    GT_LOOP(idx, 2 * 1024 * 256) {
        int n = idx & 255, i = (idx >> 8) & 1023, l = idx >> 18, d = n >> 7, j = n & 127;
        float a = 0.f;
        for (int r = 0; r < 16; ++r) a += p.w_in[((size_t)l * D + i) * INW + 3328 + d * 16 + r] * p.gla_gate_w[((l * 2 + d) * 16 + r) * 128 + j];
        WSP(float, WS_WEFF)[idx] = a;
    }
}
__device__ __forceinline__ void d_norm1(KP kp, int l) {
    const int lane = threadIdx.x & 63;
    GW_LOOP(row, MALL) {
        const float* xr = WSP(float, WS_XRES) + (size_t)row * D;
        const float* mod = WSP(float, WS_MOD) + (size_t)(l * 5 + mod_r(row)) * 6144;
        const float* g = p.norm_g + (l * 4 + 0) * D;
        float v[16], ss = 0.f;
#pragma unroll
        for (int j = 0; j < 16; ++j) { v[j] = xr[j * 64 + lane]; ss += v[j] * v[j]; }
        const float rstd = rsqrtf(wave_sum(ss) * (1.f / D) + EPS);
        bf16_t* hb = WSP(bf16_t, WS_HB) + (size_t)row * D;
#pragma unroll
        for (int j = 0; j < 16; ++j) { int cidx = j * 64 + lane; hb[cidx] = f2bf(v[j] * rstd * g[cidx] * (1.f + mod[1024 + cidx]) + mod[cidx]); }
    }
}
template <int MODE> __device__ __forceinline__ void d_gemm(KP kp, int l, float* sm) {
    float (*As)[132] = (float (*)[132])sm; float (*Bs)[68] = (float (*)[68])(sm + 16 * 132);
    const int tid = threadIdx.x, tx = tid & 15, ty = tid >> 4;
    const unsigned* cnt = WSP(unsigned, WS_CTL) + CW_CNT + l * 32;
    const int NTN = MODE == 0 ? 52 : MODE == 1 ? 4 : MODE == 3 ? 32 : 16;
    const int NE = MODE >= 3 ? NEXP : 1;
    const int MT = MODE == 2 ? nrows_l(l) / 128 : MALL / 128;
    const int total = NE * MT * NTN;
    for (int vb = blockIdx.x; vb < total; vb += gridDim.x) {
        const int e = vb / (MT * NTN), mt = (vb / NTN) % MT, nt = vb % NTN;
        int M, N, ldb; const float* B; const bf16_t* A; const int* list = nullptr; int aoff = 0;
        if (MODE == 0) { M = MALL; N = 3328; ldb = INW; B = p.w_in + (size_t)l * D * INW; A = WSP(bf16_t, WS_HB); }
        else if (MODE == 1) { M = MALL; N = 256; ldb = 256; B = WSP(float, WS_WEFF) + (size_t)l * D * 256; A = WSP(bf16_t, WS_HB); }
        else if (MODE == 2) { M = nrows_l(l); N = 1024; ldb = 1024; B = p.w_out + (size_t)l * D * D; A = WSP(bf16_t, WS_CONCAT); }
        else {
            M = (int)cnt[e]; for (int i = 0; i < e; ++i) aoff += ((int)cnt[i] + 255) & ~255;
            list = WSP(int, WS_LIST) + (size_t)e * MALL;
            if (MODE == 3) { N = 2048; ldb = 2048; B = p.exp_w1 + ((size_t)l * NEXP + e) * D * 2048; A = WSP(bf16_t, WS_HB); }
            else { N = 1024; ldb = 1024; B = p.exp_w2 + ((size_t)l * NEXP + e) * D * D; A = WSP(bf16_t, WS_ACT); }
        }
        (void)N;
        const int m0 = mt * 128, n0 = nt * 64;
        if (m0 >= M) continue;
        const int ar = tid >> 2, ak = (tid & 3) * 4;
        const int arow = m0 + ar; const bool avalid = arow < M;
        size_t abase = 0;
        if (avalid) { if (MODE == 3) abase = (size_t)(list[arow] >> 2) * D; else if (MODE == 4) abase = (size_t)(aoff + arow) * D; else abase = (size_t)arow * D; }
        const int bk = tid >> 5, bn = (tid & 31) * 2;
        float acc[4][4] = {};
        for (int k0 = 0; k0 < D; k0 += 16) {
#pragma unroll
            for (int i = 0; i < 4; ++i) As[ak + i][ar] = avalid ? bf2f(A[abase + k0 + ak + i]) : 0.f;
#pragma unroll
            for (int i = 0; i < 2; ++i) Bs[bk][bn + i] = B[(size_t)(k0 + bk) * ldb + n0 + bn + i];
            __syncthreads();
#pragma unroll
            for (int k = 0; k < 16; ++k) {
                float a[4], b[4];
#pragma unroll
                for (int i = 0; i < 4; ++i) { a[i] = As[k][ty * 4 + i]; b[i] = Bs[k][tx * 4 + i]; }
#pragma unroll
                for (int i = 0; i < 4; ++i)
#pragma unroll
                    for (int j = 0; j < 4; ++j) acc[i][j] += a[i] * b[j];
            }
            __syncthreads();
        }
#pragma unroll
        for (int i = 0; i < 4; ++i) {
            const int r = m0 + ty * 4 + i; if (r >= M) continue;
            const int n = n0 + tx * 4;
            if (MODE == 0) { bf16_t* o = WSP(bf16_t, WS_PBUF) + (size_t)r * PW + n; for (int j = 0; j < 4; ++j) o[j] = f2bf(acc[i][j]); }
            else if (MODE == 1) { bf16_t* o = WSP(bf16_t, WS_PBUF) + (size_t)r * PW + PC_GD + n; for (int j = 0; j < 4; ++j) o[j] = f2bf(acc[i][j] + p.gla_gate_b[l * 256 + n + j]); }
            else if (MODE == 2) { float* o = WSP(float, WS_YBUF) + (size_t)r * D + n; for (int j = 0; j < 4; ++j) o[j] = acc[i][j]; }
            else if (MODE == 3) {
                const float* b1 = p.exp_b1 + ((size_t)l * NEXP + e) * 2048 + n;
                bf16_t* o = WSP(bf16_t, WS_ACT) + (size_t)(aoff + r) * D + (n >> 1);
                for (int j = 0; j < 2; ++j) {
                    float glu = fminf(acc[i][2 * j] + b1[2 * j], 7.f), lin = fminf(fmaxf(acc[i][2 * j + 1] + b1[2 * j + 1], -7.f), 7.f);
                    o[j] = f2bf(glu / (1.f + expf(-1.702f * glu)) * (lin + 1.f));
                }
            } else {
                const float* b2 = p.exp_b2 + ((size_t)l * NEXP + e) * D + n;
                const float tw = WSP(float, WS_TOPW)[list[r]];
                bf16_t* o = WSP(bf16_t, WS_YSLOT) + (size_t)(aoff + r) * D + n;
                for (int j = 0; j < 4; ++j) o[j] = f2bf((acc[i][j] + b2[j]) * tw);
            }
        }
    }
}
__device__ __forceinline__ void d_rope(KP kp) {
    GT_LOOP(idx, MALL * 256) {
        const int row = idx >> 8, col = idx & 255;
        const bf16_t* pb = WSP(bf16_t, WS_PBUF) + (size_t)row * PW;
        const bool lat = row < NLAT; const int t = row & (SEQ - 1); const float prow = (float)(t >> 6), pcol = (float)(t & 63);
        {
            const int d = col & 31, hh = d >> 4, i = d & 15, ai = i & 7;
            float q = bf2f(pb[PC_AQ + col]), k = bf2f(pb[PC_AK + col]);
            if (lat) {
                const float inv = powf(10000.f, -(float)ai / 8.f), ang = (hh ? pcol : prow) * inv, cs = cosf(ang), sn = sinf(ang);
                const int pc = i < 8 ? col + 8 : col - 8; const float sg = i < 8 ? -1.f : 1.f;
                q = q * cs + sg * bf2f(pb[PC_AQ + pc]) * sn; k = k * cs + sg * bf2f(pb[PC_AK + pc]) * sn;
            }
            WSP(float, WS_QA)[idx] = q * 0.17677669529663687f; WSP(float, WS_KA)[idx] = k;
        }
        {
            const int d = col & 63, hh = d >> 5, i = d & 31, ai = i & 15;
            float q = bf2f(pb[PC_RQ + col]), k = bf2f(pb[PC_RK + col]);
            if (lat) {
                const float inv = powf(10000.f, -(float)ai / 16.f), ang = (hh ? pcol : prow) * inv, cs = cosf(ang), sn = sinf(ang);
                const int pc = i < 16 ? col + 16 : col - 16; const float sg = i < 16 ? -1.f : 1.f;
                q = q * cs + sg * bf2f(pb[PC_RQ + pc]) * sn; k = k * cs + sg * bf2f(pb[PC_RK + pc]) * sn;
            }
            WSP(float, WS_QR)[idx] = q; WSP(float, WS_KR)[idx] = k * 0.125f;
        }
        {
            const float x = bf2f(pb[PC_GD + col]);
            const float ls = fminf(x, 0.f) - log1pf(expf(-fabsf(x)));
            WSP(float, WS_LA)[idx] = ls * (1.f / 16.f);
        }
    }
}
__device__ __forceinline__ void d_attn(KP kp, int ctxq) {
    const int nq = ctxq ? CTXL : SEQ;
    GT_LOOP(gidx, BATCH * 4 * 2 * nq) {
        int idx = gidx;
        const int q = idx % nq; idx /= nq; const int m = idx & 1, h = (idx >> 1) & 3, b = idx >> 3;
        const int qrow = ctxq ? NLAT + b * CTXL + q : b * SEQ + q;
        const float* QA = WSP(float, WS_QA); const float* KA = WSP(float, WS_KA); const bf16_t* PB = WSP(bf16_t, WS_PBUF);
        float qv[32], o[64];
#pragma unroll
        for (int d = 0; d < 32; ++d) qv[d] = QA[(size_t)qrow * 256 + h * 64 + m * 32 + d];
#pragma unroll
        for (int d = 0; d < 64; ++d) o[d] = 0.f;
        float mx = -1e30f, ls = 0.f;
        const int nk = ctxq ? CTXL : SEQ + CTXL;
        for (int s = 0; s < nk; ++s) {
            const int krow = ctxq ? NLAT + b * CTXL + s : (s < SEQ ? b * SEQ + s : NLAT + b * CTXL + (s - SEQ));
            const float* kkp = KA + (size_t)krow * 256 + h * 64 + m * 32;
            float sc = 0.f;
#pragma unroll
            for (int d = 0; d < 32; ++d) sc += qv[d] * kkp[d];
            if (sc > mx) { const float f = expf(mx - sc); ls *= f;
#pragma unroll
                for (int d = 0; d < 64; ++d) o[d] *= f;
                mx = sc; }
            const float pr = expf(sc - mx); ls += pr;
            const bf16_t* vp = PB + (size_t)krow * PW + PC_AV + h * 64;
#pragma unroll
            for (int d = 0; d < 64; ++d) o[d] += pr * bf2f(vp[d]);
        }
        float* oa = WSP(float, WS_OA) + ((size_t)qrow * 8 + h * 2 + m) * 64;
        const float inv = 1.f / ls;
#pragma unroll
        for (int d = 0; d < 64; ++d) oa[d] = o[d] * inv;
    }
}
__device__ __forceinline__ void d_attn_post(KP kp, int l) {
    const int lane = threadIdx.x & 63;
    const float* dl = p.diff_lambda + l * 4 * 32;
    float s1 = 0.f, s2 = 0.f;
    for (int i = 0; i < 32; ++i) { s1 += dl[i] * dl[32 + i]; s2 += dl[64 + i] * dl[96 + i]; }
    const float lam_init = 0.8f - 0.6f * expf(-0.3f * (float)l);
    const float lam = expf(s1) - expf(s2) + lam_init;
    GW_LOOP(w, nrows_l(l) * 4) {
        const int row = w >> 2, h = w & 3;
        const float* oa = WSP(float, WS_OA) + ((size_t)row * 8 + h * 2) * 64;
        const float v = oa[lane] - lam * oa[64 + lane];
        const float rstd = rsqrtf(wave_sum(v * v) * (1.f / 64.f) + EPS);
        WSP(bf16_t, WS_CONCAT)[(size_t)row * D + h * 64 + lane] = f2bf(v * rstd * p.diff_subln_g[l * 64 + lane] * (1.f - lam_init));
    }
}
__device__ __forceinline__ void d_hy_pre(KP kp, int l) {
    GT_LOOP(idx, MALL * 256) {
        const int row = idx >> 8, c = idx & 255;
        int base, n, t; seq_info(row, base, n, t);
        const bf16_t* pb = WSP(bf16_t, WS_PBUF) + (size_t)row * PW + PC_HY;
        float u[3];
#pragma unroll
        for (int g = 0; g < 3; ++g) {
            const int cc = g * 256 + c;
            const float* sw = p.hy_short_w + l * 3 * 768;
            float a = p.hy_short_b[l * 768 + cc] + sw[768 + cc] * bf2f(pb[cc]);
            if (t > 0) a += sw[cc] * bf2f(pb[cc - PW]);
            if (t < n - 1) a += sw[2 * 768 + cc] * bf2f(pb[cc + PW]);
            u[g] = a;
        }
        WSP(float, WS_X0)[idx] = u[0]; WSP(float, WS_Z)[idx] = u[1] * u[2];
    }
}
__device__ __forceinline__ void d_hy_conv(KP kp, int l) {
    GT_LOOP(idx, nrows_l(l) * 256) {
        const int c = idx & 255, row = idx >> 8;
        int base, n, t; seq_info(row, base, n, t);
        const float* filt = row >= NLAT ? WSP(float, WS_FILTC) : WSP(float, WS_FILT) + (size_t)l * 8192 * 256;
        const float* Z = WSP(float, WS_Z);
        float y = 0.f;
        for (int s = 0; s < n; ++s) { const int tau = (t - s) & (2 * n - 1); y += filt[(size_t)tau * 256 + c] * Z[(size_t)(base + s) * 256 + c]; }
        WSP(bf16_t, WS_CONCAT)[(size_t)row * D + 256 + c] = f2bf(WSP(float, WS_X0)[(size_t)row * 256 + c] * y);
    }
}
template <int WHICH> __device__ __forceinline__ void d_scan(KP kp, int l, int unit) {
    constexpr int DK = WHICH == 0 ? 64 : 32;
    const int lane = threadIdx.x & 63, dir = unit & 1, h = (unit >> 1) & 3, b = unit >> 3;
    const bf16_t* PB = WSP(bf16_t, WS_PBUF);
    float S[DK];
#pragma unroll
    for (int k = 0; k < DK; ++k) S[k] = 0.f;
    float gam = 0.f;
    if (WHICH == 0) gam = expf(-expf(p.ret_decay[(l * 2 + dir) * 4 + h]));
    float* od = WSP(float, WS_OD) + (size_t)dir * MALL * 256 + (WHICH ? (size_t)2 * MALL * 256 : 0);
    for (int ph = 0; ph < 2; ++ph) {
        const int n = ph == 0 ? CTXL : SEQ, base = ph == 0 ? NLAT + b * CTXL : b * SEQ;
        for (int i = 0; i < n; ++i) {
            const int row = base + (dir == 0 ? i : n - 1 - i);
            float v, o = 0.f;
            if (WHICH == 0) {
                v = bf2f(PB[(size_t)row * PW + PC_RV + h * 64 + lane]);
                const float* qp = WSP(float, WS_QR) + (size_t)row * 256 + h * 64; const float* kkp = WSP(float, WS_KR) + (size_t)row * 256 + h * 64;
#pragma unroll
                for (int k = 0; k < DK; ++k) { S[k] = gam * S[k] + kkp[k] * v; o += qp[k] * S[k]; }
            } else {
                v = bf2f(PB[(size_t)row * PW + PC_GV + h * 64 + lane]);
                const bf16_t* qp = PB + (size_t)row * PW + PC_GQ + h * 32; const bf16_t* kkp = PB + (size_t)row * PW + PC_GK + h * 32;
                const float* la = WSP(float, WS_LA) + (size_t)row * 256 + dir * 128 + h * 32;
#pragma unroll
                for (int k = 0; k < DK; ++k) { S[k] = expf(la[k]) * S[k] + bf2f(kkp[k]) * v; o += bf2f(qp[k]) * 0.17677669529663687f * S[k]; }
            }
            od[(size_t)row * 256 + h * 64 + lane] = o;
        }
    }
}
template <int WHICH> __device__ __forceinline__ void d_scan_post(KP kp, int l) {
    const int lane = threadIdx.x & 63;
    GW_LOOP(w, nrows_l(l) * 4) {
        const int row = w >> 2, h = w & 3;
        const float* od = WSP(float, WS_OD) + (WHICH ? (size_t)2 * MALL * 256 : 0);
        const float v = od[(size_t)row * 256 + h * 64 + lane] + od[(size_t)(MALL + row) * 256 + h * 64 + lane];
        const float rstd = rsqrtf(wave_sum(v * v) * (1.f / 64.f) + EPS);
        const bf16_t* pb = WSP(bf16_t, WS_PBUF) + (size_t)row * PW;
        float g, gate; int cbase;
        if (WHICH == 0) { g = p.ret_norm_g[l * 256 + h * 64 + lane]; gate = bf2f(pb[PC_RG + h * 64 + lane]); cbase = 512; }
        else { g = p.gla_norm_g[l * 64 + lane]; gate = bf2f(pb[PC_GR + h * 64 + lane]); cbase = 768; }
        WSP(bf16_t, WS_CONCAT)[(size_t)row * D + cbase + h * 64 + lane] = f2bf(v * rstd * g * silu_f(gate));
    }
}
__device__ __forceinline__ void d_router(KP kp, int l) {
    const int lane = threadIdx.x & 63;
    GW_LOOP(row, nrows_l(l)) {
        float* xr = WSP(float, WS_XRES) + (size_t)row * D;
        const float* y = WSP(float, WS_YBUF) + (size_t)row * D;
        const float* mod = WSP(float, WS_MOD) + (size_t)(l * 5 + mod_r(row)) * 6144;
        const float* g1 = p.norm_g + (l * 4 + 1) * D; const float* g2 = p.norm_g + (l * 4 + 2) * D;
        float yv[16], xv[16], ss = 0.f;
#pragma unroll
        for (int j = 0; j < 16; ++j) { yv[j] = y[j * 64 + lane]; ss += yv[j] * yv[j]; }
        float rstd = rsqrtf(wave_sum(ss) * (1.f / D) + EPS);
        ss = 0.f;
#pragma unroll
        for (int j = 0; j < 16; ++j) { const int ci = j * 64 + lane; xv[j] = xr[ci] + mod[2048 + ci] * (yv[j] * rstd * g1[ci]); xr[ci] = xv[j]; ss += xv[j] * xv[j]; }
        rstd = rsqrtf(wave_sum(ss) * (1.f / D) + EPS);
        bf16_t* hb = WSP(bf16_t, WS_HB) + (size_t)row * D;
        float hv[16];
#pragma unroll
        for (int j = 0; j < 16; ++j) { const int ci = j * 64 + lane; hv[j] = xv[j] * rstd * g2[ci] * (1.f + mod[4096 + ci]) + mod[3072 + ci]; hb[ci] = f2bf(hv[j]); }
        float mylogit = -1e30f;
        for (int e = 0; e < NEXP; ++e) {
            float a = 0.f;
#pragma unroll
            for (int j = 0; j < 16; ++j) a += hv[j] * p.router_w[((size_t)l * D + j * 64 + lane) * NEXP + e];
            a = wave_sum(a) + p.router_b[l * NEXP + e];
            if (lane == e) mylogit = a;
        }
        float tv[4]; int ti[4];
#pragma unroll
        for (int k = 0; k < 4; ++k) {
            float bv = mylogit; int bi = lane;
#pragma unroll
            for (int o = 1; o < 64; o <<= 1) { const float ov = __shfl_xor(bv, o); const int oi = __shfl_xor(bi, o); if (ov > bv || (ov == bv && oi < bi)) { bv = ov; bi = oi; } }
            tv[k] = bv; ti[k] = bi; if (lane == bi) mylogit = -1e30f;
        }
        float den = 0.f, w[4];
#pragma unroll
        for (int k = 0; k < 4; ++k) { w[k] = expf(tv[k] - tv[0]); den += w[k]; }
        if (lane < 4) {
            const int e = ti[lane];
            const unsigned pos = atomicAdd(WSP(unsigned, WS_CTL) + CW_CNT + l * 32 + e, 1u);
            WSP(int, WS_LIST)[(size_t)e * MALL + pos] = row * 4 + lane;
            WSP(float, WS_TOPW)[row * 4 + lane] = w[lane] / den;
            WSP(int, WS_TOPI)[row * 4 + lane] = e; WSP(int, WS_TOPI)[MALL * 4 + row * 4 + lane] = (int)pos;
        }
    }
}
__device__ __forceinline__ void d_combine(KP kp, int l) {
    const int lane = threadIdx.x & 63;
    const unsigned* cnt = WSP(unsigned, WS_CTL) + CW_CNT + l * 32;
    GW_LOOP(row, nrows_l(l)) {
        float acc[16];
#pragma unroll
        for (int j = 0; j < 16; ++j) acc[j] = 0.f;
        for (int k = 0; k < 4; ++k) {
            const int e = WSP(int, WS_TOPI)[row * 4 + k], pos = WSP(int, WS_TOPI)[MALL * 4 + row * 4 + k];
            int aoff = 0; for (int i = 0; i < e; ++i) aoff += ((int)cnt[i] + 255) & ~255;
            const bf16_t* ys = WSP(bf16_t, WS_YSLOT) + (size_t)(aoff + pos) * D;
#pragma unroll
            for (int j = 0; j < 16; ++j) acc[j] += bf2f(ys[j * 64 + lane]);
        }
        float ss = 0.f;
#pragma unroll
        for (int j = 0; j < 16; ++j) ss += acc[j] * acc[j];
        const float rstd = rsqrtf(wave_sum(ss) * (1.f / D) + EPS);
        float* xr = WSP(float, WS_XRES) + (size_t)row * D;
        const float* mod = WSP(float, WS_MOD) + (size_t)(l * 5 + mod_r(row)) * 6144;
        const float* g3 = p.norm_g + (l * 4 + 3) * D;
#pragma unroll
        for (int j = 0; j < 16; ++j) { const int ci = j * 64 + lane; const float v = xr[ci] + mod[5120 + ci] * (acc[j] * rstd * g3[ci]); xr[ci] = v; if (l == DEPTH - 1) p.out[(size_t)row * D + ci] = v; }
    }
}

constexpr int LDS_BYTES = 147456;
constexpr int CW_BAR = 32768;
__global__ void __launch_bounds__(NT, 2) mk_fwd(P kargs) {
    const KP kp0 = (KP)__builtin_amdgcn_kernarg_segment_ptr();
    KP kp = kp0;
#define LP ({ KP k_ = kp0; asm volatile("" : "+s"(k_)); k_; })
    extern __shared__ __attribute__((aligned(16))) unsigned char lds[];
    volatile LAS unsigned* misc = (volatile LAS unsigned*)((LAS unsigned char*)lds + LDS_BYTES - 64);
    if (threadIdx.x < 16) misc[threadIdx.x] = 0u;
    __syncthreads();
    XcdBarrier bar = xcd_barrier_post(WSP(unsigned, WS_CTL) + CW_BAR, misc);
    float* sm = (float*)lds;
#define GRID_BAR() xcd_barrier(bar)
    d_init(LP); d_mod(LP); d_weff(LP);
    d_filter(LP, 0, sm); d_filter(LP, 1, sm); d_filter(LP, 2, sm);
    GRID_BAR();
    d_filter_psum(LP);
    GRID_BAR();
    d_filter_norm(LP);
    GRID_BAR();
#pragma unroll 1
    for (int l = 0; l < DEPTH; ++l) {
        d_norm1(LP, l);
        GRID_BAR();
        d_gemm<0>(LP, l, sm); d_gemm<1>(LP, l, sm);
        GRID_BAR();
        d_rope(LP);
        GRID_BAR();
        {
            const int gw = blockIdx.x * (NT / 64) + (threadIdx.x >> 6);
            if (gw < 32) d_scan<0>(LP, l, gw); else if (gw < 64) d_scan<1>(LP, l, gw - 32);
            d_attn(LP, 0); if (l == 0) d_attn(LP, 1);
            d_hy_pre(LP, l);
        }
        GRID_BAR();
        d_attn_post(LP, l); d_hy_conv(LP, l); d_scan_post<0>(LP, l); d_scan_post<1>(LP, l);
        GRID_BAR();
        d_gemm<2>(LP, l, sm);
        GRID_BAR();
        d_router(LP, l);
        GRID_BAR();
        d_gemm<3>(LP, l, sm);
        GRID_BAR();
        d_gemm<4>(LP, l, sm);
        GRID_BAR();
        d_combine(LP, l);
   #undef p
     GRID_BAR();
    }
}

extern "C" void kernel_launch(void* const* d_in, const int* in_sizes, int n_in, void* d_out, int out_size, void* d_ws, size_t ws_size, hipStream_t stream) {
    if (n_in != 31 || ws_size < WS_END || out_size != NLAT * D) { fprintf(stderr, "kernel_launch: unexpected shapes (n_in %d ws %zu out %d)\n", n_in, ws_size, out_size); return; }
    static int grid = 0;
    if (grid == 0) {
        int dev = 0, cus = 0, per_cu = 0;
        if (hipGetDevice(&dev) != hipSuccess || hipDeviceGetAttribute(&cus, hipDeviceAttributeMultiprocessorCount, dev) != hipSuccess) { grid = -1; return; }
        if (hipFuncSetAttribute((const void*)mk_fwd, hipFuncAttributeMaxDynamicSharedMemorySize, LDS_BYTES) != hipSuccess) { fprintf(stderr, "hipFuncSetAttribute failed\n"); grid = -1; return; }
        if (hipOccupancyMaxActiveBlocksPerMultiprocessor(&per_cu, (const void*)mk_fwd, NT, LDS_BYTES) != hipSuccess || per_cu < 1) { fprintf(stderr, "occupancy query says %d\n", per_cu); }
        (void)hipGetLastError();
        grid = cus;
    }
    if (grid < 0) return;
    P hp{};
    const float** pp = (const float**)&hp;
    for (int i = 0; i < 31; ++i) pp[i] = (const float*)d_in[i];
    hp.out = (float*)d_out; hp.ws = (unsigned char*)d_ws;
    (void)hipMemsetAsync((char*)d_ws + WS_CTL, 0, 1 * MiB, stream);
    hipLaunchKernelGGL(mk_fwd, dim3(grid), dim3(NT), LDS_BYTES, stream, hp);
}
```

```cpp
#include <hip/hip_runtime.h>
#include <stdint.h>
#include <stdio.h>
#include <math.h>

constexpr int D = 1024, BATCH = 4, SEQ = 4096, CTXL = 256, DEPTH = 2;
constexpr int NLAT = BATCH * SEQ, NCTX = BATCH * CTXL, MALL = NLAT + NCTX;
constexpr int INW = 3360, PW = 3584;
constexpr int NEXP = 32, TOPK = 4;
constexpr float EPS = 1e-6f;
constexpr int PC_AQ = 0, PC_AK = 256, PC_AV = 512, PC_HY = 768, PC_RQ = 1536, PC_RK = 1792, PC_RV = 2048, PC_RG = 2304,
              PC_GQ = 2560, PC_GK = 2688, PC_GV = 2816, PC_GR = 3072, PC_GD = 3328;
constexpr int ACT_ROWS = MALL * TOPK + NEXP * 256;

typedef unsigned short bf16_t;
typedef float cvt_f32x2_t __attribute__((ext_vector_type(2))); typedef __bf16 cvt_bf16x2_t __attribute__((ext_vector_type(2)));
__device__ __forceinline__ unsigned cvtpk_rne(float lo, float hi) { cvt_f32x2_t v = {lo, hi}; cvt_bf16x2_t b = __builtin_convertvector(v, cvt_bf16x2_t); return __builtin_bit_cast(unsigned, b); }
__device__ __forceinline__ bf16_t f2bf(float f) { unsigned u = __float_as_uint(f); return (bf16_t)((u + 0x7fffu + ((u >> 16) & 1u)) >> 16); }
__device__ __forceinline__ float bf2f(bf16_t b) { return __uint_as_float(((unsigned)b) << 16); }

constexpr size_t MiB = 1u << 20;
constexpr size_t WS_CTL = 0;
constexpr size_t WS_MOD = 1 * MiB;
constexpr size_t WS_WEFF = 3 * MiB;
constexpr size_t WS_FILT = 6 * MiB;
constexpr size_t WS_FILTC = WS_FILT + 16 * MiB;
constexpr size_t WS_XRES = 24 * MiB;
constexpr size_t WS_HB = WS_XRES + 68 * MiB;
constexpr size_t WS_PBUF = WS_HB + 34 * MiB;
constexpr size_t WS_CONCAT = WS_PBUF + 120 * MiB;
constexpr size_t WS_YBUF = WS_CONCAT + 34 * MiB;
constexpr size_t WS_QA = WS_YBUF + 68 * MiB;
constexpr size_t WS_KA = WS_QA + 17 * MiB;
constexpr size_t WS_QR = WS_KA + 17 * MiB;
constexpr size_t WS_KR = WS_QR + 17 * MiB;
constexpr size_t WS_OA = WS_KR + 17 * MiB;
constexpr size_t WS_Z = WS_OA + 34 * MiB;
constexpr size_t WS_X0 = WS_Z + 17 * MiB;
constexpr size_t WS_LA = WS_X0 + 17 * MiB;
constexpr size_t WS_OD = WS_LA + 17 * MiB;
constexpr size_t WS_TOPI = WS_OD + 68 * MiB;
constexpr size_t WS_TOPW = WS_TOPI + 1 * MiB;
constexpr size_t WS_LIST = WS_TOPW + 1 * MiB;
constexpr size_t WS_ACT = WS_LIST + 3 * MiB;
constexpr size_t WS_YSLOT = WS_ACT + 160 * MiB;
constexpr size_t WS_WIN_T = WS_YSLOT + 160 * MiB;
constexpr size_t WS_WOUT_T = WS_WIN_T + 14 * MiB;
constexpr size_t WS_W1_T = WS_WOUT_T + 4 * MiB;
constexpr size_t WS_W2_T = WS_W1_T + 256 * MiB;
constexpr size_t WS_BIAS_IN = WS_W2_T + 128 * MiB;
constexpr size_t WS_QRP = WS_BIAS_IN + 1 * MiB;
constexpr size_t WS_KIMG = WS_QRP + 9 * MiB;
constexpr size_t WS_VIMG = WS_KIMG + 9 * MiB;
constexpr size_t WS_QF_R = WS_VIMG + 9 * MiB;
constexpr size_t WS_KF_R = WS_QF_R + 9 * MiB;
constexpr size_t WS_KT_R = WS_KF_R + 9 * MiB;
constexpr size_t WS_KT_G = WS_KT_R + 9 * MiB;
constexpr size_t WS_VT_R = WS_KT_G + 5 * MiB;
constexpr size_t WS_VT_G = WS_VT_R + 9 * MiB;
constexpr size_t WS_CUM_G = WS_VT_G + 9 * MiB;
constexpr size_t WS_CUMT_G = WS_CUM_G + 17 * MiB;
constexpr size_t WS_US_R = WS_CUMT_G + 17 * MiB;
constexpr size_t WS_US_G = WS_US_R + 34 * MiB;
constexpr size_t WS_UG_R = WS_US_G + 17 * MiB;
constexpr size_t WS_UG_G = WS_UG_R + 5 * MiB;
constexpr size_t WS_AG = WS_UG_G + 3 * MiB;
constexpr size_t WS_ROPE = WS_AG + 1 * MiB;
constexpr size_t WS_FSPEC = WS_ROPE + 1 * MiB;
constexpr size_t WS_ZT = WS_FSPEC + 32 * MiB;
constexpr size_t WS_YT = WS_ZT + 16 * MiB;
constexpr size_t WS_X0B = WS_YT + 16 * MiB;
constexpr size_t WS_END = WS_X0B + 8 * MiB;
constexpr int CW_CNT = 1024;
constexpr int CW_NORM = 2048;

struct P {
    const float *x, *c, *ctx, *c_ctx, *w_mod, *b_mod, *norm_g, *w_in, *w_out, *diff_lambda, *diff_subln_g, *hy_short_w, *hy_short_b,
        *hy_w1, *hy_b1, *hy_w2, *hy_b2, *hy_w3, *hy_freq, *hy_bias, *ret_decay, *ret_norm_g, *gla_gate_w, *gla_gate_b, *gla_norm_g,
        *router_w, *router_b, *exp_w1, *exp_b1, *exp_w2, *exp_b2;
    float* out; unsigned char* ws;
};
typedef const __attribute__((address_space(4))) P* KP;
#define p (*kp)
#define WSP(T, off) ((T*)(p.ws + (off)))

__device__ __forceinline__ float wave_sum(float v) {
#pragma unroll
    for (int o = 1; o < 64; o <<= 1) v += __shfl_xor(v, o);
    return v;
}
__device__ __forceinline__ float silu_f(float x) { return x / (1.f + expf(-x)); }
__host__ __device__ __forceinline__ int nrows_l(int l) { return l == 0 ? MALL : NLAT; }
__device__ __forceinline__ int mod_r(int row) { return row < NLAT ? row / SEQ : 4; }
__device__ __forceinline__ void seq_info(int row, int& base, int& n, int& t) {
    if (row < NLAT) { base = row & ~(SEQ - 1); n = SEQ; t = row - base; }
    else { int r = row - NLAT; base = NLAT + (r & ~(CTXL - 1)); n = CTXL; t = row - base; }
}

__device__ __forceinline__ int ltid();
#define XB_TMO      128
#define XB_XCNT(j)  (256  + 64 * (j))
#define XB_XSUB(j)  (1280 + 64 * (j))
#define XB_XGEN(j)  (2304 + 64 * (j))
#define XB_TOP      3328
#define XB_TOPGEN   3392
#define XCD_BAR_WORDS 3456
#define XB_SPIN_CAP (1u << 22)
#define LAS __attribute__((address_space(3)))
__device__ __forceinline__ unsigned xb_ld(unsigned* ptr)            { return __hip_atomic_load(ptr, __ATOMIC_RELAXED, __HIP_MEMORY_SCOPE_AGENT); }
__device__ __forceinline__ unsigned xb_add(unsigned* ptr, unsigned v) { return __hip_atomic_fetch_add(ptr, v, __ATOMIC_RELAXED, __HIP_MEMORY_SCOPE_AGENT); }
__device__ __forceinline__ unsigned xb_xcc_id() { return (unsigned)__builtin_amdgcn_s_getreg((3 << 11) | 20) & 0xFu; }
#define XB_SPIN(cond, bar) do { unsigned _sp = 0; while (cond) { __builtin_amdgcn_s_sleep(1); \
    if ((++_sp & 255u) == 0u) { if (xb_ld(&(bar)[XB_TMO])) break; if (_sp > XB_SPIN_CAP) { atomicAdd(&(bar)[XB_TMO], 1u); break; } } } } while (0)
struct XcdBarrier { unsigned* bar; unsigned x; volatile LAS unsigned* st; };
__device__ __forceinline__ XcdBarrier xcd_barrier_post(unsigned* bar, volatile LAS unsigned* st) {
    XcdBarrier b; b.bar = bar; b.x = xb_xcc_id(); b.st = st;
    if (threadIdx.x == 0) (void)xb_add(&bar[XB_XCNT(b.x)], 1u);
    return b;
}
__device__ __forceinline__ void xcd_barrier_complete(unsigned* bar, unsigned x, unsigned& nloc, unsigned& nx) {
    const unsigned G = gridDim.x * gridDim.y * gridDim.z;
    unsigned sum, cnt, mine, sp = 0u;
    for (;;) {
        sum = 0u; cnt = 0u; mine = 0u;
#pragma unroll
        for (unsigned j = 0; j < 16; ++j) { const unsigned c = xb_ld(&bar[XB_XCNT(j)]); sum += c; cnt += (c > 0u) ? 1u : 0u; mine = (j == x) ? c : mine; }
        if (sum == G) break;
        __builtin_amdgcn_s_sleep(1);
        if ((++sp & 255u) == 0u) { if (xb_ld(&bar[XB_TMO])) break; if (sp > XB_SPIN_CAP) { atomicAdd(&bar[XB_TMO], 1u); break; } }
    }
    nloc = mine > 0u ? mine : 1u; nx = cnt > 0u ? cnt : 1u;
}
__device__ __forceinline__ void xcd_barrier(const XcdBarrier& b) {
    asm volatile("s_waitcnt vmcnt(0)" ::: "memory");
    __syncthreads();
    if (ltid() == 0) {
        unsigned* bar = b.bar;
        __builtin_amdgcn_s_waitcnt(0);
        unsigned nloc = b.st[0], nx = b.st[1];
        if (nloc == 0u) { xcd_barrier_complete(bar, b.x, nloc, nx); b.st[0] = nloc; b.st[1] = nx; }
        const unsigned old = xb_add(&bar[XB_XSUB(b.x)], 1u);
        const unsigned gen = old / nloc;
        if (old + 1u == (gen + 1u) * nloc) {
            __builtin_amdgcn_fence(__ATOMIC_RELEASE, "agent");
            asm volatile("s_waitcnt vmcnt(0)" ::: "memory");
            const unsigned og = xb_add(&bar[XB_TOP], 1u);
            const unsigned tg = og / nx;
            if (og + 1u == (tg + 1u) * nx) xb_add(&bar[XB_TOPGEN], 1u);
            else XB_SPIN(xb_ld(&bar[XB_TOPGEN]) == tg, bar);
            __builtin_amdgcn_fence(__ATOMIC_ACQUIRE, "agent");
            xb_add(&bar[XB_XGEN(b.x)], 1u);
            asm volatile("s_waitcnt vmcnt(0)" ::: "memory");
        } else {
            XB_SPIN(xb_ld(&bar[XB_XGEN(b.x)]) == gen, bar);
            __builtin_amdgcn_fence(__ATOMIC_ACQUIRE, "agent");
            asm volatile("s_waitcnt vmcnt(0)" ::: "memory");
        }
    }
    __syncthreads();
}

constexpr int NT = 512;
extern __shared__ __attribute__((aligned(16))) unsigned char g_lds[];
constexpr int LDS_BYTES = 147456;
constexpr int LDS_WTAB = LDS_BYTES - 512;
constexpr int LDS_MISC = LDS_BYTES - 64;
__device__ __forceinline__ int hw_wave_slot() { return (int)(__builtin_amdgcn_s_getreg((5 << 11) | 4) & 63u); }
__device__ __forceinline__ int ltid() {
    const int w = __builtin_amdgcn_readfirstlane(((const LAS int*)((LAS unsigned char*)g_lds + LDS_WTAB))[hw_wave_slot()]);
    unsigned ones = ~0u; asm volatile("" : "+s"(ones));
    int t = (w << 6) | (int)__builtin_amdgcn_mbcnt_hi(ones, __builtin_amdgcn_mbcnt_lo(ones, 0u));
    asm volatile("" : "+v"(t)); return t;
}
__device__ __forceinline__ int lbid() { int b = blockIdx.x; asm volatile("" : "+s"(b)); return b; }
#define PH_IDS const int tid = ltid(), bid = lbid(); (void)tid; (void)bid
#define GT_LOOP(idx, total) for (int idx = bid * NT + tid; idx < (total); idx += gridDim.x * NT)
#define GW_LOOP(w, total) for (int w = bid * (NT / 64) + (tid >> 6); w < (total); w += gridDim.x * (NT / 64))

__device__ __forceinline__ void d_init(KP kp) {
    PH_IDS;
    GT_LOOP(idx, 64 * 24) {
        const int pos = idx / 24, j = idx % 24; float ang; float* dst;
        if (j < 8) { ang = (float)pos * powf(10000.f, -(float)j / 8.f); dst = WSP(float, WS_ROPE) + (pos * 8 + j) * 2; }
        else { ang = (float)pos * powf(10000.f, -(float)(j - 8) / 16.f); dst = WSP(float, WS_ROPE) + 1024 + (pos * 16 + (j - 8)) * 2; }
        dst[0] = cosf(ang); dst[1] = sinf(ang);
    }
    float* xr = WSP(float, WS_XRES);
    GT_LOOP(i, MALL * D) xr[i] = i < NLAT * D ? p.x[i] : p.ctx[i - NLAT * D];
}
__device__ __forceinline__ void d_mod(KP kp) {
    PH_IDS;
    GT_LOOP(idx, 2 * 5 * 6144) {
        int j = idx % 6144, r = (idx / 6144) % 5, l = idx / (6144 * 5);
        const float* cv = r < 4 ? p.c + r * D : p.c_ctx;
        const float* w = p.w_mod + (size_t)l * D * 6144;
        float acc = 0.f;
        for (int i = 0; i < D; ++i) acc += silu_f(cv[i]) * w[(size_t)i * 6144 + j];
        WSP(float, WS_MOD)[idx] = acc + p.b_mod[l * 6144 + j];
    }
}
__device__ __forceinline__ void d_filter(KP kp, int which, float* sm) {
    PH_IDS;
    const int l = which == 1 ? 1 : 0, n = which == 2 ? CTXL : SEQ;
    float* filt = which == 2 ? WSP(float, WS_FILTC) : WSP(float, WS_FILT) + (size_t)l * 8192 * 256;
    float* zf = sm; float* h1 = sm + 64; float* h2 = sm + 128;
    for (int pos = bid; pos < n; pos += gridDim.x) {
        const float t = (float)pos / (float)(n - 1);
        const float w = (6.2831855f * (float)pos) / (float)n;
        if (tid == 0) zf[0] = t;
        if (tid < 16) { float f = 1e-4f + (15.f - 1e-4f) * ((float)tid / 15.f); float a = w * f; zf[1 + tid] = cosf(a); zf[17 + tid] = -sinf(a); }
        __syncthreads();
        if (tid < 64) { float a = p.hy_b1[l * 64 + tid]; for (int i = 0; i < 33; ++i) a += zf[i] * p.hy_w1[(l * 33 + i) * 64 + tid]; h1[tid] = sinf(p.hy_freq[(l * 2 + 0) * 64 + tid] * a); }
        __syncthreads();
        if (tid < 64) { float a = p.hy_b2[l * 64 + tid]; for (int i = 0; i < 64; ++i) a += h1[i] * p.hy_w2[(l * 64 + i) * 64 + tid]; h2[tid] = sinf(p.hy_freq[(l * 2 + 1) * 64 + tid] * a); }
        __syncthreads();
        float raw = 0.f;
        for (int j = 0; j < 64; ++j) raw += h2[j] * p.hy_w3[(l * 64 + j) * 512 + tid];
        const int c = tid & 255;
        const float mind = logf(1e-2f) / 1.5f, maxd = logf(1e-2f) / 0.3f;
        const float delta = fabsf(mind + (maxd - mind) * ((float)c / 255.f));
        const float v = raw * expf(-t * delta);
        if (tid < 256) { filt[(size_t)pos * 256 + c] = v; if (pos == 0) filt[(size_t)n * 256 + c] = 0.f; }
        else if (pos >= 1) { filt[(size_t)(2 * n - pos) * 256 + c] = v; }
        __syncthreads();
    }
}
__device__ __forceinline__ void d_filter_psum(KP kp) {
    PH_IDS;
    GT_LOOP(idx, 66 * 256) {
        const int vb = idx >> 8, c = idx & 255;
        const int which = vb < 32 ? 0 : vb < 64 ? 1 : 2, blk = vb < 64 ? (vb & 31) : vb - 64, l = which == 1 ? 1 : 0;
        const float* filt = which == 2 ? WSP(float, WS_FILTC) : WSP(float, WS_FILT) + (size_t)l * 8192 * 256;
        float a = 0.f;
        for (int i = 0; i < 256; ++i) a += fabsf(filt[(size_t)(blk * 256 + i) * 256 + c]);
        (WSP(float, WS_CTL) + CW_NORM)[(which * 32 + blk) * 256 + c] = a;
    }
}
__device__ __forceinline__ void d_filter_norm(KP kp) {
    PH_IDS;
    GT_LOOP(gidx, (2 * 8192 + 512) * 256) {
        const int which = gidx < 8192 * 256 ? 0 : gidx < 2 * 8192 * 256 ? 1 : 2, idx = gidx - which * 8192 * 256;
        const int l = which == 1 ? 1 : 0, n = which == 2 ? CTXL : SEQ;
        float* filt = which == 2 ? WSP(float, WS_FILTC) : WSP(float, WS_FILT) + (size_t)l * 8192 * 256;
        const float* ps = WSP(float, WS_CTL) + CW_NORM + which * 32 * 256;
        const int c = idx & 255, tau = idx >> 8;
        float nrm = 0.f;
        for (int j = 0; j < 2 * n / 256; ++j) nrm += ps[j * 256 + c];
        float v = filt[idx] / nrm;
        if (tau == 0) v += p.hy_bias[l * 256 + c];
        filt[idx] = v;
    }
}
__device__ __forceinline__ void d_weff(KP kp) {
    PH_IDS;
    GT_LOOP(idx, 2 * 1024 * 256) {
        int n = idx & 255, i = (idx >> 8) & 1023, l = idx >> 18, d = n >> 7, j = n & 127;
        float a = 0.f;
        for (int r = 0; r < 16; ++r) a += p.w_in[((size_t)l * D + i) * INW + 3328 + d * 16 + r] * p.gla_gate_w[((l * 2 + d) * 16 + r) * 128 + j];
        WSP(float, WS_WEFF)[idx] = a;
    }
}
__device__ __forceinline__ void d_norm1(KP kp, int l) {
    PH_IDS;
    const int lane = tid & 63;
    GW_LOOP(row, MALL) {
        const float* xr = WSP(float, WS_XRES) + (size_t)row * D;
        const float* mod = WSP(float, WS_MOD) + (size_t)(l * 5 + mod_r(row)) * 6144;
        const float* g = p.norm_g + (l * 4 + 0) * D;
        float v[16], ss = 0.f;
#pragma unroll
        for (int j = 0; j < 16; ++j) { v[j] = xr[j * 64 + lane]; ss += v[j] * v[j]; }
        const float rstd = rsqrtf(wave_sum(ss) * (1.f / D) + EPS);
        bf16_t* hb = WSP(bf16_t, WS_HB) + (size_t)row * D;
#pragma unroll
        for (int j = 0; j < 16; ++j) { int cidx = j * 64 + lane; hb[cidx] = f2bf(v[j] * rstd * g[cidx] * (1.f + mod[1024 + cidx]) + mod[cidx]); }
    }
}
template <int MODE> __device__ __forceinline__ void d_gemm(KP kp, int l, float* sm) {
    PH_IDS;
    float (*As)[132] = (float (*)[132])sm; float (*Bs)[68] = (float (*)[68])(sm + 16 * 132);
    const int tx = tid & 15, ty = tid >> 4;
    const unsigned* cnt = WSP(unsigned, WS_CTL) + CW_CNT + l * 32;
    const int NTN = MODE == 0 ? 52 : MODE == 1 ? 4 : MODE == 3 ? 32 : 16;
    const int NE = MODE >= 3 ? NEXP : 1;
    const int MT = MODE == 2 ? nrows_l(l) / 128 : MALL / 128;
    const int total = NE * MT * NTN;
    for (int vb = bid; vb < total; vb += gridDim.x) {
        const int e = vb / (MT * NTN), mt = (vb / NTN) % MT, nt = vb % NTN;
        int M, N, ldb; const float* B; const bf16_t* A; const int* list = nullptr; int aoff = 0;
        if (MODE == 0) { M = MALL; N = 3328; ldb = INW; B = p.w_in + (size_t)l * D * INW; A = WSP(bf16_t, WS_HB); }
        else if (MODE == 1) { M = MALL; N = 256; ldb = 256; B = WSP(float, WS_WEFF) + (size_t)l * D * 256; A = WSP(bf16_t, WS_HB); }
        else if (MODE == 2) { M = nrows_l(l); N = 1024; ldb = 1024; B = p.w_out + (size_t)l * D * D; A = WSP(bf16_t, WS_CONCAT); }
        else {
            M = (int)cnt[e]; for (int i = 0; i < e; ++i) aoff += ((int)cnt[i] + 255) & ~255;
            list = WSP(int, WS_LIST) + (size_t)e * MALL;
            if (MODE == 3) { N = 2048; ldb = 2048; B = p.exp_w1 + ((size_t)l * NEXP + e) * D * 2048; A = WSP(bf16_t, WS_HB); }
            else { N = 1024; ldb = 1024; B = p.exp_w2 + ((size_t)l * NEXP + e) * D * D; A = WSP(bf16_t, WS_ACT); }
        }
        (void)N;
        const int m0 = mt * 128, n0 = nt * 64;
        if (m0 >= M) continue;
        const int ar = tid >> 2, ak = (tid & 3) * 4;
        const int arow = m0 + ar; const bool avalid = arow < M;
        size_t abase = 0;
        if (avalid) { if (MODE == 3) abase = (size_t)(list[arow] >> 2) * D; else if (MODE == 4) abase = (size_t)(aoff + arow) * D; else abase = (size_t)arow * D; }
        const int bk = tid >> 5, bn = (tid & 31) * 2;
        float acc[4][4] = {};
        for (int k0 = 0; k0 < D; k0 += 16) {
#pragma unroll
            for (int i = 0; i < 4; ++i) As[ak + i][ar] = avalid ? bf2f(A[abase + k0 + ak + i]) : 0.f;
#pragma unroll
            for (int i = 0; i < 2; ++i) Bs[bk][bn + i] = B[(size_t)(k0 + bk) * ldb + n0 + bn + i];
            __syncthreads();
#pragma unroll
            for (int k = 0; k < 16; ++k) {
                float a[4], b[4];
#pragma unroll
                for (int i = 0; i < 4; ++i) { a[i] = As[k][ty * 4 + i]; b[i] = Bs[k][tx * 4 + i]; }
#pragma unroll
                for (int i = 0; i < 4; ++i)
#pragma unroll
                    for (int j = 0; j < 4; ++j) acc[i][j] += a[i] * b[j];
            }
            __syncthreads();
        }
#pragma unroll
        for (int i = 0; i < 4; ++i) {
            const int r = m0 + ty * 4 + i; if (r >= M) continue;
            const int n = n0 + tx * 4;
            if (MODE == 0) { bf16_t* o = WSP(bf16_t, WS_PBUF) + (size_t)r * PW + n; for (int j = 0; j < 4; ++j) o[j] = f2bf(acc[i][j]); }
            else if (MODE == 1) { bf16_t* o = WSP(bf16_t, WS_PBUF) + (size_t)r * PW + PC_GD + n; for (int j = 0; j < 4; ++j) o[j] = f2bf(acc[i][j] + p.gla_gate_b[l * 256 + n + j]); }
            else if (MODE == 2) { float* o = WSP(float, WS_YBUF) + (size_t)r * D + n; for (int j = 0; j < 4; ++j) o[j] = acc[i][j]; }
            else if (MODE == 3) {
                const float* b1 = p.exp_b1 + ((size_t)l * NEXP + e) * 2048 + n;
                bf16_t* o = WSP(bf16_t, WS_ACT) + (size_t)(aoff + r) * D + (n >> 1);
                for (int j = 0; j < 2; ++j) {
                    float glu = fminf(acc[i][2 * j] + b1[2 * j], 7.f), lin = fminf(fmaxf(acc[i][2 * j + 1] + b1[2 * j + 1], -7.f), 7.f);
                    o[j] = f2bf(glu / (1.f + expf(-1.702f * glu)) * (lin + 1.f));
                }
            } else {
                const float* b2 = p.exp_b2 + ((size_t)l * NEXP + e) * D + n;
                const float tw = WSP(float, WS_TOPW)[list[r]];
                bf16_t* o = WSP(bf16_t, WS_YSLOT) + (size_t)(aoff + r) * D + n;
                for (int j = 0; j < 4; ++j) o[j] = f2bf((acc[i][j] + b2[j]) * tw);
            }
        }
    }
}
__device__ __forceinline__ void d_rope(KP kp) {
    PH_IDS;
    GT_LOOP(idx, MALL * 256) {
        const int row = idx >> 8, col = idx & 255;
        const bf16_t* pb = WSP(bf16_t, WS_PBUF) + (size_t)row * PW;
        const bool lat = row < NLAT; const int t = row & (SEQ - 1); const float prow = (float)(t >> 6), pcol = (float)(t & 63);
        {
            const int d = col & 31, hh = d >> 4, i = d & 15, ai = i & 7;
            float q = bf2f(pb[PC_AQ + col]), k = bf2f(pb[PC_AK + col]);
            if (lat) {
                const float inv = powf(10000.f, -(float)ai / 8.f), ang = (hh ? pcol : prow) * inv, cs = cosf(ang), sn = sinf(ang);
                const int pc = i < 8 ? col + 8 : col - 8; const float sg = i < 8 ? -1.f : 1.f;
                q = q * cs + sg * bf2f(pb[PC_AQ + pc]) * sn; k = k * cs + sg * bf2f(pb[PC_AK + pc]) * sn;
            }
            WSP(float, WS_QA)[idx] = q * 0.17677669529663687f; WSP(float, WS_KA)[idx] = k;
        }
        {
            const int d = col & 63, hh = d >> 5, i = d & 31, ai = i & 15;
            float q = bf2f(pb[PC_RQ + col]), k = bf2f(pb[PC_RK + col]);
            if (lat) {
                const float inv = powf(10000.f, -(float)ai / 16.f), ang = (hh ? pcol : prow) * inv, cs = cosf(ang), sn = sinf(ang);
                const int pc = i < 16 ? col + 16 : col - 16; const float sg = i < 16 ? -1.f : 1.f;
                q = q * cs + sg * bf2f(pb[PC_RQ + pc]) * sn; k = k * cs + sg * bf2f(pb[PC_RK + pc]) * sn;
            }
            WSP(float, WS_QR)[idx] = q; WSP(float, WS_KR)[idx] = k * 0.125f;
        }
        {
            const float x = bf2f(pb[PC_GD + col]);
            const float ls = fminf(x, 0.f) - log1pf(expf(-fabsf(x)));
            WSP(float, WS_LA)[idx] = ls * (1.f / 16.f);
        }
    }
}
__device__ __forceinline__ void d_attn(KP kp, int ctxq) {
    PH_IDS;
    const int nq = ctxq ? CTXL : SEQ;
    GT_LOOP(gidx, BATCH * 4 * 2 * nq) {
        int idx = gidx;
        const int q = idx % nq; idx /= nq; const int m = idx & 1, h = (idx >> 1) & 3, b = idx >> 3;
        const int qrow = ctxq ? NLAT + b * CTXL + q : b * SEQ + q;
        const float* QA = WSP(float, WS_QA); const float* KA = WSP(float, WS_KA); const bf16_t* PB = WSP(bf16_t, WS_PBUF);
        float qv[32], o[64];
#pragma unroll
        for (int d = 0; d < 32; ++d) qv[d] = QA[(size_t)qrow * 256 + h * 64 + m * 32 + d];
#pragma unroll
        for (int d = 0; d < 64; ++d) o[d] = 0.f;
        float mx = -1e30f, ls = 0.f;
        const int nk = ctxq ? CTXL : SEQ + CTXL;
        for (int s = 0; s < nk; ++s) {
            const int krow = ctxq ? NLAT + b * CTXL + s : (s < SEQ ? b * SEQ + s : NLAT + b * CTXL + (s - SEQ));
            const float* kkp = KA + (size_t)krow * 256 + h * 64 + m * 32;
            float sc = 0.f;
#pragma unroll
            for (int d = 0; d < 32; ++d) sc += qv[d] * kkp[d];
            if (sc > mx) { const float f = expf(mx - sc); ls *= f;
#pragma unroll
                for (int d = 0; d < 64; ++d) o[d] *= f;
                mx = sc; }
            const float pr = expf(sc - mx); ls += pr;
            const bf16_t* vp = PB + (size_t)krow * PW + PC_AV + h * 64;
#pragma unroll
            for (int d = 0; d < 64; ++d) o[d] += pr * bf2f(vp[d]);
        }
        float* oa = WSP(float, WS_OA) + ((size_t)qrow * 8 + h * 2 + m) * 64;
        const float inv = 1.f / ls;
#pragma unroll
        for (int d = 0; d < 64; ++d) oa[d] = o[d] * inv;
    }
}
__device__ __forceinline__ void d_attn_post(KP kp, int l) {
    PH_IDS;
    const int lane = tid & 63;
    const float* dl = p.diff_lambda + l * 4 * 32;
    float s1 = 0.f, s2 = 0.f;
    for (int i = 0; i < 32; ++i) { s1 += dl[i] * dl[32 + i]; s2 += dl[64 + i] * dl[96 + i]; }
    const float lam_init = 0.8f - 0.6f * expf(-0.3f * (float)l);
    const float lam = expf(s1) - expf(s2) + lam_init;
    GW_LOOP(w, nrows_l(l) * 4) {
        const int row = w >> 2, h = w & 3;
        const float* oa = WSP(float, WS_OA) + ((size_t)row * 8 + h * 2) * 64;
        const float v = oa[lane] - lam * oa[64 + lane];
        const float rstd = rsqrtf(wave_sum(v * v) * (1.f / 64.f) + EPS);
        WSP(bf16_t, WS_CONCAT)[(size_t)row * D + h * 64 + lane] = f2bf(v * rstd * p.diff_subln_g[l * 64 + lane] * (1.f - lam_init));
    }
}
__device__ __forceinline__ void d_hy_pre(KP kp, int l) {
    PH_IDS;
    GT_LOOP(idx, MALL * 256) {
        const int row = idx >> 8, c = idx & 255;
        int base, n, t; seq_info(row, base, n, t);
        const bf16_t* pb = WSP(bf16_t, WS_PBUF) + (size_t)row * PW + PC_HY;
        float u[3];
#pragma unroll
        for (int g = 0; g < 3; ++g) {
            const int cc = g * 256 + c;
            const float* sw = p.hy_short_w + l * 3 * 768;
            float a = p.hy_short_b[l * 768 + cc] + sw[768 + cc] * bf2f(pb[cc]);
            if (t > 0) a += sw[cc] * bf2f(pb[cc - PW]);
            if (t < n - 1) a += sw[2 * 768 + cc] * bf2f(pb[cc + PW]);
            u[g] = a;
        }
        WSP(float, WS_X0)[idx] = u[0]; WSP(float, WS_Z)[idx] = u[1] * u[2];
    }
}
__device__ __forceinline__ void d_hy_conv(KP kp, int l) {
    PH_IDS;
    GT_LOOP(idx, nrows_l(l) * 256) {
        const int c = idx & 255, row = idx >> 8;
        int base, n, t; seq_info(row, base, n, t);
        const float* filt = row >= NLAT ? WSP(float, WS_FILTC) : WSP(float, WS_FILT) + (size_t)l * 8192 * 256;
        const float* Z = WSP(float, WS_Z);
        float y = 0.f;
        for (int s = 0; s < n; ++s) { const int tau = (t - s) & (2 * n - 1); y += filt[(size_t)tau * 256 + c] * Z[(size_t)(base + s) * 256 + c]; }
        WSP(bf16_t, WS_CONCAT)[(size_t)row * D + 256 + c] = f2bf(WSP(float, WS_X0)[(size_t)row * 256 + c] * y);
    }
}
template <int WHICH> __device__ __forceinline__ void d_scan(KP kp, int l, int unit) {
    PH_IDS;
    constexpr int DK = WHICH == 0 ? 64 : 32;
    const int lane = tid & 63, dir = unit & 1, h = (unit >> 1) & 3, b = unit >> 3;
    const bf16_t* PB = WSP(bf16_t, WS_PBUF);
    float S[DK];
#pragma unroll
    for (int k = 0; k < DK; ++k) S[k] = 0.f;
    float gam = 0.f;
    if (WHICH == 0) gam = expf(-expf(p.ret_decay[(l * 2 + dir) * 4 + h]));
    float* od = WSP(float, WS_OD) + (size_t)dir * MALL * 256 + (WHICH ? (size_t)2 * MALL * 256 : 0);
    for (int ph = 0; ph < 2; ++ph) {
        const int n = ph == 0 ? CTXL : SEQ, base = ph == 0 ? NLAT + b * CTXL : b * SEQ;
        for (int i = 0; i < n; ++i) {
            const int row = base + (dir == 0 ? i : n - 1 - i);
            float v, o = 0.f;
            if (WHICH == 0) {
                v = bf2f(PB[(size_t)row * PW + PC_RV + h * 64 + lane]);
                const float* qp = WSP(float, WS_QR) + (size_t)row * 256 + h * 64; const float* kkp = WSP(float, WS_KR) + (size_t)row * 256 + h * 64;
#pragma unroll
                for (int k = 0; k < DK; ++k) { S[k] = gam * S[k] + kkp[k] * v; o += qp[k] * S[k]; }
            } else {
                v = bf2f(PB[(size_t)row * PW + PC_GV + h * 64 + lane]);
                const bf16_t* qp = PB + (size_t)row * PW + PC_GQ + h * 32; const bf16_t* kkp = PB + (size_t)row * PW + PC_GK + h * 32;
                const float* la = WSP(float, WS_LA) + (size_t)row * 256 + dir * 128 + h * 32;
#pragma unroll
                for (int k = 0; k < DK; ++k) { S[k] = expf(la[k]) * S[k] + bf2f(kkp[k]) * v; o += bf2f(qp[k]) * 0.17677669529663687f * S[k]; }
            }
            od[(size_t)row * 256 + h * 64 + lane] = o;
        }
    }
}
template <int WHICH> __device__ __forceinline__ void d_scan_post(KP kp, int l) {
    PH_IDS;
    const int lane = tid & 63;
    GW_LOOP(w, nrows_l(l) * 4) {
        const int row = w >> 2, h = w & 3;
        const float* od = WSP(float, WS_OD) + (WHICH ? (size_t)2 * MALL * 256 : 0);
        const float v = od[(size_t)row * 256 + h * 64 + lane] + od[(size_t)(MALL + row) * 256 + h * 64 + lane];
        const float rstd = rsqrtf(wave_sum(v * v) * (1.f / 64.f) + EPS);
        const bf16_t* pb = WSP(bf16_t, WS_PBUF) + (size_t)row * PW;
        float g, gate; int cbase;
        if (WHICH == 0) { g = p.ret_norm_g[l * 256 + h * 64 + lane]; gate = bf2f(pb[PC_RG + h * 64 + lane]); cbase = 512; }
        else { g = p.gla_norm_g[l * 64 + lane]; gate = bf2f(pb[PC_GR + h * 64 + lane]); cbase = 768; }
        WSP(bf16_t, WS_CONCAT)[(size_t)row * D + cbase + h * 64 + lane] = f2bf(v * rstd * g * silu_f(gate));
    }
}
__device__ __forceinline__ void d_router(KP kp, int l) {
    PH_IDS;
    const int lane = tid & 63;
    GW_LOOP(row, nrows_l(l)) {
        float* xr = WSP(float, WS_XRES) + (size_t)row * D;
        const float* y = WSP(float, WS_YBUF) + (size_t)row * D;
        const float* mod = WSP(float, WS_MOD) + (size_t)(l * 5 + mod_r(row)) * 6144;
        const float* g1 = p.norm_g + (l * 4 + 1) * D; const float* g2 = p.norm_g + (l * 4 + 2) * D;
        float yv[16], xv[16], ss = 0.f;
#pragma unroll
        for (int j = 0; j < 16; ++j) { yv[j] = y[j * 64 + lane]; ss += yv[j] * yv[j]; }
        float rstd = rsqrtf(wave_sum(ss) * (1.f / D) + EPS);
        ss = 0.f;
#pragma unroll
        for (int j = 0; j < 16; ++j) { const int ci = j * 64 + lane; xv[j] = xr[ci] + mod[2048 + ci] * (yv[j] * rstd * g1[ci]); xr[ci] = xv[j]; ss += xv[j] * xv[j]; }
        rstd = rsqrtf(wave_sum(ss) * (1.f / D) + EPS);
        bf16_t* hb = WSP(bf16_t, WS_HB) + (size_t)row * D;
        float hv[16];
#pragma unroll
        for (int j = 0; j < 16; ++j) { const int ci = j * 64 + lane; hv[j] = xv[j] * rstd * g2[ci] * (1.f + mod[4096 + ci]) + mod[3072 + ci]; hb[ci] = f2bf(hv[j]); }
        float mylogit = -1e30f;
        for (int e = 0; e < NEXP; ++e) {
            float a = 0.f;
#pragma unroll
            for (int j = 0; j < 16; ++j) a += hv[j] * p.router_w[((size_t)l * D + j * 64 + lane) * NEXP + e];
            a = wave_sum(a) + p.router_b[l * NEXP + e];
            if (lane == e) mylogit = a;
        }
        float tv[4]; int ti[4];
#pragma unroll
        for (int k = 0; k < 4; ++k) {
            float bv = mylogit; int bi = lane;
#pragma unroll
            for (int o = 1; o < 64; o <<= 1) { const float ov = __shfl_xor(bv, o); const int oi = __shfl_xor(bi, o); if (ov > bv || (ov == bv && oi < bi)) { bv = ov; bi = oi; } }
            tv[k] = bv; ti[k] = bi; if (lane == bi) mylogit = -1e30f;
        }
        float den = 0.f, w[4];
#pragma unroll
        for (int k = 0; k < 4; ++k) { w[k] = expf(tv[k] - tv[0]); den += w[k]; }
        if (lane < 4) {
            const int e = ti[lane];
            const unsigned pos = atomicAdd(WSP(unsigned, WS_CTL) + CW_CNT + l * 32 + e, 1u);
            WSP(int, WS_LIST)[(size_t)e * MALL + pos] = row * 4 + lane;
            WSP(float, WS_TOPW)[row * 4 + lane] = w[lane] / den;
            WSP(int, WS_TOPI)[row * 4 + lane] = e; WSP(int, WS_TOPI)[MALL * 4 + row * 4 + lane] = (int)pos;
        }
    }
}
__device__ __forceinline__ void d_combine(KP kp, int l) {
    PH_IDS;
    const int lane = tid & 63;
    const unsigned* cnt = WSP(unsigned, WS_CTL) + CW_CNT + l * 32;
    GW_LOOP(row, nrows_l(l)) {
        float acc[16];
#pragma unroll
        for (int j = 0; j < 16; ++j) acc[j] = 0.f;
        for (int k = 0; k < 4; ++k) {
            const int e = WSP(int, WS_TOPI)[row * 4 + k], pos = WSP(int, WS_TOPI)[MALL * 4 + row * 4 + k];
            int aoff = 0; for (int i = 0; i < e; ++i) aoff += ((int)cnt[i] + 255) & ~255;
            const bf16_t* ys = WSP(bf16_t, WS_YSLOT) + (size_t)(aoff + pos) * D;
#pragma unroll
            for (int j = 0; j < 16; ++j) acc[j] += bf2f(ys[j * 64 + lane]);
        }
        float ss = 0.f;
#pragma unroll
        for (int j = 0; j < 16; ++j) ss += acc[j] * acc[j];
        const float rstd = rsqrtf(wave_sum(ss) * (1.f / D) + EPS);
        float* xr = WSP(float, WS_XRES) + (size_t)row * D;
        const float* mod = WSP(float, WS_MOD) + (size_t)(l * 5 + mod_r(row)) * 6144;
        const float* g3 = p.norm_g + (l * 4 + 3) * D;
#pragma unroll
        for (int j = 0; j < 16; ++j) { const int ci = j * 64 + lane; const float v = xr[ci] + mod[5120 + ci] * (acc[j] * rstd * g3[ci]); xr[ci] = v; if (l == DEPTH - 1) p.out[(size_t)row * D + ci] = v; }
    }
}

namespace pg8 {
typedef short bf16x8 __attribute__((ext_vector_type(8)));
typedef float f32x4 __attribute__((ext_vector_type(4)));
typedef unsigned u32x4 __attribute__((ext_vector_type(4)));
typedef unsigned u32x2 __attribute__((ext_vector_type(2)));
constexpr int BM = 256, BK = 64, HALF = 128, HTB = HALF * BK * 2, STAGE_BYTES = 8 * HTB, NXCD = 8, WGM = 8, K = 1024;
__host__ __device__ __forceinline__ int lds_byte(int r, int c) { const int st = (r >> 4) * 2 + (c >> 5), rr = r & 15, cc = c & 31, ob = rr * 64 + cc * 2; return st * 1024 + (ob ^ (((ob >> 9) & 1) << 5)); }
__host__ __device__ __forceinline__ void stage_rc(int b, int& R, int& C) { const int st = b / 1024, sb = b % 1024, swz = sb ^ (((sb >> 9) & 1) << 5); R = (st >> 1) * 16 + swz / 64; C = (st & 1) * 32 + (swz % 64) / 2; }
__host__ __device__ __forceinline__ int perm32(int rho) { const int n = rho >> 4, i = rho & 15; return 8 * (i >> 2) + 4 * n + (i & 3); }
__device__ __forceinline__ unsigned cvt_pk_bf16(float lo, float hi) { return cvtpk_rne(lo, hi); }

struct Unit { int pm, pn; const char* A; const char* B; const int* gl; int gcnt; int e; int row0; };

struct DenseOrder {
    int nM, nN, nwg, G, c; const char* A; const char* Bt;
    __device__ __forceinline__ void init(int M, int N, int G_, int c_, const void* A_, const void* Bt_) { nM = M / BM; nN = N / BM; nwg = nM * nN; G = G_; c = c_; A = (const char*)A_; Bt = (const char*)Bt_; }
    __device__ __forceinline__ bool next(int i, Unit& u) const {
        const long L = (long)i * G + c; if (L >= nwg) return false;
        int wgid = (int)L; { const int q = nwg / NXCD, r = nwg % NXCD, xcd = wgid % NXCD, off = wgid / NXCD; wgid = (xcd < r ? xcd * (q + 1) : r * (q + 1) + (xcd - r) * q) + off; }
        const int nig = WGM * nN, gid = wgid / nig, fm = gid * WGM, gsz = (nM - fm) < WGM ? (nM - fm) : WGM;
        u.pm = fm + ((wgid % nig) % gsz); u.pn = (wgid % nig) / gsz;
        u.A = A + (size_t)u.pm * (BM * K * 2); u.B = Bt + (size_t)u.pn * (BM * K * 2); u.gl = nullptr; u.gcnt = BM; u.e = 0; u.row0 = u.pm * BM; return true;
    }
};
struct MoeOrder {
    const LAS int* tab; int G, c, NCT; const char* A; const char* W; size_t wstride; const int* list; const unsigned* cnt; bool gather;
    __device__ __forceinline__ bool next(int i, Unit& u) const {
        const int L = i * G + c; if (L >= tab[32]) return false;
        int e = 0;
#pragma unroll 1
        for (int j = 1; j < 32; ++j) if (L >= tab[j]) e = j;
        e = __builtin_amdgcn_readfirstlane(e);
        const int r = __builtin_amdgcn_readfirstlane(L - tab[e]), ce = __builtin_amdgcn_readfirstlane((int)cnt[e]), rte = (ce + 255) >> 8, ro = __builtin_amdgcn_readfirstlane(tab[33 + e]);
        const int ct = r / rte, rt = r - ct * rte;
        u.pm = rt; u.pn = ct; u.e = e; u.row0 = ro + rt * 256; u.gl = list + (size_t)e * MALL + rt * 256; u.gcnt = min(256, ce - rt * 256);
        u.A = gather ? A : A + (size_t)u.row0 * (K * 2); u.B = W + (size_t)e * wstride + (size_t)ct * (BM * K * 2); return true;
    }
};
__device__ __forceinline__ void moe_tab_build(LAS int* tab, const unsigned* cnt, int NCT) {
    if (ltid() == 0) { int us = 0, rs = 0; for (int e = 0; e < 32; ++e) { tab[e] = us; tab[33 + e] = rs; const int rt = ((int)cnt[e] + 255) >> 8; us += rt * NCT; rs += rt * 256; } tab[32] = us; tab[65] = rs; }
    __syncthreads();
}

struct EpiBf16 {
    static constexpr bool PERM = true; bf16_t* O; int ldc; const float* bias;
    __device__ __forceinline__ void operator()(const f32x4 (&acc)[2][2][4][2], const Unit& u, int wr, int wc, int fr, int fq) const {
        const int row0 = u.row0 + wr * 64 + fr, col0 = u.pn * BM + wc * 32 + 8 * fq;
        f32x4 bv[2][2];
#pragma unroll
        for (int bj = 0; bj < 2; ++bj)
#pragma unroll
            for (int n = 0; n < 2; ++n) bv[bj][n] = bias ? *(const f32x4*)(bias + col0 + bj * HALF + 4 * n) : (f32x4){0.f, 0.f, 0.f, 0.f};
#pragma unroll
        for (int ai = 0; ai < 2; ++ai)
#pragma unroll
            for (int m = 0; m < 4; ++m) { bf16_t* rowp = O + (size_t)(row0 + ai * HALF + m * 16) * ldc + col0;
#pragma unroll
                for (int bj = 0; bj < 2; ++bj) { const f32x4 v0 = acc[ai][bj][m][0] + bv[bj][0], v1 = acc[ai][bj][m][1] + bv[bj][1];
                    u32x4 w; w.x = cvt_pk_bf16(v0[0], v0[1]); w.y = cvt_pk_bf16(v0[2], v0[3]); w.z = cvt_pk_bf16(v1[0], v1[1]); w.w = cvt_pk_bf16(v1[2], v1[3]);
                    *(u32x4*)(rowp + bj * HALF) = w; } }
    }
};
struct EpiF32 {
    static constexpr bool PERM = false; float* O; int ldc;
    __device__ __forceinline__ void operator()(const f32x4 (&acc)[2][2][4][2], const Unit& u, int wr, int wc, int fr, int fq) const {
        const int row0 = u.row0 + wr * 64 + fr, col0 = u.pn * BM + wc * 32 + 4 * fq;
#pragma unroll
        for (int ai = 0; ai < 2; ++ai)
#pragma unroll
            for (int m = 0; m < 4; ++m) { float* rowp = O + (size_t)(row0 + ai * HALF + m * 16) * ldc + col0;
#pragma unroll
                for (int bj = 0; bj < 2; ++bj)
#pragma unroll
                    for (int n = 0; n < 2; ++n) *(f32x4*)(rowp + bj * HALF + n * 16) = acc[ai][bj][m][n]; }
    }
};
struct EpiMoeUp {
    static constexpr bool PERM = true; bf16_t* ACT; const float* b1all;
    __device__ __forceinline__ void operator()(const f32x4 (&acc)[2][2][4][2], const Unit& u, int wr, int wc, int fr, int fq) const {
        const int col0 = u.pn * BM + wc * 32 + 8 * fq; const float* b1 = b1all + (size_t)u.e * 2048;
        f32x4 bv[2][2];
#pragma unroll
        for (int bj = 0; bj < 2; ++bj)
#pragma unroll
            for (int n = 0; n < 2; ++n) bv[bj][n] = *(const f32x4*)(b1 + col0 + bj * HALF + 4 * n);
#pragma unroll
        for (int ai = 0; ai < 2; ++ai)
#pragma unroll
            for (int m = 0; m < 4; ++m) { bf16_t* rowp = ACT + (size_t)(u.row0 + wr * 64 + fr + ai * HALF + m * 16) * 1024 + (col0 >> 1);
#pragma unroll
                for (int bj = 0; bj < 2; ++bj) { const f32x4 v0 = acc[ai][bj][m][0] + bv[bj][0], v1 = acc[ai][bj][m][1] + bv[bj][1];
                    float a[4];
#pragma unroll
                    for (int j = 0; j < 4; ++j) { const float gl = fminf(j < 2 ? v0[2 * j] : v1[2 * j - 4], 7.f), ln = fminf(fmaxf(j < 2 ? v0[2 * j + 1] : v1[2 * j - 3], -7.f), 7.f);
                        a[j] = gl * __builtin_amdgcn_rcpf(1.f + __builtin_amdgcn_exp2f(-1.702f * 1.4426950408889634f * gl)) * (ln + 1.f); }
                    u32x2 w; w.x = cvt_pk_bf16(a[0], a[1]); w.y = cvt_pk_bf16(a[2], a[3]);
                    *(u32x2*)(rowp + bj * 64) = w; } }
    }
};
struct EpiMoeDown {
    static constexpr bool PERM = true; bf16_t* Y; const float* b2all; const float* topw;
    __device__ __forceinline__ void operator()(const f32x4 (&acc)[2][2][4][2], const Unit& u, int wr, int wc, int fr, int fq) const {
        const int col0 = u.pn * BM + wc * 32 + 8 * fq; const float* b2 = b2all + (size_t)u.e * 1024;
        f32x4 bv[2][2];
#pragma unroll
        for (int bj = 0; bj < 2; ++bj)
#pragma unroll
            for (int n = 0; n < 2; ++n) bv[bj][n] = *(const f32x4*)(b2 + col0 + bj * HALF + 4 * n);
#pragma unroll
        for (int ai = 0; ai < 2; ++ai)
#pragma unroll
            for (int m = 0; m < 4; ++m) { const int r = wr * 64 + fr + ai * HALF + m * 16; const float tw = r < u.gcnt ? topw[u.gl[r]] : 0.f;
                bf16_t* rowp = Y + (size_t)(u.row0 + r) * 1024 + col0;
#pragma unroll
                for (int bj = 0; bj < 2; ++bj) { const f32x4 v0 = (acc[ai][bj][m][0] + bv[bj][0]) * tw, v1 = (acc[ai][bj][m][1] + bv[bj][1]) * tw;
                    u32x4 w; w.x = cvt_pk_bf16(v0[0], v0[1]); w.y = cvt_pk_bf16(v0[2], v0[3]); w.z = cvt_pk_bf16(v1[0], v1[1]); w.w = cvt_pk_bf16(v1[2], v1[3]);
                    *(u32x4*)(rowp + bj * HALF) = w; } }
    }
};

template <class Epi, class Sched, bool GATHER, bool ALIGN_EPI>
__device__ __forceinline__ void gphase(LAS unsigned char* lds, const Sched& S, const Epi& E) {
    const int tid = ltid();
    const int wid = __builtin_amdgcn_readfirstlane(tid >> 6), lane = tid & 63, wr = wid >> 2, wc = wid & 3, fr = lane & 15, fq = lane >> 4;
    constexpr int nt = K / BK;
    unsigned voffB[2], CA2[2]; int RA[2];
#pragma unroll
    for (int i = 0; i < 2; ++i) { int R, C; stage_rc(tid * 16 + i * 8192, R, C); const int Rb = Epi::PERM ? ((R & ~31) + perm32(R & 31)) : R;
        RA[i] = R; CA2[i] = (unsigned)C * 2u; voffB[i] = (unsigned)(Rb * K + C) * 2u; }
    constexpr size_t kstep = (size_t)(BK * 2), hstep = (size_t)HALF * K * 2;
    const unsigned ldsw = (unsigned)wid * 1024u;
    const int aoff = lds_byte(wr * 64 + fr, fq * 8), boff = lds_byte(wc * 32 + fr, fq * 8);
#define PG8_SA(b, h) (((b) * 2 + (h)) * HTB)
#define PG8_SB(b, h) ((4 + (b) * 2 + (h)) * HTB)
#define PG8_GL(gp, ldsoff) __builtin_amdgcn_global_load_lds((const unsigned*)(gp), (LAS unsigned*)(lds + (ldsoff)), 16, 0, 0)
#define PG8_STB(bufoff, gbase) do { PG8_GL((const char*)(gbase) + voffB[0], (bufoff) + ldsw); PG8_GL((const char*)(gbase) + voffB[1], (bufoff) + ldsw + 8192); } while (0)
#define PG8_STA(bufoff, gbase, o) do { PG8_GL((const char*)(gbase) + (o)[0], (bufoff) + ldsw); PG8_GL((const char*)(gbase) + (o)[1], (bufoff) + ldsw + 8192); } while (0)
#define PG8_LDA(dst, b, h) do { _Pragma("unroll") for (int m = 0; m < 4; ++m) _Pragma("unroll") for (int k = 0; k < 2; ++k) dst[m][k] = *(const LAS bf16x8*)(lds + PG8_SA(b, h) + aoff + m * 2048 + k * 1024); } while (0)
#define PG8_LDB(dst, b, h) do { _Pragma("unroll") for (int n = 0; n < 2; ++n) _Pragma("unroll") for (int k = 0; k < 2; ++k) dst[n][k] = *(const LAS bf16x8*)(lds + PG8_SB(b, h) + boff + n * 2048 + k * 1024); } while (0)
#define PG8_MMA(ai, bj, At, Bt) do { __builtin_amdgcn_s_setprio(1); _Pragma("unroll") for (int m = 0; m < 4; ++m) _Pragma("unroll") for (int n = 0; n < 2; ++n) _Pragma("unroll") for (int k = 0; k < 2; ++k) \
        acc[ai][bj][m][n] = __builtin_amdgcn_mfma_f32_16x16x32_bf16(Bt[n][k], At[m][k], acc[ai][bj][m][n], 0, 0, 0); __builtin_amdgcn_s_setprio(0); } while (0)
#define PG8_WAIT_V(n) asm volatile("s_waitcnt vmcnt(" #n ")" ::: "memory")
#define PG8_WAIT_L(n) asm volatile("s_waitcnt lgkmcnt(" #n ")" ::: "memory")
#define PG8_BAR __builtin_amdgcn_s_barrier()
#define PG8_SCHED __builtin_amdgcn_sched_barrier(0)
#define PG8_AOFFS(u, o) do { _Pragma("unroll") for (int h_ = 0; h_ < 2; ++h_) _Pragma("unroll") for (int i_ = 0; i_ < 2; ++i_) { \
        if (GATHER) { const int r_ = h_ * 128 + RA[i_]; const int tok_ = r_ < (u).gcnt ? ((u).gl[r_] >> 2) : 0; o[h_][i_] = (unsigned)tok_ * (unsigned)(K * 2) + CA2[i_]; } \
        else o[h_][i_] = (unsigned)((h_ * 128 + RA[i_]) * (K * 2)) + CA2[i_]; } } while (0)
    Unit cur, nxt; int ui = 0;
    if (!S.next(0, cur)) return;
    f32x4 acc[2][2][4][2];
#pragma unroll
    for (int a = 0; a < 2; ++a)
#pragma unroll
        for (int b = 0; b < 2; ++b)
#pragma unroll
            for (int m = 0; m < 4; ++m)
#pragma unroll
                for (int n = 0; n < 2; ++n) acc[a][b][m][n] = (f32x4){0.f, 0.f, 0.f, 0.f};
    bf16x8 At[4][2], B0[2][2], B1[2][2];
    unsigned oAc[2][2], oAn[2][2];
    PG8_AOFFS(cur, oAc);
    const char* cA = cur.A; const char* cB = cur.B;
    PG8_STB(PG8_SB(0, 0), cB); PG8_STB(PG8_SB(0, 1), cB + hstep); PG8_STA(PG8_SA(0, 0), cA, oAc[0]); PG8_STA(PG8_SA(0, 1), cA, oAc[1]);
    if (wr == 1) PG8_BAR;
    PG8_WAIT_V(2); PG8_BAR;
    PG8_STB(PG8_SB(1, 0), cB + kstep); PG8_STA(PG8_SA(1, 0), cA + kstep, oAc[0]); PG8_STB(PG8_SB(1, 1), cB + hstep + kstep);
    PG8_WAIT_V(6); PG8_BAR;
    for (;;) {
        const bool has_next = S.next(ui + 1, nxt);
        const char* nA = has_next ? nxt.A : cA; const char* nB = has_next ? nxt.B : cB;
        if (has_next) { PG8_AOFFS(nxt, oAn); } else {
#pragma unroll
            for (int h = 0; h < 2; ++h) { oAn[h][0] = oAc[h][0]; oAn[h][1] = oAc[h][1]; } }
#pragma unroll 1
        for (int t = 0; t < nt; t += 2) {
            const bool last = (t == nt - 2);
            const char* a1 = cA + (size_t)(t + 1) * kstep;
            const char* a2 = last ? nA : cA + (size_t)(t + 2) * kstep; const char* b2 = last ? nB : cB + (size_t)(t + 2) * kstep;
            const char* a3 = a2 + kstep; const char* b3 = b2 + kstep;
            unsigned o2[2][2];
#pragma unroll
            for (int h = 0; h < 2; ++h) { o2[h][0] = last ? oAn[h][0] : oAc[h][0]; o2[h][1] = last ? oAn[h][1] : oAc[h][1]; }
            PG8_LDB(B0, 0, 0); PG8_LDB(B1, 0, 1); PG8_SCHED; PG8_LDA(At, 0, 0); PG8_STA(PG8_SA(1, 1), a1, oAc[1]);
            PG8_WAIT_V(8); PG8_WAIT_L(0); PG8_BAR; PG8_MMA(0, 0, At, B0); PG8_MMA(0, 1, At, B1); PG8_BAR; PG8_SCHED;
            PG8_LDA(At, 0, 1); PG8_STB(PG8_SB(0, 0), b2); PG8_STB(PG8_SB(0, 1), b2 + hstep); PG8_STA(PG8_SA(0, 0), a2, o2[0]);
            PG8_WAIT_V(8); PG8_WAIT_L(0); PG8_BAR; PG8_MMA(1, 0, At, B0); PG8_MMA(1, 1, At, B1); PG8_BAR; PG8_SCHED;
            PG8_LDB(B0, 1, 0); PG8_LDB(B1, 1, 1); PG8_SCHED; PG8_LDA(At, 1, 0); PG8_STA(PG8_SA(0, 1), a2, o2[1]);
            PG8_WAIT_V(8); PG8_WAIT_L(0); PG8_BAR; PG8_MMA(0, 0, At, B0); PG8_MMA(0, 1, At, B1); PG8_BAR; PG8_SCHED;
            PG8_LDA(At, 1, 1); PG8_STB(PG8_SB(1, 0), b3); PG8_STB(PG8_SB(1, 1), b3 + hstep); PG8_STA(PG8_SA(1, 0), a3, o2[0]);
            PG8_WAIT_V(8); PG8_WAIT_L(0); PG8_BAR; PG8_MMA(1, 0, At, B0); PG8_MMA(1, 1, At, B1); PG8_BAR; PG8_SCHED;
        }
        if constexpr (ALIGN_EPI) { if (wr == 0) PG8_BAR; }
        E(acc, cur, wr, wc, fr, fq);
        if (!has_next) break;
#pragma unroll
        for (int a = 0; a < 2; ++a)
#pragma unroll
            for (int b = 0; b < 2; ++b)
#pragma unroll
                for (int m = 0; m < 4; ++m)
#pragma unroll
                    for (int n = 0; n < 2; ++n) acc[a][b][m][n] = (f32x4){0.f, 0.f, 0.f, 0.f};
        cur = nxt; cA = nA; cB = nB; ++ui;
#pragma unroll
        for (int h = 0; h < 2; ++h) { oAc[h][0] = oAn[h][0]; oAc[h][1] = oAn[h][1]; }
        if constexpr (ALIGN_EPI) { if (wr == 1) PG8_BAR; }
    }
    PG8_WAIT_V(0);
    if constexpr (!ALIGN_EPI) { if (wr == 0) PG8_BAR; }
    PG8_BAR;
#undef PG8_SA
#undef PG8_SB
#undef PG8_GL
#undef PG8_STA
#undef PG8_STB
#undef PG8_LDA
#undef PG8_LDB
#undef PG8_MMA
#undef PG8_WAIT_V
#undef PG8_WAIT_L
#undef PG8_BAR
#undef PG8_SCHED
#undef PG8_AOFFS
}
}

__device__ __forceinline__ unsigned pk2(float lo, float hi) { return (unsigned)f2bf(lo) | ((unsigned)f2bf(hi) << 16); }
__device__ __forceinline__ void transpose_item(const float* W, int ld, int nblk, bf16_t* WT, LAS float* scr, int item, int lane) {
    const int kb = item / nblk, nb = item - kb * nblk, k0 = 64 * kb, n0 = 32 * nb;
#pragma unroll 8
    for (int i = 0; i < 32; ++i) { const int kk = 2 * i + (lane >> 5); scr[kk * 33 + (lane & 31)] = W[(size_t)(k0 + kk) * ld + n0 + (lane & 31)]; }
    asm volatile("s_waitcnt lgkmcnt(0)" ::: "memory");
    const int c = lane & 7;
#pragma unroll
    for (int j = 0; j < 4; ++j) { const int n = (lane >> 3) + 8 * j; const LAS float* s = scr + (8 * c) * 33 + n;
        pg8::u32x4 o; o.x = pk2(s[0 * 33], s[1 * 33]); o.y = pk2(s[2 * 33], s[3 * 33]); o.z = pk2(s[4 * 33], s[5 * 33]); o.w = pk2(s[6 * 33], s[7 * 33]);
        *(pg8::u32x4*)(WT + (size_t)(n0 + n) * 1024 + k0 + 8 * c) = o; }
    asm volatile("s_waitcnt lgkmcnt(0)" ::: "memory");
}
__device__ __forceinline__ void d_convert_a(KP kp, LAS float* scr_all) {
    PH_IDS;
    const int lane = tid & 63; LAS float* scr = scr_all + (tid >> 6) * (64 * 33);
    constexpr int I_IN = 16 * 104, I_OUT = 16 * 32, I_W1 = 16 * 64, I_W2 = 16 * 32, I_L = I_IN + I_OUT + 32 * I_W1 + 32 * I_W2;
    GW_LOOP(it, 2 * I_L) {
        const int l = it / I_L; int r = it - l * I_L;
        if (r < I_IN) { transpose_item(p.w_in + (size_t)l * D * INW, INW, 104, WSP(bf16_t, WS_WIN_T) + (size_t)l * PW * 1024, scr, r, lane); continue; } r -= I_IN;
        if (r < I_OUT) { transpose_item(p.w_out + (size_t)l * D * D, 1024, 32, WSP(bf16_t, WS_WOUT_T) + (size_t)l * 1024 * 1024, scr, r, lane); continue; } r -= I_OUT;
        if (r < 32 * I_W1) { const int e = r / I_W1; transpose_item(p.exp_w1 + ((size_t)l * NEXP + e) * D * 2048, 2048, 64, WSP(bf16_t, WS_W1_T) + ((size_t)l * NEXP + e) * 2048 * 1024, scr, r - e * I_W1, lane); continue; } r -= 32 * I_W1;
        { const int e = r / I_W2; transpose_item(p.exp_w2 + ((size_t)l * NEXP + e) * D * D, 1024, 32, WSP(bf16_t, WS_W2_T) + ((size_t)l * NEXP + e) * 1024 * 1024, scr, r - e * I_W2, lane); }
    }
    GT_LOOP(idx, 2 * PW) { const int l = idx / PW, n = idx - l * PW; WSP(float, WS_BIAS_IN)[idx] = n < 3328 ? 0.f : p.gla_gate_b[l * 256 + n - 3328]; }
}
__device__ __forceinline__ void d_convert_b(KP kp, LAS float* scr_all) {
    PH_IDS;
    const int lane = tid & 63; LAS float* scr = scr_all + (tid >> 6) * (64 * 33);
    GW_LOOP(it, 2 * 128) { const int l = it >> 7; transpose_item(WSP(float, WS_WEFF) + (size_t)l * D * 256, 256, 8, WSP(bf16_t, WS_WIN_T) + ((size_t)l * PW + 3328) * 1024, scr, it & 127, lane); }
}

__device__ __forceinline__ void d_gemm_in(KP kp, int l, LAS unsigned char* lds) {
    PH_IDS;
    pg8::DenseOrder S; S.init(MALL, PW, gridDim.x, bid, WSP(bf16_t, WS_HB), WSP(bf16_t, WS_WIN_T) + (size_t)l * PW * 1024);
    pg8::EpiBf16 E{WSP(bf16_t, WS_PBUF), PW, WSP(float, WS_BIAS_IN) + l * PW};
    pg8::gphase<pg8::EpiBf16, pg8::DenseOrder, false, true>(lds, S, E);
}
__device__ __forceinline__ void d_gemm_out(KP kp, int l, LAS unsigned char* lds) {
    PH_IDS;
    pg8::DenseOrder S; S.init(nrows_l(l), 1024, gridDim.x, bid, WSP(bf16_t, WS_CONCAT), WSP(bf16_t, WS_WOUT_T) + (size_t)l * 1024 * 1024);
    pg8::EpiF32 E{WSP(float, WS_YBUF), 1024};
    pg8::gphase<pg8::EpiF32, pg8::DenseOrder, false, true>(lds, S, E);
}
__device__ __forceinline__ void d_moe_up(KP kp, int l, LAS unsigned char* lds) {
    PH_IDS;
    LAS int* tab = (LAS int*)(lds + pg8::STAGE_BYTES);
    const unsigned* cnt = WSP(unsigned, WS_CTL) + CW_CNT + l * 32;
    pg8::moe_tab_build(tab, cnt, 8);
    pg8::MoeOrder S{tab, (int)gridDim.x, bid, 8, (const char*)WSP(bf16_t, WS_HB), (const char*)(WSP(bf16_t, WS_W1_T) + (size_t)l * NEXP * 2048 * 1024), (size_t)2048 * 1024 * 2, WSP(int, WS_LIST), cnt, true};
    pg8::EpiMoeUp E{WSP(bf16_t, WS_ACT), p.exp_b1 + (size_t)l * NEXP * 2048};
    pg8::gphase<pg8::EpiMoeUp, pg8::MoeOrder, true, true>(lds, S, E);
}
__device__ __forceinline__ void d_moe_down(KP kp, int l, LAS unsigned char* lds) {
    PH_IDS;
    LAS int* tab = (LAS int*)(lds + pg8::STAGE_BYTES);
    const unsigned* cnt = WSP(unsigned, WS_CTL) + CW_CNT + l * 32;
    pg8::moe_tab_build(tab, cnt, 4);
    pg8::MoeOrder S{tab, (int)gridDim.x, bid, 4, (const char*)WSP(bf16_t, WS_ACT), (const char*)(WSP(bf16_t, WS_W2_T) + (size_t)l * NEXP * 1024 * 1024), (size_t)1024 * 1024 * 2, WSP(int, WS_LIST), cnt, false};
    pg8::EpiMoeDown E{WSP(bf16_t, WS_YSLOT), p.exp_b2 + (size_t)l * NEXP * 1024, WSP(float, WS_TOPW)};
    pg8::gphase<pg8::EpiMoeDown, pg8::MoeOrder, false, true>(lds, S, E);
}

constexpr int ATT_NT = 68;
constexpr float ATT_QSCALE = 0.17677669529663687f * 1.4426950408889634f;
__device__ __forceinline__ void d_prep_attn(KP kp) {
    PH_IDS;
    const bf16_t* PB = WSP(bf16_t, WS_PBUF);
    GT_LOOP(idx, MALL * 16) {
        const int row = idx >> 4, hm = (idx >> 1) & 7, ks = idx & 1, h = hm >> 1, m = hm & 1;
        const bool lat = row < NLAT; const int t = row & (SEQ - 1);
        const int ipos = ks == 0 ? (t >> 6) : (t & 63);
        const int cb = h * 64 + m * 32 + ks * 16;
        const pg8::u32x4* qs = (const pg8::u32x4*)(PB + (size_t)row * PW + PC_AQ + cb);
        const pg8::u32x4* ksrc = (const pg8::u32x4*)(PB + (size_t)row * PW + PC_AK + cb);
        pg8::u32x4 qa = qs[0], qb = qs[1], ka = ksrc[0], kb = ksrc[1];
        float qv[16], kv[16];
#pragma unroll
        for (int j = 0; j < 4; ++j) { qv[2 * j] = bf2f((bf16_t)(qa[j] & 0xffff)); qv[2 * j + 1] = bf2f((bf16_t)(qa[j] >> 16)); qv[8 + 2 * j] = bf2f((bf16_t)(qb[j] & 0xffff)); qv[9 + 2 * j] = bf2f((bf16_t)(qb[j] >> 16));
                                      kv[2 * j] = bf2f((bf16_t)(ka[j] & 0xffff)); kv[2 * j + 1] = bf2f((bf16_t)(ka[j] >> 16)); kv[8 + 2 * j] = bf2f((bf16_t)(kb[j] & 0xffff)); kv[9 + 2 * j] = bf2f((bf16_t)(kb[j] >> 16)); }
        float qo[16], ko[16];
#pragma unroll
        for (int j = 0; j < 8; ++j) {
            float cs = 1.f, sn = 0.f;
            if (lat) { const float* tb = WSP(float, WS_ROPE) + (ipos * 8 + j) * 2; cs = tb[0]; sn = tb[1]; }
            qo[j] = qv[j] * cs - qv[j + 8] * sn; qo[j + 8] = qv[j + 8] * cs + qv[j] * sn;
            ko[j] = kv[j] * cs - kv[j + 8] * sn; ko[j + 8] = kv[j + 8] * cs + kv[j] * sn;
        }
        pg8::u32x4 o0, o1;
#pragma unroll
        for (int j = 0; j < 4; ++j) { o0[j] = pk2(qo[2 * j] * ATT_QSCALE, qo[2 * j + 1] * ATT_QSCALE); o1[j] = pk2(qo[8 + 2 * j] * ATT_QSCALE, qo[9 + 2 * j] * ATT_QSCALE); }
        pg8::u32x4* qd = (pg8::u32x4*)(WSP(bf16_t, WS_QRP) + (size_t)row * 256 + cb); qd[0] = o0; qd[1] = o1;
#pragma unroll
        for (int j = 0; j < 4; ++j) { o0[j] = pk2(ko[2 * j], ko[2 * j + 1]); o1[j] = pk2(ko[8 + 2 * j], ko[9 + 2 * j]); }
        int b, tile, key; if (lat) { b = row >> 12; tile = t >> 6; key = t & 63; } else { const int r = row - NLAT; b = r >> 8; tile = 64 + ((r & 255) >> 6); key = r & 63; }
        unsigned char* img = WSP(unsigned char, WS_KIMG) + ((size_t)(b * 4 + h) * ATT_NT + tile) * 8192 + key * 128;
        const int c0 = m * 4 + ks * 2, sw = (key >> 1) & 7;
        *(pg8::u32x4*)(img + 16 * (c0 ^ sw)) = o0; *(pg8::u32x4*)(img + 16 * ((c0 + 1) ^ sw)) = o1;
    }
    GT_LOOP(idx, 16 * ATT_NT * 16 * 64) {
        const int d = idx & 63, kc = (idx >> 6) & 15, tile = (idx >> 10) % ATT_NT, bh = idx / (1024 * ATT_NT), b = bh >> 2, h = bh & 3;
        const int row0 = tile < 64 ? b * SEQ + tile * 64 + kc * 4 : NLAT + b * CTXL + (tile - 64) * 64 + kc * 4;
        const bf16_t* vp = PB + (size_t)row0 * PW + PC_AV + h * 64 + d;
        const unsigned w0 = (unsigned)vp[0] | ((unsigned)vp[PW] << 16), w1 = (unsigned)vp[2 * PW] | ((unsigned)vp[3 * PW] << 16);
        unsigned char* img = WSP(unsigned char, WS_VIMG) + ((size_t)bh * ATT_NT + tile) * 8192 + d * 128 + 8 * (kc ^ ((d >> 1) & 15));
        *(pg8::u32x2*)img = (pg8::u32x2){w0, w1};
    }
}

namespace att {
typedef short bf16x8 __attribute__((ext_vector_type(8)));
typedef float f32x16 __attribute__((ext_vector_type(16)));
typedef unsigned u32x4 __attribute__((ext_vector_type(4)));
typedef unsigned u32x2 __attribute__((ext_vector_type(2)));
constexpr int SLOT = 8192, LDS_K = 0, LDS_V = 3 * SLOT, LDS_SCR = 6 * SLOT;
constexpr float THR = 8.f;
__device__ __forceinline__ int crow(int r, int hi) { return (r & 3) + 8 * (r >> 2) + 4 * hi; }
__device__ __forceinline__ unsigned cvtpk(float lo, float hi) { return cvtpk_rne(lo, hi); }
__device__ __forceinline__ float xhalf_max(float v) { return fmaxf(v, __shfl_xor(v, 32)); }
}
__device__ __forceinline__ void attn_unit(KP kp, int l, int b, int h, int qt, LAS unsigned char* lds, float lam, float lam_init, int tid) {
    using namespace att;
    const int lane = tid & 63, wid = __builtin_amdgcn_readfirstlane(tid >> 6), q32 = lane & 31, hi = lane >> 5;
    const int t0 = qt < 0 ? 64 : 0, t1 = ATT_NT;
    const int rowbase = (qt < 0 ? NLAT + b * CTXL : b * SEQ + qt * 256) + wid * 32;
    const unsigned char* kimg = WSP(unsigned char, WS_KIMG) + (size_t)(b * 4 + h) * ATT_NT * 8192 + wid * 1024 + lane * 16;
    const unsigned char* vimg = WSP(unsigned char, WS_VIMG) + (size_t)(b * 4 + h) * ATT_NT * 8192 + wid * 1024 + lane * 16;
    LAS float* scr = (LAS float*)(lds + LDS_SCR) + wid * 64;
#define ATT_DMA(t, slot) do { __builtin_amdgcn_global_load_lds((const unsigned*)(kimg + (size_t)(t) * 8192), (LAS unsigned*)(lds + LDS_K + (slot) * SLOT + wid * 1024), 16, 0, 0); \
                              __builtin_amdgcn_global_load_lds((const unsigned*)(vimg + (size_t)(t) * 8192), (LAS unsigned*)(lds + LDS_V + (slot) * SLOT + wid * 1024), 16, 0, 0); } while (0)
    bf16x8 qf[2][2];
    { const bf16_t* qp = WSP(bf16_t, WS_QRP) + (size_t)(rowbase + q32) * 256 + h * 64 + hi * 8;
#pragma unroll
      for (int m = 0; m < 2; ++m)
#pragma unroll
        for (int ks = 0; ks < 2; ++ks) qf[m][ks] = *(const bf16x8*)(qp + m * 32 + ks * 16); }
    asm volatile("s_waitcnt vmcnt(0)" ::: "memory");
    __builtin_amdgcn_s_barrier();
    ATT_DMA(t0, 0); ATT_DMA(t0 + 1, 1);
    f32x16 O[2][2];
#pragma unroll
    for (int m = 0; m < 2; ++m)
#pragma unroll
        for (int dh = 0; dh < 2; ++dh)
#pragma unroll
            for (int r = 0; r < 16; ++r) O[m][dh][r] = 0.f;
    float mref[2] = {0.f, 0.f}, lsum[2] = {0.f, 0.f};
    const int koff = q32 * 128, ksw = (q32 >> 1) & 7;
    int slot = 0;
#pragma unroll 1
    for (int t = t0; t < t1; ++t) {
        if (t + 1 < t1) asm volatile("s_waitcnt vmcnt(2)" ::: "memory"); else asm volatile("s_waitcnt vmcnt(0)" ::: "memory");
        __builtin_amdgcn_s_barrier();
        asm volatile("" ::: "memory");
        if (t + 2 < t1) { const int s2 = slot == 0 ? 2 : slot - 1; ATT_DMA(t + 2, s2); }
        const LAS unsigned char* Ks = lds + LDS_K + slot * SLOT; const LAS unsigned char* Vs = lds + LDS_V + slot * SLOT;
        u32x4 ppk[2][2][2];
#pragma unroll
        for (int m = 0; m < 2; ++m) {
            f32x16 S[2];
            { const float nm = -mref[m];
#pragma unroll
              for (int r = 0; r < 16; ++r) { S[0][r] = nm; S[1][r] = nm; } }
#pragma unroll
            for (int kh = 0; kh < 2; ++kh)
#pragma unroll
                for (int ks = 0; ks < 2; ++ks) {
                    const bf16x8 kf = *(const LAS bf16x8*)(Ks + kh * 4096 + koff + 16 * ((m * 4 + ks * 2 + hi) ^ ksw));
                    S[kh] = __builtin_amdgcn_mfma_f32_32x32x16_bf16(kf, qf[m][ks], S[kh], 0, 0, 0);
                }
            float mx = fmaxf(S[0][0], S[1][0]);
#pragma unroll
            for (int r = 1; r < 16; ++r) mx = fmaxf(mx, fmaxf(S[0][r], S[1][r]));
            mx = xhalf_max(mx);
            const bool first = (t == t0);
            if (__any(first || mx > THR)) {
                const float dl = first ? mx : fmaxf(mx, 0.f);
                mref[m] += dl;
#pragma unroll
                for (int r = 0; r < 16; ++r) { S[0][r] -= dl; S[1][r] -= dl; }
                const float f = __builtin_amdgcn_exp2f(-dl);
                lsum[m] *= f;
                if (!first) {
                    if (hi == 0) scr[q32] = f;
                    asm volatile("s_waitcnt lgkmcnt(0)" ::: "memory");
#pragma unroll
                    for (int r = 0; r < 16; ++r) { const float fr = scr[crow(r, hi)]; O[m][0][r] *= fr; O[m][1][r] *= fr; }
                    asm volatile("s_waitcnt lgkmcnt(0)" ::: "memory");
                }
            }
            float ls = 0.f;
#pragma unroll
            for (int kh = 0; kh < 2; ++kh) {
#pragma unroll
                for (int r = 0; r < 16; ++r) { S[kh][r] = __builtin_amdgcn_exp2f(S[kh][r]); ls += S[kh][r]; }
#pragma unroll
                for (int s = 0; s < 2; ++s)
#pragma unroll
                    for (int j = 0; j < 4; ++j) ppk[m][kh][s][j] = cvtpk(S[kh][8 * s + 2 * j], S[kh][8 * s + 2 * j + 1]);
            }
            lsum[m] += ls;
        }
#pragma unroll
        for (int kh = 0; kh < 2; ++kh)
#pragma unroll
            for (int s = 0; s < 2; ++s)
#pragma unroll
                for (int dh = 0; dh < 2; ++dh) {
                    const int d = dh * 32 + q32, kc = 8 * kh + 4 * s + hi, vsw = (d >> 1) & 15;
                    const u32x2 v0 = *(const LAS u32x2*)(Vs + d * 128 + 8 * (kc ^ vsw)), v1 = *(const LAS u32x2*)(Vs + d * 128 + 8 * ((kc + 2) ^ vsw));
                    const u32x4 vv = (u32x4){v0.x, v0.y, v1.x, v1.y};
                    const bf16x8 vf = __builtin_bit_cast(bf16x8, vv);
#pragma unroll
                    for (int m = 0; m < 2; ++m) O[m][dh] = __builtin_amdgcn_mfma_f32_32x32x16_bf16(__builtin_bit_cast(bf16x8, ppk[m][kh][s]), vf, O[m][dh], 0, 0, 0);
                }
        asm volatile("s_waitcnt lgkmcnt(0)" ::: "memory");
        slot = slot == 2 ? 0 : slot + 1;
    }
#undef ATT_DMA
    float il[2][16];
#pragma unroll
    for (int m = 0; m < 2; ++m) { const float lt = lsum[m] + __shfl_xor(lsum[m], 32); if (hi == 0) scr[m * 32 + q32] = 1.f / lt; }
    asm volatile("s_waitcnt lgkmcnt(0)" ::: "memory");
#pragma unroll
    for (int m = 0; m < 2; ++m)
#pragma unroll
        for (int r = 0; r < 16; ++r) il[m][r] = scr[m * 32 + crow(r, hi)];
    asm volatile("s_waitcnt lgkmcnt(0)" ::: "memory");
    const float g0 = p.diff_subln_g[l * 64 + q32] * (1.f - lam_init), g1 = p.diff_subln_g[l * 64 + 32 + q32] * (1.f - lam_init);
    bf16_t* outp = WSP(bf16_t, WS_CONCAT) + (size_t)rowbase * D + h * 64 + q32;
#pragma unroll
    for (int r = 0; r < 16; ++r) {
        const float o0 = O[0][0][r] * il[0][r] - lam * O[1][0][r] * il[1][r], o1 = O[0][1][r] * il[0][r] - lam * O[1][1][r] * il[1][r];
        float ss = o0 * o0 + o1 * o1;
#pragma unroll
        for (int x = 1; x < 32; x <<= 1) ss += __shfl_xor(ss, x);
        const float rstd = rsqrtf(ss * (1.f / 64.f) + EPS);
        bf16_t* op = outp + (size_t)crow(r, hi) * D;
        op[0] = f2bf(o0 * rstd * g0); op[32] = f2bf(o1 * rstd * g1);
    }
}
__device__ __forceinline__ void d_attn_fast(KP kp, int l, LAS unsigned char* lds) {
    PH_IDS;
    const float* dl = p.diff_lambda + l * 4 * 32;
    float s1 = 0.f, s2 = 0.f;
    for (int i = 0; i < 32; ++i) { s1 += dl[i] * dl[32 + i]; s2 += dl[64 + i] * dl[96 + i]; }
    const float lam_init = 0.8f - 0.6f * expf(-0.3f * (float)l);
    const float lam = expf(s1) - expf(s2) + lam_init;
    const int G = gridDim.x, vb = (G % 8 == 0) ? (bid % 8) * (G / 8) + bid / 8 : bid;
    const int nunits = 256 + (l == 0 ? 16 : 0);
    for (int u = vb; u < nunits; u += G) {
        if (u < 256) attn_unit(kp, l, u >> 6, (u >> 4) & 3, u & 15, lds, lam, lam_init, tid);
        else attn_unit(kp, l, (u - 256) >> 2, (u - 256) & 3, -1, lds, lam, lam_init, tid);
    }
    __syncthreads();
}

constexpr int NCHUNK = MALL / 64;
__device__ __forceinline__ float logsig16(float x) { return (fminf(x, 0.f) - log1pf(expf(-fabsf(x)))) * (1.f / 16.f); }
__device__ __forceinline__ void d_prep_scan(KP kp) {
    PH_IDS;
    const bf16_t* PB = WSP(bf16_t, WS_PBUF);
    GT_LOOP(idx, 8 * MALL) {
        const int row = idx % MALL, hk = idx / MALL, h = hk >> 1, ks = hk & 1;
        const bool lat = row < NLAT; const int t = row & (SEQ - 1);
        const int ipos = ks == 0 ? (t >> 6) : (t & 63);
        const int cb = h * 64 + ks * 32;
        const pg8::u32x4* qs = (const pg8::u32x4*)(PB + (size_t)row * PW + PC_RQ + cb);
        const pg8::u32x4* ksrc = (const pg8::u32x4*)(PB + (size_t)row * PW + PC_RK + cb);
        float qv[32], kv[32];
#pragma unroll
        for (int c4 = 0; c4 < 4; ++c4) { const pg8::u32x4 a = qs[c4], b4 = ksrc[c4];
#pragma unroll
            for (int j = 0; j < 4; ++j) { qv[c4 * 8 + 2 * j] = bf2f((bf16_t)(a[j] & 0xffff)); qv[c4 * 8 + 2 * j + 1] = bf2f((bf16_t)(a[j] >> 16)); kv[c4 * 8 + 2 * j] = bf2f((bf16_t)(b4[j] & 0xffff)); kv[c4 * 8 + 2 * j + 1] = bf2f((bf16_t)(b4[j] >> 16)); } }
        float qo[32], ko[32];
#pragma unroll
        for (int j = 0; j < 16; ++j) {
            float cs = 1.f, sn = 0.f;
            if (lat) { const float* tb = WSP(float, WS_ROPE) + 1024 + (ipos * 16 + j) * 2; cs = tb[0]; sn = tb[1]; }
            qo[j] = qv[j] * cs - qv[j + 16] * sn; qo[j + 16] = qv[j + 16] * cs + qv[j] * sn;
            ko[j] = (kv[j] * cs - kv[j + 16] * sn) * 0.125f; ko[j + 16] = (kv[j + 16] * cs + kv[j] * sn) * 0.125f;
        }
        pg8::u32x4* qd = (pg8::u32x4*)(WSP(bf16_t, WS_QF_R) + (size_t)row * 256 + cb); pg8::u32x4* kd = (pg8::u32x4*)(WSP(bf16_t, WS_KF_R) + (size_t)row * 256 + cb);
#pragma unroll
        for (int c4 = 0; c4 < 4; ++c4) { pg8::u32x4 a, b4;
#pragma unroll
            for (int j = 0; j < 4; ++j) { a[j] = pk2(qo[c4 * 8 + 2 * j], qo[c4 * 8 + 2 * j + 1]); b4[j] = pk2(ko[c4 * 8 + 2 * j], ko[c4 * 8 + 2 * j + 1]); }
            qd[c4] = a; kd[c4] = b4; }
        bf16_t* kt = WSP(bf16_t, WS_KT_R) + ((size_t)((row >> 6) * 4 + h) * 64 + ks * 32) * 64 + (row & 63);
#pragma unroll
        for (int i = 0; i < 32; ++i) kt[(size_t)i * 64] = f2bf(ko[i]);
    }
    GT_LOOP(idx, 4 * MALL) {
        const int row = idx % MALL, h = idx / MALL;
        const pg8::u32x4* ksrc = (const pg8::u32x4*)(PB + (size_t)row * PW + PC_GK + h * 32);
        bf16_t* kt = WSP(bf16_t, WS_KT_G) + ((size_t)((row >> 6) * 4 + h) * 32) * 64 + (row & 63);
#pragma unroll
        for (int c4 = 0; c4 < 4; ++c4) { const pg8::u32x4 a = ksrc[c4];
#pragma unroll
            for (int j = 0; j < 4; ++j) { kt[(size_t)(c4 * 8 + 2 * j) * 64] = (bf16_t)(a[j] & 0xffff); kt[(size_t)(c4 * 8 + 2 * j + 1) * 64] = (bf16_t)(a[j] >> 16); } }
    }
    GT_LOOP(idx, NCHUNK * 2 * 128) {
        const int hk = idx & 127, dir = (idx >> 7) & 1, cid = idx >> 8;
        const bf16_t* src = PB + (size_t)(cid * 64) * PW + PC_GD + dir * 128 + hk;
        float* cum = WSP(float, WS_CUM_G) + ((size_t)dir * MALL + cid * 64) * 128 + hk;
        float* cumt = WSP(float, WS_CUMT_G) + (((size_t)dir * NCHUNK + cid) * 128 + hk) * 64;
        float c = 0.f;
#pragma unroll 1
        for (int g4 = 0; g4 < 16; ++g4) {
            const int j0 = dir == 0 ? 4 * g4 : 60 - 4 * g4;
            float v[4];
#pragma unroll
            for (int u = 0; u < 4; ++u) { const int j = dir == 0 ? j0 + u : j0 + 3 - u; c += logsig16(bf2f(src[(size_t)j * PW])); v[dir == 0 ? u : 3 - u] = c; cum[(size_t)j * 128] = c; }
            *(pg8::f32x4*)(cumt + j0) = (pg8::f32x4){v[0], v[1], v[2], v[3]};
        }
    }
    GT_LOOP(idx, 2 * NCHUNK * 4 * 16 * 64) {
        const int d = idx & 63, kc = (idx >> 6) & 15, ch = (idx >> 10) % (NCHUNK * 4), mx = idx / (1024 * NCHUNK * 4), h = ch & 3, cid = ch >> 2;
        const bf16_t* vp = PB + (size_t)(cid * 64 + kc * 4) * PW + (mx == 0 ? PC_RV : PC_GV) + h * 64 + d;
        const unsigned w0 = (unsigned)vp[0] | ((unsigned)vp[PW] << 16), w1 = (unsigned)vp[2 * PW] | ((unsigned)vp[3 * PW] << 16);
        unsigned char* img = WSP(unsigned char, mx == 0 ? WS_VT_R : WS_VT_G) + (size_t)ch * 8192 + d * 128 + 8 * (kc ^ ((d >> 1) & 15));
        *(pg8::u32x2*)img = (pg8::u32x2){w0, w1};
    }
}

namespace scn {
typedef short bf16x8 __attribute__((ext_vector_type(8)));
typedef float f32x16 __attribute__((ext_vector_type(16)));
typedef float f32x4 __attribute__((ext_vector_type(4)));
typedef unsigned u32x4 __attribute__((ext_vector_type(4)));
typedef unsigned u32x2 __attribute__((ext_vector_type(2)));
__device__ __forceinline__ int crow(int r, int hi) { return (r & 3) + 8 * (r >> 2) + 4 * hi; }
__device__ __forceinline__ unsigned cvtpk(float lo, float hi) { return cvtpk_rne(lo, hi); }
__device__ __forceinline__ float blo(unsigned w) { return __uint_as_float(w << 16); }
__device__ __forceinline__ float bhi(unsigned w) { return __uint_as_float(w & 0xffff0000u); }
__device__ __forceinline__ bf16x8 scale8(u32x4 raw, const float (&f)[8]) {
    u32x4 o;
#pragma unroll
    for (int j = 0; j < 4; ++j) o[j] = cvtpk(blo(raw[j]) * f[2 * j], bhi(raw[j]) * f[2 * j + 1]);
    return __builtin_bit_cast(bf16x8, o);
}
template <int MX> struct Cfg;
template <> struct Cfg<0> { static constexpr int DK = 64; };
template <> struct Cfg<1> { static constexpr int DK = 32; };
}
#define SCN_EXP(x) __builtin_amdgcn_exp2f((x) * 1.4426950408889634f)
template <int MX> __device__ __forceinline__ void scan_stage1_unit(KP kp, int l, int b, int h, int g, int tid) {
    using namespace scn;
    constexpr int DK = Cfg<MX>::DK, NKT = DK / 32, NE = DK * 64 / NT;
    const int lane = tid & 63, wid = __builtin_amdgcn_readfirstlane(tid >> 6), q32 = lane & 31, hi = lane >> 5;
    const int nch = g == 8 ? 4 : 8, cid0 = g == 8 ? 256 + 4 * b : b * 64 + 8 * g;
    float* US = WSP(float, MX == 0 ? WS_US_R : WS_US_G);
    const float* CUMT = WSP(float, WS_CUMT_G);
    if (wid < nch) {
        const int cid = cid0 + wid;
        const unsigned char* vimg = WSP(unsigned char, MX == 0 ? WS_VT_R : WS_VT_G) + (size_t)(cid * 4 + h) * 8192;
        const bf16_t* ktimg = WSP(bf16_t, MX == 0 ? WS_KT_R : WS_KT_G) + (size_t)(cid * 4 + h) * DK * 64;
        bf16x8 vb[2][4];
#pragma unroll
        for (int dh = 0; dh < 2; ++dh)
#pragma unroll
            for (int s = 0; s < 4; ++s) { const int d = dh * 32 + q32, x = (d >> 1) & 15, kc = 4 * s + 2 * hi;
                u32x4 v = *(const u32x4*)(vimg + d * 128 + 16 * ((kc ^ x) >> 1));
                if (x & 1) v = (u32x4){v.z, v.w, v.x, v.y};
                vb[dh][s] = __builtin_bit_cast(bf16x8, v); }
#pragma unroll 1
        for (int dir = 0; dir < 2; ++dir) {
            float lg = 0.f; if (MX == 0) lg = -expf(p.ret_decay[(l * 2 + dir) * 4 + h]);
#pragma unroll 1
            for (int kt = 0; kt < NKT; ++kt) {
                f32x16 U[2];
#pragma unroll
                for (int dh = 0; dh < 2; ++dh)
#pragma unroll
                    for (int r = 0; r < 16; ++r) U[dh][r] = 0.f;
                const int k = kt * 32 + q32;
                const float* ct = CUMT + (((size_t)dir * NCHUNK + cid) * 128 + h * 32 + (k & 31)) * 64;
                float E = 0.f; if (MX == 1) E = ct[dir == 0 ? 63 : 0];
#pragma unroll
                for (int s = 0; s < 4; ++s) {
                    const int j0 = 16 * s + 8 * hi;
                    const u32x4 raw = *(const u32x4*)(ktimg + (size_t)k * 64 + j0);
                    float f[8];
                    if (MX == 0) {
#pragma unroll
                        for (int jj = 0; jj < 8; ++jj) f[jj] = SCN_EXP(lg * (float)(dir == 0 ? 63 - (j0 + jj) : j0 + jj));
                    } else {
                        const f32x4 c0 = *(const f32x4*)(ct + j0), c1 = *(const f32x4*)(ct + j0 + 4);
#pragma unroll
                        for (int jj = 0; jj < 4; ++jj) { f[jj] = SCN_EXP(E - c0[jj]); f[4 + jj] = SCN_EXP(E - c1[jj]); }
                    }
                    const bf16x8 af = scale8(raw, f);
#pragma unroll
                    for (int dh = 0; dh < 2; ++dh) U[dh] = __builtin_amdgcn_mfma_f32_32x32x16_bf16(af, vb[dh][s], U[dh], 0, 0, 0);
                }
                float* up = US + ((((size_t)dir * NCHUNK + cid) * 4 + h) * DK + kt * 32 + 4 * hi) * 64 + q32;
#pragma unroll
                for (int dh = 0; dh < 2; ++dh)
#pragma unroll
                    for (int r = 0; r < 16; ++r) up[((r & 3) + 8 * (r >> 2)) * 64 + dh * 32] = U[dh][r];
            }
        }
    }
    asm volatile("s_waitcnt vmcnt(0)" ::: "memory");
    __syncthreads();
    const int k = (tid * NE) >> 6, d0 = (tid * NE) & 63;
#pragma unroll
    for (int dir = 0; dir < 2; ++dir) {
        float S[NE], Ap = 1.f;
#pragma unroll
        for (int e = 0; e < NE; ++e) S[e] = 0.f;
        float lg = 0.f; if (MX == 0) lg = -expf(p.ret_decay[(l * 2 + dir) * 4 + h]);
        for (int cc = 0; cc < nch; ++cc) {
            const int c = dir == 0 ? cc : nch - 1 - cc, cid = cid0 + c;
            float A;
            if (MX == 0) A = SCN_EXP(lg * 64.f); else A = SCN_EXP(CUMT[(((size_t)dir * NCHUNK + cid) * 128 + h * 32 + k) * 64 + (dir == 0 ? 63 : 0)]);
            const float* up = US + ((((size_t)dir * NCHUNK + cid) * 4 + h) * DK + k) * 64 + d0;
#pragma unroll
            for (int e = 0; e < NE; ++e) S[e] = A * S[e] + up[e];
            Ap *= A;
        }
        float* ug = WSP(float, MX == 0 ? WS_UG_R : WS_UG_G) + (((((size_t)dir * 4 + b) * 4 + h) * 9 + g) * DK + k) * 64 + d0;
#pragma unroll
        for (int e = 0; e < NE; ++e) ug[e] = S[e];
        if (d0 == 0) WSP(float, WS_AG)[((((MX * 2 + dir) * 4 + b) * 4 + h) * 9 + g) * 64 + k] = Ap;
    }
}
template <int MX> __device__ __forceinline__ void scan_stage2_unit(KP kp, int l, int b, int h, int g, LAS unsigned char* lds, int tid) {
    using namespace scn;
    constexpr int DK = Cfg<MX>::DK, NKS = DK / 16, NE = DK * 64 / NT, NCH16 = DK / 8;
    const int lane = tid & 63, wid = __builtin_amdgcn_readfirstlane(tid >> 6), q32 = lane & 31, hi = lane >> 5;
    const int nch = g == 8 ? 4 : 8, cid0 = g == 8 ? 256 + 4 * b : b * 64 + 8 * g;
    const bool act = wid < nch;
    const int cid = cid0 + (act ? wid : 0), row0 = cid * 64;
    const bf16_t* PB = WSP(bf16_t, WS_PBUF);
    const float* US = WSP(float, MX == 0 ? WS_US_R : WS_US_G);
    const float* UG = WSP(float, MX == 0 ? WS_UG_R : WS_UG_G);
    const float* CUMT = WSP(float, WS_CUMT_G);
    f32x16 o[2][2];
#pragma unroll
    for (int it = 0; it < 2; ++it)
#pragma unroll
        for (int dh = 0; dh < 2; ++dh)
#pragma unroll
            for (int r = 0; r < 16; ++r) o[it][dh][r] = 0.f;
    LAS unsigned char* myv = lds + 65536 + wid * 8192;
    { const unsigned char* vimg = WSP(unsigned char, MX == 0 ? WS_VT_R : WS_VT_G) + (size_t)(cid * 4 + h) * 8192 + lane * 16;
      u32x4 tmp[8];
#pragma unroll
      for (int i = 0; i < 8; ++i) tmp[i] = *(const u32x4*)(vimg + i * 1024);
#pragma unroll
      for (int i = 0; i < 8; ++i) *(LAS u32x4*)(myv + i * 1024 + lane * 16) = tmp[i]; }
    const int fk = (tid * NE) >> 6, fd0 = (tid * NE) & 63;
#pragma unroll 1
    for (int dir = 0; dir < 2; ++dir) {
        float lg = 0.f; if (MX == 0) lg = -expf(p.ret_decay[(l * 2 + dir) * 4 + h]);
        float S[NE];
#pragma unroll
        for (int e = 0; e < NE; ++e) S[e] = 0.f;
        if (g != 8) {
            const float* ugb = UG + (((size_t)dir * 4 + b) * 4 + h) * 9 * DK * 64 + (size_t)fk * 64 + fd0;
            const float* agb = WSP(float, WS_AG) + (((MX * 2 + dir) * 4 + b) * 4 + h) * 9 * 64 + fk;
#pragma unroll
            for (int e = 0; e < NE; ++e) S[e] = ugb[(size_t)8 * DK * 64 + e];
            const int ng = dir == 0 ? g : 7 - g;
            for (int q = 0; q < ng; ++q) { const int gg = dir == 0 ? q : 7 - q; const float A = agb[gg * 64];
#pragma unroll
                for (int e = 0; e < NE; ++e) S[e] = A * S[e] + ugb[(size_t)gg * DK * 64 + e]; }
        }
        for (int cc = 0; cc < nch; ++cc) {
            const int c = dir == 0 ? cc : nch - 1 - cc, ccid = cid0 + c;
            LAS unsigned char* area = lds + c * 8192;
#pragma unroll
            for (int e = 0; e < NE; ++e) { const int d = fd0 + e; const int sw = DK == 64 ? ((d >> 1) & 7) : ((d >> 2) & 3);
                *(LAS bf16_t*)(area + d * (DK * 2) + 16 * ((fk >> 3) ^ sw) + (fk & 7) * 2) = f2bf(S[e]); }
            float A;
            if (MX == 0) A = SCN_EXP(lg * 64.f); else A = SCN_EXP(CUMT[(((size_t)dir * NCHUNK + ccid) * 128 + h * 32 + fk) * 64 + (dir == 0 ? 63 : 0)]);
            const float* up = US + ((((size_t)dir * NCHUNK + ccid) * 4 + h) * DK + fk) * 64 + fd0;
#pragma unroll
            for (int e = 0; e < NE; ++e) S[e] = A * S[e] + up[e];
        }
        asm volatile("s_waitcnt lgkmcnt(0)" ::: "memory");
        __syncthreads();
        if (act) {
#define SCN_GEN(dst, ISQ, T2) do { const int il_ = 32 * (T2) + q32, row_ = row0 + il_; \
                _Pragma("unroll") for (int ks = 0; ks < NKS; ++ks) { const int kc0 = 16 * ks + 8 * hi; u32x4 raw_; float f_[8]; \
                    if (MX == 0) { raw_ = *(const u32x4*)(WSP(bf16_t, (ISQ) ? WS_QF_R : WS_KF_R) + (size_t)row_ * 256 + h * 64 + kc0); \
                        const float cm_ = lg * (float)(dir == 0 ? il_ + 1 : 64 - il_), e_ = SCN_EXP((ISQ) ? cm_ : -cm_); \
                        _Pragma("unroll") for (int jj = 0; jj < 8; ++jj) f_[jj] = e_; \
                    } else { raw_ = *(const u32x4*)(PB + (size_t)row_ * PW + ((ISQ) ? PC_GQ : PC_GK) + h * 32 + kc0); \
                        const float* cp_ = WSP(float, WS_CUM_G) + ((size_t)dir * MALL + row_) * 128 + h * 32 + kc0; \
                        const f32x4 c0_ = *(const f32x4*)cp_, c1_ = *(const f32x4*)(cp_ + 4); \
                        _Pragma("unroll") for (int jj = 0; jj < 4; ++jj) { f_[jj] = (ISQ) ? SCN_EXP(c0_[jj]) * 0.17677669529663687f : SCN_EXP(-c0_[jj]); f_[4 + jj] = (ISQ) ? SCN_EXP(c1_[jj]) * 0.17677669529663687f : SCN_EXP(-c1_[jj]); } } \
                    dst[ks] = scale8(raw_, f_); } } while (0)
#define SCN_TILE(JT, IT, MASKED) do { bf16x8 kf_[NKS]; SCN_GEN(kf_, false, JT); f32x16 P; \
                _Pragma("unroll") for (int r = 0; r < 16; ++r) P[r] = 0.f; \
                _Pragma("unroll") for (int ks = 0; ks < NKS; ++ks) P = __builtin_amdgcn_mfma_f32_32x32x16_bf16(kf_[ks], qf[ks], P, 0, 0, 0); \
                if (MASKED) { _Pragma("unroll") for (int r = 0; r < 16; ++r) { const int j = crow(r, hi); const bool keep = dir == 0 ? (j <= q32) : (j >= q32); P[r] = keep ? P[r] : 0.f; } } \
                _Pragma("unroll") for (int s = 0; s < 2; ++s) { u32x4 pk; \
                    _Pragma("unroll") for (int j = 0; j < 4; ++j) pk[j] = cvtpk(P[8 * s + 2 * j], P[8 * s + 2 * j + 1]); \
                    _Pragma("unroll") for (int dh = 0; dh < 2; ++dh) { const int d = dh * 32 + q32, x = (d >> 1) & 15, kc = 8 * JT + 4 * s + hi; \
                        const u32x2 v0 = *(const LAS u32x2*)(myv + d * 128 + 8 * (kc ^ x)), v1 = *(const LAS u32x2*)(myv + d * 128 + 8 * ((kc + 2) ^ x)); \
                        o[IT][dh] = __builtin_amdgcn_mfma_f32_32x32x16_bf16(__builtin_bit_cast(bf16x8, pk), __builtin_bit_cast(bf16x8, (u32x4){v0.x, v0.y, v1.x, v1.y}), o[IT][dh], 0, 0, 0); } } } while (0)
#define SCN_INTER(IT) do { const LAS unsigned char* area = lds + wid * 8192; \
                _Pragma("unroll") for (int dh = 0; dh < 2; ++dh) _Pragma("unroll") for (int ks = 0; ks < NKS; ++ks) { \
                    const int d = dh * 32 + q32, sw = DK == 64 ? ((d >> 1) & 7) : ((d >> 2) & 3); \
                    const bf16x8 sf = *(const LAS bf16x8*)(area + d * (DK * 2) + 16 * ((2 * ks + hi) ^ sw)); \
                    o[IT][dh] = __builtin_amdgcn_mfma_f32_32x32x16_bf16(qf[ks], sf, o[IT][dh], 0, 0, 0); } } while (0)
            { bf16x8 qf[NKS]; SCN_GEN(qf, true, 0);
              SCN_TILE(0, 0, true); if (dir == 1) SCN_TILE(1, 0, false);
              SCN_INTER(0); }
            asm volatile("" ::: "memory");
            { bf16x8 qf[NKS]; SCN_GEN(qf, true, 1);
              if (dir == 0) SCN_TILE(0, 1, false);
              SCN_TILE(1, 1, true);
              SCN_INTER(1); }
#undef SCN_GEN
#undef SCN_TILE
#undef SCN_INTER
        }
        asm volatile("s_waitcnt lgkmcnt(0)" ::: "memory");
        __syncthreads();
    }
    if (act) {
        const int gcol = (MX == 0 ? PC_RG : PC_GR) + h * 64, ccol = (MX == 0 ? 512 : 768) + h * 64;
        const float g0 = MX == 0 ? p.ret_norm_g[l * 256 + h * 64 + q32] : p.gla_norm_g[l * 64 + q32], g1 = MX == 0 ? p.ret_norm_g[l * 256 + h * 64 + 32 + q32] : p.gla_norm_g[l * 64 + 32 + q32];
#pragma unroll
        for (int it = 0; it < 2; ++it)
#pragma unroll
            for (int r = 0; r < 16; ++r) {
                const int row = row0 + 32 * it + crow(r, hi);
                const float a0 = o[it][0][r], a1 = o[it][1][r];
                float ss = a0 * a0 + a1 * a1;
#pragma unroll
                for (int x = 1; x < 32; x <<= 1) ss += __shfl_xor(ss, x);
                const float rstd = rsqrtf(ss * (1.f / 64.f) + EPS);
                const float gt0 = bf2f(PB[(size_t)row * PW + gcol + q32]), gt1 = bf2f(PB[(size_t)row * PW + gcol + 32 + q32]);
                bf16_t* op = WSP(bf16_t, WS_CONCAT) + (size_t)row * D + ccol + q32;
                op[0] = f2bf(a0 * rstd * g0 * (gt0 / (1.f + SCN_EXP(-gt0)))); op[32] = f2bf(a1 * rstd * g1 * (gt1 / (1.f + SCN_EXP(-gt1))));
                if ((r & 3) == 3) asm volatile("" ::: "memory");
            }
    }
}
__device__ __forceinline__ void d_scan_stage1(KP kp, int l) {
    PH_IDS;
    for (int u = bid; u < 2 * 16 * 9; u += gridDim.x) {
        const int mx = u / 144, r = u % 144, bh = r / 9, g = r % 9;
        if (mx == 0) scan_stage1_unit<0>(kp, l, bh >> 2, bh & 3, g, tid); else scan_stage1_unit<1>(kp, l, bh >> 2, bh & 3, g, tid);
    }
}
__device__ __forceinline__ void d_scan_stage2(KP kp, int l, LAS unsigned char* lds) {
    PH_IDS;
    const int ng = l == 0 ? 9 : 8;
    for (int u = bid; u < 2 * 16 * ng; u += gridDim.x) {
        const int mx = u / (16 * ng), r = u % (16 * ng), bh = r / ng, g = r % ng;
        if (mx == 0) scan_stage2_unit<0>(kp, l, bh >> 2, bh & 3, g, lds, tid); else scan_stage2_unit<1>(kp, l, bh >> 2, bh & 3, g, lds, tid);
    }
}

namespace hfft {
typedef float f2 __attribute__((ext_vector_type(2)));
typedef float f4 __attribute__((ext_vector_type(4)));
constexpr int N = 8192;
__device__ __forceinline__ f2 cmul(f2 a, f2 b) { return (f2){a.x * b.x - a.y * b.y, a.x * b.y + a.y * b.x}; }
__device__ __forceinline__ f2 cmulc(f2 a, f2 b) { return (f2){a.x * b.x + a.y * b.y, a.y * b.x - a.x * b.y}; }
__device__ __forceinline__ f2 tw(float frac) { float sn, cs; sincosf(6.283185307179586f * frac, &sn, &cs); return (f2){cs, -sn}; }
__device__ __forceinline__ f2 mul_mi(f2 a) { return (f2){a.y, -a.x}; }
__device__ __forceinline__ f2 mul_pi(f2 a) { return (f2){-a.y, a.x}; }
template <int LOGD> __device__ __forceinline__ void fwd_pass(LAS f2* buf, int tid) {
    constexpr int Dd = 1 << LOGD;
#pragma unroll
    for (int g = 0; g < 4; ++g) {
        const int u = tid + NT * g, pos = u & (Dd - 1), base = ((u - pos) << 2) + pos;
        const f2 wA = tw((float)pos * (1.f / (4.f * Dd))), wB = cmul(wA, wA);
#pragma unroll
        for (int arr = 0; arr < 2; ++arr) {
            LAS f2* x = buf + arr * N + base;
            const f2 a0 = x[0], a1 = x[Dd], a2 = x[2 * Dd], a3 = x[3 * Dd];
            const f2 b0 = a0 + a2, b2 = cmul(a0 - a2, wA), b1 = a1 + a3, b3 = mul_mi(cmul(a1 - a3, wA));
            x[0] = b0 + b1; x[Dd] = cmul(b0 - b1, wB); x[2 * Dd] = b2 + b3; x[3 * Dd] = cmul(b2 - b3, wB);
        }
    }
    __syncthreads();
}
template <int LOGD> __device__ __forceinline__ void inv_pass(LAS f2* buf, int tid) {
    constexpr int Dd = 1 << LOGD;
#pragma unroll
    for (int g = 0; g < 4; ++g) {
        const int u = tid + NT * g, pos = u & (Dd - 1), base = ((u - pos) << 2) + pos;
        const f2 wA = tw((float)pos * (1.f / (4.f * Dd))), wB = cmul(wA, wA);
#pragma unroll
        for (int arr = 0; arr < 2; ++arr) {
            LAS f2* x = buf + arr * N + base;
            const f2 c0 = x[0], c1 = cmulc(x[Dd], wB), c2 = x[2 * Dd], c3 = cmulc(x[3 * Dd], wB);
            const f2 b0 = c0 + c1, b1 = c0 - c1, b2 = cmulc(c2 + c3, wA), b3 = mul_pi(cmulc(c2 - c3, wA));
            x[0] = b0 + b2; x[2 * Dd] = b0 - b2; x[Dd] = b1 + b3; x[3 * Dd] = b1 - b3;
        }
    }
    __syncthreads();
}
__device__ __forceinline__ void fwd_all(LAS f2* buf, int tid) { fwd_pass<11>(buf, tid); fwd_pass<9>(buf, tid); fwd_pass<7>(buf, tid); fwd_pass<5>(buf, tid); fwd_pass<3>(buf, tid); fwd_pass<1>(buf, tid); }
__device__ __forceinline__ void inv_all(LAS f2* buf, int tid) { inv_pass<1>(buf, tid); inv_pass<3>(buf, tid); inv_pass<5>(buf, tid); inv_pass<7>(buf, tid); inv_pass<9>(buf, tid); inv_pass<11>(buf, tid); }
}
__device__ __forceinline__ void d_fspec(KP kp, LAS unsigned char* lds) {
    PH_IDS;
    using namespace hfft;
    LAS f2* buf = (LAS f2*)lds;
    for (int u = bid; u < 256; u += gridDim.x) {
        const int l = u >> 7, c0 = (u & 127) * 2;
        const float* filt = WSP(float, WS_FILT) + (size_t)l * 8192 * 256;
        for (int i = tid; i < 2 * N; i += NT) { const int arr = i >> 13, tau = i & (N - 1); buf[i] = (f2){filt[(size_t)tau * 256 + c0 + arr], 0.f}; }
        __syncthreads();
        fwd_all(buf, tid);
        f4* fs = (f4*)(WSP(float, WS_FSPEC) + ((size_t)l * 256 + c0) * 2 * N);
        for (int i = tid; i < N; i += NT) {
            const int arr = i >> 12, j = i & 4095;
            const f4 v = *(const LAS f4*)(buf + arr * N + 2 * j);
            const float sc = 1.f / 8192.f;
            fs[(size_t)arr * (N / 2) + j] = (f4){(v.x + v.z) * sc, (v.y + v.w) * sc, (v.x - v.z) * sc, (v.y - v.w) * sc};
        }
        __syncthreads();
    }
}
__device__ __forceinline__ void d_hy_pre_fast(KP kp, int l, LAS unsigned char* lds) {
    PH_IDS;
    LAS float* zt = (LAS float*)lds;
    const bf16_t* PB = WSP(bf16_t, WS_PBUF);
    const int c = tid & 255, half = tid >> 8;
    const float* sw = p.hy_short_w + l * 3 * 768; const float* sb = p.hy_short_b + l * 768;
    float w0[3], w1[3], w2[3], bb[3];
#pragma unroll
    for (int g = 0; g < 3; ++g) { w0[g] = sw[g * 256 + c]; w1[g] = sw[768 + g * 256 + c]; w2[g] = sw[1536 + g * 256 + c]; bb[g] = sb[g * 256 + c]; }
    for (int u = bid; u < NLAT / 64; u += gridDim.x) {
        const int row0 = u * 64 + half * 32, t0 = (u * 64) & (SEQ - 1);
        float prev[3], cur[3], nxt[3];
#pragma unroll
        for (int g = 0; g < 3; ++g) {
            const bf16_t* pp = PB + (size_t)row0 * PW + PC_HY + g * 256 + c;
            prev[g] = (t0 + half * 32 > 0) ? bf2f(pp[-PW]) : 0.f; cur[g] = bf2f(pp[0]);
        }
#pragma unroll 4
        for (int i = 0; i < 32; ++i) {
            const int row = row0 + i, t = t0 + half * 32 + i;
            float uu[3];
#pragma unroll
            for (int g = 0; g < 3; ++g) { nxt[g] = (t < SEQ - 1) ? bf2f(PB[(size_t)(row + 1) * PW + PC_HY + g * 256 + c]) : 0.f;
                uu[g] = bb[g] + w0[g] * prev[g] + w1[g] * cur[g] + w2[g] * nxt[g]; prev[g] = cur[g]; cur[g] = nxt[g]; }
            WSP(bf16_t, WS_X0B)[(size_t)row * 256 + c] = f2bf(uu[0]);
            zt[c * 65 + half * 32 + i] = uu[1] * uu[2];
        }
        __syncthreads();
        const int b = (u * 64) >> 12;
        for (int i = tid; i < 256 * 64; i += NT) { const int cc = i >> 6, tl = i & 63; WSP(float, WS_ZT)[((size_t)cc * 4 + b) * SEQ + t0 + tl] = zt[cc * 65 + tl]; }
        __syncthreads();
    }
}
__device__ __forceinline__ void d_hy_fft(KP kp, int l, LAS unsigned char* lds) {
    PH_IDS;
    using namespace hfft;
    LAS f2* buf = (LAS f2*)lds;
    for (int c = bid; c < 256; c += gridDim.x) {
        const float* zt = WSP(float, WS_ZT) + (size_t)c * 4 * SEQ;
        for (int i = tid; i < 2 * N; i += NT) { const int arr = i >> 13, t = i & (N - 1);
            buf[i] = t < SEQ ? (f2){zt[(size_t)(2 * arr) * SEQ + t], zt[(size_t)(2 * arr + 1) * SEQ + t]} : (f2){0.f, 0.f}; }
        __syncthreads();
        fwd_all(buf, tid);
        const f4* fs = (const f4*)(WSP(float, WS_FSPEC) + ((size_t)l * 256 + c) * 2 * N);
        for (int i = tid; i < N; i += NT) {
            const int arr = i >> 12, j = i & 4095;
            LAS f4* xp = (LAS f4*)(buf + arr * N + 2 * j);
            const f4 v = *xp; const f4 f = fs[j];
            const f2 s = cmul((f2){v.x + v.z, v.y + v.w}, (f2){f.x, f.y}), d = cmul((f2){v.x - v.z, v.y - v.w}, (f2){f.z, f.w});
            *xp = (f4){s.x + d.x, s.y + d.y, s.x - d.x, s.y - d.y};
        }
        __syncthreads();
        inv_all(buf, tid);
        float* yt = WSP(float, WS_YT) + (size_t)c * 4 * SEQ;
        for (int i = tid; i < 2 * SEQ; i += NT) { const int arr = i >> 12, t = i & (SEQ - 1); const f2 v = buf[arr * N + t];
            yt[(size_t)(2 * arr) * SEQ + t] = v.x; yt[(size_t)(2 * arr + 1) * SEQ + t] = v.y; }
        __syncthreads();
    }
}
__device__ __forceinline__ void d_hy_post(KP kp, int l, LAS unsigned char* lds) {
    PH_IDS;
    LAS float* yt = (LAS float*)lds;
    for (int u = bid; u < NLAT / 64; u += gridDim.x) {
        const int b = (u * 64) >> 12, t0 = (u * 64) & (SEQ - 1);
        for (int i = tid; i < 256 * 64; i += NT) { const int cc = i >> 6, tl = i & 63; yt[cc * 65 + tl] = WSP(float, WS_YT)[((size_t)cc * 4 + b) * SEQ + t0 + tl]; }
        __syncthreads();
        for (int i = tid; i < 64 * 256; i += NT) { const int tl = i >> 8, c = i & 255; const size_t row = (size_t)u * 64 + tl;
            WSP(bf16_t, WS_CONCAT)[row * D + 256 + c] = f2bf(bf2f(WSP(bf16_t, WS_X0B)[row * 256 + c]) * yt[c * 65 + tl]); }
        __syncthreads();
    }
    if (l == 0) {
        GT_LOOP(idx, NCTX * 256) {
            const int c = idx & 255, row = NLAT + (idx >> 8);
            int base, n, t; seq_info(row, base, n, t);
            const bf16_t* PBc = WSP(bf16_t, WS_PBUF);
            const float* sw = p.hy_short_w; const float* sb = p.hy_short_b; const float* filt = WSP(float, WS_FILTC);
            float y = 0.f, x0 = 0.f;
            for (int s = 0; s < n; ++s) {
                const bf16_t* pp = PBc + (size_t)(base + s) * PW + PC_HY + c;
                float uu[3];
#pragma unroll
                for (int g = 0; g < 3; ++g) { float a = sb[g * 256 + c] + sw[768 + g * 256 + c] * bf2f(pp[g * 256]);
                    if (s > 0) a += sw[g * 256 + c] * bf2f(pp[g * 256 - PW]); if (s < n - 1) a += sw[1536 + g * 256 + c] * bf2f(pp[g * 256 + PW]); uu[g] = a; }
                if (s == t) x0 = uu[0];
                y += filt[(size_t)((t - s) & (2 * n - 1)) * 256 + c] * (uu[1] * uu[2]);
            }
            WSP(bf16_t, WS_CONCAT)[(size_t)row * D + 256 + c] = f2bf(x0 * y);
        }
    }
}

constexpr int CW_BAR = 32768;
__global__ void __launch_bounds__(NT, 2) mk_fwd(P kargs) {
    const KP kp0 = (KP)__builtin_amdgcn_kernarg_segment_ptr();
    KP kp = kp0;
#define LP ({ KP k_ = kp0; asm volatile("" : "+s"(k_)); k_; })
    unsigned char* const lds = g_lds;
    volatile LAS unsigned* misc = (volatile LAS unsigned*)((LAS unsigned char*)lds + LDS_MISC);
    if (threadIdx.x < 16) misc[threadIdx.x] = 0u;
    if ((threadIdx.x & 63) == 0) ((LAS int*)((LAS unsigned char*)lds + LDS_WTAB))[hw_wave_slot()] = threadIdx.x >> 6;
    __syncthreads();
    (void)xcd_barrier_post(WSP(unsigned, WS_CTL) + CW_BAR, misc);
    float* sm = (float*)lds;
#define GRID_BAR() do { XcdBarrier b_; { KP kp = LP; b_.bar = WSP(unsigned, WS_CTL) + CW_BAR; } b_.x = xb_xcc_id(); b_.st = (volatile LAS unsigned*)((LAS unsigned char*)lds + LDS_MISC); xcd_barrier(b_); } while (0)
    d_init(LP); d_mod(LP); d_weff(LP);
    d_filter(LP, 0, sm); d_filter(LP, 1, sm); d_filter(LP, 2, sm);
    d_convert_a(LP, (LAS float*)lds);
    GRID_BAR();
    d_filter_psum(LP); d_convert_b(LP, (LAS float*)lds);
    GRID_BAR();
    d_filter_norm(LP);
    GRID_BAR();
    d_fspec(LP, (LAS unsigned char*)lds);
#pragma unroll 1
    for (int l = 0; l < DEPTH; ++l) {
        d_norm1(LP, l);
        GRID_BAR();
        d_gemm_in(LP, l, (LAS unsigned char*)lds);
        GRID_BAR();
        d_prep_scan(LP); d_prep_attn(LP); d_hy_pre_fast(LP, l, (LAS unsigned char*)lds);
        GRID_BAR();
        d_scan_stage1(LP, l);
        d_hy_fft(LP, l, (LAS unsigned char*)lds);
        d_attn_fast(LP, l, (LAS unsigned char*)lds);
        GRID_BAR();
        d_scan_stage2(LP, l, (LAS unsigned char*)lds);
        d_hy_post(LP, l, (LAS unsigned char*)lds);
        GRID_BAR();
        d_gemm_out(LP, l, (LAS unsigned char*)lds);
        GRID_BAR();
        d_router(LP, l);
        GRID_BAR();
        d_moe_up(LP, l, (LAS unsigned char*)lds);
        GRID_BAR();
        d_moe_down(LP, l, (LAS unsigned char*)lds);
        GRID_BAR();
        d_combine(LP, l);
        GRID_BAR();
    }
}

#undef p
extern "C" void kernel_launch(void* const* d_in, const int* in_sizes, int n_in, void* d_out, int out_size, void* d_ws, size_t ws_size, hipStream_t stream) {
    if (n_in != 31 || ws_size < WS_END || out_size != NLAT * D) { fprintf(stderr, "kernel_launch: unexpected shapes (n_in %d ws %zu out %d)\n", n_in, ws_size, out_size); return; }
    static int grid = 0;
    if (grid == 0) {
        int dev = 0, cus = 0, per_cu = 0;
        if (hipGetDevice(&dev) != hipSuccess || hipDeviceGetAttribute(&cus, hipDeviceAttributeMultiprocessorCount, dev) != hipSuccess) { grid = -1; return; }
        if (hipFuncSetAttribute((const void*)mk_fwd, hipFuncAttributeMaxDynamicSharedMemorySize, LDS_BYTES) != hipSuccess) { fprintf(stderr, "hipFuncSetAttribute failed\n"); grid = -1; return; }
        if (hipOccupancyMaxActiveBlocksPerMultiprocessor(&per_cu, (const void*)mk_fwd, NT, LDS_BYTES) != hipSuccess || per_cu < 1) { fprintf(stderr, "occupancy query says %d\n", per_cu); }
        (void)hipGetLastError();
        grid = cus;
    }
    if (grid < 0) return;
    P hp{};
    const float** pp = (const float**)&hp;
    for (int i = 0; i < 31; ++i) pp[i] = (const float*)d_in[i];
    hp.out = (float*)d_out; hp.ws = (unsigned char*)d_ws;
    (void)hipMemsetAsync((char*)d_ws + WS_CTL, 0, 1 * MiB, stream);
    hipLaunchKernelGGL(mk_fwd, dim3(grid), dim3(NT), LDS_BYTES, stream, hp);
}
```

```cpp
#include <hip/hip_runtime.h>
#include <stdint.h>
#include <stdio.h>
#include <math.h>

constexpr int D = 1024, BATCH = 4, SEQ = 4096, CTXL = 256, DEPTH = 2;
constexpr int NLAT = BATCH * SEQ, NCTX = BATCH * CTXL, MALL = NLAT + NCTX;
constexpr int INW = 3360, PW = 3584;
constexpr int NEXP = 32, TOPK = 4;
constexpr float EPS = 1e-6f;
constexpr int PC_AQ = 0, PC_AK = 256, PC_AV = 512, PC_HY = 768, PC_RQ = 1536, PC_RK = 1792, PC_RV = 2048, PC_RG = 2304,
              PC_GQ = 2560, PC_GK = 2688, PC_GV = 2816, PC_GR = 3072, PC_GD = 3328;
constexpr int ACT_ROWS = MALL * TOPK + NEXP * 256;

typedef unsigned short bf16_t;
typedef float cvt_f32x2_t __attribute__((ext_vector_type(2))); typedef __bf16 cvt_bf16x2_t __attribute__((ext_vector_type(2)));
__device__ __forceinline__ unsigned cvtpk_rne(float lo, float hi) { cvt_f32x2_t v = {lo, hi}; cvt_bf16x2_t b = __builtin_convertvector(v, cvt_bf16x2_t); return __builtin_bit_cast(unsigned, b); }
__device__ __forceinline__ bf16_t f2bf(float f) { unsigned u = __float_as_uint(f); return (bf16_t)((u + 0x7fffu + ((u >> 16) & 1u)) >> 16); }
__device__ __forceinline__ float bf2f(bf16_t b) { return __uint_as_float(((unsigned)b) << 16); }

typedef unsigned gv4u __attribute__((ext_vector_type(4))); typedef float gv4f __attribute__((ext_vector_type(4)));
__device__ __forceinline__ float gblo(unsigned w) { return __uint_as_float(w << 16); }
__device__ __forceinline__ float gbhi(unsigned w) { return __uint_as_float(w & 0xffff0000u); }
constexpr size_t MiB = 1u << 20;
constexpr size_t WS_CTL = 0;
constexpr size_t WS_MOD = 1 * MiB;
constexpr size_t WS_WEFF = 3 * MiB;
constexpr size_t WS_FILT = 6 * MiB;
constexpr size_t WS_FILTC = WS_FILT + 16 * MiB;
constexpr size_t WS_XRES = 24 * MiB;
constexpr size_t WS_HB = WS_XRES + 68 * MiB;
constexpr size_t WS_PBUF = WS_HB + 34 * MiB;
constexpr size_t WS_CONCAT = WS_PBUF + 120 * MiB;
constexpr size_t WS_YBUF = WS_CONCAT + 34 * MiB;
constexpr size_t WS_QA = WS_YBUF + 68 * MiB;
constexpr size_t WS_KA = WS_QA + 17 * MiB;
constexpr size_t WS_QR = WS_KA + 17 * MiB;
constexpr size_t WS_KR = WS_QR + 17 * MiB;
constexpr size_t WS_OA = WS_KR + 17 * MiB;
constexpr size_t WS_Z = WS_OA + 34 * MiB;
constexpr size_t WS_X0 = WS_Z + 17 * MiB;
constexpr size_t WS_LA = WS_X0 + 17 * MiB;
constexpr size_t WS_OD = WS_LA + 17 * MiB;
constexpr size_t WS_TOPI = WS_OD + 68 * MiB;
constexpr size_t WS_TOPW = WS_TOPI + 1 * MiB;
constexpr size_t WS_LIST = WS_TOPW + 1 * MiB;
constexpr size_t WS_ACT = WS_LIST + 3 * MiB;
constexpr size_t WS_YSLOT = WS_ACT + 160 * MiB;
constexpr size_t WS_WIN_T = WS_YSLOT + 160 * MiB;
constexpr size_t WS_WOUT_T = WS_WIN_T + 14 * MiB;
constexpr size_t WS_W1_T = WS_WOUT_T + 4 * MiB;
constexpr size_t WS_W2_T = WS_W1_T + 256 * MiB;
constexpr size_t WS_BIAS_IN = WS_W2_T + 128 * MiB;
constexpr size_t WS_QRP = WS_BIAS_IN + 1 * MiB;
constexpr size_t WS_KIMG = WS_QRP + 9 * MiB;
constexpr size_t WS_VIMG = WS_KIMG + 9 * MiB;
constexpr size_t WS_QF_R = WS_VIMG + 9 * MiB;
constexpr size_t WS_KF_R = WS_QF_R + 9 * MiB;
constexpr size_t WS_KT_R = WS_KF_R + 9 * MiB;
constexpr size_t WS_KT_G = WS_KT_R + 9 * MiB;
constexpr size_t WS_VT_R = WS_KT_G + 5 * MiB;
constexpr size_t WS_VT_G = WS_VT_R + 9 * MiB;
constexpr size_t WS_CUM_G = WS_VT_G + 9 * MiB;
constexpr size_t WS_CUMT_G = WS_CUM_G + 17 * MiB;
constexpr size_t WS_US_R = WS_CUMT_G + 17 * MiB;
constexpr size_t WS_US_G = WS_US_R + 34 * MiB;
constexpr size_t WS_UG_R = WS_US_G + 17 * MiB;
constexpr size_t WS_UG_G = WS_UG_R + 5 * MiB;
constexpr size_t WS_AG = WS_UG_G + 3 * MiB;
constexpr size_t WS_ROPE = WS_AG + 1 * MiB;
constexpr size_t WS_FSPEC = WS_ROPE + 1 * MiB;
constexpr size_t WS_ZT = WS_FSPEC + 32 * MiB;
constexpr size_t WS_YT = WS_ZT + 16 * MiB;
constexpr size_t WS_X0B = WS_YT + 16 * MiB;
constexpr size_t WS_MODP = WS_X0B + 8 * MiB;
constexpr size_t WS_PS = WS_MODP + 4 * MiB;
constexpr size_t WS_ZC = WS_PS + 1 * MiB;
constexpr size_t WS_X0C = WS_ZC + 1 * MiB;
constexpr size_t WS_END = WS_X0C + 1 * MiB;
constexpr int CW_CNT = 1024;
constexpr int CW_NORM = 2048;

struct P {
    const float *x, *c, *ctx, *c_ctx, *w_mod, *b_mod, *norm_g, *w_in, *w_out, *diff_lambda, *diff_subln_g, *hy_short_w, *hy_short_b,
        *hy_w1, *hy_b1, *hy_w2, *hy_b2, *hy_w3, *hy_freq, *hy_bias, *ret_decay, *ret_norm_g, *gla_gate_w, *gla_gate_b, *gla_norm_g,
        *router_w, *router_b, *exp_w1, *exp_b1, *exp_w2, *exp_b2;
    float* out; unsigned char* ws;
};
typedef const __attribute__((address_space(4))) P* KP;
#define p (*kp)
#define WSP(T, off) ((T*)(p.ws + (off)))

__device__ __forceinline__ float wave_sum(float v) {
#pragma unroll
    for (int o = 1; o < 64; o <<= 1) v += __shfl_xor(v, o);
    return v;
}
__device__ __forceinline__ float silu_f(float x) { return x / (1.f + expf(-x)); }
__host__ __device__ __forceinline__ int nrows_l(int l) { return l == 0 ? MALL : NLAT; }
__device__ __forceinline__ int mod_r(int row) { return row < NLAT ? row / SEQ : 4; }
__device__ __forceinline__ void seq_info(int row, int& base, int& n, int& t) {
    if (row < NLAT) { base = row & ~(SEQ - 1); n = SEQ; t = row - base; }
    else { int r = row - NLAT; base = NLAT + (r & ~(CTXL - 1)); n = CTXL; t = row - base; }
}

__device__ __forceinline__ int ltid();
#define XB_TMO      128
#define XB_XCNT(j)  (256  + 64 * (j))
#define XB_XSUB(j)  (1280 + 64 * (j))
#define XB_XGEN(j)  (2304 + 64 * (j))
#define XB_TOP      3328
#define XB_TOPGEN   3392
#define XCD_BAR_WORDS 3456
#define XB_SPIN_CAP (1u << 22)
#define LAS __attribute__((address_space(3)))
__device__ __forceinline__ unsigned xb_ld(unsigned* ptr)            { return __hip_atomic_load(ptr, __ATOMIC_RELAXED, __HIP_MEMORY_SCOPE_AGENT); }
__device__ __forceinline__ unsigned xb_add(unsigned* ptr, unsigned v) { return __hip_atomic_fetch_add(ptr, v, __ATOMIC_RELAXED, __HIP_MEMORY_SCOPE_AGENT); }
__device__ __forceinline__ unsigned xb_xcc_id() { return (unsigned)__builtin_amdgcn_s_getreg((3 << 11) | 20) & 0xFu; }
#define XB_SPIN(cond, bar) do { unsigned _sp = 0; while (cond) { __builtin_amdgcn_s_sleep(1); \
    if ((++_sp & 255u) == 0u) { if (xb_ld(&(bar)[XB_TMO])) break; if (_sp > XB_SPIN_CAP) { atomicAdd(&(bar)[XB_TMO], 1u); break; } } } } while (0)
struct XcdBarrier { unsigned* bar; unsigned x; volatile LAS unsigned* st; };
__device__ __forceinline__ XcdBarrier xcd_barrier_post(unsigned* bar, volatile LAS unsigned* st) {
    XcdBarrier b; b.bar = bar; b.x = xb_xcc_id(); b.st = st;
    if (threadIdx.x == 0) (void)xb_add(&bar[XB_XCNT(b.x)], 1u);
    return b;
}
__device__ __forceinline__ void xcd_barrier_complete(unsigned* bar, unsigned x, unsigned& nloc, unsigned& nx) {
    const unsigned G = gridDim.x * gridDim.y * gridDim.z;
    unsigned sum, cnt, mine, sp = 0u;
    for (;;) {
        sum = 0u; cnt = 0u; mine = 0u;
#pragma unroll
        for (unsigned j = 0; j < 16; ++j) { const unsigned c = xb_ld(&bar[XB_XCNT(j)]); sum += c; cnt += (c > 0u) ? 1u : 0u; mine = (j == x) ? c : mine; }
        if (sum == G) break;
        __builtin_amdgcn_s_sleep(1);
        if ((++sp & 255u) == 0u) { if (xb_ld(&bar[XB_TMO])) break; if (sp > XB_SPIN_CAP) { atomicAdd(&bar[XB_TMO], 1u); break; } }
    }
    nloc = mine > 0u ? mine : 1u; nx = cnt > 0u ? cnt : 1u;
}
__device__ __forceinline__ void xcd_barrier(const XcdBarrier& b) {
    asm volatile("s_waitcnt vmcnt(0)" ::: "memory");
    __syncthreads();
    if (ltid() == 0) {
        unsigned* bar = b.bar;
        __builtin_amdgcn_s_waitcnt(0);
        unsigned nloc = b.st[0], nx = b.st[1];
        if (nloc == 0u) { xcd_barrier_complete(bar, b.x, nloc, nx); b.st[0] = nloc; b.st[1] = nx; }
        const unsigned old = xb_add(&bar[XB_XSUB(b.x)], 1u);
        const unsigned gen = old / nloc;
        if (old + 1u == (gen + 1u) * nloc) {
            __builtin_amdgcn_fence(__ATOMIC_RELEASE, "agent");
            asm volatile("s_waitcnt vmcnt(0)" ::: "memory");
            const unsigned og = xb_add(&bar[XB_TOP], 1u);
            const unsigned tg = og / nx;
            if (og + 1u == (tg + 1u) * nx) xb_add(&bar[XB_TOPGEN], 1u);
            else XB_SPIN(xb_ld(&bar[XB_TOPGEN]) == tg, bar);
            __builtin_amdgcn_fence(__ATOMIC_ACQUIRE, "agent");
            xb_add(&bar[XB_XGEN(b.x)], 1u);
            asm volatile("s_waitcnt vmcnt(0)" ::: "memory");
        } else {
            XB_SPIN(xb_ld(&bar[XB_XGEN(b.x)]) == gen, bar);
            __builtin_amdgcn_fence(__ATOMIC_ACQUIRE, "agent");
            asm volatile("s_waitcnt vmcnt(0)" ::: "memory");
        }
    }
    __syncthreads();
}

constexpr int NT = 512;
extern __shared__ __attribute__((aligned(16))) unsigned char g_lds[];
constexpr int LDS_BYTES = 147456;
constexpr int LDS_WTAB = LDS_BYTES - 512;
constexpr int LDS_MISC = LDS_BYTES - 64;
__device__ __forceinline__ int hw_wave_slot() { return (int)(__builtin_amdgcn_s_getreg((5 << 11) | 4) & 63u); }
__device__ __forceinline__ int ltid() {
    const int w = __builtin_amdgcn_readfirstlane(((const LAS int*)((LAS unsigned char*)g_lds + LDS_WTAB))[hw_wave_slot()]);
    unsigned ones = ~0u; asm volatile("" : "+s"(ones));
    int t = (w << 6) | (int)__builtin_amdgcn_mbcnt_hi(ones, __builtin_amdgcn_mbcnt_lo(ones, 0u));
    asm volatile("" : "+v"(t)); return t;
}
__device__ __forceinline__ int lbid() { int b = blockIdx.x; asm volatile("" : "+s"(b)); return b; }
#define PH_IDS const int tid = ltid(), bid = lbid(); (void)tid; (void)bid
#define GT_LOOP(idx, total) for (int idx = bid * NT + tid; idx < (total); idx += gridDim.x * NT)
#define GW_LOOP(w, total) for (int w = bid * (NT / 64) + (tid >> 6); w < (total); w += gridDim.x * (NT / 64))

__device__ __forceinline__ const float* xin_row(KP kp, int l, int row) {
    return l == 0 ? (row < NLAT ? p.x + (size_t)row * D : p.ctx + (size_t)(row - NLAT) * D) : WSP(float, WS_XRES) + (size_t)row * D;
}
__device__ __forceinline__ void d_pro0(KP kp) {
    PH_IDS;
    GT_LOOP(idx, 64 * 24) {
        const int pos = idx / 24, j = idx % 24; float ang; float* dst;
        if (j < 8) { ang = (float)pos * powf(10000.f, -(float)j / 8.f); dst = WSP(float, WS_ROPE) + (pos * 8 + j) * 2; }
        else { ang = (float)pos * powf(10000.f, -(float)(j - 8) / 16.f); dst = WSP(float, WS_ROPE) + 1024 + (pos * 16 + (j - 8)) * 2; }
        dst[0] = cosf(ang); dst[1] = sinf(ang);
    }
    GT_LOOP(idx, 2 * 1024 * 256) {
        int n = idx & 255, i = (idx >> 8) & 1023, l = idx >> 18, d = n >> 7, j = n & 127;
        float a = 0.f;
        for (int r = 0; r < 16; ++r) a += p.w_in[((size_t)l * D + i) * INW + 3328 + d * 16 + r] * p.gla_gate_w[((l * 2 + d) * 16 + r) * 128 + j];
        WSP(float, WS_WEFF)[idx] = a;
    }
    const int lane = tid & 63;
    GW_LOOP(task, 2 * 96 * 16) {
        const int chunk = task & 15, jb = (task >> 4) % 96, l = task / (16 * 96), j = jb * 64 + lane;
        const float* w = p.w_mod + ((size_t)l * D + chunk * 64) * 6144 + j;
        float acc[5] = {0.f, 0.f, 0.f, 0.f, 0.f};
#pragma unroll 8
        for (int i = 0; i < 64; ++i) { const float wv = w[(size_t)i * 6144];
#pragma unroll
            for (int r = 0; r < 5; ++r) { const float cv = r < 4 ? p.c[r * D + chunk * 64 + i] : p.c_ctx[chunk * 64 + i]; acc[r] += silu_f(cv) * wv; } }
#pragma unroll
        for (int r = 0; r < 5; ++r) WSP(float, WS_MODP)[((size_t)(chunk * 2 + l) * 5 + r) * 6144 + j] = acc[r];
    }
}
__device__ __forceinline__ void d_filter(KP kp, LAS float* sm) {
    PH_IDS;
    const int lane = tid & 63; LAS float* zf = sm + (tid >> 6) * 192; LAS float* h1 = zf + 64; LAS float* h2 = zf + 128;
    GW_LOOP(task, 2 * SEQ + CTXL) {
        const int which = task < SEQ ? 0 : task < 2 * SEQ ? 1 : 2, pos = task - (which == 2 ? 2 * SEQ : which * SEQ), l = which == 1 ? 1 : 0, n = which == 2 ? CTXL : SEQ;
        float* filt = which == 2 ? WSP(float, WS_FILTC) : WSP(float, WS_FILT) + (size_t)l * 8192 * 256;
        const float t = (float)pos / (float)(n - 1), w = (6.2831855f * (float)pos) / (float)n;
        if (lane < 33) { float v = t; if (lane >= 1) { const int q = (lane - 1) & 15; const float f = 1e-4f + (15.f - 1e-4f) * ((float)q / 15.f), a = w * f; v = lane < 17 ? cosf(a) : -sinf(a); } zf[lane] = v; }
        asm volatile("s_waitcnt lgkmcnt(0)" ::: "memory");
        float a = p.hy_b1[l * 64 + lane];
        for (int i = 0; i < 33; ++i) a += zf[i] * p.hy_w1[(l * 33 + i) * 64 + lane];
        h1[lane] = sinf(p.hy_freq[(l * 2 + 0) * 64 + lane] * a);
        asm volatile("s_waitcnt lgkmcnt(0)" ::: "memory");
        a = p.hy_b2[l * 64 + lane];
        for (int i = 0; i < 64; ++i) a += h1[i] * p.hy_w2[(l * 64 + i) * 64 + lane];
        h2[lane] = sinf(p.hy_freq[(l * 2 + 1) * 64 + lane] * a);
        asm volatile("s_waitcnt lgkmcnt(0)" ::: "memory");
        float raw[8];
#pragma unroll
        for (int q = 0; q < 8; ++q) raw[q] = 0.f;
        for (int j = 0; j < 64; ++j) { const float hj = h2[j]; const float* w3 = p.hy_w3 + (size_t)(l * 64 + j) * 512 + lane;
#pragma unroll
            for (int q = 0; q < 8; ++q) raw[q] += hj * w3[q * 64]; }
        const float mind = logf(1e-2f) / 1.5f, maxd = logf(1e-2f) / 0.3f;
#pragma unroll
        for (int q = 0; q < 8; ++q) {
            const int c = (q & 3) * 64 + lane;
            const float v = raw[q] * expf(-t * fabsf(mind + (maxd - mind) * ((float)c / 255.f)));
            if (q < 4) { filt[(size_t)pos * 256 + c] = v; if (pos == 0) filt[(size_t)n * 256 + c] = 0.f; }
            else if (pos >= 1) filt[(size_t)(2 * n - pos) * 256 + c] = v;
        }
        asm volatile("s_waitcnt lgkmcnt(0)" ::: "memory");
    }
}
__device__ __forceinline__ void d_pro1(KP kp) {
    PH_IDS;
    GT_LOOP(idx, 2 * 5 * 6144) {
        const int j = idx % 6144, r = (idx / 6144) % 5, l = idx / (6144 * 5);
        float a = p.b_mod[l * 6144 + j];
        for (int ch = 0; ch < 16; ++ch) a += WSP(float, WS_MODP)[((size_t)(ch * 2 + l) * 5 + r) * 6144 + j];
        WSP(float, WS_MOD)[idx] = a;
    }
    GT_LOOP(idx, 528 * 256) {
        const int vb = idx >> 8, c = idx & 255, which = vb < 256 ? 0 : vb < 512 ? 1 : 2, slab = vb - (which == 2 ? 512 : which * 256);
        const float* filt = which == 2 ? WSP(float, WS_FILTC) : WSP(float, WS_FILT) + (size_t)which * 8192 * 256;
        float a = 0.f;
#pragma unroll 8
        for (int i = 0; i < 32; ++i) a += fabsf(filt[(size_t)(slab * 32 + i) * 256 + c]);
        WSP(float, WS_PS)[(which * 256 + slab) * 256 + c] = a;
    }
}
__device__ __forceinline__ void d_norm1(KP kp, int l) {
    PH_IDS;
    const int lane = tid & 63;
    GW_LOOP(row, MALL) {
        const float* xr = xin_row(kp, l, row);
        const float* mod = WSP(float, WS_MOD) + (size_t)(l * 5 + mod_r(row)) * 6144;
        const float* g = p.norm_g + (l * 4 + 0) * D;
        float v[16], ss = 0.f;
#pragma unroll
        for (int j = 0; j < 16; ++j) { v[j] = xr[j * 64 + lane]; ss += v[j] * v[j]; }
        const float rstd = rsqrtf(wave_sum(ss) * (1.f / D) + EPS);
        bf16_t* hb = WSP(bf16_t, WS_HB) + (size_t)row * D;
#pragma unroll
        for (int j = 0; j < 16; ++j) { int cidx = j * 64 + lane; hb[cidx] = f2bf(v[j] * rstd * g[cidx] * (1.f + mod[1024 + cidx]) + mod[cidx]); }
    }
}
__device__ __forceinline__ void d_router(KP kp, int l, LAS float* sm) {
    PH_IDS;
    const int lane = tid & 63;
    for (int i = tid; i < D * NEXP; i += NT) sm[(i >> 5) * 33 + (i & 31)] = p.router_w[(size_t)l * D * NEXP + i];
    LAS int* lcnt = (LAS int*)(sm + 33800); LAS int* lbase = lcnt + 32; LAS int* rec = lcnt + 64;
    if (tid < 32) lcnt[tid] = 0;
    __syncthreads();
    int it = 0;
    GW_LOOP(row, nrows_l(l)) {
        const float* xs = xin_row(kp, l, row);
        float* xr = WSP(float, WS_XRES) + (size_t)row * D;
        const float* y = WSP(float, WS_YBUF) + (size_t)row * D;
        const float* mod = WSP(float, WS_MOD) + (size_t)(l * 5 + mod_r(row)) * 6144;
        const float* g1 = p.norm_g + (l * 4 + 1) * D; const float* g2 = p.norm_g + (l * 4 + 2) * D;
        float yv[16], xv[16], ss = 0.f;
#pragma unroll
        for (int j = 0; j < 16; ++j) { yv[j] = y[j * 64 + lane]; ss += yv[j] * yv[j]; }
        float rstd = rsqrtf(wave_sum(ss) * (1.f / D) + EPS);
        ss = 0.f;
#pragma unroll
        for (int j = 0; j < 16; ++j) { const int ci = j * 64 + lane; xv[j] = xs[ci] + mod[2048 + ci] * (yv[j] * rstd * g1[ci]); ss += xv[j] * xv[j]; }
        float gsc[16], gsh[16];
#pragma unroll
        for (int j = 0; j < 16; ++j) { const int ci = j * 64 + lane; gsc[j] = g2[ci] * (1.f + mod[4096 + ci]); gsh[j] = mod[3072 + ci]; }
#pragma unroll
        for (int j = 0; j < 16; ++j) xr[j * 64 + lane] = xv[j];
        rstd = rsqrtf(wave_sum(ss) * (1.f / D) + EPS);
        bf16_t* hb = WSP(bf16_t, WS_HB) + (size_t)row * D;
        float v[32];
#pragma unroll
        for (int e = 0; e < 32; ++e) v[e] = 0.f;
#pragma unroll
        for (int j = 0; j < 16; ++j) { xv[j] = xv[j] * rstd * gsc[j] + gsh[j]; hb[j * 64 + lane] = f2bf(xv[j]); }
#pragma unroll
        for (int j = 0; j < 16; ++j) { const LAS float* wr = sm + (j * 64 + lane) * 33; const float hv = xv[j];
#pragma unroll
            for (int e = 0; e < 32; ++e) v[e] += hv * wr[e];
            asm volatile("" : "+v"(v[0]), "+v"(v[8]), "+v"(v[16]), "+v"(v[24])); }
#pragma unroll
        for (int k = 0; k < 16; ++k) { const bool up = lane & 32; const float send = up ? v[k] : v[k + 16], keep = up ? v[k + 16] : v[k]; v[k] = keep + __shfl_xor(send, 32); }
#pragma unroll
        for (int k = 0; k < 8; ++k) { const bool up = lane & 16; const float send = up ? v[k] : v[k + 8], keep = up ? v[k + 8] : v[k]; v[k] = keep + __shfl_xor(send, 16); }
#pragma unroll
        for (int k = 0; k < 4; ++k) { const bool up = lane & 8; const float send = up ? v[k] : v[k + 4], keep = up ? v[k + 4] : v[k]; v[k] = keep + __shfl_xor(send, 8); }
#pragma unroll
        for (int k = 0; k < 2; ++k) { const bool up = lane & 4; const float send = up ? v[k] : v[k + 2], keep = up ? v[k + 2] : v[k]; v[k] = keep + __shfl_xor(send, 4); }
        { const bool up = lane & 2; const float send = up ? v[0] : v[1], keep = up ? v[1] : v[0]; v[0] = keep + __shfl_xor(send, 2); }
        const int myexp = lane >> 1;
        float mylogit = v[0] + __shfl_xor(v[0], 1) + p.router_b[l * NEXP + myexp];
        float tv[4]; int ti[4];
#pragma unroll
        for (int k = 0; k < 4; ++k) {
            float bv = mylogit; int bi = myexp;
#pragma unroll
            for (int o = 1; o < 64; o <<= 1) { const float ov = __shfl_xor(bv, o); const int oi = __shfl_xor(bi, o); if (ov > bv || (ov == bv && oi < bi)) { bv = ov; bi = oi; } }
            tv[k] = bv; ti[k] = bi; if (myexp == bi) mylogit = -1e30f;
        }
        float den = 0.f, w[4];
#pragma unroll
        for (int k = 0; k < 4; ++k) { w[k] = expf(tv[k] - tv[0]); den += w[k]; }
        if (lane < 4) {
            const int e = lane == 0 ? ti[0] : lane == 1 ? ti[1] : lane == 2 ? ti[2] : ti[3];
            const float ww = lane == 0 ? w[0] : lane == 1 ? w[1] : lane == 2 ? w[2] : w[3];
            const int lr = __hip_atomic_fetch_add(&lcnt[e], 1, __ATOMIC_RELAXED, __HIP_MEMORY_SCOPE_WORKGROUP);
            rec[(it * 8 + (tid >> 6)) * 4 + lane] = (e << 16) | lr;
            WSP(float, WS_TOPW)[row * 4 + lane] = ww / den;
            WSP(int, WS_TOPI)[row * 4 + lane] = e;
        }
        ++it;
    }
    asm volatile("s_waitcnt lgkmcnt(0)" ::: "memory");
    __syncthreads();
    if (tid < 32) lbase[tid] = (int)atomicAdd(WSP(unsigned, WS_CTL) + CW_CNT + (l * 32 + tid) * 64, (unsigned)lcnt[tid]);
    asm volatile("s_waitcnt vmcnt(0) lgkmcnt(0)" ::: "memory");
    __syncthreads();
    it = 0;
    GW_LOOP(row, nrows_l(l)) {
        if (lane < 4) { const int rc = rec[(it * 8 + (tid >> 6)) * 4 + lane], e = rc >> 16, pos = lbase[e] + (rc & 0xffff);
            WSP(int, WS_LIST)[(size_t)e * MALL + pos] = row * 4 + lane; WSP(int, WS_TOPI)[MALL * 4 + row * 4 + lane] = pos; }
        ++it;
    }
    __syncthreads();
}
__device__ __forceinline__ void d_combine(KP kp, int l, LAS int* aoffs) {
    PH_IDS;
    const int lane = tid & 63;
    const unsigned* cnt = WSP(unsigned, WS_CTL) + CW_CNT + l * 32 * 64;
    if (tid == 0) { int a = 0; for (int e = 0; e < 32; ++e) { aoffs[e] = a; a += ((int)cnt[e * 64] + 255) & ~255; } }
    __syncthreads();
    GW_LOOP(row, nrows_l(l)) {
        int ee[4], pp[4];
#pragma unroll
        for (int k = 0; k < 4; ++k) { ee[k] = WSP(int, WS_TOPI)[row * 4 + k]; pp[k] = WSP(int, WS_TOPI)[MALL * 4 + row * 4 + k]; }
        gv4u yv[4][2];
#pragma unroll
        for (int k = 0; k < 4; ++k) { const gv4u* ys = (const gv4u*)(WSP(bf16_t, WS_YSLOT) + (size_t)(aoffs[ee[k]] + pp[k]) * D) + lane; yv[k][0] = ys[0]; yv[k][1] = ys[64]; }
        float acc[16];
#pragma unroll
        for (int j = 0; j < 16; ++j) acc[j] = 0.f;
#pragma unroll
        for (int k = 0; k < 4; ++k)
#pragma unroll
            for (int hf = 0; hf < 2; ++hf)
#pragma unroll
                for (int q = 0; q < 4; ++q) { acc[hf * 8 + 2 * q] += gblo(yv[k][hf][q]); acc[hf * 8 + 2 * q + 1] += gbhi(yv[k][hf][q]); }
        float ss = 0.f;
#pragma unroll
        for (int j = 0; j < 16; ++j) ss += acc[j] * acc[j];
        float rstd = rsqrtf(wave_sum(ss) * (1.f / D) + EPS);
        float* xr = WSP(float, WS_XRES) + (size_t)row * D;
        const float* mod = WSP(float, WS_MOD) + (size_t)(l * 5 + mod_r(row)) * 6144;
        const float* g3 = p.norm_g + (l * 4 + 3) * D;
        ss = 0.f;
        gv4f xo[4], gm[4], gg[4];
#pragma unroll
        for (int q8 = 0; q8 < 4; ++q8) { const int ci = (q8 >> 1) * 512 + lane * 8 + (q8 & 1) * 4; xo[q8] = *(const gv4f*)(xr + ci); gm[q8] = *(const gv4f*)(mod + 5120 + ci); gg[q8] = *(const gv4f*)(g3 + ci); }
        float n0[16], n1[16], n2[16];
        if (l < DEPTH - 1) {
            const float* mod2 = WSP(float, WS_MOD) + (size_t)((l + 1) * 5 + mod_r(row)) * 6144; const float* g0 = p.norm_g + ((l + 1) * 4 + 0) * D;
#pragma unroll
            for (int q8 = 0; q8 < 4; ++q8) { const int ci = (q8 >> 1) * 512 + lane * 8 + (q8 & 1) * 4; const gv4f a = *(const gv4f*)(g0 + ci), b2 = *(const gv4f*)(mod2 + 1024 + ci), c2 = *(const gv4f*)(mod2 + ci);
#pragma unroll
                for (int q = 0; q < 4; ++q) { n0[q8 * 4 + q] = a[q]; n1[q8 * 4 + q] = b2[q]; n2[q8 * 4 + q] = c2[q]; } }
        }
#pragma unroll
        for (int q8 = 0; q8 < 4; ++q8) {
            const int ci = (q8 >> 1) * 512 + lane * 8 + (q8 & 1) * 4;
            gv4f vv;
#pragma unroll
            for (int q = 0; q < 4; ++q) { const float v = xo[q8][q] + gm[q8][q] * (acc[q8 * 4 + q] * rstd * gg[q8][q]); vv[q] = v; acc[q8 * 4 + q] = v; ss += v * v; }
            if (l == DEPTH - 1) *(gv4f*)(p.out + (size_t)row * D + ci) = vv; else *(gv4f*)(xr + ci) = vv;
        }
        if (l < DEPTH - 1) {
            rstd = rsqrtf(wave_sum(ss) * (1.f / D) + EPS);
            bf16_t* hb = WSP(bf16_t, WS_HB) + (size_t)row * D;
#pragma unroll
            for (int hf = 0; hf < 2; ++hf) {
                gv4u o;
#pragma unroll
                for (int q = 0; q < 4; ++q) { const int i0 = hf * 8 + 2 * q; o[q] = cvtpk_rne(acc[i0] * rstd * n0[i0] * (1.f + n1[i0]) + n2[i0], acc[i0 + 1] * rstd * n0[i0 + 1] * (1.f + n1[i0 + 1]) + n2[i0 + 1]); }
                *(gv4u*)(hb + hf * 512 + lane * 8) = o;
            }
        }
    }
    __syncthreads();
}

namespace pg8 {
typedef short bf16x8 __attribute__((ext_vector_type(8)));
typedef float f32x4 __attribute__((ext_vector_type(4)));
typedef unsigned u32x4 __attribute__((ext_vector_type(4)));
typedef unsigned u32x2 __attribute__((ext_vector_type(2)));
constexpr int BM = 256, BK = 64, HALF = 128, HTB = HALF * BK * 2, STAGE_BYTES = 8 * HTB, NXCD = 8, WGM = 8, K = 1024;
__host__ __device__ __forceinline__ int lds_byte(int r, int c) { const int st = (r >> 4) * 2 + (c >> 5), rr = r & 15, cc = c & 31, ob = rr * 64 + cc * 2; return st * 1024 + (ob ^ (((ob >> 9) & 1) << 5)); }
__host__ __device__ __forceinline__ void stage_rc(int b, int& R, int& C) { const int st = b / 1024, sb = b % 1024, swz = sb ^ (((sb >> 9) & 1) << 5); R = (st >> 1) * 16 + swz / 64; C = (st & 1) * 32 + (swz % 64) / 2; }
__host__ __device__ __forceinline__ int perm32(int rho) { const int n = rho >> 4, i = rho & 15; return 8 * (i >> 2) + 4 * n + (i & 3); }
__device__ __forceinline__ unsigned cvt_pk_bf16(float lo, float hi) { return cvtpk_rne(lo, hi); }

struct Unit { int pm, pn; const char* A; const char* B; const int* gl; int gcnt; int e; int row0; };

struct DenseOrder {
    int nM, nN, nwg, G, c; const char* A; const char* Bt;
    __device__ __forceinline__ void init(int M, int N, int G_, int c_, const void* A_, const void* Bt_) { nM = M / BM; nN = N / BM; nwg = nM * nN; G = G_; c = c_; A = (const char*)A_; Bt = (const char*)Bt_; }
    __device__ __forceinline__ bool next(int i, Unit& u) const {
        const long L = (long)i * G + c; if (L >= nwg) return false;
        int wgid = (int)L; { const int q = nwg / NXCD, r = nwg % NXCD, xcd = wgid % NXCD, off = wgid / NXCD; wgid = (xcd < r ? xcd * (q + 1) : r * (q + 1) + (xcd - r) * q) + off; }
        const int nig = WGM * nN, gid = wgid / nig, fm = gid * WGM, gsz = (nM - fm) < WGM ? (nM - fm) : WGM;
        u.pm = fm + ((wgid % nig) % gsz); u.pn = (wgid % nig) / gsz;
        u.A = A + (size_t)u.pm * (BM * K * 2); u.B = Bt + (size_t)u.pn * (BM * K * 2); u.gl = nullptr; u.gcnt = BM; u.e = 0; u.row0 = u.pm * BM; return true;
    }
};
struct MoeOrder {
    const LAS int* tab; int G, c, NCT; const char* A; const char* W; size_t wstride; const int* list; const unsigned* cnt; bool gather;
    __device__ __forceinline__ bool next(int i, Unit& u) const {
        const int L = i * G + c; if (L >= tab[32]) return false;
        int e = 0;
#pragma unroll 1
        for (int j = 1; j < 32; ++j) if (L >= tab[j]) e = j;
        e = __builtin_amdgcn_readfirstlane(e);
        const int r = __builtin_amdgcn_readfirstlane(L - tab[e]), ce = __builtin_amdgcn_readfirstlane((int)cnt[e * 64]), rte = (ce + 255) >> 8, ro = __builtin_amdgcn_readfirstlane(tab[33 + e]);
        const int ct = r / rte, rt = r - ct * rte;
        u.pm = rt; u.pn = ct; u.e = e; u.row0 = ro + rt * 256; u.gl = list + (size_t)e * MALL + rt * 256; u.gcnt = min(256, ce - rt * 256);
        u.A = gather ? A : A + (size_t)u.row0 * (K * 2); u.B = W + (size_t)e * wstride + (size_t)ct * (BM * K * 2); return true;
    }
};
__device__ __forceinline__ void moe_tab_build(LAS int* tab, const unsigned* cnt, int NCT) {
    if (ltid() == 0) { int us = 0, rs = 0; for (int e = 0; e < 32; ++e) { tab[e] = us; tab[33 + e] = rs; const int rt = ((int)cnt[e * 64] + 255) >> 8; us += rt * NCT; rs += rt * 256; } tab[32] = us; tab[65] = rs; }
    __syncthreads();
}

struct EpiBf16 {
    static constexpr bool PERM = true; bf16_t* O; int ldc; const float* bias;
    __device__ __forceinline__ void operator()(const f32x4 (&acc)[2][2][4][2], const Unit& u, int wr, int wc, int fr, int fq) const {
        const int row0 = u.row0 + wr * 64 + fr, col0 = u.pn * BM + wc * 32 + 8 * fq;
        f32x4 bv[2][2];
#pragma unroll
        for (int bj = 0; bj < 2; ++bj)
#pragma unroll
            for (int n = 0; n < 2; ++n) bv[bj][n] = bias ? *(const f32x4*)(bias + col0 + bj * HALF + 4 * n) : (f32x4){0.f, 0.f, 0.f, 0.f};
#pragma unroll
        for (int ai = 0; ai < 2; ++ai)
#pragma unroll
            for (int m = 0; m < 4; ++m) { bf16_t* rowp = O + (size_t)(row0 + ai * HALF + m * 16) * ldc + col0;
#pragma unroll
                for (int bj = 0; bj < 2; ++bj) { const f32x4 v0 = acc[ai][bj][m][0] + bv[bj][0], v1 = acc[ai][bj][m][1] + bv[bj][1];
                    u32x4 w; w.x = cvt_pk_bf16(v0[0], v0[1]); w.y = cvt_pk_bf16(v0[2], v0[3]); w.z = cvt_pk_bf16(v1[0], v1[1]); w.w = cvt_pk_bf16(v1[2], v1[3]);
                    *(u32x4*)(rowp + bj * HALF) = w; } }
    }
};
struct EpiF32 {
    static constexpr bool PERM = false; float* O; int ldc;
    __device__ __forceinline__ void operator()(const f32x4 (&acc)[2][2][4][2], const Unit& u, int wr, int wc, int fr, int fq) const {
        const int row0 = u.row0 + wr * 64 + fr, col0 = u.pn * BM + wc * 32 + 4 * fq;
#pragma unroll
        for (int ai = 0; ai < 2; ++ai)
#pragma unroll
            for (int m = 0; m < 4; ++m) { float* rowp = O + (size_t)(row0 + ai * HALF + m * 16) * ldc + col0;
#pragma unroll
                for (int bj = 0; bj < 2; ++bj)
#pragma unroll
                    for (int n = 0; n < 2; ++n) *(f32x4*)(rowp + bj * HALF + n * 16) = acc[ai][bj][m][n]; }
    }
};
struct EpiMoeUp {
    static constexpr bool PERM = true; bf16_t* ACT; const float* b1all;
    __device__ __forceinline__ void operator()(const f32x4 (&acc)[2][2][4][2], const Unit& u, int wr, int wc, int fr, int fq) const {
        const int col0 = u.pn * BM + wc * 32 + 8 * fq; const float* b1 = b1all + (size_t)u.e * 2048;
        f32x4 bv[2][2];
#pragma unroll
        for (int bj = 0; bj < 2; ++bj)
#pragma unroll
            for (int n = 0; n < 2; ++n) bv[bj][n] = *(const f32x4*)(b1 + col0 + bj * HALF + 4 * n);
#pragma unroll
        for (int ai = 0; ai < 2; ++ai)
#pragma unroll
            for (int m = 0; m < 4; ++m) { bf16_t* rowp = ACT + (size_t)(u.row0 + wr * 64 + fr + ai * HALF + m * 16) * 1024 + (col0 >> 1);
#pragma unroll
                for (int bj = 0; bj < 2; ++bj) { const f32x4 v0 = acc[ai][bj][m][0] + bv[bj][0], v1 = acc[ai][bj][m][1] + bv[bj][1];
                    float a[4];
#pragma unroll
                    for (int j = 0; j < 4; ++j) { const float gl = fminf(j < 2 ? v0[2 * j] : v1[2 * j - 4], 7.f), ln = fminf(fmaxf(j < 2 ? v0[2 * j + 1] : v1[2 * j - 3], -7.f), 7.f);
                        a[j] = gl * __builtin_amdgcn_rcpf(1.f + __builtin_amdgcn_exp2f(-1.702f * 1.4426950408889634f * gl)) * (ln + 1.f); }
                    u32x2 w; w.x = cvt_pk_bf16(a[0], a[1]); w.y = cvt_pk_bf16(a[2], a[3]);
                    *(u32x2*)(rowp + bj * 64) = w; } }
    }
};
struct EpiMoeDown {
    static constexpr bool PERM = true; bf16_t* Y; const float* b2all; const float* topw;
    __device__ __forceinline__ void operator()(const f32x4 (&acc)[2][2][4][2], const Unit& u, int wr, int wc, int fr, int fq) const {
        const int col0 = u.pn * BM + wc * 32 + 8 * fq; const float* b2 = b2all + (size_t)u.e * 1024;
        f32x4 bv[2][2];
#pragma unroll
        for (int bj = 0; bj < 2; ++bj)
#pragma unroll
            for (int n = 0; n < 2; ++n) bv[bj][n] = *(const f32x4*)(b2 + col0 + bj * HALF + 4 * n);
#pragma unroll
        for (int ai = 0; ai < 2; ++ai)
#pragma unroll
            for (int m = 0; m < 4; ++m) { const int r = wr * 64 + fr + ai * HALF + m * 16; const float tw = r < u.gcnt ? topw[u.gl[r]] : 0.f;
                bf16_t* rowp = Y + (size_t)(u.row0 + r) * 1024 + col0;
#pragma unroll
                for (int bj = 0; bj < 2; ++bj) { const f32x4 v0 = (acc[ai][bj][m][0] + bv[bj][0]) * tw, v1 = (acc[ai][bj][m][1] + bv[bj][1]) * tw;
                    u32x4 w; w.x = cvt_pk_bf16(v0[0], v0[1]); w.y = cvt_pk_bf16(v0[2], v0[3]); w.z = cvt_pk_bf16(v1[0], v1[1]); w.w = cvt_pk_bf16(v1[2], v1[3]);
                    *(u32x4*)(rowp + bj * HALF) = w; } }
    }
};

template <class Epi, class Sched, bool GATHER, bool ALIGN_EPI>
__device__ __forceinline__ void gphase(LAS unsigned char* lds, const Sched& S, const Epi& E) {
    const int tid = ltid();
    const int wid = __builtin_amdgcn_readfirstlane(tid >> 6), lane = tid & 63, wr = wid >> 2, wc = wid & 3, fr = lane & 15, fq = lane >> 4;
    constexpr int nt = K / BK;
    unsigned voffB[2], CA2[2]; int RA[2];
#pragma unroll
    for (int i = 0; i < 2; ++i) { int R, C; stage_rc(tid * 16 + i * 8192, R, C); const int Rb = Epi::PERM ? ((R & ~31) + perm32(R & 31)) : R;
        RA[i] = R; CA2[i] = (unsigned)C * 2u; voffB[i] = (unsigned)(Rb * K + C) * 2u; }
    constexpr size_t kstep = (size_t)(BK * 2), hstep = (size_t)HALF * K * 2;
    const unsigned ldsw = (unsigned)wid * 1024u;
    const int aoff = lds_byte(wr * 64 + fr, fq * 8), boff = lds_byte(wc * 32 + fr, fq * 8);
#define PG8_SA(b, h) (((b) * 2 + (h)) * HTB)
#define PG8_SB(b, h) ((4 + (b) * 2 + (h)) * HTB)
#define PG8_GL(gp, ldsoff) __builtin_amdgcn_global_load_lds((const unsigned*)(gp), (LAS unsigned*)(lds + (ldsoff)), 16, 0, 0)
#define PG8_STB(bufoff, gbase) do { PG8_GL((const char*)(gbase) + voffB[0], (bufoff) + ldsw); PG8_GL((const char*)(gbase) + voffB[1], (bufoff) + ldsw + 8192); } while (0)
#define PG8_STA(bufoff, gbase, o) do { PG8_GL((const char*)(gbase) + (o)[0], (bufoff) + ldsw); PG8_GL((const char*)(gbase) + (o)[1], (bufoff) + ldsw + 8192); } while (0)
#define PG8_LDA(dst, b, h) do { _Pragma("unroll") for (int m = 0; m < 4; ++m) _Pragma("unroll") for (int k = 0; k < 2; ++k) dst[m][k] = *(const LAS bf16x8*)(lds + PG8_SA(b, h) + aoff + m * 2048 + k * 1024); } while (0)
#define PG8_LDB(dst, b, h) do { _Pragma("unroll") for (int n = 0; n < 2; ++n) _Pragma("unroll") for (int k = 0; k < 2; ++k) dst[n][k] = *(const LAS bf16x8*)(lds + PG8_SB(b, h) + boff + n * 2048 + k * 1024); } while (0)
#define PG8_MMA(ai, bj, At, Bt) do { __builtin_amdgcn_s_setprio(1); _Pragma("unroll") for (int m = 0; m < 4; ++m) _Pragma("unroll") for (int n = 0; n < 2; ++n) _Pragma("unroll") for (int k = 0; k < 2; ++k) \
        acc[ai][bj][m][n] = __builtin_amdgcn_mfma_f32_16x16x32_bf16(Bt[n][k], At[m][k], acc[ai][bj][m][n], 0, 0, 0); __builtin_amdgcn_s_setprio(0); } while (0)
#define PG8_WAIT_V(n) asm volatile("s_waitcnt vmcnt(" #n ")" ::: "memory")
#define PG8_WAIT_L(n) asm volatile("s_waitcnt lgkmcnt(" #n ")" ::: "memory")
#define PG8_BAR __builtin_amdgcn_s_barrier()
#define PG8_SCHED __builtin_amdgcn_sched_barrier(0)
#define PG8_AOFFS(u, o) do { _Pragma("unroll") for (int h_ = 0; h_ < 2; ++h_) _Pragma("unroll") for (int i_ = 0; i_ < 2; ++i_) { \
        if (GATHER) { const int r_ = h_ * 128 + RA[i_]; const int tok_ = r_ < (u).gcnt ? ((u).gl[r_] >> 2) : 0; o[h_][i_] = (unsigned)tok_ * (unsigned)(K * 2) + CA2[i_]; } \
        else o[h_][i_] = (unsigned)((h_ * 128 + RA[i_]) * (K * 2)) + CA2[i_]; } } while (0)
    Unit cur, nxt; int ui = 0;
    if (!S.next(0, cur)) return;
    f32x4 acc[2][2][4][2];
#pragma unroll
    for (int a = 0; a < 2; ++a)
#pragma unroll
        for (int b = 0; b < 2; ++b)
#pragma unroll
            for (int m = 0; m < 4; ++m)
#pragma unroll
                for (int n = 0; n < 2; ++n) acc[a][b][m][n] = (f32x4){0.f, 0.f, 0.f, 0.f};
    bf16x8 At[4][2], B0[2][2], B1[2][2];
    unsigned oAc[2][2], oAn[2][2];
    PG8_AOFFS(cur, oAc);
    const char* cA = cur.A; const char* cB = cur.B;
    PG8_STB(PG8_SB(0, 0), cB); PG8_STB(PG8_SB(0, 1), cB + hstep); PG8_STA(PG8_SA(0, 0), cA, oAc[0]); PG8_STA(PG8_SA(0, 1), cA, oAc[1]);
    if (wr == 1) PG8_BAR;
    PG8_WAIT_V(2); PG8_BAR;
    PG8_STB(PG8_SB(1, 0), cB + kstep); PG8_STA(PG8_SA(1, 0), cA + kstep, oAc[0]); PG8_STB(PG8_SB(1, 1), cB + hstep + kstep);
    PG8_WAIT_V(6); PG8_BAR;
    for (;;) {
        const bool has_next = S.next(ui + 1, nxt);
        const char* nA = has_next ? nxt.A : cA; const char* nB = has_next ? nxt.B : cB;
        if (has_next) { PG8_AOFFS(nxt, oAn); } else {
#pragma unroll
            for (int h = 0; h < 2; ++h) { oAn[h][0] = oAc[h][0]; oAn[h][1] = oAc[h][1]; } }
#pragma unroll 1
        for (int t = 0; t < nt; t += 2) {
            const bool last = (t == nt - 2);
            const char* a1 = cA + (size_t)(t + 1) * kstep;
            const char* a2 = last ? nA : cA + (size_t)(t + 2) * kstep; const char* b2 = last ? nB : cB + (size_t)(t + 2) * kstep;
            const char* a3 = a2 + kstep; const char* b3 = b2 + kstep;
            unsigned o2[2][2];
#pragma unroll
            for (int h = 0; h < 2; ++h) { o2[h][0] = last ? oAn[h][0] : oAc[h][0]; o2[h][1] = last ? oAn[h][1] : oAc[h][1]; }
            PG8_LDB(B0, 0, 0); PG8_LDB(B1, 0, 1); PG8_SCHED; PG8_LDA(At, 0, 0); PG8_STA(PG8_SA(1, 1), a1, oAc[1]);
            PG8_WAIT_V(8); PG8_WAIT_L(0); PG8_BAR; PG8_MMA(0, 0, At, B0); PG8_MMA(0, 1, At, B1); PG8_BAR; PG8_SCHED;
            PG8_LDA(At, 0, 1); PG8_STB(PG8_SB(0, 0), b2); PG8_STB(PG8_SB(0, 1), b2 + hstep); PG8_STA(PG8_SA(0, 0), a2, o2[0]);
            PG8_WAIT_V(8); PG8_WAIT_L(0); PG8_BAR; PG8_MMA(1, 0, At, B0); PG8_MMA(1, 1, At, B1); PG8_BAR; PG8_SCHED;
            PG8_LDB(B0, 1, 0); PG8_LDB(B1, 1, 1); PG8_SCHED; PG8_LDA(At, 1, 0); PG8_STA(PG8_SA(0, 1), a2, o2[1]);
            PG8_WAIT_V(8); PG8_WAIT_L(0); PG8_BAR; PG8_MMA(0, 0, At, B0); PG8_MMA(0, 1, At, B1); PG8_BAR; PG8_SCHED;
            PG8_LDA(At, 1, 1); PG8_STB(PG8_SB(1, 0), b3); PG8_STB(PG8_SB(1, 1), b3 + hstep); PG8_STA(PG8_SA(1, 0), a3, o2[0]);
            PG8_WAIT_V(8); PG8_WAIT_L(0); PG8_BAR; PG8_MMA(1, 0, At, B0); PG8_MMA(1, 1, At, B1); PG8_BAR; PG8_SCHED;
        }
        if constexpr (ALIGN_EPI) { if (wr == 0) PG8_BAR; }
        E(acc, cur, wr, wc, fr, fq);
        if (!has_next) break;
#pragma unroll
        for (int a = 0; a < 2; ++a)
#pragma unroll
            for (int b = 0; b < 2; ++b)
#pragma unroll
                for (int m = 0; m < 4; ++m)
#pragma unroll
                    for (int n = 0; n < 2; ++n) acc[a][b][m][n] = (f32x4){0.f, 0.f, 0.f, 0.f};
        cur = nxt; cA = nA; cB = nB; ++ui;
#pragma unroll
        for (int h = 0; h < 2; ++h) { oAc[h][0] = oAn[h][0]; oAc[h][1] = oAn[h][1]; }
        if constexpr (ALIGN_EPI) { if (wr == 1) PG8_BAR; }
    }
    PG8_WAIT_V(0);
    if constexpr (!ALIGN_EPI) { if (wr == 0) PG8_BAR; }
    PG8_BAR;
#undef PG8_SA
#undef PG8_SB
#undef PG8_GL
#undef PG8_STA
#undef PG8_STB
#undef PG8_LDA
#undef PG8_LDB
#undef PG8_MMA
#undef PG8_WAIT_V
#undef PG8_WAIT_L
#undef PG8_BAR
#undef PG8_SCHED
#undef PG8_AOFFS
}
}

__device__ __forceinline__ unsigned pk2(float lo, float hi) { return (unsigned)f2bf(lo) | ((unsigned)f2bf(hi) << 16); }
__device__ __forceinline__ void transpose_item(const float* W, int ld, int nblk, bf16_t* WT, LAS float* scr, int item, int lane) {
    const int kb = item / nblk, nb = item - kb * nblk, k0 = 64 * kb, n0 = 32 * nb;
#pragma unroll 8
    for (int i = 0; i < 32; ++i) { const int kk = 2 * i + (lane >> 5); scr[kk * 33 + (lane & 31)] = W[(size_t)(k0 + kk) * ld + n0 + (lane & 31)]; }
    asm volatile("s_waitcnt lgkmcnt(0)" ::: "memory");
    const int c = lane & 7;
#pragma unroll
    for (int j = 0; j < 4; ++j) { const int n = (lane >> 3) + 8 * j; const LAS float* s = scr + (8 * c) * 33 + n;
        pg8::u32x4 o; o.x = pk2(s[0 * 33], s[1 * 33]); o.y = pk2(s[2 * 33], s[3 * 33]); o.z = pk2(s[4 * 33], s[5 * 33]); o.w = pk2(s[6 * 33], s[7 * 33]);
        *(pg8::u32x4*)(WT + (size_t)(n0 + n) * 1024 + k0 + 8 * c) = o; }
    asm volatile("s_waitcnt lgkmcnt(0)" ::: "memory");
}
__device__ __forceinline__ void d_convert_a(KP kp, LAS float* scr_all) {
    PH_IDS;
    const int lane = tid & 63; LAS float* scr = scr_all + (tid >> 6) * (64 * 33);
    constexpr int I_IN = 16 * 104, I_OUT = 16 * 32, I_W1 = 16 * 64, I_W2 = 16 * 32, I_L = I_IN + I_OUT + 32 * I_W1 + 32 * I_W2;
    GW_LOOP(it, 2 * I_L) {
        const int l = it / I_L; int r = it - l * I_L;
        if (r < I_IN) { transpose_item(p.w_in + (size_t)l * D * INW, INW, 104, WSP(bf16_t, WS_WIN_T) + (size_t)l * PW * 1024, scr, r, lane); continue; } r -= I_IN;
        if (r < I_OUT) { transpose_item(p.w_out + (size_t)l * D * D, 1024, 32, WSP(bf16_t, WS_WOUT_T) + (size_t)l * 1024 * 1024, scr, r, lane); continue; } r -= I_OUT;
        if (r < 32 * I_W1) { const int e = r / I_W1; transpose_item(p.exp_w1 + ((size_t)l * NEXP + e) * D * 2048, 2048, 64, WSP(bf16_t, WS_W1_T) + ((size_t)l * NEXP + e) * 2048 * 1024, scr, r - e * I_W1, lane); continue; } r -= 32 * I_W1;
        { const int e = r / I_W2; transpose_item(p.exp_w2 + ((size_t)l * NEXP + e) * D * D, 1024, 32, WSP(bf16_t, WS_W2_T) + ((size_t)l * NEXP + e) * 1024 * 1024, scr, r - e * I_W2, lane); }
    }
    GT_LOOP(idx, 2 * PW) { const int l = idx / PW, n = idx - l * PW; WSP(float, WS_BIAS_IN)[idx] = n < 3328 ? 0.f : p.gla_gate_b[l * 256 + n - 3328]; }
}
__device__ __forceinline__ void d_convert_b(KP kp, LAS float* scr_all) {
    PH_IDS;
    const int lane = tid & 63; LAS float* scr = scr_all + (tid >> 6) * (64 * 33);
    GW_LOOP(it, 2 * 128) { const int l = it >> 7; transpose_item(WSP(float, WS_WEFF) + (size_t)l * D * 256, 256, 8, WSP(bf16_t, WS_WIN_T) + ((size_t)l * PW + 3328) * 1024, scr, it & 127, lane); }
}

__device__ __forceinline__ void d_gemm_in(KP kp, int l, LAS unsigned char* lds) {
    PH_IDS;
    pg8::DenseOrder S; S.init(MALL, PW, gridDim.x, bid, WSP(bf16_t, WS_HB), WSP(bf16_t, WS_WIN_T) + (size_t)l * PW * 1024);
    pg8::EpiBf16 E{WSP(bf16_t, WS_PBUF), PW, WSP(float, WS_BIAS_IN) + l * PW};
    pg8::gphase<pg8::EpiBf16, pg8::DenseOrder, false, true>(lds, S, E);
}
__device__ __forceinline__ void d_gemm_out(KP kp, int l, LAS unsigned char* lds) {
    PH_IDS;
    pg8::DenseOrder S; S.init(nrows_l(l), 1024, gridDim.x, bid, WSP(bf16_t, WS_CONCAT), WSP(bf16_t, WS_WOUT_T) + (size_t)l * 1024 * 1024);
    pg8::EpiF32 E{WSP(float, WS_YBUF), 1024};
    pg8::gphase<pg8::EpiF32, pg8::DenseOrder, false, true>(lds, S, E);
}
__device__ __forceinline__ void d_moe_up(KP kp, int l, LAS unsigned char* lds) {
    PH_IDS;
    LAS int* tab = (LAS int*)(lds + pg8::STAGE_BYTES);
    const unsigned* cnt = WSP(unsigned, WS_CTL) + CW_CNT + l * 32 * 64;
    pg8::moe_tab_build(tab, cnt, 8);
    pg8::MoeOrder S{tab, (int)gridDim.x, bid, 8, (const char*)WSP(bf16_t, WS_HB), (const char*)(WSP(bf16_t, WS_W1_T) + (size_t)l * NEXP * 2048 * 1024), (size_t)2048 * 1024 * 2, WSP(int, WS_LIST), cnt, true};
    pg8::EpiMoeUp E{WSP(bf16_t, WS_ACT), p.exp_b1 + (size_t)l * NEXP * 2048};
    pg8::gphase<pg8::EpiMoeUp, pg8::MoeOrder, true, true>(lds, S, E);
}
__device__ __forceinline__ void d_moe_down(KP kp, int l, LAS unsigned char* lds) {
    PH_IDS;
    LAS int* tab = (LAS int*)(lds + pg8::STAGE_BYTES);
    const unsigned* cnt = WSP(unsigned, WS_CTL) + CW_CNT + l * 32 * 64;
    pg8::moe_tab_build(tab, cnt, 4);
    pg8::MoeOrder S{tab, (int)gridDim.x, bid, 4, (const char*)WSP(bf16_t, WS_ACT), (const char*)(WSP(bf16_t, WS_W2_T) + (size_t)l * NEXP * 1024 * 1024), (size_t)1024 * 1024 * 2, WSP(int, WS_LIST), cnt, false};
    pg8::EpiMoeDown E{WSP(bf16_t, WS_YSLOT), p.exp_b2 + (size_t)l * NEXP * 1024, WSP(float, WS_TOPW)};
    pg8::gphase<pg8::EpiMoeDown, pg8::MoeOrder, false, true>(lds, S, E);
}

constexpr int ATT_NT = 68;
constexpr float ATT_QSCALE = 0.17677669529663687f * 1.4426950408889634f;
__device__ __forceinline__ void d_prep_attn(KP kp) {
    PH_IDS;
    const bf16_t* PB = WSP(bf16_t, WS_PBUF);
    GT_LOOP(idx, MALL * 16) {
        const int row = idx >> 4, hm = (idx >> 1) & 7, ks = idx & 1, h = hm >> 1, m = hm & 1;
        const bool lat = row < NLAT; const int t = row & (SEQ - 1);
        const int ipos = ks == 0 ? (t >> 6) : (t & 63);
        const int cb = h * 64 + m * 32 + ks * 16;
        const pg8::u32x4* qs = (const pg8::u32x4*)(PB + (size_t)row * PW + PC_AQ + cb);
        const pg8::u32x4* ksrc = (const pg8::u32x4*)(PB + (size_t)row * PW + PC_AK + cb);
        pg8::u32x4 qa = qs[0], qb = qs[1], ka = ksrc[0], kb = ksrc[1];
        float qv[16], kv[16];
#pragma unroll
        for (int j = 0; j < 4; ++j) { qv[2 * j] = bf2f((bf16_t)(qa[j] & 0xffff)); qv[2 * j + 1] = bf2f((bf16_t)(qa[j] >> 16)); qv[8 + 2 * j] = bf2f((bf16_t)(qb[j] & 0xffff)); qv[9 + 2 * j] = bf2f((bf16_t)(qb[j] >> 16));
                                      kv[2 * j] = bf2f((bf16_t)(ka[j] & 0xffff)); kv[2 * j + 1] = bf2f((bf16_t)(ka[j] >> 16)); kv[8 + 2 * j] = bf2f((bf16_t)(kb[j] & 0xffff)); kv[9 + 2 * j] = bf2f((bf16_t)(kb[j] >> 16)); }
        float qo[16], ko[16];
#pragma unroll
        for (int j = 0; j < 8; ++j) {
            float cs = 1.f, sn = 0.f;
            if (lat) { const float* tb = WSP(float, WS_ROPE) + (ipos * 8 + j) * 2; cs = tb[0]; sn = tb[1]; }
            qo[j] = qv[j] * cs - qv[j + 8] * sn; qo[j + 8] = qv[j + 8] * cs + qv[j] * sn;
            ko[j] = kv[j] * cs - kv[j + 8] * sn; ko[j + 8] = kv[j + 8] * cs + kv[j] * sn;
        }
        pg8::u32x4 o0, o1;
#pragma unroll
        for (int j = 0; j < 4; ++j) { o0[j] = pk2(qo[2 * j] * ATT_QSCALE, qo[2 * j + 1] * ATT_QSCALE); o1[j] = pk2(qo[8 + 2 * j] * ATT_QSCALE, qo[9 + 2 * j] * ATT_QSCALE); }
        pg8::u32x4* qd = (pg8::u32x4*)(WSP(bf16_t, WS_QRP) + (size_t)row * 256 + cb); qd[0] = o0; qd[1] = o1;
#pragma unroll
        for (int j = 0; j < 4; ++j) { o0[j] = pk2(ko[2 * j], ko[2 * j + 1]); o1[j] = pk2(ko[8 + 2 * j], ko[9 + 2 * j]); }
        int b, tile, key; if (lat) { b = row >> 12; tile = t >> 6; key = t & 63; } else { const int r = row - NLAT; b = r >> 8; tile = 64 + ((r & 255) >> 6); key = r & 63; }
        unsigned char* img = WSP(unsigned char, WS_KIMG) + ((size_t)(b * 4 + h) * ATT_NT + tile) * 8192 + key * 128;
        const int c0 = m * 4 + ks * 2, sw = (key >> 1) & 7;
        *(pg8::u32x4*)(img + 16 * (c0 ^ sw)) = o0; *(pg8::u32x4*)(img + 16 * ((c0 + 1) ^ sw)) = o1;
    }
    GT_LOOP(idx, 16 * ATT_NT * 16 * 64) {
        const int d = idx & 63, kc = (idx >> 6) & 15, tile = (idx >> 10) % ATT_NT, bh = idx / (1024 * ATT_NT), b = bh >> 2, h = bh & 3;
        const int row0 = tile < 64 ? b * SEQ + tile * 64 + kc * 4 : NLAT + b * CTXL + (tile - 64) * 64 + kc * 4;
        const bf16_t* vp = PB + (size_t)row0 * PW + PC_AV + h * 64 + d;
        const unsigned w0 = (unsigned)vp[0] | ((unsigned)vp[PW] << 16), w1 = (unsigned)vp[2 * PW] | ((unsigned)vp[3 * PW] << 16);
        unsigned char* img = WSP(unsigned char, WS_VIMG) + ((size_t)bh * ATT_NT + tile) * 8192 + d * 128 + 8 * (kc ^ ((d >> 1) & 15));
        *(pg8::u32x2*)img = (pg8::u32x2){w0, w1};
    }
}

namespace att {
typedef short bf16x8 __attribute__((ext_vector_type(8)));
typedef float f32x16 __attribute__((ext_vector_type(16)));
typedef unsigned u32x4 __attribute__((ext_vector_type(4)));
typedef unsigned u32x2 __attribute__((ext_vector_type(2)));
constexpr int SLOT = 8192, LDS_K = 0, LDS_V = 3 * SLOT, LDS_SCR = 6 * SLOT;
constexpr float THR = 8.f;
__device__ __forceinline__ int crow(int r, int hi) { return (r & 3) + 8 * (r >> 2) + 4 * hi; }
__device__ __forceinline__ unsigned cvtpk(float lo, float hi) { return cvtpk_rne(lo, hi); }
__device__ __forceinline__ float xhalf_max(float v) { return fmaxf(v, __shfl_xor(v, 32)); }
}
__device__ __forceinline__ void attn_unit(KP kp, int l, int b, int h, int qt, LAS unsigned char* lds, float lam, float lam_init, int tid) {
    using namespace att;
    const int lane = tid & 63, wid = __builtin_amdgcn_readfirstlane(tid >> 6), q32 = lane & 31, hi = lane >> 5;
    const int t0 = qt < 0 ? 64 : 0, t1 = ATT_NT;
    const int rowbase = (qt < 0 ? NLAT + b * CTXL : b * SEQ + qt * 256) + wid * 32;
    const unsigned char* kimg = WSP(unsigned char, WS_KIMG) + (size_t)(b * 4 + h) * ATT_NT * 8192 + wid * 1024 + lane * 16;
    const unsigned char* vimg = WSP(unsigned char, WS_VIMG) + (size_t)(b * 4 + h) * ATT_NT * 8192 + wid * 1024 + lane * 16;
    LAS float* scr = (LAS float*)(lds + LDS_SCR) + wid * 64;
#define ATT_DMA(t, slot) do { __builtin_amdgcn_global_load_lds((const unsigned*)(kimg + (size_t)(t) * 8192), (LAS unsigned*)(lds + LDS_K + (slot) * SLOT + wid * 1024), 16, 0, 0); \
                              __builtin_amdgcn_global_load_lds((const unsigned*)(vimg + (size_t)(t) * 8192), (LAS unsigned*)(lds + LDS_V + (slot) * SLOT + wid * 1024), 16, 0, 0); } while (0)
    bf16x8 qf[2][2];
    { const bf16_t* qp = WSP(bf16_t, WS_QRP) + (size_t)(rowbase + q32) * 256 + h * 64 + hi * 8;
#pragma unroll
      for (int m = 0; m < 2; ++m)
#pragma unroll
        for (int ks = 0; ks < 2; ++ks) qf[m][ks] = *(const bf16x8*)(qp + m * 32 + ks * 16); }
    asm volatile("s_waitcnt vmcnt(0)" ::: "memory");
    __builtin_amdgcn_s_barrier();
    ATT_DMA(t0, 0); ATT_DMA(t0 + 1, 1);
    f32x16 O[2][2];
#pragma unroll
    for (int m = 0; m < 2; ++m)
#pragma unroll
        for (int dh = 0; dh < 2; ++dh)
#pragma unroll
            for (int r = 0; r < 16; ++r) O[m][dh][r] = 0.f;
    float mref[2] = {0.f, 0.f}, lsum[2] = {0.f, 0.f};
    const int koff = q32 * 128, ksw = (q32 >> 1) & 7;
    int slot = 0;
#pragma unroll 1
    for (int t = t0; t < t1; ++t) {
        if (t + 1 < t1) asm volatile("s_waitcnt vmcnt(2)" ::: "memory"); else asm volatile("s_waitcnt vmcnt(0)" ::: "memory");
        __builtin_amdgcn_s_barrier();
        asm volatile("" ::: "memory");
        if (t + 2 < t1) { const int s2 = slot == 0 ? 2 : slot - 1; ATT_DMA(t + 2, s2); }
        const LAS unsigned char* Ks = lds + LDS_K + slot * SLOT; const LAS unsigned char* Vs = lds + LDS_V + slot * SLOT;
        u32x4 ppk[2][2][2];
#pragma unroll
        for (int m = 0; m < 2; ++m) {
            f32x16 S[2];
            { const float nm = -mref[m];
#pragma unroll
              for (int r = 0; r < 16; ++r) { S[0][r] = nm; S[1][r] = nm; } }
#pragma unroll
            for (int kh = 0; kh < 2; ++kh)
#pragma unroll
                for (int ks = 0; ks < 2; ++ks) {
                    const bf16x8 kf = *(const LAS bf16x8*)(Ks + kh * 4096 + koff + 16 * ((m * 4 + ks * 2 + hi) ^ ksw));
                    S[kh] = __builtin_amdgcn_mfma_f32_32x32x16_bf16(kf, qf[m][ks], S[kh], 0, 0, 0);
                }
            float mx = fmaxf(S[0][0], S[1][0]);
#pragma unroll
            for (int r = 1; r < 16; ++r) mx = fmaxf(mx, fmaxf(S[0][r], S[1][r]));
            mx = xhalf_max(mx);
            const bool first = (t == t0);
            if (__any(first || mx > THR)) {
                const float dl = first ? mx : fmaxf(mx, 0.f);
                mref[m] += dl;
#pragma unroll
                for (int r = 0; r < 16; ++r) { S[0][r] -= dl; S[1][r] -= dl; }
                const float f = __builtin_amdgcn_exp2f(-dl);
                lsum[m] *= f;
                if (!first) {
                    if (hi == 0) scr[q32] = f;
                    asm volatile("s_waitcnt lgkmcnt(0)" ::: "memory");
#pragma unroll
                    for (int r = 0; r < 16; ++r) { const float fr = scr[crow(r, hi)]; O[m][0][r] *= fr; O[m][1][r] *= fr; }
                    asm volatile("s_waitcnt lgkmcnt(0)" ::: "memory");
                }
            }
            float ls = 0.f;
#pragma unroll
            for (int kh = 0; kh < 2; ++kh) {
#pragma unroll
                for (int r = 0; r < 16; ++r) { S[kh][r] = __builtin_amdgcn_exp2f(S[kh][r]); ls += S[kh][r]; }
#pragma unroll
                for (int s = 0; s < 2; ++s)
#pragma unroll
                    for (int j = 0; j < 4; ++j) ppk[m][kh][s][j] = cvtpk(S[kh][8 * s + 2 * j], S[kh][8 * s + 2 * j + 1]);
            }
            lsum[m] += ls;
        }
#pragma unroll
        for (int kh = 0; kh < 2; ++kh)
#pragma unroll
            for (int s = 0; s < 2; ++s)
#pragma unroll
                for (int dh = 0; dh < 2; ++dh) {
                    const int d = dh * 32 + q32, kc = 8 * kh + 4 * s + hi, vsw = (d >> 1) & 15;
                    const u32x2 v0 = *(const LAS u32x2*)(Vs + d * 128 + 8 * (kc ^ vsw)), v1 = *(const LAS u32x2*)(Vs + d * 128 + 8 * ((kc + 2) ^ vsw));
                    const u32x4 vv = (u32x4){v0.x, v0.y, v1.x, v1.y};
                    const bf16x8 vf = __builtin_bit_cast(bf16x8, vv);
#pragma unroll
                    for (int m = 0; m < 2; ++m) O[m][dh] = __builtin_amdgcn_mfma_f32_32x32x16_bf16(__builtin_bit_cast(bf16x8, ppk[m][kh][s]), vf, O[m][dh], 0, 0, 0);
                }
        asm volatile("s_waitcnt lgkmcnt(0)" ::: "memory");
        slot = slot == 2 ? 0 : slot + 1;
    }
#undef ATT_DMA
    float il[2][16];
#pragma unroll
    for (int m = 0; m < 2; ++m) { const float lt = lsum[m] + __shfl_xor(lsum[m], 32); if (hi == 0) scr[m * 32 + q32] = 1.f / lt; }
    asm volatile("s_waitcnt lgkmcnt(0)" ::: "memory");
#pragma unroll
    for (int m = 0; m < 2; ++m)
#pragma unroll
        for (int r = 0; r < 16; ++r) il[m][r] = scr[m * 32 + crow(r, hi)];
    asm volatile("s_waitcnt lgkmcnt(0)" ::: "memory");
    const float g0 = p.diff_subln_g[l * 64 + q32] * (1.f - lam_init), g1 = p.diff_subln_g[l * 64 + 32 + q32] * (1.f - lam_init);
    bf16_t* outp = WSP(bf16_t, WS_CONCAT) + (size_t)rowbase * D + h * 64 + q32;
#pragma unroll
    for (int r = 0; r < 16; ++r) {
        const float o0 = O[0][0][r] * il[0][r] - lam * O[1][0][r] * il[1][r], o1 = O[0][1][r] * il[0][r] - lam * O[1][1][r] * il[1][r];
        float ss = o0 * o0 + o1 * o1;
#pragma unroll
        for (int x = 1; x < 32; x <<= 1) ss += __shfl_xor(ss, x);
        const float rstd = rsqrtf(ss * (1.f / 64.f) + EPS);
        bf16_t* op = outp + (size_t)crow(r, hi) * D;
        op[0] = f2bf(o0 * rstd * g0); op[32] = f2bf(o1 * rstd * g1);
    }
}
__device__ __forceinline__ void d_attn_fast(KP kp, int l, LAS unsigned char* lds) {
    PH_IDS;
    const float* dl = p.diff_lambda + l * 4 * 32;
    float s1 = 0.f, s2 = 0.f;
    for (int i = 0; i < 32; ++i) { s1 += dl[i] * dl[32 + i]; s2 += dl[64 + i] * dl[96 + i]; }
    const float lam_init = 0.8f - 0.6f * expf(-0.3f * (float)l);
    const float lam = expf(s1) - expf(s2) + lam_init;
    const int G = gridDim.x, vb = (G % 8 == 0) ? (bid % 8) * (G / 8) + bid / 8 : bid;
    const int nunits = 256 + (l == 0 ? 16 : 0);
    for (int u = vb; u < nunits; u += G) {
        if (u < 256) attn_unit(kp, l, u >> 6, (u >> 4) & 3, u & 15, lds, lam, lam_init, tid);
        else attn_unit(kp, l, (u - 256) >> 2, (u - 256) & 3, -1, lds, lam, lam_init, tid);
    }
    __syncthreads();
}

constexpr int NCHUNK = MALL / 64;
__device__ __forceinline__ float logsig16(float x) { return (fminf(x, 0.f) - log1pf(expf(-fabsf(x)))) * (1.f / 16.f); }
__device__ __forceinline__ void d_prep_scan(KP kp) {
    PH_IDS;
    const bf16_t* PB = WSP(bf16_t, WS_PBUF);
    GT_LOOP(idx, 8 * MALL) {
        const int row = idx % MALL, hk = idx / MALL, h = hk >> 1, ks = hk & 1;
        const bool lat = row < NLAT; const int t = row & (SEQ - 1);
        const int ipos = ks == 0 ? (t >> 6) : (t & 63);
        const int cb = h * 64 + ks * 32;
        const pg8::u32x4* qs = (const pg8::u32x4*)(PB + (size_t)row * PW + PC_RQ + cb);
        const pg8::u32x4* ksrc = (const pg8::u32x4*)(PB + (size_t)row * PW + PC_RK + cb);
        float qv[32], kv[32];
#pragma unroll
        for (int c4 = 0; c4 < 4; ++c4) { const pg8::u32x4 a = qs[c4], b4 = ksrc[c4];
#pragma unroll
            for (int j = 0; j < 4; ++j) { qv[c4 * 8 + 2 * j] = bf2f((bf16_t)(a[j] & 0xffff)); qv[c4 * 8 + 2 * j + 1] = bf2f((bf16_t)(a[j] >> 16)); kv[c4 * 8 + 2 * j] = bf2f((bf16_t)(b4[j] & 0xffff)); kv[c4 * 8 + 2 * j + 1] = bf2f((bf16_t)(b4[j] >> 16)); } }
        float qo[32], ko[32];
#pragma unroll
        for (int j = 0; j < 16; ++j) {
            float cs = 1.f, sn = 0.f;
            if (lat) { const float* tb = WSP(float, WS_ROPE) + 1024 + (ipos * 16 + j) * 2; cs = tb[0]; sn = tb[1]; }
            qo[j] = qv[j] * cs - qv[j + 16] * sn; qo[j + 16] = qv[j + 16] * cs + qv[j] * sn;
            ko[j] = (kv[j] * cs - kv[j + 16] * sn) * 0.125f; ko[j + 16] = (kv[j + 16] * cs + kv[j] * sn) * 0.125f;
        }
        pg8::u32x4* qd = (pg8::u32x4*)(WSP(bf16_t, WS_QF_R) + (size_t)row * 256 + cb); pg8::u32x4* kd = (pg8::u32x4*)(WSP(bf16_t, WS_KF_R) + (size_t)row * 256 + cb);
#pragma unroll
        for (int c4 = 0; c4 < 4; ++c4) { pg8::u32x4 a, b4;
#pragma unroll
            for (int j = 0; j < 4; ++j) { a[j] = pk2(qo[c4 * 8 + 2 * j], qo[c4 * 8 + 2 * j + 1]); b4[j] = pk2(ko[c4 * 8 + 2 * j], ko[c4 * 8 + 2 * j + 1]); }
            qd[c4] = a; kd[c4] = b4; }
        bf16_t* kt = WSP(bf16_t, WS_KT_R) + ((size_t)((row >> 6) * 4 + h) * 64 + ks * 32) * 64 + (row & 63);
#pragma unroll
        for (int i = 0; i < 32; ++i) kt[(size_t)i * 64] = f2bf(ko[i]);
    }
    GT_LOOP(idx, 4 * MALL) {
        const int row = idx % MALL, h = idx / MALL;
        const pg8::u32x4* ksrc = (const pg8::u32x4*)(PB + (size_t)row * PW + PC_GK + h * 32);
        bf16_t* kt = WSP(bf16_t, WS_KT_G) + ((size_t)((row >> 6) * 4 + h) * 32) * 64 + (row & 63);
#pragma unroll
        for (int c4 = 0; c4 < 4; ++c4) { const pg8::u32x4 a = ksrc[c4];
#pragma unroll
            for (int j = 0; j < 4; ++j) { kt[(size_t)(c4 * 8 + 2 * j) * 64] = (bf16_t)(a[j] & 0xffff); kt[(size_t)(c4 * 8 + 2 * j + 1) * 64] = (bf16_t)(a[j] >> 16); } }
    }
    GT_LOOP(idx, NCHUNK * 2 * 128) {
        const int hk = idx & 127, dir = (idx >> 7) & 1, cid = idx >> 8;
        const bf16_t* src = PB + (size_t)(cid * 64) * PW + PC_GD + dir * 128 + hk;
        float* cum = WSP(float, WS_CUM_G) + ((size_t)dir * MALL + cid * 64) * 128 + hk;
        float* cumt = WSP(float, WS_CUMT_G) + (((size_t)dir * NCHUNK + cid) * 128 + hk) * 64;
        float c = 0.f;
#pragma unroll 1
        for (int g4 = 0; g4 < 16; ++g4) {
            const int j0 = dir == 0 ? 4 * g4 : 60 - 4 * g4;
            float v[4];
#pragma unroll
            for (int u = 0; u < 4; ++u) { const int j = dir == 0 ? j0 + u : j0 + 3 - u; c += logsig16(bf2f(src[(size_t)j * PW])); v[dir == 0 ? u : 3 - u] = c; cum[(size_t)j * 128] = c; }
            *(pg8::f32x4*)(cumt + j0) = (pg8::f32x4){v[0], v[1], v[2], v[3]};
        }
    }
    GT_LOOP(idx, 2 * NCHUNK * 4 * 16 * 64) {
        const int d = idx & 63, kc = (idx >> 6) & 15, ch = (idx >> 10) % (NCHUNK * 4), mx = idx / (1024 * NCHUNK * 4), h = ch & 3, cid = ch >> 2;
        const bf16_t* vp = PB + (size_t)(cid * 64 + kc * 4) * PW + (mx == 0 ? PC_RV : PC_GV) + h * 64 + d;
        const unsigned w0 = (unsigned)vp[0] | ((unsigned)vp[PW] << 16), w1 = (unsigned)vp[2 * PW] | ((unsigned)vp[3 * PW] << 16);
        unsigned char* img = WSP(unsigned char, mx == 0 ? WS_VT_R : WS_VT_G) + (size_t)ch * 8192 + d * 128 + 8 * (kc ^ ((d >> 1) & 15));
        *(pg8::u32x2*)img = (pg8::u32x2){w0, w1};
    }
}

namespace scn {
typedef short bf16x8 __attribute__((ext_vector_type(8)));
typedef float f32x16 __attribute__((ext_vector_type(16)));
typedef float f32x4 __attribute__((ext_vector_type(4)));
typedef unsigned u32x4 __attribute__((ext_vector_type(4)));
typedef unsigned u32x2 __attribute__((ext_vector_type(2)));
__device__ __forceinline__ int crow(int r, int hi) { return (r & 3) + 8 * (r >> 2) + 4 * hi; }
__device__ __forceinline__ unsigned cvtpk(float lo, float hi) { return cvtpk_rne(lo, hi); }
__device__ __forceinline__ float blo(unsigned w) { return __uint_as_float(w << 16); }
__device__ __forceinline__ float bhi(unsigned w) { return __uint_as_float(w & 0xffff0000u); }
__device__ __forceinline__ bf16x8 scale8(u32x4 raw, const float (&f)[8]) {
    u32x4 o;
#pragma unroll
    for (int j = 0; j < 4; ++j) o[j] = cvtpk(blo(raw[j]) * f[2 * j], bhi(raw[j]) * f[2 * j + 1]);
    return __builtin_bit_cast(bf16x8, o);
}
template <int MX> struct Cfg;
template <> struct Cfg<0> { static constexpr int DK = 64; };
template <> struct Cfg<1> { static constexpr int DK = 32; };
}
#define SCN_EXP(x) __builtin_amdgcn_exp2f((x) * 1.4426950408889634f)
template <int MX> __device__ __forceinline__ void scan_stage1_unit(KP kp, int l, int b, int h, int g, int tid) {
    using namespace scn;
    constexpr int DK = Cfg<MX>::DK, NKT = DK / 32, NE = DK * 64 / NT;
    const int lane = tid & 63, wid = __builtin_amdgcn_readfirstlane(tid >> 6), q32 = lane & 31, hi = lane >> 5;
    const int nch = g == 8 ? 4 : 8, cid0 = g == 8 ? 256 + 4 * b : b * 64 + 8 * g;
    float* US = WSP(float, MX == 0 ? WS_US_R : WS_US_G);
    const float* CUMT = WSP(float, WS_CUMT_G);
    if (wid < nch) {
        const int cid = cid0 + wid;
        const unsigned char* vimg = WSP(unsigned char, MX == 0 ? WS_VT_R : WS_VT_G) + (size_t)(cid * 4 + h) * 8192;
        const bf16_t* ktimg = WSP(bf16_t, MX == 0 ? WS_KT_R : WS_KT_G) + (size_t)(cid * 4 + h) * DK * 64;
        bf16x8 vb[2][4];
#pragma unroll
        for (int dh = 0; dh < 2; ++dh)
#pragma unroll
            for (int s = 0; s < 4; ++s) { const int d = dh * 32 + q32, x = (d >> 1) & 15, kc = 4 * s + 2 * hi;
                u32x4 v = *(const u32x4*)(vimg + d * 128 + 16 * ((kc ^ x) >> 1));
                if (x & 1) v = (u32x4){v.z, v.w, v.x, v.y};
                vb[dh][s] = __builtin_bit_cast(bf16x8, v); }
#pragma unroll 1
        for (int dir = 0; dir < 2; ++dir) {
            float lg = 0.f; if (MX == 0) lg = -expf(p.ret_decay[(l * 2 + dir) * 4 + h]);
#pragma unroll 1
            for (int kt = 0; kt < NKT; ++kt) {
                f32x16 U[2];
#pragma unroll
                for (int dh = 0; dh < 2; ++dh)
#pragma unroll
                    for (int r = 0; r < 16; ++r) U[dh][r] = 0.f;
                const int k = kt * 32 + q32;
                const float* ct = CUMT + (((size_t)dir * NCHUNK + cid) * 128 + h * 32 + (k & 31)) * 64;
                float E = 0.f; if (MX == 1) E = ct[dir == 0 ? 63 : 0];
#pragma unroll
                for (int s = 0; s < 4; ++s) {
                    const int j0 = 16 * s + 8 * hi;
                    const u32x4 raw = *(const u32x4*)(ktimg + (size_t)k * 64 + j0);
                    float f[8];
                    if (MX == 0) {
#pragma unroll
                        for (int jj = 0; jj < 8; ++jj) f[jj] = SCN_EXP(lg * (float)(dir == 0 ? 63 - (j0 + jj) : j0 + jj));
                    } else {
                        const f32x4 c0 = *(const f32x4*)(ct + j0), c1 = *(const f32x4*)(ct + j0 + 4);
#pragma unroll
                        for (int jj = 0; jj < 4; ++jj) { f[jj] = SCN_EXP(E - c0[jj]); f[4 + jj] = SCN_EXP(E - c1[jj]); }
                    }
                    const bf16x8 af = scale8(raw, f);
#pragma unroll
                    for (int dh = 0; dh < 2; ++dh) U[dh] = __builtin_amdgcn_mfma_f32_32x32x16_bf16(af, vb[dh][s], U[dh], 0, 0, 0);
                }
                float* up = US + ((((size_t)dir * NCHUNK + cid) * 4 + h) * DK + kt * 32 + 4 * hi) * 64 + q32;
#pragma unroll
                for (int dh = 0; dh < 2; ++dh)
#pragma unroll
                    for (int r = 0; r < 16; ++r) up[((r & 3) + 8 * (r >> 2)) * 64 + dh * 32] = U[dh][r];
            }
        }
    }
    asm volatile("s_waitcnt vmcnt(0)" ::: "memory");
    __syncthreads();
    const int k = (tid * NE) >> 6, d0 = (tid * NE) & 63;
#pragma unroll
    for (int dir = 0; dir < 2; ++dir) {
        float S[NE], Ap = 1.f;
#pragma unroll
        for (int e = 0; e < NE; ++e) S[e] = 0.f;
        float lg = 0.f; if (MX == 0) lg = -expf(p.ret_decay[(l * 2 + dir) * 4 + h]);
        for (int cc = 0; cc < nch; ++cc) {
            const int c = dir == 0 ? cc : nch - 1 - cc, cid = cid0 + c;
            float A;
            if (MX == 0) A = SCN_EXP(lg * 64.f); else A = SCN_EXP(CUMT[(((size_t)dir * NCHUNK + cid) * 128 + h * 32 + k) * 64 + (dir == 0 ? 63 : 0)]);
            const float* up = US + ((((size_t)dir * NCHUNK + cid) * 4 + h) * DK + k) * 64 + d0;
#pragma unroll
            for (int e = 0; e < NE; ++e) S[e] = A * S[e] + up[e];
            Ap *= A;
        }
        float* ug = WSP(float, MX == 0 ? WS_UG_R : WS_UG_G) + (((((size_t)dir * 4 + b) * 4 + h) * 9 + g) * DK + k) * 64 + d0;
#pragma unroll
        for (int e = 0; e < NE; ++e) ug[e] = S[e];
        if (d0 == 0) WSP(float, WS_AG)[((((MX * 2 + dir) * 4 + b) * 4 + h) * 9 + g) * 64 + k] = Ap;
    }
}
template <int MX> __device__ __forceinline__ void scan_stage2_unit(KP kp, int l, int b, int h, int g, LAS unsigned char* lds, int tid) {
    using namespace scn;
    constexpr int DK = Cfg<MX>::DK, NKS = DK / 16, NE = DK * 64 / NT, NCH16 = DK / 8;
    const int lane = tid & 63, wid = __builtin_amdgcn_readfirstlane(tid >> 6), q32 = lane & 31, hi = lane >> 5;
    const int nch = g == 8 ? 4 : 8, cid0 = g == 8 ? 256 + 4 * b : b * 64 + 8 * g;
    const bool act = wid < nch;
    const int cid = cid0 + (act ? wid : 0), row0 = cid * 64;
    const bf16_t* PB = WSP(bf16_t, WS_PBUF);
    const float* US = WSP(float, MX == 0 ? WS_US_R : WS_US_G);
    const float* UG = WSP(float, MX == 0 ? WS_UG_R : WS_UG_G);
    const float* CUMT = WSP(float, WS_CUMT_G);
    f32x16 o[2][2];
#pragma unroll
    for (int it = 0; it < 2; ++it)
#pragma unroll
        for (int dh = 0; dh < 2; ++dh)
#pragma unroll
            for (int r = 0; r < 16; ++r) o[it][dh][r] = 0.f;
    LAS unsigned char* myv = lds + 65536 + wid * 8192;
    { const unsigned char* vimg = WSP(unsigned char, MX == 0 ? WS_VT_R : WS_VT_G) + (size_t)(cid * 4 + h) * 8192 + lane * 16;
      u32x4 tmp[8];
#pragma unroll
      for (int i = 0; i < 8; ++i) tmp[i] = *(const u32x4*)(vimg + i * 1024);
#pragma unroll
      for (int i = 0; i < 8; ++i) *(LAS u32x4*)(myv + i * 1024 + lane * 16) = tmp[i]; }
    const int fk = (tid * NE) >> 6, fd0 = (tid * NE) & 63;
#pragma unroll 1
    for (int dir = 0; dir < 2; ++dir) {
        float lg = 0.f; if (MX == 0) lg = -expf(p.ret_decay[(l * 2 + dir) * 4 + h]);
        float S[NE];
#pragma unroll
        for (int e = 0; e < NE; ++e) S[e] = 0.f;
        if (g != 8) {
            const float* ugb = UG + (((size_t)dir * 4 + b) * 4 + h) * 9 * DK * 64 + (size_t)fk * 64 + fd0;
            const float* agb = WSP(float, WS_AG) + (((MX * 2 + dir) * 4 + b) * 4 + h) * 9 * 64 + fk;
#pragma unroll
            for (int e = 0; e < NE; ++e) S[e] = ugb[(size_t)8 * DK * 64 + e];
            const int ng = dir == 0 ? g : 7 - g;
            for (int q = 0; q < ng; ++q) { const int gg = dir == 0 ? q : 7 - q; const float A = agb[gg * 64];
#pragma unroll
                for (int e = 0; e < NE; ++e) S[e] = A * S[e] + ugb[(size_t)gg * DK * 64 + e]; }
        }
        for (int cc = 0; cc < nch; ++cc) {
            const int c = dir == 0 ? cc : nch - 1 - cc, ccid = cid0 + c;
            LAS unsigned char* area = lds + c * 8192;
#pragma unroll
            for (int e = 0; e < NE; ++e) { const int d = fd0 + e; const int sw = DK == 64 ? ((d >> 1) & 7) : ((d >> 2) & 3);
                *(LAS bf16_t*)(area + d * (DK * 2) + 16 * ((fk >> 3) ^ sw) + (fk & 7) * 2) = f2bf(S[e]); }
            float A;
            if (MX == 0) A = SCN_EXP(lg * 64.f); else A = SCN_EXP(CUMT[(((size_t)dir * NCHUNK + ccid) * 128 + h * 32 + fk) * 64 + (dir == 0 ? 63 : 0)]);
            const float* up = US + ((((size_t)dir * NCHUNK + ccid) * 4 + h) * DK + fk) * 64 + fd0;
#pragma unroll
            for (int e = 0; e < NE; ++e) S[e] = A * S[e] + up[e];
        }
        asm volatile("s_waitcnt lgkmcnt(0)" ::: "memory");
        __syncthreads();
        if (act) {
#define SCN_GEN(dst, ISQ, T2) do { const int il_ = 32 * (T2) + q32, row_ = row0 + il_; \
                _Pragma("unroll") for (int ks = 0; ks < NKS; ++ks) { const int kc0 = 16 * ks + 8 * hi; u32x4 raw_; float f_[8]; \
                    if (MX == 0) { raw_ = *(const u32x4*)(WSP(bf16_t, (ISQ) ? WS_QF_R : WS_KF_R) + (size_t)row_ * 256 + h * 64 + kc0); \
                        const float cm_ = lg * (float)(dir == 0 ? il_ + 1 : 64 - il_), e_ = SCN_EXP((ISQ) ? cm_ : -cm_); \
                        _Pragma("unroll") for (int jj = 0; jj < 8; ++jj) f_[jj] = e_; \
                    } else { raw_ = *(const u32x4*)(PB + (size_t)row_ * PW + ((ISQ) ? PC_GQ : PC_GK) + h * 32 + kc0); \
                        const float* cp_ = WSP(float, WS_CUM_G) + ((size_t)dir * MALL + row_) * 128 + h * 32 + kc0; \
                        const f32x4 c0_ = *(const f32x4*)cp_, c1_ = *(const f32x4*)(cp_ + 4); \
                        _Pragma("unroll") for (int jj = 0; jj < 4; ++jj) { f_[jj] = (ISQ) ? SCN_EXP(c0_[jj]) * 0.17677669529663687f : SCN_EXP(-c0_[jj]); f_[4 + jj] = (ISQ) ? SCN_EXP(c1_[jj]) * 0.17677669529663687f : SCN_EXP(-c1_[jj]); } } \
                    dst[ks] = scale8(raw_, f_); } } while (0)
#define SCN_TILE(JT, IT, MASKED) do { bf16x8 kf_[NKS]; SCN_GEN(kf_, false, JT); f32x16 P; \
                _Pragma("unroll") for (int r = 0; r < 16; ++r) P[r] = 0.f; \
                _Pragma("unroll") for (int ks = 0; ks < NKS; ++ks) P = __builtin_amdgcn_mfma_f32_32x32x16_bf16(kf_[ks], qf[ks], P, 0, 0, 0); \
                if (MASKED) { _Pragma("unroll") for (int r = 0; r < 16; ++r) { const int j = crow(r, hi); const bool keep = dir == 0 ? (j <= q32) : (j >= q32); P[r] = keep ? P[r] : 0.f; } } \
                _Pragma("unroll") for (int s = 0; s < 2; ++s) { u32x4 pk; \
                    _Pragma("unroll") for (int j = 0; j < 4; ++j) pk[j] = cvtpk(P[8 * s + 2 * j], P[8 * s + 2 * j + 1]); \
                    _Pragma("unroll") for (int dh = 0; dh < 2; ++dh) { const int d = dh * 32 + q32, x = (d >> 1) & 15, kc = 8 * JT + 4 * s + hi; \
                        const u32x2 v0 = *(const LAS u32x2*)(myv + d * 128 + 8 * (kc ^ x)), v1 = *(const LAS u32x2*)(myv + d * 128 + 8 * ((kc + 2) ^ x)); \
                        o[IT][dh] = __builtin_amdgcn_mfma_f32_32x32x16_bf16(__builtin_bit_cast(bf16x8, pk), __builtin_bit_cast(bf16x8, (u32x4){v0.x, v0.y, v1.x, v1.y}), o[IT][dh], 0, 0, 0); } } } while (0)
#define SCN_INTER(IT) do { const LAS unsigned char* area = lds + wid * 8192; \
                _Pragma("unroll") for (int dh = 0; dh < 2; ++dh) _Pragma("unroll") for (int ks = 0; ks < NKS; ++ks) { \
                    const int d = dh * 32 + q32, sw = DK == 64 ? ((d >> 1) & 7) : ((d >> 2) & 3); \
                    const bf16x8 sf = *(const LAS bf16x8*)(area + d * (DK * 2) + 16 * ((2 * ks + hi) ^ sw)); \
                    o[IT][dh] = __builtin_amdgcn_mfma_f32_32x32x16_bf16(qf[ks], sf, o[IT][dh], 0, 0, 0); } } while (0)
            { bf16x8 qf[NKS]; SCN_GEN(qf, true, 0);
              SCN_TILE(0, 0, true); if (dir == 1) SCN_TILE(1, 0, false);
              SCN_INTER(0); }
            asm volatile("" ::: "memory");
            { bf16x8 qf[NKS]; SCN_GEN(qf, true, 1);
              if (dir == 0) SCN_TILE(0, 1, false);
              SCN_TILE(1, 1, true);
              SCN_INTER(1); }
#undef SCN_GEN
#undef SCN_TILE
#undef SCN_INTER
        }
        asm volatile("s_waitcnt lgkmcnt(0)" ::: "memory");
        __syncthreads();
    }
    if (act) {
        const int gcol = (MX == 0 ? PC_RG : PC_GR) + h * 64, ccol = (MX == 0 ? 512 : 768) + h * 64;
        const float g0 = MX == 0 ? p.ret_norm_g[l * 256 + h * 64 + q32] : p.gla_norm_g[l * 64 + q32], g1 = MX == 0 ? p.ret_norm_g[l * 256 + h * 64 + 32 + q32] : p.gla_norm_g[l * 64 + 32 + q32];
#pragma unroll
        for (int it = 0; it < 2; ++it)
#pragma unroll
            for (int r = 0; r < 16; ++r) {
                const int row = row0 + 32 * it + crow(r, hi);
                const float a0 = o[it][0][r], a1 = o[it][1][r];
                float ss = a0 * a0 + a1 * a1;
#pragma unroll
                for (int x = 1; x < 32; x <<= 1) ss += __shfl_xor(ss, x);
                const float rstd = rsqrtf(ss * (1.f / 64.f) + EPS);
                const float gt0 = bf2f(PB[(size_t)row * PW + gcol + q32]), gt1 = bf2f(PB[(size_t)row * PW + gcol + 32 + q32]);
                bf16_t* op = WSP(bf16_t, WS_CONCAT) + (size_t)row * D + ccol + q32;
                op[0] = f2bf(a0 * rstd * g0 * (gt0 / (1.f + SCN_EXP(-gt0)))); op[32] = f2bf(a1 * rstd * g1 * (gt1 / (1.f + SCN_EXP(-gt1))));
                if ((r & 3) == 3) asm volatile("" ::: "memory");
            }
    }
}
__device__ __forceinline__ void d_scan_stage1(KP kp, int l) {
    PH_IDS;
    for (int u = bid; u < 2 * 16 * 9; u += gridDim.x) {
        const int mx = u / 144, r = u % 144, bh = r / 9, g = r % 9;
        if (mx == 0) scan_stage1_unit<0>(kp, l, bh >> 2, bh & 3, g, tid); else scan_stage1_unit<1>(kp, l, bh >> 2, bh & 3, g, tid);
    }
}
__device__ __forceinline__ void d_scan_stage2(KP kp, int l, LAS unsigned char* lds) {
    PH_IDS;
    const int ng = l == 0 ? 9 : 8;
    for (int u = bid; u < 2 * 16 * ng; u += gridDim.x) {
        const int mx = u / (16 * ng), r = u % (16 * ng), bh = r / ng, g = r % ng;
        if (mx == 0) scan_stage2_unit<0>(kp, l, bh >> 2, bh & 3, g, lds, tid); else scan_stage2_unit<1>(kp, l, bh >> 2, bh & 3, g, lds, tid);
    }
}

namespace hfft {
typedef float f2 __attribute__((ext_vector_type(2)));
typedef float f4 __attribute__((ext_vector_type(4)));
constexpr int N = 8192;
__device__ __forceinline__ f2 cmul(f2 a, f2 b) { return (f2){a.x * b.x - a.y * b.y, a.x * b.y + a.y * b.x}; }
__device__ __forceinline__ f2 cmulc(f2 a, f2 b) { return (f2){a.x * b.x + a.y * b.y, a.y * b.x - a.x * b.y}; }
__device__ __forceinline__ f2 tw(float frac) { float sn, cs; sincosf(6.283185307179586f * frac, &sn, &cs); return (f2){cs, -sn}; }
__device__ __forceinline__ f2 mul_mi(f2 a) { return (f2){a.y, -a.x}; }
__device__ __forceinline__ f2 mul_pi(f2 a) { return (f2){-a.y, a.x}; }
template <int LOGD> __device__ __forceinline__ void fwd_pass(LAS f2* buf, int tid) {
    constexpr int Dd = 1 << LOGD;
#pragma unroll
    for (int g = 0; g < 4; ++g) {
        const int u = tid + NT * g, pos = u & (Dd - 1), base = ((u - pos) << 2) + pos;
        const f2 wA = tw((float)pos * (1.f / (4.f * Dd))), wB = cmul(wA, wA);
#pragma unroll
        for (int arr = 0; arr < 2; ++arr) {
            LAS f2* x = buf + arr * N + base;
            const f2 a0 = x[0], a1 = x[Dd], a2 = x[2 * Dd], a3 = x[3 * Dd];
            const f2 b0 = a0 + a2, b2 = cmul(a0 - a2, wA), b1 = a1 + a3, b3 = mul_mi(cmul(a1 - a3, wA));
            x[0] = b0 + b1; x[Dd] = cmul(b0 - b1, wB); x[2 * Dd] = b2 + b3; x[3 * Dd] = cmul(b2 - b3, wB);
        }
    }
    __syncthreads();
}
template <int LOGD> __device__ __forceinline__ void inv_pass(LAS f2* buf, int tid) {
    constexpr int Dd = 1 << LOGD;
#pragma unroll
    for (int g = 0; g < 4; ++g) {
        const int u = tid + NT * g, pos = u & (Dd - 1), base = ((u - pos) << 2) + pos;
        const f2 wA = tw((float)pos * (1.f / (4.f * Dd))), wB = cmul(wA, wA);
#pragma unroll
        for (int arr = 0; arr < 2; ++arr) {
            LAS f2* x = buf + arr * N + base;
            const f2 c0 = x[0], c1 = cmulc(x[Dd], wB), c2 = x[2 * Dd], c3 = cmulc(x[3 * Dd], wB);
            const f2 b0 = c0 + c1, b1 = c0 - c1, b2 = cmulc(c2 + c3, wA), b3 = mul_pi(cmulc(c2 - c3, wA));
            x[0] = b0 + b2; x[2 * Dd] = b0 - b2; x[Dd] = b1 + b3; x[3 * Dd] = b1 - b3;
        }
    }
    __syncthreads();
}
__device__ __forceinline__ void fwd_all(LAS f2* buf, int tid) { fwd_pass<11>(buf, tid); fwd_pass<9>(buf, tid); fwd_pass<7>(buf, tid); fwd_pass<5>(buf, tid); fwd_pass<3>(buf, tid); fwd_pass<1>(buf, tid); }
__device__ __forceinline__ void inv_all(LAS f2* buf, int tid) { inv_pass<1>(buf, tid); inv_pass<3>(buf, tid); inv_pass<5>(buf, tid); inv_pass<7>(buf, tid); inv_pass<9>(buf, tid); inv_pass<11>(buf, tid); }
}
__device__ __forceinline__ void d_fspec(KP kp, LAS unsigned char* lds) {
    PH_IDS;
    using namespace hfft;
    LAS f2* buf = (LAS f2*)lds; LAS float* nrm = (LAS float*)(lds + 131072);
    for (int u = bid; u < 256; u += gridDim.x) {
        const int l = u >> 7, c0 = (u & 127) * 2;
        const float* filt = WSP(float, WS_FILT) + (size_t)l * 8192 * 256;
        if (tid < 128) {
            const int arr = tid >> 6, ln = tid & 63; float a = 0.f;
#pragma unroll
            for (int q = 0; q < 4; ++q) a += WSP(float, WS_PS)[(size_t)(l * 256 + ln * 4 + q) * 256 + c0 + arr];
            a = wave_sum(a); if (ln == 0) nrm[arr] = a;
        }
        for (int i = tid; i < 2 * N; i += NT) { const int arr = i >> 13, tau = i & (N - 1); buf[i] = (f2){filt[(size_t)tau * 256 + c0 + arr], 0.f}; }
        __syncthreads();
        fwd_all(buf, tid);
        f4* fs = (f4*)(WSP(float, WS_FSPEC) + ((size_t)l * 256 + c0) * 2 * N);
        for (int i = tid; i < N; i += NT) {
            const int arr = i >> 12, j = i & 4095;
            const f4 v = *(const LAS f4*)(buf + arr * N + 2 * j);
            const float sc = 1.f / (8192.f * nrm[arr]), bs = p.hy_bias[l * 256 + c0 + arr] * (1.f / 8192.f);
            fs[(size_t)arr * (N / 2) + j] = (f4){(v.x + v.z) * sc + bs, (v.y + v.w) * sc, (v.x - v.z) * sc + bs, (v.y - v.w) * sc};
        }
        __syncthreads();
    }
}
__device__ __forceinline__ void d_hy_pre_fast(KP kp, int l, LAS unsigned char* lds) {
    PH_IDS;
    LAS float* zt = (LAS float*)lds;
    const bf16_t* PB = WSP(bf16_t, WS_PBUF);
    const int c = tid & 255, half = tid >> 8;
    const float* sw = p.hy_short_w + l * 3 * 768; const float* sb = p.hy_short_b + l * 768;
    float w0[3], w1[3], w2[3], bb[3];
#pragma unroll
    for (int g = 0; g < 3; ++g) { w0[g] = sw[g * 256 + c]; w1[g] = sw[768 + g * 256 + c]; w2[g] = sw[1536 + g * 256 + c]; bb[g] = sb[g * 256 + c]; }
    for (int u = bid; u < NLAT / 64; u += gridDim.x) {
        const int row0 = u * 64 + half * 32, t0 = (u * 64) & (SEQ - 1);
        float prev[3], cur[3], nxt[3];
#pragma unroll
        for (int g = 0; g < 3; ++g) {
            const bf16_t* pp = PB + (size_t)row0 * PW + PC_HY + g * 256 + c;
            prev[g] = (t0 + half * 32 > 0) ? bf2f(pp[-PW]) : 0.f; cur[g] = bf2f(pp[0]);
        }
#pragma unroll 4
        for (int i = 0; i < 32; ++i) {
            const int row = row0 + i, t = t0 + half * 32 + i;
            float uu[3];
#pragma unroll
            for (int g = 0; g < 3; ++g) { nxt[g] = (t < SEQ - 1) ? bf2f(PB[(size_t)(row + 1) * PW + PC_HY + g * 256 + c]) : 0.f;
                uu[g] = bb[g] + w0[g] * prev[g] + w1[g] * cur[g] + w2[g] * nxt[g]; prev[g] = cur[g]; cur[g] = nxt[g]; }
            WSP(bf16_t, WS_X0B)[(size_t)row * 256 + c] = f2bf(uu[0]);
            zt[c * 65 + half * 32 + i] = uu[1] * uu[2];
        }
        __syncthreads();
        const int b = (u * 64) >> 12;
        for (int i = tid; i < 256 * 64; i += NT) { const int cc = i >> 6, tl = i & 63; WSP(float, WS_ZT)[((size_t)cc * 4 + b) * SEQ + t0 + tl] = zt[cc * 65 + tl]; }
        __syncthreads();
    }
    if (l == 0) {
        GT_LOOP(idx, NCTX * 256) {
            const int r = idx >> 8, cc = idx & 255, t = r & (CTXL - 1);
            const bf16_t* pp = PB + (size_t)(NLAT + r) * PW + PC_HY + cc;
            float uu[3];
#pragma unroll
            for (int g = 0; g < 3; ++g) { float a = sb[g * 256 + cc] + sw[768 + g * 256 + cc] * bf2f(pp[g * 256]);
                if (t > 0) a += sw[g * 256 + cc] * bf2f(pp[g * 256 - PW]); if (t < CTXL - 1) a += sw[1536 + g * 256 + cc] * bf2f(pp[g * 256 + PW]); uu[g] = a; }
            WSP(float, WS_X0C)[idx] = uu[0]; WSP(float, WS_ZC)[idx] = uu[1] * uu[2];
        }
    }
}
__device__ __forceinline__ void d_hy_fft(KP kp, int l, LAS unsigned char* lds) {
    PH_IDS;
    using namespace hfft;
    LAS f2* buf = (LAS f2*)lds;
    for (int c = bid; c < 256; c += gridDim.x) {
        const float* zt = WSP(float, WS_ZT) + (size_t)c * 4 * SEQ;
        for (int i = tid; i < 2 * N; i += NT) { const int arr = i >> 13, t = i & (N - 1);
            buf[i] = t < SEQ ? (f2){zt[(size_t)(2 * arr) * SEQ + t], zt[(size_t)(2 * arr + 1) * SEQ + t]} : (f2){0.f, 0.f}; }
        __syncthreads();
        fwd_all(buf, tid);
        const f4* fs = (const f4*)(WSP(float, WS_FSPEC) + ((size_t)l * 256 + c) * 2 * N);
        for (int i = tid; i < N; i += NT) {
            const int arr = i >> 12, j = i & 4095;
            LAS f4* xp = (LAS f4*)(buf + arr * N + 2 * j);
            const f4 v = *xp; const f4 f = fs[j];
            const f2 s = cmul((f2){v.x + v.z, v.y + v.w}, (f2){f.x, f.y}), d = cmul((f2){v.x - v.z, v.y - v.w}, (f2){f.z, f.w});
            *xp = (f4){s.x + d.x, s.y + d.y, s.x - d.x, s.y - d.y};
        }
        __syncthreads();
        inv_all(buf, tid);
        float* yt = WSP(float, WS_YT) + (size_t)c * 4 * SEQ;
        for (int i = tid; i < 2 * SEQ; i += NT) { const int arr = i >> 12, t = i & (SEQ - 1); const f2 v = buf[arr * N + t];
            yt[(size_t)(2 * arr) * SEQ + t] = v.x; yt[(size_t)(2 * arr + 1) * SEQ + t] = v.y; }
        __syncthreads();
    }
}
__device__ __forceinline__ void d_hy_post(KP kp, int l, LAS unsigned char* lds) {
    PH_IDS;
    LAS float* yt = (LAS float*)lds;
    for (int u = bid; u < NLAT / 64; u += gridDim.x) {
        const int b = (u * 64) >> 12, t0 = (u * 64) & (SEQ - 1);
        for (int i = tid; i < 256 * 64; i += NT) { const int cc = i >> 6, tl = i & 63; yt[cc * 65 + tl] = WSP(float, WS_YT)[((size_t)cc * 4 + b) * SEQ + t0 + tl]; }
        __syncthreads();
        for (int i = tid; i < 64 * 256; i += NT) { const int tl = i >> 8, c = i & 255; const size_t row = (size_t)u * 64 + tl;
            WSP(bf16_t, WS_CONCAT)[row * D + 256 + c] = f2bf(bf2f(WSP(bf16_t, WS_X0B)[row * 256 + c]) * yt[c * 65 + tl]); }
        __syncthreads();
    }
    if (l == 0) {
        GT_LOOP(idx, NCTX * 256) {
            const int c = idx & 255, r = idx >> 8, t = r & (CTXL - 1), rb = r - t;
            const float* filt = WSP(float, WS_FILTC); const float* zc = WSP(float, WS_ZC);
            float nrm = 0.f;
#pragma unroll
            for (int q = 0; q < 16; ++q) nrm += WSP(float, WS_PS)[(size_t)(512 + q) * 256 + c];
            float y = 0.f;
#pragma unroll 8
            for (int s2 = 0; s2 < CTXL; ++s2) y += filt[(size_t)((t - s2) & (2 * CTXL - 1)) * 256 + c] * zc[(size_t)(rb + s2) * 256 + c];
            y = y / nrm + p.hy_bias[c] * zc[idx];
            WSP(bf16_t, WS_CONCAT)[(size_t)(NLAT + r) * D + 256 + c] = f2bf(WSP(float, WS_X0C)[idx] * y);
        }
    }
}
constexpr int CW_BAR = 32768;
__global__ void __launch_bounds__(NT, 2) mk_fwd(P kargs) {
    const KP kp0 = (KP)__builtin_amdgcn_kernarg_segment_ptr();
    KP kp = kp0;
#define LP ({ KP k_ = kp0; asm volatile("" : "+s"(k_)); k_; })
    unsigned char* const lds = g_lds;
    volatile LAS unsigned* misc = (volatile LAS unsigned*)((LAS unsigned char*)lds + LDS_MISC);
    if (threadIdx.x < 16) misc[threadIdx.x] = 0u;
    if ((threadIdx.x & 63) == 0) ((LAS int*)((LAS unsigned char*)lds + LDS_WTAB))[hw_wave_slot()] = threadIdx.x >> 6;
    __syncthreads();
    (void)xcd_barrier_post(WSP(unsigned, WS_CTL) + CW_BAR, misc);
#define GRID_BAR() do { XcdBarrier b_; { KP kp = LP; b_.bar = WSP(unsigned, WS_CTL) + CW_BAR; } b_.x = xb_xcc_id(); b_.st = (volatile LAS unsigned*)((LAS unsigned char*)lds + LDS_MISC); xcd_barrier(b_); } while (0)
    d_pro0(LP); d_filter(LP, (LAS float*)((LAS unsigned char*)lds + 73728)); d_convert_a(LP, (LAS float*)lds);
    GRID_BAR();
    d_pro1(LP); d_convert_b(LP, (LAS float*)lds);
    GRID_BAR();
    d_fspec(LP, (LAS unsigned char*)lds); d_norm1(LP, 0);
    GRID_BAR();
#pragma unroll 1
    for (int l = 0; l < DEPTH; ++l) {
        d_gemm_in(LP, l, (LAS unsigned char*)lds);
        GRID_BAR();
        d_prep_scan(LP); d_prep_attn(LP); d_hy_pre_fast(LP, l, (LAS unsigned char*)lds);
        GRID_BAR();
        d_scan_stage1(LP, l);
        d_hy_fft(LP, l, (LAS unsigned char*)lds);
        d_attn_fast(LP, l, (LAS unsigned char*)lds);
        GRID_BAR();
        d_scan_stage2(LP, l, (LAS unsigned char*)lds);
        d_hy_post(LP, l, (LAS unsigned char*)lds);
        GRID_BAR();
        d_gemm_out(LP, l, (LAS unsigned char*)lds);
        GRID_BAR();
        d_router(LP, l, (LAS float*)lds);
        GRID_BAR();
        d_moe_up(LP, l, (LAS unsigned char*)lds);
        GRID_BAR();
        d_moe_down(LP, l, (LAS unsigned char*)lds);
        GRID_BAR();
        d_combine(LP, l, (LAS int*)lds);
        GRID_BAR();
    }
}

#undef p
extern "C" void kernel_launch(void* const* d_in, const int* in_sizes, int n_in, void* d_out, int out_size, void* d_ws, size_t ws_size, hipStream_t stream) {
    if (n_in != 31 || ws_size < WS_END || out_size != NLAT * D) { fprintf(stderr, "kernel_launch: unexpected shapes (n_in %d ws %zu out %d)\n", n_in, ws_size, out_size); return; }
    static int grid = 0;
    if (grid == 0) {
        int dev = 0, cus = 0, per_cu = 0;
        if (hipGetDevice(&dev) != hipSuccess || hipDeviceGetAttribute(&cus, hipDeviceAttributeMultiprocessorCount, dev) != hipSuccess) { grid = -1; return; }
        if (hipFuncSetAttribute((const void*)mk_fwd, hipFuncAttributeMaxDynamicSharedMemorySize, LDS_BYTES) != hipSuccess) { fprintf(stderr, "hipFuncSetAttribute failed\n"); grid = -1; return; }
        if (hipOccupancyMaxActiveBlocksPerMultiprocessor(&per_cu, (const void*)mk_fwd, NT, LDS_BYTES) != hipSuccess || per_cu < 1) { fprintf(stderr, "occupancy query says %d\n", per_cu); }
        (void)hipGetLastError();
        grid = cus;
    }
    if (grid < 0) return;
    P hp{};
    const float** pp = (const float**)&hp;
    for (int i = 0; i < 31; ++i) pp[i] = (const float*)d_in[i];
    hp.out = (float*)d_out; hp.ws = (unsigned char*)d_ws;
    (void)hipMemsetAsync((char*)d_ws + WS_CTL, 0, 1 * MiB, stream);
    hipLaunchKernelGGL(mk_fwd, dim3(grid), dim3(NT), LDS_BYTES, stream, hp);
}
```

```cpp
#include <hip/hip_runtime.h>
#include <stdint.h>
#include <stdio.h>
#include <math.h>

constexpr int D = 1024, BATCH = 4, SEQ = 4096, CTXL = 256, DEPTH = 2;
constexpr int NLAT = BATCH * SEQ, NCTX = BATCH * CTXL, MALL = NLAT + NCTX;
constexpr int INW = 3360, PW = 3584;
constexpr int NEXP = 32, TOPK = 4;
constexpr float EPS = 1e-6f;
constexpr int PC_AQ = 0, PC_AK = 256, PC_AV = 512, PC_HY = 768, PC_RQ = 1536, PC_RK = 1792, PC_RV = 2048, PC_RG = 2304,
              PC_GQ = 2560, PC_GK = 2688, PC_GV = 2816, PC_GR = 3072, PC_GD = 3328;
constexpr int ACT_ROWS = MALL * TOPK + NEXP * 256;

typedef unsigned short bf16_t;
typedef float cvt_f32x2_t __attribute__((ext_vector_type(2))); typedef __bf16 cvt_bf16x2_t __attribute__((ext_vector_type(2)));
__device__ __forceinline__ unsigned cvtpk_rne(float lo, float hi) { cvt_f32x2_t v = {lo, hi}; cvt_bf16x2_t b = __builtin_convertvector(v, cvt_bf16x2_t); return __builtin_bit_cast(unsigned, b); }
__device__ __forceinline__ bf16_t f2bf(float f) { unsigned u = __float_as_uint(f); return (bf16_t)((u + 0x7fffu + ((u >> 16) & 1u)) >> 16); }
__device__ __forceinline__ float bf2f(bf16_t b) { return __uint_as_float(((unsigned)b) << 16); }

typedef unsigned gv4u __attribute__((ext_vector_type(4))); typedef float gv4f __attribute__((ext_vector_type(4)));
__device__ __forceinline__ float gblo(unsigned w) { return __uint_as_float(w << 16); }
__device__ __forceinline__ float gbhi(unsigned w) { return __uint_as_float(w & 0xffff0000u); }
constexpr size_t MiB = 1u << 20;
constexpr size_t WS_CTL = 0;
constexpr size_t WS_MOD = 1 * MiB;
constexpr size_t WS_WEFF = 3 * MiB;
constexpr size_t WS_FILT = 6 * MiB;
constexpr size_t WS_FILTC = WS_FILT + 16 * MiB;
constexpr size_t WS_XRES = 24 * MiB;
constexpr size_t WS_HB = WS_XRES + 68 * MiB;
constexpr size_t WS_PBUF = WS_HB + 34 * MiB;
constexpr size_t WS_CONCAT = WS_PBUF + 120 * MiB;
constexpr size_t WS_YBUF = WS_CONCAT + 34 * MiB;
constexpr size_t WS_QA = WS_YBUF + 68 * MiB;
constexpr size_t WS_KA = WS_QA + 17 * MiB;
constexpr size_t WS_QR = WS_KA + 17 * MiB;
constexpr size_t WS_KR = WS_QR + 17 * MiB;
constexpr size_t WS_OA = WS_KR + 17 * MiB;
constexpr size_t WS_Z = WS_OA + 34 * MiB;
constexpr size_t WS_X0 = WS_Z + 17 * MiB;
constexpr size_t WS_LA = WS_X0 + 17 * MiB;
constexpr size_t WS_OD = WS_LA + 17 * MiB;
constexpr size_t WS_TOPI = WS_OD + 68 * MiB;
constexpr size_t WS_TOPW = WS_TOPI + 1 * MiB;
constexpr size_t WS_LIST = WS_TOPW + 1 * MiB;
constexpr size_t WS_ACT = WS_LIST + 3 * MiB;
constexpr size_t WS_YSLOT = WS_ACT + 160 * MiB;
constexpr size_t WS_WIN_T = WS_YSLOT + 160 * MiB;
constexpr size_t WS_WOUT_T = WS_WIN_T + 14 * MiB;
constexpr size_t WS_W1_T = WS_WOUT_T + 4 * MiB;
constexpr size_t WS_W2_T = WS_W1_T + 256 * MiB;
constexpr size_t WS_BIAS_IN = WS_W2_T + 128 * MiB;
constexpr size_t WS_QRP = WS_BIAS_IN + 1 * MiB;
constexpr size_t WS_KIMG = WS_QRP + 9 * MiB;
constexpr size_t WS_VIMG = WS_KIMG + 9 * MiB;
constexpr size_t WS_QF_R = WS_VIMG + 9 * MiB;
constexpr size_t WS_KF_R = WS_QF_R + 9 * MiB;
constexpr size_t WS_KT_R = WS_KF_R + 9 * MiB;
constexpr size_t WS_KT_G = WS_KT_R + 9 * MiB;
constexpr size_t WS_VT_R = WS_KT_G + 5 * MiB;
constexpr size_t WS_VT_G = WS_VT_R + 9 * MiB;
constexpr size_t WS_CUM_G = WS_VT_G + 9 * MiB;
constexpr size_t WS_CUMT_G = WS_CUM_G + 17 * MiB;
constexpr size_t WS_US_R = WS_CUMT_G + 17 * MiB;
constexpr size_t WS_US_G = WS_US_R + 34 * MiB;
constexpr size_t WS_UG_R = WS_US_G + 17 * MiB;
constexpr size_t WS_UG_G = WS_UG_R + 5 * MiB;
constexpr size_t WS_AG = WS_UG_G + 3 * MiB;
constexpr size_t WS_ROPE = WS_AG + 1 * MiB;
constexpr size_t WS_FSPEC = WS_ROPE + 1 * MiB;
constexpr size_t WS_ZT = WS_FSPEC + 32 * MiB;
constexpr size_t WS_YT = WS_ZT + 16 * MiB;
constexpr size_t WS_X0B = WS_YT + 16 * MiB;
constexpr size_t WS_MODP = WS_X0B + 8 * MiB;
constexpr size_t WS_PS = WS_MODP + 4 * MiB;
constexpr size_t WS_ZC = WS_PS + 1 * MiB;
constexpr size_t WS_X0C = WS_ZC + 1 * MiB;
constexpr size_t WS_END = WS_X0C + 1 * MiB;
constexpr int CW_CNT = 1024;
constexpr int CW_NORM = 2048;

struct P {
    const float *x, *c, *ctx, *c_ctx, *w_mod, *b_mod, *norm_g, *w_in, *w_out, *diff_lambda, *diff_subln_g, *hy_short_w, *hy_short_b,
        *hy_w1, *hy_b1, *hy_w2, *hy_b2, *hy_w3, *hy_freq, *hy_bias, *ret_decay, *ret_norm_g, *gla_gate_w, *gla_gate_b, *gla_norm_g,
        *router_w, *router_b, *exp_w1, *exp_b1, *exp_w2, *exp_b2;
    float* out; unsigned char* ws;
};
typedef const __attribute__((address_space(4))) P* KP;
#define p (*kp)
#define WSP(T, off) ((T*)(p.ws + (off)))

__device__ __forceinline__ float wave_sum(float v) {
#pragma unroll
    for (int o = 1; o < 64; o <<= 1) v += __shfl_xor(v, o);
    return v;
}
__device__ __forceinline__ float silu_f(float x) { return x / (1.f + expf(-x)); }
__host__ __device__ __forceinline__ int nrows_l(int l) { return l == 0 ? MALL : NLAT; }
__device__ __forceinline__ int mod_r(int row) { return row < NLAT ? row / SEQ : 4; }
__device__ __forceinline__ void seq_info(int row, int& base, int& n, int& t) {
    if (row < NLAT) { base = row & ~(SEQ - 1); n = SEQ; t = row - base; }
    else { int r = row - NLAT; base = NLAT + (r & ~(CTXL - 1)); n = CTXL; t = row - base; }
}

__device__ __forceinline__ int ltid();
#define XB_TMO      128
#define XB_XCNT(j)  (256  + 64 * (j))
#define XB_XSUB(j)  (1280 + 64 * (j))
#define XB_XGEN(j)  (2304 + 64 * (j))
#define XB_TOP      3328
#define XB_TOPGEN   3392
#define XCD_BAR_WORDS 3456
#define XB_SPIN_CAP (1u << 22)
#define LAS __attribute__((address_space(3)))
__device__ __forceinline__ unsigned xb_ld(unsigned* ptr)            { return __hip_atomic_load(ptr, __ATOMIC_RELAXED, __HIP_MEMORY_SCOPE_AGENT); }
__device__ __forceinline__ unsigned xb_add(unsigned* ptr, unsigned v) { return __hip_atomic_fetch_add(ptr, v, __ATOMIC_RELAXED, __HIP_MEMORY_SCOPE_AGENT); }
__device__ __forceinline__ unsigned xb_xcc_id() { return (unsigned)__builtin_amdgcn_s_getreg((3 << 11) | 20) & 0xFu; }
#define XB_SPIN(cond, bar) do { unsigned _sp = 0; while (cond) { __builtin_amdgcn_s_sleep(1); \
    if ((++_sp & 255u) == 0u) { if (xb_ld(&(bar)[XB_TMO])) break; if (_sp > XB_SPIN_CAP) { atomicAdd(&(bar)[XB_TMO], 1u); break; } } } } while (0)
struct XcdBarrier { unsigned* bar; unsigned x; volatile LAS unsigned* st; };
__device__ __forceinline__ XcdBarrier xcd_barrier_post(unsigned* bar, volatile LAS unsigned* st) {
    XcdBarrier b; b.bar = bar; b.x = xb_xcc_id(); b.st = st;
    if (threadIdx.x == 0) (void)xb_add(&bar[XB_XCNT(b.x)], 1u);
    return b;
}
__device__ __forceinline__ void xcd_barrier_complete(unsigned* bar, unsigned x, unsigned& nloc, unsigned& nx) {
    const unsigned G = gridDim.x * gridDim.y * gridDim.z;
    unsigned sum, cnt, mine, sp = 0u;
    for (;;) {
        sum = 0u; cnt = 0u; mine = 0u;
#pragma unroll
        for (unsigned j = 0; j < 16; ++j) { const unsigned c = xb_ld(&bar[XB_XCNT(j)]); sum += c; cnt += (c > 0u) ? 1u : 0u; mine = (j == x) ? c : mine; }
        if (sum == G) break;
        __builtin_amdgcn_s_sleep(1);
        if ((++sp & 255u) == 0u) { if (xb_ld(&bar[XB_TMO])) break; if (sp > XB_SPIN_CAP) { atomicAdd(&bar[XB_TMO], 1u); break; } }
    }
    nloc = mine > 0u ? mine : 1u; nx = cnt > 0u ? cnt : 1u;
}
__device__ __forceinline__ void xcd_barrier(const XcdBarrier& b) {
    asm volatile("s_waitcnt vmcnt(0)" ::: "memory");
    __syncthreads();
    if (ltid() == 0) {
        unsigned* bar = b.bar;
        __builtin_amdgcn_s_waitcnt(0);
        unsigned nloc = b.st[0], nx = b.st[1];
        if (nloc == 0u) { xcd_barrier_complete(bar, b.x, nloc, nx); b.st[0] = nloc; b.st[1] = nx; }
        const unsigned old = xb_add(&bar[XB_XSUB(b.x)], 1u);
        const unsigned gen = old / nloc;
        if (old + 1u == (gen + 1u) * nloc) {
            __builtin_amdgcn_fence(__ATOMIC_RELEASE, "agent");
            asm volatile("s_waitcnt vmcnt(0)" ::: "memory");
            const unsigned og = xb_add(&bar[XB_TOP], 1u);
            const unsigned tg = og / nx;
            if (og + 1u == (tg + 1u) * nx) xb_add(&bar[XB_TOPGEN], 1u);
            else XB_SPIN(xb_ld(&bar[XB_TOPGEN]) == tg, bar);
            __builtin_amdgcn_fence(__ATOMIC_ACQUIRE, "agent");
            xb_add(&bar[XB_XGEN(b.x)], 1u);
            asm volatile("s_waitcnt vmcnt(0)" ::: "memory");
        } else {
            XB_SPIN(xb_ld(&bar[XB_XGEN(b.x)]) == gen, bar);
            __builtin_amdgcn_fence(__ATOMIC_ACQUIRE, "agent");
            asm volatile("s_waitcnt vmcnt(0)" ::: "memory");
        }
    }
    __syncthreads();
}

constexpr int NT = 512;
extern __shared__ __attribute__((aligned(16))) unsigned char g_lds[];
constexpr int LDS_BYTES = 147456;
constexpr int LDS_WTAB = LDS_BYTES - 512;
constexpr int LDS_MISC = LDS_BYTES - 64;
__device__ __forceinline__ int hw_wave_slot() { return (int)(__builtin_amdgcn_s_getreg((5 << 11) | 4) & 63u); }
__device__ __forceinline__ int ltid() {
    const int w = __builtin_amdgcn_readfirstlane(((const LAS int*)((LAS unsigned char*)g_lds + LDS_WTAB))[hw_wave_slot()]);
    unsigned ones = ~0u; asm volatile("" : "+s"(ones));
    int t = (w << 6) | (int)__builtin_amdgcn_mbcnt_hi(ones, __builtin_amdgcn_mbcnt_lo(ones, 0u));
    asm volatile("" : "+v"(t)); return t;
}
__device__ __forceinline__ int lbid() { int b = blockIdx.x; asm volatile("" : "+s"(b)); return b; }
#define PH_IDS const int tid = ltid(), bid = lbid(); (void)tid; (void)bid
#define GT_LOOP(idx, total) for (int idx = bid * NT + tid; idx < (total); idx += gridDim.x * NT)
#define GW_LOOP(w, total) for (int w = bid * (NT / 64) + (tid >> 6); w < (total); w += gridDim.x * (NT / 64))

__device__ __forceinline__ const float* xin_row(KP kp, int l, int row) {
    return l == 0 ? (row < NLAT ? p.x + (size_t)row * D : p.ctx + (size_t)(row - NLAT) * D) : WSP(float, WS_XRES) + (size_t)row * D;
}
__device__ __forceinline__ void d_pro0(KP kp, LAS float* sc) {
    PH_IDS;
    GT_LOOP(idx, 64 * 24) {
        const int pos = idx / 24, j = idx % 24; float ang; float* dst;
        if (j < 8) { ang = (float)pos * powf(10000.f, -(float)j / 8.f); dst = WSP(float, WS_ROPE) + (pos * 8 + j) * 2; }
        else { ang = (float)pos * powf(10000.f, -(float)(j - 8) / 16.f); dst = WSP(float, WS_ROPE) + 1024 + (pos * 16 + (j - 8)) * 2; }
        dst[0] = cosf(ang); dst[1] = sinf(ang);
    }
    GT_LOOP(idx, 2 * 1024 * 256) {
        int n = idx & 255, i = (idx >> 8) & 1023, l = idx >> 18, d = n >> 7, j = n & 127;
        float a = 0.f;
        for (int r = 0; r < 16; ++r) a += p.w_in[((size_t)l * D + i) * INW + 3328 + d * 16 + r] * p.gla_gate_w[((l * 2 + d) * 16 + r) * 128 + j];
        WSP(float, WS_WEFF)[idx] = a;
    }
    const int lane = tid & 63;
    for (int i = tid; i < 5 * D; i += NT) { const int r = i >> 10, ii = i & 1023; sc[i] = silu_f(r < 4 ? p.c[r * D + ii] : p.c_ctx[ii]); }
    __syncthreads();
    GW_LOOP(task, 2 * 96 * 16) {
        const int chunk = task & 15, jb = (task >> 4) % 96, l = task / (16 * 96), j = jb * 64 + lane;
        const float* w = p.w_mod + ((size_t)l * D + chunk * 64) * 6144 + j;
        float acc[5] = {0.f, 0.f, 0.f, 0.f, 0.f};
#pragma unroll 8
        for (int i = 0; i < 64; ++i) { const float wv = w[(size_t)i * 6144];
#pragma unroll
            for (int r = 0; r < 5; ++r) acc[r] += sc[r * D + chunk * 64 + i] * wv; }
#pragma unroll
        for (int r = 0; r < 5; ++r) WSP(float, WS_MODP)[((size_t)(chunk * 2 + l) * 5 + r) * 6144 + j] = acc[r];
    }
}
__device__ __forceinline__ void d_filter(KP kp, LAS float* sm) {
    PH_IDS;
    const int lane = tid & 63; LAS float* zf = sm + (tid >> 6) * 192; LAS float* h1 = zf + 64; LAS float* h2 = zf + 128;
    GW_LOOP(task, 2 * SEQ + CTXL) {
        const int which = task < SEQ ? 0 : task < 2 * SEQ ? 1 : 2, pos = task - (which == 2 ? 2 * SEQ : which * SEQ), l = which == 1 ? 1 : 0, n = which == 2 ? CTXL : SEQ;
        float* filt = which == 2 ? WSP(float, WS_FILTC) : WSP(float, WS_FILT) + (size_t)l * 8192 * 256;
        const float t = (float)pos / (float)(n - 1), w = (6.2831855f * (float)pos) / (float)n;
        if (lane < 33) { float v = t; if (lane >= 1) { const int q = (lane - 1) & 15; const float f = 1e-4f + (15.f - 1e-4f) * ((float)q / 15.f), a = w * f; v = lane < 17 ? cosf(a) : -sinf(a); } zf[lane] = v; }
        asm volatile("s_waitcnt lgkmcnt(0)" ::: "memory");
        float a = p.hy_b1[l * 64 + lane];
        for (int i = 0; i < 33; ++i) a += zf[i] * p.hy_w1[(l * 33 + i) * 64 + lane];
        h1[lane] = sinf(p.hy_freq[(l * 2 + 0) * 64 + lane] * a);
        asm volatile("s_waitcnt lgkmcnt(0)" ::: "memory");
        a = p.hy_b2[l * 64 + lane];
        for (int i = 0; i < 64; ++i) a += h1[i] * p.hy_w2[(l * 64 + i) * 64 + lane];
        h2[lane] = sinf(p.hy_freq[(l * 2 + 1) * 64 + lane] * a);
        asm volatile("s_waitcnt lgkmcnt(0)" ::: "memory");
        float raw[8];
#pragma unroll
        for (int q = 0; q < 8; ++q) raw[q] = 0.f;
        for (int j = 0; j < 64; ++j) { const float hj = h2[j]; const float* w3 = p.hy_w3 + (size_t)(l * 64 + j) * 512 + lane;
#pragma unroll
            for (int q = 0; q < 8; ++q) raw[q] += hj * w3[q * 64]; }
        const float mind = logf(1e-2f) / 1.5f, maxd = logf(1e-2f) / 0.3f;
#pragma unroll
        for (int q = 0; q < 8; ++q) {
            const int c = (q & 3) * 64 + lane;
            const float v = raw[q] * expf(-t * fabsf(mind + (maxd - mind) * ((float)c / 255.f)));
            if (q < 4) { filt[(size_t)pos * 256 + c] = v; if (pos == 0) filt[(size_t)n * 256 + c] = 0.f; }
            else if (pos >= 1) filt[(size_t)(2 * n - pos) * 256 + c] = v;
        }
        asm volatile("s_waitcnt lgkmcnt(0)" ::: "memory");
    }
}
__device__ __forceinline__ void d_pro1(KP kp) {
    PH_IDS;
    GT_LOOP(idx, 2 * 5 * 6144) {
        const int j = idx % 6144, r = (idx / 6144) % 5, l = idx / (6144 * 5);
        float a = p.b_mod[l * 6144 + j];
        for (int ch = 0; ch < 16; ++ch) a += WSP(float, WS_MODP)[((size_t)(ch * 2 + l) * 5 + r) * 6144 + j];
        WSP(float, WS_MOD)[idx] = a;
    }
    GT_LOOP(idx, 528 * 256) {
        const int vb = idx >> 8, c = idx & 255, which = vb < 256 ? 0 : vb < 512 ? 1 : 2, slab = vb - (which == 2 ? 512 : which * 256);
        const float* filt = which == 2 ? WSP(float, WS_FILTC) : WSP(float, WS_FILT) + (size_t)which * 8192 * 256;
        float a = 0.f;
#pragma unroll 8
        for (int i = 0; i < 32; ++i) a += fabsf(filt[(size_t)(slab * 32 + i) * 256 + c]);
        WSP(float, WS_PS)[(which * 256 + slab) * 256 + c] = a;
    }
}
__device__ __forceinline__ void d_norm1(KP kp, int l) {
    PH_IDS;
    const int lane = tid & 63;
    GW_LOOP(row, MALL) {
        const float* xr = xin_row(kp, l, row);
        const float* mod = WSP(float, WS_MOD) + (size_t)(l * 5 + mod_r(row)) * 6144;
        const float* g = p.norm_g + (l * 4 + 0) * D;
        float v[16], ss = 0.f;
#pragma unroll
        for (int j = 0; j < 16; ++j) { v[j] = xr[j * 64 + lane]; ss += v[j] * v[j]; }
        const float rstd = rsqrtf(wave_sum(ss) * (1.f / D) + EPS);
        bf16_t* hb = WSP(bf16_t, WS_HB) + (size_t)row * D;
#pragma unroll
        for (int j = 0; j < 16; ++j) { int cidx = j * 64 + lane; hb[cidx] = f2bf(v[j] * rstd * g[cidx] * (1.f + mod[1024 + cidx]) + mod[cidx]); }
    }
}
__device__ __forceinline__ void d_router(KP kp, int l, LAS float* sm) {
    PH_IDS;
    const int lane = tid & 63;
    for (int i = tid; i < D * NEXP; i += NT) sm[(i >> 5) * 33 + (i & 31)] = p.router_w[(size_t)l * D * NEXP + i];
    LAS int* lcnt = (LAS int*)(sm + 33800); LAS int* lbase = lcnt + 32; LAS int* rec = lcnt + 64;
    if (tid < 32) lcnt[tid] = 0;
    __syncthreads();
    int it = 0;
    GW_LOOP(row, nrows_l(l)) {
        const float* xs = xin_row(kp, l, row);
        float* xr = WSP(float, WS_XRES) + (size_t)row * D;
        const float* y = WSP(float, WS_YBUF) + (size_t)row * D;
        const float* mod = WSP(float, WS_MOD) + (size_t)(l * 5 + mod_r(row)) * 6144;
        const float* g1 = p.norm_g + (l * 4 + 1) * D; const float* g2 = p.norm_g + (l * 4 + 2) * D;
        float yv[16], xv[16], ss = 0.f;
#pragma unroll
        for (int j = 0; j < 16; ++j) { yv[j] = y[j * 64 + lane]; ss += yv[j] * yv[j]; }
        float rstd = rsqrtf(wave_sum(ss) * (1.f / D) + EPS);
        ss = 0.f;
#pragma unroll
        for (int j = 0; j < 16; ++j) { const int ci = j * 64 + lane; xv[j] = xs[ci] + mod[2048 + ci] * (yv[j] * rstd * g1[ci]); ss += xv[j] * xv[j]; }
        float gsc[16], gsh[16];
#pragma unroll
        for (int j = 0; j < 16; ++j) { const int ci = j * 64 + lane; gsc[j] = g2[ci] * (1.f + mod[4096 + ci]); gsh[j] = mod[3072 + ci]; }
#pragma unroll
        for (int j = 0; j < 16; ++j) xr[j * 64 + lane] = xv[j];
        rstd = rsqrtf(wave_sum(ss) * (1.f / D) + EPS);
        bf16_t* hb = WSP(bf16_t, WS_HB) + (size_t)row * D;
        float v[32];
#pragma unroll
        for (int e = 0; e < 32; ++e) v[e] = 0.f;
#pragma unroll
        for (int j = 0; j < 16; ++j) { xv[j] = xv[j] * rstd * gsc[j] + gsh[j]; hb[j * 64 + lane] = f2bf(xv[j]); }
#pragma unroll
        for (int j = 0; j < 16; ++j) { const LAS float* wr = sm + (j * 64 + lane) * 33; const float hv = xv[j];
#pragma unroll
            for (int e = 0; e < 32; ++e) v[e] += hv * wr[e];
            asm volatile("" : "+v"(v[0]), "+v"(v[8]), "+v"(v[16]), "+v"(v[24])); }
#pragma unroll
        for (int k = 0; k < 16; ++k) { const bool up = lane & 32; const float send = up ? v[k] : v[k + 16], keep = up ? v[k + 16] : v[k]; v[k] = keep + __shfl_xor(send, 32); }
#pragma unroll
        for (int k = 0; k < 8; ++k) { const bool up = lane & 16; const float send = up ? v[k] : v[k + 8], keep = up ? v[k + 8] : v[k]; v[k] = keep + __shfl_xor(send, 16); }
#pragma unroll
        for (int k = 0; k < 4; ++k) { const bool up = lane & 8; const float send = up ? v[k] : v[k + 4], keep = up ? v[k + 4] : v[k]; v[k] = keep + __shfl_xor(send, 8); }
#pragma unroll
        for (int k = 0; k < 2; ++k) { const bool up = lane & 4; const float send = up ? v[k] : v[k + 2], keep = up ? v[k + 2] : v[k]; v[k] = keep + __shfl_xor(send, 4); }
        { const bool up = lane & 2; const float send = up ? v[0] : v[1], keep = up ? v[1] : v[0]; v[0] = keep + __shfl_xor(send, 2); }
        const int myexp = lane >> 1;
        float mylogit = v[0] + __shfl_xor(v[0], 1) + p.router_b[l * NEXP + myexp];
        float tv[4]; int ti[4];
#pragma unroll
        for (int k = 0; k < 4; ++k) {
            float bv = mylogit; int bi = myexp;
#pragma unroll
            for (int o = 1; o < 64; o <<= 1) { const float ov = __shfl_xor(bv, o); const int oi = __shfl_xor(bi, o); if (ov > bv || (ov == bv && oi < bi)) { bv = ov; bi = oi; } }
            tv[k] = bv; ti[k] = bi; if (myexp == bi) mylogit = -1e30f;
        }
        float den = 0.f, w[4];
#pragma unroll
        for (int k = 0; k < 4; ++k) { w[k] = expf(tv[k] - tv[0]); den += w[k]; }
        if (lane < 4) {
            const int e = lane == 0 ? ti[0] : lane == 1 ? ti[1] : lane == 2 ? ti[2] : ti[3];
            const float ww = lane == 0 ? w[0] : lane == 1 ? w[1] : lane == 2 ? w[2] : w[3];
            const int lr = __hip_atomic_fetch_add(&lcnt[e], 1, __ATOMIC_RELAXED, __HIP_MEMORY_SCOPE_WORKGROUP);
            rec[(it * 8 + (tid >> 6)) * 4 + lane] = (e << 16) | lr;
            WSP(float, WS_TOPW)[row * 4 + lane] = ww / den;
            WSP(int, WS_TOPI)[row * 4 + lane] = e;
        }
        ++it;
    }
    asm volatile("s_waitcnt lgkmcnt(0)" ::: "memory");
    __syncthreads();
    if (tid < 32) lbase[tid] = (int)atomicAdd(WSP(unsigned, WS_CTL) + CW_CNT + (l * 32 + tid) * 64, (unsigned)lcnt[tid]);
    asm volatile("s_waitcnt vmcnt(0) lgkmcnt(0)" ::: "memory");
    __syncthreads();
    it = 0;
    GW_LOOP(row, nrows_l(l)) {
        if (lane < 4) { const int rc = rec[(it * 8 + (tid >> 6)) * 4 + lane], e = rc >> 16, pos = lbase[e] + (rc & 0xffff);
            WSP(int, WS_LIST)[(size_t)e * MALL + pos] = row * 4 + lane; WSP(int, WS_TOPI)[MALL * 4 + row * 4 + lane] = pos; }
        ++it;
    }
    __syncthreads();
}
__device__ __forceinline__ void d_combine(KP kp, int l, LAS int* aoffs) {
    PH_IDS;
    const int lane = tid & 63;
    const unsigned* cnt = WSP(unsigned, WS_CTL) + CW_CNT + l * 32 * 64;
    if (tid == 0) { int a = 0; for (int e = 0; e < 32; ++e) { aoffs[e] = a; a += ((int)cnt[e * 64] + 255) & ~255; } }
    __syncthreads();
    GW_LOOP(row, nrows_l(l)) {
        int ee[4], pp[4];
#pragma unroll
        for (int k = 0; k < 4; ++k) { ee[k] = WSP(int, WS_TOPI)[row * 4 + k]; pp[k] = WSP(int, WS_TOPI)[MALL * 4 + row * 4 + k]; }
        gv4u yv[4][2];
#pragma unroll
        for (int k = 0; k < 4; ++k) { const gv4u* ys = (const gv4u*)(WSP(bf16_t, WS_YSLOT) + (size_t)(aoffs[ee[k]] + pp[k]) * D) + lane; yv[k][0] = ys[0]; yv[k][1] = ys[64]; }
        float acc[16];
#pragma unroll
        for (int j = 0; j < 16; ++j) acc[j] = 0.f;
#pragma unroll
        for (int k = 0; k < 4; ++k)
#pragma unroll
            for (int hf = 0; hf < 2; ++hf)
#pragma unroll
                for (int q = 0; q < 4; ++q) { acc[hf * 8 + 2 * q] += gblo(yv[k][hf][q]); acc[hf * 8 + 2 * q + 1] += gbhi(yv[k][hf][q]); }
        float ss = 0.f;
#pragma unroll
        for (int j = 0; j < 16; ++j) ss += acc[j] * acc[j];
        float rstd = rsqrtf(wave_sum(ss) * (1.f / D) + EPS);
        float* xr = WSP(float, WS_XRES) + (size_t)row * D;
        const float* mod = WSP(float, WS_MOD) + (size_t)(l * 5 + mod_r(row)) * 6144;
        const float* g3 = p.norm_g + (l * 4 + 3) * D;
        ss = 0.f;
        gv4f xo[4], gm[4], gg[4];
#pragma unroll
        for (int q8 = 0; q8 < 4; ++q8) { const int ci = (q8 >> 1) * 512 + lane * 8 + (q8 & 1) * 4; xo[q8] = *(const gv4f*)(xr + ci); gm[q8] = *(const gv4f*)(mod + 5120 + ci); gg[q8] = *(const gv4f*)(g3 + ci); }
        float n0[16], n1[16], n2[16];
        if (l < DEPTH - 1) {
            const float* mod2 = WSP(float, WS_MOD) + (size_t)((l + 1) * 5 + mod_r(row)) * 6144; const float* g0 = p.norm_g + ((l + 1) * 4 + 0) * D;
#pragma unroll
            for (int q8 = 0; q8 < 4; ++q8) { const int ci = (q8 >> 1) * 512 + lane * 8 + (q8 & 1) * 4; const gv4f a = *(const gv4f*)(g0 + ci), b2 = *(const gv4f*)(mod2 + 1024 + ci), c2 = *(const gv4f*)(mod2 + ci);
#pragma unroll
                for (int q = 0; q < 4; ++q) { n0[q8 * 4 + q] = a[q]; n1[q8 * 4 + q] = b2[q]; n2[q8 * 4 + q] = c2[q]; } }
        }
#pragma unroll
        for (int q8 = 0; q8 < 4; ++q8) {
            const int ci = (q8 >> 1) * 512 + lane * 8 + (q8 & 1) * 4;
            gv4f vv;
#pragma unroll
            for (int q = 0; q < 4; ++q) { const float v = xo[q8][q] + gm[q8][q] * (acc[q8 * 4 + q] * rstd * gg[q8][q]); vv[q] = v; acc[q8 * 4 + q] = v; ss += v * v; }
            if (l == DEPTH - 1) *(gv4f*)(p.out + (size_t)row * D + ci) = vv; else *(gv4f*)(xr + ci) = vv;
        }
        if (l < DEPTH - 1) {
            rstd = rsqrtf(wave_sum(ss) * (1.f / D) + EPS);
            bf16_t* hb = WSP(bf16_t, WS_HB) + (size_t)row * D;
#pragma unroll
            for (int hf = 0; hf < 2; ++hf) {
                gv4u o;
#pragma unroll
                for (int q = 0; q < 4; ++q) { const int i0 = hf * 8 + 2 * q; o[q] = cvtpk_rne(acc[i0] * rstd * n0[i0] * (1.f + n1[i0]) + n2[i0], acc[i0 + 1] * rstd * n0[i0 + 1] * (1.f + n1[i0 + 1]) + n2[i0 + 1]); }
                *(gv4u*)(hb + hf * 512 + lane * 8) = o;
            }
        }
    }
    __syncthreads();
}

namespace pg8 {
typedef short bf16x8 __attribute__((ext_vector_type(8)));
typedef float f32x4 __attribute__((ext_vector_type(4)));
typedef unsigned u32x4 __attribute__((ext_vector_type(4)));
typedef unsigned u32x2 __attribute__((ext_vector_type(2)));
constexpr int BM = 256, BK = 64, HALF = 128, HTB = HALF * BK * 2, STAGE_BYTES = 8 * HTB, NXCD = 8, WGM = 8, K = 1024;
__host__ __device__ __forceinline__ int lds_byte(int r, int c) { const int st = (r >> 4) * 2 + (c >> 5), rr = r & 15, cc = c & 31, ob = rr * 64 + cc * 2; return st * 1024 + (ob ^ (((ob >> 9) & 1) << 5)); }
__host__ __device__ __forceinline__ void stage_rc(int b, int& R, int& C) { const int st = b / 1024, sb = b % 1024, swz = sb ^ (((sb >> 9) & 1) << 5); R = (st >> 1) * 16 + swz / 64; C = (st & 1) * 32 + (swz % 64) / 2; }
__host__ __device__ __forceinline__ int perm32(int rho) { const int n = rho >> 4, i = rho & 15; return 8 * (i >> 2) + 4 * n + (i & 3); }
__device__ __forceinline__ unsigned cvt_pk_bf16(float lo, float hi) { return cvtpk_rne(lo, hi); }

struct Unit { int pm, pn; const char* A; const char* B; const int* gl; int gcnt; int e; int row0; };

struct DenseOrder {
    int nM, nN, nwg, G, c; const char* A; const char* Bt;
    __device__ __forceinline__ void init(int M, int N, int G_, int c_, const void* A_, const void* Bt_) { nM = M / BM; nN = N / BM; nwg = nM * nN; G = G_; c = c_; A = (const char*)A_; Bt = (const char*)Bt_; }
    __device__ __forceinline__ bool next(int i, Unit& u) const {
        const long L = (long)i * G + c; if (L >= nwg) return false;
        int wgid = (int)L; { const int q = nwg / NXCD, r = nwg % NXCD, xcd = wgid % NXCD, off = wgid / NXCD; wgid = (xcd < r ? xcd * (q + 1) : r * (q + 1) + (xcd - r) * q) + off; }
        const int nig = WGM * nN, gid = wgid / nig, fm = gid * WGM, gsz = (nM - fm) < WGM ? (nM - fm) : WGM;
        u.pm = fm + ((wgid % nig) % gsz); u.pn = (wgid % nig) / gsz;
        u.A = A + (size_t)u.pm * (BM * K * 2); u.B = Bt + (size_t)u.pn * (BM * K * 2); u.gl = nullptr; u.gcnt = BM; u.e = 0; u.row0 = u.pm * BM; return true;
    }
};
struct MoeOrder {
    const LAS int* tab; int G, c, NCT; const char* A; const char* W; size_t wstride; const int* list; const unsigned* cnt; bool gather;
    __device__ __forceinline__ bool next(int i, Unit& u) const {
        const int xg = c & 7, L = (c >> 3) + (G >> 3) * i; const LAS int* gt = tab + 72 + xg * 5;
        if (L >= gt[4]) return false;
        int q = 0;
#pragma unroll
        for (int j = 1; j < 4; ++j) if (L >= gt[j]) q = j;
        const int e = __builtin_amdgcn_readfirstlane(xg + 8 * q);
        const int r = __builtin_amdgcn_readfirstlane(L - gt[q]), ce = __builtin_amdgcn_readfirstlane((int)cnt[e * 64]), rte = (ce + 255) >> 8, ro = __builtin_amdgcn_readfirstlane(tab[33 + e]);
        const int ct = r / rte, rt = r - ct * rte;
        u.pm = rt; u.pn = ct; u.e = e; u.row0 = ro + rt * 256; u.gl = list + (size_t)e * MALL + rt * 256; u.gcnt = min(256, ce - rt * 256);
        u.A = gather ? A : A + (size_t)u.row0 * (K * 2); u.B = W + (size_t)e * wstride + (size_t)ct * (BM * K * 2); return true;
    }
};
__device__ __forceinline__ void moe_tab_build(LAS int* tab, const unsigned* cnt, int NCT) {
    if (ltid() == 0) {
        int rs = 0; for (int e = 0; e < 32; ++e) { tab[33 + e] = rs; rs += (((int)cnt[e * 64] + 255) >> 8) * 256; } tab[65] = rs;
        for (int g = 0; g < 8; ++g) { int us = 0; for (int q = 0; q < 4; ++q) { tab[72 + g * 5 + q] = us; us += (((int)cnt[(g + 8 * q) * 64] + 255) >> 8) * NCT; } tab[72 + g * 5 + 4] = us; }
    }
    __syncthreads();
}

struct EpiBf16 {
    static constexpr bool PERM = true; bf16_t* O; int ldc; const float* bias;
    __device__ __forceinline__ void operator()(const f32x4 (&acc)[2][2][4][2], const Unit& u, int wr, int wc, int fr, int fq) const {
        const int row0 = u.row0 + wr * 64 + fr, col0 = u.pn * BM + wc * 32 + 8 * fq;
        f32x4 bv[2][2];
#pragma unroll
        for (int bj = 0; bj < 2; ++bj)
#pragma unroll
            for (int n = 0; n < 2; ++n) bv[bj][n] = bias ? *(const f32x4*)(bias + col0 + bj * HALF + 4 * n) : (f32x4){0.f, 0.f, 0.f, 0.f};
#pragma unroll
        for (int ai = 0; ai < 2; ++ai)
#pragma unroll
            for (int m = 0; m < 4; ++m) { bf16_t* rowp = O + (size_t)(row0 + ai * HALF + m * 16) * ldc + col0;
#pragma unroll
                for (int bj = 0; bj < 2; ++bj) { const f32x4 v0 = acc[ai][bj][m][0] + bv[bj][0], v1 = acc[ai][bj][m][1] + bv[bj][1];
                    u32x4 w; w.x = cvt_pk_bf16(v0[0], v0[1]); w.y = cvt_pk_bf16(v0[2], v0[3]); w.z = cvt_pk_bf16(v1[0], v1[1]); w.w = cvt_pk_bf16(v1[2], v1[3]);
                    *(u32x4*)(rowp + bj * HALF) = w; } }
    }
};
struct EpiF32 {
    static constexpr bool PERM = false; float* O; int ldc;
    __device__ __forceinline__ void operator()(const f32x4 (&acc)[2][2][4][2], const Unit& u, int wr, int wc, int fr, int fq) const {
        const int row0 = u.row0 + wr * 64 + fr, col0 = u.pn * BM + wc * 32 + 4 * fq;
#pragma unroll
        for (int ai = 0; ai < 2; ++ai)
#pragma unroll
            for (int m = 0; m < 4; ++m) { float* rowp = O + (size_t)(row0 + ai * HALF + m * 16) * ldc + col0;
#pragma unroll
                for (int bj = 0; bj < 2; ++bj)
#pragma unroll
                    for (int n = 0; n < 2; ++n) *(f32x4*)(rowp + bj * HALF + n * 16) = acc[ai][bj][m][n]; }
    }
};
struct EpiMoeUp {
    static constexpr bool PERM = true; bf16_t* ACT; const float* b1all;
    __device__ __forceinline__ void operator()(const f32x4 (&acc)[2][2][4][2], const Unit& u, int wr, int wc, int fr, int fq) const {
        const int col0 = u.pn * BM + wc * 32 + 8 * fq; const float* b1 = b1all + (size_t)u.e * 2048;
        f32x4 bv[2][2];
#pragma unroll
        for (int bj = 0; bj < 2; ++bj)
#pragma unroll
            for (int n = 0; n < 2; ++n) bv[bj][n] = *(const f32x4*)(b1 + col0 + bj * HALF + 4 * n);
#pragma unroll
        for (int ai = 0; ai < 2; ++ai)
#pragma unroll
            for (int m = 0; m < 4; ++m) { bf16_t* rowp = ACT + (size_t)(u.row0 + wr * 64 + fr + ai * HALF + m * 16) * 1024 + (col0 >> 1);
#pragma unroll
                for (int bj = 0; bj < 2; ++bj) { const f32x4 v0 = acc[ai][bj][m][0] + bv[bj][0], v1 = acc[ai][bj][m][1] + bv[bj][1];
                    float a[4];
#pragma unroll
                    for (int j = 0; j < 4; ++j) { const float gl = fminf(j < 2 ? v0[2 * j] : v1[2 * j - 4], 7.f), ln = fminf(fmaxf(j < 2 ? v0[2 * j + 1] : v1[2 * j - 3], -7.f), 7.f);
                        a[j] = gl * __builtin_amdgcn_rcpf(1.f + __builtin_amdgcn_exp2f(-1.702f * 1.4426950408889634f * gl)) * (ln + 1.f); }
                    u32x2 w; w.x = cvt_pk_bf16(a[0], a[1]); w.y = cvt_pk_bf16(a[2], a[3]);
                    *(u32x2*)(rowp + bj * 64) = w; } }
    }
};
struct EpiMoeDown {
    static constexpr bool PERM = true; bf16_t* Y; const float* b2all; const float* topw;
    __device__ __forceinline__ void operator()(const f32x4 (&acc)[2][2][4][2], const Unit& u, int wr, int wc, int fr, int fq) const {
        const int col0 = u.pn * BM + wc * 32 + 8 * fq; const float* b2 = b2all + (size_t)u.e * 1024;
        f32x4 bv[2][2];
#pragma unroll
        for (int bj = 0; bj < 2; ++bj)
#pragma unroll
            for (int n = 0; n < 2; ++n) bv[bj][n] = *(const f32x4*)(b2 + col0 + bj * HALF + 4 * n);
#pragma unroll
        for (int ai = 0; ai < 2; ++ai)
#pragma unroll
            for (int m = 0; m < 4; ++m) { const int r = wr * 64 + fr + ai * HALF + m * 16; const float tw = r < u.gcnt ? topw[u.gl[r]] : 0.f;
                bf16_t* rowp = Y + (size_t)(u.row0 + r) * 1024 + col0;
#pragma unroll
                for (int bj = 0; bj < 2; ++bj) { const f32x4 v0 = (acc[ai][bj][m][0] + bv[bj][0]) * tw, v1 = (acc[ai][bj][m][1] + bv[bj][1]) * tw;
                    u32x4 w; w.x = cvt_pk_bf16(v0[0], v0[1]); w.y = cvt_pk_bf16(v0[2], v0[3]); w.z = cvt_pk_bf16(v1[0], v1[1]); w.w = cvt_pk_bf16(v1[2], v1[3]);
                    *(u32x4*)(rowp + bj * HALF) = w; } }
    }
};

template <class Epi, class Sched, bool GATHER, bool ALIGN_EPI>
__device__ __forceinline__ void gphase(LAS unsigned char* lds, const Sched& S, const Epi& E) {
    const int tid = ltid();
    const int wid = __builtin_amdgcn_readfirstlane(tid >> 6), lane = tid & 63, wr = wid >> 2, wc = wid & 3, fr = lane & 15, fq = lane >> 4;
    constexpr int nt = K / BK;
    unsigned voffB[2], CA2[2]; int RA[2];
#pragma unroll
    for (int i = 0; i < 2; ++i) { int R, C; stage_rc(tid * 16 + i * 8192, R, C); const int Rb = Epi::PERM ? ((R & ~31) + perm32(R & 31)) : R;
        RA[i] = R; CA2[i] = (unsigned)C * 2u; voffB[i] = (unsigned)(Rb * K + C) * 2u; }
    constexpr size_t kstep = (size_t)(BK * 2), hstep = (size_t)HALF * K * 2;
    const unsigned ldsw = (unsigned)wid * 1024u;
    const int aoff = lds_byte(wr * 64 + fr, fq * 8), boff = lds_byte(wc * 32 + fr, fq * 8);
#define PG8_SA(b, h) (((b) * 2 + (h)) * HTB)
#define PG8_SB(b, h) ((4 + (b) * 2 + (h)) * HTB)
#define PG8_GL(gp, ldsoff) __builtin_amdgcn_global_load_lds((const unsigned*)(gp), (LAS unsigned*)(lds + (ldsoff)), 16, 0, 0)
#define PG8_STB(bufoff, gbase) do { PG8_GL((const char*)(gbase) + voffB[0], (bufoff) + ldsw); PG8_GL((const char*)(gbase) + voffB[1], (bufoff) + ldsw + 8192); } while (0)
#define PG8_STA(bufoff, gbase, o) do { PG8_GL((const char*)(gbase) + (o)[0], (bufoff) + ldsw); PG8_GL((const char*)(gbase) + (o)[1], (bufoff) + ldsw + 8192); } while (0)
#define PG8_LDA(dst, b, h) do { _Pragma("unroll") for (int m = 0; m < 4; ++m) _Pragma("unroll") for (int k = 0; k < 2; ++k) dst[m][k] = *(const LAS bf16x8*)(lds + PG8_SA(b, h) + aoff + m * 2048 + k * 1024); } while (0)
#define PG8_LDB(dst, b, h) do { _Pragma("unroll") for (int n = 0; n < 2; ++n) _Pragma("unroll") for (int k = 0; k < 2; ++k) dst[n][k] = *(const LAS bf16x8*)(lds + PG8_SB(b, h) + boff + n * 2048 + k * 1024); } while (0)
#define PG8_MMA(ai, bj, At, Bt) do { __builtin_amdgcn_s_setprio(1); _Pragma("unroll") for (int m = 0; m < 4; ++m) _Pragma("unroll") for (int n = 0; n < 2; ++n) _Pragma("unroll") for (int k = 0; k < 2; ++k) \
        acc[ai][bj][m][n] = __builtin_amdgcn_mfma_f32_16x16x32_bf16(Bt[n][k], At[m][k], acc[ai][bj][m][n], 0, 0, 0); __builtin_amdgcn_s_setprio(0); } while (0)
#define PG8_WAIT_V(n) asm volatile("s_waitcnt vmcnt(" #n ")" ::: "memory")
#define PG8_WAIT_L(n) asm volatile("s_waitcnt lgkmcnt(" #n ")" ::: "memory")
#define PG8_BAR __builtin_amdgcn_s_barrier()
#define PG8_SCHED __builtin_amdgcn_sched_barrier(0)
#define PG8_AOFFS(u, o) do { _Pragma("unroll") for (int h_ = 0; h_ < 2; ++h_) _Pragma("unroll") for (int i_ = 0; i_ < 2; ++i_) { \
        if (GATHER) { const int r_ = h_ * 128 + RA[i_]; const int tok_ = r_ < (u).gcnt ? ((u).gl[r_] >> 2) : 0; o[h_][i_] = (unsigned)tok_ * (unsigned)(K * 2) + CA2[i_]; } \
        else o[h_][i_] = (unsigned)((h_ * 128 + RA[i_]) * (K * 2)) + CA2[i_]; } } while (0)
    Unit cur, nxt; int ui = 0;
    if (!S.next(0, cur)) return;
    f32x4 acc[2][2][4][2];
#pragma unroll
    for (int a = 0; a < 2; ++a)
#pragma unroll
        for (int b = 0; b < 2; ++b)
#pragma unroll
            for (int m = 0; m < 4; ++m)
#pragma unroll
                for (int n = 0; n < 2; ++n) acc[a][b][m][n] = (f32x4){0.f, 0.f, 0.f, 0.f};
    bf16x8 At[4][2], B0[2][2], B1[2][2];
    unsigned oAc[2][2], oAn[2][2];
    PG8_AOFFS(cur, oAc);
    const char* cA = cur.A; const char* cB = cur.B;
    PG8_STB(PG8_SB(0, 0), cB); PG8_STB(PG8_SB(0, 1), cB + hstep); PG8_STA(PG8_SA(0, 0), cA, oAc[0]); PG8_STA(PG8_SA(0, 1), cA, oAc[1]);
    if (wr == 1) PG8_BAR;
    PG8_WAIT_V(2); PG8_BAR;
    PG8_STB(PG8_SB(1, 0), cB + kstep); PG8_STA(PG8_SA(1, 0), cA + kstep, oAc[0]); PG8_STB(PG8_SB(1, 1), cB + hstep + kstep);
    PG8_WAIT_V(6); PG8_BAR;
    for (;;) {
        const bool has_next = S.next(ui + 1, nxt);
        const char* nA = has_next ? nxt.A : cA; const char* nB = has_next ? nxt.B : cB;
        if (has_next) { PG8_AOFFS(nxt, oAn); } else {
#pragma unroll
            for (int h = 0; h < 2; ++h) { oAn[h][0] = oAc[h][0]; oAn[h][1] = oAc[h][1]; } }
#pragma unroll 1
        for (int t = 0; t < nt; t += 2) {
            const bool last = (t == nt - 2);
            const char* a1 = cA + (size_t)(t + 1) * kstep;
            const char* a2 = last ? nA : cA + (size_t)(t + 2) * kstep; const char* b2 = last ? nB : cB + (size_t)(t + 2) * kstep;
            const char* a3 = a2 + kstep; const char* b3 = b2 + kstep;
            unsigned o2[2][2];
#pragma unroll
            for (int h = 0; h < 2; ++h) { o2[h][0] = last ? oAn[h][0] : oAc[h][0]; o2[h][1] = last ? oAn[h][1] : oAc[h][1]; }
            PG8_LDB(B0, 0, 0); PG8_LDB(B1, 0, 1); PG8_SCHED; PG8_LDA(At, 0, 0); PG8_STA(PG8_SA(1, 1), a1, oAc[1]);
            PG8_WAIT_V(8); PG8_WAIT_L(0); PG8_BAR; PG8_MMA(0, 0, At, B0); PG8_MMA(0, 1, At, B1); PG8_BAR; PG8_SCHED;
            PG8_LDA(At, 0, 1); PG8_STB(PG8_SB(0, 0), b2); PG8_STB(PG8_SB(0, 1), b2 + hstep); PG8_STA(PG8_SA(0, 0), a2, o2[0]);
            PG8_WAIT_V(8); PG8_WAIT_L(0); PG8_BAR; PG8_MMA(1, 0, At, B0); PG8_MMA(1, 1, At, B1); PG8_BAR; PG8_SCHED;
            PG8_LDB(B0, 1, 0); PG8_LDB(B1, 1, 1); PG8_SCHED; PG8_LDA(At, 1, 0); PG8_STA(PG8_SA(0, 1), a2, o2[1]);
            PG8_WAIT_V(8); PG8_WAIT_L(0); PG8_BAR; PG8_MMA(0, 0, At, B0); PG8_MMA(0, 1, At, B1); PG8_BAR; PG8_SCHED;
            PG8_LDA(At, 1, 1); PG8_STB(PG8_SB(1, 0), b3); PG8_STB(PG8_SB(1, 1), b3 + hstep); PG8_STA(PG8_SA(1, 0), a3, o2[0]);
            PG8_WAIT_V(8); PG8_WAIT_L(0); PG8_BAR; PG8_MMA(1, 0, At, B0); PG8_MMA(1, 1, At, B1); PG8_BAR; PG8_SCHED;
        }
        if constexpr (ALIGN_EPI) { if (wr == 0) PG8_BAR; }
        E(acc, cur, wr, wc, fr, fq);
        if (!has_next) break;
#pragma unroll
        for (int a = 0; a < 2; ++a)
#pragma unroll
            for (int b = 0; b < 2; ++b)
#pragma unroll
                for (int m = 0; m < 4; ++m)
#pragma unroll
                    for (int n = 0; n < 2; ++n) acc[a][b][m][n] = (f32x4){0.f, 0.f, 0.f, 0.f};
        cur = nxt; cA = nA; cB = nB; ++ui;
#pragma unroll
        for (int h = 0; h < 2; ++h) { oAc[h][0] = oAn[h][0]; oAc[h][1] = oAn[h][1]; }
        if constexpr (ALIGN_EPI) { if (wr == 1) PG8_BAR; }
    }
    PG8_WAIT_V(0);
    if constexpr (!ALIGN_EPI) { if (wr == 0) PG8_BAR; }
    PG8_BAR;
#undef PG8_SA
#undef PG8_SB
#undef PG8_GL
#undef PG8_STA
#undef PG8_STB
#undef PG8_LDA
#undef PG8_LDB
#undef PG8_MMA
#undef PG8_WAIT_V
#undef PG8_WAIT_L
#undef PG8_BAR
#undef PG8_SCHED
#undef PG8_AOFFS
}
}

__device__ __forceinline__ unsigned pk2(float lo, float hi) { return (unsigned)f2bf(lo) | ((unsigned)f2bf(hi) << 16); }
__device__ __forceinline__ void transpose_item(const float* W, int ld, int nblk, bf16_t* WT, LAS float* scr, int item, int lane) {
    const int kb = item / nblk, nb = item - kb * nblk, k0 = 64 * kb, n0 = 32 * nb;
#pragma unroll 8
    for (int i = 0; i < 32; ++i) { const int kk = 2 * i + (lane >> 5); scr[kk * 33 + (lane & 31)] = W[(size_t)(k0 + kk) * ld + n0 + (lane & 31)]; }
    asm volatile("s_waitcnt lgkmcnt(0)" ::: "memory");
    const int c = lane & 7;
#pragma unroll
    for (int j = 0; j < 4; ++j) { const int n = (lane >> 3) + 8 * j; const LAS float* s = scr + (8 * c) * 33 + n;
        pg8::u32x4 o; o.x = pk2(s[0 * 33], s[1 * 33]); o.y = pk2(s[2 * 33], s[3 * 33]); o.z = pk2(s[4 * 33], s[5 * 33]); o.w = pk2(s[6 * 33], s[7 * 33]);
        *(pg8::u32x4*)(WT + (size_t)(n0 + n) * 1024 + k0 + 8 * c) = o; }
    asm volatile("s_waitcnt lgkmcnt(0)" ::: "memory");
}
__device__ __forceinline__ void d_convert_a(KP kp, LAS float* scr_all) {
    PH_IDS;
    const int lane = tid & 63; LAS float* scr = scr_all + (tid >> 6) * (64 * 33);
    constexpr int I_IN = 16 * 104, I_OUT = 16 * 32, I_W1 = 16 * 64, I_W2 = 16 * 32, I_L = I_IN + I_OUT + 32 * I_W1 + 32 * I_W2;
    GW_LOOP(it, 2 * I_L) {
        const int l = it / I_L; int r = it - l * I_L;
        if (r < I_IN) { transpose_item(p.w_in + (size_t)l * D * INW, INW, 104, WSP(bf16_t, WS_WIN_T) + (size_t)l * PW * 1024, scr, r, lane); continue; } r -= I_IN;
        if (r < I_OUT) { transpose_item(p.w_out + (size_t)l * D * D, 1024, 32, WSP(bf16_t, WS_WOUT_T) + (size_t)l * 1024 * 1024, scr, r, lane); continue; } r -= I_OUT;
        if (r < 32 * I_W1) { const int e = r / I_W1; transpose_item(p.exp_w1 + ((size_t)l * NEXP + e) * D * 2048, 2048, 64, WSP(bf16_t, WS_W1_T) + ((size_t)l * NEXP + e) * 2048 * 1024, scr, r - e * I_W1, lane); continue; } r -= 32 * I_W1;
        { const int e = r / I_W2; transpose_item(p.exp_w2 + ((size_t)l * NEXP + e) * D * D, 1024, 32, WSP(bf16_t, WS_W2_T) + ((size_t)l * NEXP + e) * 1024 * 1024, scr, r - e * I_W2, lane); }
    }
    GT_LOOP(idx, 2 * PW) { const int l = idx / PW, n = idx - l * PW; WSP(float, WS_BIAS_IN)[idx] = n < 3328 ? 0.f : p.gla_gate_b[l * 256 + n - 3328]; }
}
__device__ __forceinline__ void d_convert_b(KP kp, LAS float* scr_all) {
    PH_IDS;
    const int lane = tid & 63; LAS float* scr = scr_all + (tid >> 6) * (64 * 33);
    GW_LOOP(it, 2 * 128) { const int l = it >> 7; transpose_item(WSP(float, WS_WEFF) + (size_t)l * D * 256, 256, 8, WSP(bf16_t, WS_WIN_T) + ((size_t)l * PW + 3328) * 1024, scr, it & 127, lane); }
}

__device__ __forceinline__ void d_gemm_in(KP kp, int l, LAS unsigned char* lds) {
    PH_IDS;
    pg8::DenseOrder S; S.init(MALL, PW, gridDim.x, bid, WSP(bf16_t, WS_HB), WSP(bf16_t, WS_WIN_T) + (size_t)l * PW * 1024);
    pg8::EpiBf16 E{WSP(bf16_t, WS_PBUF), PW, WSP(float, WS_BIAS_IN) + l * PW};
    pg8::gphase<pg8::EpiBf16, pg8::DenseOrder, false, true>(lds, S, E);
}
__device__ __forceinline__ void d_gemm_out(KP kp, int l, LAS unsigned char* lds) {
    PH_IDS;
    pg8::DenseOrder S; S.init(nrows_l(l), 1024, gridDim.x, bid, WSP(bf16_t, WS_CONCAT), WSP(bf16_t, WS_WOUT_T) + (size_t)l * 1024 * 1024);
    pg8::EpiF32 E{WSP(float, WS_YBUF), 1024};
    pg8::gphase<pg8::EpiF32, pg8::DenseOrder, false, true>(lds, S, E);
}
__device__ __forceinline__ void d_moe_up(KP kp, int l, LAS unsigned char* lds) {
    PH_IDS;
    LAS int* tab = (LAS int*)(lds + pg8::STAGE_BYTES);
    const unsigned* cnt = WSP(unsigned, WS_CTL) + CW_CNT + l * 32 * 64;
    pg8::moe_tab_build(tab, cnt, 8);
    pg8::MoeOrder S{tab, (int)gridDim.x, bid, 8, (const char*)WSP(bf16_t, WS_HB), (const char*)(WSP(bf16_t, WS_W1_T) + (size_t)l * NEXP * 2048 * 1024), (size_t)2048 * 1024 * 2, WSP(int, WS_LIST), cnt, true};
    pg8::EpiMoeUp E{WSP(bf16_t, WS_ACT), p.exp_b1 + (size_t)l * NEXP * 2048};
    pg8::gphase<pg8::EpiMoeUp, pg8::MoeOrder, true, true>(lds, S, E);
}
__device__ __forceinline__ void d_moe_down(KP kp, int l, LAS unsigned char* lds) {
    PH_IDS;
    LAS int* tab = (LAS int*)(lds + pg8::STAGE_BYTES);
    const unsigned* cnt = WSP(unsigned, WS_CTL) + CW_CNT + l * 32 * 64;
    pg8::moe_tab_build(tab, cnt, 4);
    pg8::MoeOrder S{tab, (int)gridDim.x, bid, 4, (const char*)WSP(bf16_t, WS_ACT), (const char*)(WSP(bf16_t, WS_W2_T) + (size_t)l * NEXP * 1024 * 1024), (size_t)1024 * 1024 * 2, WSP(int, WS_LIST), cnt, false};
    pg8::EpiMoeDown E{WSP(bf16_t, WS_YSLOT), p.exp_b2 + (size_t)l * NEXP * 1024, WSP(float, WS_TOPW)};
    pg8::gphase<pg8::EpiMoeDown, pg8::MoeOrder, false, true>(lds, S, E);
}

constexpr int ATT_NT = 68;
constexpr float ATT_QSCALE = 0.17677669529663687f * 1.4426950408889634f;
__device__ __forceinline__ void d_prep_attn(KP kp) {
    PH_IDS;
    const bf16_t* PB = WSP(bf16_t, WS_PBUF);
    GT_LOOP(idx, MALL * 16) {
        const int row = idx >> 4, hm = (idx >> 1) & 7, ks = idx & 1, h = hm >> 1, m = hm & 1;
        const bool lat = row < NLAT; const int t = row & (SEQ - 1);
        const int ipos = ks == 0 ? (t >> 6) : (t & 63);
        const int cb = h * 64 + m * 32 + ks * 16;
        const pg8::u32x4* qs = (const pg8::u32x4*)(PB + (size_t)row * PW + PC_AQ + cb);
        const pg8::u32x4* ksrc = (const pg8::u32x4*)(PB + (size_t)row * PW + PC_AK + cb);
        pg8::u32x4 qa = qs[0], qb = qs[1], ka = ksrc[0], kb = ksrc[1];
        float qv[16], kv[16];
#pragma unroll
        for (int j = 0; j < 4; ++j) { qv[2 * j] = bf2f((bf16_t)(qa[j] & 0xffff)); qv[2 * j + 1] = bf2f((bf16_t)(qa[j] >> 16)); qv[8 + 2 * j] = bf2f((bf16_t)(qb[j] & 0xffff)); qv[9 + 2 * j] = bf2f((bf16_t)(qb[j] >> 16));
                                      kv[2 * j] = bf2f((bf16_t)(ka[j] & 0xffff)); kv[2 * j + 1] = bf2f((bf16_t)(ka[j] >> 16)); kv[8 + 2 * j] = bf2f((bf16_t)(kb[j] & 0xffff)); kv[9 + 2 * j] = bf2f((bf16_t)(kb[j] >> 16)); }
        float qo[16], ko[16];
#pragma unroll
        for (int j = 0; j < 8; ++j) {
            float cs = 1.f, sn = 0.f;
            if (lat) { const float* tb = WSP(float, WS_ROPE) + (ipos * 8 + j) * 2; cs = tb[0]; sn = tb[1]; }
            qo[j] = qv[j] * cs - qv[j + 8] * sn; qo[j + 8] = qv[j + 8] * cs + qv[j] * sn;
            ko[j] = kv[j] * cs - kv[j + 8] * sn; ko[j + 8] = kv[j + 8] * cs + kv[j] * sn;
        }
        pg8::u32x4 o0, o1;
#pragma unroll
        for (int j = 0; j < 4; ++j) { o0[j] = pk2(qo[2 * j] * ATT_QSCALE, qo[2 * j + 1] * ATT_QSCALE); o1[j] = pk2(qo[8 + 2 * j] * ATT_QSCALE, qo[9 + 2 * j] * ATT_QSCALE); }
        pg8::u32x4* qd = (pg8::u32x4*)(WSP(bf16_t, WS_QRP) + (size_t)row * 256 + cb); qd[0] = o0; qd[1] = o1;
#pragma unroll
        for (int j = 0; j < 4; ++j) { o0[j] = pk2(ko[2 * j], ko[2 * j + 1]); o1[j] = pk2(ko[8 + 2 * j], ko[9 + 2 * j]); }
        int b, tile, key; if (lat) { b = row >> 12; tile = t >> 6; key = t & 63; } else { const int r = row - NLAT; b = r >> 8; tile = 64 + ((r & 255) >> 6); key = r & 63; }
        unsigned char* img = WSP(unsigned char, WS_KIMG) + ((size_t)(b * 4 + h) * ATT_NT + tile) * 8192 + key * 128;
        const int c0 = m * 4 + ks * 2, sw = (key >> 1) & 7;
        *(pg8::u32x4*)(img + 16 * (c0 ^ sw)) = o0; *(pg8::u32x4*)(img + 16 * ((c0 + 1) ^ sw)) = o1;
    }
    GT_LOOP(idx, 16 * ATT_NT * 2 * 64) {
        const int d = idx & 63, half = (idx >> 6) & 1, tile = (idx >> 7) % ATT_NT, bh = idx / (128 * ATT_NT), b = bh >> 2, h = bh & 3;
        const int row0 = (tile < 64 ? b * SEQ + tile * 64 : NLAT + b * CTXL + (tile - 64) * 64) + half * 32;
        const bf16_t* vp = PB + (size_t)row0 * PW + PC_AV + h * 64 + d;
        unsigned short vv[32];
#pragma unroll
        for (int j = 0; j < 32; ++j) vv[j] = vp[(size_t)j * PW];
        unsigned char* img = WSP(unsigned char, WS_VIMG) + ((size_t)bh * ATT_NT + tile) * 8192 + d * 128; const int x = (d >> 1) & 15;
#pragma unroll
        for (int j = 0; j < 8; ++j) *(pg8::u32x2*)(img + 8 * ((half * 8 + j) ^ x)) = (pg8::u32x2){(unsigned)vv[4 * j] | ((unsigned)vv[4 * j + 1] << 16), (unsigned)vv[4 * j + 2] | ((unsigned)vv[4 * j + 3] << 16)};
    }
}

namespace att {
typedef short bf16x8 __attribute__((ext_vector_type(8)));
typedef float f32x16 __attribute__((ext_vector_type(16)));
typedef unsigned u32x4 __attribute__((ext_vector_type(4)));
typedef unsigned u32x2 __attribute__((ext_vector_type(2)));
constexpr int SLOT = 8192, NSLOT = 4, LDS_K = 0, LDS_V = NSLOT * SLOT, LDS_SCR = 2 * NSLOT * SLOT;
constexpr float THR = 8.f;
__device__ __forceinline__ int crow(int r, int hi) { return (r & 3) + 8 * (r >> 2) + 4 * hi; }
__device__ __forceinline__ unsigned cvtpk(float lo, float hi) { return cvtpk_rne(lo, hi); }
__device__ __forceinline__ float xhalf_max(float v) { return fmaxf(v, __shfl_xor(v, 32)); }
}
__device__ __forceinline__ void attn_unit(KP kp, int l, int b, int h, int qt, LAS unsigned char* lds, float lam, float lam_init, int tid) {
    using namespace att;
    const int lane = tid & 63, wid = __builtin_amdgcn_readfirstlane(tid >> 6), q32 = lane & 31, hi = lane >> 5;
    const int t0 = qt < 0 ? 64 : 0, t1 = ATT_NT;
    const int rowbase = (qt < 0 ? NLAT + b * CTXL : b * SEQ + qt * 256) + wid * 32;
    const unsigned char* kimg = WSP(unsigned char, WS_KIMG) + (size_t)(b * 4 + h) * ATT_NT * 8192 + wid * 1024 + lane * 16;
    const unsigned char* vimg = WSP(unsigned char, WS_VIMG) + (size_t)(b * 4 + h) * ATT_NT * 8192 + wid * 1024 + lane * 16;
    LAS float* scr = (LAS float*)(lds + LDS_SCR) + wid * 64;
#define ATT_DMA(t, slot) do { __builtin_amdgcn_global_load_lds((const unsigned*)(kimg + (size_t)(t) * 8192), (LAS unsigned*)(lds + LDS_K + (slot) * SLOT + wid * 1024), 16, 0, 0); \
                              __builtin_amdgcn_global_load_lds((const unsigned*)(vimg + (size_t)(t) * 8192), (LAS unsigned*)(lds + LDS_V + (slot) * SLOT + wid * 1024), 16, 0, 0); } while (0)
    bf16x8 qf[2][2];
    { const bf16_t* qp = WSP(bf16_t, WS_QRP) + (size_t)(rowbase + q32) * 256 + h * 64 + hi * 8;
#pragma unroll
      for (int m = 0; m < 2; ++m)
#pragma unroll
        for (int ks = 0; ks < 2; ++ks) qf[m][ks] = *(const bf16x8*)(qp + m * 32 + ks * 16); }
    asm volatile("s_waitcnt vmcnt(0)" ::: "memory");
    __builtin_amdgcn_s_barrier();
    ATT_DMA(t0, 0); ATT_DMA(t0 + 1, 1); ATT_DMA(t0 + 2, 2);
    asm volatile("s_waitcnt vmcnt(4)" ::: "memory");
    __builtin_amdgcn_s_barrier();
    f32x16 O[2][2];
#pragma unroll
    for (int m = 0; m < 2; ++m)
#pragma unroll
        for (int dh = 0; dh < 2; ++dh)
#pragma unroll
            for (int r = 0; r < 16; ++r) O[m][dh][r] = 0.f;
    float mref[2] = {0.f, 0.f}, lsum[2] = {0.f, 0.f};
    const int koff = q32 * 128, ksw = (q32 >> 1) & 7;
    int slot = 0;
#pragma unroll 1
    for (int t = t0; t < t1; ++t) {
        asm volatile("s_waitcnt vmcnt(0)" ::: "memory");
        __builtin_amdgcn_s_barrier();
        asm volatile("" ::: "memory");
        if (t + 3 < t1) { const int s3 = (slot + 3) & 3; ATT_DMA(t + 3, s3); }
        const LAS unsigned char* Ks = lds + LDS_K + slot * SLOT; const LAS unsigned char* Vs = lds + LDS_V + slot * SLOT;
        u32x4 ppk[2][2][2];
#pragma unroll
        for (int m = 0; m < 2; ++m) {
            f32x16 S[2];
            { const float nm = -mref[m];
#pragma unroll
              for (int r = 0; r < 16; ++r) { S[0][r] = nm; S[1][r] = nm; } }
#pragma unroll
            for (int kh = 0; kh < 2; ++kh)
#pragma unroll
                for (int ks = 0; ks < 2; ++ks) {
                    const bf16x8 kf = *(const LAS bf16x8*)(Ks + kh * 4096 + koff + 16 * ((m * 4 + ks * 2 + hi) ^ ksw));
                    S[kh] = __builtin_amdgcn_mfma_f32_32x32x16_bf16(kf, qf[m][ks], S[kh], 0, 0, 0);
                }
            float mx = fmaxf(S[0][0], S[1][0]);
#pragma unroll
            for (int r = 1; r < 16; ++r) mx = fmaxf(mx, fmaxf(S[0][r], S[1][r]));
            mx = xhalf_max(mx);
            const bool first = (t == t0);
            if (__any(first || mx > THR)) {
                const float dl = first ? mx : fmaxf(mx, 0.f);
                mref[m] += dl;
#pragma unroll
                for (int r = 0; r < 16; ++r) { S[0][r] -= dl; S[1][r] -= dl; }
                const float f = __builtin_amdgcn_exp2f(-dl);
                lsum[m] *= f;
                if (!first) {
                    if (hi == 0) scr[q32] = f;
                    asm volatile("s_waitcnt lgkmcnt(0)" ::: "memory");
#pragma unroll
                    for (int r = 0; r < 16; ++r) { const float fr = scr[crow(r, hi)]; O[m][0][r] *= fr; O[m][1][r] *= fr; }
                    asm volatile("s_waitcnt lgkmcnt(0)" ::: "memory");
                }
            }
            float ls = 0.f;
#pragma unroll
            for (int kh = 0; kh < 2; ++kh) {
#pragma unroll
                for (int r = 0; r < 16; ++r) { S[kh][r] = __builtin_amdgcn_exp2f(S[kh][r]); ls += S[kh][r]; }
#pragma unroll
                for (int s = 0; s < 2; ++s)
#pragma unroll
                    for (int j = 0; j < 4; ++j) ppk[m][kh][s][j] = cvtpk(S[kh][8 * s + 2 * j], S[kh][8 * s + 2 * j + 1]);
            }
            lsum[m] += ls;
        }
#pragma unroll
        for (int kh = 0; kh < 2; ++kh)
#pragma unroll
            for (int s = 0; s < 2; ++s)
#pragma unroll
                for (int dh = 0; dh < 2; ++dh) {
                    const int d = dh * 32 + q32, kc = 8 * kh + 4 * s + hi, vsw = (d >> 1) & 15;
                    const u32x2 v0 = *(const LAS u32x2*)(Vs + d * 128 + 8 * (kc ^ vsw)), v1 = *(const LAS u32x2*)(Vs + d * 128 + 8 * ((kc + 2) ^ vsw));
                    const u32x4 vv = (u32x4){v0.x, v0.y, v1.x, v1.y};
                    const bf16x8 vf = __builtin_bit_cast(bf16x8, vv);
#pragma unroll
                    for (int m = 0; m < 2; ++m) O[m][dh] = __builtin_amdgcn_mfma_f32_32x32x16_bf16(__builtin_bit_cast(bf16x8, ppk[m][kh][s]), vf, O[m][dh], 0, 0, 0);
                }
        asm volatile("s_waitcnt lgkmcnt(0)" ::: "memory");
        slot = (slot + 1) & 3;
    }
#undef ATT_DMA
    float il[2][16];
#pragma unroll
    for (int m = 0; m < 2; ++m) { const float lt = lsum[m] + __shfl_xor(lsum[m], 32); if (hi == 0) scr[m * 32 + q32] = 1.f / lt; }
    asm volatile("s_waitcnt lgkmcnt(0)" ::: "memory");
#pragma unroll
    for (int m = 0; m < 2; ++m)
#pragma unroll
        for (int r = 0; r < 16; ++r) il[m][r] = scr[m * 32 + crow(r, hi)];
    asm volatile("s_waitcnt lgkmcnt(0)" ::: "memory");
    const float g0 = p.diff_subln_g[l * 64 + q32] * (1.f - lam_init), g1 = p.diff_subln_g[l * 64 + 32 + q32] * (1.f - lam_init);
    bf16_t* outp = WSP(bf16_t, WS_CONCAT) + (size_t)rowbase * D + h * 64 + q32;
#pragma unroll
    for (int r = 0; r < 16; ++r) {
        const float o0 = O[0][0][r] * il[0][r] - lam * O[1][0][r] * il[1][r], o1 = O[0][1][r] * il[0][r] - lam * O[1][1][r] * il[1][r];
        float ss = o0 * o0 + o1 * o1;
#pragma unroll
        for (int x = 1; x < 32; x <<= 1) ss += __shfl_xor(ss, x);
        const float rstd = rsqrtf(ss * (1.f / 64.f) + EPS);
        bf16_t* op = outp + (size_t)crow(r, hi) * D;
        op[0] = f2bf(o0 * rstd * g0); op[32] = f2bf(o1 * rstd * g1);
    }
}
__device__ __forceinline__ void d_attn_fast(KP kp, int l, LAS unsigned char* lds) {
    PH_IDS;
    const float* dl = p.diff_lambda + l * 4 * 32;
    float s1 = 0.f, s2 = 0.f;
    for (int i = 0; i < 32; ++i) { s1 += dl[i] * dl[32 + i]; s2 += dl[64 + i] * dl[96 + i]; }
    const float lam_init = 0.8f - 0.6f * expf(-0.3f * (float)l);
    const float lam = expf(s1) - expf(s2) + lam_init;
    const int G = gridDim.x, vb = (G % 8 == 0) ? (bid % 8) * (G / 8) + bid / 8 : bid;
    const int nunits = 256 + (l == 0 ? 16 : 0);
    for (int u = vb; u < nunits; u += G) {
        if (u < 256) attn_unit(kp, l, u >> 6, (u >> 4) & 3, u & 15, lds, lam, lam_init, tid);
        else attn_unit(kp, l, (u - 256) >> 2, (u - 256) & 3, -1, lds, lam, lam_init, tid);
    }
    __syncthreads();
}

constexpr int NCHUNK = MALL / 64;
__device__ __forceinline__ float logsig16(float x) { const float y = __builtin_amdgcn_exp2f(-fabsf(x) * 1.4426950408889634f); return (fminf(x, 0.f) - __builtin_amdgcn_logf(1.f + y) * 0.6931471805599453f) * (1.f / 16.f); }
__device__ __forceinline__ void d_prep_scan(KP kp) {
    PH_IDS;
    const bf16_t* PB = WSP(bf16_t, WS_PBUF);
    GT_LOOP(idx, 8 * MALL) {
        const int row = idx % MALL, hk = idx / MALL, h = hk >> 1, ks = hk & 1;
        const bool lat = row < NLAT; const int t = row & (SEQ - 1);
        const int ipos = ks == 0 ? (t >> 6) : (t & 63);
        const int cb = h * 64 + ks * 32;
        const pg8::u32x4* qs = (const pg8::u32x4*)(PB + (size_t)row * PW + PC_RQ + cb);
        const pg8::u32x4* ksrc = (const pg8::u32x4*)(PB + (size_t)row * PW + PC_RK + cb);
        float qv[32], kv[32];
#pragma unroll
        for (int c4 = 0; c4 < 4; ++c4) { const pg8::u32x4 a = qs[c4], b4 = ksrc[c4];
#pragma unroll
            for (int j = 0; j < 4; ++j) { qv[c4 * 8 + 2 * j] = bf2f((bf16_t)(a[j] & 0xffff)); qv[c4 * 8 + 2 * j + 1] = bf2f((bf16_t)(a[j] >> 16)); kv[c4 * 8 + 2 * j] = bf2f((bf16_t)(b4[j] & 0xffff)); kv[c4 * 8 + 2 * j + 1] = bf2f((bf16_t)(b4[j] >> 16)); } }
        float qo[32], ko[32];
#pragma unroll
        for (int j = 0; j < 16; ++j) {
            float cs = 1.f, sn = 0.f;
            if (lat) { const float* tb = WSP(float, WS_ROPE) + 1024 + (ipos * 16 + j) * 2; cs = tb[0]; sn = tb[1]; }
            qo[j] = qv[j] * cs - qv[j + 16] * sn; qo[j + 16] = qv[j + 16] * cs + qv[j] * sn;
            ko[j] = (kv[j] * cs - kv[j + 16] * sn) * 0.125f; ko[j + 16] = (kv[j + 16] * cs + kv[j] * sn) * 0.125f;
        }
        pg8::u32x4* qd = (pg8::u32x4*)(WSP(bf16_t, WS_QF_R) + (size_t)row * 256 + cb); pg8::u32x4* kd = (pg8::u32x4*)(WSP(bf16_t, WS_KF_R) + (size_t)row * 256 + cb);
#pragma unroll
        for (int c4 = 0; c4 < 4; ++c4) { pg8::u32x4 a, b4;
#pragma unroll
            for (int j = 0; j < 4; ++j) { a[j] = pk2(qo[c4 * 8 + 2 * j], qo[c4 * 8 + 2 * j + 1]); b4[j] = pk2(ko[c4 * 8 + 2 * j], ko[c4 * 8 + 2 * j + 1]); }
            qd[c4] = a; kd[c4] = b4; }
        bf16_t* kt = WSP(bf16_t, WS_KT_R) + ((size_t)((row >> 6) * 4 + h) * 64 + ks * 32) * 64 + (row & 63);
#pragma unroll
        for (int i = 0; i < 32; ++i) kt[(size_t)i * 64] = f2bf(ko[i]);
    }
    GT_LOOP(idx, 4 * MALL) {
        const int row = idx % MALL, h = idx / MALL;
        const pg8::u32x4* ksrc = (const pg8::u32x4*)(PB + (size_t)row * PW + PC_GK + h * 32);
        bf16_t* kt = WSP(bf16_t, WS_KT_G) + ((size_t)((row >> 6) * 4 + h) * 32) * 64 + (row & 63);
#pragma unroll
        for (int c4 = 0; c4 < 4; ++c4) { const pg8::u32x4 a = ksrc[c4];
#pragma unroll
            for (int j = 0; j < 4; ++j) { kt[(size_t)(c4 * 8 + 2 * j) * 64] = (bf16_t)(a[j] & 0xffff); kt[(size_t)(c4 * 8 + 2 * j + 1) * 64] = (bf16_t)(a[j] >> 16); } }
    }
    GT_LOOP(idx, NCHUNK * 2 * 128) {
        const int hk = idx & 127, dir = (idx >> 7) & 1, cid = idx >> 8;
        const bf16_t* src = PB + (size_t)(cid * 64) * PW + PC_GD + dir * 128 + hk;
        float* cum = WSP(float, WS_CUM_G) + ((size_t)dir * MALL + cid * 64) * 128 + hk;
        float* cumt = WSP(float, WS_CUMT_G) + (((size_t)dir * NCHUNK + cid) * 128 + hk) * 64;
        float v[64];
#pragma unroll
        for (int j = 0; j < 64; ++j) v[j] = bf2f(src[(size_t)j * PW]);
#pragma unroll
        for (int j = 0; j < 64; ++j) v[j] = logsig16(v[j]);
        if (dir == 0) {
#pragma unroll
            for (int j = 1; j < 64; ++j) v[j] += v[j - 1];
        } else {
#pragma unroll
            for (int j = 62; j >= 0; --j) v[j] += v[j + 1];
        }
#pragma unroll
        for (int j = 0; j < 64; ++j) cum[(size_t)j * 128] = v[j];
#pragma unroll
        for (int j = 0; j < 16; ++j) *(pg8::f32x4*)(cumt + 4 * j) = (pg8::f32x4){v[4 * j], v[4 * j + 1], v[4 * j + 2], v[4 * j + 3]};
    }
    GT_LOOP(idx, 2 * NCHUNK * 4 * 2 * 64) {
        const int d = idx & 63, half = (idx >> 6) & 1, ch = (idx >> 7) % (NCHUNK * 4), mx = idx / (128 * NCHUNK * 4), h = ch & 3, cid = ch >> 2;
        const bf16_t* vp = PB + (size_t)(cid * 64 + half * 32) * PW + (mx == 0 ? PC_RV : PC_GV) + h * 64 + d;
        unsigned short vv[32];
#pragma unroll
        for (int j = 0; j < 32; ++j) vv[j] = vp[(size_t)j * PW];
        unsigned char* img = WSP(unsigned char, mx == 0 ? WS_VT_R : WS_VT_G) + (size_t)ch * 8192 + d * 128; const int x = (d >> 1) & 15;
#pragma unroll
        for (int j = 0; j < 8; ++j) *(pg8::u32x2*)(img + 8 * ((half * 8 + j) ^ x)) = (pg8::u32x2){(unsigned)vv[4 * j] | ((unsigned)vv[4 * j + 1] << 16), (unsigned)vv[4 * j + 2] | ((unsigned)vv[4 * j + 3] << 16)};
    }
}

namespace scn {
typedef short bf16x8 __attribute__((ext_vector_type(8)));
typedef float f32x16 __attribute__((ext_vector_type(16)));
typedef float f32x4 __attribute__((ext_vector_type(4)));
typedef unsigned u32x4 __attribute__((ext_vector_type(4)));
typedef unsigned u32x2 __attribute__((ext_vector_type(2)));
__device__ __forceinline__ int crow(int r, int hi) { return (r & 3) + 8 * (r >> 2) + 4 * hi; }
__device__ __forceinline__ unsigned cvtpk(float lo, float hi) { return cvtpk_rne(lo, hi); }
__device__ __forceinline__ float blo(unsigned w) { return __uint_as_float(w << 16); }
__device__ __forceinline__ float bhi(unsigned w) { return __uint_as_float(w & 0xffff0000u); }
__device__ __forceinline__ bf16x8 scale8(u32x4 raw, const float (&f)[8]) {
    u32x4 o;
#pragma unroll
    for (int j = 0; j < 4; ++j) o[j] = cvtpk(blo(raw[j]) * f[2 * j], bhi(raw[j]) * f[2 * j + 1]);
    return __builtin_bit_cast(bf16x8, o);
}
template <int MX> struct Cfg;
template <> struct Cfg<0> { static constexpr int DK = 64; };
template <> struct Cfg<1> { static constexpr int DK = 32; };
}
#define SCN_EXP(x) __builtin_amdgcn_exp2f((x) * 1.4426950408889634f)
template <int MX> __device__ __forceinline__ void scan_stage1_unit(KP kp, int l, int b, int h, int g, int tid) {
    using namespace scn;
    constexpr int DK = Cfg<MX>::DK, NKT = DK / 32, NE = DK * 64 / NT;
    const int lane = tid & 63, wid = __builtin_amdgcn_readfirstlane(tid >> 6), q32 = lane & 31, hi = lane >> 5;
    const int nch = g == 8 ? 4 : 8, cid0 = g == 8 ? 256 + 4 * b : b * 64 + 8 * g;
    float* US = WSP(float, MX == 0 ? WS_US_R : WS_US_G);
    const float* CUMT = WSP(float, WS_CUMT_G);
    if (wid < nch) {
        const int cid = cid0 + wid;
        const unsigned char* vimg = WSP(unsigned char, MX == 0 ? WS_VT_R : WS_VT_G) + (size_t)(cid * 4 + h) * 8192;
        const bf16_t* ktimg = WSP(bf16_t, MX == 0 ? WS_KT_R : WS_KT_G) + (size_t)(cid * 4 + h) * DK * 64;
        bf16x8 vb[2][4];
#pragma unroll
        for (int dh = 0; dh < 2; ++dh)
#pragma unroll
            for (int s = 0; s < 4; ++s) { const int d = dh * 32 + q32, x = (d >> 1) & 15, kc = 4 * s + 2 * hi;
                u32x4 v = *(const u32x4*)(vimg + d * 128 + 16 * ((kc ^ x) >> 1));
                if (x & 1) v = (u32x4){v.z, v.w, v.x, v.y};
                vb[dh][s] = __builtin_bit_cast(bf16x8, v); }
#pragma unroll 1
        for (int dir = 0; dir < 2; ++dir) {
            float lg = 0.f; if (MX == 0) lg = -expf(p.ret_decay[(l * 2 + dir) * 4 + h]);
#pragma unroll 1
            for (int kt = 0; kt < NKT; ++kt) {
                f32x16 U[2];
#pragma unroll
                for (int dh = 0; dh < 2; ++dh)
#pragma unroll
                    for (int r = 0; r < 16; ++r) U[dh][r] = 0.f;
                const int k = kt * 32 + q32;
                const float* ct = CUMT + (((size_t)dir * NCHUNK + cid) * 128 + h * 32 + (k & 31)) * 64;
                float E = 0.f; if (MX == 1) E = ct[dir == 0 ? 63 : 0];
#pragma unroll
                for (int s = 0; s < 4; ++s) {
                    const int j0 = 16 * s + 8 * hi;
                    const u32x4 raw = *(const u32x4*)(ktimg + (size_t)k * 64 + j0);
                    float f[8];
                    if (MX == 0) {
#pragma unroll
                        for (int jj = 0; jj < 8; ++jj) f[jj] = SCN_EXP(lg * (float)(dir == 0 ? 63 - (j0 + jj) : j0 + jj));
                    } else {
                        const f32x4 c0 = *(const f32x4*)(ct + j0), c1 = *(const f32x4*)(ct + j0 + 4);
#pragma unroll
                        for (int jj = 0; jj < 4; ++jj) { f[jj] = SCN_EXP(E - c0[jj]); f[4 + jj] = SCN_EXP(E - c1[jj]); }
                    }
                    const bf16x8 af = scale8(raw, f);
#pragma unroll
                    for (int dh = 0; dh < 2; ++dh) U[dh] = __builtin_amdgcn_mfma_f32_32x32x16_bf16(af, vb[dh][s], U[dh], 0, 0, 0);
                }
                float* up = US + ((((size_t)dir * NCHUNK + cid) * 4 + h) * DK + kt * 32 + 4 * hi) * 64 + q32;
#pragma unroll
                for (int dh = 0; dh < 2; ++dh)
#pragma unroll
                    for (int r = 0; r < 16; ++r) up[((r & 3) + 8 * (r >> 2)) * 64 + dh * 32] = U[dh][r];
            }
        }
    }
    asm volatile("s_waitcnt vmcnt(0)" ::: "memory");
    __syncthreads();
    const int k = (tid * NE) >> 6, d0 = (tid * NE) & 63;
#pragma unroll
    for (int dir = 0; dir < 2; ++dir) {
        float S[NE], Ap = 1.f;
#pragma unroll
        for (int e = 0; e < NE; ++e) S[e] = 0.f;
        float lg = 0.f; if (MX == 0) lg = -expf(p.ret_decay[(l * 2 + dir) * 4 + h]);
        for (int cc = 0; cc < nch; ++cc) {
            const int c = dir == 0 ? cc : nch - 1 - cc, cid = cid0 + c;
            float A;
            if (MX == 0) A = SCN_EXP(lg * 64.f); else A = SCN_EXP(CUMT[(((size_t)dir * NCHUNK + cid) * 128 + h * 32 + k) * 64 + (dir == 0 ? 63 : 0)]);
            const float* up = US + ((((size_t)dir * NCHUNK + cid) * 4 + h) * DK + k) * 64 + d0;
#pragma unroll
            for (int e = 0; e < NE; ++e) S[e] = A * S[e] + up[e];
            Ap *= A;
        }
        float* ug = WSP(float, MX == 0 ? WS_UG_R : WS_UG_G) + (((((size_t)dir * 4 + b) * 4 + h) * 9 + g) * DK + k) * 64 + d0;
#pragma unroll
        for (int e = 0; e < NE; ++e) ug[e] = S[e];
        if (d0 == 0) WSP(float, WS_AG)[((((MX * 2 + dir) * 4 + b) * 4 + h) * 9 + g) * 64 + k] = Ap;
    }
}
template <int MX> __device__ __forceinline__ void scan_stage2_unit(KP kp, int l, int b, int h, int g, LAS unsigned char* lds, int tid) {
    using namespace scn;
    constexpr int DK = Cfg<MX>::DK, NKS = DK / 16, NE = DK * 64 / NT, NCH16 = DK / 8;
    const int lane = tid & 63, wid = __builtin_amdgcn_readfirstlane(tid >> 6), q32 = lane & 31, hi = lane >> 5;
    const int nch = g == 8 ? 4 : 8, cid0 = g == 8 ? 256 + 4 * b : b * 64 + 8 * g;
    const bool act = wid < nch;
    const int cid = cid0 + (act ? wid : 0), row0 = cid * 64;
    const bf16_t* PB = WSP(bf16_t, WS_PBUF);
    const float* US = WSP(float, MX == 0 ? WS_US_R : WS_US_G);
    const float* UG = WSP(float, MX == 0 ? WS_UG_R : WS_UG_G);
    const float* CUMT = WSP(float, WS_CUMT_G);
    f32x16 o[2][2];
#pragma unroll
    for (int it = 0; it < 2; ++it)
#pragma unroll
        for (int dh = 0; dh < 2; ++dh)
#pragma unroll
            for (int r = 0; r < 16; ++r) o[it][dh][r] = 0.f;
    LAS unsigned char* myv = lds + 65536 + wid * 8192;
    { const unsigned char* vimg = WSP(unsigned char, MX == 0 ? WS_VT_R : WS_VT_G) + (size_t)(cid * 4 + h) * 8192 + lane * 16;
      u32x4 tmp[8];
#pragma unroll
      for (int i = 0; i < 8; ++i) tmp[i] = *(const u32x4*)(vimg + i * 1024);
#pragma unroll
      for (int i = 0; i < 8; ++i) *(LAS u32x4*)(myv + i * 1024 + lane * 16) = tmp[i]; }
    const int fk = (tid * NE) >> 6, fd0 = (tid * NE) & 63;
#pragma unroll 1
    for (int dir = 0; dir < 2; ++dir) {
        float lg = 0.f; if (MX == 0) lg = -expf(p.ret_decay[(l * 2 + dir) * 4 + h]);
        float S[NE];
#pragma unroll
        for (int e = 0; e < NE; ++e) S[e] = 0.f;
        if (g != 8) {
            const float* ugb = UG + (((size_t)dir * 4 + b) * 4 + h) * 9 * DK * 64 + (size_t)fk * 64 + fd0;
            const float* agb = WSP(float, WS_AG) + (((MX * 2 + dir) * 4 + b) * 4 + h) * 9 * 64 + fk;
            const int ng = dir == 0 ? g : 7 - g;
            float ug[7][NE], ag[7];
#pragma unroll
            for (int e = 0; e < NE; ++e) S[e] = ugb[(size_t)8 * DK * 64 + e];
#pragma unroll
            for (int q = 0; q < 7; ++q) { const int gg = dir == 0 ? q : 7 - q; const bool on = q < ng; ag[q] = on ? agb[gg * 64] : 1.f;
#pragma unroll
                for (int e = 0; e < NE; ++e) ug[q][e] = on ? ugb[(size_t)gg * DK * 64 + e] : 0.f; }
#pragma unroll
            for (int q = 0; q < 7; ++q)
#pragma unroll
                for (int e = 0; e < NE; ++e) S[e] = ag[q] * S[e] + ug[q][e];
        }
        {
            float uc[8][NE], ac[8];
#pragma unroll
            for (int cc = 0; cc < 8; ++cc) { const bool on = cc < nch; const int c = dir == 0 ? cc : nch - 1 - cc, ccid = cid0 + (on ? c : 0);
                if (MX == 0) ac[cc] = SCN_EXP(lg * 64.f); else ac[cc] = SCN_EXP(CUMT[(((size_t)dir * NCHUNK + ccid) * 128 + h * 32 + fk) * 64 + (dir == 0 ? 63 : 0)]);
                const float* up = US + ((((size_t)dir * NCHUNK + ccid) * 4 + h) * DK + fk) * 64 + fd0;
#pragma unroll
                for (int e = 0; e < NE; ++e) uc[cc][e] = up[e]; }
#pragma unroll
            for (int cc = 0; cc < 8; ++cc) if (cc < nch) {
                const int c = dir == 0 ? cc : nch - 1 - cc;
                LAS unsigned char* area = lds + c * 8192;
#pragma unroll
                for (int e = 0; e < NE; ++e) { const int d = fd0 + e; const int sw = DK == 64 ? ((d >> 1) & 7) : ((d >> 2) & 3);
                    *(LAS bf16_t*)(area + d * (DK * 2) + 16 * ((fk >> 3) ^ sw) + (fk & 7) * 2) = f2bf(S[e]); }
#pragma unroll
                for (int e = 0; e < NE; ++e) S[e] = ac[cc] * S[e] + uc[cc][e];
            }
        }
        asm volatile("s_waitcnt lgkmcnt(0)" ::: "memory");
        __syncthreads();
        if (act) {
#define SCN_GEN(dst, ISQ, T2) do { const int il_ = 32 * (T2) + q32, row_ = row0 + il_; \
                _Pragma("unroll") for (int ks = 0; ks < NKS; ++ks) { const int kc0 = 16 * ks + 8 * hi; u32x4 raw_; float f_[8]; \
                    if (MX == 0) { raw_ = *(const u32x4*)(WSP(bf16_t, (ISQ) ? WS_QF_R : WS_KF_R) + (size_t)row_ * 256 + h * 64 + kc0); \
                        const float cm_ = lg * (float)(dir == 0 ? il_ + 1 : 64 - il_), e_ = SCN_EXP((ISQ) ? cm_ : -cm_); \
                        _Pragma("unroll") for (int jj = 0; jj < 8; ++jj) f_[jj] = e_; \
                    } else { raw_ = *(const u32x4*)(PB + (size_t)row_ * PW + ((ISQ) ? PC_GQ : PC_GK) + h * 32 + kc0); \
                        const float* cp_ = WSP(float, WS_CUM_G) + ((size_t)dir * MALL + row_) * 128 + h * 32 + kc0; \
                        const f32x4 c0_ = *(const f32x4*)cp_, c1_ = *(const f32x4*)(cp_ + 4); \
                        _Pragma("unroll") for (int jj = 0; jj < 4; ++jj) { f_[jj] = (ISQ) ? SCN_EXP(c0_[jj]) * 0.17677669529663687f : SCN_EXP(-c0_[jj]); f_[4 + jj] = (ISQ) ? SCN_EXP(c1_[jj]) * 0.17677669529663687f : SCN_EXP(-c1_[jj]); } } \
                    dst[ks] = scale8(raw_, f_); } } while (0)
#define SCN_TILE(JT, IT, MASKED) do { bf16x8 kf_[NKS]; SCN_GEN(kf_, false, JT); f32x16 P; \
                _Pragma("unroll") for (int r = 0; r < 16; ++r) P[r] = 0.f; \
                _Pragma("unroll") for (int ks = 0; ks < NKS; ++ks) P = __builtin_amdgcn_mfma_f32_32x32x16_bf16(kf_[ks], qf[ks], P, 0, 0, 0); \
                if (MASKED) { _Pragma("unroll") for (int r = 0; r < 16; ++r) { const int j = crow(r, hi); const bool keep = dir == 0 ? (j <= q32) : (j >= q32); P[r] = keep ? P[r] : 0.f; } } \
                _Pragma("unroll") for (int s = 0; s < 2; ++s) { u32x4 pk; \
                    _Pragma("unroll") for (int j = 0; j < 4; ++j) pk[j] = cvtpk(P[8 * s + 2 * j], P[8 * s + 2 * j + 1]); \
                    _Pragma("unroll") for (int dh = 0; dh < 2; ++dh) { const int d = dh * 32 + q32, x = (d >> 1) & 15, kc = 8 * JT + 4 * s + hi; \
                        const u32x2 v0 = *(const LAS u32x2*)(myv + d * 128 + 8 * (kc ^ x)), v1 = *(const LAS u32x2*)(myv + d * 128 + 8 * ((kc + 2) ^ x)); \
                        o[IT][dh] = __builtin_amdgcn_mfma_f32_32x32x16_bf16(__builtin_bit_cast(bf16x8, pk), __builtin_bit_cast(bf16x8, (u32x4){v0.x, v0.y, v1.x, v1.y}), o[IT][dh], 0, 0, 0); } } } while (0)
#define SCN_INTER(IT) do { const LAS unsigned char* area = lds + wid * 8192; \
                _Pragma("unroll") for (int dh = 0; dh < 2; ++dh) _Pragma("unroll") for (int ks = 0; ks < NKS; ++ks) { \
                    const int d = dh * 32 + q32, sw = DK == 64 ? ((d >> 1) & 7) : ((d >> 2) & 3); \
                    const bf16x8 sf = *(const LAS bf16x8*)(area + d * (DK * 2) + 16 * ((2 * ks + hi) ^ sw)); \
                    o[IT][dh] = __builtin_amdgcn_mfma_f32_32x32x16_bf16(qf[ks], sf, o[IT][dh], 0, 0, 0); } } while (0)
            { bf16x8 qf[NKS]; SCN_GEN(qf, true, 0);
              SCN_TILE(0, 0, true); if (dir == 1) SCN_TILE(1, 0, false);
              SCN_INTER(0); }
            asm volatile("" ::: "memory");
            { bf16x8 qf[NKS]; SCN_GEN(qf, true, 1);
              if (dir == 0) SCN_TILE(0, 1, false);
              SCN_TILE(1, 1, true);
              SCN_INTER(1); }
#undef SCN_GEN
#undef SCN_TILE
#undef SCN_INTER
        }
        asm volatile("s_waitcnt lgkmcnt(0)" ::: "memory");
        __syncthreads();
    }
    if (act) {
        const int gcol = (MX == 0 ? PC_RG : PC_GR) + h * 64, ccol = (MX == 0 ? 512 : 768) + h * 64;
        const float g0 = MX == 0 ? p.ret_norm_g[l * 256 + h * 64 + q32] : p.gla_norm_g[l * 64 + q32], g1 = MX == 0 ? p.ret_norm_g[l * 256 + h * 64 + 32 + q32] : p.gla_norm_g[l * 64 + 32 + q32];
#pragma unroll
        for (int it = 0; it < 2; ++it)
#pragma unroll
            for (int r = 0; r < 16; ++r) {
                const int row = row0 + 32 * it + crow(r, hi);
                const float a0 = o[it][0][r], a1 = o[it][1][r];
                float ss = a0 * a0 + a1 * a1;
#pragma unroll
                for (int x = 1; x < 32; x <<= 1) ss += __shfl_xor(ss, x);
                const float rstd = rsqrtf(ss * (1.f / 64.f) + EPS);
                const float gt0 = bf2f(PB[(size_t)row * PW + gcol + q32]), gt1 = bf2f(PB[(size_t)row * PW + gcol + 32 + q32]);
                bf16_t* op = WSP(bf16_t, WS_CONCAT) + (size_t)row * D + ccol + q32;
                op[0] = f2bf(a0 * rstd * g0 * (gt0 / (1.f + SCN_EXP(-gt0)))); op[32] = f2bf(a1 * rstd * g1 * (gt1 / (1.f + SCN_EXP(-gt1))));
                if ((r & 3) == 3) asm volatile("" ::: "memory");
            }
    }
}
__device__ __forceinline__ void d_scan_stage1(KP kp, int l) {
    PH_IDS;
    for (int u = bid; u < 2 * 16 * 9; u += gridDim.x) {
        const int mx = u / 144, r = u % 144, bh = r / 9, g = r % 9;
        if (mx == 0) scan_stage1_unit<0>(kp, l, bh >> 2, bh & 3, g, tid); else scan_stage1_unit<1>(kp, l, bh >> 2, bh & 3, g, tid);
    }
}
__device__ __forceinline__ void d_scan_stage2(KP kp, int l, LAS unsigned char* lds) {
    PH_IDS;
    const int ng = l == 0 ? 9 : 8;
    for (int u = bid; u < 2 * 16 * ng; u += gridDim.x) {
        const int mx = u / (16 * ng), r = u % (16 * ng), bh = r / ng, g = r % ng;
        if (mx == 0) scan_stage2_unit<0>(kp, l, bh >> 2, bh & 3, g, lds, tid); else scan_stage2_unit<1>(kp, l, bh >> 2, bh & 3, g, lds, tid);
    }
}

namespace hfft {
typedef float f2 __attribute__((ext_vector_type(2)));
typedef float f4 __attribute__((ext_vector_type(4)));
constexpr int N = 8192;
__device__ __forceinline__ f2 cmul(f2 a, f2 b) { return (f2){a.x * b.x - a.y * b.y, a.x * b.y + a.y * b.x}; }
__device__ __forceinline__ f2 cmulc(f2 a, f2 b) { return (f2){a.x * b.x + a.y * b.y, a.y * b.x - a.x * b.y}; }
__device__ __forceinline__ f2 tw(float frac) { float sn, cs; sincosf(6.283185307179586f * frac, &sn, &cs); return (f2){cs, -sn}; }
constexpr int TWOFF = 131072 + 64;
__device__ __forceinline__ void tw_build(LAS unsigned char* lds, int tid) { LAS f2* T = (LAS f2*)(lds + TWOFF); for (int k = tid; k < 1024; k += NT) T[k] = tw((float)k * (1.f / 8192.f)); }
__device__ __forceinline__ f2 twk(const LAS f2* T, int k) {
    const f2 a = T[k & 1023]; const float r = 0.70710678118654752f;
    return (k & 1024) ? (f2){(a.x + a.y) * r, (a.y - a.x) * r} : a;
}
__device__ __forceinline__ f2 mul_mi(f2 a) { return (f2){a.y, -a.x}; }
__device__ __forceinline__ f2 mul_pi(f2 a) { return (f2){-a.y, a.x}; }
template <int LOGD> __device__ __forceinline__ void fwd_pass(LAS f2* buf, int tid) {
    constexpr int Dd = 1 << LOGD;
#pragma unroll
    for (int g = 0; g < 4; ++g) {
        const int u = tid + NT * g, pos = u & (Dd - 1), base = ((u - pos) << 2) + pos;
        const f2 wA = twk((const LAS f2*)((LAS unsigned char*)buf + TWOFF), pos << (11 - LOGD)), wB = cmul(wA, wA);
#pragma unroll
        for (int arr = 0; arr < 2; ++arr) {
            LAS f2* x = buf + arr * N + base;
            const f2 a0 = x[0], a1 = x[Dd], a2 = x[2 * Dd], a3 = x[3 * Dd];
            const f2 b0 = a0 + a2, b2 = cmul(a0 - a2, wA), b1 = a1 + a3, b3 = mul_mi(cmul(a1 - a3, wA));
            x[0] = b0 + b1; x[Dd] = cmul(b0 - b1, wB); x[2 * Dd] = b2 + b3; x[3 * Dd] = cmul(b2 - b3, wB);
        }
    }
    __syncthreads();
}
template <int LOGD> __device__ __forceinline__ void inv_pass(LAS f2* buf, int tid) {
    constexpr int Dd = 1 << LOGD;
#pragma unroll
    for (int g = 0; g < 4; ++g) {
        const int u = tid + NT * g, pos = u & (Dd - 1), base = ((u - pos) << 2) + pos;
        const f2 wA = twk((const LAS f2*)((LAS unsigned char*)buf + TWOFF), pos << (11 - LOGD)), wB = cmul(wA, wA);
#pragma unroll
        for (int arr = 0; arr < 2; ++arr) {
            LAS f2* x = buf + arr * N + base;
            const f2 c0 = x[0], c1 = cmulc(x[Dd], wB), c2 = x[2 * Dd], c3 = cmulc(x[3 * Dd], wB);
            const f2 b0 = c0 + c1, b1 = c0 - c1, b2 = cmulc(c2 + c3, wA), b3 = mul_pi(cmulc(c2 - c3, wA));
            x[0] = b0 + b2; x[2 * Dd] = b0 - b2; x[Dd] = b1 + b3; x[3 * Dd] = b1 - b3;
        }
    }
    __syncthreads();
}
__device__ __forceinline__ void fwd_all(LAS f2* buf, int tid) { fwd_pass<11>(buf, tid); fwd_pass<9>(buf, tid); fwd_pass<7>(buf, tid); fwd_pass<5>(buf, tid); fwd_pass<3>(buf, tid); fwd_pass<1>(buf, tid); }
__device__ __forceinline__ void inv_all(LAS f2* buf, int tid) { inv_pass<1>(buf, tid); inv_pass<3>(buf, tid); inv_pass<5>(buf, tid); inv_pass<7>(buf, tid); inv_pass<9>(buf, tid); inv_pass<11>(buf, tid); }
}
__device__ __forceinline__ void d_fspec(KP kp, LAS unsigned char* lds) {
    PH_IDS;
    using namespace hfft;
    LAS f2* buf = (LAS f2*)lds; LAS float* nrm = (LAS float*)(lds + 131072);
    tw_build(lds, tid);
    for (int u = bid; u < 256; u += gridDim.x) {
        const int l = u >> 7, c0 = (u & 127) * 2;
        const float* filt = WSP(float, WS_FILT) + (size_t)l * 8192 * 256;
        if (tid < 128) {
            const int arr = tid >> 6, ln = tid & 63; float a = 0.f;
#pragma unroll
            for (int q = 0; q < 4; ++q) a += WSP(float, WS_PS)[(size_t)(l * 256 + ln * 4 + q) * 256 + c0 + arr];
            a = wave_sum(a); if (ln == 0) nrm[arr] = a;
        }
        for (int i = tid; i < 2 * N; i += NT) { const int arr = i >> 13, tau = i & (N - 1); buf[i] = (f2){filt[(size_t)tau * 256 + c0 + arr], 0.f}; }
        __syncthreads();
        fwd_all(buf, tid);
        f4* fs = (f4*)(WSP(float, WS_FSPEC) + ((size_t)l * 256 + c0) * 2 * N);
        for (int i = tid; i < N; i += NT) {
            const int arr = i >> 12, j = i & 4095;
            const f4 v = *(const LAS f4*)(buf + arr * N + 2 * j);
            const float sc = 1.f / (8192.f * nrm[arr]), bs = p.hy_bias[l * 256 + c0 + arr] * (1.f / 8192.f);
            fs[(size_t)arr * (N / 2) + j] = (f4){(v.x + v.z) * sc + bs, (v.y + v.w) * sc, (v.x - v.z) * sc + bs, (v.y - v.w) * sc};
        }
        __syncthreads();
    }
}
__device__ __forceinline__ void d_hy_pre_fast(KP kp, int l, LAS unsigned char* lds) {
    PH_IDS;
    LAS float* zt = (LAS float*)lds;
    const bf16_t* PB = WSP(bf16_t, WS_PBUF);
    const int c = tid & 255, half = tid >> 8;
    const float* sw = p.hy_short_w + l * 3 * 768; const float* sb = p.hy_short_b + l * 768;
    float w0[3], w1[3], w2[3], bb[3];
#pragma unroll
    for (int g = 0; g < 3; ++g) { w0[g] = sw[g * 256 + c]; w1[g] = sw[768 + g * 256 + c]; w2[g] = sw[1536 + g * 256 + c]; bb[g] = sb[g * 256 + c]; }
    for (int u = bid; u < NLAT / 64; u += gridDim.x) {
        const int row0 = u * 64 + half * 32, t0 = (u * 64) & (SEQ - 1);
        const int tfirst = t0 + half * 32;
        float xin[3][34];
#pragma unroll
        for (int g = 0; g < 3; ++g) {
            const bf16_t* pp = PB + (size_t)row0 * PW + PC_HY + g * 256 + c;
#pragma unroll
            for (int i = 0; i < 34; ++i) { const int t = tfirst + i - 1; xin[g][i] = (t >= 0 && t < SEQ) ? bf2f(pp[(ptrdiff_t)(i - 1) * PW]) : 0.f; }
        }
#pragma unroll
        for (int i = 0; i < 32; ++i) {
            float uu[3];
#pragma unroll
            for (int g = 0; g < 3; ++g) uu[g] = bb[g] + w0[g] * xin[g][i] + w1[g] * xin[g][i + 1] + w2[g] * xin[g][i + 2];
            WSP(bf16_t, WS_X0B)[(size_t)(row0 + i) * 256 + c] = f2bf(uu[0]);
            zt[c * 65 + half * 32 + i] = uu[1] * uu[2];
        }
        __syncthreads();
        const int b = (u * 64) >> 12;
        for (int i = tid; i < 256 * 64; i += NT) { const int cc = i >> 6, tl = i & 63; WSP(float, WS_ZT)[((size_t)cc * 4 + b) * SEQ + t0 + tl] = zt[cc * 65 + tl]; }
        __syncthreads();
    }
    if (l == 0) {
        GT_LOOP(idx, NCTX * 256) {
            const int r = idx >> 8, cc = idx & 255, t = r & (CTXL - 1);
            const bf16_t* pp = PB + (size_t)(NLAT + r) * PW + PC_HY + cc;
            float uu[3];
#pragma unroll
            for (int g = 0; g < 3; ++g) { float a = sb[g * 256 + cc] + sw[768 + g * 256 + cc] * bf2f(pp[g * 256]);
                if (t > 0) a += sw[g * 256 + cc] * bf2f(pp[g * 256 - PW]); if (t < CTXL - 1) a += sw[1536 + g * 256 + cc] * bf2f(pp[g * 256 + PW]); uu[g] = a; }
            WSP(float, WS_X0C)[idx] = uu[0]; WSP(float, WS_ZC)[idx] = uu[1] * uu[2];
        }
    }
}
__device__ __forceinline__ void d_hy_fft(KP kp, int l, LAS unsigned char* lds) {
    PH_IDS;
    using namespace hfft;
    LAS f2* buf = (LAS f2*)lds;
    tw_build(lds, tid);
    for (int c = bid; c < 256; c += gridDim.x) {
        const float* zt = WSP(float, WS_ZT) + (size_t)c * 4 * SEQ;
        for (int i = tid; i < 2 * N; i += NT) { const int arr = i >> 13, t = i & (N - 1);
            buf[i] = t < SEQ ? (f2){zt[(size_t)(2 * arr) * SEQ + t], zt[(size_t)(2 * arr + 1) * SEQ + t]} : (f2){0.f, 0.f}; }
        __syncthreads();
        fwd_all(buf, tid);
        const f4* fs = (const f4*)(WSP(float, WS_FSPEC) + ((size_t)l * 256 + c) * 2 * N);
        for (int i = tid; i < N; i += NT) {
            const int arr = i >> 12, j = i & 4095;
            LAS f4* xp = (LAS f4*)(buf + arr * N + 2 * j);
            const f4 v = *xp; const f4 f = fs[j];
            const f2 s = cmul((f2){v.x + v.z, v.y + v.w}, (f2){f.x, f.y}), d = cmul((f2){v.x - v.z, v.y - v.w}, (f2){f.z, f.w});
            *xp = (f4){s.x + d.x, s.y + d.y, s.x - d.x, s.y - d.y};
        }
        __syncthreads();
        inv_all(buf, tid);
        float* yt = WSP(float, WS_YT) + (size_t)c * 4 * SEQ;
        for (int i = tid; i < 2 * SEQ; i += NT) { const int arr = i >> 12, t = i & (SEQ - 1); const f2 v = buf[arr * N + t];
            yt[(size_t)(2 * arr) * SEQ + t] = v.x; yt[(size_t)(2 * arr + 1) * SEQ + t] = v.y; }
        __syncthreads();
    }
}
__device__ __forceinline__ void d_hy_post(KP kp, int l, LAS unsigned char* lds) {
    PH_IDS;
    LAS float* yt = (LAS float*)lds;
    for (int u = bid; u < NLAT / 64; u += gridDim.x) {
        const int b = (u * 64) >> 12, t0 = (u * 64) & (SEQ - 1);
        for (int i = tid; i < 256 * 64; i += NT) { const int cc = i >> 6, tl = i & 63; yt[cc * 65 + tl] = WSP(float, WS_YT)[((size_t)cc * 4 + b) * SEQ + t0 + tl]; }
        __syncthreads();
        for (int i = tid; i < 64 * 256; i += NT) { const int tl = i >> 8, c = i & 255; const size_t row = (size_t)u * 64 + tl;
            WSP(bf16_t, WS_CONCAT)[row * D + 256 + c] = f2bf(bf2f(WSP(bf16_t, WS_X0B)[row * 256 + c]) * yt[c * 65 + tl]); }
        __syncthreads();
    }
    if (l == 0) {
        GT_LOOP(idx, NCTX * 256) {
            const int c = idx & 255, r = idx >> 8, t = r & (CTXL - 1), rb = r - t;
            const float* filt = WSP(float, WS_FILTC); const float* zc = WSP(float, WS_ZC);
            float nrm = 0.f;
#pragma unroll
            for (int q = 0; q < 16; ++q) nrm += WSP(float, WS_PS)[(size_t)(512 + q) * 256 + c];
            float y = 0.f;
#pragma unroll 8
            for (int s2 = 0; s2 < CTXL; ++s2) y += filt[(size_t)((t - s2) & (2 * CTXL - 1)) * 256 + c] * zc[(size_t)(rb + s2) * 256 + c];
            y = y / nrm + p.hy_bias[c] * zc[idx];
            WSP(bf16_t, WS_CONCAT)[(size_t)(NLAT + r) * D + 256 + c] = f2bf(WSP(float, WS_X0C)[idx] * y);
        }
    }
}
constexpr int CW_BAR = 32768;
__global__ void __launch_bounds__(NT, 2) mk_fwd(P kargs) {
    const KP kp0 = (KP)__builtin_amdgcn_kernarg_segment_ptr();
    KP kp = kp0;
#define LP ({ KP k_ = kp0; asm volatile("" : "+s"(k_)); k_; })
    unsigned char* const lds = g_lds;
    volatile LAS unsigned* misc = (volatile LAS unsigned*)((LAS unsigned char*)lds + LDS_MISC);
    if (threadIdx.x < 16) misc[threadIdx.x] = 0u;
    if ((threadIdx.x & 63) == 0) ((LAS int*)((LAS unsigned char*)lds + LDS_WTAB))[hw_wave_slot()] = threadIdx.x >> 6;
    __syncthreads();
    (void)xcd_barrier_post(WSP(unsigned, WS_CTL) + CW_BAR, misc);
#define GRID_BAR() do { XcdBarrier b_; { KP kp = LP; b_.bar = WSP(unsigned, WS_CTL) + CW_BAR; } b_.x = xb_xcc_id(); b_.st = (volatile LAS unsigned*)((LAS unsigned char*)lds + LDS_MISC); xcd_barrier(b_); } while (0)
    d_pro0(LP, (LAS float*)((LAS unsigned char*)lds + 98304)); d_filter(LP, (LAS float*)((LAS unsigned char*)lds + 73728)); d_convert_a(LP, (LAS float*)lds);
    GRID_BAR();
    d_pro1(LP); d_convert_b(LP, (LAS float*)lds);
    GRID_BAR();
    d_fspec(LP, (LAS unsigned char*)lds); d_norm1(LP, 0);
    GRID_BAR();
#pragma unroll 1
    for (int l = 0; l < DEPTH; ++l) {
        d_gemm_in(LP, l, (LAS unsigned char*)lds);
        GRID_BAR();
        d_prep_scan(LP); d_prep_attn(LP); d_hy_pre_fast(LP, l, (LAS unsigned char*)lds);
        GRID_BAR();
        d_scan_stage1(LP, l);
        d_hy_fft(LP, l, (LAS unsigned char*)lds);
        d_attn_fast(LP, l, (LAS unsigned char*)lds);
        GRID_BAR();
        d_scan_stage2(LP, l, (LAS unsigned char*)lds);
        d_hy_post(LP, l, (LAS unsigned char*)lds);
        GRID_BAR();
        d_gemm_out(LP, l, (LAS unsigned char*)lds);
        GRID_BAR();
        d_router(LP, l, (LAS float*)lds);
        GRID_BAR();
        d_moe_up(LP, l, (LAS unsigned char*)lds);
        GRID_BAR();
        d_moe_down(LP, l, (LAS unsigned char*)lds);
        GRID_BAR();
        d_combine(LP, l, (LAS int*)lds);
        GRID_BAR();
    }
}

#undef p
extern "C" void kernel_launch(void* const* d_in, const int* in_sizes, int n_in, void* d_out, int out_size, void* d_ws, size_t ws_size, hipStream_t stream) {
    if (n_in != 31 || ws_size < WS_END || out_size != NLAT * D) { fprintf(stderr, "kernel_launch: unexpected shapes (n_in %d ws %zu out %d)\n", n_in, ws_size, out_size); return; }
    static int grid = 0;
    if (grid == 0) {
        int dev = 0, cus = 0, per_cu = 0;
        if (hipGetDevice(&dev) != hipSuccess || hipDeviceGetAttribute(&cus, hipDeviceAttributeMultiprocessorCount, dev) != hipSuccess) { grid = -1; return; }
        if (hipFuncSetAttribute((const void*)mk_fwd, hipFuncAttributeMaxDynamicSharedMemorySize, LDS_BYTES) != hipSuccess) { fprintf(stderr, "hipFuncSetAttribute failed\n"); grid = -1; return; }
        if (hipOccupancyMaxActiveBlocksPerMultiprocessor(&per_cu, (const void*)mk_fwd, NT, LDS_BYTES) != hipSuccess || per_cu < 1) { fprintf(stderr, "occupancy query says %d\n", per_cu); }
        (void)hipGetLastError();
        grid = cus;
    }
    if (grid < 0) return;
    P hp{};
    const float** pp = (const float**)&hp;
    for (int i = 0; i < 31; ++i) pp[i] = (const float*)d_in[i];
    hp.out = (float*)d_out; hp.ws = (unsigned char*)d_ws;
    (void)hipMemsetAsync((char*)d_ws + WS_CTL, 0, 1 * MiB, stream);
    hipLaunchKernelGGL(mk_fwd, dim3(grid), dim3(NT), LDS_BYTES, stream, hp);
}
```

```cpp
#include <hip/hip_runtime.h>
#include <stdint.h>
#include <stdio.h>
#include <math.h>

constexpr int D = 1024, BATCH = 4, SEQ = 4096, CTXL = 256, DEPTH = 2;
constexpr int NLAT = BATCH * SEQ, NCTX = BATCH * CTXL, MALL = NLAT + NCTX;
constexpr int INW = 3360, PW = 3584;
constexpr int NEXP = 32, TOPK = 4;
constexpr float EPS = 1e-6f;
constexpr int PC_AQ = 0, PC_AK = 256, PC_AV = 512, PC_HY = 768, PC_RQ = 1536, PC_RK = 1792, PC_RV = 2048, PC_RG = 2304,
              PC_GQ = 2560, PC_GK = 2688, PC_GV = 2816, PC_GR = 3072, PC_GD = 3328;
constexpr int ACT_ROWS = MALL * TOPK + NEXP * 256;

typedef unsigned short bf16_t;
typedef float cvt_f32x2_t __attribute__((ext_vector_type(2))); typedef __bf16 cvt_bf16x2_t __attribute__((ext_vector_type(2)));
__device__ __forceinline__ unsigned cvtpk_rne(float lo, float hi) { cvt_f32x2_t v = {lo, hi}; cvt_bf16x2_t b = __builtin_convertvector(v, cvt_bf16x2_t); return __builtin_bit_cast(unsigned, b); }
__device__ __forceinline__ bf16_t f2bf(float f) { unsigned u = __float_as_uint(f); return (bf16_t)((u + 0x7fffu + ((u >> 16) & 1u)) >> 16); }
__device__ __forceinline__ float bf2f(bf16_t b) { return __uint_as_float(((unsigned)b) << 16); }

typedef unsigned gv4u __attribute__((ext_vector_type(4))); typedef float gv4f __attribute__((ext_vector_type(4)));
__device__ __forceinline__ float gblo(unsigned w) { return __uint_as_float(w << 16); }
__device__ __forceinline__ float gbhi(unsigned w) { return __uint_as_float(w & 0xffff0000u); }
constexpr size_t MiB = 1u << 20;
constexpr size_t WS_CTL = 0;
constexpr size_t WS_MOD = 1 * MiB;
constexpr size_t WS_WEFF = 3 * MiB;
constexpr size_t WS_FILT = 6 * MiB;
constexpr size_t WS_FILTC = WS_FILT + 16 * MiB;
constexpr size_t WS_XRES = 24 * MiB;
constexpr size_t WS_HB = WS_XRES + 68 * MiB;
constexpr size_t WS_PBUF = WS_HB + 34 * MiB;
constexpr size_t WS_CONCAT = WS_PBUF + 120 * MiB;
constexpr size_t WS_YBUF = WS_CONCAT + 34 * MiB;
constexpr size_t WS_QA = WS_YBUF + 68 * MiB;
constexpr size_t WS_KA = WS_QA + 17 * MiB;
constexpr size_t WS_QR = WS_KA + 17 * MiB;
constexpr size_t WS_KR = WS_QR + 17 * MiB;
constexpr size_t WS_OA = WS_KR + 17 * MiB;
constexpr size_t WS_Z = WS_OA + 34 * MiB;
constexpr size_t WS_X0 = WS_Z + 17 * MiB;
constexpr size_t WS_LA = WS_X0 + 17 * MiB;
constexpr size_t WS_OD = WS_LA + 17 * MiB;
constexpr size_t WS_TOPI = WS_OD + 68 * MiB;
constexpr size_t WS_TOPW = WS_TOPI + 1 * MiB;
constexpr size_t WS_LIST = WS_TOPW + 1 * MiB;
constexpr size_t WS_ACT = WS_LIST + 3 * MiB;
constexpr size_t WS_YSLOT = WS_ACT + 160 * MiB;
constexpr size_t WS_WIN_T = WS_YSLOT + 160 * MiB;
constexpr size_t WS_WOUT_T = WS_WIN_T + 14 * MiB;
constexpr size_t WS_W1_T = WS_WOUT_T + 4 * MiB;
constexpr size_t WS_W2_T = WS_W1_T + 256 * MiB;
constexpr size_t WS_BIAS_IN = WS_W2_T + 128 * MiB;
constexpr size_t WS_QRP = WS_BIAS_IN + 1 * MiB;
constexpr size_t WS_KIMG = WS_QRP + 9 * MiB;
constexpr size_t WS_VIMG = WS_KIMG + 9 * MiB;
constexpr size_t WS_QF_R = WS_VIMG + 9 * MiB;
constexpr size_t WS_KF_R = WS_QF_R + 9 * MiB;
constexpr size_t WS_KT_R = WS_KF_R + 9 * MiB;
constexpr size_t WS_KT_G = WS_KT_R + 9 * MiB;
constexpr size_t WS_VT_R = WS_KT_G + 5 * MiB;
constexpr size_t WS_VT_G = WS_VT_R + 9 * MiB;
constexpr size_t WS_CUM_G = WS_VT_G + 9 * MiB;
constexpr size_t WS_CUMT_G = WS_CUM_G + 17 * MiB;
constexpr size_t WS_US_R = WS_CUMT_G + 17 * MiB;
constexpr size_t WS_US_G = WS_US_R + 34 * MiB;
constexpr size_t WS_UG_R = WS_US_G + 17 * MiB;
constexpr size_t WS_UG_G = WS_UG_R + 5 * MiB;
constexpr size_t WS_AG = WS_UG_G + 3 * MiB;
constexpr size_t WS_ROPE = WS_AG + 1 * MiB;
constexpr size_t WS_FSPEC = WS_ROPE + 1 * MiB;
constexpr size_t WS_ZT = WS_FSPEC + 32 * MiB;
constexpr size_t WS_YT = WS_ZT + 16 * MiB;
constexpr size_t WS_X0B = WS_YT + 16 * MiB;
constexpr size_t WS_MODP = WS_X0B + 8 * MiB;
constexpr size_t WS_PS = WS_MODP + 4 * MiB;
constexpr size_t WS_ZC = WS_PS + 1 * MiB;
constexpr size_t WS_X0C = WS_ZC + 1 * MiB;
constexpr size_t WS_END = WS_X0C + 1 * MiB;
constexpr int CW_CNT = 1024;
constexpr int CW_NORM = 2048;

struct P {
    const float *x, *c, *ctx, *c_ctx, *w_mod, *b_mod, *norm_g, *w_in, *w_out, *diff_lambda, *diff_subln_g, *hy_short_w, *hy_short_b,
        *hy_w1, *hy_b1, *hy_w2, *hy_b2, *hy_w3, *hy_freq, *hy_bias, *ret_decay, *ret_norm_g, *gla_gate_w, *gla_gate_b, *gla_norm_g,
        *router_w, *router_b, *exp_w1, *exp_b1, *exp_w2, *exp_b2;
    float* out; unsigned char* ws;
};
typedef const __attribute__((address_space(4))) P* KP;
#define p (*kp)
#define WSP(T, off) ((T*)(p.ws + (off)))

__device__ __forceinline__ float wave_sum(float v) {
#pragma unroll
    for (int o = 1; o < 64; o <<= 1) v += __shfl_xor(v, o);
    return v;
}
__device__ __forceinline__ float silu_f(float x) { return x / (1.f + expf(-x)); }
__host__ __device__ __forceinline__ int nrows_l(int l) { return l == 0 ? MALL : NLAT; }
__device__ __forceinline__ int mod_r(int row) { return row < NLAT ? row / SEQ : 4; }
__device__ __forceinline__ void seq_info(int row, int& base, int& n, int& t) {
    if (row < NLAT) { base = row & ~(SEQ - 1); n = SEQ; t = row - base; }
    else { int r = row - NLAT; base = NLAT + (r & ~(CTXL - 1)); n = CTXL; t = row - base; }
}

__device__ __forceinline__ int ltid();
#define XB_TMO      128
#define XB_XCNT(j)  (256  + 64 * (j))
#define XB_XSUB(j)  (1280 + 64 * (j))
#define XB_XGEN(j)  (2304 + 64 * (j))
#define XB_TOP      3328
#define XB_TOPGEN   3392
#define XCD_BAR_WORDS 3456
#define XB_SPIN_CAP (1u << 22)
#define LAS __attribute__((address_space(3)))
__device__ __forceinline__ unsigned xb_ld(unsigned* ptr)            { return __hip_atomic_load(ptr, __ATOMIC_RELAXED, __HIP_MEMORY_SCOPE_AGENT); }
__device__ __forceinline__ unsigned xb_add(unsigned* ptr, unsigned v) { return __hip_atomic_fetch_add(ptr, v, __ATOMIC_RELAXED, __HIP_MEMORY_SCOPE_AGENT); }
__device__ __forceinline__ unsigned xb_xcc_id() { return (unsigned)__builtin_amdgcn_s_getreg((3 << 11) | 20) & 0xFu; }
#define XB_SPIN(cond, bar) do { unsigned _sp = 0; while (cond) { __builtin_amdgcn_s_sleep(1); \
    if ((++_sp & 255u) == 0u) { if (xb_ld(&(bar)[XB_TMO])) break; if (_sp > XB_SPIN_CAP) { atomicAdd(&(bar)[XB_TMO], 1u); break; } } } } while (0)
struct XcdBarrier { unsigned* bar; unsigned x; volatile LAS unsigned* st; };
__device__ __forceinline__ XcdBarrier xcd_barrier_post(unsigned* bar, volatile LAS unsigned* st) {
    XcdBarrier b; b.bar = bar; b.x = xb_xcc_id(); b.st = st;
    if (threadIdx.x == 0) (void)xb_add(&bar[XB_XCNT(b.x)], 1u);
    return b;
}
__device__ __forceinline__ void xcd_barrier_complete(unsigned* bar, unsigned x, unsigned& nloc, unsigned& nx) {
    const unsigned G = gridDim.x * gridDim.y * gridDim.z;
    unsigned sum, cnt, mine, sp = 0u;
    for (;;) {
        sum = 0u; cnt = 0u; mine = 0u;
#pragma unroll
        for (unsigned j = 0; j < 16; ++j) { const unsigned c = xb_ld(&bar[XB_XCNT(j)]); sum += c; cnt += (c > 0u) ? 1u : 0u; mine = (j == x) ? c : mine; }
        if (sum == G) break;
        __builtin_amdgcn_s_sleep(1);
        if ((++sp & 255u) == 0u) { if (xb_ld(&bar[XB_TMO])) break; if (sp > XB_SPIN_CAP) { atomicAdd(&bar[XB_TMO], 1u); break; } }
    }
    nloc = mine > 0u ? mine : 1u; nx = cnt > 0u ? cnt : 1u;
}
__device__ __forceinline__ void xcd_barrier(const XcdBarrier& b) {
    asm volatile("s_waitcnt vmcnt(0)" ::: "memory");
    __syncthreads();
    if (ltid() == 0) {
        unsigned* bar = b.bar;
        __builtin_amdgcn_s_waitcnt(0);
        unsigned nloc = b.st[0], nx = b.st[1];
        if (nloc == 0u) { xcd_barrier_complete(bar, b.x, nloc, nx); b.st[0] = nloc; b.st[1] = nx; }
        const unsigned old = xb_add(&bar[XB_XSUB(b.x)], 1u);
        const unsigned gen = old / nloc;
        if (old + 1u == (gen + 1u) * nloc) {
            __builtin_amdgcn_fence(__ATOMIC_RELEASE, "agent");
            asm volatile("s_waitcnt vmcnt(0)" ::: "memory");
            const unsigned og = xb_add(&bar[XB_TOP], 1u);
            const unsigned tg = og / nx;
            if (og + 1u == (tg + 1u) * nx) xb_add(&bar[XB_TOPGEN], 1u);
            else XB_SPIN(xb_ld(&bar[XB_TOPGEN]) == tg, bar);
            __builtin_amdgcn_fence(__ATOMIC_ACQUIRE, "agent");
            xb_add(&bar[XB_XGEN(b.x)], 1u);
            asm volatile("s_waitcnt vmcnt(0)" ::: "memory");
        } else {
            XB_SPIN(xb_ld(&bar[XB_XGEN(b.x)]) == gen, bar);
            __builtin_amdgcn_fence(__ATOMIC_ACQUIRE, "agent");
            asm volatile("s_waitcnt vmcnt(0)" ::: "memory");
        }
    }
    __syncthreads();
}

constexpr int NT = 512;
extern __shared__ __attribute__((aligned(16))) unsigned char g_lds[];
constexpr int LDS_BYTES = 147456;
constexpr int LDS_WTAB = LDS_BYTES - 512;
constexpr int LDS_MISC = LDS_BYTES - 64;
__device__ __forceinline__ int hw_wave_slot() { return (int)(__builtin_amdgcn_s_getreg((5 << 11) | 4) & 63u); }
__device__ __forceinline__ int ltid() {
    const int w = __builtin_amdgcn_readfirstlane(((const LAS int*)((LAS unsigned char*)g_lds + LDS_WTAB))[hw_wave_slot()]);
    unsigned ones = ~0u; asm volatile("" : "+s"(ones));
    int t = (w << 6) | (int)__builtin_amdgcn_mbcnt_hi(ones, __builtin_amdgcn_mbcnt_lo(ones, 0u));
    asm volatile("" : "+v"(t)); return t;
}
__device__ __forceinline__ int lbid() { int b = blockIdx.x; asm volatile("" : "+s"(b)); return b; }
#define PH_IDS const int tid = ltid(), bid = lbid(); (void)tid; (void)bid
#define GT_LOOP(idx, total) for (int idx = bid * NT + tid; idx < (total); idx += gridDim.x * NT)
#define GW_LOOP(w, total) for (int w = bid * (NT / 64) + (tid >> 6); w < (total); w += gridDim.x * (NT / 64))

__device__ __forceinline__ const float* xin_row(KP kp, int l, int row) {
    return l == 0 ? (row < NLAT ? p.x + (size_t)row * D : p.ctx + (size_t)(row - NLAT) * D) : WSP(float, WS_XRES) + (size_t)row * D;
}
__device__ __forceinline__ void d_pro0(KP kp, LAS float* sc) {
    PH_IDS;
    GT_LOOP(idx, 64 * 24) {
        const int pos = idx / 24, j = idx % 24; float ang; float* dst;
        if (j < 8) { ang = (float)pos * powf(10000.f, -(float)j / 8.f); dst = WSP(float, WS_ROPE) + (pos * 8 + j) * 2; }
        else { ang = (float)pos * powf(10000.f, -(float)(j - 8) / 16.f); dst = WSP(float, WS_ROPE) + 1024 + (pos * 16 + (j - 8)) * 2; }
        dst[0] = cosf(ang); dst[1] = sinf(ang);
    }
    GT_LOOP(idx, 2 * 1024 * 256) {
        int n = idx & 255, i = (idx >> 8) & 1023, l = idx >> 18, d = n >> 7, j = n & 127;
        float a = 0.f;
        for (int r = 0; r < 16; ++r) a += p.w_in[((size_t)l * D + i) * INW + 3328 + d * 16 + r] * p.gla_gate_w[((l * 2 + d) * 16 + r) * 128 + j];
        WSP(float, WS_WEFF)[idx] = a;
    }
    const int lane = tid & 63;
    for (int i = tid; i < 5 * D; i += NT) { const int r = i >> 10, ii = i & 1023; sc[i] = silu_f(r < 4 ? p.c[r * D + ii] : p.c_ctx[ii]); }
    __syncthreads();
    GW_LOOP(task, 2 * 96 * 16) {
        const int chunk = task & 15, jb = (task >> 4) % 96, l = task / (16 * 96), j = jb * 64 + lane;
        const float* w = p.w_mod + ((size_t)l * D + chunk * 64) * 6144 + j;
        float acc[5] = {0.f, 0.f, 0.f, 0.f, 0.f};
#pragma unroll 8
        for (int i = 0; i < 64; ++i) { const float wv = w[(size_t)i * 6144];
#pragma unroll
            for (int r = 0; r < 5; ++r) acc[r] += sc[r * D + chunk * 64 + i] * wv; }
#pragma unroll
        for (int r = 0; r < 5; ++r) WSP(float, WS_MODP)[((size_t)(chunk * 2 + l) * 5 + r) * 6144 + j] = acc[r];
    }
}
__device__ __forceinline__ void d_filter(KP kp, LAS float* sm) {
    PH_IDS;
    const int lane = tid & 63; LAS float* zf = sm + (tid >> 6) * 192; LAS float* h1 = zf + 64; LAS float* h2 = zf + 128;
    GW_LOOP(task, 2 * SEQ + CTXL) {
        const int which = task < SEQ ? 0 : task < 2 * SEQ ? 1 : 2, pos = task - (which == 2 ? 2 * SEQ : which * SEQ), l = which == 1 ? 1 : 0, n = which == 2 ? CTXL : SEQ;
        float* filt = which == 2 ? WSP(float, WS_FILTC) : WSP(float, WS_FILT) + (size_t)l * 8192 * 256;
        const float t = (float)pos / (float)(n - 1), w = (6.2831855f * (float)pos) / (float)n;
        if (lane < 33) { float v = t; if (lane >= 1) { const int q = (lane - 1) & 15; const float f = 1e-4f + (15.f - 1e-4f) * ((float)q / 15.f), a = w * f; v = lane < 17 ? cosf(a) : -sinf(a); } zf[lane] = v; }
        asm volatile("s_waitcnt lgkmcnt(0)" ::: "memory");
        float a = p.hy_b1[l * 64 + lane];
        for (int i = 0; i < 33; ++i) a += zf[i] * p.hy_w1[(l * 33 + i) * 64 + lane];
        h1[lane] = sinf(p.hy_freq[(l * 2 + 0) * 64 + lane] * a);
        asm volatile("s_waitcnt lgkmcnt(0)" ::: "memory");
        a = p.hy_b2[l * 64 + lane];
        for (int i = 0; i < 64; ++i) a += h1[i] * p.hy_w2[(l * 64 + i) * 64 + lane];
        h2[lane] = sinf(p.hy_freq[(l * 2 + 1) * 64 + lane] * a);
        asm volatile("s_waitcnt lgkmcnt(0)" ::: "memory");
        float raw[8];
#pragma unroll
        for (int q = 0; q < 8; ++q) raw[q] = 0.f;
        for (int j = 0; j < 64; ++j) { const float hj = h2[j]; const float* w3 = p.hy_w3 + (size_t)(l * 64 + j) * 512 + lane;
#pragma unroll
            for (int q = 0; q < 8; ++q) raw[q] += hj * w3[q * 64]; }
        const float mind = logf(1e-2f) / 1.5f, maxd = logf(1e-2f) / 0.3f;
#pragma unroll
        for (int q = 0; q < 8; ++q) {
            const int c = (q & 3) * 64 + lane;
            const float v = raw[q] * expf(-t * fabsf(mind + (maxd - mind) * ((float)c / 255.f)));
            if (q < 4) { filt[(size_t)pos * 256 + c] = v; if (pos == 0) filt[(size_t)n * 256 + c] = 0.f; }
            else if (pos >= 1) filt[(size_t)(2 * n - pos) * 256 + c] = v;
        }
        asm volatile("s_waitcnt lgkmcnt(0)" ::: "memory");
    }
}
__device__ __forceinline__ void d_pro1(KP kp) {
    PH_IDS;
    GT_LOOP(idx, 2 * 5 * 6144) {
        const int j = idx % 6144, r = (idx / 6144) % 5, l = idx / (6144 * 5);
        float a = p.b_mod[l * 6144 + j];
        for (int ch = 0; ch < 16; ++ch) a += WSP(float, WS_MODP)[((size_t)(ch * 2 + l) * 5 + r) * 6144 + j];
        WSP(float, WS_MOD)[idx] = a;
    }
    GT_LOOP(idx, 528 * 256) {
        const int vb = idx >> 8, c = idx & 255, which = vb < 256 ? 0 : vb < 512 ? 1 : 2, slab = vb - (which == 2 ? 512 : which * 256);
        const float* filt = which == 2 ? WSP(float, WS_FILTC) : WSP(float, WS_FILT) + (size_t)which * 8192 * 256;
        float a = 0.f;
#pragma unroll 8
        for (int i = 0; i < 32; ++i) a += fabsf(filt[(size_t)(slab * 32 + i) * 256 + c]);
        WSP(float, WS_PS)[(which * 256 + slab) * 256 + c] = a;
    }
}
__device__ __forceinline__ void d_norm1(KP kp, int l) {
    PH_IDS;
    const int lane = tid & 63;
    GW_LOOP(row, MALL) {
        const float* xr = xin_row(kp, l, row);
        const float* mod = WSP(float, WS_MOD) + (size_t)(l * 5 + mod_r(row)) * 6144;
        const float* g = p.norm_g + (l * 4 + 0) * D;
        float v[16], ss = 0.f;
#pragma unroll
        for (int j = 0; j < 16; ++j) { v[j] = xr[j * 64 + lane]; ss += v[j] * v[j]; }
        const float rstd = rsqrtf(wave_sum(ss) * (1.f / D) + EPS);
        bf16_t* hb = WSP(bf16_t, WS_HB) + (size_t)row * D;
#pragma unroll
        for (int j = 0; j < 16; ++j) { int cidx = j * 64 + lane; hb[cidx] = f2bf(v[j] * rstd * g[cidx] * (1.f + mod[1024 + cidx]) + mod[cidx]); }
    }
}
__device__ __forceinline__ void d_router(KP kp, int l, LAS float* sm) {
    PH_IDS;
    const int lane = tid & 63;
    for (int i = tid; i < D * NEXP; i += NT) sm[(i >> 5) * 33 + (i & 31)] = p.router_w[(size_t)l * D * NEXP + i];
    LAS int* lcnt = (LAS int*)(sm + 33800); LAS int* lbase = lcnt + 32; LAS int* rec = lcnt + 64;
    if (tid < 32) lcnt[tid] = 0;
    __syncthreads();
    int it = 0;
    GW_LOOP(row, nrows_l(l)) {
        const float* xs = xin_row(kp, l, row);
        float* xr = WSP(float, WS_XRES) + (size_t)row * D;
        const float* y = WSP(float, WS_YBUF) + (size_t)row * D;
        const float* mod = WSP(float, WS_MOD) + (size_t)(l * 5 + mod_r(row)) * 6144;
        const float* g1 = p.norm_g + (l * 4 + 1) * D; const float* g2 = p.norm_g + (l * 4 + 2) * D;
        float yv[16], xv[16], ss = 0.f;
#pragma unroll
        for (int j = 0; j < 16; ++j) { yv[j] = y[j * 64 + lane]; ss += yv[j] * yv[j]; }
        float rstd = rsqrtf(wave_sum(ss) * (1.f / D) + EPS);
        ss = 0.f;
#pragma unroll
        for (int j = 0; j < 16; ++j) { const int ci = j * 64 + lane; xv[j] = xs[ci] + mod[2048 + ci] * (yv[j] * rstd * g1[ci]); ss += xv[j] * xv[j]; }
        float gsc[16], gsh[16];
#pragma unroll
        for (int j = 0; j < 16; ++j) { const int ci = j * 64 + lane; gsc[j] = g2[ci] * (1.f + mod[4096 + ci]); gsh[j] = mod[3072 + ci]; }
#pragma unroll
        for (int j = 0; j < 16; ++j) xr[j * 64 + lane] = xv[j];
        rstd = rsqrtf(wave_sum(ss) * (1.f / D) + EPS);
        bf16_t* hb = WSP(bf16_t, WS_HB) + (size_t)row * D;
        float v[32];
#pragma unroll
        for (int e = 0; e < 32; ++e) v[e] = 0.f;
#pragma unroll
        for (int j = 0; j < 16; ++j) { xv[j] = xv[j] * rstd * gsc[j] + gsh[j]; hb[j * 64 + lane] = f2bf(xv[j]); }
#pragma unroll
        for (int j = 0; j < 16; ++j) { const LAS float* wr = sm + (j * 64 + lane) * 33; const float hv = xv[j];
#pragma unroll
            for (int e = 0; e < 32; ++e) v[e] += hv * wr[e];
            asm volatile("" : "+v"(v[0]), "+v"(v[8]), "+v"(v[16]), "+v"(v[24])); }
#pragma unroll
        for (int k = 0; k < 16; ++k) { const bool up = lane & 32; const float send = up ? v[k] : v[k + 16], keep = up ? v[k + 16] : v[k]; v[k] = keep + __shfl_xor(send, 32); }
#pragma unroll
        for (int k = 0; k < 8; ++k) { const bool up = lane & 16; const float send = up ? v[k] : v[k + 8], keep = up ? v[k + 8] : v[k]; v[k] = keep + __shfl_xor(send, 16); }
#pragma unroll
        for (int k = 0; k < 4; ++k) { const bool up = lane & 8; const float send = up ? v[k] : v[k + 4], keep = up ? v[k + 4] : v[k]; v[k] = keep + __shfl_xor(send, 8); }
#pragma unroll
        for (int k = 0; k < 2; ++k) { const bool up = lane & 4; const float send = up ? v[k] : v[k + 2], keep = up ? v[k + 2] : v[k]; v[k] = keep + __shfl_xor(send, 4); }
        { const bool up = lane & 2; const float send = up ? v[0] : v[1], keep = up ? v[1] : v[0]; v[0] = keep + __shfl_xor(send, 2); }
        const int myexp = lane >> 1;
        float mylogit = v[0] + __shfl_xor(v[0], 1) + p.router_b[l * NEXP + myexp];
        float tv[4]; int ti[4];
#pragma unroll
        for (int k = 0; k < 4; ++k) {
            float bv = mylogit; int bi = myexp;
#pragma unroll
            for (int o = 1; o < 64; o <<= 1) { const float ov = __shfl_xor(bv, o); const int oi = __shfl_xor(bi, o); if (ov > bv || (ov == bv && oi < bi)) { bv = ov; bi = oi; } }
            tv[k] = bv; ti[k] = bi; if (myexp == bi) mylogit = -1e30f;
        }
        float den = 0.f, w[4];
#pragma unroll
        for (int k = 0; k < 4; ++k) { w[k] = expf(tv[k] - tv[0]); den += w[k]; }
        if (lane < 4) {
            const int e = lane == 0 ? ti[0] : lane == 1 ? ti[1] : lane == 2 ? ti[2] : ti[3];
            const float ww = lane == 0 ? w[0] : lane == 1 ? w[1] : lane == 2 ? w[2] : w[3];
            const int lr = __hip_atomic_fetch_add(&lcnt[e], 1, __ATOMIC_RELAXED, __HIP_MEMORY_SCOPE_WORKGROUP);
            rec[(it * 8 + (tid >> 6)) * 4 + lane] = (e << 16) | lr;
            WSP(float, WS_TOPW)[row * 4 + lane] = ww / den;
            WSP(int, WS_TOPI)[row * 4 + lane] = e;
        }
        ++it;
    }
    asm volatile("s_waitcnt lgkmcnt(0)" ::: "memory");
    __syncthreads();
    if (tid < 32) lbase[tid] = (int)atomicAdd(WSP(unsigned, WS_CTL) + CW_CNT + (l * 32 + tid) * 64, (unsigned)lcnt[tid]);
    asm volatile("s_waitcnt vmcnt(0) lgkmcnt(0)" ::: "memory");
    __syncthreads();
    it = 0;
    GW_LOOP(row, nrows_l(l)) {
        if (lane < 4) { const int rc = rec[(it * 8 + (tid >> 6)) * 4 + lane], e = rc >> 16, pos = lbase[e] + (rc & 0xffff);
            WSP(int, WS_LIST)[(size_t)e * MALL + pos] = row * 4 + lane; WSP(int, WS_TOPI)[MALL * 4 + row * 4 + lane] = pos; }
        ++it;
    }
    __syncthreads();
}
__device__ __forceinline__ void d_combine(KP kp, int l, LAS int* aoffs) {
    PH_IDS;
    const int lane = tid & 63;
    const unsigned* cnt = WSP(unsigned, WS_CTL) + CW_CNT + l * 32 * 64;
    if (tid == 0) { int a = 0; for (int e = 0; e < 32; ++e) { aoffs[e] = a; a += ((int)cnt[e * 64] + 255) & ~255; } }
    __syncthreads();
    GW_LOOP(row, nrows_l(l)) {
        int ee[4], pp[4];
#pragma unroll
        for (int k = 0; k < 4; ++k) { ee[k] = WSP(int, WS_TOPI)[row * 4 + k]; pp[k] = WSP(int, WS_TOPI)[MALL * 4 + row * 4 + k]; }
        gv4u yv[4][2];
#pragma unroll
        for (int k = 0; k < 4; ++k) { const gv4u* ys = (const gv4u*)(WSP(bf16_t, WS_YSLOT) + (size_t)(aoffs[ee[k]] + pp[k]) * D) + lane; yv[k][0] = ys[0]; yv[k][1] = ys[64]; }
        float acc[16];
#pragma unroll
        for (int j = 0; j < 16; ++j) acc[j] = 0.f;
#pragma unroll
        for (int k = 0; k < 4; ++k)
#pragma unroll
            for (int hf = 0; hf < 2; ++hf)
#pragma unroll
                for (int q = 0; q < 4; ++q) { acc[hf * 8 + 2 * q] += gblo(yv[k][hf][q]); acc[hf * 8 + 2 * q + 1] += gbhi(yv[k][hf][q]); }
        float ss = 0.f;
#pragma unroll
        for (int j = 0; j < 16; ++j) ss += acc[j] * acc[j];
        float rstd = rsqrtf(wave_sum(ss) * (1.f / D) + EPS);
        float* xr = WSP(float, WS_XRES) + (size_t)row * D;
        const float* mod = WSP(float, WS_MOD) + (size_t)(l * 5 + mod_r(row)) * 6144;
        const float* g3 = p.norm_g + (l * 4 + 3) * D;
        ss = 0.f;
        gv4f xo[4], gm[4], gg[4];
#pragma unroll
        for (int q8 = 0; q8 < 4; ++q8) { const int ci = (q8 >> 1) * 512 + lane * 8 + (q8 & 1) * 4; xo[q8] = *(const gv4f*)(xr + ci); gm[q8] = *(const gv4f*)(mod + 5120 + ci); gg[q8] = *(const gv4f*)(g3 + ci); }
        float n0[16], n1[16], n2[16];
        if (l < DEPTH - 1) {
            const float* mod2 = WSP(float, WS_MOD) + (size_t)((l + 1) * 5 + mod_r(row)) * 6144; const float* g0 = p.norm_g + ((l + 1) * 4 + 0) * D;
#pragma unroll
            for (int q8 = 0; q8 < 4; ++q8) { const int ci = (q8 >> 1) * 512 + lane * 8 + (q8 & 1) * 4; const gv4f a = *(const gv4f*)(g0 + ci), b2 = *(const gv4f*)(mod2 + 1024 + ci), c2 = *(const gv4f*)(mod2 + ci);
#pragma unroll
                for (int q = 0; q < 4; ++q) { n0[q8 * 4 + q] = a[q]; n1[q8 * 4 + q] = b2[q]; n2[q8 * 4 + q] = c2[q]; } }
        }
#pragma unroll
        for (int q8 = 0; q8 < 4; ++q8) {
            const int ci = (q8 >> 1) * 512 + lane * 8 + (q8 & 1) * 4;
            gv4f vv;
#pragma unroll
            for (int q = 0; q < 4; ++q) { const float v = xo[q8][q] + gm[q8][q] * (acc[q8 * 4 + q] * rstd * gg[q8][q]); vv[q] = v; acc[q8 * 4 + q] = v; ss += v * v; }
            if (l == DEPTH - 1) *(gv4f*)(p.out + (size_t)row * D + ci) = vv; else *(gv4f*)(xr + ci) = vv;
        }
        if (l < DEPTH - 1) {
            rstd = rsqrtf(wave_sum(ss) * (1.f / D) + EPS);
            bf16_t* hb = WSP(bf16_t, WS_HB) + (size_t)row * D;
#pragma unroll
            for (int hf = 0; hf < 2; ++hf) {
                gv4u o;
#pragma unroll
                for (int q = 0; q < 4; ++q) { const int i0 = hf * 8 + 2 * q; o[q] = cvtpk_rne(acc[i0] * rstd * n0[i0] * (1.f + n1[i0]) + n2[i0], acc[i0 + 1] * rstd * n0[i0 + 1] * (1.f + n1[i0 + 1]) + n2[i0 + 1]); }
                *(gv4u*)(hb + hf * 512 + lane * 8) = o;
            }
        }
    }
    __syncthreads();
}

namespace pg8 {
typedef short bf16x8 __attribute__((ext_vector_type(8)));
typedef float f32x4 __attribute__((ext_vector_type(4)));
typedef unsigned u32x4 __attribute__((ext_vector_type(4)));
typedef unsigned u32x2 __attribute__((ext_vector_type(2)));
constexpr int BM = 256, BK = 64, HALF = 128, HTB = HALF * BK * 2, STAGE_BYTES = 8 * HTB, NXCD = 8, WGM = 8, K = 1024;
__host__ __device__ __forceinline__ int lds_byte(int r, int c) { const int st = (r >> 4) * 2 + (c >> 5), rr = r & 15, cc = c & 31, ob = rr * 64 + cc * 2; return st * 1024 + (ob ^ (((ob >> 9) & 1) << 5)); }
__host__ __device__ __forceinline__ void stage_rc(int b, int& R, int& C) { const int st = b / 1024, sb = b % 1024, swz = sb ^ (((sb >> 9) & 1) << 5); R = (st >> 1) * 16 + swz / 64; C = (st & 1) * 32 + (swz % 64) / 2; }
__host__ __device__ __forceinline__ int perm32(int rho) { const int n = rho >> 4, i = rho & 15; return 8 * (i >> 2) + 4 * n + (i & 3); }
__device__ __forceinline__ unsigned cvt_pk_bf16(float lo, float hi) { return cvtpk_rne(lo, hi); }

struct Unit { int pm, pn; const char* A; const char* B; const int* gl; int gcnt; int e; int row0; };

struct DenseOrder {
    int nM, nN, nwg, G, c; const char* A; const char* Bt;
    __device__ __forceinline__ void init(int M, int N, int G_, int c_, const void* A_, const void* Bt_) { nM = M / BM; nN = N / BM; nwg = nM * nN; G = G_; c = c_; A = (const char*)A_; Bt = (const char*)Bt_; }
    __device__ __forceinline__ bool next(int i, Unit& u) const {
        const long L = (long)i * G + c; if (L >= nwg) return false;
        int wgid = (int)L; { const int q = nwg / NXCD, r = nwg % NXCD, xcd = wgid % NXCD, off = wgid / NXCD; wgid = (xcd < r ? xcd * (q + 1) : r * (q + 1) + (xcd - r) * q) + off; }
        const int nig = WGM * nN, gid = wgid / nig, fm = gid * WGM, gsz = (nM - fm) < WGM ? (nM - fm) : WGM;
        u.pm = fm + ((wgid % nig) % gsz); u.pn = (wgid % nig) / gsz;
        u.A = A + (size_t)u.pm * (BM * K * 2); u.B = Bt + (size_t)u.pn * (BM * K * 2); u.gl = nullptr; u.gcnt = BM; u.e = 0; u.row0 = u.pm * BM; return true;
    }
};
struct MoeOrder {
    const LAS int* tab; int G, c, NCT; const char* A; const char* W; size_t wstride; const int* list; const unsigned* cnt; bool gather;
    __device__ __forceinline__ bool next(int i, Unit& u) const {
        const int xg = c & 7, L = (c >> 3) + (G >> 3) * i; const LAS int* gt = tab + 72 + xg * 5;
        if (L >= gt[4]) return false;
        int q = 0;
#pragma unroll
        for (int j = 1; j < 4; ++j) if (L >= gt[j]) q = j;
        const int e = __builtin_amdgcn_readfirstlane(xg + 8 * q);
        const int r = __builtin_amdgcn_readfirstlane(L - gt[q]), ce = __builtin_amdgcn_readfirstlane((int)cnt[e * 64]), rte = (ce + 255) >> 8, ro = __builtin_amdgcn_readfirstlane(tab[33 + e]);
        const int ct = r / rte, rt = r - ct * rte;
        u.pm = rt; u.pn = ct; u.e = e; u.row0 = ro + rt * 256; u.gl = list + (size_t)e * MALL + rt * 256; u.gcnt = min(256, ce - rt * 256);
        u.A = gather ? A : A + (size_t)u.row0 * (K * 2); u.B = W + (size_t)e * wstride + (size_t)ct * (BM * K * 2); return true;
    }
};
__device__ __forceinline__ void moe_tab_build(LAS int* tab, const unsigned* cnt, int NCT) {
    if (ltid() == 0) {
        int rs = 0; for (int e = 0; e < 32; ++e) { tab[33 + e] = rs; rs += (((int)cnt[e * 64] + 255) >> 8) * 256; } tab[65] = rs;
        for (int g = 0; g < 8; ++g) { int us = 0; for (int q = 0; q < 4; ++q) { tab[72 + g * 5 + q] = us; us += (((int)cnt[(g + 8 * q) * 64] + 255) >> 8) * NCT; } tab[72 + g * 5 + 4] = us; }
    }
    __syncthreads();
}

struct EpiBf16 {
    static constexpr bool PERM = true; bf16_t* O; int ldc; const float* bias;
    __device__ __forceinline__ void operator()(const f32x4 (&acc)[2][2][4][2], const Unit& u, int wr, int wc, int fr, int fq) const {
        const int row0 = u.row0 + wr * 64 + fr, col0 = u.pn * BM + wc * 32 + 8 * fq;
        f32x4 bv[2][2];
#pragma unroll
        for (int bj = 0; bj < 2; ++bj)
#pragma unroll
            for (int n = 0; n < 2; ++n) bv[bj][n] = bias ? *(const f32x4*)(bias + col0 + bj * HALF + 4 * n) : (f32x4){0.f, 0.f, 0.f, 0.f};
#pragma unroll
        for (int ai = 0; ai < 2; ++ai)
#pragma unroll
            for (int m = 0; m < 4; ++m) { bf16_t* rowp = O + (size_t)(row0 + ai * HALF + m * 16) * ldc + col0;
#pragma unroll
                for (int bj = 0; bj < 2; ++bj) { const f32x4 v0 = acc[ai][bj][m][0] + bv[bj][0], v1 = acc[ai][bj][m][1] + bv[bj][1];
                    u32x4 w; w.x = cvt_pk_bf16(v0[0], v0[1]); w.y = cvt_pk_bf16(v0[2], v0[3]); w.z = cvt_pk_bf16(v1[0], v1[1]); w.w = cvt_pk_bf16(v1[2], v1[3]);
                    *(u32x4*)(rowp + bj * HALF) = w; } }
    }
};
struct EpiF32 {
    static constexpr bool PERM = false; float* O; int ldc;
    __device__ __forceinline__ void operator()(const f32x4 (&acc)[2][2][4][2], const Unit& u, int wr, int wc, int fr, int fq) const {
        const int row0 = u.row0 + wr * 64 + fr, col0 = u.pn * BM + wc * 32 + 4 * fq;
#pragma unroll
        for (int ai = 0; ai < 2; ++ai)
#pragma unroll
            for (int m = 0; m < 4; ++m) { float* rowp = O + (size_t)(row0 + ai * HALF + m * 16) * ldc + col0;
#pragma unroll
                for (int bj = 0; bj < 2; ++bj)
#pragma unroll
                    for (int n = 0; n < 2; ++n) *(f32x4*)(rowp + bj * HALF + n * 16) = acc[ai][bj][m][n]; }
    }
};
struct EpiMoeUp {
    static constexpr bool PERM = true; bf16_t* ACT; const float* b1all;
    __device__ __forceinline__ void operator()(const f32x4 (&acc)[2][2][4][2], const Unit& u, int wr, int wc, int fr, int fq) const {
        const int col0 = u.pn * BM + wc * 32 + 8 * fq; const float* b1 = b1all + (size_t)u.e * 2048;
        f32x4 bv[2][2];
#pragma unroll
        for (int bj = 0; bj < 2; ++bj)
#pragma unroll
            for (int n = 0; n < 2; ++n) bv[bj][n] = *(const f32x4*)(b1 + col0 + bj * HALF + 4 * n);
#pragma unroll
        for (int ai = 0; ai < 2; ++ai)
#pragma unroll
            for (int m = 0; m < 4; ++m) { bf16_t* rowp = ACT + (size_t)(u.row0 + wr * 64 + fr + ai * HALF + m * 16) * 1024 + (col0 >> 1);
#pragma unroll
                for (int bj = 0; bj < 2; ++bj) { const f32x4 v0 = acc[ai][bj][m][0] + bv[bj][0], v1 = acc[ai][bj][m][1] + bv[bj][1];
                    float a[4];
#pragma unroll
                    for (int j = 0; j < 4; ++j) { const float gl = fminf(j < 2 ? v0[2 * j] : v1[2 * j - 4], 7.f), ln = fminf(fmaxf(j < 2 ? v0[2 * j + 1] : v1[2 * j - 3], -7.f), 7.f);
                        a[j] = gl * __builtin_amdgcn_rcpf(1.f + __builtin_amdgcn_exp2f(-1.702f * 1.4426950408889634f * gl)) * (ln + 1.f); }
                    u32x2 w; w.x = cvt_pk_bf16(a[0], a[1]); w.y = cvt_pk_bf16(a[2], a[3]);
                    *(u32x2*)(rowp + bj * 64) = w; } }
    }
};
struct EpiMoeDown {
    static constexpr bool PERM = true; bf16_t* Y; const float* b2all; const float* topw;
    __device__ __forceinline__ void operator()(const f32x4 (&acc)[2][2][4][2], const Unit& u, int wr, int wc, int fr, int fq) const {
        const int col0 = u.pn * BM + wc * 32 + 8 * fq; const float* b2 = b2all + (size_t)u.e * 1024;
        f32x4 bv[2][2];
#pragma unroll
        for (int bj = 0; bj < 2; ++bj)
#pragma unroll
            for (int n = 0; n < 2; ++n) bv[bj][n] = *(const f32x4*)(b2 + col0 + bj * HALF + 4 * n);
#pragma unroll
        for (int ai = 0; ai < 2; ++ai)
#pragma unroll
            for (int m = 0; m < 4; ++m) { const int r = wr * 64 + fr + ai * HALF + m * 16; const float tw = r < u.gcnt ? topw[u.gl[r]] : 0.f;
                bf16_t* rowp = Y + (size_t)(u.row0 + r) * 1024 + col0;
#pragma unroll
                for (int bj = 0; bj < 2; ++bj) { const f32x4 v0 = (acc[ai][bj][m][0] + bv[bj][0]) * tw, v1 = (acc[ai][bj][m][1] + bv[bj][1]) * tw;
                    u32x4 w; w.x = cvt_pk_bf16(v0[0], v0[1]); w.y = cvt_pk_bf16(v0[2], v0[3]); w.z = cvt_pk_bf16(v1[0], v1[1]); w.w = cvt_pk_bf16(v1[2], v1[3]);
                    *(u32x4*)(rowp + bj * HALF) = w; } }
    }
};

template <class Epi, class Sched, bool GATHER, bool ALIGN_EPI>
__device__ __forceinline__ void gphase(LAS unsigned char* lds, const Sched& S, const Epi& E) {
    const int tid = ltid();
    const int wid = __builtin_amdgcn_readfirstlane(tid >> 6), lane = tid & 63, wr = wid >> 2, wc = wid & 3, fr = lane & 15, fq = lane >> 4;
    constexpr int nt = K / BK;
    unsigned voffB[2], CA2[2]; int RA[2];
#pragma unroll
    for (int i = 0; i < 2; ++i) { int R, C; stage_rc(tid * 16 + i * 8192, R, C); const int Rb = Epi::PERM ? ((R & ~31) + perm32(R & 31)) : R;
        RA[i] = R; CA2[i] = (unsigned)C * 2u; voffB[i] = (unsigned)(Rb * K + C) * 2u; }
    constexpr size_t kstep = (size_t)(BK * 2), hstep = (size_t)HALF * K * 2;
    const unsigned ldsw = (unsigned)wid * 1024u;
    const int aoff = lds_byte(wr * 64 + fr, fq * 8), boff = lds_byte(wc * 32 + fr, fq * 8);
#define PG8_SA(b, h) (((b) * 2 + (h)) * HTB)
#define PG8_SB(b, h) ((4 + (b) * 2 + (h)) * HTB)
#define PG8_GL(gp, ldsoff) __builtin_amdgcn_global_load_lds((const unsigned*)(gp), (LAS unsigned*)(lds + (ldsoff)), 16, 0, 0)
#define PG8_STB(bufoff, gbase) do { PG8_GL((const char*)(gbase) + voffB[0], (bufoff) + ldsw); PG8_GL((const char*)(gbase) + voffB[1], (bufoff) + ldsw + 8192); } while (0)
#define PG8_STA(bufoff, gbase, o) do { PG8_GL((const char*)(gbase) + (o)[0], (bufoff) + ldsw); PG8_GL((const char*)(gbase) + (o)[1], (bufoff) + ldsw + 8192); } while (0)
#define PG8_LDA(dst, b, h) do { _Pragma("unroll") for (int m = 0; m < 4; ++m) _Pragma("unroll") for (int k = 0; k < 2; ++k) dst[m][k] = *(const LAS bf16x8*)(lds + PG8_SA(b, h) + aoff + m * 2048 + k * 1024); } while (0)
#define PG8_LDB(dst, b, h) do { _Pragma("unroll") for (int n = 0; n < 2; ++n) _Pragma("unroll") for (int k = 0; k < 2; ++k) dst[n][k] = *(const LAS bf16x8*)(lds + PG8_SB(b, h) + boff + n * 2048 + k * 1024); } while (0)
#define PG8_MMA(ai, bj, At, Bt) do { __builtin_amdgcn_s_setprio(1); _Pragma("unroll") for (int m = 0; m < 4; ++m) _Pragma("unroll") for (int n = 0; n < 2; ++n) _Pragma("unroll") for (int k = 0; k < 2; ++k) \
        acc[ai][bj][m][n] = __builtin_amdgcn_mfma_f32_16x16x32_bf16(Bt[n][k], At[m][k], acc[ai][bj][m][n], 0, 0, 0); __builtin_amdgcn_s_setprio(0); } while (0)
#define PG8_WAIT_V(n) asm volatile("s_waitcnt vmcnt(" #n ")" ::: "memory")
#define PG8_WAIT_L(n) asm volatile("s_waitcnt lgkmcnt(" #n ")" ::: "memory")
#define PG8_BAR __builtin_amdgcn_s_barrier()
#define PG8_SCHED __builtin_amdgcn_sched_barrier(0)
#define PG8_AOFFS(u, o) do { _Pragma("unroll") for (int h_ = 0; h_ < 2; ++h_) _Pragma("unroll") for (int i_ = 0; i_ < 2; ++i_) { \
        if (GATHER) { const int r_ = h_ * 128 + RA[i_]; const int tok_ = r_ < (u).gcnt ? ((u).gl[r_] >> 2) : 0; o[h_][i_] = (unsigned)tok_ * (unsigned)(K * 2) + CA2[i_]; } \
        else o[h_][i_] = (unsigned)((h_ * 128 + RA[i_]) * (K * 2)) + CA2[i_]; } } while (0)
    Unit cur, nxt; int ui = 0;
    if (!S.next(0, cur)) return;
    f32x4 acc[2][2][4][2];
#pragma unroll
    for (int a = 0; a < 2; ++a)
#pragma unroll
        for (int b = 0; b < 2; ++b)
#pragma unroll
            for (int m = 0; m < 4; ++m)
#pragma unroll
                for (int n = 0; n < 2; ++n) acc[a][b][m][n] = (f32x4){0.f, 0.f, 0.f, 0.f};
    bf16x8 At[4][2], B0[2][2], B1[2][2];
    unsigned oAc[2][2], oAn[2][2];
    PG8_AOFFS(cur, oAc);
    const char* cA = cur.A; const char* cB = cur.B;
    PG8_STB(PG8_SB(0, 0), cB); PG8_STB(PG8_SB(0, 1), cB + hstep); PG8_STA(PG8_SA(0, 0), cA, oAc[0]); PG8_STA(PG8_SA(0, 1), cA, oAc[1]);
    if (wr == 1) PG8_BAR;
    PG8_WAIT_V(2); PG8_BAR;
    PG8_STB(PG8_SB(1, 0), cB + kstep); PG8_STA(PG8_SA(1, 0), cA + kstep, oAc[0]); PG8_STB(PG8_SB(1, 1), cB + hstep + kstep);
    PG8_WAIT_V(6); PG8_BAR;
    for (;;) {
        const bool has_next = S.next(ui + 1, nxt);
        const char* nA = has_next ? nxt.A : cA; const char* nB = has_next ? nxt.B : cB;
        if (has_next) { PG8_AOFFS(nxt, oAn); } else {
#pragma unroll
            for (int h = 0; h < 2; ++h) { oAn[h][0] = oAc[h][0]; oAn[h][1] = oAc[h][1]; } }
#pragma unroll 1
        for (int t = 0; t < nt; t += 2) {
            const bool last = (t == nt - 2);
            const char* a1 = cA + (size_t)(t + 1) * kstep;
            const char* a2 = last ? nA : cA + (size_t)(t + 2) * kstep; const char* b2 = last ? nB : cB + (size_t)(t + 2) * kstep;
            const char* a3 = a2 + kstep; const char* b3 = b2 + kstep;
            unsigned o2[2][2];
#pragma unroll
            for (int h = 0; h < 2; ++h) { o2[h][0] = last ? oAn[h][0] : oAc[h][0]; o2[h][1] = last ? oAn[h][1] : oAc[h][1]; }
            PG8_LDB(B0, 0, 0); PG8_LDB(B1, 0, 1); PG8_SCHED; PG8_LDA(At, 0, 0); PG8_STA(PG8_SA(1, 1), a1, oAc[1]);
            PG8_WAIT_V(8); PG8_WAIT_L(0); PG8_BAR; PG8_MMA(0, 0, At, B0); PG8_MMA(0, 1, At, B1); PG8_BAR; PG8_SCHED;
            PG8_LDA(At, 0, 1); PG8_STB(PG8_SB(0, 0), b2); PG8_STB(PG8_SB(0, 1), b2 + hstep); PG8_STA(PG8_SA(0, 0), a2, o2[0]);
            PG8_WAIT_V(8); PG8_WAIT_L(0); PG8_BAR; PG8_MMA(1, 0, At, B0); PG8_MMA(1, 1, At, B1); PG8_BAR; PG8_SCHED;
            PG8_LDB(B0, 1, 0); PG8_LDB(B1, 1, 1); PG8_SCHED; PG8_LDA(At, 1, 0); PG8_STA(PG8_SA(0, 1), a2, o2[1]);
            PG8_WAIT_V(8); PG8_WAIT_L(0); PG8_BAR; PG8_MMA(0, 0, At, B0); PG8_MMA(0, 1, At, B1); PG8_BAR; PG8_SCHED;
            PG8_LDA(At, 1, 1); PG8_STB(PG8_SB(1, 0), b3); PG8_STB(PG8_SB(1, 1), b3 + hstep); PG8_STA(PG8_SA(1, 0), a3, o2[0]);
            PG8_WAIT_V(8); PG8_WAIT_L(0); PG8_BAR; PG8_MMA(1, 0, At, B0); PG8_MMA(1, 1, At, B1); PG8_BAR; PG8_SCHED;
        }
        if constexpr (ALIGN_EPI) { if (wr == 0) PG8_BAR; }
        E(acc, cur, wr, wc, fr, fq);
        if (!has_next) break;
#pragma unroll
        for (int a = 0; a < 2; ++a)
#pragma unroll
            for (int b = 0; b < 2; ++b)
#pragma unroll
                for (int m = 0; m < 4; ++m)
#pragma unroll
                    for (int n = 0; n < 2; ++n) acc[a][b][m][n] = (f32x4){0.f, 0.f, 0.f, 0.f};
        cur = nxt; cA = nA; cB = nB; ++ui;
#pragma unroll
        for (int h = 0; h < 2; ++h) { oAc[h][0] = oAn[h][0]; oAc[h][1] = oAn[h][1]; }
        if constexpr (ALIGN_EPI) { if (wr == 1) PG8_BAR; }
    }
    PG8_WAIT_V(0);
    if constexpr (!ALIGN_EPI) { if (wr == 0) PG8_BAR; }
    PG8_BAR;
#undef PG8_SA
#undef PG8_SB
#undef PG8_GL
#undef PG8_STA
#undef PG8_STB
#undef PG8_LDA
#undef PG8_LDB
#undef PG8_MMA
#undef PG8_WAIT_V
#undef PG8_WAIT_L
#undef PG8_BAR
#undef PG8_SCHED
#undef PG8_AOFFS
}
}

__device__ __forceinline__ unsigned pk2(float lo, float hi) { return (unsigned)f2bf(lo) | ((unsigned)f2bf(hi) << 16); }
__device__ __forceinline__ void transpose_item(const float* W, int ld, int nblk, bf16_t* WT, LAS float* scr, int item, int lane) {
    const int kb = item / nblk, nb = item - kb * nblk, k0 = 64 * kb, n0 = 32 * nb;
#pragma unroll 8
    for (int i = 0; i < 32; ++i) { const int kk = 2 * i + (lane >> 5); scr[kk * 33 + (lane & 31)] = W[(size_t)(k0 + kk) * ld + n0 + (lane & 31)]; }
    asm volatile("s_waitcnt lgkmcnt(0)" ::: "memory");
    const int c = lane & 7;
#pragma unroll
    for (int j = 0; j < 4; ++j) { const int n = (lane >> 3) + 8 * j; const LAS float* s = scr + (8 * c) * 33 + n;
        pg8::u32x4 o; o.x = pk2(s[0 * 33], s[1 * 33]); o.y = pk2(s[2 * 33], s[3 * 33]); o.z = pk2(s[4 * 33], s[5 * 33]); o.w = pk2(s[6 * 33], s[7 * 33]);
        *(pg8::u32x4*)(WT + (size_t)(n0 + n) * 1024 + k0 + 8 * c) = o; }
    asm volatile("s_waitcnt lgkmcnt(0)" ::: "memory");
}
__device__ __forceinline__ void d_convert_a(KP kp, LAS float* scr_all) {
    PH_IDS;
    const int lane = tid & 63; LAS float* scr = scr_all + (tid >> 6) * (64 * 33);
    constexpr int I_IN = 16 * 104, I_OUT = 16 * 32, I_W1 = 16 * 64, I_W2 = 16 * 32, I_L = I_IN + I_OUT + 32 * I_W1 + 32 * I_W2;
    GW_LOOP(it, 2 * I_L) {
        const int l = it / I_L; int r = it - l * I_L;
        if (r < I_IN) { transpose_item(p.w_in + (size_t)l * D * INW, INW, 104, WSP(bf16_t, WS_WIN_T) + (size_t)l * PW * 1024, scr, r, lane); continue; } r -= I_IN;
        if (r < I_OUT) { transpose_item(p.w_out + (size_t)l * D * D, 1024, 32, WSP(bf16_t, WS_WOUT_T) + (size_t)l * 1024 * 1024, scr, r, lane); continue; } r -= I_OUT;
        if (r < 32 * I_W1) { const int e = r / I_W1; transpose_item(p.exp_w1 + ((size_t)l * NEXP + e) * D * 2048, 2048, 64, WSP(bf16_t, WS_W1_T) + ((size_t)l * NEXP + e) * 2048 * 1024, scr, r - e * I_W1, lane); continue; } r -= 32 * I_W1;
        { const int e = r / I_W2; transpose_item(p.exp_w2 + ((size_t)l * NEXP + e) * D * D, 1024, 32, WSP(bf16_t, WS_W2_T) + ((size_t)l * NEXP + e) * 1024 * 1024, scr, r - e * I_W2, lane); }
    }
    GT_LOOP(idx, 2 * PW) { const int l = idx / PW, n = idx - l * PW; WSP(float, WS_BIAS_IN)[idx] = n < 3328 ? 0.f : p.gla_gate_b[l * 256 + n - 3328]; }
}
__device__ __forceinline__ void d_convert_b(KP kp, LAS float* scr_all) {
    PH_IDS;
    const int lane = tid & 63; LAS float* scr = scr_all + (tid >> 6) * (64 * 33);
    GW_LOOP(it, 2 * 128) { const int l = it >> 7; transpose_item(WSP(float, WS_WEFF) + (size_t)l * D * 256, 256, 8, WSP(bf16_t, WS_WIN_T) + ((size_t)l * PW + 3328) * 1024, scr, it & 127, lane); }
}

__device__ __forceinline__ void d_gemm_in(KP kp, int l, LAS unsigned char* lds) {
    PH_IDS;
    pg8::DenseOrder S; S.init(MALL, PW, gridDim.x, bid, WSP(bf16_t, WS_HB), WSP(bf16_t, WS_WIN_T) + (size_t)l * PW * 1024);
    pg8::EpiBf16 E{WSP(bf16_t, WS_PBUF), PW, WSP(float, WS_BIAS_IN) + l * PW};
    pg8::gphase<pg8::EpiBf16, pg8::DenseOrder, false, true>(lds, S, E);
}
__device__ __forceinline__ void d_gemm_out(KP kp, int l, LAS unsigned char* lds) {
    PH_IDS;
    pg8::DenseOrder S; S.init(nrows_l(l), 1024, gridDim.x, bid, WSP(bf16_t, WS_CONCAT), WSP(bf16_t, WS_WOUT_T) + (size_t)l * 1024 * 1024);
    pg8::EpiF32 E{WSP(float, WS_YBUF), 1024};
    pg8::gphase<pg8::EpiF32, pg8::DenseOrder, false, true>(lds, S, E);
}
__device__ __forceinline__ void d_moe_up(KP kp, int l, LAS unsigned char* lds) {
    PH_IDS;
    LAS int* tab = (LAS int*)(lds + pg8::STAGE_BYTES);
    const unsigned* cnt = WSP(unsigned, WS_CTL) + CW_CNT + l * 32 * 64;
    pg8::moe_tab_build(tab, cnt, 8);
    pg8::MoeOrder S{tab, (int)gridDim.x, bid, 8, (const char*)WSP(bf16_t, WS_HB), (const char*)(WSP(bf16_t, WS_W1_T) + (size_t)l * NEXP * 2048 * 1024), (size_t)2048 * 1024 * 2, WSP(int, WS_LIST), cnt, true};
    pg8::EpiMoeUp E{WSP(bf16_t, WS_ACT), p.exp_b1 + (size_t)l * NEXP * 2048};
    pg8::gphase<pg8::EpiMoeUp, pg8::MoeOrder, true, true>(lds, S, E);
}
__device__ __forceinline__ void d_moe_down(KP kp, int l, LAS unsigned char* lds) {
    PH_IDS;
    LAS int* tab = (LAS int*)(lds + pg8::STAGE_BYTES);
    const unsigned* cnt = WSP(unsigned, WS_CTL) + CW_CNT + l * 32 * 64;
    pg8::moe_tab_build(tab, cnt, 4);
    pg8::MoeOrder S{tab, (int)gridDim.x, bid, 4, (const char*)WSP(bf16_t, WS_ACT), (const char*)(WSP(bf16_t, WS_W2_T) + (size_t)l * NEXP * 1024 * 1024), (size_t)1024 * 1024 * 2, WSP(int, WS_LIST), cnt, false};
    pg8::EpiMoeDown E{WSP(bf16_t, WS_YSLOT), p.exp_b2 + (size_t)l * NEXP * 1024, WSP(float, WS_TOPW)};
    pg8::gphase<pg8::EpiMoeDown, pg8::MoeOrder, false, true>(lds, S, E);
}

constexpr int ATT_NT = 68;
constexpr float ATT_QSCALE = 0.17677669529663687f * 1.4426950408889634f;
__device__ __forceinline__ void d_prep_attn(KP kp) {
    PH_IDS;
    const bf16_t* PB = WSP(bf16_t, WS_PBUF);
    GT_LOOP(idx, MALL * 16) {
        const int row = idx >> 4, hm = (idx >> 1) & 7, ks = idx & 1, h = hm >> 1, m = hm & 1;
        const bool lat = row < NLAT; const int t = row & (SEQ - 1);
        const int ipos = ks == 0 ? (t >> 6) : (t & 63);
        const int cb = h * 64 + m * 32 + ks * 16;
        const pg8::u32x4* qs = (const pg8::u32x4*)(PB + (size_t)row * PW + PC_AQ + cb);
        const pg8::u32x4* ksrc = (const pg8::u32x4*)(PB + (size_t)row * PW + PC_AK + cb);
        pg8::u32x4 qa = qs[0], qb = qs[1], ka = ksrc[0], kb = ksrc[1];
        float qv[16], kv[16];
#pragma unroll
        for (int j = 0; j < 4; ++j) { qv[2 * j] = bf2f((bf16_t)(qa[j] & 0xffff)); qv[2 * j + 1] = bf2f((bf16_t)(qa[j] >> 16)); qv[8 + 2 * j] = bf2f((bf16_t)(qb[j] & 0xffff)); qv[9 + 2 * j] = bf2f((bf16_t)(qb[j] >> 16));
                                      kv[2 * j] = bf2f((bf16_t)(ka[j] & 0xffff)); kv[2 * j + 1] = bf2f((bf16_t)(ka[j] >> 16)); kv[8 + 2 * j] = bf2f((bf16_t)(kb[j] & 0xffff)); kv[9 + 2 * j] = bf2f((bf16_t)(kb[j] >> 16)); }
        float qo[16], ko[16];
#pragma unroll
        for (int j = 0; j < 8; ++j) {
            float cs = 1.f, sn = 0.f;
            if (lat) { const float* tb = WSP(float, WS_ROPE) + (ipos * 8 + j) * 2; cs = tb[0]; sn = tb[1]; }
            qo[j] = qv[j] * cs - qv[j + 8] * sn; qo[j + 8] = qv[j + 8] * cs + qv[j] * sn;
            ko[j] = kv[j] * cs - kv[j + 8] * sn; ko[j + 8] = kv[j + 8] * cs + kv[j] * sn;
        }
        pg8::u32x4 o0, o1;
#pragma unroll
        for (int j = 0; j < 4; ++j) { o0[j] = pk2(qo[2 * j] * ATT_QSCALE, qo[2 * j + 1] * ATT_QSCALE); o1[j] = pk2(qo[8 + 2 * j] * ATT_QSCALE, qo[9 + 2 * j] * ATT_QSCALE); }
        pg8::u32x4* qd = (pg8::u32x4*)(WSP(bf16_t, WS_QRP) + (size_t)row * 256 + cb); qd[0] = o0; qd[1] = o1;
#pragma unroll
        for (int j = 0; j < 4; ++j) { o0[j] = pk2(ko[2 * j], ko[2 * j + 1]); o1[j] = pk2(ko[8 + 2 * j], ko[9 + 2 * j]); }
        int b, tile, key; if (lat) { b = row >> 12; tile = t >> 6; key = t & 63; } else { const int r = row - NLAT; b = r >> 8; tile = 64 + ((r & 255) >> 6); key = r & 63; }
        unsigned char* img = WSP(unsigned char, WS_KIMG) + ((size_t)(b * 4 + h) * ATT_NT + tile) * 8192 + key * 128;
        const int c0 = m * 4 + ks * 2, sw = (key >> 1) & 7;
        *(pg8::u32x4*)(img + 16 * (c0 ^ sw)) = o0; *(pg8::u32x4*)(img + 16 * ((c0 + 1) ^ sw)) = o1;
    }
    GT_LOOP(idx, 16 * ATT_NT * 2 * 64) {
        const int d = idx & 63, half = (idx >> 6) & 1, tile = (idx >> 7) % ATT_NT, bh = idx / (128 * ATT_NT), b = bh >> 2, h = bh & 3;
        const int row0 = (tile < 64 ? b * SEQ + tile * 64 : NLAT + b * CTXL + (tile - 64) * 64) + half * 32;
        const bf16_t* vp = PB + (size_t)row0 * PW + PC_AV + h * 64 + d;
        unsigned short vv[32];
#pragma unroll
        for (int j = 0; j < 32; ++j) vv[j] = vp[(size_t)j * PW];
        unsigned char* img = WSP(unsigned char, WS_VIMG) + ((size_t)bh * ATT_NT + tile) * 8192 + d * 128; const int x = (d >> 1) & 15;
#pragma unroll
        for (int j = 0; j < 8; ++j) *(pg8::u32x2*)(img + 8 * ((half * 8 + j) ^ x)) = (pg8::u32x2){(unsigned)vv[4 * j] | ((unsigned)vv[4 * j + 1] << 16), (unsigned)vv[4 * j + 2] | ((unsigned)vv[4 * j + 3] << 16)};
    }
}

namespace att {
typedef short bf16x8 __attribute__((ext_vector_type(8)));
typedef float f32x16 __attribute__((ext_vector_type(16)));
typedef unsigned u32x4 __attribute__((ext_vector_type(4)));
typedef unsigned u32x2 __attribute__((ext_vector_type(2)));
constexpr int SLOT = 8192, NSLOT = 4, LDS_K = 0, LDS_V = NSLOT * SLOT, LDS_SCR = 2 * NSLOT * SLOT;
constexpr float THR = 8.f;
__device__ __forceinline__ int crow(int r, int hi) { return (r & 3) + 8 * (r >> 2) + 4 * hi; }
__device__ __forceinline__ unsigned cvtpk(float lo, float hi) { return cvtpk_rne(lo, hi); }
__device__ __forceinline__ float xhalf_max(float v) { return fmaxf(v, __shfl_xor(v, 32)); }
}
__device__ __forceinline__ void attn_unit(KP kp, int l, int b, int h, int qt, LAS unsigned char* lds, float lam, float lam_init, int tid) {
    using namespace att;
    const int lane = tid & 63, wid = __builtin_amdgcn_readfirstlane(tid >> 6), q32 = lane & 31, hi = lane >> 5;
    const int t0 = qt < 0 ? 64 : 0, t1 = ATT_NT;
    const int rowbase = (qt < 0 ? NLAT + b * CTXL : b * SEQ + qt * 256) + wid * 32;
    const unsigned char* kimg = WSP(unsigned char, WS_KIMG) + (size_t)(b * 4 + h) * ATT_NT * 8192 + wid * 1024 + lane * 16;
    const unsigned char* vimg = WSP(unsigned char, WS_VIMG) + (size_t)(b * 4 + h) * ATT_NT * 8192 + wid * 1024 + lane * 16;
    LAS float* scr = (LAS float*)(lds + LDS_SCR) + wid * 64;
#define ATT_DMA(t, slot) do { __builtin_amdgcn_global_load_lds((const unsigned*)(kimg + (size_t)(t) * 8192), (LAS unsigned*)(lds + LDS_K + (slot) * SLOT + wid * 1024), 16, 0, 0); \
                              __builtin_amdgcn_global_load_lds((const unsigned*)(vimg + (size_t)(t) * 8192), (LAS unsigned*)(lds + LDS_V + (slot) * SLOT + wid * 1024), 16, 0, 0); } while (0)
    bf16x8 qf[2][2];
    { const bf16_t* qp = WSP(bf16_t, WS_QRP) + (size_t)(rowbase + q32) * 256 + h * 64 + hi * 8;
#pragma unroll
      for (int m = 0; m < 2; ++m)
#pragma unroll
        for (int ks = 0; ks < 2; ++ks) qf[m][ks] = *(const bf16x8*)(qp + m * 32 + ks * 16); }
    asm volatile("s_waitcnt vmcnt(0)" ::: "memory");
    __builtin_amdgcn_s_barrier();
    ATT_DMA(t0, 0); ATT_DMA(t0 + 1, 1); ATT_DMA(t0 + 2, 2);
    asm volatile("s_waitcnt vmcnt(4)" ::: "memory");
    __builtin_amdgcn_s_barrier();
    f32x16 O[2][2];
#pragma unroll
    for (int m = 0; m < 2; ++m)
#pragma unroll
        for (int dh = 0; dh < 2; ++dh)
#pragma unroll
            for (int r = 0; r < 16; ++r) O[m][dh][r] = 0.f;
    float mref[2] = {0.f, 0.f}, lsum[2] = {0.f, 0.f};
    const int koff = q32 * 128, ksw = (q32 >> 1) & 7;
    int slot = 0;
#pragma unroll 1
    for (int t = t0; t < t1; ++t) {
        asm volatile("s_waitcnt vmcnt(0)" ::: "memory");
        __builtin_amdgcn_s_barrier();
        asm volatile("" ::: "memory");
        if (t + 3 < t1) { const int s3 = (slot + 3) & 3; ATT_DMA(t + 3, s3); }
        const LAS unsigned char* Ks = lds + LDS_K + slot * SLOT; const LAS unsigned char* Vs = lds + LDS_V + slot * SLOT;
        u32x4 ppk[2][2][2];
#pragma unroll
        for (int m = 0; m < 2; ++m) {
            f32x16 S[2];
            { const float nm = -mref[m];
#pragma unroll
              for (int r = 0; r < 16; ++r) { S[0][r] = nm; S[1][r] = nm; } }
#pragma unroll
            for (int kh = 0; kh < 2; ++kh)
#pragma unroll
                for (int ks = 0; ks < 2; ++ks) {
                    const bf16x8 kf = *(const LAS bf16x8*)(Ks + kh * 4096 + koff + 16 * ((m * 4 + ks * 2 + hi) ^ ksw));
                    S[kh] = __builtin_amdgcn_mfma_f32_32x32x16_bf16(kf, qf[m][ks], S[kh], 0, 0, 0);
                }
            float mx = fmaxf(S[0][0], S[1][0]);
#pragma unroll
            for (int r = 1; r < 16; ++r) mx = fmaxf(mx, fmaxf(S[0][r], S[1][r]));
            mx = xhalf_max(mx);
            const bool first = (t == t0);
            if (__any(first || mx > THR)) {
                const float dl = first ? mx : fmaxf(mx, 0.f);
                mref[m] += dl;
#pragma unroll
                for (int r = 0; r < 16; ++r) { S[0][r] -= dl; S[1][r] -= dl; }
                const float f = __builtin_amdgcn_exp2f(-dl);
                lsum[m] *= f;
                if (!first) {
                    if (hi == 0) scr[q32] = f;
                    asm volatile("s_waitcnt lgkmcnt(0)" ::: "memory");
#pragma unroll
                    for (int r = 0; r < 16; ++r) { const float fr = scr[crow(r, hi)]; O[m][0][r] *= fr; O[m][1][r] *= fr; }
                    asm volatile("s_waitcnt lgkmcnt(0)" ::: "memory");
                }
            }
            float ls = 0.f;
#pragma unroll
            for (int kh = 0; kh < 2; ++kh) {
#pragma unroll
                for (int r = 0; r < 16; ++r) { S[kh][r] = __builtin_amdgcn_exp2f(S[kh][r]); ls += S[kh][r]; }
#pragma unroll
                for (int s = 0; s < 2; ++s)
#pragma unroll
                    for (int j = 0; j < 4; ++j) ppk[m][kh][s][j] = cvtpk(S[kh][8 * s + 2 * j], S[kh][8 * s + 2 * j + 1]);
            }
            lsum[m] += ls;
        }
#pragma unroll
        for (int kh = 0; kh < 2; ++kh)
#pragma unroll
            for (int s = 0; s < 2; ++s)
#pragma unroll
                for (int dh = 0; dh < 2; ++dh) {
                    const int d = dh * 32 + q32, kc = 8 * kh + 4 * s + hi, vsw = (d >> 1) & 15;
                    const u32x2 v0 = *(const LAS u32x2*)(Vs + d * 128 + 8 * (kc ^ vsw)), v1 = *(const LAS u32x2*)(Vs + d * 128 + 8 * ((kc + 2) ^ vsw));
                    const u32x4 vv = (u32x4){v0.x, v0.y, v1.x, v1.y};
                    const bf16x8 vf = __builtin_bit_cast(bf16x8, vv);
#pragma unroll
                    for (int m = 0; m < 2; ++m) O[m][dh] = __builtin_amdgcn_mfma_f32_32x32x16_bf16(__builtin_bit_cast(bf16x8, ppk[m][kh][s]), vf, O[m][dh], 0, 0, 0);
                }
        asm volatile("s_waitcnt lgkmcnt(0)" ::: "memory");
        slot = (slot + 1) & 3;
    }
#undef ATT_DMA
    float il[2][16];
#pragma unroll
    for (int m = 0; m < 2; ++m) { const float lt = lsum[m] + __shfl_xor(lsum[m], 32); if (hi == 0) scr[m * 32 + q32] = 1.f / lt; }
    asm volatile("s_waitcnt lgkmcnt(0)" ::: "memory");
#pragma unroll
    for (int m = 0; m < 2; ++m)
#pragma unroll
        for (int r = 0; r < 16; ++r) il[m][r] = scr[m * 32 + crow(r, hi)];
    asm volatile("s_waitcnt lgkmcnt(0)" ::: "memory");
    const float g0 = p.diff_subln_g[l * 64 + q32] * (1.f - lam_init), g1 = p.diff_subln_g[l * 64 + 32 + q32] * (1.f - lam_init);
    bf16_t* outp = WSP(bf16_t, WS_CONCAT) + (size_t)rowbase * D + h * 64 + q32;
#pragma unroll
    for (int r = 0; r < 16; ++r) {
        const float o0 = O[0][0][r] * il[0][r] - lam * O[1][0][r] * il[1][r], o1 = O[0][1][r] * il[0][r] - lam * O[1][1][r] * il[1][r];
        float ss = o0 * o0 + o1 * o1;
#pragma unroll
        for (int x = 1; x < 32; x <<= 1) ss += __shfl_xor(ss, x);
        const float rstd = rsqrtf(ss * (1.f / 64.f) + EPS);
        bf16_t* op = outp + (size_t)crow(r, hi) * D;
        op[0] = f2bf(o0 * rstd * g0); op[32] = f2bf(o1 * rstd * g1);
    }
}
__device__ __forceinline__ void d_attn_fast(KP kp, int l, LAS unsigned char* lds) {
    PH_IDS;
    const float* dl = p.diff_lambda + l * 4 * 32;
    float s1 = 0.f, s2 = 0.f;
    for (int i = 0; i < 32; ++i) { s1 += dl[i] * dl[32 + i]; s2 += dl[64 + i] * dl[96 + i]; }
    const float lam_init = 0.8f - 0.6f * expf(-0.3f * (float)l);
    const float lam = expf(s1) - expf(s2) + lam_init;
    const int G = gridDim.x, vb = (G % 8 == 0) ? (bid % 8) * (G / 8) + bid / 8 : bid;
    const int nunits = 256 + (l == 0 ? 16 : 0);
    for (int u = vb; u < nunits; u += G) {
        if (u < 256) attn_unit(kp, l, u >> 6, (u >> 4) & 3, u & 15, lds, lam, lam_init, tid);
        else attn_unit(kp, l, (u - 256) >> 2, (u - 256) & 3, -1, lds, lam, lam_init, tid);
    }
    __syncthreads();
}

constexpr int NCHUNK = MALL / 64;
__device__ __forceinline__ float logsig16(float x) { const float y = __builtin_amdgcn_exp2f(-fabsf(x) * 1.4426950408889634f); return (fminf(x, 0.f) - __builtin_amdgcn_logf(1.f + y) * 0.6931471805599453f) * (1.f / 16.f); }
__device__ __forceinline__ void d_prep_scan(KP kp) {
    PH_IDS;
    const bf16_t* PB = WSP(bf16_t, WS_PBUF);
    GT_LOOP(idx, 8 * MALL) {
        const int row = idx % MALL, hk = idx / MALL, h = hk >> 1, ks = hk & 1;
        const bool lat = row < NLAT; const int t = row & (SEQ - 1);
        const int ipos = ks == 0 ? (t >> 6) : (t & 63);
        const int cb = h * 64 + ks * 32;
        const pg8::u32x4* qs = (const pg8::u32x4*)(PB + (size_t)row * PW + PC_RQ + cb);
        const pg8::u32x4* ksrc = (const pg8::u32x4*)(PB + (size_t)row * PW + PC_RK + cb);
        float qv[32], kv[32];
#pragma unroll
        for (int c4 = 0; c4 < 4; ++c4) { const pg8::u32x4 a = qs[c4], b4 = ksrc[c4];
#pragma unroll
            for (int j = 0; j < 4; ++j) { qv[c4 * 8 + 2 * j] = bf2f((bf16_t)(a[j] & 0xffff)); qv[c4 * 8 + 2 * j + 1] = bf2f((bf16_t)(a[j] >> 16)); kv[c4 * 8 + 2 * j] = bf2f((bf16_t)(b4[j] & 0xffff)); kv[c4 * 8 + 2 * j + 1] = bf2f((bf16_t)(b4[j] >> 16)); } }
        float qo[32], ko[32];
#pragma unroll
        for (int j = 0; j < 16; ++j) {
            float cs = 1.f, sn = 0.f;
            if (lat) { const float* tb = WSP(float, WS_ROPE) + 1024 + (ipos * 16 + j) * 2; cs = tb[0]; sn = tb[1]; }
            qo[j] = qv[j] * cs - qv[j + 16] * sn; qo[j + 16] = qv[j + 16] * cs + qv[j] * sn;
            ko[j] = (kv[j] * cs - kv[j + 16] * sn) * 0.125f; ko[j + 16] = (kv[j + 16] * cs + kv[j] * sn) * 0.125f;
        }
        pg8::u32x4* qd = (pg8::u32x4*)(WSP(bf16_t, WS_QF_R) + (size_t)row * 256 + cb); pg8::u32x4* kd = (pg8::u32x4*)(WSP(bf16_t, WS_KF_R) + (size_t)row * 256 + cb);
#pragma unroll
        for (int c4 = 0; c4 < 4; ++c4) { pg8::u32x4 a, b4;
#pragma unroll
            for (int j = 0; j < 4; ++j) { a[j] = pk2(qo[c4 * 8 + 2 * j], qo[c4 * 8 + 2 * j + 1]); b4[j] = pk2(ko[c4 * 8 + 2 * j], ko[c4 * 8 + 2 * j + 1]); }
            qd[c4] = a; kd[c4] = b4; }
        bf16_t* kt = WSP(bf16_t, WS_KT_R) + ((size_t)((row >> 6) * 4 + h) * 64 + ks * 32) * 64 + (row & 63);
#pragma unroll
        for (int i = 0; i < 32; ++i) kt[(size_t)i * 64] = f2bf(ko[i]);
    }
    GT_LOOP(idx, 4 * MALL) {
        const int row = idx % MALL, h = idx / MALL;
        const pg8::u32x4* ksrc = (const pg8::u32x4*)(PB + (size_t)row * PW + PC_GK + h * 32);
        bf16_t* kt = WSP(bf16_t, WS_KT_G) + ((size_t)((row >> 6) * 4 + h) * 32) * 64 + (row & 63);
#pragma unroll
        for (int c4 = 0; c4 < 4; ++c4) { const pg8::u32x4 a = ksrc[c4];
#pragma unroll
            for (int j = 0; j < 4; ++j) { kt[(size_t)(c4 * 8 + 2 * j) * 64] = (bf16_t)(a[j] & 0xffff); kt[(size_t)(c4 * 8 + 2 * j + 1) * 64] = (bf16_t)(a[j] >> 16); } }
    }
    GT_LOOP(idx, NCHUNK * 2 * 128) {
        const int hk = idx & 127, dir = (idx >> 7) & 1, cid = idx >> 8;
        const bf16_t* src = PB + (size_t)(cid * 64) * PW + PC_GD + dir * 128 + hk;
        float* cum = WSP(float, WS_CUM_G) + ((size_t)dir * MALL + cid * 64) * 128 + hk;
        float* cumt = WSP(float, WS_CUMT_G) + (((size_t)dir * NCHUNK + cid) * 128 + hk) * 64;
        float v[64];
#pragma unroll
        for (int j = 0; j < 64; ++j) v[j] = bf2f(src[(size_t)j * PW]);
#pragma unroll
        for (int j = 0; j < 64; ++j) v[j] = logsig16(v[j]);
        if (dir == 0) {
#pragma unroll
            for (int j = 1; j < 64; ++j) v[j] += v[j - 1];
        } else {
#pragma unroll
            for (int j = 62; j >= 0; --j) v[j] += v[j + 1];
        }
#pragma unroll
        for (int j = 0; j < 64; ++j) cum[(size_t)j * 128] = v[j];
#pragma unroll
        for (int j = 0; j < 16; ++j) *(pg8::f32x4*)(cumt + 4 * j) = (pg8::f32x4){v[4 * j], v[4 * j + 1], v[4 * j + 2], v[4 * j + 3]};
    }
    GT_LOOP(idx, 2 * NCHUNK * 4 * 2 * 64) {
        const int d = idx & 63, half = (idx >> 6) & 1, ch = (idx >> 7) % (NCHUNK * 4), mx = idx / (128 * NCHUNK * 4), h = ch & 3, cid = ch >> 2;
        const bf16_t* vp = PB + (size_t)(cid * 64 + half * 32) * PW + (mx == 0 ? PC_RV : PC_GV) + h * 64 + d;
        unsigned short vv[32];
#pragma unroll
        for (int j = 0; j < 32; ++j) vv[j] = vp[(size_t)j * PW];
        unsigned char* img = WSP(unsigned char, mx == 0 ? WS_VT_R : WS_VT_G) + (size_t)ch * 8192 + d * 128; const int x = (d >> 1) & 15;
#pragma unroll
        for (int j = 0; j < 8; ++j) *(pg8::u32x2*)(img + 8 * ((half * 8 + j) ^ x)) = (pg8::u32x2){(unsigned)vv[4 * j] | ((unsigned)vv[4 * j + 1] << 16), (unsigned)vv[4 * j + 2] | ((unsigned)vv[4 * j + 3] << 16)};
    }
}

namespace scn {
typedef short bf16x8 __attribute__((ext_vector_type(8)));
typedef float f32x16 __attribute__((ext_vector_type(16)));
typedef float f32x4 __attribute__((ext_vector_type(4)));
typedef unsigned u32x4 __attribute__((ext_vector_type(4)));
typedef unsigned u32x2 __attribute__((ext_vector_type(2)));
__device__ __forceinline__ int crow(int r, int hi) { return (r & 3) + 8 * (r >> 2) + 4 * hi; }
__device__ __forceinline__ unsigned cvtpk(float lo, float hi) { return cvtpk_rne(lo, hi); }
__device__ __forceinline__ float blo(unsigned w) { return __uint_as_float(w << 16); }
__device__ __forceinline__ float bhi(unsigned w) { return __uint_as_float(w & 0xffff0000u); }
__device__ __forceinline__ bf16x8 scale8(u32x4 raw, const float (&f)[8]) {
    u32x4 o;
#pragma unroll
    for (int j = 0; j < 4; ++j) o[j] = cvtpk(blo(raw[j]) * f[2 * j], bhi(raw[j]) * f[2 * j + 1]);
    return __builtin_bit_cast(bf16x8, o);
}
template <int MX> struct Cfg;
template <> struct Cfg<0> { static constexpr int DK = 64; };
template <> struct Cfg<1> { static constexpr int DK = 32; };
}
#define SCN_EXP(x) __builtin_amdgcn_exp2f((x) * 1.4426950408889634f)
template <int MX> __device__ __forceinline__ void scan_stage1_unit(KP kp, int l, int b, int h, int g, int tid) {
    using namespace scn;
    constexpr int DK = Cfg<MX>::DK, NKT = DK / 32, NE = DK * 64 / NT;
    const int lane = tid & 63, wid = __builtin_amdgcn_readfirstlane(tid >> 6), q32 = lane & 31, hi = lane >> 5;
    const int nch = g == 8 ? 4 : 8, cid0 = g == 8 ? 256 + 4 * b : b * 64 + 8 * g;
    float* US = WSP(float, MX == 0 ? WS_US_R : WS_US_G);
    const float* CUMT = WSP(float, WS_CUMT_G);
    if (wid < nch) {
        const int cid = cid0 + wid;
        const unsigned char* vimg = WSP(unsigned char, MX == 0 ? WS_VT_R : WS_VT_G) + (size_t)(cid * 4 + h) * 8192;
        const bf16_t* ktimg = WSP(bf16_t, MX == 0 ? WS_KT_R : WS_KT_G) + (size_t)(cid * 4 + h) * DK * 64;
        bf16x8 vb[2][4];
#pragma unroll
        for (int dh = 0; dh < 2; ++dh)
#pragma unroll
            for (int s = 0; s < 4; ++s) { const int d = dh * 32 + q32, x = (d >> 1) & 15, kc = 4 * s + 2 * hi;
                u32x4 v = *(const u32x4*)(vimg + d * 128 + 16 * ((kc ^ x) >> 1));
                if (x & 1) v = (u32x4){v.z, v.w, v.x, v.y};
                vb[dh][s] = __builtin_bit_cast(bf16x8, v); }
#pragma unroll 1
        for (int dir = 0; dir < 2; ++dir) {
            float lg = 0.f; if (MX == 0) lg = -expf(p.ret_decay[(l * 2 + dir) * 4 + h]);
#pragma unroll 1
            for (int kt = 0; kt < NKT; ++kt) {
                f32x16 U[2];
#pragma unroll
                for (int dh = 0; dh < 2; ++dh)
#pragma unroll
                    for (int r = 0; r < 16; ++r) U[dh][r] = 0.f;
                const int k = kt * 32 + q32;
                const float* ct = CUMT + (((size_t)dir * NCHUNK + cid) * 128 + h * 32 + (k & 31)) * 64;
                float E = 0.f; if (MX == 1) E = ct[dir == 0 ? 63 : 0];
#pragma unroll
                for (int s = 0; s < 4; ++s) {
                    const int j0 = 16 * s + 8 * hi;
                    const u32x4 raw = *(const u32x4*)(ktimg + (size_t)k * 64 + j0);
                    float f[8];
                    if (MX == 0) {
#pragma unroll
                        for (int jj = 0; jj < 8; ++jj) f[jj] = SCN_EXP(lg * (float)(dir == 0 ? 63 - (j0 + jj) : j0 + jj));
                    } else {
                        const f32x4 c0 = *(const f32x4*)(ct + j0), c1 = *(const f32x4*)(ct + j0 + 4);
#pragma unroll
                        for (int jj = 0; jj < 4; ++jj) { f[jj] = SCN_EXP(E - c0[jj]); f[4 + jj] = SCN_EXP(E - c1[jj]); }
                    }
                    const bf16x8 af = scale8(raw, f);
#pragma unroll
                    for (int dh = 0; dh < 2; ++dh) U[dh] = __builtin_amdgcn_mfma_f32_32x32x16_bf16(af, vb[dh][s], U[dh], 0, 0, 0);
                }
                float* up = US + ((((size_t)dir * NCHUNK + cid) * 4 + h) * DK + kt * 32 + 4 * hi) * 64 + q32;
#pragma unroll
                for (int dh = 0; dh < 2; ++dh)
#pragma unroll
                    for (int r = 0; r < 16; ++r) up[((r & 3) + 8 * (r >> 2)) * 64 + dh * 32] = U[dh][r];
            }
        }
    }
    asm volatile("s_waitcnt vmcnt(0)" ::: "memory");
    __syncthreads();
    const int k = (tid * NE) >> 6, d0 = (tid * NE) & 63;
#pragma unroll
    for (int dir = 0; dir < 2; ++dir) {
        float S[NE], Ap = 1.f;
#pragma unroll
        for (int e = 0; e < NE; ++e) S[e] = 0.f;
        float lg = 0.f; if (MX == 0) lg = -expf(p.ret_decay[(l * 2 + dir) * 4 + h]);
        for (int cc = 0; cc < nch; ++cc) {
            const int c = dir == 0 ? cc : nch - 1 - cc, cid = cid0 + c;
            float A;
            if (MX == 0) A = SCN_EXP(lg * 64.f); else A = SCN_EXP(CUMT[(((size_t)dir * NCHUNK + cid) * 128 + h * 32 + k) * 64 + (dir == 0 ? 63 : 0)]);
            const float* up = US + ((((size_t)dir * NCHUNK + cid) * 4 + h) * DK + k) * 64 + d0;
#pragma unroll
            for (int e = 0; e < NE; ++e) S[e] = A * S[e] + up[e];
            Ap *= A;
        }
        float* ug = WSP(float, MX == 0 ? WS_UG_R : WS_UG_G) + (((((size_t)dir * 4 + b) * 4 + h) * 9 + g) * DK + k) * 64 + d0;
#pragma unroll
        for (int e = 0; e < NE; ++e) ug[e] = S[e];
        if (d0 == 0) WSP(float, WS_AG)[((((MX * 2 + dir) * 4 + b) * 4 + h) * 9 + g) * 64 + k] = Ap;
    }
}
template <int MX> __device__ __forceinline__ void scan_stage2_unit(KP kp, int l, int b, int h, int g, LAS unsigned char* lds, int tid) {
    using namespace scn;
    constexpr int DK = Cfg<MX>::DK, NKS = DK / 16, NE = DK * 64 / NT, NCH16 = DK / 8;
    const int lane = tid & 63, wid = __builtin_amdgcn_readfirstlane(tid >> 6), q32 = lane & 31, hi = lane >> 5;
    const int nch = g == 8 ? 4 : 8, cid0 = g == 8 ? 256 + 4 * b : b * 64 + 8 * g;
    const bool act = wid < nch;
    const int cid = cid0 + (act ? wid : 0), row0 = cid * 64;
    const bf16_t* PB = WSP(bf16_t, WS_PBUF);
    const float* US = WSP(float, MX == 0 ? WS_US_R : WS_US_G);
    const float* UG = WSP(float, MX == 0 ? WS_UG_R : WS_UG_G);
    const float* CUMT = WSP(float, WS_CUMT_G);
    f32x16 o[2][2];
#pragma unroll
    for (int it = 0; it < 2; ++it)
#pragma unroll
        for (int dh = 0; dh < 2; ++dh)
#pragma unroll
            for (int r = 0; r < 16; ++r) o[it][dh][r] = 0.f;
    LAS unsigned char* myv = lds + 65536 + wid * 8192;
    { const unsigned char* vimg = WSP(unsigned char, MX == 0 ? WS_VT_R : WS_VT_G) + (size_t)(cid * 4 + h) * 8192 + lane * 16;
      u32x4 tmp[8];
#pragma unroll
      for (int i = 0; i < 8; ++i) tmp[i] = *(const u32x4*)(vimg + i * 1024);
#pragma unroll
      for (int i = 0; i < 8; ++i) *(LAS u32x4*)(myv + i * 1024 + lane * 16) = tmp[i]; }
    const int fk = (tid * NE) >> 6, fd0 = (tid * NE) & 63;
#pragma unroll 1
    for (int dir = 0; dir < 2; ++dir) {
        float lg = 0.f; if (MX == 0) lg = -expf(p.ret_decay[(l * 2 + dir) * 4 + h]);
        float S[NE];
#pragma unroll
        for (int e = 0; e < NE; ++e) S[e] = 0.f;
        if (g != 8) {
            const float* ugb = UG + (((size_t)dir * 4 + b) * 4 + h) * 9 * DK * 64 + (size_t)fk * 64 + fd0;
            const float* agb = WSP(float, WS_AG) + (((MX * 2 + dir) * 4 + b) * 4 + h) * 9 * 64 + fk;
            const int ng = dir == 0 ? g : 7 - g;
            float ug[7][NE], ag[7];
#pragma unroll
            for (int e = 0; e < NE; ++e) S[e] = ugb[(size_t)8 * DK * 64 + e];
#pragma unroll
            for (int q = 0; q < 7; ++q) { const int gg = dir == 0 ? q : 7 - q; const bool on = q < ng; ag[q] = on ? agb[gg * 64] : 1.f;
#pragma unroll
                for (int e = 0; e < NE; ++e) ug[q][e] = on ? ugb[(size_t)gg * DK * 64 + e] : 0.f; }
#pragma unroll
            for (int q = 0; q < 7; ++q)
#pragma unroll
                for (int e = 0; e < NE; ++e) S[e] = ag[q] * S[e] + ug[q][e];
        }
        {
            float uc[8][NE], ac[8];
#pragma unroll
            for (int cc = 0; cc < 8; ++cc) { const bool on = cc < nch; const int c = dir == 0 ? cc : nch - 1 - cc, ccid = cid0 + (on ? c : 0);
                if (MX == 0) ac[cc] = SCN_EXP(lg * 64.f); else ac[cc] = SCN_EXP(CUMT[(((size_t)dir * NCHUNK + ccid) * 128 + h * 32 + fk) * 64 + (dir == 0 ? 63 : 0)]);
                const float* up = US + ((((size_t)dir * NCHUNK + ccid) * 4 + h) * DK + fk) * 64 + fd0;
#pragma unroll
                for (int e = 0; e < NE; ++e) uc[cc][e] = up[e]; }
#pragma unroll
            for (int cc = 0; cc < 8; ++cc) if (cc < nch) {
                const int c = dir == 0 ? cc : nch - 1 - cc;
                LAS unsigned char* area = lds + c * 8192;
#pragma unroll
                for (int e = 0; e < NE; ++e) { const int d = fd0 + e; const int sw = DK == 64 ? ((d >> 1) & 7) : ((d >> 2) & 3);
                    *(LAS bf16_t*)(area + d * (DK * 2) + 16 * ((fk >> 3) ^ sw) + (fk & 7) * 2) = f2bf(S[e]); }
#pragma unroll
                for (int e = 0; e < NE; ++e) S[e] = ac[cc] * S[e] + uc[cc][e];
            }
        }
        asm volatile("s_waitcnt lgkmcnt(0)" ::: "memory");
        __syncthreads();
        if (act) {
#define SCN_GEN(dst, ISQ, T2) do { const int il_ = 32 * (T2) + q32, row_ = row0 + il_; \
                _Pragma("unroll") for (int ks = 0; ks < NKS; ++ks) { const int kc0 = 16 * ks + 8 * hi; u32x4 raw_; float f_[8]; \
                    if (MX == 0) { raw_ = *(const u32x4*)(WSP(bf16_t, (ISQ) ? WS_QF_R : WS_KF_R) + (size_t)row_ * 256 + h * 64 + kc0); \
                        const float cm_ = lg * (float)(dir == 0 ? il_ + 1 : 64 - il_), e_ = SCN_EXP((ISQ) ? cm_ : -cm_); \
                        _Pragma("unroll") for (int jj = 0; jj < 8; ++jj) f_[jj] = e_; \
                    } else { raw_ = *(const u32x4*)(PB + (size_t)row_ * PW + ((ISQ) ? PC_GQ : PC_GK) + h * 32 + kc0); \
                        const float* cp_ = WSP(float, WS_CUM_G) + ((size_t)dir * MALL + row_) * 128 + h * 32 + kc0; \
                        const f32x4 c0_ = *(const f32x4*)cp_, c1_ = *(const f32x4*)(cp_ + 4); \
                        _Pragma("unroll") for (int jj = 0; jj < 4; ++jj) { f_[jj] = (ISQ) ? SCN_EXP(c0_[jj]) * 0.17677669529663687f : SCN_EXP(-c0_[jj]); f_[4 + jj] = (ISQ) ? SCN_EXP(c1_[jj]) * 0.17677669529663687f : SCN_EXP(-c1_[jj]); } } \
                    dst[ks] = scale8(raw_, f_); } } while (0)
#define SCN_TILE(JT, IT, MASKED) do { bf16x8 kf_[NKS]; SCN_GEN(kf_, false, JT); f32x16 P; \
                _Pragma("unroll") for (int r = 0; r < 16; ++r) P[r] = 0.f; \
                _Pragma("unroll") for (int ks = 0; ks < NKS; ++ks) P = __builtin_amdgcn_mfma_f32_32x32x16_bf16(kf_[ks], qf[ks], P, 0, 0, 0); \
                if (MASKED) { _Pragma("unroll") for (int r = 0; r < 16; ++r) { const int j = crow(r, hi); const bool keep = dir == 0 ? (j <= q32) : (j >= q32); P[r] = keep ? P[r] : 0.f; } } \
                _Pragma("unroll") for (int s = 0; s < 2; ++s) { u32x4 pk; \
                    _Pragma("unroll") for (int j = 0; j < 4; ++j) pk[j] = cvtpk(P[8 * s + 2 * j], P[8 * s + 2 * j + 1]); \
                    _Pragma("unroll") for (int dh = 0; dh < 2; ++dh) { const int d = dh * 32 + q32, x = (d >> 1) & 15, kc = 8 * JT + 4 * s + hi; \
                        const u32x2 v0 = *(const LAS u32x2*)(myv + d * 128 + 8 * (kc ^ x)), v1 = *(const LAS u32x2*)(myv + d * 128 + 8 * ((kc + 2) ^ x)); \
                        o[IT][dh] = __builtin_amdgcn_mfma_f32_32x32x16_bf16(__builtin_bit_cast(bf16x8, pk), __builtin_bit_cast(bf16x8, (u32x4){v0.x, v0.y, v1.x, v1.y}), o[IT][dh], 0, 0, 0); } } } while (0)
#define SCN_INTER(IT) do { const LAS unsigned char* area = lds + wid * 8192; \
                _Pragma("unroll") for (int dh = 0; dh < 2; ++dh) _Pragma("unroll") for (int ks = 0; ks < NKS; ++ks) { \
                    const int d = dh * 32 + q32, sw = DK == 64 ? ((d >> 1) & 7) : ((d >> 2) & 3); \
                    const bf16x8 sf = *(const LAS bf16x8*)(area + d * (DK * 2) + 16 * ((2 * ks + hi) ^ sw)); \
                    o[IT][dh] = __builtin_amdgcn_mfma_f32_32x32x16_bf16(qf[ks], sf, o[IT][dh], 0, 0, 0); } } while (0)
            { bf16x8 qf[NKS]; SCN_GEN(qf, true, 0);
              SCN_TILE(0, 0, true); if (dir == 1) SCN_TILE(1, 0, false);
              SCN_INTER(0); }
            asm volatile("" ::: "memory");
            { bf16x8 qf[NKS]; SCN_GEN(qf, true, 1);
              if (dir == 0) SCN_TILE(0, 1, false);
              SCN_TILE(1, 1, true);
              SCN_INTER(1); }
#undef SCN_GEN
#undef SCN_TILE
#undef SCN_INTER
        }
        asm volatile("s_waitcnt lgkmcnt(0)" ::: "memory");
        __syncthreads();
    }
    if (act) {
        const int gcol = (MX == 0 ? PC_RG : PC_GR) + h * 64, ccol = (MX == 0 ? 512 : 768) + h * 64;
        const float g0 = MX == 0 ? p.ret_norm_g[l * 256 + h * 64 + q32] : p.gla_norm_g[l * 64 + q32], g1 = MX == 0 ? p.ret_norm_g[l * 256 + h * 64 + 32 + q32] : p.gla_norm_g[l * 64 + 32 + q32];
#pragma unroll
        for (int it = 0; it < 2; ++it)
#pragma unroll
            for (int r = 0; r < 16; ++r) {
                const int row = row0 + 32 * it + crow(r, hi);
                const float a0 = o[it][0][r], a1 = o[it][1][r];
                float ss = a0 * a0 + a1 * a1;
#pragma unroll
                for (int x = 1; x < 32; x <<= 1) ss += __shfl_xor(ss, x);
                const float rstd = rsqrtf(ss * (1.f / 64.f) + EPS);
                const float gt0 = bf2f(PB[(size_t)row * PW + gcol + q32]), gt1 = bf2f(PB[(size_t)row * PW + gcol + 32 + q32]);
                bf16_t* op = WSP(bf16_t, WS_CONCAT) + (size_t)row * D + ccol + q32;
                op[0] = f2bf(a0 * rstd * g0 * (gt0 / (1.f + SCN_EXP(-gt0)))); op[32] = f2bf(a1 * rstd * g1 * (gt1 / (1.f + SCN_EXP(-gt1))));
                if ((r & 3) == 3) asm volatile("" ::: "memory");
            }
    }
}
__device__ __forceinline__ bool scan_unit(int slot, bool with_ctx, int& mx, int& bh, int& g) {
    if (slot < 256) { mx = slot >> 7; const int r = slot & 127; bh = r >> 3; g = r & 7; return true; }
    if (!with_ctx) return false;
    const int j = slot - 256 - 128;
    if (j < 0 || j >= 32) return false;
    mx = j >> 4; bh = j & 15; g = 8; return true;
}
__device__ __forceinline__ void d_scan_stage1(KP kp, int l) {
    PH_IDS;
    for (int slot = bid; slot < 512; slot += gridDim.x) {
        int mx, bh, g; if (!scan_unit(slot, true, mx, bh, g)) continue;
        if (mx == 0) scan_stage1_unit<0>(kp, l, bh >> 2, bh & 3, g, tid); else scan_stage1_unit<1>(kp, l, bh >> 2, bh & 3, g, tid);
    }
}
__device__ __forceinline__ void d_scan_stage2(KP kp, int l, LAS unsigned char* lds) {
    PH_IDS;
    for (int slot = bid; slot < 512; slot += gridDim.x) {
        int mx, bh, g; if (!scan_unit(slot, l == 0, mx, bh, g)) continue;
        if (mx == 0) scan_stage2_unit<0>(kp, l, bh >> 2, bh & 3, g, lds, tid); else scan_stage2_unit<1>(kp, l, bh >> 2, bh & 3, g, lds, tid);
    }
}
namespace hfft {
typedef float f2 __attribute__((ext_vector_type(2)));
typedef float f4 __attribute__((ext_vector_type(4)));
constexpr int N = 8192;
__device__ __forceinline__ f2 cmul(f2 a, f2 b) { return (f2){a.x * b.x - a.y * b.y, a.x * b.y + a.y * b.x}; }
__device__ __forceinline__ f2 cmulc(f2 a, f2 b) { return (f2){a.x * b.x + a.y * b.y, a.y * b.x - a.x * b.y}; }
__device__ __forceinline__ f2 tw(float frac) { float sn, cs; sincosf(6.283185307179586f * frac, &sn, &cs); return (f2){cs, -sn}; }
constexpr int TWOFF = 131072 + 64;
__device__ __forceinline__ void tw_build(LAS unsigned char* lds, int tid) { LAS f2* T = (LAS f2*)(lds + TWOFF); for (int k = tid; k < 1024; k += NT) T[k] = tw((float)k * (1.f / 8192.f)); }
__device__ __forceinline__ f2 twk(const LAS f2* T, int k) {
    const f2 a = T[k & 1023]; const float r = 0.70710678118654752f;
    return (k & 1024) ? (f2){(a.x + a.y) * r, (a.y - a.x) * r} : a;
}
__device__ __forceinline__ f2 mul_mi(f2 a) { return (f2){a.y, -a.x}; }
__device__ __forceinline__ f2 mul_pi(f2 a) { return (f2){-a.y, a.x}; }
template <int LOGD> __device__ __forceinline__ void fwd_pass(LAS f2* buf, int tid) {
    constexpr int Dd = 1 << LOGD;
#pragma unroll
    for (int g = 0; g < 4; ++g) {
        const int u = tid + NT * g, pos = u & (Dd - 1), base = ((u - pos) << 2) + pos;
        const f2 wA = twk((const LAS f2*)((LAS unsigned char*)buf + TWOFF), pos << (11 - LOGD)), wB = cmul(wA, wA);
#pragma unroll
        for (int arr = 0; arr < 2; ++arr) {
            LAS f2* x = buf + arr * N + base;
            const f2 a0 = x[0], a1 = x[Dd], a2 = x[2 * Dd], a3 = x[3 * Dd];
            const f2 b0 = a0 + a2, b2 = cmul(a0 - a2, wA), b1 = a1 + a3, b3 = mul_mi(cmul(a1 - a3, wA));
            x[0] = b0 + b1; x[Dd] = cmul(b0 - b1, wB); x[2 * Dd] = b2 + b3; x[3 * Dd] = cmul(b2 - b3, wB);
        }
    }
    __syncthreads();
}
template <int LOGD> __device__ __forceinline__ void inv_pass(LAS f2* buf, int tid) {
    constexpr int Dd = 1 << LOGD;
#pragma unroll
    for (int g = 0; g < 4; ++g) {
        const int u = tid + NT * g, pos = u & (Dd - 1), base = ((u - pos) << 2) + pos;
        const f2 wA = twk((const LAS f2*)((LAS unsigned char*)buf + TWOFF), pos << (11 - LOGD)), wB = cmul(wA, wA);
#pragma unroll
        for (int arr = 0; arr < 2; ++arr) {
            LAS f2* x = buf + arr * N + base;
            const f2 c0 = x[0], c1 = cmulc(x[Dd], wB), c2 = x[2 * Dd], c3 = cmulc(x[3 * Dd], wB);
            const f2 b0 = c0 + c1, b1 = c0 - c1, b2 = cmulc(c2 + c3, wA), b3 = mul_pi(cmulc(c2 - c3, wA));
            x[0] = b0 + b2; x[2 * Dd] = b0 - b2; x[Dd] = b1 + b3; x[3 * Dd] = b1 - b3;
        }
    }
    __syncthreads();
}
__device__ __forceinline__ void fwd_all(LAS f2* buf, int tid) { fwd_pass<11>(buf, tid); fwd_pass<9>(buf, tid); fwd_pass<7>(buf, tid); fwd_pass<5>(buf, tid); fwd_pass<3>(buf, tid); fwd_pass<1>(buf, tid); }
__device__ __forceinline__ void inv_all(LAS f2* buf, int tid) { inv_pass<1>(buf, tid); inv_pass<3>(buf, tid); inv_pass<5>(buf, tid); inv_pass<7>(buf, tid); inv_pass<9>(buf, tid); inv_pass<11>(buf, tid); }
}
__device__ __forceinline__ void d_fspec(KP kp, LAS unsigned char* lds) {
    PH_IDS;
    using namespace hfft;
    LAS f2* buf = (LAS f2*)lds; LAS float* nrm = (LAS float*)(lds + 131072);
    tw_build(lds, tid);
    for (int u = bid; u < 256; u += gridDim.x) {
        const int l = u >> 7, c0 = (u & 127) * 2;
        const float* filt = WSP(float, WS_FILT) + (size_t)l * 8192 * 256;
        if (tid < 128) {
            const int arr = tid >> 6, ln = tid & 63; float a = 0.f;
#pragma unroll
            for (int q = 0; q < 4; ++q) a += WSP(float, WS_PS)[(size_t)(l * 256 + ln * 4 + q) * 256 + c0 + arr];
            a = wave_sum(a); if (ln == 0) nrm[arr] = a;
        }
        for (int i = tid; i < 2 * N; i += NT) { const int arr = i >> 13, tau = i & (N - 1); buf[i] = (f2){filt[(size_t)tau * 256 + c0 + arr], 0.f}; }
        __syncthreads();
        fwd_all(buf, tid);
        f4* fs = (f4*)(WSP(float, WS_FSPEC) + ((size_t)l * 256 + c0) * 2 * N);
        for (int i = tid; i < N; i += NT) {
            const int arr = i >> 12, j = i & 4095;
            const f4 v = *(const LAS f4*)(buf + arr * N + 2 * j);
            const float sc = 1.f / (8192.f * nrm[arr]), bs = p.hy_bias[l * 256 + c0 + arr] * (1.f / 8192.f);
            fs[(size_t)arr * (N / 2) + j] = (f4){(v.x + v.z) * sc + bs, (v.y + v.w) * sc, (v.x - v.z) * sc + bs, (v.y - v.w) * sc};
        }
        __syncthreads();
    }
}
__device__ __forceinline__ void d_hy_pre_fast(KP kp, int l, LAS unsigned char* lds) {
    PH_IDS;
    LAS float* zt = (LAS float*)lds;
    const bf16_t* PB = WSP(bf16_t, WS_PBUF);
    const int c = tid & 255, half = tid >> 8;
    const float* sw = p.hy_short_w + l * 3 * 768; const float* sb = p.hy_short_b + l * 768;
    float w0[3], w1[3], w2[3], bb[3];
#pragma unroll
    for (int g = 0; g < 3; ++g) { w0[g] = sw[g * 256 + c]; w1[g] = sw[768 + g * 256 + c]; w2[g] = sw[1536 + g * 256 + c]; bb[g] = sb[g * 256 + c]; }
    for (int u = bid; u < NLAT / 64; u += gridDim.x) {
        const int row0 = u * 64 + half * 32, t0 = (u * 64) & (SEQ - 1);
        const int tfirst = t0 + half * 32;
        float xin[3][34];
#pragma unroll
        for (int g = 0; g < 3; ++g) {
            const bf16_t* pp = PB + (size_t)row0 * PW + PC_HY + g * 256 + c;
#pragma unroll
            for (int i = 0; i < 34; ++i) { const int t = tfirst + i - 1; xin[g][i] = (t >= 0 && t < SEQ) ? bf2f(pp[(ptrdiff_t)(i - 1) * PW]) : 0.f; }
        }
#pragma unroll
        for (int i = 0; i < 32; ++i) {
            float uu[3];
#pragma unroll
            for (int g = 0; g < 3; ++g) uu[g] = bb[g] + w0[g] * xin[g][i] + w1[g] * xin[g][i + 1] + w2[g] * xin[g][i + 2];
            WSP(bf16_t, WS_X0B)[(size_t)(row0 + i) * 256 + c] = f2bf(uu[0]);
            zt[c * 65 + half * 32 + i] = uu[1] * uu[2];
        }
        __syncthreads();
        const int b = (u * 64) >> 12;
        for (int i = tid; i < 256 * 64; i += NT) { const int cc = i >> 6, tl = i & 63; WSP(float, WS_ZT)[((size_t)cc * 4 + b) * SEQ + t0 + tl] = zt[cc * 65 + tl]; }
        __syncthreads();
    }
    if (l == 0) {
        GT_LOOP(idx, NCTX * 256) {
            const int r = idx >> 8, cc = idx & 255, t = r & (CTXL - 1);
            const bf16_t* pp = PB + (size_t)(NLAT + r) * PW + PC_HY + cc;
            float uu[3];
#pragma unroll
            for (int g = 0; g < 3; ++g) { float a = sb[g * 256 + cc] + sw[768 + g * 256 + cc] * bf2f(pp[g * 256]);
                if (t > 0) a += sw[g * 256 + cc] * bf2f(pp[g * 256 - PW]); if (t < CTXL - 1) a += sw[1536 + g * 256 + cc] * bf2f(pp[g * 256 + PW]); uu[g] = a; }
            WSP(float, WS_X0C)[idx] = uu[0]; WSP(float, WS_ZC)[idx] = uu[1] * uu[2];
        }
    }
}
__device__ __forceinline__ void d_hy_fft(KP kp, int l, LAS unsigned char* lds) {
    PH_IDS;
    using namespace hfft;
    LAS f2* buf = (LAS f2*)lds;
    tw_build(lds, tid);
    for (int c = bid; c < 256; c += gridDim.x) {
        const float* zt = WSP(float, WS_ZT) + (size_t)c * 4 * SEQ;
        for (int i = tid; i < 2 * N; i += NT) { const int arr = i >> 13, t = i & (N - 1);
            buf[i] = t < SEQ ? (f2){zt[(size_t)(2 * arr) * SEQ + t], zt[(size_t)(2 * arr + 1) * SEQ + t]} : (f2){0.f, 0.f}; }
        __syncthreads();
        fwd_all(buf, tid);
        const f4* fs = (const f4*)(WSP(float, WS_FSPEC) + ((size_t)l * 256 + c) * 2 * N);
        for (int i = tid; i < N; i += NT) {
            const int arr = i >> 12, j = i & 4095;
            LAS f4* xp = (LAS f4*)(buf + arr * N + 2 * j);
            const f4 v = *xp; const f4 f = fs[j];
            const f2 s = cmul((f2){v.x + v.z, v.y + v.w}, (f2){f.x, f.y}), d = cmul((f2){v.x - v.z, v.y - v.w}, (f2){f.z, f.w});
            *xp = (f4){s.x + d.x, s.y + d.y, s.x - d.x, s.y - d.y};
        }
        __syncthreads();
        inv_all(buf, tid);
        float* yt = WSP(float, WS_YT) + (size_t)c * 4 * SEQ;
        for (int i = tid; i < 2 * SEQ; i += NT) { const int arr = i >> 12, t = i & (SEQ - 1); const f2 v = buf[arr * N + t];
            yt[(size_t)(2 * arr) * SEQ + t] = v.x; yt[(size_t)(2 * arr + 1) * SEQ + t] = v.y; }
        __syncthreads();
    }
}
__device__ __forceinline__ void d_hy_post(KP kp, int l, LAS unsigned char* lds) {
    PH_IDS;
    LAS float* yt = (LAS float*)lds;
    for (int u = bid; u < NLAT / 64; u += gridDim.x) {
        const int b = (u * 64) >> 12, t0 = (u * 64) & (SEQ - 1);
#pragma unroll 1
        for (int hb2 = 0; hb2 < 4; ++hb2) {
            float yv[8];
#pragma unroll
            for (int i = 0; i < 8; ++i) { const int idx = tid + (hb2 * 8 + i) * NT; yv[i] = WSP(float, WS_YT)[((size_t)(idx >> 6) * 4 + b) * SEQ + t0 + (idx & 63)]; }
#pragma unroll
            for (int i = 0; i < 8; ++i) { const int idx = tid + (hb2 * 8 + i) * NT; yt[(idx >> 6) * 65 + (idx & 63)] = yv[i]; }
            asm volatile("" ::: "memory");
        }
        __syncthreads();
        {
            const int c = tid & 255, th = tid >> 8;
#pragma unroll 1
            for (int hb2 = 0; hb2 < 4; ++hb2) {
                float x0v[8];
#pragma unroll
                for (int i = 0; i < 8; ++i) x0v[i] = bf2f(WSP(bf16_t, WS_X0B)[((size_t)u * 64 + 2 * (hb2 * 8 + i) + th) * 256 + c]);
#pragma unroll
                for (int i = 0; i < 8; ++i) { const int tl = 2 * (hb2 * 8 + i) + th; WSP(bf16_t, WS_CONCAT)[((size_t)u * 64 + tl) * D + 256 + c] = f2bf(x0v[i] * yt[c * 65 + tl]); }
                asm volatile("" ::: "memory");
            }
        }
        __syncthreads();
    }
    if (l == 0) {
        GT_LOOP(idx, NCTX * 256) {
            const int c = idx & 255, r = idx >> 8, t = r & (CTXL - 1), rb = r - t;
            const float* filt = WSP(float, WS_FILTC); const float* zc = WSP(float, WS_ZC);
            float nrm = 0.f;
#pragma unroll
            for (int q = 0; q < 16; ++q) nrm += WSP(float, WS_PS)[(size_t)(512 + q) * 256 + c];
            float y = 0.f;
#pragma unroll 32
            for (int s2 = 0; s2 < CTXL; ++s2) y += filt[(size_t)((t - s2) & (2 * CTXL - 1)) * 256 + c] * zc[(size_t)(rb + s2) * 256 + c];
            y = y / nrm + p.hy_bias[c] * zc[idx];
            WSP(bf16_t, WS_CONCAT)[(size_t)(NLAT + r) * D + 256 + c] = f2bf(WSP(float, WS_X0C)[idx] * y);
        }
    }
}
constexpr int CW_BAR = 32768;
__global__ void __launch_bounds__(NT, 2) mk_fwd(P kargs) {
    const KP kp0 = (KP)__builtin_amdgcn_kernarg_segment_ptr();
    KP kp = kp0;
#define LP ({ KP k_ = kp0; asm volatile("" : "+s"(k_)); k_; })
    unsigned char* const lds = g_lds;
    volatile LAS unsigned* misc = (volatile LAS unsigned*)((LAS unsigned char*)lds + LDS_MISC);
    if (threadIdx.x < 16) misc[threadIdx.x] = 0u;
    if ((threadIdx.x & 63) == 0) ((LAS int*)((LAS unsigned char*)lds + LDS_WTAB))[hw_wave_slot()] = threadIdx.x >> 6;
    __syncthreads();
    (void)xcd_barrier_post(WSP(unsigned, WS_CTL) + CW_BAR, misc);
#define GRID_BAR() do { XcdBarrier b_; { KP kp = LP; b_.bar = WSP(unsigned, WS_CTL) + CW_BAR; } b_.x = xb_xcc_id(); b_.st = (volatile LAS unsigned*)((LAS unsigned char*)lds + LDS_MISC); xcd_barrier(b_); } while (0)
    d_pro0(LP, (LAS float*)((LAS unsigned char*)lds + 98304)); d_filter(LP, (LAS float*)((LAS unsigned char*)lds + 73728)); d_convert_a(LP, (LAS float*)lds);
    GRID_BAR();
    d_pro1(LP); d_convert_b(LP, (LAS float*)lds);
    GRID_BAR();
    d_fspec(LP, (LAS unsigned char*)lds); d_norm1(LP, 0);
    GRID_BAR();
#pragma unroll 1
    for (int l = 0; l < DEPTH; ++l) {
        d_gemm_in(LP, l, (LAS unsigned char*)lds);
        GRID_BAR();
        d_prep_scan(LP); d_prep_attn(LP); d_hy_pre_fast(LP, l, (LAS unsigned char*)lds);
        GRID_BAR();
        d_scan_stage1(LP, l);
        d_hy_fft(LP, l, (LAS unsigned char*)lds);
        d_attn_fast(LP, l, (LAS unsigned char*)lds);
        GRID_BAR();
        d_scan_stage2(LP, l, (LAS unsigned char*)lds);
        d_hy_post(LP, l, (LAS unsigned char*)lds);
        GRID_BAR();
        d_gemm_out(LP, l, (LAS unsigned char*)lds);
        GRID_BAR();
        d_router(LP, l, (LAS float*)lds);
        GRID_BAR();
        d_moe_up(LP, l, (LAS unsigned char*)lds);
        GRID_BAR();
        d_moe_down(LP, l, (LAS unsigned char*)lds);
        GRID_BAR();
        d_combine(LP, l, (LAS int*)lds);
        GRID_BAR();
    }
}

#undef p
extern "C" void kernel_launch(void* const* d_in, const int* in_sizes, int n_in, void* d_out, int out_size, void* d_ws, size_t ws_size, hipStream_t stream) {
    if (n_in != 31 || ws_size < WS_END || out_size != NLAT * D) { fprintf(stderr, "kernel_launch: unexpected shapes (n_in %d ws %zu out %d)\n", n_in, ws_size, out_size); return; }
    static int grid = 0;
    if (grid == 0) {
        int dev = 0, cus = 0, per_cu = 0;
        if (hipGetDevice(&dev) != hipSuccess || hipDeviceGetAttribute(&cus, hipDeviceAttributeMultiprocessorCount, dev) != hipSuccess) { grid = -1; return; }
        if (hipFuncSetAttribute((const void*)mk_fwd, hipFuncAttributeMaxDynamicSharedMemorySize, LDS_BYTES) != hipSuccess) { fprintf(stderr, "hipFuncSetAttribute failed\n"); grid = -1; return; }
        if (hipOccupancyMaxActiveBlocksPerMultiprocessor(&per_cu, (const void*)mk_fwd, NT, LDS_BYTES) != hipSuccess || per_cu < 1) { fprintf(stderr, "occupancy query says %d\n", per_cu); }
        (void)hipGetLastError();
        grid = cus;
    }
    if (grid < 0) return;
    P hp{};
    const float** pp = (const float**)&hp;
    for (int i = 0; i < 31; ++i) pp[i] = (const float*)d_in[i];
    hp.out = (float*)d_out; hp.ws = (unsigned char*)d_ws;
    (void)hipMemsetAsync((char*)d_ws + WS_CTL, 0, 1 * MiB, stream);
    hipLaunchKernelGGL(mk_fwd, dim3(grid), dim3(NT), LDS_BYTES, stream, hp);
}
```

```cpp
#include <hip/hip_runtime.h>
#include <stdint.h>
#include <stdio.h>
#include <math.h>

constexpr int D = 1024, BATCH = 4, SEQ = 4096, CTXL = 256, DEPTH = 2;
constexpr int NLAT = BATCH * SEQ, NCTX = BATCH * CTXL, MALL = NLAT + NCTX;
constexpr int INW = 3360, PW = 3584;
constexpr int NEXP = 32, TOPK = 4;
constexpr float EPS = 1e-6f;
constexpr int PC_AQ = 0, PC_AK = 256, PC_AV = 512, PC_HY = 768, PC_RQ = 1536, PC_RK = 1792, PC_RV = 2048, PC_RG = 2304,
              PC_GQ = 2560, PC_GK = 2688, PC_GV = 2816, PC_GR = 3072, PC_GD = 3328;
constexpr int ACT_ROWS = MALL * TOPK + NEXP * 256;

typedef unsigned short bf16_t;
typedef float cvt_f32x2_t __attribute__((ext_vector_type(2))); typedef __bf16 cvt_bf16x2_t __attribute__((ext_vector_type(2)));
__device__ __forceinline__ unsigned cvtpk_rne(float lo, float hi) { cvt_f32x2_t v = {lo, hi}; cvt_bf16x2_t b = __builtin_convertvector(v, cvt_bf16x2_t); return __builtin_bit_cast(unsigned, b); }
__device__ __forceinline__ bf16_t f2bf(float f) { unsigned u = __float_as_uint(f); return (bf16_t)((u + 0x7fffu + ((u >> 16) & 1u)) >> 16); }
__device__ __forceinline__ float bf2f(bf16_t b) { return __uint_as_float(((unsigned)b) << 16); }

typedef unsigned gv4u __attribute__((ext_vector_type(4))); typedef float gv4f __attribute__((ext_vector_type(4)));
__device__ __forceinline__ float gblo(unsigned w) { return __uint_as_float(w << 16); }
__device__ __forceinline__ float gbhi(unsigned w) { return __uint_as_float(w & 0xffff0000u); }
constexpr size_t MiB = 1u << 20;
constexpr size_t WS_CTL = 0;
constexpr size_t WS_MOD = 1 * MiB;
constexpr size_t WS_WEFF = 3 * MiB;
constexpr size_t WS_FILT = 6 * MiB;
constexpr size_t WS_FILTC = WS_FILT + 16 * MiB;
constexpr size_t WS_XRES = 24 * MiB;
constexpr size_t WS_HB = WS_XRES + 68 * MiB;
constexpr size_t WS_PBUF = WS_HB + 34 * MiB;
constexpr size_t WS_CONCAT = WS_PBUF + 120 * MiB;
constexpr size_t WS_YBUF = WS_CONCAT + 34 * MiB;
constexpr size_t WS_QA = WS_YBUF + 68 * MiB;
constexpr size_t WS_KA = WS_QA + 17 * MiB;
constexpr size_t WS_QR = WS_KA + 17 * MiB;
constexpr size_t WS_KR = WS_QR + 17 * MiB;
constexpr size_t WS_OA = WS_KR + 17 * MiB;
constexpr size_t WS_Z = WS_OA + 34 * MiB;
constexpr size_t WS_X0 = WS_Z + 17 * MiB;
constexpr size_t WS_LA = WS_X0 + 17 * MiB;
constexpr size_t WS_OD = WS_LA + 17 * MiB;
constexpr size_t WS_TOPI = WS_OD + 68 * MiB;
constexpr size_t WS_TOPW = WS_TOPI + 1 * MiB;
constexpr size_t WS_LIST = WS_TOPW + 1 * MiB;
constexpr size_t WS_ACT = WS_LIST + 3 * MiB;
constexpr size_t WS_YSLOT = WS_ACT + 160 * MiB;
constexpr size_t WS_WIN_T = WS_YSLOT + 160 * MiB;
constexpr size_t WS_WOUT_T = WS_WIN_T + 14 * MiB;
constexpr size_t WS_W1_T = WS_WOUT_T + 4 * MiB;
constexpr size_t WS_W2_T = WS_W1_T + 256 * MiB;
constexpr size_t WS_BIAS_IN = WS_W2_T + 128 * MiB;
constexpr size_t WS_QRP = WS_BIAS_IN + 1 * MiB;
constexpr size_t WS_KIMG = WS_QRP + 9 * MiB;
constexpr size_t WS_VIMG = WS_KIMG + 9 * MiB;
constexpr size_t WS_QF_R = WS_VIMG + 9 * MiB;
constexpr size_t WS_KF_R = WS_QF_R + 9 * MiB;
constexpr size_t WS_KT_R = WS_KF_R + 9 * MiB;
constexpr size_t WS_KT_G = WS_KT_R + 9 * MiB;
constexpr size_t WS_VT_R = WS_KT_G + 5 * MiB;
constexpr size_t WS_VT_G = WS_VT_R + 9 * MiB;
constexpr size_t WS_CUM_G = WS_VT_G + 9 * MiB;
constexpr size_t WS_CUMT_G = WS_CUM_G + 17 * MiB;
constexpr size_t WS_US_R = WS_CUMT_G + 17 * MiB;
constexpr size_t WS_US_G = WS_US_R + 34 * MiB;
constexpr size_t WS_UG_R = WS_US_G + 17 * MiB;
constexpr size_t WS_UG_G = WS_UG_R + 5 * MiB;
constexpr size_t WS_AG = WS_UG_G + 3 * MiB;
constexpr size_t WS_ROPE = WS_AG + 1 * MiB;
constexpr size_t WS_FSPEC = WS_ROPE + 1 * MiB;
constexpr size_t WS_ZT = WS_FSPEC + 32 * MiB;
constexpr size_t WS_YT = WS_ZT + 16 * MiB;
constexpr size_t WS_X0B = WS_YT + 16 * MiB;
constexpr size_t WS_MODP = WS_X0B + 8 * MiB;
constexpr size_t WS_PS = WS_MODP + 4 * MiB;
constexpr size_t WS_ZC = WS_PS + 1 * MiB;
constexpr size_t WS_X0C = WS_ZC + 1 * MiB;
constexpr size_t WS_END = WS_X0C + 1 * MiB;
constexpr int CW_CNT = 1024;
constexpr int CW_NORM = 2048;

struct P {
    const float *x, *c, *ctx, *c_ctx, *w_mod, *b_mod, *norm_g, *w_in, *w_out, *diff_lambda, *diff_subln_g, *hy_short_w, *hy_short_b,
        *hy_w1, *hy_b1, *hy_w2, *hy_b2, *hy_w3, *hy_freq, *hy_bias, *ret_decay, *ret_norm_g, *gla_gate_w, *gla_gate_b, *gla_norm_g,
        *router_w, *router_b, *exp_w1, *exp_b1, *exp_w2, *exp_b2;
    float* out; unsigned char* ws;
};
typedef const __attribute__((address_space(4))) P* KP;
#define p (*kp)
#define WSP(T, off) ((T*)(p.ws + (off)))

__device__ __forceinline__ float wave_sum(float v) {
#pragma unroll
    for (int o = 1; o < 64; o <<= 1) v += __shfl_xor(v, o);
    return v;
}
__device__ __forceinline__ float silu_f(float x) { return x / (1.f + expf(-x)); }
__host__ __device__ __forceinline__ int nrows_l(int l) { return l == 0 ? MALL : NLAT; }
__device__ __forceinline__ int mod_r(int row) { return row < NLAT ? row / SEQ : 4; }
__device__ __forceinline__ void seq_info(int row, int& base, int& n, int& t) {
    if (row < NLAT) { base = row & ~(SEQ - 1); n = SEQ; t = row - base; }
    else { int r = row - NLAT; base = NLAT + (r & ~(CTXL - 1)); n = CTXL; t = row - base; }
}

__device__ __forceinline__ int ltid();
#define XB_TMO      128
#define XB_XCNT(j)  (256  + 64 * (j))
#define XB_XSUB(j)  (1280 + 64 * (j))
#define XB_XGEN(j)  (2304 + 64 * (j))
#define XB_TOP      3328
#define XB_TOPGEN   3392
#define XCD_BAR_WORDS 3456
#define XB_SPIN_CAP (1u << 22)
#define LAS __attribute__((address_space(3)))
__device__ __forceinline__ unsigned xb_ld(unsigned* ptr)            { return __hip_atomic_load(ptr, __ATOMIC_RELAXED, __HIP_MEMORY_SCOPE_AGENT); }
__device__ __forceinline__ unsigned xb_add(unsigned* ptr, unsigned v) { return __hip_atomic_fetch_add(ptr, v, __ATOMIC_RELAXED, __HIP_MEMORY_SCOPE_AGENT); }
__device__ __forceinline__ unsigned xb_xcc_id() { return (unsigned)__builtin_amdgcn_s_getreg((3 << 11) | 20) & 0xFu; }
#define XB_SPIN(cond, bar) do { unsigned _sp = 0; while (cond) { __builtin_amdgcn_s_sleep(1); \
    if ((++_sp & 255u) == 0u) { if (xb_ld(&(bar)[XB_TMO])) break; if (_sp > XB_SPIN_CAP) { atomicAdd(&(bar)[XB_TMO], 1u); break; } } } } while (0)
struct XcdBarrier { unsigned* bar; unsigned x; volatile LAS unsigned* st; };
__device__ __forceinline__ XcdBarrier xcd_barrier_post(unsigned* bar, volatile LAS unsigned* st) {
    XcdBarrier b; b.bar = bar; b.x = xb_xcc_id(); b.st = st;
    if (threadIdx.x == 0) (void)xb_add(&bar[XB_XCNT(b.x)], 1u);
    return b;
}
__device__ __forceinline__ void xcd_barrier_complete(unsigned* bar, unsigned x, unsigned& nloc, unsigned& nx) {
    const unsigned G = gridDim.x * gridDim.y * gridDim.z;
    unsigned sum, cnt, mine, sp = 0u;
    for (;;) {
        sum = 0u; cnt = 0u; mine = 0u;
#pragma unroll
        for (unsigned j = 0; j < 16; ++j) { const unsigned c = xb_ld(&bar[XB_XCNT(j)]); sum += c; cnt += (c > 0u) ? 1u : 0u; mine = (j == x) ? c : mine; }
        if (sum == G) break;
        __builtin_amdgcn_s_sleep(1);
        if ((++sp & 255u) == 0u) { if (xb_ld(&bar[XB_TMO])) break; if (sp > XB_SPIN_CAP) { atomicAdd(&bar[XB_TMO], 1u); break; } }
    }
    nloc = mine > 0u ? mine : 1u; nx = cnt > 0u ? cnt : 1u;
}
__device__ __forceinline__ void xcd_barrier(const XcdBarrier& b) {
    asm volatile("s_waitcnt vmcnt(0)" ::: "memory");
    __syncthreads();
    if (ltid() == 0) {
        unsigned* bar = b.bar;
        __builtin_amdgcn_s_waitcnt(0);
        unsigned nloc = b.st[0], nx = b.st[1];
        if (nloc == 0u) { xcd_barrier_complete(bar, b.x, nloc, nx); b.st[0] = nloc; b.st[1] = nx; }
        const unsigned old = xb_add(&bar[XB_XSUB(b.x)], 1u);
        const unsigned gen = old / nloc;
        if (old + 1u == (gen + 1u) * nloc) {
            __builtin_amdgcn_fence(__ATOMIC_RELEASE, "agent");
            asm volatile("s_waitcnt vmcnt(0)" ::: "memory");
            const unsigned og = xb_add(&bar[XB_TOP], 1u);
            const unsigned tg = og / nx;
            if (og + 1u == (tg + 1u) * nx) xb_add(&bar[XB_TOPGEN], 1u);
            else XB_SPIN(xb_ld(&bar[XB_TOPGEN]) == tg, bar);
            __builtin_amdgcn_fence(__ATOMIC_ACQUIRE, "agent");
            xb_add(&bar[XB_XGEN(b.x)], 1u);
            asm volatile("s_waitcnt vmcnt(0)" ::: "memory");
        } else {
            XB_SPIN(xb_ld(&bar[XB_XGEN(b.x)]) == gen, bar);
            __builtin_amdgcn_fence(__ATOMIC_ACQUIRE, "agent");
            asm volatile("s_waitcnt vmcnt(0)" ::: "memory");
        }
    }
    __syncthreads();
}

constexpr int NT = 512;
extern __shared__ __attribute__((aligned(16))) unsigned char g_lds[];
constexpr int LDS_BYTES = 147456;
constexpr int LDS_WTAB = LDS_BYTES - 512;
constexpr int LDS_MISC = LDS_BYTES - 64;
__device__ __forceinline__ int hw_wave_slot() { return (int)(__builtin_amdgcn_s_getreg((5 << 11) | 4) & 63u); }
__device__ __forceinline__ int ltid() {
    const int w = __builtin_amdgcn_readfirstlane(((const LAS int*)((LAS unsigned char*)g_lds + LDS_WTAB))[hw_wave_slot()]);
    unsigned ones = ~0u; asm volatile("" : "+s"(ones));
    int t = (w << 6) | (int)__builtin_amdgcn_mbcnt_hi(ones, __builtin_amdgcn_mbcnt_lo(ones, 0u));
    asm volatile("" : "+v"(t)); return t;
}
__device__ __forceinline__ int lbid() { int b = blockIdx.x; asm volatile("" : "+s"(b)); return b; }
#define PH_IDS const int tid = ltid(), bid = lbid(); (void)tid; (void)bid
#define GT_LOOP(idx, total) for (int idx = bid * NT + tid; idx < (total); idx += gridDim.x * NT)
#define GW_LOOP(w, total) for (int w = bid * (NT / 64) + (tid >> 6); w < (total); w += gridDim.x * (NT / 64))

__device__ __forceinline__ const float* xin_row(KP kp, int l, int row) {
    return l == 0 ? (row < NLAT ? p.x + (size_t)row * D : p.ctx + (size_t)(row - NLAT) * D) : WSP(float, WS_XRES) + (size_t)row * D;
}
__device__ __forceinline__ void d_pro0(KP kp, LAS float* sc) {
    PH_IDS;
    GT_LOOP(idx, 64 * 24) {
        const int pos = idx / 24, j = idx % 24; float ang; float* dst;
        if (j < 8) { ang = (float)pos * powf(10000.f, -(float)j / 8.f); dst = WSP(float, WS_ROPE) + (pos * 8 + j) * 2; }
        else { ang = (float)pos * powf(10000.f, -(float)(j - 8) / 16.f); dst = WSP(float, WS_ROPE) + 1024 + (pos * 16 + (j - 8)) * 2; }
        dst[0] = cosf(ang); dst[1] = sinf(ang);
    }
    GT_LOOP(idx, 2 * 1024 * 256) {
        int n = idx & 255, i = (idx >> 8) & 1023, l = idx >> 18, d = n >> 7, j = n & 127;
        float a = 0.f;
        for (int r = 0; r < 16; ++r) a += p.w_in[((size_t)l * D + i) * INW + 3328 + d * 16 + r] * p.gla_gate_w[((l * 2 + d) * 16 + r) * 128 + j];
        WSP(float, WS_WEFF)[idx] = a;
    }
    const int lane = tid & 63;
    for (int i = tid; i < 5 * D; i += NT) { const int r = i >> 10, ii = i & 1023; sc[i] = silu_f(r < 4 ? p.c[r * D + ii] : p.c_ctx[ii]); }
    __syncthreads();
    GW_LOOP(task, 2 * 96 * 16) {
        const int chunk = task & 15, jb = (task >> 4) % 96, l = task / (16 * 96), j = jb * 64 + lane;
        const float* w = p.w_mod + ((size_t)l * D + chunk * 64) * 6144 + j;
        float acc[5] = {0.f, 0.f, 0.f, 0.f, 0.f};
#pragma unroll 8
        for (int i = 0; i < 64; ++i) { const float wv = w[(size_t)i * 6144];
#pragma unroll
            for (int r = 0; r < 5; ++r) acc[r] += sc[r * D + chunk * 64 + i] * wv; }
#pragma unroll
        for (int r = 0; r < 5; ++r) WSP(float, WS_MODP)[((size_t)(chunk * 2 + l) * 5 + r) * 6144 + j] = acc[r];
    }
}
__device__ __forceinline__ void d_filter(KP kp, LAS float* sm) {
    PH_IDS;
    const int lane = tid & 63; LAS float* zf = sm + (tid >> 6) * 192; LAS float* h1 = zf + 64; LAS float* h2 = zf + 128;
    GW_LOOP(task, 2 * SEQ + CTXL) {
        const int which = task < SEQ ? 0 : task < 2 * SEQ ? 1 : 2, pos = task - (which == 2 ? 2 * SEQ : which * SEQ), l = which == 1 ? 1 : 0, n = which == 2 ? CTXL : SEQ;
        float* filt = which == 2 ? WSP(float, WS_FILTC) : WSP(float, WS_FILT) + (size_t)l * 8192 * 256;
        const float t = (float)pos / (float)(n - 1), w = (6.2831855f * (float)pos) / (float)n;
        if (lane < 33) { float v = t; if (lane >= 1) { const int q = (lane - 1) & 15; const float f = 1e-4f + (15.f - 1e-4f) * ((float)q / 15.f), a = w * f; v = lane < 17 ? cosf(a) : -sinf(a); } zf[lane] = v; }
        asm volatile("s_waitcnt lgkmcnt(0)" ::: "memory");
        float a = p.hy_b1[l * 64 + lane];
        for (int i = 0; i < 33; ++i) a += zf[i] * p.hy_w1[(l * 33 + i) * 64 + lane];
        h1[lane] = sinf(p.hy_freq[(l * 2 + 0) * 64 + lane] * a);
        asm volatile("s_waitcnt lgkmcnt(0)" ::: "memory");
        a = p.hy_b2[l * 64 + lane];
        for (int i = 0; i < 64; ++i) a += h1[i] * p.hy_w2[(l * 64 + i) * 64 + lane];
        h2[lane] = sinf(p.hy_freq[(l * 2 + 1) * 64 + lane] * a);
        asm volatile("s_waitcnt lgkmcnt(0)" ::: "memory");
        float raw[8];
#pragma unroll
        for (int q = 0; q < 8; ++q) raw[q] = 0.f;
        for (int j = 0; j < 64; ++j) { const float hj = h2[j]; const float* w3 = p.hy_w3 + (size_t)(l * 64 + j) * 512 + lane;
#pragma unroll
            for (int q = 0; q < 8; ++q) raw[q] += hj * w3[q * 64]; }
        const float mind = logf(1e-2f) / 1.5f, maxd = logf(1e-2f) / 0.3f;
#pragma unroll
        for (int q = 0; q < 8; ++q) {
            const int c = (q & 3) * 64 + lane;
            const float v = raw[q] * expf(-t * fabsf(mind + (maxd - mind) * ((float)c / 255.f)));
            if (q < 4) { filt[(size_t)pos * 256 + c] = v; if (pos == 0) filt[(size_t)n * 256 + c] = 0.f; }
            else if (pos >= 1) filt[(size_t)(2 * n - pos) * 256 + c] = v;
        }
        asm volatile("s_waitcnt lgkmcnt(0)" ::: "memory");
    }
}
__device__ __forceinline__ void d_pro1(KP kp) {
    PH_IDS;
    GT_LOOP(idx, 2 * 5 * 6144) {
        const int j = idx % 6144, r = (idx / 6144) % 5, l = idx / (6144 * 5);
        float a = p.b_mod[l * 6144 + j];
        for (int ch = 0; ch < 16; ++ch) a += WSP(float, WS_MODP)[((size_t)(ch * 2 + l) * 5 + r) * 6144 + j];
        WSP(float, WS_MOD)[idx] = a;
    }
    GT_LOOP(idx, 528 * 256) {
        const int vb = idx >> 8, c = idx & 255, which = vb < 256 ? 0 : vb < 512 ? 1 : 2, slab = vb - (which == 2 ? 512 : which * 256);
        const float* filt = which == 2 ? WSP(float, WS_FILTC) : WSP(float, WS_FILT) + (size_t)which * 8192 * 256;
        float a = 0.f;
#pragma unroll 8
        for (int i = 0; i < 32; ++i) a += fabsf(filt[(size_t)(slab * 32 + i) * 256 + c]);
        WSP(float, WS_PS)[(which * 256 + slab) * 256 + c] = a;
    }
}
__device__ __forceinline__ void d_norm1(KP kp, int l) {
    PH_IDS;
    const int lane = tid & 63;
    GW_LOOP(row, MALL) {
        const float* xr = xin_row(kp, l, row);
        const float* mod = WSP(float, WS_MOD) + (size_t)(l * 5 + mod_r(row)) * 6144;
        const float* g = p.norm_g + (l * 4 + 0) * D;
        float v[16], ss = 0.f;
#pragma unroll
        for (int j = 0; j < 16; ++j) { v[j] = xr[j * 64 + lane]; ss += v[j] * v[j]; }
        const float rstd = rsqrtf(wave_sum(ss) * (1.f / D) + EPS);
        bf16_t* hb = WSP(bf16_t, WS_HB) + (size_t)row * D;
#pragma unroll
        for (int j = 0; j < 16; ++j) { int cidx = j * 64 + lane; hb[cidx] = f2bf(v[j] * rstd * g[cidx] * (1.f + mod[1024 + cidx]) + mod[cidx]); }
    }
}
__device__ __forceinline__ void d_router(KP kp, int l, LAS float* sm) {
    PH_IDS;
    const int lane = tid & 63;
    for (int i = tid; i < D * NEXP; i += NT) sm[(i >> 5) * 33 + (i & 31)] = p.router_w[(size_t)l * D * NEXP + i];
    LAS int* lcnt = (LAS int*)(sm + 33800); LAS int* lbase = lcnt + 32; LAS int* rec = lcnt + 64;
    if (tid < 32) lcnt[tid] = 0;
    __syncthreads();
    int it = 0;
    GW_LOOP(row, nrows_l(l)) {
        const float* xs = xin_row(kp, l, row);
        float* xr = WSP(float, WS_XRES) + (size_t)row * D;
        const float* y = WSP(float, WS_YBUF) + (size_t)row * D;
        const float* mod = WSP(float, WS_MOD) + (size_t)(l * 5 + mod_r(row)) * 6144;
        const float* g1 = p.norm_g + (l * 4 + 1) * D; const float* g2 = p.norm_g + (l * 4 + 2) * D;
        float yv[16], xv[16], ss = 0.f;
#pragma unroll
        for (int j = 0; j < 16; ++j) { yv[j] = y[j * 64 + lane]; ss += yv[j] * yv[j]; }
        float rstd = rsqrtf(wave_sum(ss) * (1.f / D) + EPS);
        ss = 0.f;
#pragma unroll
        for (int j = 0; j < 16; ++j) { const int ci = j * 64 + lane; xv[j] = xs[ci] + mod[2048 + ci] * (yv[j] * rstd * g1[ci]); ss += xv[j] * xv[j]; }
        float gsc[16], gsh[16];
#pragma unroll
        for (int j = 0; j < 16; ++j) { const int ci = j * 64 + lane; gsc[j] = g2[ci] * (1.f + mod[4096 + ci]); gsh[j] = mod[3072 + ci]; }
#pragma unroll
        for (int j = 0; j < 16; ++j) xr[j * 64 + lane] = xv[j];
        rstd = rsqrtf(wave_sum(ss) * (1.f / D) + EPS);
        bf16_t* hb = WSP(bf16_t, WS_HB) + (size_t)row * D;
        float v[32];
#pragma unroll
        for (int e = 0; e < 32; ++e) v[e] = 0.f;
#pragma unroll
        for (int j = 0; j < 16; ++j) { xv[j] = xv[j] * rstd * gsc[j] + gsh[j]; hb[j * 64 + lane] = f2bf(xv[j]); }
#pragma unroll
        for (int j = 0; j < 16; ++j) { const LAS float* wr = sm + (j * 64 + lane) * 33; const float hv = xv[j];
#pragma unroll
            for (int e = 0; e < 32; ++e) v[e] += hv * wr[e];
            asm volatile("" : "+v"(v[0]), "+v"(v[8]), "+v"(v[16]), "+v"(v[24])); }
#pragma unroll
        for (int k = 0; k < 16; ++k) { const bool up = lane & 32; const float send = up ? v[k] : v[k + 16], keep = up ? v[k + 16] : v[k]; v[k] = keep + __shfl_xor(send, 32); }
#pragma unroll
        for (int k = 0; k < 8; ++k) { const bool up = lane & 16; const float send = up ? v[k] : v[k + 8], keep = up ? v[k + 8] : v[k]; v[k] = keep + __shfl_xor(send, 16); }
#pragma unroll
        for (int k = 0; k < 4; ++k) { const bool up = lane & 8; const float send = up ? v[k] : v[k + 4], keep = up ? v[k + 4] : v[k]; v[k] = keep + __shfl_xor(send, 8); }
#pragma unroll
        for (int k = 0; k < 2; ++k) { const bool up = lane & 4; const float send = up ? v[k] : v[k + 2], keep = up ? v[k + 2] : v[k]; v[k] = keep + __shfl_xor(send, 4); }
        { const bool up = lane & 2; const float send = up ? v[0] : v[1], keep = up ? v[1] : v[0]; v[0] = keep + __shfl_xor(send, 2); }
        const int myexp = lane >> 1;
        float mylogit = v[0] + __shfl_xor(v[0], 1) + p.router_b[l * NEXP + myexp];
        float tv[4]; int ti[4];
#pragma unroll
        for (int k = 0; k < 4; ++k) {
            float bv = mylogit; int bi = myexp;
#pragma unroll
            for (int o = 1; o < 64; o <<= 1) { const float ov = __shfl_xor(bv, o); const int oi = __shfl_xor(bi, o); if (ov > bv || (ov == bv && oi < bi)) { bv = ov; bi = oi; } }
            tv[k] = bv; ti[k] = bi; if (myexp == bi) mylogit = -1e30f;
        }
        float den = 0.f, w[4];
#pragma unroll
        for (int k = 0; k < 4; ++k) { w[k] = expf(tv[k] - tv[0]); den += w[k]; }
        if (lane < 4) {
            const int e = lane == 0 ? ti[0] : lane == 1 ? ti[1] : lane == 2 ? ti[2] : ti[3];
            const float ww = lane == 0 ? w[0] : lane == 1 ? w[1] : lane == 2 ? w[2] : w[3];
            const int lr = __hip_atomic_fetch_add(&lcnt[e], 1, __ATOMIC_RELAXED, __HIP_MEMORY_SCOPE_WORKGROUP);
            rec[(it * 8 + (tid >> 6)) * 4 + lane] = (e << 16) | lr;
            WSP(float, WS_TOPW)[row * 4 + lane] = ww / den;
            WSP(int, WS_TOPI)[row * 4 + lane] = e;
        }
        ++it;
    }
    asm volatile("s_waitcnt lgkmcnt(0)" ::: "memory");
    __syncthreads();
    if (tid < 32) lbase[tid] = (int)atomicAdd(WSP(unsigned, WS_CTL) + CW_CNT + (l * 32 + tid) * 64, (unsigned)lcnt[tid]);
    asm volatile("s_waitcnt vmcnt(0) lgkmcnt(0)" ::: "memory");
    __syncthreads();
    it = 0;
    GW_LOOP(row, nrows_l(l)) {
        if (lane < 4) { const int rc = rec[(it * 8 + (tid >> 6)) * 4 + lane], e = rc >> 16, pos = lbase[e] + (rc & 0xffff);
            WSP(int, WS_LIST)[(size_t)e * MALL + pos] = row * 4 + lane; WSP(int, WS_TOPI)[MALL * 4 + row * 4 + lane] = pos; }
        ++it;
    }
    __syncthreads();
}
__device__ __forceinline__ void d_combine(KP kp, int l, LAS int* aoffs) {
    PH_IDS;
    const int lane = tid & 63;
    const unsigned* cnt = WSP(unsigned, WS_CTL) + CW_CNT + l * 32 * 64;
    if (tid == 0) { int a = 0; for (int e = 0; e < 32; ++e) { aoffs[e] = a; a += ((int)cnt[e * 64] + 255) & ~255; } }
    __syncthreads();
    GW_LOOP(row, nrows_l(l)) {
        int ee[4], pp[4];
#pragma unroll
        for (int k = 0; k < 4; ++k) { ee[k] = WSP(int, WS_TOPI)[row * 4 + k]; pp[k] = WSP(int, WS_TOPI)[MALL * 4 + row * 4 + k]; }
        gv4u yv[4][2];
#pragma unroll
        for (int k = 0; k < 4; ++k) { const gv4u* ys = (const gv4u*)(WSP(bf16_t, WS_YSLOT) + (size_t)(aoffs[ee[k]] + pp[k]) * D) + lane; yv[k][0] = ys[0]; yv[k][1] = ys[64]; }
        float acc[16];
#pragma unroll
        for (int j = 0; j < 16; ++j) acc[j] = 0.f;
#pragma unroll
        for (int k = 0; k < 4; ++k)
#pragma unroll
            for (int hf = 0; hf < 2; ++hf)
#pragma unroll
                for (int q = 0; q < 4; ++q) { acc[hf * 8 + 2 * q] += gblo(yv[k][hf][q]); acc[hf * 8 + 2 * q + 1] += gbhi(yv[k][hf][q]); }
        float ss = 0.f;
#pragma unroll
        for (int j = 0; j < 16; ++j) ss += acc[j] * acc[j];
        float rstd = rsqrtf(wave_sum(ss) * (1.f / D) + EPS);
        float* xr = WSP(float, WS_XRES) + (size_t)row * D;
        const float* mod = WSP(float, WS_MOD) + (size_t)(l * 5 + mod_r(row)) * 6144;
        const float* g3 = p.norm_g + (l * 4 + 3) * D;
        ss = 0.f;
        gv4f xo[4], gm[4], gg[4];
#pragma unroll
        for (int q8 = 0; q8 < 4; ++q8) { const int ci = (q8 >> 1) * 512 + lane * 8 + (q8 & 1) * 4; xo[q8] = *(const gv4f*)(xr + ci); gm[q8] = *(const gv4f*)(mod + 5120 + ci); gg[q8] = *(const gv4f*)(g3 + ci); }
        float n0[16], n1[16], n2[16];
        if (l < DEPTH - 1) {
            const float* mod2 = WSP(float, WS_MOD) + (size_t)((l + 1) * 5 + mod_r(row)) * 6144; const float* g0 = p.norm_g + ((l + 1) * 4 + 0) * D;
#pragma unroll
            for (int q8 = 0; q8 < 4; ++q8) { const int ci = (q8 >> 1) * 512 + lane * 8 + (q8 & 1) * 4; const gv4f a = *(const gv4f*)(g0 + ci), b2 = *(const gv4f*)(mod2 + 1024 + ci), c2 = *(const gv4f*)(mod2 + ci);
#pragma unroll
                for (int q = 0; q < 4; ++q) { n0[q8 * 4 + q] = a[q]; n1[q8 * 4 + q] = b2[q]; n2[q8 * 4 + q] = c2[q]; } }
        }
#pragma unroll
        for (int q8 = 0; q8 < 4; ++q8) {
            const int ci = (q8 >> 1) * 512 + lane * 8 + (q8 & 1) * 4;
            gv4f vv;
#pragma unroll
            for (int q = 0; q < 4; ++q) { const float v = xo[q8][q] + gm[q8][q] * (acc[q8 * 4 + q] * rstd * gg[q8][q]); vv[q] = v; acc[q8 * 4 + q] = v; ss += v * v; }
            if (l == DEPTH - 1) *(gv4f*)(p.out + (size_t)row * D + ci) = vv; else *(gv4f*)(xr + ci) = vv;
        }
        if (l < DEPTH - 1) {
            rstd = rsqrtf(wave_sum(ss) * (1.f / D) + EPS);
            bf16_t* hb = WSP(bf16_t, WS_HB) + (size_t)row * D;
#pragma unroll
            for (int hf = 0; hf < 2; ++hf) {
                gv4u o;
#pragma unroll
                for (int q = 0; q < 4; ++q) { const int i0 = hf * 8 + 2 * q; o[q] = cvtpk_rne(acc[i0] * rstd * n0[i0] * (1.f + n1[i0]) + n2[i0], acc[i0 + 1] * rstd * n0[i0 + 1] * (1.f + n1[i0 + 1]) + n2[i0 + 1]); }
                *(gv4u*)(hb + hf * 512 + lane * 8) = o;
            }
        }
    }
    __syncthreads();
}

namespace pg8 {
typedef short bf16x8 __attribute__((ext_vector_type(8)));
typedef float f32x4 __attribute__((ext_vector_type(4)));
typedef unsigned u32x4 __attribute__((ext_vector_type(4)));
typedef unsigned u32x2 __attribute__((ext_vector_type(2)));
constexpr int BM = 256, BK = 64, HALF = 128, HTB = HALF * BK * 2, STAGE_BYTES = 8 * HTB, NXCD = 8, WGM = 8, K = 1024;
__host__ __device__ __forceinline__ int lds_byte(int r, int c) { const int st = (r >> 4) * 2 + (c >> 5), rr = r & 15, cc = c & 31, ob = rr * 64 + cc * 2; return st * 1024 + (ob ^ (((ob >> 9) & 1) << 5)); }
__host__ __device__ __forceinline__ void stage_rc(int b, int& R, int& C) { const int st = b / 1024, sb = b % 1024, swz = sb ^ (((sb >> 9) & 1) << 5); R = (st >> 1) * 16 + swz / 64; C = (st & 1) * 32 + (swz % 64) / 2; }
__host__ __device__ __forceinline__ int perm32(int rho) { const int n = rho >> 4, i = rho & 15; return 8 * (i >> 2) + 4 * n + (i & 3); }
__device__ __forceinline__ unsigned cvt_pk_bf16(float lo, float hi) { return cvtpk_rne(lo, hi); }

struct Unit { int pm, pn; const char* A; const char* B; const int* gl; int gcnt; int e; int row0; };

struct DenseOrder {
    int nM, nN, nwg, G, c; const char* A; const char* Bt;
    __device__ __forceinline__ void init(int M, int N, int G_, int c_, const void* A_, const void* Bt_) { nM = M / BM; nN = N / BM; nwg = nM * nN; G = G_; c = c_; A = (const char*)A_; Bt = (const char*)Bt_; }
    __device__ __forceinline__ bool next(int i, Unit& u) const {
        const long L = (long)i * G + c; if (L >= nwg) return false;
        int wgid = (int)L; { const int q = nwg / NXCD, r = nwg % NXCD, xcd = wgid % NXCD, off = wgid / NXCD; wgid = (xcd < r ? xcd * (q + 1) : r * (q + 1) + (xcd - r) * q) + off; }
        const int nig = WGM * nN, gid = wgid / nig, fm = gid * WGM, gsz = (nM - fm) < WGM ? (nM - fm) : WGM;
        u.pm = fm + ((wgid % nig) % gsz); u.pn = (wgid % nig) / gsz;
        u.A = A + (size_t)u.pm * (BM * K * 2); u.B = Bt + (size_t)u.pn * (BM * K * 2); u.gl = nullptr; u.gcnt = BM; u.e = 0; u.row0 = u.pm * BM; return true;
    }
};
struct MoeOrder {
    const LAS int* tab; int G, c, NCT; const char* A; const char* W; size_t wstride; const int* list; const unsigned* cnt; bool gather;
    __device__ __forceinline__ bool next(int i, Unit& u) const {
        const int xg = c & 7, L = (c >> 3) + (G >> 3) * i; const LAS int* gt = tab + 72 + xg * 5;
        if (L >= gt[4]) return false;
        int q = 0;
#pragma unroll
        for (int j = 1; j < 4; ++j) if (L >= gt[j]) q = j;
        const int e = __builtin_amdgcn_readfirstlane(xg + 8 * q);
        const int r = __builtin_amdgcn_readfirstlane(L - gt[q]), ce = __builtin_amdgcn_readfirstlane((int)cnt[e * 64]), rte = (ce + 255) >> 8, ro = __builtin_amdgcn_readfirstlane(tab[33 + e]);
        const int ct = r / rte, rt = r - ct * rte;
        u.pm = rt; u.pn = ct; u.e = e; u.row0 = ro + rt * 256; u.gl = list + (size_t)e * MALL + rt * 256; u.gcnt = min(256, ce - rt * 256);
        u.A = gather ? A : A + (size_t)u.row0 * (K * 2); u.B = W + (size_t)e * wstride + (size_t)ct * (BM * K * 2); return true;
    }
};
__device__ __forceinline__ void moe_tab_build(LAS int* tab, const unsigned* cnt, int NCT) {
    if (ltid() == 0) {
        int rs = 0; for (int e = 0; e < 32; ++e) { tab[33 + e] = rs; rs += (((int)cnt[e * 64] + 255) >> 8) * 256; } tab[65] = rs;
        for (int g = 0; g < 8; ++g) { int us = 0; for (int q = 0; q < 4; ++q) { tab[72 + g * 5 + q] = us; us += (((int)cnt[(g + 8 * q) * 64] + 255) >> 8) * NCT; } tab[72 + g * 5 + 4] = us; }
    }
    __syncthreads();
}

struct EpiBf16 {
    static constexpr bool PERM = true; bf16_t* O; int ldc; const float* bias;
    __device__ __forceinline__ void operator()(const f32x4 (&acc)[2][2][4][2], const Unit& u, int wr, int wc, int fr, int fq) const {
        const int row0 = u.row0 + wr * 64 + fr, col0 = u.pn * BM + wc * 32 + 8 * fq;
        f32x4 bv[2][2];
#pragma unroll
        for (int bj = 0; bj < 2; ++bj)
#pragma unroll
            for (int n = 0; n < 2; ++n) bv[bj][n] = bias ? *(const f32x4*)(bias + col0 + bj * HALF + 4 * n) : (f32x4){0.f, 0.f, 0.f, 0.f};
#pragma unroll
        for (int ai = 0; ai < 2; ++ai)
#pragma unroll
            for (int m = 0; m < 4; ++m) { bf16_t* rowp = O + (size_t)(row0 + ai * HALF + m * 16) * ldc + col0;
#pragma unroll
                for (int bj = 0; bj < 2; ++bj) { const f32x4 v0 = acc[ai][bj][m][0] + bv[bj][0], v1 = acc[ai][bj][m][1] + bv[bj][1];
                    u32x4 w; w.x = cvt_pk_bf16(v0[0], v0[1]); w.y = cvt_pk_bf16(v0[2], v0[3]); w.z = cvt_pk_bf16(v1[0], v1[1]); w.w = cvt_pk_bf16(v1[2], v1[3]);
                    *(u32x4*)(rowp + bj * HALF) = w; } }
    }
};
struct EpiF32 {
    static constexpr bool PERM = false; float* O; int ldc;
    __device__ __forceinline__ void operator()(const f32x4 (&acc)[2][2][4][2], const Unit& u, int wr, int wc, int fr, int fq) const {
        const int row0 = u.row0 + wr * 64 + fr, col0 = u.pn * BM + wc * 32 + 4 * fq;
#pragma unroll
        for (int ai = 0; ai < 2; ++ai)
#pragma unroll
            for (int m = 0; m < 4; ++m) { float* rowp = O + (size_t)(row0 + ai * HALF + m * 16) * ldc + col0;
#pragma unroll
                for (int bj = 0; bj < 2; ++bj)
#pragma unroll
                    for (int n = 0; n < 2; ++n) *(f32x4*)(rowp + bj * HALF + n * 16) = acc[ai][bj][m][n]; }
    }
};
struct EpiMoeUp {
    static constexpr bool PERM = true; bf16_t* ACT; const float* b1all;
    __device__ __forceinline__ void operator()(const f32x4 (&acc)[2][2][4][2], const Unit& u, int wr, int wc, int fr, int fq) const {
        const int col0 = u.pn * BM + wc * 32 + 8 * fq; const float* b1 = b1all + (size_t)u.e * 2048;
        f32x4 bv[2][2];
#pragma unroll
        for (int bj = 0; bj < 2; ++bj)
#pragma unroll
            for (int n = 0; n < 2; ++n) bv[bj][n] = *(const f32x4*)(b1 + col0 + bj * HALF + 4 * n);
#pragma unroll
        for (int ai = 0; ai < 2; ++ai)
#pragma unroll
            for (int m = 0; m < 4; ++m) { bf16_t* rowp = ACT + (size_t)(u.row0 + wr * 64 + fr + ai * HALF + m * 16) * 1024 + (col0 >> 1);
#pragma unroll
                for (int bj = 0; bj < 2; ++bj) { const f32x4 v0 = acc[ai][bj][m][0] + bv[bj][0], v1 = acc[ai][bj][m][1] + bv[bj][1];
                    float a[4];
#pragma unroll
                    for (int j = 0; j < 4; ++j) { const float gl = fminf(j < 2 ? v0[2 * j] : v1[2 * j - 4], 7.f), ln = fminf(fmaxf(j < 2 ? v0[2 * j + 1] : v1[2 * j - 3], -7.f), 7.f);
                        a[j] = gl * __builtin_amdgcn_rcpf(1.f + __builtin_amdgcn_exp2f(-1.702f * 1.4426950408889634f * gl)) * (ln + 1.f); }
                    u32x2 w; w.x = cvt_pk_bf16(a[0], a[1]); w.y = cvt_pk_bf16(a[2], a[3]);
                    *(u32x2*)(rowp + bj * 64) = w; } }
    }
};
struct EpiMoeDown {
    static constexpr bool PERM = true; bf16_t* Y; const float* b2all; const float* topw;
    __device__ __forceinline__ void operator()(const f32x4 (&acc)[2][2][4][2], const Unit& u, int wr, int wc, int fr, int fq) const {
        const int col0 = u.pn * BM + wc * 32 + 8 * fq; const float* b2 = b2all + (size_t)u.e * 1024;
        f32x4 bv[2][2];
#pragma unroll
        for (int bj = 0; bj < 2; ++bj)
#pragma unroll
            for (int n = 0; n < 2; ++n) bv[bj][n] = *(const f32x4*)(b2 + col0 + bj * HALF + 4 * n);
#pragma unroll
        for (int ai = 0; ai < 2; ++ai)
#pragma unroll
            for (int m = 0; m < 4; ++m) { const int r = wr * 64 + fr + ai * HALF + m * 16; const int rc = r < u.gcnt ? r : u.gcnt - 1; const float twl = topw[u.gl[rc]]; const float tw = r < u.gcnt ? twl : 0.f;
                bf16_t* rowp = Y + (size_t)(u.row0 + r) * 1024 + col0;
#pragma unroll
                for (int bj = 0; bj < 2; ++bj) { const f32x4 v0 = (acc[ai][bj][m][0] + bv[bj][0]) * tw, v1 = (acc[ai][bj][m][1] + bv[bj][1]) * tw;
                    u32x4 w; w.x = cvt_pk_bf16(v0[0], v0[1]); w.y = cvt_pk_bf16(v0[2], v0[3]); w.z = cvt_pk_bf16(v1[0], v1[1]); w.w = cvt_pk_bf16(v1[2], v1[3]);
                    *(u32x4*)(rowp + bj * HALF) = w; } }
    }
};

template <class Epi, class Sched, bool GATHER, bool ALIGN_EPI>
__device__ __forceinline__ void gphase(LAS unsigned char* lds, const Sched& S, const Epi& E) {
    const int tid = ltid();
    const int wid = __builtin_amdgcn_readfirstlane(tid >> 6), lane = tid & 63, wr = wid >> 2, wc = wid & 3, fr = lane & 15, fq = lane >> 4;
    constexpr int nt = K / BK;
    unsigned voffB[2], CA2[2]; int RA[2];
#pragma unroll
    for (int i = 0; i < 2; ++i) { int R, C; stage_rc(tid * 16 + i * 8192, R, C); const int Rb = Epi::PERM ? ((R & ~31) + perm32(R & 31)) : R;
        RA[i] = R; CA2[i] = (unsigned)C * 2u; voffB[i] = (unsigned)(Rb * K + C) * 2u; }
    constexpr size_t kstep = (size_t)(BK * 2), hstep = (size_t)HALF * K * 2;
    const unsigned ldsw = (unsigned)wid * 1024u;
    const int aoff = lds_byte(wr * 64 + fr, fq * 8), boff = lds_byte(wc * 32 + fr, fq * 8);
#define PG8_SA(b, h) (((b) * 2 + (h)) * HTB)
#define PG8_SB(b, h) ((4 + (b) * 2 + (h)) * HTB)
#define PG8_GL(gp, ldsoff) __builtin_amdgcn_global_load_lds((const unsigned*)(gp), (LAS unsigned*)(lds + (ldsoff)), 16, 0, 0)
#define PG8_STB(bufoff, gbase) do { PG8_GL((const char*)(gbase) + voffB[0], (bufoff) + ldsw); PG8_GL((const char*)(gbase) + voffB[1], (bufoff) + ldsw + 8192); } while (0)
#define PG8_STA(bufoff, gbase, o) do { PG8_GL((const char*)(gbase) + (o)[0], (bufoff) + ldsw); PG8_GL((const char*)(gbase) + (o)[1], (bufoff) + ldsw + 8192); } while (0)
#define PG8_LDA(dst, b, h) do { _Pragma("unroll") for (int m = 0; m < 4; ++m) _Pragma("unroll") for (int k = 0; k < 2; ++k) dst[m][k] = *(const LAS bf16x8*)(lds + PG8_SA(b, h) + aoff + m * 2048 + k * 1024); } while (0)
#define PG8_LDB(dst, b, h) do { _Pragma("unroll") for (int n = 0; n < 2; ++n) _Pragma("unroll") for (int k = 0; k < 2; ++k) dst[n][k] = *(const LAS bf16x8*)(lds + PG8_SB(b, h) + boff + n * 2048 + k * 1024); } while (0)
#define PG8_MMA(ai, bj, At, Bt) do { __builtin_amdgcn_s_setprio(1); _Pragma("unroll") for (int m = 0; m < 4; ++m) _Pragma("unroll") for (int n = 0; n < 2; ++n) _Pragma("unroll") for (int k = 0; k < 2; ++k) \
        acc[ai][bj][m][n] = __builtin_amdgcn_mfma_f32_16x16x32_bf16(Bt[n][k], At[m][k], acc[ai][bj][m][n], 0, 0, 0); __builtin_amdgcn_s_setprio(0); } while (0)
#define PG8_WAIT_V(n) asm volatile("s_waitcnt vmcnt(" #n ")" ::: "memory")
#define PG8_WAIT_L(n) asm volatile("s_waitcnt lgkmcnt(" #n ")" ::: "memory")
#define PG8_BAR __builtin_amdgcn_s_barrier()
#define PG8_SCHED __builtin_amdgcn_sched_barrier(0)
#define PG8_AOFFS(u, o) do { _Pragma("unroll") for (int h_ = 0; h_ < 2; ++h_) _Pragma("unroll") for (int i_ = 0; i_ < 2; ++i_) { \
        if (GATHER) { const int r_ = h_ * 128 + RA[i_]; const int rc_ = r_ < (u).gcnt ? r_ : (u).gcnt - 1; const int tok_ = (u).gl[rc_] >> 2; o[h_][i_] = (unsigned)tok_ * (unsigned)(K * 2) + CA2[i_]; } \
        else o[h_][i_] = (unsigned)((h_ * 128 + RA[i_]) * (K * 2)) + CA2[i_]; } } while (0)
    Unit cur, nxt; int ui = 0;
    if (!S.next(0, cur)) return;
    f32x4 acc[2][2][4][2];
#pragma unroll
    for (int a = 0; a < 2; ++a)
#pragma unroll
        for (int b = 0; b < 2; ++b)
#pragma unroll
            for (int m = 0; m < 4; ++m)
#pragma unroll
                for (int n = 0; n < 2; ++n) acc[a][b][m][n] = (f32x4){0.f, 0.f, 0.f, 0.f};
    bf16x8 At[4][2], B0[2][2], B1[2][2];
    unsigned oAc[2][2], oAn[2][2];
    PG8_AOFFS(cur, oAc);
    const char* cA = cur.A; const char* cB = cur.B;
    PG8_STB(PG8_SB(0, 0), cB); PG8_STB(PG8_SB(0, 1), cB + hstep); PG8_STA(PG8_SA(0, 0), cA, oAc[0]); PG8_STA(PG8_SA(0, 1), cA, oAc[1]);
    if (wr == 1) PG8_BAR;
    PG8_WAIT_V(2); PG8_BAR;
    PG8_STB(PG8_SB(1, 0), cB + kstep); PG8_STA(PG8_SA(1, 0), cA + kstep, oAc[0]); PG8_STB(PG8_SB(1, 1), cB + hstep + kstep);
    PG8_WAIT_V(6); PG8_BAR;
    for (;;) {
        const bool has_next = S.next(ui + 1, nxt);
        const char* nA = has_next ? nxt.A : cA; const char* nB = has_next ? nxt.B : cB;
        if (has_next) { PG8_AOFFS(nxt, oAn); } else {
#pragma unroll
            for (int h = 0; h < 2; ++h) { oAn[h][0] = oAc[h][0]; oAn[h][1] = oAc[h][1]; } }
#pragma unroll 1
        for (int t = 0; t < nt; t += 2) {
            const bool last = (t == nt - 2);
            const char* a1 = cA + (size_t)(t + 1) * kstep;
            const char* a2 = last ? nA : cA + (size_t)(t + 2) * kstep; const char* b2 = last ? nB : cB + (size_t)(t + 2) * kstep;
            const char* a3 = a2 + kstep; const char* b3 = b2 + kstep;
            unsigned o2[2][2];
#pragma unroll
            for (int h = 0; h < 2; ++h) { o2[h][0] = last ? oAn[h][0] : oAc[h][0]; o2[h][1] = last ? oAn[h][1] : oAc[h][1]; }
            PG8_LDB(B0, 0, 0); PG8_LDB(B1, 0, 1); PG8_SCHED; PG8_LDA(At, 0, 0); PG8_STA(PG8_SA(1, 1), a1, oAc[1]);
            PG8_WAIT_V(8); PG8_WAIT_L(0); PG8_BAR; PG8_MMA(0, 0, At, B0); PG8_MMA(0, 1, At, B1); PG8_BAR; PG8_SCHED;
            PG8_LDA(At, 0, 1); PG8_STB(PG8_SB(0, 0), b2); PG8_STB(PG8_SB(0, 1), b2 + hstep); PG8_STA(PG8_SA(0, 0), a2, o2[0]);
            PG8_WAIT_V(8); PG8_WAIT_L(0); PG8_BAR; PG8_MMA(1, 0, At, B0); PG8_MMA(1, 1, At, B1); PG8_BAR; PG8_SCHED;
            PG8_LDB(B0, 1, 0); PG8_LDB(B1, 1, 1); PG8_SCHED; PG8_LDA(At, 1, 0); PG8_STA(PG8_SA(0, 1), a2, o2[1]);
            PG8_WAIT_V(8); PG8_WAIT_L(0); PG8_BAR; PG8_MMA(0, 0, At, B0); PG8_MMA(0, 1, At, B1); PG8_BAR; PG8_SCHED;
            PG8_LDA(At, 1, 1); PG8_STB(PG8_SB(1, 0), b3); PG8_STB(PG8_SB(1, 1), b3 + hstep); PG8_STA(PG8_SA(1, 0), a3, o2[0]);
            PG8_WAIT_V(8); PG8_WAIT_L(0); PG8_BAR; PG8_MMA(1, 0, At, B0); PG8_MMA(1, 1, At, B1); PG8_BAR; PG8_SCHED;
        }
        if constexpr (ALIGN_EPI) { if (wr == 0) PG8_BAR; }
        E(acc, cur, wr, wc, fr, fq);
        if (!has_next) break;
#pragma unroll
        for (int a = 0; a < 2; ++a)
#pragma unroll
            for (int b = 0; b < 2; ++b)
#pragma unroll
                for (int m = 0; m < 4; ++m)
#pragma unroll
                    for (int n = 0; n < 2; ++n) acc[a][b][m][n] = (f32x4){0.f, 0.f, 0.f, 0.f};
        cur = nxt; cA = nA; cB = nB; ++ui;
#pragma unroll
        for (int h = 0; h < 2; ++h) { oAc[h][0] = oAn[h][0]; oAc[h][1] = oAn[h][1]; }
        if constexpr (ALIGN_EPI) { if (wr == 1) PG8_BAR; }
    }
    PG8_WAIT_V(0);
    if constexpr (!ALIGN_EPI) { if (wr == 0) PG8_BAR; }
    PG8_BAR;
#undef PG8_SA
#undef PG8_SB
#undef PG8_GL
#undef PG8_STA
#undef PG8_STB
#undef PG8_LDA
#undef PG8_LDB
#undef PG8_MMA
#undef PG8_WAIT_V
#undef PG8_WAIT_L
#undef PG8_BAR
#undef PG8_SCHED
#undef PG8_AOFFS
}
}

__device__ __forceinline__ unsigned pk2(float lo, float hi) { return (unsigned)f2bf(lo) | ((unsigned)f2bf(hi) << 16); }
__device__ __forceinline__ void transpose_item(const float* W, int ld, int nblk, bf16_t* WT, LAS float* scr, int item, int lane) {
    const int kb = item / nblk, nb = item - kb * nblk, k0 = 64 * kb, n0 = 32 * nb;
#pragma unroll 8
    for (int i = 0; i < 32; ++i) { const int kk = 2 * i + (lane >> 5); scr[kk * 33 + (lane & 31)] = W[(size_t)(k0 + kk) * ld + n0 + (lane & 31)]; }
    asm volatile("s_waitcnt lgkmcnt(0)" ::: "memory");
    const int c = lane & 7;
#pragma unroll
    for (int j = 0; j < 4; ++j) { const int n = (lane >> 3) + 8 * j; const LAS float* s = scr + (8 * c) * 33 + n;
        pg8::u32x4 o; o.x = pk2(s[0 * 33], s[1 * 33]); o.y = pk2(s[2 * 33], s[3 * 33]); o.z = pk2(s[4 * 33], s[5 * 33]); o.w = pk2(s[6 * 33], s[7 * 33]);
        *(pg8::u32x4*)(WT + (size_t)(n0 + n) * 1024 + k0 + 8 * c) = o; }
    asm volatile("s_waitcnt lgkmcnt(0)" ::: "memory");
}
__device__ __forceinline__ void d_convert_a(KP kp, LAS float* scr_all) {
    PH_IDS;
    const int lane = tid & 63; LAS float* scr = scr_all + (tid >> 6) * (64 * 33);
    constexpr int I_IN = 16 * 104, I_OUT = 16 * 32, I_W1 = 16 * 64, I_W2 = 16 * 32, I_L = I_IN + I_OUT + 32 * I_W1 + 32 * I_W2;
    GW_LOOP(it, 2 * I_L) {
        const int l = it / I_L; int r = it - l * I_L;
        if (r < I_IN) { transpose_item(p.w_in + (size_t)l * D * INW, INW, 104, WSP(bf16_t, WS_WIN_T) + (size_t)l * PW * 1024, scr, r, lane); continue; } r -= I_IN;
        if (r < I_OUT) { transpose_item(p.w_out + (size_t)l * D * D, 1024, 32, WSP(bf16_t, WS_WOUT_T) + (size_t)l * 1024 * 1024, scr, r, lane); continue; } r -= I_OUT;
        if (r < 32 * I_W1) { const int e = r / I_W1; transpose_item(p.exp_w1 + ((size_t)l * NEXP + e) * D * 2048, 2048, 64, WSP(bf16_t, WS_W1_T) + ((size_t)l * NEXP + e) * 2048 * 1024, scr, r - e * I_W1, lane); continue; } r -= 32 * I_W1;
        { const int e = r / I_W2; transpose_item(p.exp_w2 + ((size_t)l * NEXP + e) * D * D, 1024, 32, WSP(bf16_t, WS_W2_T) + ((size_t)l * NEXP + e) * 1024 * 1024, scr, r - e * I_W2, lane); }
    }
    GT_LOOP(idx, 2 * PW) { const int l = idx / PW, n = idx - l * PW; WSP(float, WS_BIAS_IN)[idx] = n < 3328 ? 0.f : p.gla_gate_b[l * 256 + n - 3328]; }
}
__device__ __forceinline__ void d_convert_b(KP kp, LAS float* scr_all) {
    PH_IDS;
    const int lane = tid & 63; LAS float* scr = scr_all + (tid >> 6) * (64 * 33);
    GW_LOOP(it, 2 * 128) { const int l = it >> 7; transpose_item(WSP(float, WS_WEFF) + (size_t)l * D * 256, 256, 8, WSP(bf16_t, WS_WIN_T) + ((size_t)l * PW + 3328) * 1024, scr, it & 127, lane); }
}

__device__ __forceinline__ void d_gemm_in(KP kp, int l, LAS unsigned char* lds) {
    PH_IDS;
    pg8::DenseOrder S; S.init(MALL, PW, gridDim.x, bid, WSP(bf16_t, WS_HB), WSP(bf16_t, WS_WIN_T) + (size_t)l * PW * 1024);
    pg8::EpiBf16 E{WSP(bf16_t, WS_PBUF), PW, WSP(float, WS_BIAS_IN) + l * PW};
    pg8::gphase<pg8::EpiBf16, pg8::DenseOrder, false, true>(lds, S, E);
}
__device__ __forceinline__ void d_gemm_out(KP kp, int l, LAS unsigned char* lds) {
    PH_IDS;
    pg8::DenseOrder S; S.init(nrows_l(l), 1024, gridDim.x, bid, WSP(bf16_t, WS_CONCAT), WSP(bf16_t, WS_WOUT_T) + (size_t)l * 1024 * 1024);
    pg8::EpiF32 E{WSP(float, WS_YBUF), 1024};
    pg8::gphase<pg8::EpiF32, pg8::DenseOrder, false, true>(lds, S, E);
}
__device__ __forceinline__ void d_moe_up(KP kp, int l, LAS unsigned char* lds) {
    PH_IDS;
    LAS int* tab = (LAS int*)(lds + pg8::STAGE_BYTES);
    const unsigned* cnt = WSP(unsigned, WS_CTL) + CW_CNT + l * 32 * 64;
    pg8::moe_tab_build(tab, cnt, 8);
    pg8::MoeOrder S{tab, (int)gridDim.x, bid, 8, (const char*)WSP(bf16_t, WS_HB), (const char*)(WSP(bf16_t, WS_W1_T) + (size_t)l * NEXP * 2048 * 1024), (size_t)2048 * 1024 * 2, WSP(int, WS_LIST), cnt, true};
    pg8::EpiMoeUp E{WSP(bf16_t, WS_ACT), p.exp_b1 + (size_t)l * NEXP * 2048};
    pg8::gphase<pg8::EpiMoeUp, pg8::MoeOrder, true, true>(lds, S, E);
}
__device__ __forceinline__ void d_moe_down(KP kp, int l, LAS unsigned char* lds) {
    PH_IDS;
    LAS int* tab = (LAS int*)(lds + pg8::STAGE_BYTES);
    const unsigned* cnt = WSP(unsigned, WS_CTL) + CW_CNT + l * 32 * 64;
    pg8::moe_tab_build(tab, cnt, 4);
    pg8::MoeOrder S{tab, (int)gridDim.x, bid, 4, (const char*)WSP(bf16_t, WS_ACT), (const char*)(WSP(bf16_t, WS_W2_T) + (size_t)l * NEXP * 1024 * 1024), (size_t)1024 * 1024 * 2, WSP(int, WS_LIST), cnt, false};
    pg8::EpiMoeDown E{WSP(bf16_t, WS_YSLOT), p.exp_b2 + (size_t)l * NEXP * 1024, WSP(float, WS_TOPW)};
    pg8::gphase<pg8::EpiMoeDown, pg8::MoeOrder, false, true>(lds, S, E);
}

constexpr int ATT_NT = 68;
constexpr float ATT_QSCALE = 0.17677669529663687f * 1.4426950408889634f;
__device__ __forceinline__ void d_prep_attn(KP kp) {
    PH_IDS;
    const bf16_t* PB = WSP(bf16_t, WS_PBUF);
    GT_LOOP(idx, MALL * 16) {
        const int row = idx >> 4, hm = (idx >> 1) & 7, ks = idx & 1, h = hm >> 1, m = hm & 1;
        const bool lat = row < NLAT; const int t = row & (SEQ - 1);
        const int ipos = lat ? (ks == 0 ? (t >> 6) : (t & 63)) : 0;
        const int cb = h * 64 + m * 32 + ks * 16;
        const pg8::u32x4* qs = (const pg8::u32x4*)(PB + (size_t)row * PW + PC_AQ + cb);
        const pg8::u32x4* ksrc = (const pg8::u32x4*)(PB + (size_t)row * PW + PC_AK + cb);
        pg8::u32x4 qa = qs[0], qb = qs[1], ka = ksrc[0], kb = ksrc[1];
        float qv[16], kv[16];
#pragma unroll
        for (int j = 0; j < 4; ++j) { qv[2 * j] = bf2f((bf16_t)(qa[j] & 0xffff)); qv[2 * j + 1] = bf2f((bf16_t)(qa[j] >> 16)); qv[8 + 2 * j] = bf2f((bf16_t)(qb[j] & 0xffff)); qv[9 + 2 * j] = bf2f((bf16_t)(qb[j] >> 16));
                                      kv[2 * j] = bf2f((bf16_t)(ka[j] & 0xffff)); kv[2 * j + 1] = bf2f((bf16_t)(ka[j] >> 16)); kv[8 + 2 * j] = bf2f((bf16_t)(kb[j] & 0xffff)); kv[9 + 2 * j] = bf2f((bf16_t)(kb[j] >> 16)); }
        float qo[16], ko[16];
#pragma unroll
        for (int j = 0; j < 8; ++j) {
            const float* tb = WSP(float, WS_ROPE) + (ipos * 8 + j) * 2; const float cs = tb[0], sn = tb[1];
            qo[j] = qv[j] * cs - qv[j + 8] * sn; qo[j + 8] = qv[j + 8] * cs + qv[j] * sn;
            ko[j] = kv[j] * cs - kv[j + 8] * sn; ko[j + 8] = kv[j + 8] * cs + kv[j] * sn;
        }
        pg8::u32x4 o0, o1;
#pragma unroll
        for (int j = 0; j < 4; ++j) { o0[j] = pk2(qo[2 * j] * ATT_QSCALE, qo[2 * j + 1] * ATT_QSCALE); o1[j] = pk2(qo[8 + 2 * j] * ATT_QSCALE, qo[9 + 2 * j] * ATT_QSCALE); }
        pg8::u32x4* qd = (pg8::u32x4*)(WSP(bf16_t, WS_QRP) + (size_t)row * 256 + cb); qd[0] = o0; qd[1] = o1;
#pragma unroll
        for (int j = 0; j < 4; ++j) { o0[j] = pk2(ko[2 * j], ko[2 * j + 1]); o1[j] = pk2(ko[8 + 2 * j], ko[9 + 2 * j]); }
        int b, tile, key; if (lat) { b = row >> 12; tile = t >> 6; key = t & 63; } else { const int r = row - NLAT; b = r >> 8; tile = 64 + ((r & 255) >> 6); key = r & 63; }
        unsigned char* img = WSP(unsigned char, WS_KIMG) + ((size_t)(b * 4 + h) * ATT_NT + tile) * 8192 + key * 128;
        const int c0 = m * 4 + ks * 2, sw = (key >> 1) & 7;
        *(pg8::u32x4*)(img + 16 * (c0 ^ sw)) = o0; *(pg8::u32x4*)(img + 16 * ((c0 + 1) ^ sw)) = o1;
    }
    GT_LOOP(idx, 16 * ATT_NT * 2 * 64) {
        const int d = idx & 63, half = (idx >> 6) & 1, tile = (idx >> 7) % ATT_NT, bh = idx / (128 * ATT_NT), b = bh >> 2, h = bh & 3;
        const int row0 = (tile < 64 ? b * SEQ + tile * 64 : NLAT + b * CTXL + (tile - 64) * 64) + half * 32;
        const bf16_t* vp = PB + (size_t)row0 * PW + PC_AV + h * 64 + d;
        unsigned short vv[32];
#pragma unroll
        for (int j = 0; j < 32; ++j) vv[j] = vp[(size_t)j * PW];
        unsigned char* img = WSP(unsigned char, WS_VIMG) + ((size_t)bh * ATT_NT + tile) * 8192 + d * 128; const int x = (d >> 1) & 15;
#pragma unroll
        for (int j = 0; j < 8; ++j) *(pg8::u32x2*)(img + 8 * ((half * 8 + j) ^ x)) = (pg8::u32x2){(unsigned)vv[4 * j] | ((unsigned)vv[4 * j + 1] << 16), (unsigned)vv[4 * j + 2] | ((unsigned)vv[4 * j + 3] << 16)};
    }
}

namespace att {
typedef short bf16x8 __attribute__((ext_vector_type(8)));
typedef float f32x16 __attribute__((ext_vector_type(16)));
typedef unsigned u32x4 __attribute__((ext_vector_type(4)));
typedef unsigned u32x2 __attribute__((ext_vector_type(2)));
constexpr int SLOT = 8192, NSLOT = 4, LDS_K = 0, LDS_V = NSLOT * SLOT, LDS_SCR = 2 * NSLOT * SLOT;
constexpr float THR = 8.f;
__device__ __forceinline__ int crow(int r, int hi) { return (r & 3) + 8 * (r >> 2) + 4 * hi; }
__device__ __forceinline__ unsigned cvtpk(float lo, float hi) { return cvtpk_rne(lo, hi); }
__device__ __forceinline__ float xhalf_max(float v) { return fmaxf(v, __shfl_xor(v, 32)); }
}
__device__ __forceinline__ void attn_unit(KP kp, int l, int b, int h, int qt, LAS unsigned char* lds, float lam, float lam_init, int tid) {
    using namespace att;
    const int lane = tid & 63, wid = __builtin_amdgcn_readfirstlane(tid >> 6), q32 = lane & 31, hi = lane >> 5;
    const int t0 = qt < 0 ? 64 : 0, t1 = ATT_NT;
    const int rowbase = (qt < 0 ? NLAT + b * CTXL : b * SEQ + qt * 256) + wid * 32;
    const unsigned char* kimg = WSP(unsigned char, WS_KIMG) + (size_t)(b * 4 + h) * ATT_NT * 8192 + wid * 1024 + lane * 16;
    const unsigned char* vimg = WSP(unsigned char, WS_VIMG) + (size_t)(b * 4 + h) * ATT_NT * 8192 + wid * 1024 + lane * 16;
    LAS float* scr = (LAS float*)(lds + LDS_SCR) + wid * 64;
#define ATT_DMA(t, slot) do { __builtin_amdgcn_global_load_lds((const unsigned*)(kimg + (size_t)(t) * 8192), (LAS unsigned*)(lds + LDS_K + (slot) * SLOT + wid * 1024), 16, 0, 0); \
                              __builtin_amdgcn_global_load_lds((const unsigned*)(vimg + (size_t)(t) * 8192), (LAS unsigned*)(lds + LDS_V + (slot) * SLOT + wid * 1024), 16, 0, 0); } while (0)
    bf16x8 qf[2][2];
    { const bf16_t* qp = WSP(bf16_t, WS_QRP) + (size_t)(rowbase + q32) * 256 + h * 64 + hi * 8;
#pragma unroll
      for (int m = 0; m < 2; ++m)
#pragma unroll
        for (int ks = 0; ks < 2; ++ks) qf[m][ks] = *(const bf16x8*)(qp + m * 32 + ks * 16); }
    asm volatile("s_waitcnt vmcnt(0)" ::: "memory");
    __builtin_amdgcn_s_barrier();
    ATT_DMA(t0, 0); ATT_DMA(t0 + 1, 1); ATT_DMA(t0 + 2, 2);
    asm volatile("s_waitcnt vmcnt(4)" ::: "memory");
    __builtin_amdgcn_s_barrier();
    f32x16 O[2][2];
#pragma unroll
    for (int m = 0; m < 2; ++m)
#pragma unroll
        for (int dh = 0; dh < 2; ++dh)
#pragma unroll
            for (int r = 0; r < 16; ++r) O[m][dh][r] = 0.f;
    float mref[2] = {0.f, 0.f}, lsum[2] = {0.f, 0.f};
    const int koff = q32 * 128, ksw = (q32 >> 1) & 7;
    int slot = 0;
#pragma unroll 1
    for (int t = t0; t < t1; ++t) {
        asm volatile("s_waitcnt vmcnt(0)" ::: "memory");
        __builtin_amdgcn_s_barrier();
        asm volatile("" ::: "memory");
        if (t + 3 < t1) { const int s3 = (slot + 3) & 3; ATT_DMA(t + 3, s3); }
        const LAS unsigned char* Ks = lds + LDS_K + slot * SLOT; const LAS unsigned char* Vs = lds + LDS_V + slot * SLOT;
        u32x4 ppk[2][2][2];
#pragma unroll
        for (int m = 0; m < 2; ++m) {
            f32x16 S[2];
            { const float nm = -mref[m];
#pragma unroll
              for (int r = 0; r < 16; ++r) { S[0][r] = nm; S[1][r] = nm; } }
#pragma unroll
            for (int kh = 0; kh < 2; ++kh)
#pragma unroll
                for (int ks = 0; ks < 2; ++ks) {
                    const bf16x8 kf = *(const LAS bf16x8*)(Ks + kh * 4096 + koff + 16 * ((m * 4 + ks * 2 + hi) ^ ksw));
                    S[kh] = __builtin_amdgcn_mfma_f32_32x32x16_bf16(kf, qf[m][ks], S[kh], 0, 0, 0);
                }
            float mx = fmaxf(S[0][0], S[1][0]);
#pragma unroll
            for (int r = 1; r < 16; ++r) mx = fmaxf(mx, fmaxf(S[0][r], S[1][r]));
            mx = xhalf_max(mx);
            const bool first = (t == t0);
            if (__any(first || mx > THR)) {
                const float dl = first ? mx : fmaxf(mx, 0.f);
                mref[m] += dl;
#pragma unroll
                for (int r = 0; r < 16; ++r) { S[0][r] -= dl; S[1][r] -= dl; }
                const float f = __builtin_amdgcn_exp2f(-dl);
                lsum[m] *= f;
                if (!first) {
                    if (hi == 0) scr[q32] = f;
                    asm volatile("s_waitcnt lgkmcnt(0)" ::: "memory");
#pragma unroll
                    for (int r = 0; r < 16; ++r) { const float fr = scr[crow(r, hi)]; O[m][0][r] *= fr; O[m][1][r] *= fr; }
                    asm volatile("s_waitcnt lgkmcnt(0)" ::: "memory");
                }
            }
            float ls = 0.f;
#pragma unroll
            for (int kh = 0; kh < 2; ++kh) {
#pragma unroll
                for (int r = 0; r < 16; ++r) { S[kh][r] = __builtin_amdgcn_exp2f(S[kh][r]); ls += S[kh][r]; }
#pragma unroll
                for (int s = 0; s < 2; ++s)
#pragma unroll
                    for (int j = 0; j < 4; ++j) ppk[m][kh][s][j] = cvtpk(S[kh][8 * s + 2 * j], S[kh][8 * s + 2 * j + 1]);
            }
            lsum[m] += ls;
        }
#pragma unroll
        for (int kh = 0; kh < 2; ++kh)
#pragma unroll
            for (int s = 0; s < 2; ++s)
#pragma unroll
                for (int dh = 0; dh < 2; ++dh) {
                    const int d = dh * 32 + q32, kc = 8 * kh + 4 * s + hi, vsw = (d >> 1) & 15;
                    const u32x2 v0 = *(const LAS u32x2*)(Vs + d * 128 + 8 * (kc ^ vsw)), v1 = *(const LAS u32x2*)(Vs + d * 128 + 8 * ((kc + 2) ^ vsw));
                    const u32x4 vv = (u32x4){v0.x, v0.y, v1.x, v1.y};
                    const bf16x8 vf = __builtin_bit_cast(bf16x8, vv);
#pragma unroll
                    for (int m = 0; m < 2; ++m) O[m][dh] = __builtin_amdgcn_mfma_f32_32x32x16_bf16(__builtin_bit_cast(bf16x8, ppk[m][kh][s]), vf, O[m][dh], 0, 0, 0);
                }
        asm volatile("s_waitcnt lgkmcnt(0)" ::: "memory");
        slot = (slot + 1) & 3;
    }
#undef ATT_DMA
    float il[2][16];
#pragma unroll
    for (int m = 0; m < 2; ++m) { const float lt = lsum[m] + __shfl_xor(lsum[m], 32); if (hi == 0) scr[m * 32 + q32] = 1.f / lt; }
    asm volatile("s_waitcnt lgkmcnt(0)" ::: "memory");
#pragma unroll
    for (int m = 0; m < 2; ++m)
#pragma unroll
        for (int r = 0; r < 16; ++r) il[m][r] = scr[m * 32 + crow(r, hi)];
    asm volatile("s_waitcnt lgkmcnt(0)" ::: "memory");
    const float g0 = p.diff_subln_g[l * 64 + q32] * (1.f - lam_init), g1 = p.diff_subln_g[l * 64 + 32 + q32] * (1.f - lam_init);
    bf16_t* outp = WSP(bf16_t, WS_CONCAT) + (size_t)rowbase * D + h * 64 + q32;
#pragma unroll
    for (int r = 0; r < 16; ++r) {
        const float o0 = O[0][0][r] * il[0][r] - lam * O[1][0][r] * il[1][r], o1 = O[0][1][r] * il[0][r] - lam * O[1][1][r] * il[1][r];
        float ss = o0 * o0 + o1 * o1;
#pragma unroll
        for (int x = 1; x < 32; x <<= 1) ss += __shfl_xor(ss, x);
        const float rstd = rsqrtf(ss * (1.f / 64.f) + EPS);
        bf16_t* op = outp + (size_t)crow(r, hi) * D;
        op[0] = f2bf(o0 * rstd * g0); op[32] = f2bf(o1 * rstd * g1);
    }
}
__device__ __forceinline__ void d_attn_fast(KP kp, int l, LAS unsigned char* lds) {
    PH_IDS;
    const float* dl = p.diff_lambda + l * 4 * 32;
    float s1 = 0.f, s2 = 0.f;
    for (int i = 0; i < 32; ++i) { s1 += dl[i] * dl[32 + i]; s2 += dl[64 + i] * dl[96 + i]; }
    const float lam_init = 0.8f - 0.6f * expf(-0.3f * (float)l);
    const float lam = expf(s1) - expf(s2) + lam_init;
    const int G = gridDim.x, vb = (G % 8 == 0) ? (bid % 8) * (G / 8) + bid / 8 : bid;
    const int nunits = 256 + (l == 0 ? 16 : 0);
    for (int u = vb; u < nunits; u += G) {
        if (u < 256) attn_unit(kp, l, u >> 6, (u >> 4) & 3, u & 15, lds, lam, lam_init, tid);
        else attn_unit(kp, l, (u - 256) >> 2, (u - 256) & 3, -1, lds, lam, lam_init, tid);
    }
    __syncthreads();
}

constexpr int NCHUNK = MALL / 64;
__device__ __forceinline__ float logsig16(float x) { const float y = __builtin_amdgcn_exp2f(-fabsf(x) * 1.4426950408889634f); return (fminf(x, 0.f) - __builtin_amdgcn_logf(1.f + y) * 0.6931471805599453f) * (1.f / 16.f); }
__device__ __forceinline__ void d_prep_scan(KP kp) {
    PH_IDS;
    const bf16_t* PB = WSP(bf16_t, WS_PBUF);
    GT_LOOP(idx, 8 * MALL) {
        const int row = idx % MALL, hk = idx / MALL, h = hk >> 1, ks = hk & 1;
        const bool lat = row < NLAT; const int t = row & (SEQ - 1);
        const int ipos = lat ? (ks == 0 ? (t >> 6) : (t & 63)) : 0;
        const int cb = h * 64 + ks * 32;
        const pg8::u32x4* qs = (const pg8::u32x4*)(PB + (size_t)row * PW + PC_RQ + cb);
        const pg8::u32x4* ksrc = (const pg8::u32x4*)(PB + (size_t)row * PW + PC_RK + cb);
        float qv[32], kv[32];
#pragma unroll
        for (int c4 = 0; c4 < 4; ++c4) { const pg8::u32x4 a = qs[c4], b4 = ksrc[c4];
#pragma unroll
            for (int j = 0; j < 4; ++j) { qv[c4 * 8 + 2 * j] = bf2f((bf16_t)(a[j] & 0xffff)); qv[c4 * 8 + 2 * j + 1] = bf2f((bf16_t)(a[j] >> 16)); kv[c4 * 8 + 2 * j] = bf2f((bf16_t)(b4[j] & 0xffff)); kv[c4 * 8 + 2 * j + 1] = bf2f((bf16_t)(b4[j] >> 16)); } }
        float qo[32], ko[32];
#pragma unroll
        for (int j = 0; j < 16; ++j) {
            const float* tb = WSP(float, WS_ROPE) + 1024 + (ipos * 16 + j) * 2; const float cs = tb[0], sn = tb[1];
            qo[j] = qv[j] * cs - qv[j + 16] * sn; qo[j + 16] = qv[j + 16] * cs + qv[j] * sn;
            ko[j] = (kv[j] * cs - kv[j + 16] * sn) * 0.125f; ko[j + 16] = (kv[j + 16] * cs + kv[j] * sn) * 0.125f;
        }
        pg8::u32x4* qd = (pg8::u32x4*)(WSP(bf16_t, WS_QF_R) + (size_t)row * 256 + cb); pg8::u32x4* kd = (pg8::u32x4*)(WSP(bf16_t, WS_KF_R) + (size_t)row * 256 + cb);
#pragma unroll
        for (int c4 = 0; c4 < 4; ++c4) { pg8::u32x4 a, b4;
#pragma unroll
            for (int j = 0; j < 4; ++j) { a[j] = pk2(qo[c4 * 8 + 2 * j], qo[c4 * 8 + 2 * j + 1]); b4[j] = pk2(ko[c4 * 8 + 2 * j], ko[c4 * 8 + 2 * j + 1]); }
            qd[c4] = a; kd[c4] = b4; }
        bf16_t* kt = WSP(bf16_t, WS_KT_R) + ((size_t)((row >> 6) * 4 + h) * 64 + ks * 32) * 64 + (row & 63);
#pragma unroll
        for (int i = 0; i < 32; ++i) kt[(size_t)i * 64] = f2bf(ko[i]);
    }
    GT_LOOP(idx, 4 * MALL) {
        const int row = idx % MALL, h = idx / MALL;
        const pg8::u32x4* ksrc = (const pg8::u32x4*)(PB + (size_t)row * PW + PC_GK + h * 32);
        bf16_t* kt = WSP(bf16_t, WS_KT_G) + ((size_t)((row >> 6) * 4 + h) * 32) * 64 + (row & 63);
#pragma unroll
        for (int c4 = 0; c4 < 4; ++c4) { const pg8::u32x4 a = ksrc[c4];
#pragma unroll
            for (int j = 0; j < 4; ++j) { kt[(size_t)(c4 * 8 + 2 * j) * 64] = (bf16_t)(a[j] & 0xffff); kt[(size_t)(c4 * 8 + 2 * j + 1) * 64] = (bf16_t)(a[j] >> 16); } }
    }
    GT_LOOP(idx, NCHUNK * 2 * 128) {
        const int hk = idx & 127, dir = (idx >> 7) & 1, cid = idx >> 8;
        const bf16_t* src = PB + (size_t)(cid * 64) * PW + PC_GD + dir * 128 + hk;
        float* cum = WSP(float, WS_CUM_G) + ((size_t)dir * MALL + cid * 64) * 128 + hk;
        float* cumt = WSP(float, WS_CUMT_G) + (((size_t)dir * NCHUNK + cid) * 128 + hk) * 64;
        float v[64];
#pragma unroll
        for (int j = 0; j < 64; ++j) v[j] = bf2f(src[(size_t)j * PW]);
#pragma unroll
        for (int j = 0; j < 64; ++j) v[j] = logsig16(v[j]);
        if (dir == 0) {
#pragma unroll
            for (int j = 1; j < 64; ++j) v[j] += v[j - 1];
        } else {
#pragma unroll
            for (int j = 62; j >= 0; --j) v[j] += v[j + 1];
        }
#pragma unroll
        for (int j = 0; j < 64; ++j) cum[(size_t)j * 128] = v[j];
#pragma unroll
        for (int j = 0; j < 16; ++j) *(pg8::f32x4*)(cumt + 4 * j) = (pg8::f32x4){v[4 * j], v[4 * j + 1], v[4 * j + 2], v[4 * j + 3]};
    }
    GT_LOOP(idx, 2 * NCHUNK * 4 * 2 * 64) {
        const int d = idx & 63, half = (idx >> 6) & 1, ch = (idx >> 7) % (NCHUNK * 4), mx = idx / (128 * NCHUNK * 4), h = ch & 3, cid = ch >> 2;
        const bf16_t* vp = PB + (size_t)(cid * 64 + half * 32) * PW + (mx == 0 ? PC_RV : PC_GV) + h * 64 + d;
        unsigned short vv[32];
#pragma unroll
        for (int j = 0; j < 32; ++j) vv[j] = vp[(size_t)j * PW];
        unsigned char* img = WSP(unsigned char, mx == 0 ? WS_VT_R : WS_VT_G) + (size_t)ch * 8192 + d * 128; const int x = (d >> 1) & 15;
#pragma unroll
        for (int j = 0; j < 8; ++j) *(pg8::u32x2*)(img + 8 * ((half * 8 + j) ^ x)) = (pg8::u32x2){(unsigned)vv[4 * j] | ((unsigned)vv[4 * j + 1] << 16), (unsigned)vv[4 * j + 2] | ((unsigned)vv[4 * j + 3] << 16)};
    }
}

namespace scn {
typedef short bf16x8 __attribute__((ext_vector_type(8)));
typedef float f32x16 __attribute__((ext_vector_type(16)));
typedef float f32x4 __attribute__((ext_vector_type(4)));
typedef unsigned u32x4 __attribute__((ext_vector_type(4)));
typedef unsigned u32x2 __attribute__((ext_vector_type(2)));
__device__ __forceinline__ int crow(int r, int hi) { return (r & 3) + 8 * (r >> 2) + 4 * hi; }
__device__ __forceinline__ unsigned cvtpk(float lo, float hi) { return cvtpk_rne(lo, hi); }
__device__ __forceinline__ float blo(unsigned w) { return __uint_as_float(w << 16); }
__device__ __forceinline__ float bhi(unsigned w) { return __uint_as_float(w & 0xffff0000u); }
__device__ __forceinline__ bf16x8 scale8(u32x4 raw, const float (&f)[8]) {
    u32x4 o;
#pragma unroll
    for (int j = 0; j < 4; ++j) o[j] = cvtpk(blo(raw[j]) * f[2 * j], bhi(raw[j]) * f[2 * j + 1]);
    return __builtin_bit_cast(bf16x8, o);
}
template <int MX> struct Cfg;
template <> struct Cfg<0> { static constexpr int DK = 64; };
template <> struct Cfg<1> { static constexpr int DK = 32; };
}
#define SCN_EXP(x) __builtin_amdgcn_exp2f((x) * 1.4426950408889634f)
template <int MX> __device__ __forceinline__ void scan_stage1_unit(KP kp, int l, int b, int h, int g, int tid) {
    using namespace scn;
    constexpr int DK = Cfg<MX>::DK, NKT = DK / 32, NE = DK * 64 / NT;
    const int lane = tid & 63, wid = __builtin_amdgcn_readfirstlane(tid >> 6), q32 = lane & 31, hi = lane >> 5;
    const int nch = g == 8 ? 4 : 8, cid0 = g == 8 ? 256 + 4 * b : b * 64 + 8 * g;
    float* US = WSP(float, MX == 0 ? WS_US_R : WS_US_G);
    const float* CUMT = WSP(float, WS_CUMT_G);
    if (wid < nch) {
        const int cid = cid0 + wid;
        const unsigned char* vimg = WSP(unsigned char, MX == 0 ? WS_VT_R : WS_VT_G) + (size_t)(cid * 4 + h) * 8192;
        const bf16_t* ktimg = WSP(bf16_t, MX == 0 ? WS_KT_R : WS_KT_G) + (size_t)(cid * 4 + h) * DK * 64;
        bf16x8 vb[2][4];
#pragma unroll
        for (int dh = 0; dh < 2; ++dh)
#pragma unroll
            for (int s = 0; s < 4; ++s) { const int d = dh * 32 + q32, x = (d >> 1) & 15, kc = 4 * s + 2 * hi;
                u32x4 v = *(const u32x4*)(vimg + d * 128 + 16 * ((kc ^ x) >> 1));
                if (x & 1) v = (u32x4){v.z, v.w, v.x, v.y};
                vb[dh][s] = __builtin_bit_cast(bf16x8, v); }
#pragma unroll 1
        for (int dir = 0; dir < 2; ++dir) {
            float lg = 0.f; if (MX == 0) lg = -expf(p.ret_decay[(l * 2 + dir) * 4 + h]);
#pragma unroll 1
            for (int kt = 0; kt < NKT; ++kt) {
                f32x16 U[2];
#pragma unroll
                for (int dh = 0; dh < 2; ++dh)
#pragma unroll
                    for (int r = 0; r < 16; ++r) U[dh][r] = 0.f;
                const int k = kt * 32 + q32;
                const float* ct = CUMT + (((size_t)dir * NCHUNK + cid) * 128 + h * 32 + (k & 31)) * 64;
                float E = 0.f; if (MX == 1) E = ct[dir == 0 ? 63 : 0];
#pragma unroll
                for (int s = 0; s < 4; ++s) {
                    const int j0 = 16 * s + 8 * hi;
                    const u32x4 raw = *(const u32x4*)(ktimg + (size_t)k * 64 + j0);
                    float f[8];
                    if (MX == 0) {
#pragma unroll
                        for (int jj = 0; jj < 8; ++jj) f[jj] = SCN_EXP(lg * (float)(dir == 0 ? 63 - (j0 + jj) : j0 + jj));
                    } else {
                        const f32x4 c0 = *(const f32x4*)(ct + j0), c1 = *(const f32x4*)(ct + j0 + 4);
#pragma unroll
                        for (int jj = 0; jj < 4; ++jj) { f[jj] = SCN_EXP(E - c0[jj]); f[4 + jj] = SCN_EXP(E - c1[jj]); }
                    }
                    const bf16x8 af = scale8(raw, f);
#pragma unroll
                    for (int dh = 0; dh < 2; ++dh) U[dh] = __builtin_amdgcn_mfma_f32_32x32x16_bf16(af, vb[dh][s], U[dh], 0, 0, 0);
                }
                float* up = US + ((((size_t)dir * NCHUNK + cid) * 4 + h) * DK + kt * 32 + 4 * hi) * 64 + q32;
#pragma unroll
                for (int dh = 0; dh < 2; ++dh)
#pragma unroll
                    for (int r = 0; r < 16; ++r) up[((r & 3) + 8 * (r >> 2)) * 64 + dh * 32] = U[dh][r];
            }
        }
    }
    asm volatile("s_waitcnt vmcnt(0)" ::: "memory");
    __syncthreads();
    const int k = (tid * NE) >> 6, d0 = (tid * NE) & 63;
#pragma unroll
    for (int dir = 0; dir < 2; ++dir) {
        float S[NE], Ap = 1.f;
#pragma unroll
        for (int e = 0; e < NE; ++e) S[e] = 0.f;
        float lg = 0.f; if (MX == 0) lg = -expf(p.ret_decay[(l * 2 + dir) * 4 + h]);
        for (int cc = 0; cc < nch; ++cc) {
            const int c = dir == 0 ? cc : nch - 1 - cc, cid = cid0 + c;
            float A;
            if (MX == 0) A = SCN_EXP(lg * 64.f); else A = SCN_EXP(CUMT[(((size_t)dir * NCHUNK + cid) * 128 + h * 32 + k) * 64 + (dir == 0 ? 63 : 0)]);
            const float* up = US + ((((size_t)dir * NCHUNK + cid) * 4 + h) * DK + k) * 64 + d0;
#pragma unroll
            for (int e = 0; e < NE; ++e) S[e] = A * S[e] + up[e];
            Ap *= A;
        }
        float* ug = WSP(float, MX == 0 ? WS_UG_R : WS_UG_G) + (((((size_t)dir * 4 + b) * 4 + h) * 9 + g) * DK + k) * 64 + d0;
#pragma unroll
        for (int e = 0; e < NE; ++e) ug[e] = S[e];
        if (d0 == 0) WSP(float, WS_AG)[((((MX * 2 + dir) * 4 + b) * 4 + h) * 9 + g) * 64 + k] = Ap;
    }
}
template <int MX> __device__ __forceinline__ void scan_stage2_unit(KP kp, int l, int b, int h, int g, LAS unsigned char* lds, int tid) {
    using namespace scn;
    constexpr int DK = Cfg<MX>::DK, NKS = DK / 16, NE = DK * 64 / NT, NCH16 = DK / 8;
    const int lane = tid & 63, wid = __builtin_amdgcn_readfirstlane(tid >> 6), q32 = lane & 31, hi = lane >> 5;
    const int nch = g == 8 ? 4 : 8, cid0 = g == 8 ? 256 + 4 * b : b * 64 + 8 * g;
    const bool act = wid < nch;
    const int cid = cid0 + (act ? wid : 0), row0 = cid * 64;
    const bf16_t* PB = WSP(bf16_t, WS_PBUF);
    const float* US = WSP(float, MX == 0 ? WS_US_R : WS_US_G);
    const float* UG = WSP(float, MX == 0 ? WS_UG_R : WS_UG_G);
    const float* CUMT = WSP(float, WS_CUMT_G);
    f32x16 o[2][2];
#pragma unroll
    for (int it = 0; it < 2; ++it)
#pragma unroll
        for (int dh = 0; dh < 2; ++dh)
#pragma unroll
            for (int r = 0; r < 16; ++r) o[it][dh][r] = 0.f;
    LAS unsigned char* myv = lds + 65536 + wid * 8192;
    { const unsigned char* vimg = WSP(unsigned char, MX == 0 ? WS_VT_R : WS_VT_G) + (size_t)(cid * 4 + h) * 8192 + lane * 16;
      u32x4 tmp[8];
#pragma unroll
      for (int i = 0; i < 8; ++i) tmp[i] = *(const u32x4*)(vimg + i * 1024);
#pragma unroll
      for (int i = 0; i < 8; ++i) *(LAS u32x4*)(myv + i * 1024 + lane * 16) = tmp[i]; }
    const int fk = (tid * NE) >> 6, fd0 = (tid * NE) & 63;
#pragma unroll 1
    for (int dir = 0; dir < 2; ++dir) {
        float lg = 0.f; if (MX == 0) lg = -expf(p.ret_decay[(l * 2 + dir) * 4 + h]);
        float S[NE];
#pragma unroll
        for (int e = 0; e < NE; ++e) S[e] = 0.f;
        if (g != 8) {
            const float* ugb = UG + (((size_t)dir * 4 + b) * 4 + h) * 9 * DK * 64 + (size_t)fk * 64 + fd0;
            const float* agb = WSP(float, WS_AG) + (((MX * 2 + dir) * 4 + b) * 4 + h) * 9 * 64 + fk;
            const int ng = dir == 0 ? g : 7 - g;
            float ug[7][NE], ag[7];
#pragma unroll
            for (int e = 0; e < NE; ++e) S[e] = ugb[(size_t)8 * DK * 64 + e];
#pragma unroll
            for (int q = 0; q < 7; ++q) { const bool on = q < ng; const int qq = on ? q : 0, gg = dir == 0 ? qq : 7 - qq; const float av = agb[gg * 64]; ag[q] = on ? av : 1.f;
#pragma unroll
                for (int e = 0; e < NE; ++e) { const float uv = ugb[(size_t)gg * DK * 64 + e]; ug[q][e] = on ? uv : 0.f; } }
#pragma unroll
            for (int q = 0; q < 7; ++q)
#pragma unroll
                for (int e = 0; e < NE; ++e) S[e] = ag[q] * S[e] + ug[q][e];
        }
        {
            float uc[8][NE], ac[8];
#pragma unroll
            for (int cc = 0; cc < 8; ++cc) { const bool on = cc < nch; const int c = dir == 0 ? cc : nch - 1 - cc, ccid = cid0 + (on ? c : 0);
                if (MX == 0) ac[cc] = SCN_EXP(lg * 64.f); else ac[cc] = SCN_EXP(CUMT[(((size_t)dir * NCHUNK + ccid) * 128 + h * 32 + fk) * 64 + (dir == 0 ? 63 : 0)]);
                const float* up = US + ((((size_t)dir * NCHUNK + ccid) * 4 + h) * DK + fk) * 64 + fd0;
#pragma unroll
                for (int e = 0; e < NE; ++e) uc[cc][e] = up[e]; }
#pragma unroll
            for (int cc = 0; cc < 8; ++cc) if (cc < nch) {
                const int c = dir == 0 ? cc : nch - 1 - cc;
                LAS unsigned char* area = lds + c * 8192;
#pragma unroll
                for (int e = 0; e < NE; ++e) { const int d = fd0 + e; const int sw = DK == 64 ? ((d >> 1) & 7) : ((d >> 2) & 3);
                    *(LAS bf16_t*)(area + d * (DK * 2) + 16 * ((fk >> 3) ^ sw) + (fk & 7) * 2) = f2bf(S[e]); }
#pragma unroll
                for (int e = 0; e < NE; ++e) S[e] = ac[cc] * S[e] + uc[cc][e];
            }
        }
        asm volatile("s_waitcnt lgkmcnt(0)" ::: "memory");
        __syncthreads();
        if (act) {
#define SCN_GEN(dst, ISQ, T2) do { const int il_ = 32 * (T2) + q32, row_ = row0 + il_; \
                _Pragma("unroll") for (int ks = 0; ks < NKS; ++ks) { const int kc0 = 16 * ks + 8 * hi; u32x4 raw_; float f_[8]; \
                    if (MX == 0) { raw_ = *(const u32x4*)(WSP(bf16_t, (ISQ) ? WS_QF_R : WS_KF_R) + (size_t)row_ * 256 + h * 64 + kc0); \
                        const float cm_ = lg * (float)(dir == 0 ? il_ + 1 : 64 - il_), e_ = SCN_EXP((ISQ) ? cm_ : -cm_); \
                        _Pragma("unroll") for (int jj = 0; jj < 8; ++jj) f_[jj] = e_; \
                    } else { raw_ = *(const u32x4*)(PB + (size_t)row_ * PW + ((ISQ) ? PC_GQ : PC_GK) + h * 32 + kc0); \
                        const float* cp_ = WSP(float, WS_CUM_G) + ((size_t)dir * MALL + row_) * 128 + h * 32 + kc0; \
                        const f32x4 c0_ = *(const f32x4*)cp_, c1_ = *(const f32x4*)(cp_ + 4); \
                        _Pragma("unroll") for (int jj = 0; jj < 4; ++jj) { f_[jj] = (ISQ) ? SCN_EXP(c0_[jj]) * 0.17677669529663687f : SCN_EXP(-c0_[jj]); f_[4 + jj] = (ISQ) ? SCN_EXP(c1_[jj]) * 0.17677669529663687f : SCN_EXP(-c1_[jj]); } } \
                    dst[ks] = scale8(raw_, f_); } } while (0)
#define SCN_TILE(JT, IT, MASKED) do { bf16x8 kf_[NKS]; SCN_GEN(kf_, false, JT); f32x16 P; \
                _Pragma("unroll") for (int r = 0; r < 16; ++r) P[r] = 0.f; \
                _Pragma("unroll") for (int ks = 0; ks < NKS; ++ks) P = __builtin_amdgcn_mfma_f32_32x32x16_bf16(kf_[ks], qf[ks], P, 0, 0, 0); \
                if (MASKED) { _Pragma("unroll") for (int r = 0; r < 16; ++r) { const int j = crow(r, hi); const bool keep = dir == 0 ? (j <= q32) : (j >= q32); P[r] = keep ? P[r] : 0.f; } } \
                _Pragma("unroll") for (int s = 0; s < 2; ++s) { u32x4 pk; \
                    _Pragma("unroll") for (int j = 0; j < 4; ++j) pk[j] = cvtpk(P[8 * s + 2 * j], P[8 * s + 2 * j + 1]); \
                    _Pragma("unroll") for (int dh = 0; dh < 2; ++dh) { const int d = dh * 32 + q32, x = (d >> 1) & 15, kc = 8 * JT + 4 * s + hi; \
                        const u32x2 v0 = *(const LAS u32x2*)(myv + d * 128 + 8 * (kc ^ x)), v1 = *(const LAS u32x2*)(myv + d * 128 + 8 * ((kc + 2) ^ x)); \
                        o[IT][dh] = __builtin_amdgcn_mfma_f32_32x32x16_bf16(__builtin_bit_cast(bf16x8, pk), __builtin_bit_cast(bf16x8, (u32x4){v0.x, v0.y, v1.x, v1.y}), o[IT][dh], 0, 0, 0); } } } while (0)
#define SCN_INTER(IT) do { const LAS unsigned char* area = lds + wid * 8192; \
                _Pragma("unroll") for (int dh = 0; dh < 2; ++dh) _Pragma("unroll") for (int ks = 0; ks < NKS; ++ks) { \
                    const int d = dh * 32 + q32, sw = DK == 64 ? ((d >> 1) & 7) : ((d >> 2) & 3); \
                    const bf16x8 sf = *(const LAS bf16x8*)(area + d * (DK * 2) + 16 * ((2 * ks + hi) ^ sw)); \
                    o[IT][dh] = __builtin_amdgcn_mfma_f32_32x32x16_bf16(qf[ks], sf, o[IT][dh], 0, 0, 0); } } while (0)
            { bf16x8 qf[NKS]; SCN_GEN(qf, true, 0);
              SCN_TILE(0, 0, true); if (dir == 1) SCN_TILE(1, 0, false);
              SCN_INTER(0); }
            asm volatile("" ::: "memory");
            { bf16x8 qf[NKS]; SCN_GEN(qf, true, 1);
              if (dir == 0) SCN_TILE(0, 1, false);
              SCN_TILE(1, 1, true);
              SCN_INTER(1); }
#undef SCN_GEN
#undef SCN_TILE
#undef SCN_INTER
        }
        asm volatile("s_waitcnt lgkmcnt(0)" ::: "memory");
        __syncthreads();
    }
    if (act) {
        const int gcol = (MX == 0 ? PC_RG : PC_GR) + h * 64, ccol = (MX == 0 ? 512 : 768) + h * 64;
        const float g0 = MX == 0 ? p.ret_norm_g[l * 256 + h * 64 + q32] : p.gla_norm_g[l * 64 + q32], g1 = MX == 0 ? p.ret_norm_g[l * 256 + h * 64 + 32 + q32] : p.gla_norm_g[l * 64 + 32 + q32];
#pragma unroll
        for (int it = 0; it < 2; ++it)
#pragma unroll
            for (int r = 0; r < 16; ++r) {
                const int row = row0 + 32 * it + crow(r, hi);
                const float a0 = o[it][0][r], a1 = o[it][1][r];
                float ss = a0 * a0 + a1 * a1;
#pragma unroll
                for (int x = 1; x < 32; x <<= 1) ss += __shfl_xor(ss, x);
                const float rstd = rsqrtf(ss * (1.f / 64.f) + EPS);
                const float gt0 = bf2f(PB[(size_t)row * PW + gcol + q32]), gt1 = bf2f(PB[(size_t)row * PW + gcol + 32 + q32]);
                bf16_t* op = WSP(bf16_t, WS_CONCAT) + (size_t)row * D + ccol + q32;
                op[0] = f2bf(a0 * rstd * g0 * (gt0 / (1.f + SCN_EXP(-gt0)))); op[32] = f2bf(a1 * rstd * g1 * (gt1 / (1.f + SCN_EXP(-gt1))));
                if ((r & 3) == 3) asm volatile("" ::: "memory");
            }
    }
}
__device__ __forceinline__ bool scan_unit(int slot, bool with_ctx, int& mx, int& bh, int& g) {
    if (slot < 256) { mx = slot >> 7; const int r = slot & 127; bh = r >> 3; g = r & 7; return true; }
    if (!with_ctx) return false;
    const int j = slot - 256 - 128;
    if (j < 0 || j >= 32) return false;
    mx = j >> 4; bh = j & 15; g = 8; return true;
}
__device__ __forceinline__ void d_scan_stage1(KP kp, int l) {
    PH_IDS;
    for (int slot = bid; slot < 512; slot += gridDim.x) {
        int mx, bh, g; if (!scan_unit(slot, true, mx, bh, g)) continue;
        if (mx == 0) scan_stage1_unit<0>(kp, l, bh >> 2, bh & 3, g, tid); else scan_stage1_unit<1>(kp, l, bh >> 2, bh & 3, g, tid);
    }
}
__device__ __forceinline__ void d_scan_stage2(KP kp, int l, LAS unsigned char* lds) {
    PH_IDS;
    for (int slot = bid; slot < 512; slot += gridDim.x) {
        int mx, bh, g; if (!scan_unit(slot, l == 0, mx, bh, g)) continue;
        if (mx == 0) scan_stage2_unit<0>(kp, l, bh >> 2, bh & 3, g, lds, tid); else scan_stage2_unit<1>(kp, l, bh >> 2, bh & 3, g, lds, tid);
    }
}
namespace hfft {
typedef float f2 __attribute__((ext_vector_type(2)));
typedef float f4 __attribute__((ext_vector_type(4)));
constexpr int N = 8192;
__device__ __forceinline__ f2 cmul(f2 a, f2 b) { return (f2){a.x * b.x - a.y * b.y, a.x * b.y + a.y * b.x}; }
__device__ __forceinline__ f2 cmulc(f2 a, f2 b) { return (f2){a.x * b.x + a.y * b.y, a.y * b.x - a.x * b.y}; }
__device__ __forceinline__ f2 tw(float frac) { float sn, cs; sincosf(6.283185307179586f * frac, &sn, &cs); return (f2){cs, -sn}; }
constexpr int TWOFF = 131072 + 64;
__device__ __forceinline__ void tw_build(LAS unsigned char* lds, int tid) { LAS f2* T = (LAS f2*)(lds + TWOFF); for (int k = tid; k < 1024; k += NT) T[k] = tw((float)k * (1.f / 8192.f)); }
__device__ __forceinline__ f2 twk(const LAS f2* T, int k) {
    const f2 a = T[k & 1023]; const float r = 0.70710678118654752f;
    return (k & 1024) ? (f2){(a.x + a.y) * r, (a.y - a.x) * r} : a;
}
__device__ __forceinline__ f2 mul_mi(f2 a) { return (f2){a.y, -a.x}; }
__device__ __forceinline__ f2 mul_pi(f2 a) { return (f2){-a.y, a.x}; }
template <int LOGD> __device__ __forceinline__ void fwd_pass(LAS f2* buf, int tid) {
    constexpr int Dd = 1 << LOGD;
#pragma unroll
    for (int g = 0; g < 4; ++g) {
        const int u = tid + NT * g, pos = u & (Dd - 1), base = ((u - pos) << 2) + pos;
        const f2 wA = twk((const LAS f2*)((LAS unsigned char*)buf + TWOFF), pos << (11 - LOGD)), wB = cmul(wA, wA);
#pragma unroll
        for (int arr = 0; arr < 2; ++arr) {
            LAS f2* x = buf + arr * N + base;
            const f2 a0 = x[0], a1 = x[Dd], a2 = x[2 * Dd], a3 = x[3 * Dd];
            const f2 b0 = a0 + a2, b2 = cmul(a0 - a2, wA), b1 = a1 + a3, b3 = mul_mi(cmul(a1 - a3, wA));
            x[0] = b0 + b1; x[Dd] = cmul(b0 - b1, wB); x[2 * Dd] = b2 + b3; x[3 * Dd] = cmul(b2 - b3, wB);
        }
    }
    __syncthreads();
}
template <int LOGD> __device__ __forceinline__ void inv_pass(LAS f2* buf, int tid) {
    constexpr int Dd = 1 << LOGD;
#pragma unroll
    for (int g = 0; g < 4; ++g) {
        const int u = tid + NT * g, pos = u & (Dd - 1), base = ((u - pos) << 2) + pos;
        const f2 wA = twk((const LAS f2*)((LAS unsigned char*)buf + TWOFF), pos << (11 - LOGD)), wB = cmul(wA, wA);
#pragma unroll
        for (int arr = 0; arr < 2; ++arr) {
            LAS f2* x = buf + arr * N + base;
            const f2 c0 = x[0], c1 = cmulc(x[Dd], wB), c2 = x[2 * Dd], c3 = cmulc(x[3 * Dd], wB);
            const f2 b0 = c0 + c1, b1 = c0 - c1, b2 = cmulc(c2 + c3, wA), b3 = mul_pi(cmulc(c2 - c3, wA));
            x[0] = b0 + b2; x[2 * Dd] = b0 - b2; x[Dd] = b1 + b3; x[3 * Dd] = b1 - b3;
        }
    }
    __syncthreads();
}
__device__ __forceinline__ void fwd_all(LAS f2* buf, int tid) { fwd_pass<11>(buf, tid); fwd_pass<9>(buf, tid); fwd_pass<7>(buf, tid); fwd_pass<5>(buf, tid); fwd_pass<3>(buf, tid); fwd_pass<1>(buf, tid); }
__device__ __forceinline__ void inv_all(LAS f2* buf, int tid) { inv_pass<1>(buf, tid); inv_pass<3>(buf, tid); inv_pass<5>(buf, tid); inv_pass<7>(buf, tid); inv_pass<9>(buf, tid); inv_pass<11>(buf, tid); }
}
__device__ __forceinline__ void d_fspec(KP kp, LAS unsigned char* lds) {
    PH_IDS;
    using namespace hfft;
    LAS f2* buf = (LAS f2*)lds; LAS float* nrm = (LAS float*)(lds + 131072);
    tw_build(lds, tid);
    for (int u = bid; u < 256; u += gridDim.x) {
        const int l = u >> 7, c0 = (u & 127) * 2;
        const float* filt = WSP(float, WS_FILT) + (size_t)l * 8192 * 256;
        if (tid < 128) {
            const int arr = tid >> 6, ln = tid & 63; float a = 0.f;
#pragma unroll
            for (int q = 0; q < 4; ++q) a += WSP(float, WS_PS)[(size_t)(l * 256 + ln * 4 + q) * 256 + c0 + arr];
            a = wave_sum(a); if (ln == 0) nrm[arr] = a;
        }
        for (int i = tid; i < 2 * N; i += NT) { const int arr = i >> 13, tau = i & (N - 1); buf[i] = (f2){filt[(size_t)tau * 256 + c0 + arr], 0.f}; }
        __syncthreads();
        fwd_all(buf, tid);
        f4* fs = (f4*)(WSP(float, WS_FSPEC) + ((size_t)l * 256 + c0) * 2 * N);
        for (int i = tid; i < N; i += NT) {
            const int arr = i >> 12, j = i & 4095;
            const f4 v = *(const LAS f4*)(buf + arr * N + 2 * j);
            const float sc = 1.f / (8192.f * nrm[arr]), bs = p.hy_bias[l * 256 + c0 + arr] * (1.f / 8192.f);
            fs[(size_t)arr * (N / 2) + j] = (f4){(v.x + v.z) * sc + bs, (v.y + v.w) * sc, (v.x - v.z) * sc + bs, (v.y - v.w) * sc};
        }
        __syncthreads();
    }
}
__device__ __forceinline__ void d_hy_pre_fast(KP kp, int l, LAS unsigned char* lds) {
    PH_IDS;
    LAS float* zt = (LAS float*)lds;
    const bf16_t* PB = WSP(bf16_t, WS_PBUF);
    const int c = tid & 255, half = tid >> 8;
    const float* sw = p.hy_short_w + l * 3 * 768; const float* sb = p.hy_short_b + l * 768;
    float w0[3], w1[3], w2[3], bb[3];
#pragma unroll
    for (int g = 0; g < 3; ++g) { w0[g] = sw[g * 256 + c]; w1[g] = sw[768 + g * 256 + c]; w2[g] = sw[1536 + g * 256 + c]; bb[g] = sb[g * 256 + c]; }
    for (int u = bid; u < NLAT / 64; u += gridDim.x) {
        const int row0 = u * 64 + half * 32, t0 = (u * 64) & (SEQ - 1);
        const int tfirst = t0 + half * 32;
        float xin[3][34];
#pragma unroll
        for (int g = 0; g < 3; ++g) {
            const bf16_t* pp = PB + (size_t)row0 * PW + PC_HY + g * 256 + c;
#pragma unroll
            for (int i = 0; i < 34; ++i) { const int t = tfirst + i - 1, tc = t < 0 ? 0 : (t > SEQ - 1 ? SEQ - 1 : t); const float v = bf2f(pp[(ptrdiff_t)(tc - tfirst) * PW]); xin[g][i] = (t == tc) ? v : 0.f; }
        }
#pragma unroll
        for (int i = 0; i < 32; ++i) {
            float uu[3];
#pragma unroll
            for (int g = 0; g < 3; ++g) uu[g] = bb[g] + w0[g] * xin[g][i] + w1[g] * xin[g][i + 1] + w2[g] * xin[g][i + 2];
            WSP(bf16_t, WS_X0B)[(size_t)(row0 + i) * 256 + c] = f2bf(uu[0]);
            zt[c * 65 + half * 32 + i] = uu[1] * uu[2];
        }
        __syncthreads();
        const int b = (u * 64) >> 12;
        for (int i = tid; i < 256 * 64; i += NT) { const int cc = i >> 6, tl = i & 63; WSP(float, WS_ZT)[((size_t)cc * 4 + b) * SEQ + t0 + tl] = zt[cc * 65 + tl]; }
        __syncthreads();
    }
    if (l == 0) {
        GT_LOOP(idx, NCTX * 256) {
            const int r = idx >> 8, cc = idx & 255, t = r & (CTXL - 1);
            const bf16_t* pp = PB + (size_t)(NLAT + r) * PW + PC_HY + cc;
            float uu[3];
#pragma unroll
            for (int g = 0; g < 3; ++g) { float a = sb[g * 256 + cc] + sw[768 + g * 256 + cc] * bf2f(pp[g * 256]);
                const float pv = bf2f(pp[g * 256 - (t > 0 ? PW : 0)]), nv = bf2f(pp[g * 256 + (t < CTXL - 1 ? PW : 0)]);
                a += sw[g * 256 + cc] * (t > 0 ? pv : 0.f) + sw[1536 + g * 256 + cc] * (t < CTXL - 1 ? nv : 0.f); uu[g] = a; }
            WSP(float, WS_X0C)[idx] = uu[0]; WSP(float, WS_ZC)[idx] = uu[1] * uu[2];
        }
    }
}
__device__ __forceinline__ void d_hy_fft(KP kp, int l, LAS unsigned char* lds) {
    PH_IDS;
    using namespace hfft;
    LAS f2* buf = (LAS f2*)lds;
    tw_build(lds, tid);
    for (int c = bid; c < 256; c += gridDim.x) {
        const float* zt = WSP(float, WS_ZT) + (size_t)c * 4 * SEQ;
#pragma unroll
        for (int arr = 0; arr < 2; ++arr) {
            float re[8], im[8];
#pragma unroll
            for (int i = 0; i < 8; ++i) { re[i] = zt[(size_t)(2 * arr) * SEQ + tid + i * NT]; im[i] = zt[(size_t)(2 * arr + 1) * SEQ + tid + i * NT]; }
#pragma unroll
            for (int i = 0; i < 8; ++i) { buf[arr * N + tid + i * NT] = (f2){re[i], im[i]}; buf[arr * N + SEQ + tid + i * NT] = (f2){0.f, 0.f}; }
        }
        __syncthreads();
        fwd_all(buf, tid);
        const f4* fs = (const f4*)(WSP(float, WS_FSPEC) + ((size_t)l * 256 + c) * 2 * N);
        for (int i = tid; i < N; i += NT) {
            const int arr = i >> 12, j = i & 4095;
            LAS f4* xp = (LAS f4*)(buf + arr * N + 2 * j);
            const f4 v = *xp; const f4 f = fs[j];
            const f2 s = cmul((f2){v.x + v.z, v.y + v.w}, (f2){f.x, f.y}), d = cmul((f2){v.x - v.z, v.y - v.w}, (f2){f.z, f.w});
            *xp = (f4){s.x + d.x, s.y + d.y, s.x - d.x, s.y - d.y};
        }
        __syncthreads();
        inv_all(buf, tid);
        float* yt = WSP(float, WS_YT) + (size_t)c * 4 * SEQ;
        for (int i = tid; i < 2 * SEQ; i += NT) { const int arr = i >> 12, t = i & (SEQ - 1); const f2 v = buf[arr * N + t];
            yt[(size_t)(2 * arr) * SEQ + t] = v.x; yt[(size_t)(2 * arr + 1) * SEQ + t] = v.y; }
        __syncthreads();
    }
}
__device__ __forceinline__ void d_hy_post(KP kp, int l, LAS unsigned char* lds) {
    PH_IDS;
    LAS float* yt = (LAS float*)lds;
    for (int u = bid; u < NLAT / 64; u += gridDim.x) {
        const int b = (u * 64) >> 12, t0 = (u * 64) & (SEQ - 1);
#pragma unroll 1
        for (int hb2 = 0; hb2 < 4; ++hb2) {
            float yv[8];
#pragma unroll
            for (int i = 0; i < 8; ++i) { const int idx = tid + (hb2 * 8 + i) * NT; yv[i] = WSP(float, WS_YT)[((size_t)(idx >> 6) * 4 + b) * SEQ + t0 + (idx & 63)]; }
#pragma unroll
            for (int i = 0; i < 8; ++i) { const int idx = tid + (hb2 * 8 + i) * NT; yt[(idx >> 6) * 65 + (idx & 63)] = yv[i]; }
            asm volatile("" ::: "memory");
        }
        __syncthreads();
        {
            const int c = tid & 255, th = tid >> 8;
#pragma unroll 1
            for (int hb2 = 0; hb2 < 4; ++hb2) {
                float x0v[8];
#pragma unroll
                for (int i = 0; i < 8; ++i) x0v[i] = bf2f(WSP(bf16_t, WS_X0B)[((size_t)u * 64 + 2 * (hb2 * 8 + i) + th) * 256 + c]);
#pragma unroll
                for (int i = 0; i < 8; ++i) { const int tl = 2 * (hb2 * 8 + i) + th; WSP(bf16_t, WS_CONCAT)[((size_t)u * 64 + tl) * D + 256 + c] = f2bf(x0v[i] * yt[c * 65 + tl]); }
                asm volatile("" ::: "memory");
            }
        }
        __syncthreads();
    }
    if (l == 0) {
        GT_LOOP(idx, NCTX * 256) {
            const int c = idx & 255, r = idx >> 8, t = r & (CTXL - 1), rb = r - t;
            const float* filt = WSP(float, WS_FILTC); const float* zc = WSP(float, WS_ZC);
            float nrm = 0.f;
#pragma unroll
            for (int q = 0; q < 16; ++q) nrm += WSP(float, WS_PS)[(size_t)(512 + q) * 256 + c];
            float y = 0.f;
#pragma unroll 32
            for (int s2 = 0; s2 < CTXL; ++s2) y += filt[(size_t)((t - s2) & (2 * CTXL - 1)) * 256 + c] * zc[(size_t)(rb + s2) * 256 + c];
            y = y / nrm + p.hy_bias[c] * zc[idx];
            WSP(bf16_t, WS_CONCAT)[(size_t)(NLAT + r) * D + 256 + c] = f2bf(WSP(float, WS_X0C)[idx] * y);
        }
    }
}
constexpr int CW_BAR = 32768;
__global__ void __launch_bounds__(NT, 2) mk_fwd(P kargs) {
    const KP kp0 = (KP)__builtin_amdgcn_kernarg_segment_ptr();
    KP kp = kp0;
#define LP ({ KP k_ = kp0; asm volatile("" : "+s"(k_)); k_; })
    unsigned char* const lds = g_lds;
    volatile LAS unsigned* misc = (volatile LAS unsigned*)((LAS unsigned char*)lds + LDS_MISC);
    if (threadIdx.x < 16) misc[threadIdx.x] = 0u;
    if ((threadIdx.x & 63) == 0) ((LAS int*)((LAS unsigned char*)lds + LDS_WTAB))[hw_wave_slot()] = threadIdx.x >> 6;
    __syncthreads();
    (void)xcd_barrier_post(WSP(unsigned, WS_CTL) + CW_BAR, misc);
#define GRID_BAR() do { XcdBarrier b_; { KP kp = LP; b_.bar = WSP(unsigned, WS_CTL) + CW_BAR; } b_.x = xb_xcc_id(); b_.st = (volatile LAS unsigned*)((LAS unsigned char*)lds + LDS_MISC); xcd_barrier(b_); } while (0)
    d_pro0(LP, (LAS float*)((LAS unsigned char*)lds + 98304)); d_filter(LP, (LAS float*)((LAS unsigned char*)lds + 73728)); d_convert_a(LP, (LAS float*)lds);
    GRID_BAR();
    d_pro1(LP); d_convert_b(LP, (LAS float*)lds);
    GRID_BAR();
    d_fspec(LP, (LAS unsigned char*)lds); d_norm1(LP, 0);
    GRID_BAR();
#pragma unroll 1
    for (int l = 0; l < DEPTH; ++l) {
        d_gemm_in(LP, l, (LAS unsigned char*)lds);
        GRID_BAR();
        d_prep_scan(LP); d_prep_attn(LP); d_hy_pre_fast(LP, l, (LAS unsigned char*)lds);
        GRID_BAR();
        d_scan_stage1(LP, l);
        d_hy_fft(LP, l, (LAS unsigned char*)lds);
        d_attn_fast(LP, l, (LAS unsigned char*)lds);
        GRID_BAR();
        d_scan_stage2(LP, l, (LAS unsigned char*)lds);
        d_hy_post(LP, l, (LAS unsigned char*)lds);
        GRID_BAR();
        d_gemm_out(LP, l, (LAS unsigned char*)lds);
        GRID_BAR();
        d_router(LP, l, (LAS float*)lds);
        GRID_BAR();
        d_moe_up(LP, l, (LAS unsigned char*)lds);
        GRID_BAR();
        d_moe_down(LP, l, (LAS unsigned char*)lds);
        GRID_BAR();
        d_combine(LP, l, (LAS int*)lds);
        GRID_BAR();
    }
}

#undef p
extern "C" void kernel_launch(void* const* d_in, const int* in_sizes, int n_in, void* d_out, int out_size, void* d_ws, size_t ws_size, hipStream_t stream) {
    if (n_in != 31 || ws_size < WS_END || out_size != NLAT * D) { fprintf(stderr, "kernel_launch: unexpected shapes (n_in %d ws %zu out %d)\n", n_in, ws_size, out_size); return; }
    static int grid = 0;
    if (grid == 0) {
        int dev = 0, cus = 0, per_cu = 0;
        if (hipGetDevice(&dev) != hipSuccess || hipDeviceGetAttribute(&cus, hipDeviceAttributeMultiprocessorCount, dev) != hipSuccess) { grid = -1; return; }
        if (hipFuncSetAttribute((const void*)mk_fwd, hipFuncAttributeMaxDynamicSharedMemorySize, LDS_BYTES) != hipSuccess) { fprintf(stderr, "hipFuncSetAttribute failed\n"); grid = -1; return; }
        if (hipOccupancyMaxActiveBlocksPerMultiprocessor(&per_cu, (const void*)mk_fwd, NT, LDS_BYTES) != hipSuccess || per_cu < 1) { fprintf(stderr, "occupancy query says %d\n", per_cu); }
        (void)hipGetLastError();
        grid = cus;
    }
    if (grid < 0) return;
    P hp{};
    const float** pp = (const float**)&hp;
    for (int i = 0; i < 31; ++i) pp[i] = (const float*)d_in[i];
    hp.out = (float*)d_out; hp.ws = (unsigned char*)d_ws;
    (void)hipMemsetAsync((char*)d_ws + WS_CTL, 0, 1 * MiB, stream);
    hipLaunchKernelGGL(mk_fwd, dim3(grid), dim3(NT), LDS_BYTES, stream, hp);
}
```

```cpp
#include <hip/hip_runtime.h>
#include <stdint.h>
#include <stdio.h>
#include <math.h>

constexpr int D = 1024, BATCH = 4, SEQ = 4096, CTXL = 256, DEPTH = 2;
constexpr int NLAT = BATCH * SEQ, NCTX = BATCH * CTXL, MALL = NLAT + NCTX;
constexpr int INW = 3360, PW = 3584;
constexpr int NEXP = 32, TOPK = 4;
constexpr float EPS = 1e-6f;
constexpr int PC_AQ = 0, PC_AK = 256, PC_AV = 512, PC_HY = 768, PC_RQ = 1536, PC_RK = 1792, PC_RV = 2048, PC_RG = 2304,
              PC_GQ = 2560, PC_GK = 2688, PC_GV = 2816, PC_GR = 3072, PC_GD = 3328;
constexpr int ACT_ROWS = MALL * TOPK + NEXP * 256;

typedef unsigned short bf16_t;
typedef float cvt_f32x2_t __attribute__((ext_vector_type(2))); typedef __bf16 cvt_bf16x2_t __attribute__((ext_vector_type(2)));
__device__ __forceinline__ unsigned cvtpk_rne(float lo, float hi) { cvt_f32x2_t v = {lo, hi}; cvt_bf16x2_t b = __builtin_convertvector(v, cvt_bf16x2_t); return __builtin_bit_cast(unsigned, b); }
__device__ __forceinline__ bf16_t f2bf(float f) { unsigned u = __float_as_uint(f); return (bf16_t)((u + 0x7fffu + ((u >> 16) & 1u)) >> 16); }
__device__ __forceinline__ float bf2f(bf16_t b) { return __uint_as_float(((unsigned)b) << 16); }

typedef unsigned gv4u __attribute__((ext_vector_type(4))); typedef float gv4f __attribute__((ext_vector_type(4)));
__device__ __forceinline__ float gblo(unsigned w) { return __uint_as_float(w << 16); }
__device__ __forceinline__ float gbhi(unsigned w) { return __uint_as_float(w & 0xffff0000u); }
__device__ __forceinline__ unsigned pk4_fp8(float a, float b, float c, float d) { int r = __builtin_amdgcn_cvt_pk_fp8_f32(a, b, 0, false); r = __builtin_amdgcn_cvt_pk_fp8_f32(c, d, r, true); return (unsigned)r; }
constexpr float W8_SCALE = 64.f;
constexpr size_t MiB = 1u << 20;
constexpr size_t WS_CTL = 0;
constexpr size_t WS_MOD = 1 * MiB;
constexpr size_t WS_WEFF = 3 * MiB;
constexpr size_t WS_FILT = 6 * MiB;
constexpr size_t WS_FILTC = WS_FILT + 16 * MiB;
constexpr size_t WS_XRES = 24 * MiB;
constexpr size_t WS_HB = WS_XRES + 68 * MiB;
constexpr size_t WS_PBUF = WS_HB + 34 * MiB;
constexpr size_t WS_CONCAT = WS_PBUF + 120 * MiB;
constexpr size_t WS_YBUF = WS_CONCAT + 34 * MiB;
constexpr size_t WS_QA = WS_YBUF + 68 * MiB;
constexpr size_t WS_KA = WS_QA + 17 * MiB;
constexpr size_t WS_QR = WS_KA + 17 * MiB;
constexpr size_t WS_KR = WS_QR + 17 * MiB;
constexpr size_t WS_OA = WS_KR + 17 * MiB;
constexpr size_t WS_Z = WS_OA + 34 * MiB;
constexpr size_t WS_X0 = WS_Z + 17 * MiB;
constexpr size_t WS_LA = WS_X0 + 17 * MiB;
constexpr size_t WS_OD = WS_LA + 17 * MiB;
constexpr size_t WS_TOPI = WS_OD + 68 * MiB;
constexpr size_t WS_TOPW = WS_TOPI + 1 * MiB;
constexpr size_t WS_LIST = WS_TOPW + 1 * MiB;
constexpr size_t WS_ACT = WS_LIST + 3 * MiB;
constexpr size_t WS_YSLOT = WS_ACT + 160 * MiB;
constexpr size_t WS_WIN_T = WS_YSLOT + 160 * MiB;
constexpr size_t WS_WOUT_T = WS_WIN_T + 14 * MiB;
constexpr size_t WS_W1_T = WS_WOUT_T + 4 * MiB;
constexpr size_t WS_W2_T = WS_W1_T + 256 * MiB;
constexpr size_t WS_BIAS_IN = WS_W2_T + 128 * MiB;
constexpr size_t WS_QRP = WS_BIAS_IN + 1 * MiB;
constexpr size_t WS_KIMG = WS_QRP + 9 * MiB;
constexpr size_t WS_VIMG = WS_KIMG + 9 * MiB;
constexpr size_t WS_QF_R = WS_VIMG + 9 * MiB;
constexpr size_t WS_KF_R = WS_QF_R + 9 * MiB;
constexpr size_t WS_KT_R = WS_KF_R + 9 * MiB;
constexpr size_t WS_KT_G = WS_KT_R + 9 * MiB;
constexpr size_t WS_VT_R = WS_KT_G + 5 * MiB;
constexpr size_t WS_VT_G = WS_VT_R + 9 * MiB;
constexpr size_t WS_CUM_G = WS_VT_G + 9 * MiB;
constexpr size_t WS_CUMT_G = WS_CUM_G + 17 * MiB;
constexpr size_t WS_US_R = WS_CUMT_G + 17 * MiB;
constexpr size_t WS_US_G = WS_US_R + 34 * MiB;
constexpr size_t WS_UG_R = WS_US_G + 17 * MiB;
constexpr size_t WS_UG_G = WS_UG_R + 5 * MiB;
constexpr size_t WS_AG = WS_UG_G + 3 * MiB;
constexpr size_t WS_ROPE = WS_AG + 1 * MiB;
constexpr size_t WS_FSPEC = WS_ROPE + 1 * MiB;
constexpr size_t WS_ZT = WS_FSPEC + 32 * MiB;
constexpr size_t WS_YT = WS_ZT + 16 * MiB;
constexpr size_t WS_X0B = WS_YT + 16 * MiB;
constexpr size_t WS_MODP = WS_X0B + 8 * MiB;
constexpr size_t WS_PS = WS_MODP + 4 * MiB;
constexpr size_t WS_ZC = WS_PS + 1 * MiB;
constexpr size_t WS_X0C = WS_ZC + 1 * MiB;
constexpr size_t WS_HB8 = WS_X0C + 1 * MiB;
constexpr size_t WS_END = WS_HB8 + 17 * MiB;
constexpr int CW_CNT = 1024;
constexpr int CW_NORM = 2048;

struct P {
    const float *x, *c, *ctx, *c_ctx, *w_mod, *b_mod, *norm_g, *w_in, *w_out, *diff_lambda, *diff_subln_g, *hy_short_w, *hy_short_b,
        *hy_w1, *hy_b1, *hy_w2, *hy_b2, *hy_w3, *hy_freq, *hy_bias, *ret_decay, *ret_norm_g, *gla_gate_w, *gla_gate_b, *gla_norm_g,
        *router_w, *router_b, *exp_w1, *exp_b1, *exp_w2, *exp_b2;
    float* out; unsigned char* ws;
};
typedef const __attribute__((address_space(4))) P* KP;
#define p (*kp)
#define WSP(T, off) ((T*)(p.ws + (off)))

__device__ __forceinline__ float wave_sum(float v) {
#pragma unroll
    for (int o = 1; o < 64; o <<= 1) v += __shfl_xor(v, o);
    return v;
}
__device__ __forceinline__ float silu_f(float x) { return x / (1.f + expf(-x)); }
__host__ __device__ __forceinline__ int nrows_l(int l) { return l == 0 ? MALL : NLAT; }
__device__ __forceinline__ int mod_r(int row) { return row < NLAT ? row / SEQ : 4; }
__device__ __forceinline__ void seq_info(int row, int& base, int& n, int& t) {
    if (row < NLAT) { base = row & ~(SEQ - 1); n = SEQ; t = row - base; }
    else { int r = row - NLAT; base = NLAT + (r & ~(CTXL - 1)); n = CTXL; t = row - base; }
}

__device__ __forceinline__ int ltid();
#define XB_TMO      128
#define XB_XCNT(j)  (256  + 64 * (j))
#define XB_XSUB(j)  (1280 + 64 * (j))
#define XB_XGEN(j)  (2304 + 64 * (j))
#define XB_TOP      3328
#define XB_TOPGEN   3392
#define XCD_BAR_WORDS 3456
#define XB_SPIN_CAP (1u << 22)
#define LAS __attribute__((address_space(3)))
__device__ __forceinline__ unsigned xb_ld(unsigned* ptr)            { return __hip_atomic_load(ptr, __ATOMIC_RELAXED, __HIP_MEMORY_SCOPE_AGENT); }
__device__ __forceinline__ unsigned xb_add(unsigned* ptr, unsigned v) { return __hip_atomic_fetch_add(ptr, v, __ATOMIC_RELAXED, __HIP_MEMORY_SCOPE_AGENT); }
__device__ __forceinline__ unsigned xb_xcc_id() { return (unsigned)__builtin_amdgcn_s_getreg((3 << 11) | 20) & 0xFu; }
#define XB_SPIN(cond, bar) do { unsigned _sp = 0; while (cond) { __builtin_amdgcn_s_sleep(1); \
    if ((++_sp & 255u) == 0u) { if (xb_ld(&(bar)[XB_TMO])) break; if (_sp > XB_SPIN_CAP) { atomicAdd(&(bar)[XB_TMO], 1u); break; } } } } while (0)
struct XcdBarrier { unsigned* bar; unsigned x; volatile LAS unsigned* st; };
__device__ __forceinline__ XcdBarrier xcd_barrier_post(unsigned* bar, volatile LAS unsigned* st) {
    XcdBarrier b; b.bar = bar; b.x = xb_xcc_id(); b.st = st;
    if (threadIdx.x == 0) (void)xb_add(&bar[XB_XCNT(b.x)], 1u);
    return b;
}
__device__ __forceinline__ void xcd_barrier_complete(unsigned* bar, unsigned x, unsigned& nloc, unsigned& nx) {
    const unsigned G = gridDim.x * gridDim.y * gridDim.z;
    unsigned sum, cnt, mine, sp = 0u;
    for (;;) {
        sum = 0u; cnt = 0u; mine = 0u;
#pragma unroll
        for (unsigned j = 0; j < 16; ++j) { const unsigned c = xb_ld(&bar[XB_XCNT(j)]); sum += c; cnt += (c > 0u) ? 1u : 0u; mine = (j == x) ? c : mine; }
        if (sum == G) break;
        __builtin_amdgcn_s_sleep(1);
        if ((++sp & 255u) == 0u) { if (xb_ld(&bar[XB_TMO])) break; if (sp > XB_SPIN_CAP) { atomicAdd(&bar[XB_TMO], 1u); break; } }
    }
    nloc = mine > 0u ? mine : 1u; nx = cnt > 0u ? cnt : 1u;
}
__device__ __forceinline__ void xcd_barrier(const XcdBarrier& b) {
    asm volatile("s_waitcnt vmcnt(0)" ::: "memory");
    __syncthreads();
    if (ltid() == 0) {
        unsigned* bar = b.bar;
        __builtin_amdgcn_s_waitcnt(0);
        unsigned nloc = b.st[0], nx = b.st[1];
        if (nloc == 0u) { xcd_barrier_complete(bar, b.x, nloc, nx); b.st[0] = nloc; b.st[1] = nx; }
        const unsigned old = xb_add(&bar[XB_XSUB(b.x)], 1u);
        const unsigned gen = old / nloc;
        if (old + 1u == (gen + 1u) * nloc) {
            __builtin_amdgcn_fence(__ATOMIC_RELEASE, "agent");
            asm volatile("s_waitcnt vmcnt(0)" ::: "memory");
            const unsigned og = xb_add(&bar[XB_TOP], 1u);
            const unsigned tg = og / nx;
            if (og + 1u == (tg + 1u) * nx) xb_add(&bar[XB_TOPGEN], 1u);
            else XB_SPIN(xb_ld(&bar[XB_TOPGEN]) == tg, bar);
            __builtin_amdgcn_fence(__ATOMIC_ACQUIRE, "agent");
            xb_add(&bar[XB_XGEN(b.x)], 1u);
            asm volatile("s_waitcnt vmcnt(0)" ::: "memory");
        } else {
            XB_SPIN(xb_ld(&bar[XB_XGEN(b.x)]) == gen, bar);
            __builtin_amdgcn_fence(__ATOMIC_ACQUIRE, "agent");
            asm volatile("s_waitcnt vmcnt(0)" ::: "memory");
        }
    }
    __syncthreads();
}

constexpr int NT = 512;
extern __shared__ __attribute__((aligned(16))) unsigned char g_lds[];
constexpr int LDS_BYTES = 147456;
constexpr int LDS_WTAB = LDS_BYTES - 512;
constexpr int LDS_MISC = LDS_BYTES - 64;
__device__ __forceinline__ int hw_wave_slot() { return (int)(__builtin_amdgcn_s_getreg((5 << 11) | 4) & 63u); }
__device__ __forceinline__ int ltid() {
    const int w = __builtin_amdgcn_readfirstlane(((const LAS int*)((LAS unsigned char*)g_lds + LDS_WTAB))[hw_wave_slot()]);
    unsigned ones = ~0u; asm volatile("" : "+s"(ones));
    int t = (w << 6) | (int)__builtin_amdgcn_mbcnt_hi(ones, __builtin_amdgcn_mbcnt_lo(ones, 0u));
    asm volatile("" : "+v"(t)); return t;
}
__device__ __forceinline__ int lbid() { int b = blockIdx.x; asm volatile("" : "+s"(b)); return b; }
#define PH_IDS const int tid = ltid(), bid = lbid(); (void)tid; (void)bid
#define GT_LOOP(idx, total) for (int idx = bid * NT + tid; idx < (total); idx += gridDim.x * NT)
#define GW_LOOP(w, total) for (int w = bid * (NT / 64) + (tid >> 6); w < (total); w += gridDim.x * (NT / 64))

__device__ __forceinline__ const float* xin_row(KP kp, int l, int row) {
    return l == 0 ? (row < NLAT ? p.x + (size_t)row * D : p.ctx + (size_t)(row - NLAT) * D) : WSP(float, WS_XRES) + (size_t)row * D;
}
__device__ __forceinline__ void d_pro0(KP kp, LAS float* sc) {
    PH_IDS;
    GT_LOOP(idx, 64 * 24) {
        const int pos = idx / 24, j = idx % 24; float ang; float* dst;
        if (j < 8) { ang = (float)pos * powf(10000.f, -(float)j / 8.f); dst = WSP(float, WS_ROPE) + (pos * 8 + j) * 2; }
        else { ang = (float)pos * powf(10000.f, -(float)(j - 8) / 16.f); dst = WSP(float, WS_ROPE) + 1024 + (pos * 16 + (j - 8)) * 2; }
        dst[0] = cosf(ang); dst[1] = sinf(ang);
    }
    GT_LOOP(idx, 2 * 1024 * 256) {
        int n = idx & 255, i = (idx >> 8) & 1023, l = idx >> 18, d = n >> 7, j = n & 127;
        float a = 0.f;
        for (int r = 0; r < 16; ++r) a += p.w_in[((size_t)l * D + i) * INW + 3328 + d * 16 + r] * p.gla_gate_w[((l * 2 + d) * 16 + r) * 128 + j];
        WSP(float, WS_WEFF)[idx] = a;
    }
    const int lane = tid & 63;
    for (int i = tid; i < 5 * D; i += NT) { const int r = i >> 10, ii = i & 1023; sc[i] = silu_f(r < 4 ? p.c[r * D + ii] : p.c_ctx[ii]); }
    __syncthreads();
    GW_LOOP(task, 2 * 96 * 16) {
        const int chunk = task & 15, jb = (task >> 4) % 96, l = task / (16 * 96), j = jb * 64 + lane;
        const float* w = p.w_mod + ((size_t)l * D + chunk * 64) * 6144 + j;
        float acc[5] = {0.f, 0.f, 0.f, 0.f, 0.f};
#pragma unroll 8
        for (int i = 0; i < 64; ++i) { const float wv = w[(size_t)i * 6144];
#pragma unroll
            for (int r = 0; r < 5; ++r) acc[r] += sc[r * D + chunk * 64 + i] * wv; }
#pragma unroll
        for (int r = 0; r < 5; ++r) WSP(float, WS_MODP)[((size_t)(chunk * 2 + l) * 5 + r) * 6144 + j] = acc[r];
    }
}
__device__ __forceinline__ void d_filter(KP kp, LAS float* sm) {
    PH_IDS;
    const int lane = tid & 63; LAS float* zf = sm + (tid >> 6) * 192; LAS float* h1 = zf + 64; LAS float* h2 = zf + 128;
    GW_LOOP(task, 2 * SEQ + CTXL) {
        const int which = task < SEQ ? 0 : task < 2 * SEQ ? 1 : 2, pos = task - (which == 2 ? 2 * SEQ : which * SEQ), l = which == 1 ? 1 : 0, n = which == 2 ? CTXL : SEQ;
        float* filt = which == 2 ? WSP(float, WS_FILTC) : WSP(float, WS_FILT) + (size_t)l * 8192 * 256;
        const float t = (float)pos / (float)(n - 1), w = (6.2831855f * (float)pos) / (float)n;
        if (lane < 33) { float v = t; if (lane >= 1) { const int q = (lane - 1) & 15; const float f = 1e-4f + (15.f - 1e-4f) * ((float)q / 15.f), a = w * f; v = lane < 17 ? cosf(a) : -sinf(a); } zf[lane] = v; }
        asm volatile("s_waitcnt lgkmcnt(0)" ::: "memory");
        float a = p.hy_b1[l * 64 + lane];
        for (int i = 0; i < 33; ++i) a += zf[i] * p.hy_w1[(l * 33 + i) * 64 + lane];
        h1[lane] = sinf(p.hy_freq[(l * 2 + 0) * 64 + lane] * a);
        asm volatile("s_waitcnt lgkmcnt(0)" ::: "memory");
        a = p.hy_b2[l * 64 + lane];
        for (int i = 0; i < 64; ++i) a += h1[i] * p.hy_w2[(l * 64 + i) * 64 + lane];
        h2[lane] = sinf(p.hy_freq[(l * 2 + 1) * 64 + lane] * a);
        asm volatile("s_waitcnt lgkmcnt(0)" ::: "memory");
        float raw[8];
#pragma unroll
        for (int q = 0; q < 8; ++q) raw[q] = 0.f;
        for (int j = 0; j < 64; ++j) { const float hj = h2[j]; const float* w3 = p.hy_w3 + (size_t)(l * 64 + j) * 512 + lane;
#pragma unroll
            for (int q = 0; q < 8; ++q) raw[q] += hj * w3[q * 64]; }
        const float mind = logf(1e-2f) / 1.5f, maxd = logf(1e-2f) / 0.3f;
#pragma unroll
        for (int q = 0; q < 8; ++q) {
            const int c = (q & 3) * 64 + lane;
            const float v = raw[q] * expf(-t * fabsf(mind + (maxd - mind) * ((float)c / 255.f)));
            if (q < 4) { filt[(size_t)pos * 256 + c] = v; if (pos == 0) filt[(size_t)n * 256 + c] = 0.f; }
            else if (pos >= 1) filt[(size_t)(2 * n - pos) * 256 + c] = v;
        }
        asm volatile("s_waitcnt lgkmcnt(0)" ::: "memory");
    }
}
__device__ __forceinline__ void d_pro1(KP kp) {
    PH_IDS;
    GT_LOOP(idx, 2 * 5 * 6144) {
        const int j = idx % 6144, r = (idx / 6144) % 5, l = idx / (6144 * 5);
        float a = p.b_mod[l * 6144 + j];
        for (int ch = 0; ch < 16; ++ch) a += WSP(float, WS_MODP)[((size_t)(ch * 2 + l) * 5 + r) * 6144 + j];
        WSP(float, WS_MOD)[idx] = a;
    }
    GT_LOOP(idx, 528 * 256) {
        const int vb = idx >> 8, c = idx & 255, which = vb < 256 ? 0 : vb < 512 ? 1 : 2, slab = vb - (which == 2 ? 512 : which * 256);
        const float* filt = which == 2 ? WSP(float, WS_FILTC) : WSP(float, WS_FILT) + (size_t)which * 8192 * 256;
        float a = 0.f;
#pragma unroll 8
        for (int i = 0; i < 32; ++i) a += fabsf(filt[(size_t)(slab * 32 + i) * 256 + c]);
        WSP(float, WS_PS)[(which * 256 + slab) * 256 + c] = a;
    }
}
__device__ __forceinline__ void d_norm1(KP kp, int l) {
    PH_IDS;
    const int lane = tid & 63;
    GW_LOOP(row, MALL) {
        const float* xr = xin_row(kp, l, row);
        const float* mod = WSP(float, WS_MOD) + (size_t)(l * 5 + mod_r(row)) * 6144;
        const float* g = p.norm_g + (l * 4 + 0) * D;
        float v[16], ss = 0.f;
#pragma unroll
        for (int j = 0; j < 16; ++j) { v[j] = xr[j * 64 + lane]; ss += v[j] * v[j]; }
        const float rstd = rsqrtf(wave_sum(ss) * (1.f / D) + EPS);
        bf16_t* hb = WSP(bf16_t, WS_HB) + (size_t)row * D;
#pragma unroll
        for (int j = 0; j < 16; ++j) { int cidx = j * 64 + lane; hb[cidx] = f2bf(v[j] * rstd * g[cidx] * (1.f + mod[1024 + cidx]) + mod[cidx]); }
    }
}
__device__ __forceinline__ void d_router(KP kp, int l, LAS float* sm) {
    PH_IDS;
    const int lane = tid & 63;
    for (int i = tid; i < D * NEXP; i += NT) sm[(i >> 5) * 33 + (i & 31)] = p.router_w[(size_t)l * D * NEXP + i];
    LAS int* lcnt = (LAS int*)(sm + 33800); LAS int* lbase = lcnt + 32; LAS int* rec = lcnt + 64;
    if (tid < 32) lcnt[tid] = 0;
    __syncthreads();
    int it = 0;
    GW_LOOP(row, nrows_l(l)) {
        const float* xs = xin_row(kp, l, row);
        float* xr = WSP(float, WS_XRES) + (size_t)row * D;
        const float* y = WSP(float, WS_YBUF) + (size_t)row * D;
        const float* mod = WSP(float, WS_MOD) + (size_t)(l * 5 + mod_r(row)) * 6144;
        const float* g1 = p.norm_g + (l * 4 + 1) * D; const float* g2 = p.norm_g + (l * 4 + 2) * D;
        float yv[16], xv[16], ss = 0.f;
#pragma unroll
        for (int j = 0; j < 16; ++j) { yv[j] = y[j * 64 + lane]; ss += yv[j] * yv[j]; }
        float rstd = rsqrtf(wave_sum(ss) * (1.f / D) + EPS);
        ss = 0.f;
#pragma unroll
        for (int j = 0; j < 16; ++j) { const int ci = j * 64 + lane; xv[j] = xs[ci] + mod[2048 + ci] * (yv[j] * rstd * g1[ci]); ss += xv[j] * xv[j]; }
        float gsc[16], gsh[16];
#pragma unroll
        for (int j = 0; j < 16; ++j) { const int ci = j * 64 + lane; gsc[j] = g2[ci] * (1.f + mod[4096 + ci]); gsh[j] = mod[3072 + ci]; }
#pragma unroll
        for (int j = 0; j < 16; ++j) xr[j * 64 + lane] = xv[j];
        rstd = rsqrtf(wave_sum(ss) * (1.f / D) + EPS);
        unsigned char* hb = WSP(unsigned char, WS_HB8) + (size_t)row * D;
        float v[32];
#pragma unroll
        for (int e = 0; e < 32; ++e) v[e] = 0.f;
#pragma unroll
        for (int j = 0; j < 16; ++j) { xv[j] = xv[j] * rstd * gsc[j] + gsh[j]; hb[j * 64 + lane] = (unsigned char)(__builtin_amdgcn_cvt_pk_fp8_f32(xv[j], xv[j], 0, false) & 0xff); }
#pragma unroll
        for (int j = 0; j < 16; ++j) { const LAS float* wr = sm + (j * 64 + lane) * 33; const float hv = xv[j];
#pragma unroll
            for (int e = 0; e < 32; ++e) v[e] += hv * wr[e];
            asm volatile("" : "+v"(v[0]), "+v"(v[8]), "+v"(v[16]), "+v"(v[24])); }
#pragma unroll
        for (int k = 0; k < 16; ++k) { const bool up = lane & 32; const float send = up ? v[k] : v[k + 16], keep = up ? v[k + 16] : v[k]; v[k] = keep + __shfl_xor(send, 32); }
#pragma unroll
        for (int k = 0; k < 8; ++k) { const bool up = lane & 16; const float send = up ? v[k] : v[k + 8], keep = up ? v[k + 8] : v[k]; v[k] = keep + __shfl_xor(send, 16); }
#pragma unroll
        for (int k = 0; k < 4; ++k) { const bool up = lane & 8; const float send = up ? v[k] : v[k + 4], keep = up ? v[k + 4] : v[k]; v[k] = keep + __shfl_xor(send, 8); }
#pragma unroll
        for (int k = 0; k < 2; ++k) { const bool up = lane & 4; const float send = up ? v[k] : v[k + 2], keep = up ? v[k + 2] : v[k]; v[k] = keep + __shfl_xor(send, 4); }
        { const bool up = lane & 2; const float send = up ? v[0] : v[1], keep = up ? v[1] : v[0]; v[0] = keep + __shfl_xor(send, 2); }
        const int myexp = lane >> 1;
        float mylogit = v[0] + __shfl_xor(v[0], 1) + p.router_b[l * NEXP + myexp];
        float tv[4]; int ti[4];
#pragma unroll
        for (int k = 0; k < 4; ++k) {
            float bv = mylogit; int bi = myexp;
#pragma unroll
            for (int o = 1; o < 64; o <<= 1) { const float ov = __shfl_xor(bv, o); const int oi = __shfl_xor(bi, o); if (ov > bv || (ov == bv && oi < bi)) { bv = ov; bi = oi; } }
            tv[k] = bv; ti[k] = bi; if (myexp == bi) mylogit = -1e30f;
        }
        float den = 0.f, w[4];
#pragma unroll
        for (int k = 0; k < 4; ++k) { w[k] = expf(tv[k] - tv[0]); den += w[k]; }
        if (lane < 4) {
            const int e = lane == 0 ? ti[0] : lane == 1 ? ti[1] : lane == 2 ? ti[2] : ti[3];
            const float ww = lane == 0 ? w[0] : lane == 1 ? w[1] : lane == 2 ? w[2] : w[3];
            const int lr = __hip_atomic_fetch_add(&lcnt[e], 1, __ATOMIC_RELAXED, __HIP_MEMORY_SCOPE_WORKGROUP);
            rec[(it * 8 + (tid >> 6)) * 4 + lane] = (e << 16) | lr;
            WSP(float, WS_TOPW)[row * 4 + lane] = ww / den;
            WSP(int, WS_TOPI)[row * 4 + lane] = e;
        }
        ++it;
    }
    asm volatile("s_waitcnt lgkmcnt(0)" ::: "memory");
    __syncthreads();
    if (tid < 32) lbase[tid] = (int)atomicAdd(WSP(unsigned, WS_CTL) + CW_CNT + (l * 32 + tid) * 64, (unsigned)lcnt[tid]);
    asm volatile("s_waitcnt vmcnt(0) lgkmcnt(0)" ::: "memory");
    __syncthreads();
    it = 0;
    GW_LOOP(row, nrows_l(l)) {
        if (lane < 4) { const int rc = rec[(it * 8 + (tid >> 6)) * 4 + lane], e = rc >> 16, pos = lbase[e] + (rc & 0xffff);
            WSP(int, WS_LIST)[(size_t)e * MALL + pos] = row * 4 + lane; WSP(int, WS_TOPI)[MALL * 4 + row * 4 + lane] = pos; }
        ++it;
    }
    __syncthreads();
}
__device__ __forceinline__ void d_combine(KP kp, int l, LAS int* aoffs) {
    PH_IDS;
    const int lane = tid & 63;
    const unsigned* cnt = WSP(unsigned, WS_CTL) + CW_CNT + l * 32 * 64;
    if (tid == 0) { int a = 0; for (int e = 0; e < 32; ++e) { aoffs[e] = a; a += ((int)cnt[e * 64] + 255) & ~255; } }
    __syncthreads();
    GW_LOOP(row, nrows_l(l)) {
        int ee[4], pp[4];
#pragma unroll
        for (int k = 0; k < 4; ++k) { ee[k] = WSP(int, WS_TOPI)[row * 4 + k]; pp[k] = WSP(int, WS_TOPI)[MALL * 4 + row * 4 + k]; }
        gv4u yv[4][2];
#pragma unroll
        for (int k = 0; k < 4; ++k) { const gv4u* ys = (const gv4u*)(WSP(bf16_t, WS_YSLOT) + (size_t)(aoffs[ee[k]] + pp[k]) * D) + lane; yv[k][0] = ys[0]; yv[k][1] = ys[64]; }
        float acc[16];
#pragma unroll
        for (int j = 0; j < 16; ++j) acc[j] = 0.f;
#pragma unroll
        for (int k = 0; k < 4; ++k)
#pragma unroll
            for (int hf = 0; hf < 2; ++hf)
#pragma unroll
                for (int q = 0; q < 4; ++q) { acc[hf * 8 + 2 * q] += gblo(yv[k][hf][q]); acc[hf * 8 + 2 * q + 1] += gbhi(yv[k][hf][q]); }
        float ss = 0.f;
#pragma unroll
        for (int j = 0; j < 16; ++j) ss += acc[j] * acc[j];
        float rstd = rsqrtf(wave_sum(ss) * (1.f / D) + EPS);
        float* xr = WSP(float, WS_XRES) + (size_t)row * D;
        const float* mod = WSP(float, WS_MOD) + (size_t)(l * 5 + mod_r(row)) * 6144;
        const float* g3 = p.norm_g + (l * 4 + 3) * D;
        ss = 0.f;
        gv4f xo[4], gm[4], gg[4];
#pragma unroll
        for (int q8 = 0; q8 < 4; ++q8) { const int ci = (q8 >> 1) * 512 + lane * 8 + (q8 & 1) * 4; xo[q8] = *(const gv4f*)(xr + ci); gm[q8] = *(const gv4f*)(mod + 5120 + ci); gg[q8] = *(const gv4f*)(g3 + ci); }
        float n0[16], n1[16], n2[16];
        if (l < DEPTH - 1) {
            const float* mod2 = WSP(float, WS_MOD) + (size_t)((l + 1) * 5 + mod_r(row)) * 6144; const float* g0 = p.norm_g + ((l + 1) * 4 + 0) * D;
#pragma unroll
            for (int q8 = 0; q8 < 4; ++q8) { const int ci = (q8 >> 1) * 512 + lane * 8 + (q8 & 1) * 4; const gv4f a = *(const gv4f*)(g0 + ci), b2 = *(const gv4f*)(mod2 + 1024 + ci), c2 = *(const gv4f*)(mod2 + ci);
#pragma unroll
                for (int q = 0; q < 4; ++q) { n0[q8 * 4 + q] = a[q]; n1[q8 * 4 + q] = b2[q]; n2[q8 * 4 + q] = c2[q]; } }
        }
#pragma unroll
        for (int q8 = 0; q8 < 4; ++q8) {
            const int ci = (q8 >> 1) * 512 + lane * 8 + (q8 & 1) * 4;
            gv4f vv;
#pragma unroll
            for (int q = 0; q < 4; ++q) { const float v = xo[q8][q] + gm[q8][q] * (acc[q8 * 4 + q] * rstd * gg[q8][q]); vv[q] = v; acc[q8 * 4 + q] = v; ss += v * v; }
            if (l == DEPTH - 1) *(gv4f*)(p.out + (size_t)row * D + ci) = vv; else *(gv4f*)(xr + ci) = vv;
        }
        if (l < DEPTH - 1) {
            rstd = rsqrtf(wave_sum(ss) * (1.f / D) + EPS);
            bf16_t* hb = WSP(bf16_t, WS_HB) + (size_t)row * D;
#pragma unroll
            for (int hf = 0; hf < 2; ++hf) {
                gv4u o;
#pragma unroll
                for (int q = 0; q < 4; ++q) { const int i0 = hf * 8 + 2 * q; o[q] = cvtpk_rne(acc[i0] * rstd * n0[i0] * (1.f + n1[i0]) + n2[i0], acc[i0 + 1] * rstd * n0[i0 + 1] * (1.f + n1[i0 + 1]) + n2[i0 + 1]); }
                *(gv4u*)(hb + hf * 512 + lane * 8) = o;
            }
        }
    }
    __syncthreads();
}

namespace pg8 {
typedef short bf16x8 __attribute__((ext_vector_type(8)));
typedef float f32x4 __attribute__((ext_vector_type(4)));
typedef unsigned u32x4 __attribute__((ext_vector_type(4)));
typedef unsigned u32x2 __attribute__((ext_vector_type(2)));
constexpr int BM = 256, BK = 64, HALF = 128, HTB = HALF * BK * 2, STAGE_BYTES = 8 * HTB, NXCD = 8, WGM = 8, K = 1024;
__host__ __device__ __forceinline__ int lds_byte(int r, int c) { const int st = (r >> 4) * 2 + (c >> 5), rr = r & 15, cc = c & 31, ob = rr * 64 + cc * 2; return st * 1024 + (ob ^ (((ob >> 9) & 1) << 5)); }
__host__ __device__ __forceinline__ void stage_rc(int b, int& R, int& C) { const int st = b / 1024, sb = b % 1024, swz = sb ^ (((sb >> 9) & 1) << 5); R = (st >> 1) * 16 + swz / 64; C = (st & 1) * 32 + (swz % 64) / 2; }
__host__ __device__ __forceinline__ int perm32(int rho) { const int n = rho >> 4, i = rho & 15; return 8 * (i >> 2) + 4 * n + (i & 3); }
__device__ __forceinline__ unsigned cvt_pk_bf16(float lo, float hi) { return cvtpk_rne(lo, hi); }

struct Unit { int pm, pn; const char* A; const char* B; const int* gl; int gcnt; int e; int row0; };

struct DenseOrder {
    int nM, nN, nwg, G, c; const char* A; const char* Bt;
    __device__ __forceinline__ void init(int M, int N, int G_, int c_, const void* A_, const void* Bt_) { nM = M / BM; nN = N / BM; nwg = nM * nN; G = G_; c = c_; A = (const char*)A_; Bt = (const char*)Bt_; }
    __device__ __forceinline__ bool next(int i, Unit& u) const {
        const long L = (long)i * G + c; if (L >= nwg) return false;
        int wgid = (int)L; { const int q = nwg / NXCD, r = nwg % NXCD, xcd = wgid % NXCD, off = wgid / NXCD; wgid = (xcd < r ? xcd * (q + 1) : r * (q + 1) + (xcd - r) * q) + off; }
        const int nig = WGM * nN, gid = wgid / nig, fm = gid * WGM, gsz = (nM - fm) < WGM ? (nM - fm) : WGM;
        u.pm = fm + ((wgid % nig) % gsz); u.pn = (wgid % nig) / gsz;
        u.A = A + (size_t)u.pm * (BM * K * 2); u.B = Bt + (size_t)u.pn * (BM * K * 2); u.gl = nullptr; u.gcnt = BM; u.e = 0; u.row0 = u.pm * BM; return true;
    }
};
struct MoeOrder {
    const LAS int* tab; int G, c, NCT; const char* A; const char* W; size_t wstride; const int* list; const unsigned* cnt; bool gather; int rowb;
    __device__ __forceinline__ bool next(int i, Unit& u) const {
        const int xg = c & 7, L = (c >> 3) + (G >> 3) * i; const LAS int* gt = tab + 72 + xg * 5;
        if (L >= gt[4]) return false;
        int q = 0;
#pragma unroll
        for (int j = 1; j < 4; ++j) if (L >= gt[j]) q = j;
        const int e = __builtin_amdgcn_readfirstlane(xg + 8 * q);
        const int r = __builtin_amdgcn_readfirstlane(L - gt[q]), ce = __builtin_amdgcn_readfirstlane((int)cnt[e * 64]), rte = (ce + 255) >> 8, ro = __builtin_amdgcn_readfirstlane(tab[33 + e]);
        const int ct = r / rte, rt = r - ct * rte;
        u.pm = rt; u.pn = ct; u.e = e; u.row0 = ro + rt * 256; u.gl = list + (size_t)e * MALL + rt * 256; u.gcnt = min(256, ce - rt * 256);
        u.A = gather ? A : A + (size_t)u.row0 * rowb; u.B = W + (size_t)e * wstride + (size_t)ct * BM * rowb; return true;
    }
};
__device__ __forceinline__ void moe_tab_build(LAS int* tab, const unsigned* cnt, int NCT) {
    if (ltid() == 0) {
        int rs = 0; for (int e = 0; e < 32; ++e) { tab[33 + e] = rs; rs += (((int)cnt[e * 64] + 255) >> 8) * 256; } tab[65] = rs;
        for (int g = 0; g < 8; ++g) { int us = 0; for (int q = 0; q < 4; ++q) { tab[72 + g * 5 + q] = us; us += (((int)cnt[(g + 8 * q) * 64] + 255) >> 8) * NCT; } tab[72 + g * 5 + 4] = us; }
    }
    __syncthreads();
}

struct EpiBf16 {
    static constexpr bool PERM = true; bf16_t* O; int ldc; const float* bias;
    __device__ __forceinline__ void operator()(const f32x4 (&acc)[2][2][4][2], const Unit& u, int wr, int wc, int fr, int fq) const {
        const int row0 = u.row0 + wr * 64 + fr, col0 = u.pn * BM + wc * 32 + 8 * fq;
        f32x4 bv[2][2];
#pragma unroll
        for (int bj = 0; bj < 2; ++bj)
#pragma unroll
            for (int n = 0; n < 2; ++n) bv[bj][n] = bias ? *(const f32x4*)(bias + col0 + bj * HALF + 4 * n) : (f32x4){0.f, 0.f, 0.f, 0.f};
#pragma unroll
        for (int ai = 0; ai < 2; ++ai)
#pragma unroll
            for (int m = 0; m < 4; ++m) { bf16_t* rowp = O + (size_t)(row0 + ai * HALF + m * 16) * ldc + col0;
#pragma unroll
                for (int bj = 0; bj < 2; ++bj) { const f32x4 v0 = acc[ai][bj][m][0] + bv[bj][0], v1 = acc[ai][bj][m][1] + bv[bj][1];
                    u32x4 w; w.x = cvt_pk_bf16(v0[0], v0[1]); w.y = cvt_pk_bf16(v0[2], v0[3]); w.z = cvt_pk_bf16(v1[0], v1[1]); w.w = cvt_pk_bf16(v1[2], v1[3]);
                    *(u32x4*)(rowp + bj * HALF) = w; } }
    }
};
struct EpiF32 {
    static constexpr bool PERM = false; float* O; int ldc;
    __device__ __forceinline__ void operator()(const f32x4 (&acc)[2][2][4][2], const Unit& u, int wr, int wc, int fr, int fq) const {
        const int row0 = u.row0 + wr * 64 + fr, col0 = u.pn * BM + wc * 32 + 4 * fq;
#pragma unroll
        for (int ai = 0; ai < 2; ++ai)
#pragma unroll
            for (int m = 0; m < 4; ++m) { float* rowp = O + (size_t)(row0 + ai * HALF + m * 16) * ldc + col0;
#pragma unroll
                for (int bj = 0; bj < 2; ++bj)
#pragma unroll
                    for (int n = 0; n < 2; ++n) *(f32x4*)(rowp + bj * HALF + n * 16) = acc[ai][bj][m][n]; }
    }
};
struct EpiMoeUp {
    static constexpr bool PERM = true; unsigned char* ACT; const float* b1all;
    __device__ __forceinline__ void operator()(const f32x4 (&acc)[2][2][4][2], const Unit& u, int wr, int wc, int fr, int fq) const {
        const int col0 = u.pn * BM + wc * 32 + 8 * fq; const float* b1 = b1all + (size_t)u.e * 2048;
        f32x4 bv[2][2];
#pragma unroll
        for (int bj = 0; bj < 2; ++bj)
#pragma unroll
            for (int n = 0; n < 2; ++n) bv[bj][n] = *(const f32x4*)(b1 + col0 + bj * HALF + 4 * n);
#pragma unroll
        for (int ai = 0; ai < 2; ++ai)
#pragma unroll
            for (int m = 0; m < 4; ++m) { unsigned char* rowp = ACT + (size_t)(u.row0 + wr * 64 + fr + ai * HALF + m * 16) * 1024 + (col0 >> 1);
#pragma unroll
                for (int bj = 0; bj < 2; ++bj) { const f32x4 v0 = acc[ai][bj][m][0] * (1.f / W8_SCALE) + bv[bj][0], v1 = acc[ai][bj][m][1] * (1.f / W8_SCALE) + bv[bj][1];
                    float a[4];
#pragma unroll
                    for (int j = 0; j < 4; ++j) { const float gl = fminf(j < 2 ? v0[2 * j] : v1[2 * j - 4], 7.f), ln = fminf(fmaxf(j < 2 ? v0[2 * j + 1] : v1[2 * j - 3], -7.f), 7.f);
                        a[j] = gl * __builtin_amdgcn_rcpf(1.f + __builtin_amdgcn_exp2f(-1.702f * 1.4426950408889634f * gl)) * (ln + 1.f); }
                    *(unsigned*)(rowp + bj * 64) = pk4_fp8(a[0], a[1], a[2], a[3]); } }
    }
};
struct EpiMoeDown {
    static constexpr bool PERM = true; bf16_t* Y; const float* b2all; const float* topw;
    __device__ __forceinline__ void operator()(const f32x4 (&acc)[2][2][4][2], const Unit& u, int wr, int wc, int fr, int fq) const {
        const int col0 = u.pn * BM + wc * 32 + 8 * fq; const float* b2 = b2all + (size_t)u.e * 1024;
        f32x4 bv[2][2];
#pragma unroll
        for (int bj = 0; bj < 2; ++bj)
#pragma unroll
            for (int n = 0; n < 2; ++n) bv[bj][n] = *(const f32x4*)(b2 + col0 + bj * HALF + 4 * n);
#pragma unroll
        for (int ai = 0; ai < 2; ++ai)
#pragma unroll
            for (int m = 0; m < 4; ++m) { const int r = wr * 64 + fr + ai * HALF + m * 16; const int rc = r < u.gcnt ? r : u.gcnt - 1; const float twl = topw[u.gl[rc]]; const float tw = r < u.gcnt ? twl : 0.f;
                bf16_t* rowp = Y + (size_t)(u.row0 + r) * 1024 + col0;
#pragma unroll
                for (int bj = 0; bj < 2; ++bj) { const f32x4 v0 = (acc[ai][bj][m][0] * (1.f / W8_SCALE) + bv[bj][0]) * tw, v1 = (acc[ai][bj][m][1] * (1.f / W8_SCALE) + bv[bj][1]) * tw;
                    u32x4 w; w.x = cvt_pk_bf16(v0[0], v0[1]); w.y = cvt_pk_bf16(v0[2], v0[3]); w.z = cvt_pk_bf16(v1[0], v1[1]); w.w = cvt_pk_bf16(v1[2], v1[3]);
                    *(u32x4*)(rowp + bj * HALF) = w; } }
    }
};

typedef int v8i __attribute__((ext_vector_type(8)));
template <class Epi, class Sched, bool GATHER, bool ALIGN_EPI, bool F8 = false>
__device__ __forceinline__ void gphase(LAS unsigned char* lds, const Sched& S, const Epi& E) {
    const int tid = ltid();
    const int wid = __builtin_amdgcn_readfirstlane(tid >> 6), lane = tid & 63, wr = wid >> 2, wc = wid & 3, fr = lane & 15, fq = lane >> 4;
    constexpr int ROWB = F8 ? K : K * 2, nt = ROWB / 128, KSTR = F8 ? 16 : 1024;
    unsigned voffB[2], CA2[2]; int RA[2];
#pragma unroll
    for (int i = 0; i < 2; ++i) { int R, C; stage_rc(tid * 16 + i * 8192, R, C); const int Rb = Epi::PERM ? ((R & ~31) + perm32(R & 31)) : R;
        RA[i] = R; CA2[i] = (unsigned)C * 2u; voffB[i] = (unsigned)(Rb * ROWB + C * 2); }
    constexpr size_t kstep = (size_t)(BK * 2), hstep = (size_t)HALF * ROWB;
    const unsigned ldsw = (unsigned)wid * 1024u;
    const int aoff = lds_byte(wr * 64 + fr, fq * (F8 ? 16 : 8)), boff = lds_byte(wc * 32 + fr, fq * (F8 ? 16 : 8));
#define PG8_SA(b, h) (((b) * 2 + (h)) * HTB)
#define PG8_SB(b, h) ((4 + (b) * 2 + (h)) * HTB)
#define PG8_GL(gp, ldsoff) __builtin_amdgcn_global_load_lds((const unsigned*)(gp), (LAS unsigned*)(lds + (ldsoff)), 16, 0, 0)
#define PG8_STB(bufoff, gbase) do { PG8_GL((const char*)(gbase) + voffB[0], (bufoff) + ldsw); PG8_GL((const char*)(gbase) + voffB[1], (bufoff) + ldsw + 8192); } while (0)
#define PG8_STA(bufoff, gbase, o) do { PG8_GL((const char*)(gbase) + (o)[0], (bufoff) + ldsw); PG8_GL((const char*)(gbase) + (o)[1], (bufoff) + ldsw + 8192); } while (0)
#define PG8_LDA(dst, b, h) do { _Pragma("unroll") for (int m = 0; m < 4; ++m) { if constexpr (F8) dst##8[m] = *(const LAS v8i*)(lds + PG8_SA(b, h) + aoff + m * 2048); else { _Pragma("unroll") for (int k = 0; k < 2; ++k) dst[m][k] = *(const LAS bf16x8*)(lds + PG8_SA(b, h) + aoff + m * 2048 + k * KSTR); } } } while (0)
#define PG8_LDB(dst, b, h) do { _Pragma("unroll") for (int n = 0; n < 2; ++n) { if constexpr (F8) dst##8[n] = *(const LAS v8i*)(lds + PG8_SB(b, h) + boff + n * 2048); else { _Pragma("unroll") for (int k = 0; k < 2; ++k) dst[n][k] = *(const LAS bf16x8*)(lds + PG8_SB(b, h) + boff + n * 2048 + k * KSTR); } } } while (0)
#define PG8_MMA(ai, bj, At, Bt) do { __builtin_amdgcn_s_setprio(1); _Pragma("unroll") for (int m = 0; m < 4; ++m) _Pragma("unroll") for (int n = 0; n < 2; ++n) { \
        if constexpr (F8) asm volatile("v_mfma_scale_f32_16x16x128_f8f6f4 %0, %1, %2, %0, %3, %3 op_sel_hi:[0,0,0]" : "+v"(acc[ai][bj][m][n]) : "v"(Bt##8[n]), "v"(At##8[m]), "v"(f8scale) : "memory"); \
        else { _Pragma("unroll") for (int k = 0; k < 2; ++k) acc[ai][bj][m][n] = __builtin_amdgcn_mfma_f32_16x16x32_bf16(Bt[n][k], At[m][k], acc[ai][bj][m][n], 0, 0, 0); } } \
        __builtin_amdgcn_s_setprio(0); } while (0)
#define PG8_WAIT_V(n) asm volatile("s_waitcnt vmcnt(" #n ")" ::: "memory")
#define PG8_WAIT_L(n) asm volatile("s_waitcnt lgkmcnt(" #n ")" ::: "memory")
#define PG8_BAR __builtin_amdgcn_s_barrier()
#define PG8_SCHED __builtin_amdgcn_sched_barrier(0)
#define PG8_AOFFS(u, o) do { _Pragma("unroll") for (int h_ = 0; h_ < 2; ++h_) _Pragma("unroll") for (int i_ = 0; i_ < 2; ++i_) { \
        if (GATHER) { const int r_ = h_ * 128 + RA[i_]; const int rc_ = r_ < (u).gcnt ? r_ : (u).gcnt - 1; const int tok_ = (u).gl[rc_] >> 2; o[h_][i_] = (unsigned)tok_ * (unsigned)ROWB + CA2[i_]; } \
        else o[h_][i_] = (unsigned)((h_ * 128 + RA[i_]) * ROWB) + CA2[i_]; } } while (0)
    Unit cur, nxt; int ui = 0;
    if (!S.next(0, cur)) return;
    f32x4 acc[2][2][4][2];
#pragma unroll
    for (int a = 0; a < 2; ++a)
#pragma unroll
        for (int b = 0; b < 2; ++b)
#pragma unroll
            for (int m = 0; m < 4; ++m)
#pragma unroll
                for (int n = 0; n < 2; ++n) acc[a][b][m][n] = (f32x4){0.f, 0.f, 0.f, 0.f};
    int f8scale = 0x7f7f7f7f; asm volatile("" : "+v"(f8scale));
    bf16x8 At[F8 ? 1 : 4][2], B0[F8 ? 1 : 2][2], B1[F8 ? 1 : 2][2]; v8i At8[F8 ? 4 : 1], B08[F8 ? 2 : 1], B18[F8 ? 2 : 1];
    (void)At; (void)B0; (void)B1; (void)At8; (void)B08; (void)B18;
    unsigned oAc[2][2], oAn[2][2];
    PG8_AOFFS(cur, oAc);
    const char* cA = cur.A; const char* cB = cur.B;
    PG8_STB(PG8_SB(0, 0), cB); PG8_STB(PG8_SB(0, 1), cB + hstep); PG8_STA(PG8_SA(0, 0), cA, oAc[0]); PG8_STA(PG8_SA(0, 1), cA, oAc[1]);
    if (wr == 1) PG8_BAR;
    PG8_WAIT_V(2); PG8_BAR;
    PG8_STB(PG8_SB(1, 0), cB + kstep); PG8_STA(PG8_SA(1, 0), cA + kstep, oAc[0]); PG8_STB(PG8_SB(1, 1), cB + hstep + kstep);
    PG8_WAIT_V(6); PG8_BAR;
    for (;;) {
        const bool has_next = S.next(ui + 1, nxt);
        const char* nA = has_next ? nxt.A : cA; const char* nB = has_next ? nxt.B : cB;
        if (has_next) { PG8_AOFFS(nxt, oAn); } else {
#pragma unroll
            for (int h = 0; h < 2; ++h) { oAn[h][0] = oAc[h][0]; oAn[h][1] = oAc[h][1]; } }
#pragma unroll 1
        for (int t = 0; t < nt; t += 2) {
            const bool last = (t == nt - 2);
            const char* a1 = cA + (size_t)(t + 1) * kstep;
            const char* a2 = last ? nA : cA + (size_t)(t + 2) * kstep; const char* b2 = last ? nB : cB + (size_t)(t + 2) * kstep;
            const char* a3 = a2 + kstep; const char* b3 = b2 + kstep;
            unsigned o2[2][2];
#pragma unroll
            for (int h = 0; h < 2; ++h) { o2[h][0] = last ? oAn[h][0] : oAc[h][0]; o2[h][1] = last ? oAn[h][1] : oAc[h][1]; }
            PG8_LDB(B0, 0, 0); PG8_LDB(B1, 0, 1); PG8_SCHED; PG8_LDA(At, 0, 0); PG8_STA(PG8_SA(1, 1), a1, oAc[1]);
            PG8_WAIT_V(8); PG8_WAIT_L(0); PG8_BAR; PG8_MMA(0, 0, At, B0); PG8_MMA(0, 1, At, B1); PG8_BAR; PG8_SCHED;
            PG8_LDA(At, 0, 1); PG8_STB(PG8_SB(0, 0), b2); PG8_STB(PG8_SB(0, 1), b2 + hstep); PG8_STA(PG8_SA(0, 0), a2, o2[0]);
            PG8_WAIT_V(8); PG8_WAIT_L(0); PG8_BAR; PG8_MMA(1, 0, At, B0); PG8_MMA(1, 1, At, B1); PG8_BAR; PG8_SCHED;
            PG8_LDB(B0, 1, 0); PG8_LDB(B1, 1, 1); PG8_SCHED; PG8_LDA(At, 1, 0); PG8_STA(PG8_SA(0, 1), a2, o2[1]);
            PG8_WAIT_V(8); PG8_WAIT_L(0); PG8_BAR; PG8_MMA(0, 0, At, B0); PG8_MMA(0, 1, At, B1); PG8_BAR; PG8_SCHED;
            PG8_LDA(At, 1, 1); PG8_STB(PG8_SB(1, 0), b3); PG8_STB(PG8_SB(1, 1), b3 + hstep); PG8_STA(PG8_SA(1, 0), a3, o2[0]);
            PG8_WAIT_V(8); PG8_WAIT_L(0); PG8_BAR; PG8_MMA(1, 0, At, B0); PG8_MMA(1, 1, At, B1); PG8_BAR; PG8_SCHED;
        }
        if constexpr (F8) asm volatile("s_nop 15\n\ts_nop 15" ::: "memory");
        if constexpr (ALIGN_EPI) { if (wr == 0) PG8_BAR; }
        E(acc, cur, wr, wc, fr, fq);
        if (!has_next) break;
#pragma unroll
        for (int a = 0; a < 2; ++a)
#pragma unroll
            for (int b = 0; b < 2; ++b)
#pragma unroll
                for (int m = 0; m < 4; ++m)
#pragma unroll
                    for (int n = 0; n < 2; ++n) acc[a][b][m][n] = (f32x4){0.f, 0.f, 0.f, 0.f};
        cur = nxt; cA = nA; cB = nB; ++ui;
#pragma unroll
        for (int h = 0; h < 2; ++h) { oAc[h][0] = oAn[h][0]; oAc[h][1] = oAn[h][1]; }
        if constexpr (ALIGN_EPI) { if (wr == 1) PG8_BAR; }
    }
    PG8_WAIT_V(0);
    if constexpr (!ALIGN_EPI) { if (wr == 0) PG8_BAR; }
    PG8_BAR;
#undef PG8_SA
#undef PG8_SB
#undef PG8_GL
#undef PG8_STA
#undef PG8_STB
#undef PG8_LDA
#undef PG8_LDB
#undef PG8_MMA
#undef PG8_WAIT_V
#undef PG8_WAIT_L
#undef PG8_BAR
#undef PG8_SCHED
#undef PG8_AOFFS
}
}

__device__ __forceinline__ unsigned pk2(float lo, float hi) { return (unsigned)f2bf(lo) | ((unsigned)f2bf(hi) << 16); }
__device__ __forceinline__ void transpose_item(const float* W, int ld, int nblk, bf16_t* WT, LAS float* scr, int item, int lane) {
    const int kb = item / nblk, nb = item - kb * nblk, k0 = 64 * kb, n0 = 32 * nb;
#pragma unroll 8
    for (int i = 0; i < 32; ++i) { const int kk = 2 * i + (lane >> 5); scr[kk * 33 + (lane & 31)] = W[(size_t)(k0 + kk) * ld + n0 + (lane & 31)]; }
    asm volatile("s_waitcnt lgkmcnt(0)" ::: "memory");
    const int c = lane & 7;
#pragma unroll
    for (int j = 0; j < 4; ++j) { const int n = (lane >> 3) + 8 * j; const LAS float* s = scr + (8 * c) * 33 + n;
        pg8::u32x4 o; o.x = pk2(s[0 * 33], s[1 * 33]); o.y = pk2(s[2 * 33], s[3 * 33]); o.z = pk2(s[4 * 33], s[5 * 33]); o.w = pk2(s[6 * 33], s[7 * 33]);
        *(pg8::u32x4*)(WT + (size_t)(n0 + n) * 1024 + k0 + 8 * c) = o; }
    asm volatile("s_waitcnt lgkmcnt(0)" ::: "memory");
}
__device__ __forceinline__ void transpose_item8(const float* W, int ld, int nblk, unsigned char* WT, LAS float* scr, int item, int lane) {
    const int kb = item / nblk, nb = item - kb * nblk, k0 = 64 * kb, n0 = 32 * nb;
#pragma unroll 8
    for (int i = 0; i < 32; ++i) { const int kk = 2 * i + (lane >> 5); scr[kk * 33 + (lane & 31)] = W[(size_t)(k0 + kk) * ld + n0 + (lane & 31)]; }
    asm volatile("s_waitcnt lgkmcnt(0)" ::: "memory");
    const int c = lane & 3;
#pragma unroll
    for (int j = 0; j < 2; ++j) { const int n = (lane >> 2) + 16 * j; const LAS float* sp = scr + (16 * c) * 33 + n;
        pg8::u32x4 o;
#pragma unroll
        for (int q = 0; q < 4; ++q) o[q] = pk4_fp8(sp[(4 * q) * 33] * W8_SCALE, sp[(4 * q + 1) * 33] * W8_SCALE, sp[(4 * q + 2) * 33] * W8_SCALE, sp[(4 * q + 3) * 33] * W8_SCALE);
        *(pg8::u32x4*)(WT + (size_t)(n0 + n) * 1024 + k0 + 16 * c) = o; }
    asm volatile("s_waitcnt lgkmcnt(0)" ::: "memory");
}
__device__ __forceinline__ void d_convert_a(KP kp, LAS float* scr_all) {
    PH_IDS;
    const int lane = tid & 63; LAS float* scr = scr_all + (tid >> 6) * (64 * 33);
    constexpr int I_IN = 16 * 104, I_OUT = 16 * 32, I_W1 = 16 * 64, I_W2 = 16 * 32, I_L = I_IN + I_OUT + 32 * I_W1 + 32 * I_W2;
    GW_LOOP(it, 2 * I_L) {
        const int l = it / I_L; int r = it - l * I_L;
        if (r < I_IN) { transpose_item(p.w_in + (size_t)l * D * INW, INW, 104, WSP(bf16_t, WS_WIN_T) + (size_t)l * PW * 1024, scr, r, lane); continue; } r -= I_IN;
        if (r < I_OUT) { transpose_item(p.w_out + (size_t)l * D * D, 1024, 32, WSP(bf16_t, WS_WOUT_T) + (size_t)l * 1024 * 1024, scr, r, lane); continue; } r -= I_OUT;
        if (r < 32 * I_W1) { const int e = r / I_W1; transpose_item8(p.exp_w1 + ((size_t)l * NEXP + e) * D * 2048, 2048, 64, WSP(unsigned char, WS_W1_T) + ((size_t)l * NEXP + e) * 2048 * 1024, scr, r - e * I_W1, lane); continue; } r -= 32 * I_W1;
        { const int e = r / I_W2; transpose_item8(p.exp_w2 + ((size_t)l * NEXP + e) * D * D, 1024, 32, WSP(unsigned char, WS_W2_T) + ((size_t)l * NEXP + e) * 1024 * 1024, scr, r - e * I_W2, lane); }
    }
    GT_LOOP(idx, 2 * PW) { const int l = idx / PW, n = idx - l * PW; WSP(float, WS_BIAS_IN)[idx] = n < 3328 ? 0.f : p.gla_gate_b[l * 256 + n - 3328]; }
}
__device__ __forceinline__ void d_convert_b(KP kp, LAS float* scr_all) {
    PH_IDS;
    const int lane = tid & 63; LAS float* scr = scr_all + (tid >> 6) * (64 * 33);
    GW_LOOP(it, 2 * 128) { const int l = it >> 7; transpose_item(WSP(float, WS_WEFF) + (size_t)l * D * 256, 256, 8, WSP(bf16_t, WS_WIN_T) + ((size_t)l * PW + 3328) * 1024, scr, it & 127, lane); }
}

__device__ __forceinline__ void d_gemm_in(KP kp, int l, LAS unsigned char* lds) {
    PH_IDS;
    pg8::DenseOrder S; S.init(MALL, PW, gridDim.x, bid, WSP(bf16_t, WS_HB), WSP(bf16_t, WS_WIN_T) + (size_t)l * PW * 1024);
    pg8::EpiBf16 E{WSP(bf16_t, WS_PBUF), PW, WSP(float, WS_BIAS_IN) + l * PW};
    pg8::gphase<pg8::EpiBf16, pg8::DenseOrder, false, true>(lds, S, E);
}
__device__ __forceinline__ void d_gemm_out(KP kp, int l, LAS unsigned char* lds) {
    PH_IDS;
    pg8::DenseOrder S; S.init(nrows_l(l), 1024, gridDim.x, bid, WSP(bf16_t, WS_CONCAT), WSP(bf16_t, WS_WOUT_T) + (size_t)l * 1024 * 1024);
    pg8::EpiF32 E{WSP(float, WS_YBUF), 1024};
    pg8::gphase<pg8::EpiF32, pg8::DenseOrder, false, true>(lds, S, E);
}
__device__ __forceinline__ void d_moe_up(KP kp, int l, LAS unsigned char* lds) {
    PH_IDS;
    LAS int* tab = (LAS int*)(lds + pg8::STAGE_BYTES);
    const unsigned* cnt = WSP(unsigned, WS_CTL) + CW_CNT + l * 32 * 64;
    pg8::moe_tab_build(tab, cnt, 8);
    pg8::MoeOrder S{tab, (int)gridDim.x, bid, 8, (const char*)WSP(unsigned char, WS_HB8), (const char*)(WSP(unsigned char, WS_W1_T) + (size_t)l * NEXP * 2048 * 1024), (size_t)2048 * 1024, WSP(int, WS_LIST), cnt, true, 1024};
    pg8::EpiMoeUp E{WSP(unsigned char, WS_ACT), p.exp_b1 + (size_t)l * NEXP * 2048};
    pg8::gphase<pg8::EpiMoeUp, pg8::MoeOrder, true, true, true>(lds, S, E);
}
__device__ __forceinline__ void d_moe_down(KP kp, int l, LAS unsigned char* lds) {
    PH_IDS;
    LAS int* tab = (LAS int*)(lds + pg8::STAGE_BYTES);
    const unsigned* cnt = WSP(unsigned, WS_CTL) + CW_CNT + l * 32 * 64;
    pg8::moe_tab_build(tab, cnt, 4);
    pg8::MoeOrder S{tab, (int)gridDim.x, bid, 4, (const char*)WSP(unsigned char, WS_ACT), (const char*)(WSP(unsigned char, WS_W2_T) + (size_t)l * NEXP * 1024 * 1024), (size_t)1024 * 1024, WSP(int, WS_LIST), cnt, false, 1024};
    pg8::EpiMoeDown E{WSP(bf16_t, WS_YSLOT), p.exp_b2 + (size_t)l * NEXP * 1024, WSP(float, WS_TOPW)};
    pg8::gphase<pg8::EpiMoeDown, pg8::MoeOrder, false, true, true>(lds, S, E);
}

constexpr int ATT_NT = 68;
constexpr float ATT_QSCALE = 0.17677669529663687f * 1.4426950408889634f;
__device__ __forceinline__ void d_prep_attn(KP kp) {
    PH_IDS;
    const bf16_t* PB = WSP(bf16_t, WS_PBUF);
    GT_LOOP(idx, MALL * 16) {
        const int row = idx >> 4, hm = (idx >> 1) & 7, ks = idx & 1, h = hm >> 1, m = hm & 1;
        const bool lat = row < NLAT; const int t = row & (SEQ - 1);
        const int ipos = lat ? (ks == 0 ? (t >> 6) : (t & 63)) : 0;
        const int cb = h * 64 + m * 32 + ks * 16;
        const pg8::u32x4* qs = (const pg8::u32x4*)(PB + (size_t)row * PW + PC_AQ + cb);
        const pg8::u32x4* ksrc = (const pg8::u32x4*)(PB + (size_t)row * PW + PC_AK + cb);
        pg8::u32x4 qa = qs[0], qb = qs[1], ka = ksrc[0], kb = ksrc[1];
        float qv[16], kv[16];
#pragma unroll
        for (int j = 0; j < 4; ++j) { qv[2 * j] = bf2f((bf16_t)(qa[j] & 0xffff)); qv[2 * j + 1] = bf2f((bf16_t)(qa[j] >> 16)); qv[8 + 2 * j] = bf2f((bf16_t)(qb[j] & 0xffff)); qv[9 + 2 * j] = bf2f((bf16_t)(qb[j] >> 16));
                                      kv[2 * j] = bf2f((bf16_t)(ka[j] & 0xffff)); kv[2 * j + 1] = bf2f((bf16_t)(ka[j] >> 16)); kv[8 + 2 * j] = bf2f((bf16_t)(kb[j] & 0xffff)); kv[9 + 2 * j] = bf2f((bf16_t)(kb[j] >> 16)); }
        float qo[16], ko[16];
#pragma unroll
        for (int j = 0; j < 8; ++j) {
            const float* tb = WSP(float, WS_ROPE) + (ipos * 8 + j) * 2; const float cs = tb[0], sn = tb[1];
            qo[j] = qv[j] * cs - qv[j + 8] * sn; qo[j + 8] = qv[j + 8] * cs + qv[j] * sn;
            ko[j] = kv[j] * cs - kv[j + 8] * sn; ko[j + 8] = kv[j + 8] * cs + kv[j] * sn;
        }
        pg8::u32x4 o0, o1;
#pragma unroll
        for (int j = 0; j < 4; ++j) { o0[j] = pk2(qo[2 * j] * ATT_QSCALE, qo[2 * j + 1] * ATT_QSCALE); o1[j] = pk2(qo[8 + 2 * j] * ATT_QSCALE, qo[9 + 2 * j] * ATT_QSCALE); }
        pg8::u32x4* qd = (pg8::u32x4*)(WSP(bf16_t, WS_QRP) + (size_t)row * 256 + cb); qd[0] = o0; qd[1] = o1;
#pragma unroll
        for (int j = 0; j < 4; ++j) { o0[j] = pk2(ko[2 * j], ko[2 * j + 1]); o1[j] = pk2(ko[8 + 2 * j], ko[9 + 2 * j]); }
        int b, tile, key; if (lat) { b = row >> 12; tile = t >> 6; key = t & 63; } else { const int r = row - NLAT; b = r >> 8; tile = 64 + ((r & 255) >> 6); key = r & 63; }
        unsigned char* img = WSP(unsigned char, WS_KIMG) + ((size_t)(b * 4 + h) * ATT_NT + tile) * 8192 + key * 128;
        const int c0 = m * 4 + ks * 2, sw = (key >> 1) & 7;
        *(pg8::u32x4*)(img + 16 * (c0 ^ sw)) = o0; *(pg8::u32x4*)(img + 16 * ((c0 + 1) ^ sw)) = o1;
    }
    GT_LOOP(idx, 16 * ATT_NT * 2 * 64) {
        const int d = idx & 63, half = (idx >> 6) & 1, tile = (idx >> 7) % ATT_NT, bh = idx / (128 * ATT_NT), b = bh >> 2, h = bh & 3;
        const int row0 = (tile < 64 ? b * SEQ + tile * 64 : NLAT + b * CTXL + (tile - 64) * 64) + half * 32;
        const bf16_t* vp = PB + (size_t)row0 * PW + PC_AV + h * 64 + d;
        unsigned short vv[32];
#pragma unroll
        for (int j = 0; j < 32; ++j) vv[j] = vp[(size_t)j * PW];
        unsigned char* img = WSP(unsigned char, WS_VIMG) + ((size_t)bh * ATT_NT + tile) * 8192 + d * 128; const int x = (d >> 1) & 15;
#pragma unroll
        for (int j = 0; j < 8; ++j) *(pg8::u32x2*)(img + 8 * ((half * 8 + j) ^ x)) = (pg8::u32x2){(unsigned)vv[4 * j] | ((unsigned)vv[4 * j + 1] << 16), (unsigned)vv[4 * j + 2] | ((unsigned)vv[4 * j + 3] << 16)};
    }
}

namespace att {
typedef short bf16x8 __attribute__((ext_vector_type(8)));
typedef float f32x16 __attribute__((ext_vector_type(16)));
typedef unsigned u32x4 __attribute__((ext_vector_type(4)));
typedef unsigned u32x2 __attribute__((ext_vector_type(2)));
constexpr int SLOT = 8192, NSLOT = 4, LDS_K = 0, LDS_V = NSLOT * SLOT, LDS_SCR = 2 * NSLOT * SLOT;
constexpr float THR = 8.f;
__device__ __forceinline__ int crow(int r, int hi) { return (r & 3) + 8 * (r >> 2) + 4 * hi; }
__device__ __forceinline__ unsigned cvtpk(float lo, float hi) { return cvtpk_rne(lo, hi); }
__device__ __forceinline__ float xhalf_max(float v) { return fmaxf(v, __shfl_xor(v, 32)); }
}
__device__ __forceinline__ void attn_unit(KP kp, int l, int b, int h, int qt, LAS unsigned char* lds, float lam, float lam_init, int tid) {
    using namespace att;
    const int lane = tid & 63, wid = __builtin_amdgcn_readfirstlane(tid >> 6), q32 = lane & 31, hi = lane >> 5;
    const int t0 = qt < 0 ? 64 : 0, t1 = ATT_NT;
    const int rowbase = (qt < 0 ? NLAT + b * CTXL : b * SEQ + qt * 256) + wid * 32;
    const unsigned char* kimg = WSP(unsigned char, WS_KIMG) + (size_t)(b * 4 + h) * ATT_NT * 8192 + wid * 1024 + lane * 16;
    const unsigned char* vimg = WSP(unsigned char, WS_VIMG) + (size_t)(b * 4 + h) * ATT_NT * 8192 + wid * 1024 + lane * 16;
    LAS float* scr = (LAS float*)(lds + LDS_SCR) + wid * 64;
#define ATT_DMA(t, slot) do { __builtin_amdgcn_global_load_lds((const unsigned*)(kimg + (size_t)(t) * 8192), (LAS unsigned*)(lds + LDS_K + (slot) * SLOT + wid * 1024), 16, 0, 0); \
                              __builtin_amdgcn_global_load_lds((const unsigned*)(vimg + (size_t)(t) * 8192), (LAS unsigned*)(lds + LDS_V + (slot) * SLOT + wid * 1024), 16, 0, 0); } while (0)
    bf16x8 qf[2][2];
    { const bf16_t* qp = WSP(bf16_t, WS_QRP) + (size_t)(rowbase + q32) * 256 + h * 64 + hi * 8;
#pragma unroll
      for (int m = 0; m < 2; ++m)
#pragma unroll
        for (int ks = 0; ks < 2; ++ks) qf[m][ks] = *(const bf16x8*)(qp + m * 32 + ks * 16); }
    asm volatile("s_waitcnt vmcnt(0)" ::: "memory");
    __builtin_amdgcn_s_barrier();
    ATT_DMA(t0, 0); ATT_DMA(t0 + 1, 1); ATT_DMA(t0 + 2, 2);
    asm volatile("s_waitcnt vmcnt(4)" ::: "memory");
    __builtin_amdgcn_s_barrier();
    f32x16 O[2][2];
#pragma unroll
    for (int m = 0; m < 2; ++m)
#pragma unroll
        for (int dh = 0; dh < 2; ++dh)
#pragma unroll
            for (int r = 0; r < 16; ++r) O[m][dh][r] = 0.f;
    float mref[2] = {0.f, 0.f}, lsum[2] = {0.f, 0.f};
    const int koff = q32 * 128, ksw = (q32 >> 1) & 7;
    int slot = 0;
#pragma unroll 1
    for (int t = t0; t < t1; ++t) {
        asm volatile("s_waitcnt vmcnt(0)" ::: "memory");
        __builtin_amdgcn_s_barrier();
        asm volatile("" ::: "memory");
        if (t + 3 < t1) { const int s3 = (slot + 3) & 3; ATT_DMA(t + 3, s3); }
        const LAS unsigned char* Ks = lds + LDS_K + slot * SLOT; const LAS unsigned char* Vs = lds + LDS_V + slot * SLOT;
        u32x4 ppk[2][2][2];
#pragma unroll
        for (int m = 0; m < 2; ++m) {
            f32x16 S[2];
            { const float nm = -mref[m];
#pragma unroll
              for (int r = 0; r < 16; ++r) { S[0][r] = nm; S[1][r] = nm; } }
#pragma unroll
            for (int kh = 0; kh < 2; ++kh)
#pragma unroll
                for (int ks = 0; ks < 2; ++ks) {
                    const bf16x8 kf = *(const LAS bf16x8*)(Ks + kh * 4096 + koff + 16 * ((m * 4 + ks * 2 + hi) ^ ksw));
                    S[kh] = __builtin_amdgcn_mfma_f32_32x32x16_bf16(kf, qf[m][ks], S[kh], 0, 0, 0);
                }
            float mx = fmaxf(S[0][0], S[1][0]);
#pragma unroll
            for (int r = 1; r < 16; ++r) mx = fmaxf(mx, fmaxf(S[0][r], S[1][r]));
            mx = xhalf_max(mx);
            const bool first = (t == t0);
            if (__any(first || mx > THR)) {
                const float dl = first ? mx : fmaxf(mx, 0.f);
                mref[m] += dl;
#pragma unroll
                for (int r = 0; r < 16; ++r) { S[0][r] -= dl; S[1][r] -= dl; }
                const float f = __builtin_amdgcn_exp2f(-dl);
                lsum[m] *= f;
                if (!first) {
                    if (hi == 0) scr[q32] = f;
                    asm volatile("s_waitcnt lgkmcnt(0)" ::: "memory");
#pragma unroll
                    for (int r = 0; r < 16; ++r) { const float fr = scr[crow(r, hi)]; O[m][0][r] *= fr; O[m][1][r] *= fr; }
                    asm volatile("s_waitcnt lgkmcnt(0)" ::: "memory");
                }
            }
            float ls = 0.f;
#pragma unroll
            for (int kh = 0; kh < 2; ++kh) {
#pragma unroll
                for (int r = 0; r < 16; ++r) { S[kh][r] = __builtin_amdgcn_exp2f(S[kh][r]); ls += S[kh][r]; }
#pragma unroll
                for (int s = 0; s < 2; ++s)
#pragma unroll
                    for (int j = 0; j < 4; ++j) ppk[m][kh][s][j] = cvtpk(S[kh][8 * s + 2 * j], S[kh][8 * s + 2 * j + 1]);
            }
            lsum[m] += ls;
        }
#pragma unroll
        for (int kh = 0; kh < 2; ++kh)
#pragma unroll
            for (int s = 0; s < 2; ++s)
#pragma unroll
                for (int dh = 0; dh < 2; ++dh) {
                    const int d = dh * 32 + q32, kc = 8 * kh + 4 * s + hi, vsw = (d >> 1) & 15;
                    const u32x2 v0 = *(const LAS u32x2*)(Vs + d * 128 + 8 * (kc ^ vsw)), v1 = *(const LAS u32x2*)(Vs + d * 128 + 8 * ((kc + 2) ^ vsw));
                    const u32x4 vv = (u32x4){v0.x, v0.y, v1.x, v1.y};
                    const bf16x8 vf = __builtin_bit_cast(bf16x8, vv);
#pragma unroll
                    for (int m = 0; m < 2; ++m) O[m][dh] = __builtin_amdgcn_mfma_f32_32x32x16_bf16(__builtin_bit_cast(bf16x8, ppk[m][kh][s]), vf, O[m][dh], 0, 0, 0);
                }
        asm volatile("s_waitcnt lgkmcnt(0)" ::: "memory");
        slot = (slot + 1) & 3;
    }
#undef ATT_DMA
    float il[2][16];
#pragma unroll
    for (int m = 0; m < 2; ++m) { const float lt = lsum[m] + __shfl_xor(lsum[m], 32); if (hi == 0) scr[m * 32 + q32] = 1.f / lt; }
    asm volatile("s_waitcnt lgkmcnt(0)" ::: "memory");
#pragma unroll
    for (int m = 0; m < 2; ++m)
#pragma unroll
        for (int r = 0; r < 16; ++r) il[m][r] = scr[m * 32 + crow(r, hi)];
    asm volatile("s_waitcnt lgkmcnt(0)" ::: "memory");
    const float g0 = p.diff_subln_g[l * 64 + q32] * (1.f - lam_init), g1 = p.diff_subln_g[l * 64 + 32 + q32] * (1.f - lam_init);
    bf16_t* outp = WSP(bf16_t, WS_CONCAT) + (size_t)rowbase * D + h * 64 + q32;
#pragma unroll
    for (int r = 0; r < 16; ++r) {
        const float o0 = O[0][0][r] * il[0][r] - lam * O[1][0][r] * il[1][r], o1 = O[0][1][r] * il[0][r] - lam * O[1][1][r] * il[1][r];
        float ss = o0 * o0 + o1 * o1;
#pragma unroll
        for (int x = 1; x < 32; x <<= 1) ss += __shfl_xor(ss, x);
        const float rstd = rsqrtf(ss * (1.f / 64.f) + EPS);
        bf16_t* op = outp + (size_t)crow(r, hi) * D;
        op[0] = f2bf(o0 * rstd * g0); op[32] = f2bf(o1 * rstd * g1);
    }
}
__device__ __forceinline__ void d_attn_fast(KP kp, int l, LAS unsigned char* lds) {
    PH_IDS;
    const float* dl = p.diff_lambda + l * 4 * 32;
    float s1 = 0.f, s2 = 0.f;
    for (int i = 0; i < 32; ++i) { s1 += dl[i] * dl[32 + i]; s2 += dl[64 + i] * dl[96 + i]; }
    const float lam_init = 0.8f - 0.6f * expf(-0.3f * (float)l);
    const float lam = expf(s1) - expf(s2) + lam_init;
    const int G = gridDim.x, vb = (G % 8 == 0) ? (bid % 8) * (G / 8) + bid / 8 : bid;
    const int nunits = 256 + (l == 0 ? 16 : 0);
    for (int u = vb; u < nunits; u += G) {
        if (u < 256) attn_unit(kp, l, u >> 6, (u >> 4) & 3, u & 15, lds, lam, lam_init, tid);
        else attn_unit(kp, l, (u - 256) >> 2, (u - 256) & 3, -1, lds, lam, lam_init, tid);
    }
    __syncthreads();
}

constexpr int NCHUNK = MALL / 64;
__device__ __forceinline__ float logsig16(float x) { const float y = __builtin_amdgcn_exp2f(-fabsf(x) * 1.4426950408889634f); return (fminf(x, 0.f) - __builtin_amdgcn_logf(1.f + y) * 0.6931471805599453f) * (1.f / 16.f); }
__device__ __forceinline__ void d_prep_scan(KP kp) {
    PH_IDS;
    const bf16_t* PB = WSP(bf16_t, WS_PBUF);
    GT_LOOP(idx, 8 * MALL) {
        const int row = idx % MALL, hk = idx / MALL, h = hk >> 1, ks = hk & 1;
        const bool lat = row < NLAT; const int t = row & (SEQ - 1);
        const int ipos = lat ? (ks == 0 ? (t >> 6) : (t & 63)) : 0;
        const int cb = h * 64 + ks * 32;
        const pg8::u32x4* qs = (const pg8::u32x4*)(PB + (size_t)row * PW + PC_RQ + cb);
        const pg8::u32x4* ksrc = (const pg8::u32x4*)(PB + (size_t)row * PW + PC_RK + cb);
        float qv[32], kv[32];
#pragma unroll
        for (int c4 = 0; c4 < 4; ++c4) { const pg8::u32x4 a = qs[c4], b4 = ksrc[c4];
#pragma unroll
            for (int j = 0; j < 4; ++j) { qv[c4 * 8 + 2 * j] = bf2f((bf16_t)(a[j] & 0xffff)); qv[c4 * 8 + 2 * j + 1] = bf2f((bf16_t)(a[j] >> 16)); kv[c4 * 8 + 2 * j] = bf2f((bf16_t)(b4[j] & 0xffff)); kv[c4 * 8 + 2 * j + 1] = bf2f((bf16_t)(b4[j] >> 16)); } }
        float qo[32], ko[32];
#pragma unroll
        for (int j = 0; j < 16; ++j) {
            const float* tb = WSP(float, WS_ROPE) + 1024 + (ipos * 16 + j) * 2; const float cs = tb[0], sn = tb[1];
            qo[j] = qv[j] * cs - qv[j + 16] * sn; qo[j + 16] = qv[j + 16] * cs + qv[j] * sn;
            ko[j] = (kv[j] * cs - kv[j + 16] * sn) * 0.125f; ko[j + 16] = (kv[j + 16] * cs + kv[j] * sn) * 0.125f;
        }
        pg8::u32x4* qd = (pg8::u32x4*)(WSP(bf16_t, WS_QF_R) + (size_t)row * 256 + cb); pg8::u32x4* kd = (pg8::u32x4*)(WSP(bf16_t, WS_KF_R) + (size_t)row * 256 + cb);
#pragma unroll
        for (int c4 = 0; c4 < 4; ++c4) { pg8::u32x4 a, b4;
#pragma unroll
            for (int j = 0; j < 4; ++j) { a[j] = pk2(qo[c4 * 8 + 2 * j], qo[c4 * 8 + 2 * j + 1]); b4[j] = pk2(ko[c4 * 8 + 2 * j], ko[c4 * 8 + 2 * j + 1]); }
            qd[c4] = a; kd[c4] = b4; }
        bf16_t* kt = WSP(bf16_t, WS_KT_R) + ((size_t)((row >> 6) * 4 + h) * 64 + ks * 32) * 64 + (row & 63);
#pragma unroll
        for (int i = 0; i < 32; ++i) kt[(size_t)i * 64] = f2bf(ko[i]);
    }
    GT_LOOP(idx, 4 * MALL) {
        const int row = idx % MALL, h = idx / MALL;
        const pg8::u32x4* ksrc = (const pg8::u32x4*)(PB + (size_t)row * PW + PC_GK + h * 32);
        bf16_t* kt = WSP(bf16_t, WS_KT_G) + ((size_t)((row >> 6) * 4 + h) * 32) * 64 + (row & 63);
#pragma unroll
        for (int c4 = 0; c4 < 4; ++c4) { const pg8::u32x4 a = ksrc[c4];
#pragma unroll
            for (int j = 0; j < 4; ++j) { kt[(size_t)(c4 * 8 + 2 * j) * 64] = (bf16_t)(a[j] & 0xffff); kt[(size_t)(c4 * 8 + 2 * j + 1) * 64] = (bf16_t)(a[j] >> 16); } }
    }
    GT_LOOP(idx, NCHUNK * 2 * 128) {
        const int hk = idx & 127, dir = (idx >> 7) & 1, cid = idx >> 8;
        const bf16_t* src = PB + (size_t)(cid * 64) * PW + PC_GD + dir * 128 + hk;
        float* cum = WSP(float, WS_CUM_G) + ((size_t)dir * MALL + cid * 64) * 128 + hk;
        float* cumt = WSP(float, WS_CUMT_G) + (((size_t)dir * NCHUNK + cid) * 128 + hk) * 64;
        float v[64];
#pragma unroll
        for (int j = 0; j < 64; ++j) v[j] = bf2f(src[(size_t)j * PW]);
#pragma unroll
        for (int j = 0; j < 64; ++j) v[j] = logsig16(v[j]);
        if (dir == 0) {
#pragma unroll
            for (int j = 1; j < 64; ++j) v[j] += v[j - 1];
        } else {
#pragma unroll
            for (int j = 62; j >= 0; --j) v[j] += v[j + 1];
        }
#pragma unroll
        for (int j = 0; j < 64; ++j) cum[(size_t)j * 128] = v[j];
#pragma unroll
        for (int j = 0; j < 16; ++j) *(pg8::f32x4*)(cumt + 4 * j) = (pg8::f32x4){v[4 * j], v[4 * j + 1], v[4 * j + 2], v[4 * j + 3]};
    }
    GT_LOOP(idx, 2 * NCHUNK * 4 * 2 * 64) {
        const int d = idx & 63, half = (idx >> 6) & 1, ch = (idx >> 7) % (NCHUNK * 4), mx = idx / (128 * NCHUNK * 4), h = ch & 3, cid = ch >> 2;
        const bf16_t* vp = PB + (size_t)(cid * 64 + half * 32) * PW + (mx == 0 ? PC_RV : PC_GV) + h * 64 + d;
        unsigned short vv[32];
#pragma unroll
        for (int j = 0; j < 32; ++j) vv[j] = vp[(size_t)j * PW];
        unsigned char* img = WSP(unsigned char, mx == 0 ? WS_VT_R : WS_VT_G) + (size_t)ch * 8192 + d * 128; const int x = (d >> 1) & 15;
#pragma unroll
        for (int j = 0; j < 8; ++j) *(pg8::u32x2*)(img + 8 * ((half * 8 + j) ^ x)) = (pg8::u32x2){(unsigned)vv[4 * j] | ((unsigned)vv[4 * j + 1] << 16), (unsigned)vv[4 * j + 2] | ((unsigned)vv[4 * j + 3] << 16)};
    }
}

namespace scn {
typedef short bf16x8 __attribute__((ext_vector_type(8)));
typedef float f32x16 __attribute__((ext_vector_type(16)));
typedef float f32x4 __attribute__((ext_vector_type(4)));
typedef unsigned u32x4 __attribute__((ext_vector_type(4)));
typedef unsigned u32x2 __attribute__((ext_vector_type(2)));
__device__ __forceinline__ int crow(int r, int hi) { return (r & 3) + 8 * (r >> 2) + 4 * hi; }
__device__ __forceinline__ unsigned cvtpk(float lo, float hi) { return cvtpk_rne(lo, hi); }
__device__ __forceinline__ float blo(unsigned w) { return __uint_as_float(w << 16); }
__device__ __forceinline__ float bhi(unsigned w) { return __uint_as_float(w & 0xffff0000u); }
__device__ __forceinline__ bf16x8 scale8(u32x4 raw, const float (&f)[8]) {
    u32x4 o;
#pragma unroll
    for (int j = 0; j < 4; ++j) o[j] = cvtpk(blo(raw[j]) * f[2 * j], bhi(raw[j]) * f[2 * j + 1]);
    return __builtin_bit_cast(bf16x8, o);
}
template <int MX> struct Cfg;
template <> struct Cfg<0> { static constexpr int DK = 64; };
template <> struct Cfg<1> { static constexpr int DK = 32; };
}
#define SCN_EXP(x) __builtin_amdgcn_exp2f((x) * 1.4426950408889634f)
template <int MX> __device__ __forceinline__ void scan_stage1_unit(KP kp, int l, int b, int h, int g, int tid) {
    using namespace scn;
    constexpr int DK = Cfg<MX>::DK, NKT = DK / 32, NE = DK * 64 / NT;
    const int lane = tid & 63, wid = __builtin_amdgcn_readfirstlane(tid >> 6), q32 = lane & 31, hi = lane >> 5;
    const int nch = g == 8 ? 4 : 8, cid0 = g == 8 ? 256 + 4 * b : b * 64 + 8 * g;
    float* US = WSP(float, MX == 0 ? WS_US_R : WS_US_G);
    const float* CUMT = WSP(float, WS_CUMT_G);
    if (wid < nch) {
        const int cid = cid0 + wid;
        const unsigned char* vimg = WSP(unsigned char, MX == 0 ? WS_VT_R : WS_VT_G) + (size_t)(cid * 4 + h) * 8192;
        const bf16_t* ktimg = WSP(bf16_t, MX == 0 ? WS_KT_R : WS_KT_G) + (size_t)(cid * 4 + h) * DK * 64;
        bf16x8 vb[2][4];
#pragma unroll
        for (int dh = 0; dh < 2; ++dh)
#pragma unroll
            for (int s = 0; s < 4; ++s) { const int d = dh * 32 + q32, x = (d >> 1) & 15, kc = 4 * s + 2 * hi;
                u32x4 v = *(const u32x4*)(vimg + d * 128 + 16 * ((kc ^ x) >> 1));
                if (x & 1) v = (u32x4){v.z, v.w, v.x, v.y};
                vb[dh][s] = __builtin_bit_cast(bf16x8, v); }
#pragma unroll 1
        for (int dir = 0; dir < 2; ++dir) {
            float lg = 0.f; if (MX == 0) lg = -expf(p.ret_decay[(l * 2 + dir) * 4 + h]);
#pragma unroll 1
            for (int kt = 0; kt < NKT; ++kt) {
                f32x16 U[2];
#pragma unroll
                for (int dh = 0; dh < 2; ++dh)
#pragma unroll
                    for (int r = 0; r < 16; ++r) U[dh][r] = 0.f;
                const int k = kt * 32 + q32;
                const float* ct = CUMT + (((size_t)dir * NCHUNK + cid) * 128 + h * 32 + (k & 31)) * 64;
                float E = 0.f; if (MX == 1) E = ct[dir == 0 ? 63 : 0];
#pragma unroll
                for (int s = 0; s < 4; ++s) {
                    const int j0 = 16 * s + 8 * hi;
                    const u32x4 raw = *(const u32x4*)(ktimg + (size_t)k * 64 + j0);
                    float f[8];
                    if (MX == 0) {
#pragma unroll
                        for (int jj = 0; jj < 8; ++jj) f[jj] = SCN_EXP(lg * (float)(dir == 0 ? 63 - (j0 + jj) : j0 + jj));
                    } else {
                        const f32x4 c0 = *(const f32x4*)(ct + j0), c1 = *(const f32x4*)(ct + j0 + 4);
#pragma unroll
                        for (int jj = 0; jj < 4; ++jj) { f[jj] = SCN_EXP(E - c0[jj]); f[4 + jj] = SCN_EXP(E - c1[jj]); }
                    }
                    const bf16x8 af = scale8(raw, f);
#pragma unroll
                    for (int dh = 0; dh < 2; ++dh) U[dh] = __builtin_amdgcn_mfma_f32_32x32x16_bf16(af, vb[dh][s], U[dh], 0, 0, 0);
                }
                float* up = US + ((((size_t)dir * NCHUNK + cid) * 4 + h) * DK + kt * 32 + 4 * hi) * 64 + q32;
#pragma unroll
                for (int dh = 0; dh < 2; ++dh)
#pragma unroll
                    for (int r = 0; r < 16; ++r) up[((r & 3) + 8 * (r >> 2)) * 64 + dh * 32] = U[dh][r];
            }
        }
    }
    asm volatile("s_waitcnt vmcnt(0)" ::: "memory");
    __syncthreads();
    const int k = (tid * NE) >> 6, d0 = (tid * NE) & 63;
#pragma unroll
    for (int dir = 0; dir < 2; ++dir) {
        float S[NE], Ap = 1.f;
#pragma unroll
        for (int e = 0; e < NE; ++e) S[e] = 0.f;
        float lg = 0.f; if (MX == 0) lg = -expf(p.ret_decay[(l * 2 + dir) * 4 + h]);
        for (int cc = 0; cc < nch; ++cc) {
            const int c = dir == 0 ? cc : nch - 1 - cc, cid = cid0 + c;
            float A;
            if (MX == 0) A = SCN_EXP(lg * 64.f); else A = SCN_EXP(CUMT[(((size_t)dir * NCHUNK + cid) * 128 + h * 32 + k) * 64 + (dir == 0 ? 63 : 0)]);
            const float* up = US + ((((size_t)dir * NCHUNK + cid) * 4 + h) * DK + k) * 64 + d0;
#pragma unroll
            for (int e = 0; e < NE; ++e) S[e] = A * S[e] + up[e];
            Ap *= A;
        }
        float* ug = WSP(float, MX == 0 ? WS_UG_R : WS_UG_G) + (((((size_t)dir * 4 + b) * 4 + h) * 9 + g) * DK + k) * 64 + d0;
#pragma unroll
        for (int e = 0; e < NE; ++e) ug[e] = S[e];
        if (d0 == 0) WSP(float, WS_AG)[((((MX * 2 + dir) * 4 + b) * 4 + h) * 9 + g) * 64 + k] = Ap;
    }
}
template <int MX> __device__ __forceinline__ void scan_stage2_unit(KP kp, int l, int b, int h, int g, LAS unsigned char* lds, int tid) {
    using namespace scn;
    constexpr int DK = Cfg<MX>::DK, NKS = DK / 16, NE = DK * 64 / NT, NCH16 = DK / 8;
    const int lane = tid & 63, wid = __builtin_amdgcn_readfirstlane(tid >> 6), q32 = lane & 31, hi = lane >> 5;
    const int nch = g == 8 ? 4 : 8, cid0 = g == 8 ? 256 + 4 * b : b * 64 + 8 * g;
    const bool act = wid < nch;
    const int cid = cid0 + (act ? wid : 0), row0 = cid * 64;
    const bf16_t* PB = WSP(bf16_t, WS_PBUF);
    const float* US = WSP(float, MX == 0 ? WS_US_R : WS_US_G);
    const float* UG = WSP(float, MX == 0 ? WS_UG_R : WS_UG_G);
    const float* CUMT = WSP(float, WS_CUMT_G);
    f32x16 o[2][2];
#pragma unroll
    for (int it = 0; it < 2; ++it)
#pragma unroll
        for (int dh = 0; dh < 2; ++dh)
#pragma unroll
            for (int r = 0; r < 16; ++r) o[it][dh][r] = 0.f;
    LAS unsigned char* myv = lds + 65536 + wid * 8192;
    { const unsigned char* vimg = WSP(unsigned char, MX == 0 ? WS_VT_R : WS_VT_G) + (size_t)(cid * 4 + h) * 8192 + lane * 16;
      u32x4 tmp[8];
#pragma unroll
      for (int i = 0; i < 8; ++i) tmp[i] = *(const u32x4*)(vimg + i * 1024);
#pragma unroll
      for (int i = 0; i < 8; ++i) *(LAS u32x4*)(myv + i * 1024 + lane * 16) = tmp[i]; }
    const int fk = (tid * NE) >> 6, fd0 = (tid * NE) & 63;
#pragma unroll 1
    for (int dir = 0; dir < 2; ++dir) {
        float lg = 0.f; if (MX == 0) lg = -expf(p.ret_decay[(l * 2 + dir) * 4 + h]);
        float S[NE];
#pragma unroll
        for (int e = 0; e < NE; ++e) S[e] = 0.f;
        if (g != 8) {
            const float* ugb = UG + (((size_t)dir * 4 + b) * 4 + h) * 9 * DK * 64 + (size_t)fk * 64 + fd0;
            const float* agb = WSP(float, WS_AG) + (((MX * 2 + dir) * 4 + b) * 4 + h) * 9 * 64 + fk;
            const int ng = dir == 0 ? g : 7 - g;
            float ug[7][NE], ag[7];
#pragma unroll
            for (int e = 0; e < NE; ++e) S[e] = ugb[(size_t)8 * DK * 64 + e];
#pragma unroll
            for (int q = 0; q < 7; ++q) { const bool on = q < ng; const int qq = on ? q : 0, gg = dir == 0 ? qq : 7 - qq; const float av = agb[gg * 64]; ag[q] = on ? av : 1.f;
#pragma unroll
                for (int e = 0; e < NE; ++e) { const float uv = ugb[(size_t)gg * DK * 64 + e]; ug[q][e] = on ? uv : 0.f; } }
#pragma unroll
            for (int q = 0; q < 7; ++q)
#pragma unroll
                for (int e = 0; e < NE; ++e) S[e] = ag[q] * S[e] + ug[q][e];
        }
        {
            float uc[8][NE], ac[8];
#pragma unroll
            for (int cc = 0; cc < 8; ++cc) { const bool on = cc < nch; const int c = dir == 0 ? cc : nch - 1 - cc, ccid = cid0 + (on ? c : 0);
                if (MX == 0) ac[cc] = SCN_EXP(lg * 64.f); else ac[cc] = SCN_EXP(CUMT[(((size_t)dir * NCHUNK + ccid) * 128 + h * 32 + fk) * 64 + (dir == 0 ? 63 : 0)]);
                const float* up = US + ((((size_t)dir * NCHUNK + ccid) * 4 + h) * DK + fk) * 64 + fd0;
#pragma unroll
                for (int e = 0; e < NE; ++e) uc[cc][e] = up[e]; }
#pragma unroll
            for (int cc = 0; cc < 8; ++cc) if (cc < nch) {
                const int c = dir == 0 ? cc : nch - 1 - cc;
                LAS unsigned char* area = lds + c * 8192;
#pragma unroll
                for (int e = 0; e < NE; ++e) { const int d = fd0 + e; const int sw = DK == 64 ? ((d >> 1) & 7) : ((d >> 2) & 3);
                    *(LAS bf16_t*)(area + d * (DK * 2) + 16 * ((fk >> 3) ^ sw) + (fk & 7) * 2) = f2bf(S[e]); }
#pragma unroll
                for (int e = 0; e < NE; ++e) S[e] = ac[cc] * S[e] + uc[cc][e];
            }
        }
        asm volatile("s_waitcnt lgkmcnt(0)" ::: "memory");
        __syncthreads();
        if (act) {
#define SCN_GEN(dst, ISQ, T2) do { const int il_ = 32 * (T2) + q32, row_ = row0 + il_; \
                _Pragma("unroll") for (int ks = 0; ks < NKS; ++ks) { const int kc0 = 16 * ks + 8 * hi; u32x4 raw_; float f_[8]; \
                    if (MX == 0) { raw_ = *(const u32x4*)(WSP(bf16_t, (ISQ) ? WS_QF_R : WS_KF_R) + (size_t)row_ * 256 + h * 64 + kc0); \
                        const float cm_ = lg * (float)(dir == 0 ? il_ + 1 : 64 - il_), e_ = SCN_EXP((ISQ) ? cm_ : -cm_); \
                        _Pragma("unroll") for (int jj = 0; jj < 8; ++jj) f_[jj] = e_; \
                    } else { raw_ = *(const u32x4*)(PB + (size_t)row_ * PW + ((ISQ) ? PC_GQ : PC_GK) + h * 32 + kc0); \
                        const float* cp_ = WSP(float, WS_CUM_G) + ((size_t)dir * MALL + row_) * 128 + h * 32 + kc0; \
                        const f32x4 c0_ = *(const f32x4*)cp_, c1_ = *(const f32x4*)(cp_ + 4); \
                        _Pragma("unroll") for (int jj = 0; jj < 4; ++jj) { f_[jj] = (ISQ) ? SCN_EXP(c0_[jj]) * 0.17677669529663687f : SCN_EXP(-c0_[jj]); f_[4 + jj] = (ISQ) ? SCN_EXP(c1_[jj]) * 0.17677669529663687f : SCN_EXP(-c1_[jj]); } } \
                    dst[ks] = scale8(raw_, f_); } } while (0)
#define SCN_TILE(JT, IT, MASKED) do { bf16x8 kf_[NKS]; SCN_GEN(kf_, false, JT); f32x16 P; \
                _Pragma("unroll") for (int r = 0; r < 16; ++r) P[r] = 0.f; \
                _Pragma("unroll") for (int ks = 0; ks < NKS; ++ks) P = __builtin_amdgcn_mfma_f32_32x32x16_bf16(kf_[ks], qf[ks], P, 0, 0, 0); \
                if (MASKED) { _Pragma("unroll") for (int r = 0; r < 16; ++r) { const int j = crow(r, hi); const bool keep = dir == 0 ? (j <= q32) : (j >= q32); P[r] = keep ? P[r] : 0.f; } } \
                _Pragma("unroll") for (int s = 0; s < 2; ++s) { u32x4 pk; \
                    _Pragma("unroll") for (int j = 0; j < 4; ++j) pk[j] = cvtpk(P[8 * s + 2 * j], P[8 * s + 2 * j + 1]); \
                    _Pragma("unroll") for (int dh = 0; dh < 2; ++dh) { const int d = dh * 32 + q32, x = (d >> 1) & 15, kc = 8 * JT + 4 * s + hi; \
                        const u32x2 v0 = *(const LAS u32x2*)(myv + d * 128 + 8 * (kc ^ x)), v1 = *(const LAS u32x2*)(myv + d * 128 + 8 * ((kc + 2) ^ x)); \
                        o[IT][dh] = __builtin_amdgcn_mfma_f32_32x32x16_bf16(__builtin_bit_cast(bf16x8, pk), __builtin_bit_cast(bf16x8, (u32x4){v0.x, v0.y, v1.x, v1.y}), o[IT][dh], 0, 0, 0); } } } while (0)
#define SCN_INTER(IT) do { const LAS unsigned char* area = lds + wid * 8192; \
                _Pragma("unroll") for (int dh = 0; dh < 2; ++dh) _Pragma("unroll") for (int ks = 0; ks < NKS; ++ks) { \
                    const int d = dh * 32 + q32, sw = DK == 64 ? ((d >> 1) & 7) : ((d >> 2) & 3); \
                    const bf16x8 sf = *(const LAS bf16x8*)(area + d * (DK * 2) + 16 * ((2 * ks + hi) ^ sw)); \
                    o[IT][dh] = __builtin_amdgcn_mfma_f32_32x32x16_bf16(qf[ks], sf, o[IT][dh], 0, 0, 0); } } while (0)
            { bf16x8 qf[NKS]; SCN_GEN(qf, true, 0);
              SCN_TILE(0, 0, true); if (dir == 1) SCN_TILE(1, 0, false);
              SCN_INTER(0); }
            asm volatile("" ::: "memory");
            { bf16x8 qf[NKS]; SCN_GEN(qf, true, 1);
              if (dir == 0) SCN_TILE(0, 1, false);
              SCN_TILE(1, 1, true);
              SCN_INTER(1); }
#undef SCN_GEN
#undef SCN_TILE
#undef SCN_INTER
        }
        asm volatile("s_waitcnt lgkmcnt(0)" ::: "memory");
        __syncthreads();
    }
    if (act) {
        const int gcol = (MX == 0 ? PC_RG : PC_GR) + h * 64, ccol = (MX == 0 ? 512 : 768) + h * 64;
        const float g0 = MX == 0 ? p.ret_norm_g[l * 256 + h * 64 + q32] : p.gla_norm_g[l * 64 + q32], g1 = MX == 0 ? p.ret_norm_g[l * 256 + h * 64 + 32 + q32] : p.gla_norm_g[l * 64 + 32 + q32];
#pragma unroll
        for (int it = 0; it < 2; ++it)
#pragma unroll
            for (int r = 0; r < 16; ++r) {
                const int row = row0 + 32 * it + crow(r, hi);
                const float a0 = o[it][0][r], a1 = o[it][1][r];
                float ss = a0 * a0 + a1 * a1;
#pragma unroll
                for (int x = 1; x < 32; x <<= 1) ss += __shfl_xor(ss, x);
                const float rstd = rsqrtf(ss * (1.f / 64.f) + EPS);
                const float gt0 = bf2f(PB[(size_t)row * PW + gcol + q32]), gt1 = bf2f(PB[(size_t)row * PW + gcol + 32 + q32]);
                bf16_t* op = WSP(bf16_t, WS_CONCAT) + (size_t)row * D + ccol + q32;
                op[0] = f2bf(a0 * rstd * g0 * (gt0 / (1.f + SCN_EXP(-gt0)))); op[32] = f2bf(a1 * rstd * g1 * (gt1 / (1.f + SCN_EXP(-gt1))));
                if ((r & 3) == 3) asm volatile("" ::: "memory");
            }
    }
}
__device__ __forceinline__ bool scan_unit(int slot, bool with_ctx, int& mx, int& bh, int& g) {
    if (slot < 256) { mx = slot >> 7; const int r = slot & 127; bh = r >> 3; g = r & 7; return true; }
    if (!with_ctx) return false;
    const int j = slot - 256 - 128;
    if (j < 0 || j >= 32) return false;
    mx = j >> 4; bh = j & 15; g = 8; return true;
}
__device__ __forceinline__ void d_scan_stage1(KP kp, int l) {
    PH_IDS;
    for (int slot = bid; slot < 512; slot += gridDim.x) {
        int mx, bh, g; if (!scan_unit(slot, true, mx, bh, g)) continue;
        if (mx == 0) scan_stage1_unit<0>(kp, l, bh >> 2, bh & 3, g, tid); else scan_stage1_unit<1>(kp, l, bh >> 2, bh & 3, g, tid);
    }
}
__device__ __forceinline__ void d_scan_stage2(KP kp, int l, LAS unsigned char* lds) {
    PH_IDS;
    for (int slot = bid; slot < 512; slot += gridDim.x) {
        int mx, bh, g; if (!scan_unit(slot, l == 0, mx, bh, g)) continue;
        if (mx == 0) scan_stage2_unit<0>(kp, l, bh >> 2, bh & 3, g, lds, tid); else scan_stage2_unit<1>(kp, l, bh >> 2, bh & 3, g, lds, tid);
    }
}
namespace hfft {
typedef float f2 __attribute__((ext_vector_type(2)));
typedef float f4 __attribute__((ext_vector_type(4)));
constexpr int N = 8192;
__device__ __forceinline__ f2 cmul(f2 a, f2 b) { return (f2){a.x * b.x - a.y * b.y, a.x * b.y + a.y * b.x}; }
__device__ __forceinline__ f2 cmulc(f2 a, f2 b) { return (f2){a.x * b.x + a.y * b.y, a.y * b.x - a.x * b.y}; }
__device__ __forceinline__ f2 tw(float frac) { float sn, cs; sincosf(6.283185307179586f * frac, &sn, &cs); return (f2){cs, -sn}; }
constexpr int TWOFF = 131072 + 64;
__device__ __forceinline__ void tw_build(LAS unsigned char* lds, int tid) { LAS f2* T = (LAS f2*)(lds + TWOFF); for (int k = tid; k < 1024; k += NT) T[k] = tw((float)k * (1.f / 8192.f)); }
__device__ __forceinline__ f2 twk(const LAS f2* T, int k) {
    const f2 a = T[k & 1023]; const float r = 0.70710678118654752f;
    return (k & 1024) ? (f2){(a.x + a.y) * r, (a.y - a.x) * r} : a;
}
__device__ __forceinline__ f2 mul_mi(f2 a) { return (f2){a.y, -a.x}; }
__device__ __forceinline__ f2 mul_pi(f2 a) { return (f2){-a.y, a.x}; }
template <int LOGD> __device__ __forceinline__ void fwd_pass(LAS f2* buf, int tid) {
    constexpr int Dd = 1 << LOGD;
#pragma unroll
    for (int g = 0; g < 4; ++g) {
        const int u = tid + NT * g, pos = u & (Dd - 1), base = ((u - pos) << 2) + pos;
        const f2 wA = twk((const LAS f2*)((LAS unsigned char*)buf + TWOFF), pos << (11 - LOGD)), wB = cmul(wA, wA);
#pragma unroll
        for (int arr = 0; arr < 2; ++arr) {
            LAS f2* x = buf + arr * N + base;
            const f2 a0 = x[0], a1 = x[Dd], a2 = x[2 * Dd], a3 = x[3 * Dd];
            const f2 b0 = a0 + a2, b2 = cmul(a0 - a2, wA), b1 = a1 + a3, b3 = mul_mi(cmul(a1 - a3, wA));
            x[0] = b0 + b1; x[Dd] = cmul(b0 - b1, wB); x[2 * Dd] = b2 + b3; x[3 * Dd] = cmul(b2 - b3, wB);
        }
    }
    __syncthreads();
}
template <int LOGD> __device__ __forceinline__ void inv_pass(LAS f2* buf, int tid) {
    constexpr int Dd = 1 << LOGD;
#pragma unroll
    for (int g = 0; g < 4; ++g) {
        const int u = tid + NT * g, pos = u & (Dd - 1), base = ((u - pos) << 2) + pos;
        const f2 wA = twk((const LAS f2*)((LAS unsigned char*)buf + TWOFF), pos << (11 - LOGD)), wB = cmul(wA, wA);
#pragma unroll
        for (int arr = 0; arr < 2; ++arr) {
            LAS f2* x = buf + arr * N + base;
            const f2 c0 = x[0], c1 = cmulc(x[Dd], wB), c2 = x[2 * Dd], c3 = cmulc(x[3 * Dd], wB);
            const f2 b0 = c0 + c1, b1 = c0 - c1, b2 = cmulc(c2 + c3, wA), b3 = mul_pi(cmulc(c2 - c3, wA));
            x[0] = b0 + b2; x[2 * Dd] = b0 - b2; x[Dd] = b1 + b3; x[3 * Dd] = b1 - b3;
        }
    }
    __syncthreads();
}
__device__ __forceinline__ void fwd_all(LAS f2* buf, int tid) { fwd_pass<11>(buf, tid); fwd_pass<9>(buf, tid); fwd_pass<7>(buf, tid); fwd_pass<5>(buf, tid); fwd_pass<3>(buf, tid); fwd_pass<1>(buf, tid); }
__device__ __forceinline__ void inv_all(LAS f2* buf, int tid) { inv_pass<1>(buf, tid); inv_pass<3>(buf, tid); inv_pass<5>(buf, tid); inv_pass<7>(buf, tid); inv_pass<9>(buf, tid); inv_pass<11>(buf, tid); }
}
__device__ __forceinline__ void d_fspec(KP kp, LAS unsigned char* lds) {
    PH_IDS;
    using namespace hfft;
    LAS f2* buf = (LAS f2*)lds; LAS float* nrm = (LAS float*)(lds + 131072);
    tw_build(lds, tid);
    for (int u = bid; u < 256; u += gridDim.x) {
        const int l = u >> 7, c0 = (u & 127) * 2;
        const float* filt = WSP(float, WS_FILT) + (size_t)l * 8192 * 256;
        if (tid < 128) {
            const int arr = tid >> 6, ln = tid & 63; float a = 0.f;
#pragma unroll
            for (int q = 0; q < 4; ++q) a += WSP(float, WS_PS)[(size_t)(l * 256 + ln * 4 + q) * 256 + c0 + arr];
            a = wave_sum(a); if (ln == 0) nrm[arr] = a;
        }
        for (int i = tid; i < 2 * N; i += NT) { const int arr = i >> 13, tau = i & (N - 1); buf[i] = (f2){filt[(size_t)tau * 256 + c0 + arr], 0.f}; }
        __syncthreads();
        fwd_all(buf, tid);
        f4* fs = (f4*)(WSP(float, WS_FSPEC) + ((size_t)l * 256 + c0) * 2 * N);
        for (int i = tid; i < N; i += NT) {
            const int arr = i >> 12, j = i & 4095;
            const f4 v = *(const LAS f4*)(buf + arr * N + 2 * j);
            const float sc = 1.f / (8192.f * nrm[arr]), bs = p.hy_bias[l * 256 + c0 + arr] * (1.f / 8192.f);
            fs[(size_t)arr * (N / 2) + j] = (f4){(v.x + v.z) * sc + bs, (v.y + v.w) * sc, (v.x - v.z) * sc + bs, (v.y - v.w) * sc};
        }
        __syncthreads();
    }
}
__device__ __forceinline__ void d_hy_pre_fast(KP kp, int l, LAS unsigned char* lds) {
    PH_IDS;
    LAS float* zt = (LAS float*)lds;
    const bf16_t* PB = WSP(bf16_t, WS_PBUF);
    const int c = tid & 255, half = tid >> 8;
    const float* sw = p.hy_short_w + l * 3 * 768; const float* sb = p.hy_short_b + l * 768;
    float w0[3], w1[3], w2[3], bb[3];
#pragma unroll
    for (int g = 0; g < 3; ++g) { w0[g] = sw[g * 256 + c]; w1[g] = sw[768 + g * 256 + c]; w2[g] = sw[1536 + g * 256 + c]; bb[g] = sb[g * 256 + c]; }
    for (int u = bid; u < NLAT / 64; u += gridDim.x) {
        const int row0 = u * 64 + half * 32, t0 = (u * 64) & (SEQ - 1);
        const int tfirst = t0 + half * 32;
        float xin[3][34];
#pragma unroll
        for (int g = 0; g < 3; ++g) {
            const bf16_t* pp = PB + (size_t)row0 * PW + PC_HY + g * 256 + c;
#pragma unroll
            for (int i = 0; i < 34; ++i) { const int t = tfirst + i - 1, tc = t < 0 ? 0 : (t > SEQ - 1 ? SEQ - 1 : t); const float v = bf2f(pp[(ptrdiff_t)(tc - tfirst) * PW]); xin[g][i] = (t == tc) ? v : 0.f; }
        }
#pragma unroll
        for (int i = 0; i < 32; ++i) {
            float uu[3];
#pragma unroll
            for (int g = 0; g < 3; ++g) uu[g] = bb[g] + w0[g] * xin[g][i] + w1[g] * xin[g][i + 1] + w2[g] * xin[g][i + 2];
            WSP(bf16_t, WS_X0B)[(size_t)(row0 + i) * 256 + c] = f2bf(uu[0]);
            zt[c * 65 + half * 32 + i] = uu[1] * uu[2];
        }
        __syncthreads();
        const int b = (u * 64) >> 12;
        for (int i = tid; i < 256 * 64; i += NT) { const int cc = i >> 6, tl = i & 63; WSP(float, WS_ZT)[((size_t)cc * 4 + b) * SEQ + t0 + tl] = zt[cc * 65 + tl]; }
        __syncthreads();
    }
    if (l == 0) {
        GT_LOOP(idx, NCTX * 256) {
            const int r = idx >> 8, cc = idx & 255, t = r & (CTXL - 1);
            const bf16_t* pp = PB + (size_t)(NLAT + r) * PW + PC_HY + cc;
            float uu[3];
#pragma unroll
            for (int g = 0; g < 3; ++g) { float a = sb[g * 256 + cc] + sw[768 + g * 256 + cc] * bf2f(pp[g * 256]);
                const float pv = bf2f(pp[g * 256 - (t > 0 ? PW : 0)]), nv = bf2f(pp[g * 256 + (t < CTXL - 1 ? PW : 0)]);
                a += sw[g * 256 + cc] * (t > 0 ? pv : 0.f) + sw[1536 + g * 256 + cc] * (t < CTXL - 1 ? nv : 0.f); uu[g] = a; }
            WSP(float, WS_X0C)[idx] = uu[0]; WSP(float, WS_ZC)[idx] = uu[1] * uu[2];
        }
    }
}
__device__ __forceinline__ void d_hy_fft(KP kp, int l, LAS unsigned char* lds) {
    PH_IDS;
    using namespace hfft;
    LAS f2* buf = (LAS f2*)lds;
    tw_build(lds, tid);
    for (int c = bid; c < 256; c += gridDim.x) {
        const float* zt = WSP(float, WS_ZT) + (size_t)c * 4 * SEQ;
#pragma unroll
        for (int arr = 0; arr < 2; ++arr) {
            float re[8], im[8];
#pragma unroll
            for (int i = 0; i < 8; ++i) { re[i] = zt[(size_t)(2 * arr) * SEQ + tid + i * NT]; im[i] = zt[(size_t)(2 * arr + 1) * SEQ + tid + i * NT]; }
#pragma unroll
            for (int i = 0; i < 8; ++i) { buf[arr * N + tid + i * NT] = (f2){re[i], im[i]}; buf[arr * N + SEQ + tid + i * NT] = (f2){0.f, 0.f}; }
        }
        __syncthreads();
        fwd_all(buf, tid);
        const f4* fs = (const f4*)(WSP(float, WS_FSPEC) + ((size_t)l * 256 + c) * 2 * N);
        for (int i = tid; i < N; i += NT) {
            const int arr = i >> 12, j = i & 4095;
            LAS f4* xp = (LAS f4*)(buf + arr * N + 2 * j);
            const f4 v = *xp; const f4 f = fs[j];
            const f2 s = cmul((f2){v.x + v.z, v.y + v.w}, (f2){f.x, f.y}), d = cmul((f2){v.x - v.z, v.y - v.w}, (f2){f.z, f.w});
            *xp = (f4){s.x + d.x, s.y + d.y, s.x - d.x, s.y - d.y};
        }
        __syncthreads();
        inv_all(buf, tid);
        float* yt = WSP(float, WS_YT) + (size_t)c * 4 * SEQ;
        for (int i = tid; i < 2 * SEQ; i += NT) { const int arr = i >> 12, t = i & (SEQ - 1); const f2 v = buf[arr * N + t];
            yt[(size_t)(2 * arr) * SEQ + t] = v.x; yt[(size_t)(2 * arr + 1) * SEQ + t] = v.y; }
        __syncthreads();
    }
}
__device__ __forceinline__ void d_hy_post(KP kp, int l, LAS unsigned char* lds) {
    PH_IDS;
    LAS float* yt = (LAS float*)lds;
    for (int u = bid; u < NLAT / 64; u += gridDim.x) {
        const int b = (u * 64) >> 12, t0 = (u * 64) & (SEQ - 1);
#pragma unroll 1
        for (int hb2 = 0; hb2 < 4; ++hb2) {
            float yv[8];
#pragma unroll
            for (int i = 0; i < 8; ++i) { const int idx = tid + (hb2 * 8 + i) * NT; yv[i] = WSP(float, WS_YT)[((size_t)(idx >> 6) * 4 + b) * SEQ + t0 + (idx & 63)]; }
#pragma unroll
            for (int i = 0; i < 8; ++i) { const int idx = tid + (hb2 * 8 + i) * NT; yt[(idx >> 6) * 65 + (idx & 63)] = yv[i]; }
            asm volatile("" ::: "memory");
        }
        __syncthreads();
        {
            const int c = tid & 255, th = tid >> 8;
#pragma unroll 1
            for (int hb2 = 0; hb2 < 4; ++hb2) {
                float x0v[8];
#pragma unroll
                for (int i = 0; i < 8; ++i) x0v[i] = bf2f(WSP(bf16_t, WS_X0B)[((size_t)u * 64 + 2 * (hb2 * 8 + i) + th) * 256 + c]);
#pragma unroll
                for (int i = 0; i < 8; ++i) { const int tl = 2 * (hb2 * 8 + i) + th; WSP(bf16_t, WS_CONCAT)[((size_t)u * 64 + tl) * D + 256 + c] = f2bf(x0v[i] * yt[c * 65 + tl]); }
                asm volatile("" ::: "memory");
            }
        }
        __syncthreads();
    }
    if (l == 0) {
        GT_LOOP(idx, NCTX * 256) {
            const int c = idx & 255, r = idx >> 8, t = r & (CTXL - 1), rb = r - t;
            const float* filt = WSP(float, WS_FILTC); const float* zc = WSP(float, WS_ZC);
            float nrm = 0.f;
#pragma unroll
            for (int q = 0; q < 16; ++q) nrm += WSP(float, WS_PS)[(size_t)(512 + q) * 256 + c];
            float y = 0.f;
#pragma unroll 32
            for (int s2 = 0; s2 < CTXL; ++s2) y += filt[(size_t)((t - s2) & (2 * CTXL - 1)) * 256 + c] * zc[(size_t)(rb + s2) * 256 + c];
            y = y / nrm + p.hy_bias[c] * zc[idx];
            WSP(bf16_t, WS_CONCAT)[(size_t)(NLAT + r) * D + 256 + c] = f2bf(WSP(float, WS_X0C)[idx] * y);
        }
    }
}
constexpr int CW_BAR = 32768;
__global__ void __launch_bounds__(NT, 2) mk_fwd(P kargs) {
    const KP kp0 = (KP)__builtin_amdgcn_kernarg_segment_ptr();
    KP kp = kp0;
#define LP ({ KP k_ = kp0; asm volatile("" : "+s"(k_)); k_; })
    unsigned char* const lds = g_lds;
    volatile LAS unsigned* misc = (volatile LAS unsigned*)((LAS unsigned char*)lds + LDS_MISC);
    if (threadIdx.x < 16) misc[threadIdx.x] = 0u;
    if ((threadIdx.x & 63) == 0) ((LAS int*)((LAS unsigned char*)lds + LDS_WTAB))[hw_wave_slot()] = threadIdx.x >> 6;
    __syncthreads();
    (void)xcd_barrier_post(WSP(unsigned, WS_CTL) + CW_BAR, misc);
#define GRID_BAR() do { XcdBarrier b_; { KP kp = LP; b_.bar = WSP(unsigned, WS_CTL) + CW_BAR; } b_.x = xb_xcc_id(); b_.st = (volatile LAS unsigned*)((LAS unsigned char*)lds + LDS_MISC); xcd_barrier(b_); } while (0)
    d_pro0(LP, (LAS float*)((LAS unsigned char*)lds + 98304)); d_filter(LP, (LAS float*)((LAS unsigned char*)lds + 73728)); d_convert_a(LP, (LAS float*)lds);
    GRID_BAR();
    d_pro1(LP); d_convert_b(LP, (LAS float*)lds);
    GRID_BAR();
    d_fspec(LP, (LAS unsigned char*)lds); d_norm1(LP, 0);
    GRID_BAR();
#pragma unroll 1
    for (int l = 0; l < DEPTH; ++l) {
        d_gemm_in(LP, l, (LAS unsigned char*)lds);
        GRID_BAR();
        d_prep_scan(LP); d_prep_attn(LP); d_hy_pre_fast(LP, l, (LAS unsigned char*)lds);
        GRID_BAR();
        d_scan_stage1(LP, l);
        d_hy_fft(LP, l, (LAS unsigned char*)lds);
        d_attn_fast(LP, l, (LAS unsigned char*)lds);
        GRID_BAR();
        d_scan_stage2(LP, l, (LAS unsigned char*)lds);
        d_hy_post(LP, l, (LAS unsigned char*)lds);
        GRID_BAR();
        d_gemm_out(LP, l, (LAS unsigned char*)lds);
        GRID_BAR();
        d_router(LP, l, (LAS float*)lds);
        GRID_BAR();
        d_moe_up(LP, l, (LAS unsigned char*)lds);
        GRID_BAR();
        d_moe_down(LP, l, (LAS unsigned char*)lds);
        GRID_BAR();
        d_combine(LP, l, (LAS int*)lds);
        GRID_BAR();
    }
}

#undef p
extern "C" void kernel_launch(void* const* d_in, const int* in_sizes, int n_in, void* d_out, int out_size, void* d_ws, size_t ws_size, hipStream_t stream) {
    if (n_in != 31 || ws_size < WS_END || out_size != NLAT * D) { fprintf(stderr, "kernel_launch: unexpected shapes (n_in %d ws %zu out %d)\n", n_in, ws_size, out_size); return; }
    static int grid = 0;
    if (grid == 0) {
        int dev = 0, cus = 0, per_cu = 0;
        if (hipGetDevice(&dev) != hipSuccess || hipDeviceGetAttribute(&cus, hipDeviceAttributeMultiprocessorCount, dev) != hipSuccess) { grid = -1; return; }
        if (hipFuncSetAttribute((const void*)mk_fwd, hipFuncAttributeMaxDynamicSharedMemorySize, LDS_BYTES) != hipSuccess) { fprintf(stderr, "hipFuncSetAttribute failed\n"); grid = -1; return; }
        if (hipOccupancyMaxActiveBlocksPerMultiprocessor(&per_cu, (const void*)mk_fwd, NT, LDS_BYTES) != hipSuccess || per_cu < 1) { fprintf(stderr, "occupancy query says %d\n", per_cu); }
        (void)hipGetLastError();
        grid = cus;
    }
    if (grid < 0) return;
    P hp{};
    const float** pp = (const float**)&hp;
    for (int i = 0; i < 31; ++i) pp[i] = (const float*)d_in[i];
    hp.out = (float*)d_out; hp.ws = (unsigned char*)d_ws;
    (void)hipMemsetAsync((char*)d_ws + WS_CTL, 0, 1 * MiB, stream);
    hipLaunchKernelGGL(mk_fwd, dim3(grid), dim3(NT), LDS_BYTES, stream, hp);
}
```

```cpp
#include <hip/hip_runtime.h>
#include <stdint.h>
#include <stdio.h>
#include <math.h>

constexpr int D = 1024, BATCH = 4, SEQ = 4096, CTXL = 256, DEPTH = 2;
constexpr int NLAT = BATCH * SEQ, NCTX = BATCH * CTXL, MALL = NLAT + NCTX;
constexpr int INW = 3360, PW = 3584;
constexpr int NEXP = 32, TOPK = 4;
constexpr float EPS = 1e-6f;
constexpr int PC_AQ = 0, PC_AK = 256, PC_AV = 512, PC_HY = 768, PC_RQ = 1536, PC_RK = 1792, PC_RV = 2048, PC_RG = 2304,
              PC_GQ = 2560, PC_GK = 2688, PC_GV = 2816, PC_GR = 3072, PC_GD = 3328;
constexpr int ACT_ROWS = MALL * TOPK + NEXP * 256;

typedef unsigned short bf16_t;
typedef float cvt_f32x2_t __attribute__((ext_vector_type(2))); typedef __bf16 cvt_bf16x2_t __attribute__((ext_vector_type(2)));
__device__ __forceinline__ unsigned cvtpk_rne(float lo, float hi) { cvt_f32x2_t v = {lo, hi}; cvt_bf16x2_t b = __builtin_convertvector(v, cvt_bf16x2_t); return __builtin_bit_cast(unsigned, b); }
__device__ __forceinline__ bf16_t f2bf(float f) { unsigned u = __float_as_uint(f); return (bf16_t)((u + 0x7fffu + ((u >> 16) & 1u)) >> 16); }
__device__ __forceinline__ float bf2f(bf16_t b) { return __uint_as_float(((unsigned)b) << 16); }

typedef unsigned gv4u __attribute__((ext_vector_type(4))); typedef float gv4f __attribute__((ext_vector_type(4)));
__device__ __forceinline__ float gblo(unsigned w) { return __uint_as_float(w << 16); }
__device__ __forceinline__ float gbhi(unsigned w) { return __uint_as_float(w & 0xffff0000u); }
__device__ __forceinline__ unsigned pk4_fp8(float a, float b, float c, float d) { int r = __builtin_amdgcn_cvt_pk_fp8_f32(a, b, 0, false); r = __builtin_amdgcn_cvt_pk_fp8_f32(c, d, r, true); return (unsigned)r; }
constexpr float W8_SCALE = 64.f;
constexpr size_t MiB = 1u << 20;
constexpr size_t WS_CTL = 0;
constexpr size_t WS_MOD = 1 * MiB;
constexpr size_t WS_WEFF = 3 * MiB;
constexpr size_t WS_FILT = 6 * MiB;
constexpr size_t WS_FILTC = WS_FILT + 16 * MiB;
constexpr size_t WS_XRES = 24 * MiB;
constexpr size_t WS_HB = WS_XRES + 68 * MiB;
constexpr size_t WS_PBUF = WS_HB + 34 * MiB;
constexpr size_t WS_CONCAT = WS_PBUF + 120 * MiB;
constexpr size_t WS_YBUF = WS_CONCAT + 34 * MiB;
constexpr size_t WS_QA = WS_YBUF + 68 * MiB;
constexpr size_t WS_KA = WS_QA + 17 * MiB;
constexpr size_t WS_QR = WS_KA + 17 * MiB;
constexpr size_t WS_KR = WS_QR + 17 * MiB;
constexpr size_t WS_OA = WS_KR + 17 * MiB;
constexpr size_t WS_Z = WS_OA + 34 * MiB;
constexpr size_t WS_X0 = WS_Z + 17 * MiB;
constexpr size_t WS_LA = WS_X0 + 17 * MiB;
constexpr size_t WS_OD = WS_LA + 17 * MiB;
constexpr size_t WS_TOPI = WS_OD + 68 * MiB;
constexpr size_t WS_TOPW = WS_TOPI + 1 * MiB;
constexpr size_t WS_LIST = WS_TOPW + 1 * MiB;
constexpr size_t WS_ACT = WS_LIST + 3 * MiB;
constexpr size_t WS_YSLOT = WS_ACT + 160 * MiB;
constexpr size_t WS_WIN_T = WS_YSLOT + 160 * MiB;
constexpr size_t WS_WOUT_T = WS_WIN_T + 14 * MiB;
constexpr size_t WS_W1_T = WS_WOUT_T + 4 * MiB;
constexpr size_t WS_W2_T = WS_W1_T + 256 * MiB;
constexpr size_t WS_BIAS_IN = WS_W2_T + 128 * MiB;
constexpr size_t WS_QRP = WS_BIAS_IN + 1 * MiB;
constexpr size_t WS_KIMG = WS_QRP + 9 * MiB;
constexpr size_t WS_VIMG = WS_KIMG + 9 * MiB;
constexpr size_t WS_QF_R = WS_VIMG + 9 * MiB;
constexpr size_t WS_KF_R = WS_QF_R + 9 * MiB;
constexpr size_t WS_KT_R = WS_KF_R + 9 * MiB;
constexpr size_t WS_KT_G = WS_KT_R + 9 * MiB;
constexpr size_t WS_VT_R = WS_KT_G + 5 * MiB;
constexpr size_t WS_VT_G = WS_VT_R + 9 * MiB;
constexpr size_t WS_CUM_G = WS_VT_G + 9 * MiB;
constexpr size_t WS_CUMT_G = WS_CUM_G + 17 * MiB;
constexpr size_t WS_US_R = WS_CUMT_G + 17 * MiB;
constexpr size_t WS_US_G = WS_US_R + 34 * MiB;
constexpr size_t WS_UG_R = WS_US_G + 17 * MiB;
constexpr size_t WS_UG_G = WS_UG_R + 5 * MiB;
constexpr size_t WS_AG = WS_UG_G + 3 * MiB;
constexpr size_t WS_ROPE = WS_AG + 1 * MiB;
constexpr size_t WS_FSPEC = WS_ROPE + 1 * MiB;
constexpr size_t WS_ZT = WS_FSPEC + 32 * MiB;
constexpr size_t WS_YT = WS_ZT + 16 * MiB;
constexpr size_t WS_X0B = WS_YT + 16 * MiB;
constexpr size_t WS_MODP = WS_X0B + 8 * MiB;
constexpr size_t WS_PS = WS_MODP + 4 * MiB;
constexpr size_t WS_ZC = WS_PS + 1 * MiB;
constexpr size_t WS_X0C = WS_ZC + 1 * MiB;
constexpr size_t WS_HB8 = WS_X0C + 1 * MiB;
constexpr size_t WS_END = WS_HB8 + 17 * MiB;
constexpr int CW_CNT = 1024;
constexpr int CW_NORM = 2048;

struct P {
    const float *x, *c, *ctx, *c_ctx, *w_mod, *b_mod, *norm_g, *w_in, *w_out, *diff_lambda, *diff_subln_g, *hy_short_w, *hy_short_b,
        *hy_w1, *hy_b1, *hy_w2, *hy_b2, *hy_w3, *hy_freq, *hy_bias, *ret_decay, *ret_norm_g, *gla_gate_w, *gla_gate_b, *gla_norm_g,
        *router_w, *router_b, *exp_w1, *exp_b1, *exp_w2, *exp_b2;
    float* out; unsigned char* ws;
};
typedef const __attribute__((address_space(4))) P* KP;
#define KP_PTR(kp_) ((KP)((unsigned long long)(kp_) & ~7ull))
#define p (*KP_PTR(kp))
#define WSP(T, off) ((T*)(p.ws + (off)))

__device__ __forceinline__ float wave_sum(float v) {
#pragma unroll
    for (int o = 1; o < 64; o <<= 1) v += __shfl_xor(v, o);
    return v;
}
__device__ __forceinline__ float silu_f(float x) { return x / (1.f + expf(-x)); }
__host__ __device__ __forceinline__ int nrows_l(int l) { return l == 0 ? MALL : NLAT; }
__device__ __forceinline__ int mod_r(int row) { return row < NLAT ? row / SEQ : 4; }
__device__ __forceinline__ void seq_info(int row, int& base, int& n, int& t) {
    if (row < NLAT) { base = row & ~(SEQ - 1); n = SEQ; t = row - base; }
    else { int r = row - NLAT; base = NLAT + (r & ~(CTXL - 1)); n = CTXL; t = row - base; }
}

#define XB_TMO      128
#define XB_XCNT(j)  (256  + 64 * (j))
#define XB_XSUB(j)  (1280 + 64 * (j))
#define XB_XGEN(j)  (2304 + 64 * (j))
#define XB_TOP      3328
#define XB_TOPGEN   3392
#define XCD_BAR_WORDS 3456
#define XB_SPIN_CAP (1u << 22)
#define LAS __attribute__((address_space(3)))
__device__ __forceinline__ unsigned xb_ld(unsigned* ptr)            { return __hip_atomic_load(ptr, __ATOMIC_RELAXED, __HIP_MEMORY_SCOPE_AGENT); }
__device__ __forceinline__ unsigned xb_add(unsigned* ptr, unsigned v) { return __hip_atomic_fetch_add(ptr, v, __ATOMIC_RELAXED, __HIP_MEMORY_SCOPE_AGENT); }
__device__ __forceinline__ unsigned xb_xcc_id() { return (unsigned)__builtin_amdgcn_s_getreg((3 << 11) | 20) & 0xFu; }
#define XB_SPIN(cond, bar) do { unsigned _sp = 0; while (cond) { __builtin_amdgcn_s_sleep(1); \
    if ((++_sp & 255u) == 0u) { if (xb_ld(&(bar)[XB_TMO])) break; if (_sp > XB_SPIN_CAP) { atomicAdd(&(bar)[XB_TMO], 1u); break; } } } } while (0)
struct XcdBarrier { unsigned* bar; unsigned x; volatile LAS unsigned* st; };
__device__ __forceinline__ XcdBarrier xcd_barrier_post(unsigned* bar, volatile LAS unsigned* st) {
    XcdBarrier b; b.bar = bar; b.x = xb_xcc_id(); b.st = st;
    if (threadIdx.x == 0) (void)xb_add(&bar[XB_XCNT(b.x)], 1u);
    return b;
}
__device__ __forceinline__ void xcd_barrier_complete(unsigned* bar, unsigned x, unsigned& nloc, unsigned& nx) {
    const unsigned G = gridDim.x * gridDim.y * gridDim.z;
    unsigned sum, cnt, mine, sp = 0u;
    for (;;) {
        sum = 0u; cnt = 0u; mine = 0u;
#pragma unroll
        for (unsigned j = 0; j < 16; ++j) { const unsigned c = xb_ld(&bar[XB_XCNT(j)]); sum += c; cnt += (c > 0u) ? 1u : 0u; mine = (j == x) ? c : mine; }
        if (sum == G) break;
        __builtin_amdgcn_s_sleep(1);
        if ((++sp & 255u) == 0u) { if (xb_ld(&bar[XB_TMO])) break; if (sp > XB_SPIN_CAP) { atomicAdd(&bar[XB_TMO], 1u); break; } }
    }
    nloc = mine > 0u ? mine : 1u; nx = cnt > 0u ? cnt : 1u;
}
__device__ __forceinline__ void xcd_barrier(const XcdBarrier& b, bool thread0) {
    asm volatile("s_waitcnt vmcnt(0)" ::: "memory");
    __syncthreads();
    if (thread0) {
        unsigned* bar = b.bar;
        __builtin_amdgcn_s_waitcnt(0);
        unsigned nloc = b.st[0], nx = b.st[1];
        if (nloc == 0u) { xcd_barrier_complete(bar, b.x, nloc, nx); b.st[0] = nloc; b.st[1] = nx; }
        const unsigned old = xb_add(&bar[XB_XSUB(b.x)], 1u);
        const unsigned gen = old / nloc;
        if (old + 1u == (gen + 1u) * nloc) {
            __builtin_amdgcn_fence(__ATOMIC_RELEASE, "agent");
            asm volatile("s_waitcnt vmcnt(0)" ::: "memory");
            const unsigned og = xb_add(&bar[XB_TOP], 1u);
            const unsigned tg = og / nx;
            if (og + 1u == (tg + 1u) * nx) xb_add(&bar[XB_TOPGEN], 1u);
            else XB_SPIN(xb_ld(&bar[XB_TOPGEN]) == tg, bar);
            __builtin_amdgcn_fence(__ATOMIC_ACQUIRE, "agent");
            xb_add(&bar[XB_XGEN(b.x)], 1u);
            asm volatile("s_waitcnt vmcnt(0)" ::: "memory");
        } else {
            XB_SPIN(xb_ld(&bar[XB_XGEN(b.x)]) == gen, bar);
            __builtin_amdgcn_fence(__ATOMIC_ACQUIRE, "agent");
            asm volatile("s_waitcnt vmcnt(0)" ::: "memory");
        }
    }
    __syncthreads();
}

constexpr int NT = 512;
extern __shared__ __attribute__((aligned(16))) unsigned char g_lds[];
constexpr int LDS_BYTES = 147456;
constexpr int LDS_MISC = LDS_BYTES - 64;
__device__ __forceinline__ int ltid_kp(KP kp) {
    const int w = (int)((unsigned long long)kp & 7ull);
    unsigned ones = ~0u; asm volatile("" : "+s"(ones));
    int t = (w << 6) | (int)__builtin_amdgcn_mbcnt_hi(ones, __builtin_amdgcn_mbcnt_lo(ones, 0u));
    asm volatile("" : "+v"(t)); return t;
}
__device__ __forceinline__ int lbid() { int b = blockIdx.x; asm volatile("" : "+s"(b)); return b; }
#define PH_IDS const int tid = ltid_kp(kp), bid = lbid(); (void)tid; (void)bid
#define GT_LOOP(idx, total) for (int idx = bid * NT + tid; idx < (total); idx += gridDim.x * NT)
#define GW_LOOP(w, total) for (int w = bid * (NT / 64) + (tid >> 6); w < (total); w += gridDim.x * (NT / 64))

__device__ __forceinline__ const float* xin_row(KP kp, int l, int row) {
    return l == 0 ? (row < NLAT ? p.x + (size_t)row * D : p.ctx + (size_t)(row - NLAT) * D) : WSP(float, WS_XRES) + (size_t)row * D;
}
__device__ __forceinline__ void d_pro0(KP kp, LAS float* sc) {
    PH_IDS;
    GT_LOOP(idx, 64 * 24) {
        const int pos = idx / 24, j = idx % 24; float ang; float* dst;
        if (j < 8) { ang = (float)pos * powf(10000.f, -(float)j / 8.f); dst = WSP(float, WS_ROPE) + (pos * 8 + j) * 2; }
        else { ang = (float)pos * powf(10000.f, -(float)(j - 8) / 16.f); dst = WSP(float, WS_ROPE) + 1024 + (pos * 16 + (j - 8)) * 2; }
        dst[0] = cosf(ang); dst[1] = sinf(ang);
    }
    GT_LOOP(idx, 2 * 1024 * 256) {
        int n = idx & 255, i = (idx >> 8) & 1023, l = idx >> 18, d = n >> 7, j = n & 127;
        float a = 0.f;
        for (int r = 0; r < 16; ++r) a += p.w_in[((size_t)l * D + i) * INW + 3328 + d * 16 + r] * p.gla_gate_w[((l * 2 + d) * 16 + r) * 128 + j];
        WSP(float, WS_WEFF)[idx] = a;
    }
    const int lane = tid & 63;
    for (int i = tid; i < 5 * D; i += NT) { const int r = i >> 10, ii = i & 1023; sc[i] = silu_f(r < 4 ? p.c[r * D + ii] : p.c_ctx[ii]); }
    __syncthreads();
    GW_LOOP(task, 2 * 96 * 16) {
        const int chunk = task & 15, jb = (task >> 4) % 96, l = task / (16 * 96), j = jb * 64 + lane;
        const float* w = p.w_mod + ((size_t)l * D + chunk * 64) * 6144 + j;
        float acc[5] = {0.f, 0.f, 0.f, 0.f, 0.f};
#pragma unroll 8
        for (int i = 0; i < 64; ++i) { const float wv = w[(size_t)i * 6144];
#pragma unroll
            for (int r = 0; r < 5; ++r) acc[r] += sc[r * D + chunk * 64 + i] * wv; }
#pragma unroll
        for (int r = 0; r < 5; ++r) WSP(float, WS_MODP)[((size_t)(chunk * 2 + l) * 5 + r) * 6144 + j] = acc[r];
    }
}
__device__ __forceinline__ void d_filter(KP kp, LAS float* sm) {
    PH_IDS;
    const int lane = tid & 63; LAS float* zf = sm + (tid >> 6) * 192; LAS float* h1 = zf + 64; LAS float* h2 = zf + 128;
    GW_LOOP(task, 2 * SEQ + CTXL) {
        const int which = task < SEQ ? 0 : task < 2 * SEQ ? 1 : 2, pos = task - (which == 2 ? 2 * SEQ : which * SEQ), l = which == 1 ? 1 : 0, n = which == 2 ? CTXL : SEQ;
        float* filt = which == 2 ? WSP(float, WS_FILTC) : WSP(float, WS_FILT) + (size_t)l * 8192 * 256;
        const float t = (float)pos / (float)(n - 1), w = (6.2831855f * (float)pos) / (float)n;
        if (lane < 33) { float v = t; if (lane >= 1) { const int q = (lane - 1) & 15; const float f = 1e-4f + (15.f - 1e-4f) * ((float)q / 15.f), a = w * f; v = lane < 17 ? cosf(a) : -sinf(a); } zf[lane] = v; }
        asm volatile("s_waitcnt lgkmcnt(0)" ::: "memory");
        float a = p.hy_b1[l * 64 + lane];
        for (int i = 0; i < 33; ++i) a += zf[i] * p.hy_w1[(l * 33 + i) * 64 + lane];
        h1[lane] = sinf(p.hy_freq[(l * 2 + 0) * 64 + lane] * a);
        asm volatile("s_waitcnt lgkmcnt(0)" ::: "memory");
        a = p.hy_b2[l * 64 + lane];
        for (int i = 0; i < 64; ++i) a += h1[i] * p.hy_w2[(l * 64 + i) * 64 + lane];
        h2[lane] = sinf(p.hy_freq[(l * 2 + 1) * 64 + lane] * a);
        asm volatile("s_waitcnt lgkmcnt(0)" ::: "memory");
        float raw[8];
#pragma unroll
        for (int q = 0; q < 8; ++q) raw[q] = 0.f;
        for (int j = 0; j < 64; ++j) { const float hj = h2[j]; const float* w3 = p.hy_w3 + (size_t)(l * 64 + j) * 512 + lane;
#pragma unroll
            for (int q = 0; q < 8; ++q) raw[q] += hj * w3[q * 64]; }
        const float mind = logf(1e-2f) / 1.5f, maxd = logf(1e-2f) / 0.3f;
#pragma unroll
        for (int q = 0; q < 8; ++q) {
            const int c = (q & 3) * 64 + lane;
            const float v = raw[q] * expf(-t * fabsf(mind + (maxd - mind) * ((float)c / 255.f)));
            if (q < 4) { filt[(size_t)pos * 256 + c] = v; if (pos == 0) filt[(size_t)n * 256 + c] = 0.f; }
            else if (pos >= 1) filt[(size_t)(2 * n - pos) * 256 + c] = v;
        }
        asm volatile("s_waitcnt lgkmcnt(0)" ::: "memory");
    }
}
__device__ __forceinline__ void d_pro1(KP kp) {
    PH_IDS;
    GT_LOOP(idx, 2 * 5 * 6144) {
        const int j = idx % 6144, r = (idx / 6144) % 5, l = idx / (6144 * 5);
        float a = p.b_mod[l * 6144 + j];
        for (int ch = 0; ch < 16; ++ch) a += WSP(float, WS_MODP)[((size_t)(ch * 2 + l) * 5 + r) * 6144 + j];
        WSP(float, WS_MOD)[idx] = a;
    }
    GT_LOOP(idx, 528 * 256) {
        const int vb = idx >> 8, c = idx & 255, which = vb < 256 ? 0 : vb < 512 ? 1 : 2, slab = vb - (which == 2 ? 512 : which * 256);
        const float* filt = which == 2 ? WSP(float, WS_FILTC) : WSP(float, WS_FILT) + (size_t)which * 8192 * 256;
        float a = 0.f;
#pragma unroll 8
        for (int i = 0; i < 32; ++i) a += fabsf(filt[(size_t)(slab * 32 + i) * 256 + c]);
        WSP(float, WS_PS)[(which * 256 + slab) * 256 + c] = a;
    }
}
__device__ __forceinline__ void d_norm1(KP kp, int l) {
    PH_IDS;
    const int lane = tid & 63;
    GW_LOOP(row, MALL) {
        const float* xr = xin_row(kp, l, row);
        const float* mod = WSP(float, WS_MOD) + (size_t)(l * 5 + mod_r(row)) * 6144;
        const float* g = p.norm_g + (l * 4 + 0) * D;
        float v[16], ss = 0.f;
#pragma unroll
        for (int j = 0; j < 16; ++j) { v[j] = xr[j * 64 + lane]; ss += v[j] * v[j]; }
        const float rstd = rsqrtf(wave_sum(ss) * (1.f / D) + EPS);
        bf16_t* hb = WSP(bf16_t, WS_HB) + (size_t)row * D;
#pragma unroll
        for (int j = 0; j < 16; ++j) { int cidx = j * 64 + lane; hb[cidx] = f2bf(v[j] * rstd * g[cidx] * (1.f + mod[1024 + cidx]) + mod[cidx]); }
    }
}
__device__ __forceinline__ void d_router(KP kp, int l, LAS float* sm) {
    PH_IDS;
    const int lane = tid & 63;
    for (int i = tid; i < D * NEXP; i += NT) sm[(i >> 5) * 33 + (i & 31)] = p.router_w[(size_t)l * D * NEXP + i];
    LAS int* lcnt = (LAS int*)(sm + 33800); LAS int* lbase = lcnt + 32; LAS int* rec = lcnt + 64;
    if (tid < 32) lcnt[tid] = 0;
    __syncthreads();
    int it = 0;
    GW_LOOP(row, nrows_l(l)) {
        const float* xs = xin_row(kp, l, row);
        float* xr = WSP(float, WS_XRES) + (size_t)row * D;
        const float* y = WSP(float, WS_YBUF) + (size_t)row * D;
        const float* mod = WSP(float, WS_MOD) + (size_t)(l * 5 + mod_r(row)) * 6144;
        const float* g1 = p.norm_g + (l * 4 + 1) * D; const float* g2 = p.norm_g + (l * 4 + 2) * D;
        float yv[16], xv[16], ss = 0.f;
#pragma unroll
        for (int j = 0; j < 16; ++j) { yv[j] = y[j * 64 + lane]; ss += yv[j] * yv[j]; }
        float rstd = rsqrtf(wave_sum(ss) * (1.f / D) + EPS);
        ss = 0.f;
#pragma unroll
        for (int j = 0; j < 16; ++j) { const int ci = j * 64 + lane; xv[j] = xs[ci] + mod[2048 + ci] * (yv[j] * rstd * g1[ci]); ss += xv[j] * xv[j]; }
        float gsc[16], gsh[16];
#pragma unroll
        for (int j = 0; j < 16; ++j) { const int ci = j * 64 + lane; gsc[j] = g2[ci] * (1.f + mod[4096 + ci]); gsh[j] = mod[3072 + ci]; }
#pragma unroll
        for (int j = 0; j < 16; ++j) xr[j * 64 + lane] = xv[j];
        rstd = rsqrtf(wave_sum(ss) * (1.f / D) + EPS);
        unsigned char* hb = WSP(unsigned char, WS_HB8) + (size_t)row * D;
        float v[32];
#pragma unroll
        for (int e = 0; e < 32; ++e) v[e] = 0.f;
#pragma unroll
        for (int j = 0; j < 16; ++j) { xv[j] = xv[j] * rstd * gsc[j] + gsh[j]; hb[j * 64 + lane] = (unsigned char)(__builtin_amdgcn_cvt_pk_fp8_f32(xv[j], xv[j], 0, false) & 0xff); }
#pragma unroll
        for (int j = 0; j < 16; ++j) { const LAS float* wr = sm + (j * 64 + lane) * 33; const float hv = xv[j];
#pragma unroll
            for (int e = 0; e < 32; ++e) v[e] += hv * wr[e];
            asm volatile("" : "+v"(v[0]), "+v"(v[8]), "+v"(v[16]), "+v"(v[24])); }
#pragma unroll
        for (int k = 0; k < 16; ++k) { const bool up = lane & 32; const float send = up ? v[k] : v[k + 16], keep = up ? v[k + 16] : v[k]; v[k] = keep + __shfl_xor(send, 32); }
#pragma unroll
        for (int k = 0; k < 8; ++k) { const bool up = lane & 16; const float send = up ? v[k] : v[k + 8], keep = up ? v[k + 8] : v[k]; v[k] = keep + __shfl_xor(send, 16); }
#pragma unroll
        for (int k = 0; k < 4; ++k) { const bool up = lane & 8; const float send = up ? v[k] : v[k + 4], keep = up ? v[k + 4] : v[k]; v[k] = keep + __shfl_xor(send, 8); }
#pragma unroll
        for (int k = 0; k < 2; ++k) { const bool up = lane & 4; const float send = up ? v[k] : v[k + 2], keep = up ? v[k + 2] : v[k]; v[k] = keep + __shfl_xor(send, 4); }
        { const bool up = lane & 2; const float send = up ? v[0] : v[1], keep = up ? v[1] : v[0]; v[0] = keep + __shfl_xor(send, 2); }
        const int myexp = lane >> 1;
        float mylogit = v[0] + __shfl_xor(v[0], 1) + p.router_b[l * NEXP + myexp];
        float tv[4]; int ti[4];
#pragma unroll
        for (int k = 0; k < 4; ++k) {
            float bv = mylogit; int bi = myexp;
#pragma unroll
            for (int o = 1; o < 64; o <<= 1) { const float ov = __shfl_xor(bv, o); const int oi = __shfl_xor(bi, o); if (ov > bv || (ov == bv && oi < bi)) { bv = ov; bi = oi; } }
            tv[k] = bv; ti[k] = bi; if (myexp == bi) mylogit = -1e30f;
        }
        float den = 0.f, w[4];
#pragma unroll
        for (int k = 0; k < 4; ++k) { w[k] = expf(tv[k] - tv[0]); den += w[k]; }
        if (lane < 4) {
            const int e = lane == 0 ? ti[0] : lane == 1 ? ti[1] : lane == 2 ? ti[2] : ti[3];
            const float ww = lane == 0 ? w[0] : lane == 1 ? w[1] : lane == 2 ? w[2] : w[3];
            const int lr = __hip_atomic_fetch_add(&lcnt[e], 1, __ATOMIC_RELAXED, __HIP_MEMORY_SCOPE_WORKGROUP);
            rec[(it * 8 + (tid >> 6)) * 4 + lane] = (e << 16) | lr;
            WSP(float, WS_TOPW)[row * 4 + lane] = ww / den;
            WSP(int, WS_TOPI)[row * 4 + lane] = e;
        }
        ++it;
    }
    asm volatile("s_waitcnt lgkmcnt(0)" ::: "memory");
    __syncthreads();
    if (tid < 32) lbase[tid] = (int)atomicAdd(WSP(unsigned, WS_CTL) + CW_CNT + (l * 32 + tid) * 64, (unsigned)lcnt[tid]);
    asm volatile("s_waitcnt vmcnt(0) lgkmcnt(0)" ::: "memory");
    __syncthreads();
    it = 0;
    GW_LOOP(row, nrows_l(l)) {
        if (lane < 4) { const int rc = rec[(it * 8 + (tid >> 6)) * 4 + lane], e = rc >> 16, pos = lbase[e] + (rc & 0xffff);
            WSP(int, WS_LIST)[(size_t)e * MALL + pos] = row * 4 + lane; WSP(int, WS_TOPI)[MALL * 4 + row * 4 + lane] = pos; }
        ++it;
    }
    __syncthreads();
}
__device__ __forceinline__ void d_combine(KP kp, int l, LAS int* aoffs) {
    PH_IDS;
    const int lane = tid & 63;
    const unsigned* cnt = WSP(unsigned, WS_CTL) + CW_CNT + l * 32 * 64;
    if (tid == 0) { int a = 0; for (int e = 0; e < 32; ++e) { aoffs[e] = a; a += ((int)cnt[e * 64] + 255) & ~255; } }
    __syncthreads();
    GW_LOOP(row, nrows_l(l)) {
        int ee[4], pp[4];
#pragma unroll
        for (int k = 0; k < 4; ++k) { ee[k] = WSP(int, WS_TOPI)[row * 4 + k]; pp[k] = WSP(int, WS_TOPI)[MALL * 4 + row * 4 + k]; }
        gv4u yv[4][2];
#pragma unroll
        for (int k = 0; k < 4; ++k) { const gv4u* ys = (const gv4u*)(WSP(bf16_t, WS_YSLOT) + (size_t)(aoffs[ee[k]] + pp[k]) * D) + lane; yv[k][0] = ys[0]; yv[k][1] = ys[64]; }
        float acc[16];
#pragma unroll
        for (int j = 0; j < 16; ++j) acc[j] = 0.f;
#pragma unroll
        for (int k = 0; k < 4; ++k)
#pragma unroll
            for (int hf = 0; hf < 2; ++hf)
#pragma unroll
                for (int q = 0; q < 4; ++q) { acc[hf * 8 + 2 * q] += gblo(yv[k][hf][q]); acc[hf * 8 + 2 * q + 1] += gbhi(yv[k][hf][q]); }
        float ss = 0.f;
#pragma unroll
        for (int j = 0; j < 16; ++j) ss += acc[j] * acc[j];
        float rstd = rsqrtf(wave_sum(ss) * (1.f / D) + EPS);
        float* xr = WSP(float, WS_XRES) + (size_t)row * D;
        const float* mod = WSP(float, WS_MOD) + (size_t)(l * 5 + mod_r(row)) * 6144;
        const float* g3 = p.norm_g + (l * 4 + 3) * D;
        ss = 0.f;
        gv4f xo[4], gm[4], gg[4];
#pragma unroll
        for (int q8 = 0; q8 < 4; ++q8) { const int ci = (q8 >> 1) * 512 + lane * 8 + (q8 & 1) * 4; xo[q8] = *(const gv4f*)(xr + ci); gm[q8] = *(const gv4f*)(mod + 5120 + ci); gg[q8] = *(const gv4f*)(g3 + ci); }
        float n0[16], n1[16], n2[16];
        if (l < DEPTH - 1) {
            const float* mod2 = WSP(float, WS_MOD) + (size_t)((l + 1) * 5 + mod_r(row)) * 6144; const float* g0 = p.norm_g + ((l + 1) * 4 + 0) * D;
#pragma unroll
            for (int q8 = 0; q8 < 4; ++q8) { const int ci = (q8 >> 1) * 512 + lane * 8 + (q8 & 1) * 4; const gv4f a = *(const gv4f*)(g0 + ci), b2 = *(const gv4f*)(mod2 + 1024 + ci), c2 = *(const gv4f*)(mod2 + ci);
#pragma unroll
                for (int q = 0; q < 4; ++q) { n0[q8 * 4 + q] = a[q]; n1[q8 * 4 + q] = b2[q]; n2[q8 * 4 + q] = c2[q]; } }
        }
#pragma unroll
        for (int q8 = 0; q8 < 4; ++q8) {
            const int ci = (q8 >> 1) * 512 + lane * 8 + (q8 & 1) * 4;
            gv4f vv;
#pragma unroll
            for (int q = 0; q < 4; ++q) { const float v = xo[q8][q] + gm[q8][q] * (acc[q8 * 4 + q] * rstd * gg[q8][q]); vv[q] = v; acc[q8 * 4 + q] = v; ss += v * v; }
            if (l == DEPTH - 1) *(gv4f*)(p.out + (size_t)row * D + ci) = vv; else *(gv4f*)(xr + ci) = vv;
        }
        if (l < DEPTH - 1) {
            rstd = rsqrtf(wave_sum(ss) * (1.f / D) + EPS);
            bf16_t* hb = WSP(bf16_t, WS_HB) + (size_t)row * D;
#pragma unroll
            for (int hf = 0; hf < 2; ++hf) {
                gv4u o;
#pragma unroll
                for (int q = 0; q < 4; ++q) { const int i0 = hf * 8 + 2 * q; o[q] = cvtpk_rne(acc[i0] * rstd * n0[i0] * (1.f + n1[i0]) + n2[i0], acc[i0 + 1] * rstd * n0[i0 + 1] * (1.f + n1[i0 + 1]) + n2[i0 + 1]); }
                *(gv4u*)(hb + hf * 512 + lane * 8) = o;
            }
        }
    }
    __syncthreads();
}

namespace pg8 {
typedef short bf16x8 __attribute__((ext_vector_type(8)));
typedef float f32x4 __attribute__((ext_vector_type(4)));
typedef unsigned u32x4 __attribute__((ext_vector_type(4)));
typedef unsigned u32x2 __attribute__((ext_vector_type(2)));
constexpr int BM = 256, BK = 64, HALF = 128, HTB = HALF * BK * 2, STAGE_BYTES = 8 * HTB, NXCD = 8, WGM = 8, K = 1024;
__host__ __device__ __forceinline__ int lds_byte(int r, int c) { const int st = (r >> 4) * 2 + (c >> 5), rr = r & 15, cc = c & 31, ob = rr * 64 + cc * 2; return st * 1024 + (ob ^ (((ob >> 9) & 1) << 5)); }
__host__ __device__ __forceinline__ void stage_rc(int b, int& R, int& C) { const int st = b / 1024, sb = b % 1024, swz = sb ^ (((sb >> 9) & 1) << 5); R = (st >> 1) * 16 + swz / 64; C = (st & 1) * 32 + (swz % 64) / 2; }
__host__ __device__ __forceinline__ int perm32(int rho) { const int n = rho >> 4, i = rho & 15; return 8 * (i >> 2) + 4 * n + (i & 3); }
__device__ __forceinline__ unsigned cvt_pk_bf16(float lo, float hi) { return cvtpk_rne(lo, hi); }

struct Unit { int pm, pn; const char* A; const char* B; const int* gl; int gcnt; int e; int row0; };

struct DenseOrder {
    int nM, nN, nwg, G, c; const char* A; const char* Bt;
    __device__ __forceinline__ void init(int M, int N, int G_, int c_, const void* A_, const void* Bt_) { nM = M / BM; nN = N / BM; nwg = nM * nN; G = G_; c = c_; A = (const char*)A_; Bt = (const char*)Bt_; }
    __device__ __forceinline__ bool next(int i, Unit& u) const {
        const long L = (long)i * G + c; if (L >= nwg) return false;
        int wgid = (int)L; { const int q = nwg / NXCD, r = nwg % NXCD, xcd = wgid % NXCD, off = wgid / NXCD; wgid = (xcd < r ? xcd * (q + 1) : r * (q + 1) + (xcd - r) * q) + off; }
        const int nig = WGM * nN, gid = wgid / nig, fm = gid * WGM, gsz = (nM - fm) < WGM ? (nM - fm) : WGM;
        u.pm = fm + ((wgid % nig) % gsz); u.pn = (wgid % nig) / gsz;
        u.A = A + (size_t)u.pm * (BM * K * 2); u.B = Bt + (size_t)u.pn * (BM * K * 2); u.gl = nullptr; u.gcnt = BM; u.e = 0; u.row0 = u.pm * BM; return true;
    }
};
struct MoeOrder {
    const LAS int* tab; int G, c, NCT; const char* A; const char* W; size_t wstride; const int* list; const unsigned* cnt; bool gather; int rowb;
    __device__ __forceinline__ bool next(int i, Unit& u) const {
        const int xg = c & 7, L = (c >> 3) + (G >> 3) * i; const LAS int* gt = tab + 72 + xg * 5;
        if (L >= gt[4]) return false;
        int q = 0;
#pragma unroll
        for (int j = 1; j < 4; ++j) if (L >= gt[j]) q = j;
        const int e = __builtin_amdgcn_readfirstlane(xg + 8 * q);
        const int r = __builtin_amdgcn_readfirstlane(L - gt[q]), ce = __builtin_amdgcn_readfirstlane((int)cnt[e * 64]), rte = (ce + 255) >> 8, ro = __builtin_amdgcn_readfirstlane(tab[33 + e]);
        const int ct = r / rte, rt = r - ct * rte;
        u.pm = rt; u.pn = ct; u.e = e; u.row0 = ro + rt * 256; u.gl = list + (size_t)e * MALL + rt * 256; u.gcnt = min(256, ce - rt * 256);
        u.A = gather ? A : A + (size_t)u.row0 * rowb; u.B = W + (size_t)e * wstride + (size_t)ct * BM * rowb; return true;
    }
};
__device__ __forceinline__ void moe_tab_build(LAS int* tab, const unsigned* cnt, int NCT, int tid) {
    if (tid == 0) {
        int rs = 0; for (int e = 0; e < 32; ++e) { tab[33 + e] = rs; rs += (((int)cnt[e * 64] + 255) >> 8) * 256; } tab[65] = rs;
        for (int g = 0; g < 8; ++g) { int us = 0; for (int q = 0; q < 4; ++q) { tab[72 + g * 5 + q] = us; us += (((int)cnt[(g + 8 * q) * 64] + 255) >> 8) * NCT; } tab[72 + g * 5 + 4] = us; }
    }
    __syncthreads();
}

struct EpiBf16 {
    static constexpr bool PERM = true; bf16_t* O; int ldc; const float* bias;
    __device__ __forceinline__ void operator()(const f32x4 (&acc)[2][2][4][2], const Unit& u, int wr, int wc, int fr, int fq) const {
        const int row0 = u.row0 + wr * 64 + fr, col0 = u.pn * BM + wc * 32 + 8 * fq;
        f32x4 bv[2][2];
#pragma unroll
        for (int bj = 0; bj < 2; ++bj)
#pragma unroll
            for (int n = 0; n < 2; ++n) bv[bj][n] = bias ? *(const f32x4*)(bias + col0 + bj * HALF + 4 * n) : (f32x4){0.f, 0.f, 0.f, 0.f};
#pragma unroll
        for (int ai = 0; ai < 2; ++ai)
#pragma unroll
            for (int m = 0; m < 4; ++m) { bf16_t* rowp = O + (size_t)(row0 + ai * HALF + m * 16) * ldc + col0;
#pragma unroll
                for (int bj = 0; bj < 2; ++bj) { const f32x4 v0 = acc[ai][bj][m][0] + bv[bj][0], v1 = acc[ai][bj][m][1] + bv[bj][1];
                    u32x4 w; w.x = cvt_pk_bf16(v0[0], v0[1]); w.y = cvt_pk_bf16(v0[2], v0[3]); w.z = cvt_pk_bf16(v1[0], v1[1]); w.w = cvt_pk_bf16(v1[2], v1[3]);
                    *(u32x4*)(rowp + bj * HALF) = w; } }
    }
};
struct EpiF32 {
    static constexpr bool PERM = false; float* O; int ldc;
    __device__ __forceinline__ void operator()(const f32x4 (&acc)[2][2][4][2], const Unit& u, int wr, int wc, int fr, int fq) const {
        const int row0 = u.row0 + wr * 64 + fr, col0 = u.pn * BM + wc * 32 + 4 * fq;
#pragma unroll
        for (int ai = 0; ai < 2; ++ai)
#pragma unroll
            for (int m = 0; m < 4; ++m) { float* rowp = O + (size_t)(row0 + ai * HALF + m * 16) * ldc + col0;
#pragma unroll
                for (int bj = 0; bj < 2; ++bj)
#pragma unroll
                    for (int n = 0; n < 2; ++n) *(f32x4*)(rowp + bj * HALF + n * 16) = acc[ai][bj][m][n]; }
    }
};
struct EpiMoeUp {
    static constexpr bool PERM = true; unsigned char* ACT; const float* b1all;
    __device__ __forceinline__ void operator()(const f32x4 (&acc)[2][2][4][2], const Unit& u, int wr, int wc, int fr, int fq) const {
        const int col0 = u.pn * BM + wc * 32 + 8 * fq; const float* b1 = b1all + (size_t)u.e * 2048;
        f32x4 bv[2][2];
#pragma unroll
        for (int bj = 0; bj < 2; ++bj)
#pragma unroll
            for (int n = 0; n < 2; ++n) bv[bj][n] = *(const f32x4*)(b1 + col0 + bj * HALF + 4 * n);
#pragma unroll
        for (int ai = 0; ai < 2; ++ai)
#pragma unroll
            for (int m = 0; m < 4; ++m) { unsigned char* rowp = ACT + (size_t)(u.row0 + wr * 64 + fr + ai * HALF + m * 16) * 1024 + (col0 >> 1);
#pragma unroll
                for (int bj = 0; bj < 2; ++bj) { const f32x4 v0 = acc[ai][bj][m][0] * (1.f / W8_SCALE) + bv[bj][0], v1 = acc[ai][bj][m][1] * (1.f / W8_SCALE) + bv[bj][1];
                    float a[4];
#pragma unroll
                    for (int j = 0; j < 4; ++j) { const float gl = fminf(j < 2 ? v0[2 * j] : v1[2 * j - 4], 7.f), ln = fminf(fmaxf(j < 2 ? v0[2 * j + 1] : v1[2 * j - 3], -7.f), 7.f);
                        a[j] = gl * __builtin_amdgcn_rcpf(1.f + __builtin_amdgcn_exp2f(-1.702f * 1.4426950408889634f * gl)) * (ln + 1.f); }
                    *(unsigned*)(rowp + bj * 64) = pk4_fp8(a[0], a[1], a[2], a[3]); } }
    }
};
struct EpiMoeDown {
    static constexpr bool PERM = true; bf16_t* Y; const float* b2all; const float* topw;
    __device__ __forceinline__ void operator()(const f32x4 (&acc)[2][2][4][2], const Unit& u, int wr, int wc, int fr, int fq) const {
        const int col0 = u.pn * BM + wc * 32 + 8 * fq; const float* b2 = b2all + (size_t)u.e * 1024;
        f32x4 bv[2][2];
#pragma unroll
        for (int bj = 0; bj < 2; ++bj)
#pragma unroll
            for (int n = 0; n < 2; ++n) bv[bj][n] = *(const f32x4*)(b2 + col0 + bj * HALF + 4 * n);
#pragma unroll
        for (int ai = 0; ai < 2; ++ai)
#pragma unroll
            for (int m = 0; m < 4; ++m) { const int r = wr * 64 + fr + ai * HALF + m * 16; const int rc = r < u.gcnt ? r : u.gcnt - 1; const float twl = topw[u.gl[rc]]; const float tw = r < u.gcnt ? twl : 0.f;
                bf16_t* rowp = Y + (size_t)(u.row0 + r) * 1024 + col0;
#pragma unroll
                for (int bj = 0; bj < 2; ++bj) { const f32x4 v0 = (acc[ai][bj][m][0] * (1.f / W8_SCALE) + bv[bj][0]) * tw, v1 = (acc[ai][bj][m][1] * (1.f / W8_SCALE) + bv[bj][1]) * tw;
                    u32x4 w; w.x = cvt_pk_bf16(v0[0], v0[1]); w.y = cvt_pk_bf16(v0[2], v0[3]); w.z = cvt_pk_bf16(v1[0], v1[1]); w.w = cvt_pk_bf16(v1[2], v1[3]);
                    *(u32x4*)(rowp + bj * HALF) = w; } }
    }
};

typedef int v8i __attribute__((ext_vector_type(8)));
typedef int v4i __attribute__((ext_vector_type(4)));
template <class Epi, class Sched, bool GATHER, bool ALIGN_EPI, bool F8 = false>
__device__ __forceinline__ void gphase(LAS unsigned char* lds, const Sched& S, const Epi& E, const int tid) {
    const int wid = __builtin_amdgcn_readfirstlane(tid >> 6), lane = tid & 63, wr = wid >> 2, wc = wid & 3, fr = lane & 15, fq = lane >> 4;
    constexpr int ROWB = F8 ? K : K * 2, nt = ROWB / 128, KSTR = F8 ? 16 : 1024;
    unsigned voffB[2], CA2[2]; int RA[2];
#pragma unroll
    for (int i = 0; i < 2; ++i) { int R, C; stage_rc(tid * 16 + i * 8192, R, C); const int Rb = Epi::PERM ? ((R & ~31) + perm32(R & 31)) : R;
        RA[i] = R; CA2[i] = (unsigned)C * 2u; voffB[i] = (unsigned)(Rb * ROWB + C * 2); }
    constexpr size_t kstep = (size_t)(BK * 2), hstep = (size_t)HALF * ROWB;
    const unsigned ldsw = (unsigned)wid * 1024u;
    const int aoff = lds_byte(wr * 64 + fr, fq * 8), boff = lds_byte(wc * 32 + fr, fq * 8);
#define PG8_SA(b, h) (((b) * 2 + (h)) * HTB)
#define PG8_SB(b, h) ((4 + (b) * 2 + (h)) * HTB)
#define PG8_GL(gp, ldsoff) __builtin_amdgcn_global_load_lds((const unsigned*)(gp), (LAS unsigned*)(lds + (ldsoff)), 16, 0, 0)
#define PG8_STB(bufoff, gbase) do { PG8_GL((const char*)(gbase) + voffB[0], (bufoff) + ldsw); PG8_GL((const char*)(gbase) + voffB[1], (bufoff) + ldsw + 8192); } while (0)
#define PG8_STA(bufoff, gbase, o) do { PG8_GL((const char*)(gbase) + (o)[0], (bufoff) + ldsw); PG8_GL((const char*)(gbase) + (o)[1], (bufoff) + ldsw + 8192); } while (0)
#define PG8_LDA(dst, b, h) do { _Pragma("unroll") for (int m = 0; m < 4; ++m) { if constexpr (F8) { const v4i lo_ = *(const LAS v4i*)(lds + PG8_SA(b, h) + aoff + m * 2048), hi_ = *(const LAS v4i*)(lds + PG8_SA(b, h) + aoff + m * 2048 + 1024); dst##8[m] = __builtin_shufflevector(lo_, hi_, 0, 1, 2, 3, 4, 5, 6, 7); } else { _Pragma("unroll") for (int k = 0; k < 2; ++k) dst[m][k] = *(const LAS bf16x8*)(lds + PG8_SA(b, h) + aoff + m * 2048 + k * KSTR); } } } while (0)
#define PG8_LDB(dst, b, h) do { _Pragma("unroll") for (int n = 0; n < 2; ++n) { if constexpr (F8) { const v4i lo_ = *(const LAS v4i*)(lds + PG8_SB(b, h) + boff + n * 2048), hi_ = *(const LAS v4i*)(lds + PG8_SB(b, h) + boff + n * 2048 + 1024); dst##8[n] = __builtin_shufflevector(lo_, hi_, 0, 1, 2, 3, 4, 5, 6, 7); } else { _Pragma("unroll") for (int k = 0; k < 2; ++k) dst[n][k] = *(const LAS bf16x8*)(lds + PG8_SB(b, h) + boff + n * 2048 + k * KSTR); } } } while (0)
#define PG8_MMA(ai, bj, At, Bt) do { __builtin_amdgcn_s_setprio(1); _Pragma("unroll") for (int m = 0; m < 4; ++m) _Pragma("unroll") for (int n = 0; n < 2; ++n) { \
        if constexpr (F8) asm volatile("v_mfma_scale_f32_16x16x128_f8f6f4 %0, %1, %2, %0, %3, %3 op_sel_hi:[0,0,0]" : "+v"(acc[ai][bj][m][n]) : "v"(Bt##8[n]), "v"(At##8[m]), "v"(f8scale) : "memory"); \
        else { _Pragma("unroll") for (int k = 0; k < 2; ++k) acc[ai][bj][m][n] = __builtin_amdgcn_mfma_f32_16x16x32_bf16(Bt[n][k], At[m][k], acc[ai][bj][m][n], 0, 0, 0); } } \
        __builtin_amdgcn_s_setprio(0); } while (0)
#define PG8_WAIT_V(n) asm volatile("s_waitcnt vmcnt(" #n ")" ::: "memory")
#define PG8_WAIT_L(n) asm volatile("s_waitcnt lgkmcnt(" #n ")" ::: "memory")
#define PG8_BAR __builtin_amdgcn_s_barrier()
#define PG8_SCHED __builtin_amdgcn_sched_barrier(0)
#define PG8_AOFFS(u, o) do { _Pragma("unroll") for (int h_ = 0; h_ < 2; ++h_) _Pragma("unroll") for (int i_ = 0; i_ < 2; ++i_) { \
        if (GATHER) { const int r_ = h_ * 128 + RA[i_]; const int rc_ = r_ < (u).gcnt ? r_ : (u).gcnt - 1; const int tok_ = (u).gl[rc_] >> 2; o[h_][i_] = (unsigned)tok_ * (unsigned)ROWB + CA2[i_]; } \
        else o[h_][i_] = (unsigned)((h_ * 128 + RA[i_]) * ROWB) + CA2[i_]; } } while (0)
    Unit cur, nxt; int ui = 0;
    if (!S.next(0, cur)) return;
    f32x4 acc[2][2][4][2];
#pragma unroll
    for (int a = 0; a < 2; ++a)
#pragma unroll
        for (int b = 0; b < 2; ++b)
#pragma unroll
            for (int m = 0; m < 4; ++m)
#pragma unroll
                for (int n = 0; n < 2; ++n) acc[a][b][m][n] = (f32x4){0.f, 0.f, 0.f, 0.f};
    int f8scale = 0x7f7f7f7f; asm volatile("" : "+v"(f8scale));
    bf16x8 At[F8 ? 1 : 4][2], B0[F8 ? 1 : 2][2], B1[F8 ? 1 : 2][2]; v8i At8[F8 ? 4 : 1], B08[F8 ? 2 : 1], B18[F8 ? 2 : 1];
    (void)At; (void)B0; (void)B1; (void)At8; (void)B08; (void)B18;
    unsigned oAc[2][2], oAn[2][2];
    PG8_AOFFS(cur, oAc);
    const char* cA = cur.A; const char* cB = cur.B;
    PG8_STB(PG8_SB(0, 0), cB); PG8_STB(PG8_SB(0, 1), cB + hstep); PG8_STA(PG8_SA(0, 0), cA, oAc[0]); PG8_STA(PG8_SA(0, 1), cA, oAc[1]);
    if (wr == 1) PG8_BAR;
    PG8_WAIT_V(2); PG8_BAR;
    PG8_STB(PG8_SB(1, 0), cB + kstep); PG8_STA(PG8_SA(1, 0), cA + kstep, oAc[0]); PG8_STB(PG8_SB(1, 1), cB + hstep + kstep);
    PG8_WAIT_V(6); PG8_BAR;
    for (;;) {
        const bool has_next = S.next(ui + 1, nxt);
        const char* nA = has_next ? nxt.A : cA; const char* nB = has_next ? nxt.B : cB;
        if (has_next) { PG8_AOFFS(nxt, oAn); } else {
#pragma unroll
            for (int h = 0; h < 2; ++h) { oAn[h][0] = oAc[h][0]; oAn[h][1] = oAc[h][1]; } }
#pragma unroll 1
        for (int t = 0; t < nt; t += 2) {
            const bool last = (t == nt - 2);
            const char* a1 = cA + (size_t)(t + 1) * kstep;
            const char* a2 = last ? nA : cA + (size_t)(t + 2) * kstep; const char* b2 = last ? nB : cB + (size_t)(t + 2) * kstep;
            const char* a3 = a2 + kstep; const char* b3 = b2 + kstep;
            unsigned o2[2][2];
#pragma unroll
            for (int h = 0; h < 2; ++h) { o2[h][0] = last ? oAn[h][0] : oAc[h][0]; o2[h][1] = last ? oAn[h][1] : oAc[h][1]; }
            PG8_LDB(B0, 0, 0); PG8_LDB(B1, 0, 1); PG8_SCHED; PG8_LDA(At, 0, 0); PG8_STA(PG8_SA(1, 1), a1, oAc[1]);
            PG8_WAIT_V(8); PG8_WAIT_L(0); PG8_BAR; PG8_MMA(0, 0, At, B0); PG8_MMA(0, 1, At, B1); PG8_BAR; PG8_SCHED;
            PG8_LDA(At, 0, 1); PG8_STB(PG8_SB(0, 0), b2); PG8_STB(PG8_SB(0, 1), b2 + hstep); PG8_STA(PG8_SA(0, 0), a2, o2[0]);
            PG8_WAIT_V(8); PG8_WAIT_L(0); PG8_BAR; PG8_MMA(1, 0, At, B0); PG8_MMA(1, 1, At, B1); PG8_BAR; PG8_SCHED;
            PG8_LDB(B0, 1, 0); PG8_LDB(B1, 1, 1); PG8_SCHED; PG8_LDA(At, 1, 0); PG8_STA(PG8_SA(0, 1), a2, o2[1]);
            PG8_WAIT_V(8); PG8_WAIT_L(0); PG8_BAR; PG8_MMA(0, 0, At, B0); PG8_MMA(0, 1, At, B1); PG8_BAR; PG8_SCHED;
            PG8_LDA(At, 1, 1); PG8_STB(PG8_SB(1, 0), b3); PG8_STB(PG8_SB(1, 1), b3 + hstep); PG8_STA(PG8_SA(1, 0), a3, o2[0]);
            PG8_WAIT_V(8); PG8_WAIT_L(0); PG8_BAR; PG8_MMA(1, 0, At, B0); PG8_MMA(1, 1, At, B1); PG8_BAR; PG8_SCHED;
        }
        if constexpr (F8) asm volatile("s_nop 15\n\ts_nop 15" ::: "memory");
        if constexpr (ALIGN_EPI) { if (wr == 0) PG8_BAR; }
        E(acc, cur, wr, wc, fr, fq);
        if (!has_next) break;
#pragma unroll
        for (int a = 0; a < 2; ++a)
#pragma unroll
            for (int b = 0; b < 2; ++b)
#pragma unroll
                for (int m = 0; m < 4; ++m)
#pragma unroll
                    for (int n = 0; n < 2; ++n) acc[a][b][m][n] = (f32x4){0.f, 0.f, 0.f, 0.f};
        cur = nxt; cA = nA; cB = nB; ++ui;
#pragma unroll
        for (int h = 0; h < 2; ++h) { oAc[h][0] = oAn[h][0]; oAc[h][1] = oAn[h][1]; }
        if constexpr (ALIGN_EPI) { if (wr == 1) PG8_BAR; }
    }
    PG8_WAIT_V(0);
    if constexpr (!ALIGN_EPI) { if (wr == 0) PG8_BAR; }
    PG8_BAR;
#undef PG8_SA
#undef PG8_SB
#undef PG8_GL
#undef PG8_STA
#undef PG8_STB
#undef PG8_LDA
#undef PG8_LDB
#undef PG8_MMA
#undef PG8_WAIT_V
#undef PG8_WAIT_L
#undef PG8_BAR
#undef PG8_SCHED
#undef PG8_AOFFS
}
}

__device__ __forceinline__ unsigned pk2(float lo, float hi) { return (unsigned)f2bf(lo) | ((unsigned)f2bf(hi) << 16); }
__device__ __forceinline__ void transpose_item(const float* W, int ld, int nblk, bf16_t* WT, LAS float* scr, int item, int lane) {
    const int kb = item / nblk, nb = item - kb * nblk, k0 = 64 * kb, n0 = 32 * nb;
#pragma unroll 8
    for (int i = 0; i < 32; ++i) { const int kk = 2 * i + (lane >> 5); scr[kk * 33 + (lane & 31)] = W[(size_t)(k0 + kk) * ld + n0 + (lane & 31)]; }
    asm volatile("s_waitcnt lgkmcnt(0)" ::: "memory");
    const int c = lane & 7;
#pragma unroll
    for (int j = 0; j < 4; ++j) { const int n = (lane >> 3) + 8 * j; const LAS float* s = scr + (8 * c) * 33 + n;
        pg8::u32x4 o; o.x = pk2(s[0 * 33], s[1 * 33]); o.y = pk2(s[2 * 33], s[3 * 33]); o.z = pk2(s[4 * 33], s[5 * 33]); o.w = pk2(s[6 * 33], s[7 * 33]);
        *(pg8::u32x4*)(WT + (size_t)(n0 + n) * 1024 + k0 + 8 * c) = o; }
    asm volatile("s_waitcnt lgkmcnt(0)" ::: "memory");
}
__device__ __forceinline__ void transpose_item8(const float* W, int ld, int nblk, unsigned char* WT, LAS float* scr, int item, int lane) {
    const int kb = item / nblk, nb = item - kb * nblk, k0 = 64 * kb, n0 = 32 * nb;
#pragma unroll 8
    for (int i = 0; i < 32; ++i) { const int kk = 2 * i + (lane >> 5); scr[kk * 33 + (lane & 31)] = W[(size_t)(k0 + kk) * ld + n0 + (lane & 31)]; }
    asm volatile("s_waitcnt lgkmcnt(0)" ::: "memory");
    const int c = lane & 3;
#pragma unroll
    for (int j = 0; j < 2; ++j) { const int n = (lane >> 2) + 16 * j; const LAS float* sp = scr + (16 * c) * 33 + n;
        pg8::u32x4 o;
#pragma unroll
        for (int q = 0; q < 4; ++q) o[q] = pk4_fp8(sp[(4 * q) * 33] * W8_SCALE, sp[(4 * q + 1) * 33] * W8_SCALE, sp[(4 * q + 2) * 33] * W8_SCALE, sp[(4 * q + 3) * 33] * W8_SCALE);
        *(pg8::u32x4*)(WT + (size_t)(n0 + n) * 1024 + k0 + 16 * c) = o; }
    asm volatile("s_waitcnt lgkmcnt(0)" ::: "memory");
}
__device__ __forceinline__ void d_convert_a(KP kp, LAS float* scr_all) {
    PH_IDS;
    const int lane = tid & 63; LAS float* scr = scr_all + (tid >> 6) * (64 * 33);
    constexpr int I_IN = 16 * 104, I_OUT = 16 * 32, I_W1 = 16 * 64, I_W2 = 16 * 32, I_L = I_IN + I_OUT + 32 * I_W1 + 32 * I_W2;
    GW_LOOP(it, 2 * I_L) {
        const int l = it / I_L; int r = it - l * I_L;
        if (r < I_IN) { transpose_item(p.w_in + (size_t)l * D * INW, INW, 104, WSP(bf16_t, WS_WIN_T) + (size_t)l * PW * 1024, scr, r, lane); continue; } r -= I_IN;
        if (r < I_OUT) { transpose_item(p.w_out + (size_t)l * D * D, 1024, 32, WSP(bf16_t, WS_WOUT_T) + (size_t)l * 1024 * 1024, scr, r, lane); continue; } r -= I_OUT;
        if (r < 32 * I_W1) { const int e = r / I_W1; transpose_item8(p.exp_w1 + ((size_t)l * NEXP + e) * D * 2048, 2048, 64, WSP(unsigned char, WS_W1_T) + ((size_t)l * NEXP + e) * 2048 * 1024, scr, r - e * I_W1, lane); continue; } r -= 32 * I_W1;
        { const int e = r / I_W2; transpose_item8(p.exp_w2 + ((size_t)l * NEXP + e) * D * D, 1024, 32, WSP(unsigned char, WS_W2_T) + ((size_t)l * NEXP + e) * 1024 * 1024, scr, r - e * I_W2, lane); }
    }
    GT_LOOP(idx, 2 * PW) { const int l = idx / PW, n = idx - l * PW; WSP(float, WS_BIAS_IN)[idx] = n < 3328 ? 0.f : p.gla_gate_b[l * 256 + n - 3328]; }
}
__device__ __forceinline__ void d_convert_b(KP kp, LAS float* scr_all) {
    PH_IDS;
    const int lane = tid & 63; LAS float* scr = scr_all + (tid >> 6) * (64 * 33);
    GW_LOOP(it, 2 * 128) { const int l = it >> 7; transpose_item(WSP(float, WS_WEFF) + (size_t)l * D * 256, 256, 8, WSP(bf16_t, WS_WIN_T) + ((size_t)l * PW + 3328) * 1024, scr, it & 127, lane); }
}

__device__ __forceinline__ void d_gemm_in(KP kp, int l, LAS unsigned char* lds) {
    PH_IDS;
    pg8::DenseOrder S; S.init(MALL, PW, gridDim.x, bid, WSP(bf16_t, WS_HB), WSP(bf16_t, WS_WIN_T) + (size_t)l * PW * 1024);
    pg8::EpiBf16 E{WSP(bf16_t, WS_PBUF), PW, WSP(float, WS_BIAS_IN) + l * PW};
    pg8::gphase<pg8::EpiBf16, pg8::DenseOrder, false, true>(lds, S, E, tid);
}
__device__ __forceinline__ void d_gemm_out(KP kp, int l, LAS unsigned char* lds) {
    PH_IDS;
    pg8::DenseOrder S; S.init(nrows_l(l), 1024, gridDim.x, bid, WSP(bf16_t, WS_CONCAT), WSP(bf16_t, WS_WOUT_T) + (size_t)l * 1024 * 1024);
    pg8::EpiF32 E{WSP(float, WS_YBUF), 1024};
    pg8::gphase<pg8::EpiF32, pg8::DenseOrder, false, true>(lds, S, E, tid);
}
__device__ __forceinline__ void d_moe_up(KP kp, int l, LAS unsigned char* lds) {
    PH_IDS;
    LAS int* tab = (LAS int*)(lds + pg8::STAGE_BYTES);
    const unsigned* cnt = WSP(unsigned, WS_CTL) + CW_CNT + l * 32 * 64;
    pg8::moe_tab_build(tab, cnt, 8, tid);
    pg8::MoeOrder S{tab, (int)gridDim.x, bid, 8, (const char*)WSP(unsigned char, WS_HB8), (const char*)(WSP(unsigned char, WS_W1_T) + (size_t)l * NEXP * 2048 * 1024), (size_t)2048 * 1024, WSP(int, WS_LIST), cnt, true, 1024};
    pg8::EpiMoeUp E{WSP(unsigned char, WS_ACT), p.exp_b1 + (size_t)l * NEXP * 2048};
    pg8::gphase<pg8::EpiMoeUp, pg8::MoeOrder, true, true, true>(lds, S, E, tid);
}
__device__ __forceinline__ void d_moe_down(KP kp, int l, LAS unsigned char* lds) {
    PH_IDS;
    LAS int* tab = (LAS int*)(lds + pg8::STAGE_BYTES);
    const unsigned* cnt = WSP(unsigned, WS_CTL) + CW_CNT + l * 32 * 64;
    pg8::moe_tab_build(tab, cnt, 4, tid);
    pg8::MoeOrder S{tab, (int)gridDim.x, bid, 4, (const char*)WSP(unsigned char, WS_ACT), (const char*)(WSP(unsigned char, WS_W2_T) + (size_t)l * NEXP * 1024 * 1024), (size_t)1024 * 1024, WSP(int, WS_LIST), cnt, false, 1024};
    pg8::EpiMoeDown E{WSP(bf16_t, WS_YSLOT), p.exp_b2 + (size_t)l * NEXP * 1024, WSP(float, WS_TOPW)};
    pg8::gphase<pg8::EpiMoeDown, pg8::MoeOrder, false, true, true>(lds, S, E, tid);
}

constexpr int ATT_NT = 68;
constexpr float ATT_QSCALE = 0.17677669529663687f * 1.4426950408889634f;
__device__ __forceinline__ void d_prep_attn(KP kp) {
    PH_IDS;
    const bf16_t* PB = WSP(bf16_t, WS_PBUF);
    GT_LOOP(idx, MALL * 16) {
        const int row = idx >> 4, hm = (idx >> 1) & 7, ks = idx & 1, h = hm >> 1, m = hm & 1;
        const bool lat = row < NLAT; const int t = row & (SEQ - 1);
        const int ipos = lat ? (ks == 0 ? (t >> 6) : (t & 63)) : 0;
        const int cb = h * 64 + m * 32 + ks * 16;
        const pg8::u32x4* qs = (const pg8::u32x4*)(PB + (size_t)row * PW + PC_AQ + cb);
        const pg8::u32x4* ksrc = (const pg8::u32x4*)(PB + (size_t)row * PW + PC_AK + cb);
        pg8::u32x4 qa = qs[0], qb = qs[1], ka = ksrc[0], kb = ksrc[1];
        float qv[16], kv[16];
#pragma unroll
        for (int j = 0; j < 4; ++j) { qv[2 * j] = bf2f((bf16_t)(qa[j] & 0xffff)); qv[2 * j + 1] = bf2f((bf16_t)(qa[j] >> 16)); qv[8 + 2 * j] = bf2f((bf16_t)(qb[j] & 0xffff)); qv[9 + 2 * j] = bf2f((bf16_t)(qb[j] >> 16));
                                      kv[2 * j] = bf2f((bf16_t)(ka[j] & 0xffff)); kv[2 * j + 1] = bf2f((bf16_t)(ka[j] >> 16)); kv[8 + 2 * j] = bf2f((bf16_t)(kb[j] & 0xffff)); kv[9 + 2 * j] = bf2f((bf16_t)(kb[j] >> 16)); }
        float qo[16], ko[16];
#pragma unroll
        for (int j = 0; j < 8; ++j) {
            const float* tb = WSP(float, WS_ROPE) + (ipos * 8 + j) * 2; const float cs = tb[0], sn = tb[1];
            qo[j] = qv[j] * cs - qv[j + 8] * sn; qo[j + 8] = qv[j + 8] * cs + qv[j] * sn;
            ko[j] = kv[j] * cs - kv[j + 8] * sn; ko[j + 8] = kv[j + 8] * cs + kv[j] * sn;
        }
        pg8::u32x4 o0, o1;
#pragma unroll
        for (int j = 0; j < 4; ++j) { o0[j] = pk2(qo[2 * j] * ATT_QSCALE, qo[2 * j + 1] * ATT_QSCALE); o1[j] = pk2(qo[8 + 2 * j] * ATT_QSCALE, qo[9 + 2 * j] * ATT_QSCALE); }
        pg8::u32x4* qd = (pg8::u32x4*)(WSP(bf16_t, WS_QRP) + (size_t)row * 256 + cb); qd[0] = o0; qd[1] = o1;
#pragma unroll
        for (int j = 0; j < 4; ++j) { o0[j] = pk2(ko[2 * j], ko[2 * j + 1]); o1[j] = pk2(ko[8 + 2 * j], ko[9 + 2 * j]); }
        int b, tile, key; if (lat) { b = row >> 12; tile = t >> 6; key = t & 63; } else { const int r = row - NLAT; b = r >> 8; tile = 64 + ((r & 255) >> 6); key = r & 63; }
        unsigned char* img = WSP(unsigned char, WS_KIMG) + ((size_t)(b * 4 + h) * ATT_NT + tile) * 8192 + key * 128;
        const int c0 = m * 4 + ks * 2, sw = (key >> 1) & 7;
        *(pg8::u32x4*)(img + 16 * (c0 ^ sw)) = o0; *(pg8::u32x4*)(img + 16 * ((c0 + 1) ^ sw)) = o1;
    }
    GT_LOOP(idx, 16 * ATT_NT * 2 * 64) {
        const int d = idx & 63, half = (idx >> 6) & 1, tile = (idx >> 7) % ATT_NT, bh = idx / (128 * ATT_NT), b = bh >> 2, h = bh & 3;
        const int row0 = (tile < 64 ? b * SEQ + tile * 64 : NLAT + b * CTXL + (tile - 64) * 64) + half * 32;
        const bf16_t* vp = PB + (size_t)row0 * PW + PC_AV + h * 64 + d;
        unsigned short vv[32];
#pragma unroll
        for (int j = 0; j < 32; ++j) vv[j] = vp[(size_t)j * PW];
        unsigned char* img = WSP(unsigned char, WS_VIMG) + ((size_t)bh * ATT_NT + tile) * 8192 + d * 128; const int x = (d >> 1) & 7;
#pragma unroll
        for (int s2 = 0; s2 < 2; ++s2)
#pragma unroll
            for (int hh = 0; hh < 2; ++hh) { const int j = 4 * s2 + hh, u = 4 * half + 2 * s2 + hh;
                *(pg8::u32x4*)(img + 16 * (u ^ x)) = (pg8::u32x4){(unsigned)vv[4 * j] | ((unsigned)vv[4 * j + 1] << 16), (unsigned)vv[4 * j + 2] | ((unsigned)vv[4 * j + 3] << 16),
                                                                   (unsigned)vv[4 * j + 8] | ((unsigned)vv[4 * j + 9] << 16), (unsigned)vv[4 * j + 10] | ((unsigned)vv[4 * j + 11] << 16)}; }
    }
}

namespace att {
typedef short bf16x8 __attribute__((ext_vector_type(8)));
typedef float f32x16 __attribute__((ext_vector_type(16)));
typedef unsigned u32x4 __attribute__((ext_vector_type(4)));
typedef unsigned u32x2 __attribute__((ext_vector_type(2)));
typedef float f32x2 __attribute__((ext_vector_type(2)));
constexpr int SLOT = 8192, NSLOT = 4, LDS_K = 0, LDS_V = NSLOT * SLOT, LDS_SCR = 2 * NSLOT * SLOT;
constexpr float THR = 8.f;
__device__ __forceinline__ int crow(int r, int hi) { return (r & 3) + 8 * (r >> 2) + 4 * hi; }
__device__ __forceinline__ unsigned cvtpk(float lo, float hi) { return cvtpk_rne(lo, hi); }
__device__ __forceinline__ float xhalf_max(float v) { return fmaxf(v, __shfl_xor(v, 32)); }
}
__device__ __forceinline__ void attn_unit(KP kp, int l, int b, int h, int qt, LAS unsigned char* lds, float lam, float lam_init, int tid) {
    using namespace att;
    const int lane = tid & 63, wid = __builtin_amdgcn_readfirstlane(tid >> 6), q32 = lane & 31, hi = lane >> 5;
    const int t0 = qt < 0 ? 64 : 0, t1 = ATT_NT;
    const int rowbase = (qt < 0 ? NLAT + b * CTXL : b * SEQ + qt * 256) + wid * 32;
    const unsigned char* kimg = WSP(unsigned char, WS_KIMG) + (size_t)(b * 4 + h) * ATT_NT * 8192 + wid * 1024 + lane * 16;
    const unsigned char* vimg = WSP(unsigned char, WS_VIMG) + (size_t)(b * 4 + h) * ATT_NT * 8192 + wid * 1024 + lane * 16;
    LAS float* scr = (LAS float*)(lds + LDS_SCR) + wid * 64;
#define ATT_DMA(t, slot) do { __builtin_amdgcn_global_load_lds((const unsigned*)(kimg + (size_t)(t) * 8192), (LAS unsigned*)(lds + LDS_K + (slot) * SLOT + wid * 1024), 16, 0, 0); \
                              __builtin_amdgcn_global_load_lds((const unsigned*)(vimg + (size_t)(t) * 8192), (LAS unsigned*)(lds + LDS_V + (slot) * SLOT + wid * 1024), 16, 0, 0); } while (0)
    bf16x8 qf[2][2];
    { const bf16_t* qp = WSP(bf16_t, WS_QRP) + (size_t)(rowbase + q32) * 256 + h * 64 + hi * 8;
#pragma unroll
      for (int m = 0; m < 2; ++m)
#pragma unroll
        for (int ks = 0; ks < 2; ++ks) qf[m][ks] = *(const bf16x8*)(qp + m * 32 + ks * 16); }
    asm volatile("s_waitcnt vmcnt(0)" ::: "memory");
    __builtin_amdgcn_s_barrier();
    ATT_DMA(t0, 0); ATT_DMA(t0 + 1, 1); ATT_DMA(t0 + 2, 2);
    asm volatile("s_waitcnt vmcnt(4)" ::: "memory");
    __builtin_amdgcn_s_barrier();
    f32x16 O[2][2];
#pragma unroll
    for (int m = 0; m < 2; ++m)
#pragma unroll
        for (int dh = 0; dh < 2; ++dh)
#pragma unroll
            for (int r = 0; r < 16; ++r) O[m][dh][r] = 0.f;
    float mref[2] = {0.f, 0.f}; f32x2 lsum[2] = {{0.f, 0.f}, {0.f, 0.f}};
    f32x16 negm[2];
#pragma unroll
    for (int m = 0; m < 2; ++m) {
#pragma unroll
        for (int r = 0; r < 16; ++r) negm[m][r] = 0.f;
        asm volatile("" : "+v"(negm[m])); }
    const int koff = q32 * 128, ksw = (q32 >> 1) & 7;
    int slot = 0;
    bf16x8 kf[2][2][2];
#define ATT_KLD(slot_) do { const LAS unsigned char* kb_ = lds + LDS_K + (slot_) * SLOT + koff; _Pragma("unroll") for (int m_ = 0; m_ < 2; ++m_) _Pragma("unroll") for (int kh_ = 0; kh_ < 2; ++kh_) \
        _Pragma("unroll") for (int ks_ = 0; ks_ < 2; ++ks_) kf[m_][kh_][ks_] = *(const LAS bf16x8*)(kb_ + kh_ * 4096 + 16 * ((m_ * 4 + ks_ * 2 + hi) ^ ksw)); } while (0)
    ATT_KLD(0);
#pragma unroll 1
    for (int t = t0; t < t1; ++t) {
        asm volatile("s_waitcnt vmcnt(2)" ::: "memory");
        __builtin_amdgcn_s_barrier();
        asm volatile("" ::: "memory");
        { const int s3 = (slot + 3) & 3; const int tn = t + 3 < t1 ? t + 3 : t1 - 1; ATT_DMA(tn, s3); }
        const LAS unsigned char* Vs = lds + LDS_V + slot * SLOT;
        u32x4 ppk[2][2][2];
        f32x16 S[2][2];
#pragma unroll
        for (int m = 0; m < 2; ++m)
#pragma unroll
            for (int kh = 0; kh < 2; ++kh)
#pragma unroll
                for (int ks = 0; ks < 2; ++ks) {
                    if (ks == 0) S[m][kh] = __builtin_amdgcn_mfma_f32_32x32x16_bf16(kf[m][kh][ks], qf[m][ks], negm[m], 0, 0, 0);
                    else S[m][kh] = __builtin_amdgcn_mfma_f32_32x32x16_bf16(kf[m][kh][ks], qf[m][ks], S[m][kh], 0, 0, 0);
                }
        float mx[2];
#pragma unroll
        for (int m = 0; m < 2; ++m) { mx[m] = __builtin_elementwise_maximum(S[m][0][0], S[m][1][0]);
#pragma unroll
            for (int r = 1; r < 16; ++r) mx[m] = __builtin_elementwise_maximum(__builtin_elementwise_maximum(mx[m], S[m][0][r]), S[m][1][r]); }
        mx[0] = xhalf_max(mx[0]); mx[1] = xhalf_max(mx[1]);
        const bool first = (t == t0);
        if (__any(first || mx[0] > THR || mx[1] > THR)) {
#pragma unroll
            for (int m = 0; m < 2; ++m) {
                const float dl = first ? mx[m] : fmaxf(mx[m], 0.f);
                mref[m] += dl;
                { const float nm = -mref[m];
#pragma unroll
                  for (int r = 0; r < 16; ++r) negm[m][r] = nm;
                  asm volatile("" : "+v"(negm[m])); }
#pragma unroll
                for (int r = 0; r < 16; ++r) { S[m][0][r] -= dl; S[m][1][r] -= dl; }
                const float f = __builtin_amdgcn_exp2f(-dl);
                lsum[m] *= f;
                if (!first) {
                    if (hi == 0) scr[q32] = f;
                    asm volatile("s_waitcnt lgkmcnt(0)" ::: "memory");
#pragma unroll
                    for (int r = 0; r < 16; ++r) { const float fr = scr[crow(r, hi)]; O[m][0][r] *= fr; O[m][1][r] *= fr; }
                    asm volatile("s_waitcnt lgkmcnt(0)" ::: "memory");
                }
            }
        }
        bf16x8 vf[2][2][2], vg[2][2];
#define ATT_VLD(dst, kh_) do { _Pragma("unroll") for (int sx_ = 0; sx_ < 2; ++sx_) _Pragma("unroll") for (int dh_ = 0; dh_ < 2; ++dh_) { const int d_ = dh_ * 32 + q32; \
            dst[sx_][dh_] = *(const LAS bf16x8*)(Vs + d_ * 128 + 16 * (((kh_) * 4 + sx_ * 2 + hi) ^ ((d_ >> 1) & 7))); } } while (0)
        ATT_VLD(vf[0], 0);
        __builtin_amdgcn_sched_barrier(0);
#pragma unroll
        for (int kh = 0; kh < 2; ++kh) {
#pragma unroll
            for (int r = 0; r < 16; r += 2) { S[0][kh][r] = __builtin_amdgcn_exp2f(S[0][kh][r]); S[0][kh][r + 1] = __builtin_amdgcn_exp2f(S[0][kh][r + 1]); lsum[0] += (f32x2){S[0][kh][r], S[0][kh][r + 1]}; }
#pragma unroll
            for (int sx = 0; sx < 2; ++sx)
#pragma unroll
                for (int j = 0; j < 4; ++j) ppk[0][kh][sx][j] = cvtpk(S[0][kh][8 * sx + 2 * j], S[0][kh][8 * sx + 2 * j + 1]);
        }
        __builtin_amdgcn_sched_barrier(0);
#pragma unroll
        for (int i = 0; i < 8; ++i) {
            { const int kh = i >> 2, sx = (i >> 1) & 1, dh = i & 1;
              O[0][dh] = __builtin_amdgcn_mfma_f32_32x32x16_bf16(__builtin_bit_cast(bf16x8, ppk[0][kh][sx]), vf[kh][sx][dh], O[0][dh], 0, 0, 0); }
            if (i == 1) ATT_VLD(vf[1], 1);
            if (i == 5) ATT_VLD(vg, 0);
            { const int kh = i >> 2, r0 = 4 * (i & 3), sx = r0 >> 3, j0 = (r0 & 7) >> 1;
#pragma unroll
              for (int r = r0; r < r0 + 4; r += 2) { S[1][kh][r] = __builtin_amdgcn_exp2f(S[1][kh][r]); S[1][kh][r + 1] = __builtin_amdgcn_exp2f(S[1][kh][r + 1]); lsum[1] += (f32x2){S[1][kh][r], S[1][kh][r + 1]}; }
              ppk[1][kh][sx][j0] = cvtpk(S[1][kh][r0], S[1][kh][r0 + 1]); ppk[1][kh][sx][j0 + 1] = cvtpk(S[1][kh][r0 + 2], S[1][kh][r0 + 3]); }
            __builtin_amdgcn_sched_barrier(0);
        }
        ATT_KLD((slot + 1) & 3);
#pragma unroll
        for (int i = 0; i < 8; ++i) { const int kh = i >> 2, sx = (i >> 1) & 1, dh = i & 1;
            O[1][dh] = __builtin_amdgcn_mfma_f32_32x32x16_bf16(__builtin_bit_cast(bf16x8, ppk[1][kh][sx]), kh == 0 ? vg[sx][dh] : vf[1][sx][dh], O[1][dh], 0, 0, 0); }
#undef ATT_VLD
        asm volatile("s_waitcnt lgkmcnt(0)" ::: "memory");
        slot = (slot + 1) & 3;
    }
    asm volatile("s_waitcnt vmcnt(0)" ::: "memory");
#undef ATT_DMA
#undef ATT_KLD
    float il[2][16];
#pragma unroll
    for (int m = 0; m < 2; ++m) { const float lh = lsum[m].x + lsum[m].y; const float lt = lh + __shfl_xor(lh, 32); if (hi == 0) scr[m * 32 + q32] = 1.f / lt; }
    asm volatile("s_waitcnt lgkmcnt(0)" ::: "memory");
#pragma unroll
    for (int m = 0; m < 2; ++m)
#pragma unroll
        for (int r = 0; r < 16; ++r) il[m][r] = scr[m * 32 + crow(r, hi)];
    asm volatile("s_waitcnt lgkmcnt(0)" ::: "memory");
    const float g0 = p.diff_subln_g[l * 64 + q32] * (1.f - lam_init), g1 = p.diff_subln_g[l * 64 + 32 + q32] * (1.f - lam_init);
    bf16_t* outp = WSP(bf16_t, WS_CONCAT) + (size_t)rowbase * D + h * 64 + q32;
#pragma unroll
    for (int r = 0; r < 16; ++r) {
        const float o0 = O[0][0][r] * il[0][r] - lam * O[1][0][r] * il[1][r], o1 = O[0][1][r] * il[0][r] - lam * O[1][1][r] * il[1][r];
        float ss = o0 * o0 + o1 * o1;
#pragma unroll
        for (int x = 1; x < 32; x <<= 1) ss += __shfl_xor(ss, x);
        const float rstd = rsqrtf(ss * (1.f / 64.f) + EPS);
        bf16_t* op = outp + (size_t)crow(r, hi) * D;
        op[0] = f2bf(o0 * rstd * g0); op[32] = f2bf(o1 * rstd * g1);
    }
}
__device__ __forceinline__ void d_attn_fast(KP kp, int l, LAS unsigned char* lds) {
    PH_IDS;
    const float* dl = p.diff_lambda + l * 4 * 32;
    float s1 = 0.f, s2 = 0.f;
    for (int i = 0; i < 32; ++i) { s1 += dl[i] * dl[32 + i]; s2 += dl[64 + i] * dl[96 + i]; }
    const float lam_init = 0.8f - 0.6f * expf(-0.3f * (float)l);
    const float lam = expf(s1) - expf(s2) + lam_init;
    const int G = gridDim.x, vb = (G % 8 == 0) ? (bid % 8) * (G / 8) + bid / 8 : bid;
    const int nunits = 256 + (l == 0 ? 16 : 0);
    for (int u = vb; u < nunits; u += G) {
        if (u < 256) attn_unit(kp, l, u >> 6, (u >> 4) & 3, u & 15, lds, lam, lam_init, tid);
        else attn_unit(kp, l, (u - 256) >> 2, (u - 256) & 3, -1, lds, lam, lam_init, tid);
    }
    __syncthreads();
}

constexpr int NCHUNK = MALL / 64;
__device__ __forceinline__ float logsig16(float x) { const float y = __builtin_amdgcn_exp2f(-fabsf(x) * 1.4426950408889634f); return (fminf(x, 0.f) - __builtin_amdgcn_logf(1.f + y) * 0.6931471805599453f) * (1.f / 16.f); }
__device__ __forceinline__ void d_prep_scan(KP kp) {
    PH_IDS;
    const bf16_t* PB = WSP(bf16_t, WS_PBUF);
    GT_LOOP(idx, 8 * MALL) {
        const int row = idx % MALL, hk = idx / MALL, h = hk >> 1, ks = hk & 1;
        const bool lat = row < NLAT; const int t = row & (SEQ - 1);
        const int ipos = lat ? (ks == 0 ? (t >> 6) : (t & 63)) : 0;
        const int cb = h * 64 + ks * 32;
        const pg8::u32x4* qs = (const pg8::u32x4*)(PB + (size_t)row * PW + PC_RQ + cb);
        const pg8::u32x4* ksrc = (const pg8::u32x4*)(PB + (size_t)row * PW + PC_RK + cb);
        float qv[32], kv[32];
#pragma unroll
        for (int c4 = 0; c4 < 4; ++c4) { const pg8::u32x4 a = qs[c4], b4 = ksrc[c4];
#pragma unroll
            for (int j = 0; j < 4; ++j) { qv[c4 * 8 + 2 * j] = bf2f((bf16_t)(a[j] & 0xffff)); qv[c4 * 8 + 2 * j + 1] = bf2f((bf16_t)(a[j] >> 16)); kv[c4 * 8 + 2 * j] = bf2f((bf16_t)(b4[j] & 0xffff)); kv[c4 * 8 + 2 * j + 1] = bf2f((bf16_t)(b4[j] >> 16)); } }
        float qo[32], ko[32];
#pragma unroll
        for (int j = 0; j < 16; ++j) {
            const float* tb = WSP(float, WS_ROPE) + 1024 + (ipos * 16 + j) * 2; const float cs = tb[0], sn = tb[1];
            qo[j] = qv[j] * cs - qv[j + 16] * sn; qo[j + 16] = qv[j + 16] * cs + qv[j] * sn;
            ko[j] = (kv[j] * cs - kv[j + 16] * sn) * 0.125f; ko[j + 16] = (kv[j + 16] * cs + kv[j] * sn) * 0.125f;
        }
        pg8::u32x4* qd = (pg8::u32x4*)(WSP(bf16_t, WS_QF_R) + (size_t)row * 256 + cb); pg8::u32x4* kd = (pg8::u32x4*)(WSP(bf16_t, WS_KF_R) + (size_t)row * 256 + cb);
#pragma unroll
        for (int c4 = 0; c4 < 4; ++c4) { pg8::u32x4 a, b4;
#pragma unroll
            for (int j = 0; j < 4; ++j) { a[j] = pk2(qo[c4 * 8 + 2 * j], qo[c4 * 8 + 2 * j + 1]); b4[j] = pk2(ko[c4 * 8 + 2 * j], ko[c4 * 8 + 2 * j + 1]); }
            qd[c4] = a; kd[c4] = b4; }
        bf16_t* kt = WSP(bf16_t, WS_KT_R) + ((size_t)((row >> 6) * 4 + h) * 64 + ks * 32) * 64 + (row & 63);
#pragma unroll
        for (int i = 0; i < 32; ++i) kt[(size_t)i * 64] = f2bf(ko[i]);
    }
    GT_LOOP(idx, 4 * MALL) {
        const int row = idx % MALL, h = idx / MALL;
        const pg8::u32x4* ksrc = (const pg8::u32x4*)(PB + (size_t)row * PW + PC_GK + h * 32);
        bf16_t* kt = WSP(bf16_t, WS_KT_G) + ((size_t)((row >> 6) * 4 + h) * 32) * 64 + (row & 63);
#pragma unroll
        for (int c4 = 0; c4 < 4; ++c4) { const pg8::u32x4 a = ksrc[c4];
#pragma unroll
            for (int j = 0; j < 4; ++j) { kt[(size_t)(c4 * 8 + 2 * j) * 64] = (bf16_t)(a[j] & 0xffff); kt[(size_t)(c4 * 8 + 2 * j + 1) * 64] = (bf16_t)(a[j] >> 16); } }
    }
    GT_LOOP(idx, NCHUNK * 2 * 128) {
        const int hk = idx & 127, dir = (idx >> 7) & 1, cid = idx >> 8;
        const bf16_t* src = PB + (size_t)(cid * 64) * PW + PC_GD + dir * 128 + hk;
        float* cum = WSP(float, WS_CUM_G) + ((size_t)dir * MALL + cid * 64) * 128 + hk;
        float* cumt = WSP(float, WS_CUMT_G) + (((size_t)dir * NCHUNK + cid) * 128 + hk) * 64;
        float v[64];
#pragma unroll
        for (int j = 0; j < 64; ++j) v[j] = bf2f(src[(size_t)j * PW]);
#pragma unroll
        for (int j = 0; j < 64; ++j) v[j] = logsig16(v[j]);
        if (dir == 0) {
#pragma unroll
            for (int j = 1; j < 64; ++j) v[j] += v[j - 1];
        } else {
#pragma unroll
            for (int j = 62; j >= 0; --j) v[j] += v[j + 1];
        }
#pragma unroll
        for (int j = 0; j < 64; ++j) cum[(size_t)j * 128] = v[j];
#pragma unroll
        for (int j = 0; j < 16; ++j) *(pg8::f32x4*)(cumt + 4 * j) = (pg8::f32x4){v[4 * j], v[4 * j + 1], v[4 * j + 2], v[4 * j + 3]};
    }
    GT_LOOP(idx, 2 * NCHUNK * 4 * 2 * 64) {
        const int d = idx & 63, half = (idx >> 6) & 1, ch = (idx >> 7) % (NCHUNK * 4), mx = idx / (128 * NCHUNK * 4), h = ch & 3, cid = ch >> 2;
        const bf16_t* vp = PB + (size_t)(cid * 64 + half * 32) * PW + (mx == 0 ? PC_RV : PC_GV) + h * 64 + d;
        unsigned short vv[32];
#pragma unroll
        for (int j = 0; j < 32; ++j) vv[j] = vp[(size_t)j * PW];
        unsigned char* img = WSP(unsigned char, mx == 0 ? WS_VT_R : WS_VT_G) + (size_t)ch * 8192 + d * 128; const int x = (d >> 1) & 15;
#pragma unroll
        for (int j = 0; j < 8; ++j) *(pg8::u32x2*)(img + 8 * ((half * 8 + j) ^ x)) = (pg8::u32x2){(unsigned)vv[4 * j] | ((unsigned)vv[4 * j + 1] << 16), (unsigned)vv[4 * j + 2] | ((unsigned)vv[4 * j + 3] << 16)};
    }
}

namespace scn {
typedef short bf16x8 __attribute__((ext_vector_type(8)));
typedef float f32x16 __attribute__((ext_vector_type(16)));
typedef float f32x4 __attribute__((ext_vector_type(4)));
typedef unsigned u32x4 __attribute__((ext_vector_type(4)));
typedef unsigned u32x2 __attribute__((ext_vector_type(2)));
__device__ __forceinline__ int crow(int r, int hi) { return (r & 3) + 8 * (r >> 2) + 4 * hi; }
__device__ __forceinline__ unsigned cvtpk(float lo, float hi) { return cvtpk_rne(lo, hi); }
__device__ __forceinline__ float blo(unsigned w) { return __uint_as_float(w << 16); }
__device__ __forceinline__ float bhi(unsigned w) { return __uint_as_float(w & 0xffff0000u); }
__device__ __forceinline__ bf16x8 scale8(u32x4 raw, const float (&f)[8]) {
    u32x4 o;
#pragma unroll
    for (int j = 0; j < 4; ++j) o[j] = cvtpk(blo(raw[j]) * f[2 * j], bhi(raw[j]) * f[2 * j + 1]);
    return __builtin_bit_cast(bf16x8, o);
}
template <int MX> struct Cfg;
template <> struct Cfg<0> { static constexpr int DK = 64; };
template <> struct Cfg<1> { static constexpr int DK = 32; };
}
#define SCN_EXP(x) __builtin_amdgcn_exp2f((x) * 1.4426950408889634f)
template <int MX> __device__ __forceinline__ void scan_stage1_unit(KP kp, int l, int b, int h, int g, int tid) {
    using namespace scn;
    constexpr int DK = Cfg<MX>::DK, NKT = DK / 32, NE = DK * 64 / NT;
    const int lane = tid & 63, wid = __builtin_amdgcn_readfirstlane(tid >> 6), q32 = lane & 31, hi = lane >> 5;
    const int nch = g == 8 ? 4 : 8, cid0 = g == 8 ? 256 + 4 * b : b * 64 + 8 * g;
    float* US = WSP(float, MX == 0 ? WS_US_R : WS_US_G);
    const float* CUMT = WSP(float, WS_CUMT_G);
    if (wid < nch) {
        const int cid = cid0 + wid;
        const unsigned char* vimg = WSP(unsigned char, MX == 0 ? WS_VT_R : WS_VT_G) + (size_t)(cid * 4 + h) * 8192;
        const bf16_t* ktimg = WSP(bf16_t, MX == 0 ? WS_KT_R : WS_KT_G) + (size_t)(cid * 4 + h) * DK * 64;
        bf16x8 vb[2][4];
#pragma unroll
        for (int dh = 0; dh < 2; ++dh)
#pragma unroll
            for (int s = 0; s < 4; ++s) { const int d = dh * 32 + q32, x = (d >> 1) & 15, kc = 4 * s + 2 * hi;
                u32x4 v = *(const u32x4*)(vimg + d * 128 + 16 * ((kc ^ x) >> 1));
                if (x & 1) v = (u32x4){v.z, v.w, v.x, v.y};
                vb[dh][s] = __builtin_bit_cast(bf16x8, v); }
#pragma unroll 1
        for (int dir = 0; dir < 2; ++dir) {
            float lg = 0.f; if (MX == 0) lg = -expf(p.ret_decay[(l * 2 + dir) * 4 + h]);
#pragma unroll 1
            for (int kt = 0; kt < NKT; ++kt) {
                f32x16 U[2];
#pragma unroll
                for (int dh = 0; dh < 2; ++dh)
#pragma unroll
                    for (int r = 0; r < 16; ++r) U[dh][r] = 0.f;
                const int k = kt * 32 + q32;
                const float* ct = CUMT + (((size_t)dir * NCHUNK + cid) * 128 + h * 32 + (k & 31)) * 64;
                float E = 0.f; if (MX == 1) E = ct[dir == 0 ? 63 : 0];
#pragma unroll
                for (int s = 0; s < 4; ++s) {
                    const int j0 = 16 * s + 8 * hi;
                    const u32x4 raw = *(const u32x4*)(ktimg + (size_t)k * 64 + j0);
                    float f[8];
                    if (MX == 0) {
#pragma unroll
                        for (int jj = 0; jj < 8; ++jj) f[jj] = SCN_EXP(lg * (float)(dir == 0 ? 63 - (j0 + jj) : j0 + jj));
                    } else {
                        const f32x4 c0 = *(const f32x4*)(ct + j0), c1 = *(const f32x4*)(ct + j0 + 4);
#pragma unroll
                        for (int jj = 0; jj < 4; ++jj) { f[jj] = SCN_EXP(E - c0[jj]); f[4 + jj] = SCN_EXP(E - c1[jj]); }
                    }
                    const bf16x8 af = scale8(raw, f);
#pragma unroll
                    for (int dh = 0; dh < 2; ++dh) U[dh] = __builtin_amdgcn_mfma_f32_32x32x16_bf16(af, vb[dh][s], U[dh], 0, 0, 0);
                }
                float* up = US + ((((size_t)dir * NCHUNK + cid) * 4 + h) * DK + kt * 32 + 4 * hi) * 64 + q32;
#pragma unroll
                for (int dh = 0; dh < 2; ++dh)
#pragma unroll
                    for (int r = 0; r < 16; ++r) up[((r & 3) + 8 * (r >> 2)) * 64 + dh * 32] = U[dh][r];
            }
        }
    }
    asm volatile("s_waitcnt vmcnt(0)" ::: "memory");
    __syncthreads();
    const int k = (tid * NE) >> 6, d0 = (tid * NE) & 63;
#pragma unroll 1
    for (int dir = 0; dir < 2; ++dir) {
        float S[NE], Ap = 1.f;
#pragma unroll
        for (int e = 0; e < NE; ++e) S[e] = 0.f;
        float lg = 0.f; if (MX == 0) lg = -expf(p.ret_decay[(l * 2 + dir) * 4 + h]);
        {
            float uc[8][NE], ac[8];
#pragma unroll
            for (int cc = 0; cc < 8; ++cc) { const bool on = cc < nch; const int c = dir == 0 ? cc : nch - 1 - cc, cid = cid0 + (on ? c : 0);
                if (MX == 0) ac[cc] = SCN_EXP(lg * 64.f); else ac[cc] = SCN_EXP(CUMT[(((size_t)dir * NCHUNK + cid) * 128 + h * 32 + k) * 64 + (dir == 0 ? 63 : 0)]);
                const float* up = US + ((((size_t)dir * NCHUNK + cid) * 4 + h) * DK + k) * 64 + d0;
#pragma unroll
                for (int e = 0; e < NE; ++e) uc[cc][e] = up[e]; }
#pragma unroll
            for (int cc = 0; cc < 8; ++cc) if (cc < nch) {
#pragma unroll
                for (int e = 0; e < NE; ++e) S[e] = ac[cc] * S[e] + uc[cc][e];
                Ap *= ac[cc]; }
        }
        float* ug = WSP(float, MX == 0 ? WS_UG_R : WS_UG_G) + (((((size_t)dir * 4 + b) * 4 + h) * 9 + g) * DK + k) * 64 + d0;
#pragma unroll
        for (int e = 0; e < NE; ++e) ug[e] = S[e];
        if (d0 == 0) WSP(float, WS_AG)[((((MX * 2 + dir) * 4 + b) * 4 + h) * 9 + g) * 64 + k] = Ap;
    }
}
template <int MX> __device__ __forceinline__ void scan_stage2_unit(KP kp, int l, int b, int h, int g, LAS unsigned char* lds, int tid) {
    using namespace scn;
    constexpr int DK = Cfg<MX>::DK, NKS = DK / 16, NE = DK * 64 / NT, NCH16 = DK / 8;
    const int lane = tid & 63, wid = __builtin_amdgcn_readfirstlane(tid >> 6), q32 = lane & 31, hi = lane >> 5;
    const int nch = g == 8 ? 4 : 8, cid0 = g == 8 ? 256 + 4 * b : b * 64 + 8 * g;
    const bool act = wid < nch;
    const int cid = cid0 + (act ? wid : 0), row0 = cid * 64;
    const bf16_t* PB = WSP(bf16_t, WS_PBUF);
    const float* US = WSP(float, MX == 0 ? WS_US_R : WS_US_G);
    const float* UG = WSP(float, MX == 0 ? WS_UG_R : WS_UG_G);
    const float* CUMT = WSP(float, WS_CUMT_G);
    f32x16 o[2][2];
#pragma unroll
    for (int it = 0; it < 2; ++it)
#pragma unroll
        for (int dh = 0; dh < 2; ++dh)
#pragma unroll
            for (int r = 0; r < 16; ++r) o[it][dh][r] = 0.f;
    LAS unsigned char* myv = lds + 65536 + wid * 8192;
    { const unsigned char* vimg = WSP(unsigned char, MX == 0 ? WS_VT_R : WS_VT_G) + (size_t)(cid * 4 + h) * 8192 + lane * 16;
      u32x4 tmp[8];
#pragma unroll
      for (int i = 0; i < 8; ++i) tmp[i] = *(const u32x4*)(vimg + i * 1024);
#pragma unroll
      for (int i = 0; i < 8; ++i) *(LAS u32x4*)(myv + i * 1024 + lane * 16) = tmp[i]; }
    const int fk = (tid * NE) >> 6, fd0 = (tid * NE) & 63;
#pragma unroll 1
    for (int dir = 0; dir < 2; ++dir) {
        float lg = 0.f; if (MX == 0) lg = -expf(p.ret_decay[(l * 2 + dir) * 4 + h]);
        float S[NE];
#pragma unroll
        for (int e = 0; e < NE; ++e) S[e] = 0.f;
        if (g != 8) {
            const float* ugb = UG + (((size_t)dir * 4 + b) * 4 + h) * 9 * DK * 64 + (size_t)fk * 64 + fd0;
            const float* agb = WSP(float, WS_AG) + (((MX * 2 + dir) * 4 + b) * 4 + h) * 9 * 64 + fk;
            const int ng = dir == 0 ? g : 7 - g;
            float ug[7][NE], ag[7];
#pragma unroll
            for (int e = 0; e < NE; ++e) S[e] = ugb[(size_t)8 * DK * 64 + e];
#pragma unroll
            for (int q = 0; q < 7; ++q) { const bool on = q < ng; const int qq = on ? q : 0, gg = dir == 0 ? qq : 7 - qq; const float av = agb[gg * 64]; ag[q] = on ? av : 1.f;
#pragma unroll
                for (int e = 0; e < NE; ++e) { const float uv = ugb[(size_t)gg * DK * 64 + e]; ug[q][e] = on ? uv : 0.f; } }
#pragma unroll
            for (int q = 0; q < 7; ++q)
#pragma unroll
                for (int e = 0; e < NE; ++e) S[e] = ag[q] * S[e] + ug[q][e];
        }
        {
            float uc[8][NE], ac[8];
#pragma unroll
            for (int cc = 0; cc < 8; ++cc) { const bool on = cc < nch; const int c = dir == 0 ? cc : nch - 1 - cc, ccid = cid0 + (on ? c : 0);
                if (MX == 0) ac[cc] = SCN_EXP(lg * 64.f); else ac[cc] = SCN_EXP(CUMT[(((size_t)dir * NCHUNK + ccid) * 128 + h * 32 + fk) * 64 + (dir == 0 ? 63 : 0)]);
                const float* up = US + ((((size_t)dir * NCHUNK + ccid) * 4 + h) * DK + fk) * 64 + fd0;
#pragma unroll
                for (int e = 0; e < NE; ++e) uc[cc][e] = up[e]; }
#pragma unroll
            for (int cc = 0; cc < 8; ++cc) if (cc < nch) {
                const int c = dir == 0 ? cc : nch - 1 - cc;
                LAS unsigned char* area = lds + c * 8192;
#pragma unroll
                for (int e = 0; e < NE; ++e) { const int d = fd0 + e; const int sw = DK == 64 ? ((d >> 1) & 7) : ((d >> 2) & 3);
                    *(LAS bf16_t*)(area + d * (DK * 2) + 16 * ((fk >> 3) ^ sw) + (fk & 7) * 2) = f2bf(S[e]); }
#pragma unroll
                for (int e = 0; e < NE; ++e) S[e] = ac[cc] * S[e] + uc[cc][e];
            }
        }
        asm volatile("s_waitcnt lgkmcnt(0)" ::: "memory");
        __syncthreads();
        if (act) {
#define SCN_GEN(dst, ISQ, T2) do { const int il_ = 32 * (T2) + q32, row_ = row0 + il_; \
                _Pragma("unroll") for (int ks = 0; ks < NKS; ++ks) { const int kc0 = 16 * ks + 8 * hi; u32x4 raw_; float f_[8]; \
                    if (MX == 0) { raw_ = *(const u32x4*)(WSP(bf16_t, (ISQ) ? WS_QF_R : WS_KF_R) + (size_t)row_ * 256 + h * 64 + kc0); \
                        const float cm_ = lg * (float)(dir == 0 ? il_ + 1 : 64 - il_), e_ = SCN_EXP((ISQ) ? cm_ : -cm_); \
                        _Pragma("unroll") for (int jj = 0; jj < 8; ++jj) f_[jj] = e_; \
                    } else { raw_ = *(const u32x4*)(PB + (size_t)row_ * PW + ((ISQ) ? PC_GQ : PC_GK) + h * 32 + kc0); \
                        const float* cp_ = WSP(float, WS_CUM_G) + ((size_t)dir * MALL + row_) * 128 + h * 32 + kc0; \
                        const f32x4 c0_ = *(const f32x4*)cp_, c1_ = *(const f32x4*)(cp_ + 4); \
                        _Pragma("unroll") for (int jj = 0; jj < 4; ++jj) { f_[jj] = (ISQ) ? SCN_EXP(c0_[jj]) * 0.17677669529663687f : SCN_EXP(-c0_[jj]); f_[4 + jj] = (ISQ) ? SCN_EXP(c1_[jj]) * 0.17677669529663687f : SCN_EXP(-c1_[jj]); } } \
                    dst[ks] = scale8(raw_, f_); } } while (0)
#define SCN_TILE(JT, IT, MASKED) do { bf16x8 kf_[NKS]; SCN_GEN(kf_, false, JT); f32x16 P; \
                _Pragma("unroll") for (int r = 0; r < 16; ++r) P[r] = 0.f; \
                _Pragma("unroll") for (int ks = 0; ks < NKS; ++ks) P = __builtin_amdgcn_mfma_f32_32x32x16_bf16(kf_[ks], qf[ks], P, 0, 0, 0); \
                if (MASKED) { _Pragma("unroll") for (int r = 0; r < 16; ++r) { const int j = crow(r, hi); const bool keep = dir == 0 ? (j <= q32) : (j >= q32); P[r] = keep ? P[r] : 0.f; } } \
                _Pragma("unroll") for (int s = 0; s < 2; ++s) { u32x4 pk; \
                    _Pragma("unroll") for (int j = 0; j < 4; ++j) pk[j] = cvtpk(P[8 * s + 2 * j], P[8 * s + 2 * j + 1]); \
                    _Pragma("unroll") for (int dh = 0; dh < 2; ++dh) { const int d = dh * 32 + q32, x = (d >> 1) & 15, kc = 8 * JT + 4 * s + hi; \
                        const u32x2 v0 = *(const LAS u32x2*)(myv + d * 128 + 8 * (kc ^ x)), v1 = *(const LAS u32x2*)(myv + d * 128 + 8 * ((kc + 2) ^ x)); \
                        o[IT][dh] = __builtin_amdgcn_mfma_f32_32x32x16_bf16(__builtin_bit_cast(bf16x8, pk), __builtin_bit_cast(bf16x8, (u32x4){v0.x, v0.y, v1.x, v1.y}), o[IT][dh], 0, 0, 0); } } } while (0)
#define SCN_INTER(IT) do { const LAS unsigned char* area = lds + wid * 8192; \
                _Pragma("unroll") for (int dh = 0; dh < 2; ++dh) _Pragma("unroll") for (int ks = 0; ks < NKS; ++ks) { \
                    const int d = dh * 32 + q32, sw = DK == 64 ? ((d >> 1) & 7) : ((d >> 2) & 3); \
                    const bf16x8 sf = *(const LAS bf16x8*)(area + d * (DK * 2) + 16 * ((2 * ks + hi) ^ sw)); \
                    o[IT][dh] = __builtin_amdgcn_mfma_f32_32x32x16_bf16(qf[ks], sf, o[IT][dh], 0, 0, 0); } } while (0)
            { bf16x8 qf[NKS]; SCN_GEN(qf, true, 0);
              SCN_TILE(0, 0, true); if (dir == 1) SCN_TILE(1, 0, false);
              SCN_INTER(0); }
            asm volatile("" ::: "memory");
            { bf16x8 qf[NKS]; SCN_GEN(qf, true, 1);
              if (dir == 0) SCN_TILE(0, 1, false);
              SCN_TILE(1, 1, true);
              SCN_INTER(1); }
#undef SCN_GEN
#undef SCN_TILE
#undef SCN_INTER
        }
        asm volatile("s_waitcnt lgkmcnt(0)" ::: "memory");
        __syncthreads();
    }
    if (act) {
        const int gcol = (MX == 0 ? PC_RG : PC_GR) + h * 64, ccol = (MX == 0 ? 512 : 768) + h * 64;
        const float g0 = MX == 0 ? p.ret_norm_g[l * 256 + h * 64 + q32] : p.gla_norm_g[l * 64 + q32], g1 = MX == 0 ? p.ret_norm_g[l * 256 + h * 64 + 32 + q32] : p.gla_norm_g[l * 64 + 32 + q32];
#pragma unroll
        for (int it = 0; it < 2; ++it)
#pragma unroll
            for (int r = 0; r < 16; ++r) {
                const int row = row0 + 32 * it + crow(r, hi);
                const float a0 = o[it][0][r], a1 = o[it][1][r];
                float ss = a0 * a0 + a1 * a1;
#pragma unroll
                for (int x = 1; x < 32; x <<= 1) ss += __shfl_xor(ss, x);
                const float rstd = rsqrtf(ss * (1.f / 64.f) + EPS);
                const float gt0 = bf2f(PB[(size_t)row * PW + gcol + q32]), gt1 = bf2f(PB[(size_t)row * PW + gcol + 32 + q32]);
                bf16_t* op = WSP(bf16_t, WS_CONCAT) + (size_t)row * D + ccol + q32;
                op[0] = f2bf(a0 * rstd * g0 * (gt0 / (1.f + SCN_EXP(-gt0)))); op[32] = f2bf(a1 * rstd * g1 * (gt1 / (1.f + SCN_EXP(-gt1))));
                if ((r & 3) == 3) asm volatile("" ::: "memory");
            }
    }
}
__device__ __forceinline__ bool scan_unit(int slot, bool with_ctx, int& mx, int& bh, int& g) {
    if (slot < 256) { mx = slot >> 7; const int r = slot & 127; bh = r >> 3; g = r & 7; return true; }
    if (!with_ctx) return false;
    const int j = slot - 256 - 128;
    if (j < 0 || j >= 32) return false;
    mx = j >> 4; bh = j & 15; g = 8; return true;
}
__device__ __forceinline__ void d_scan_stage1(KP kp, int l) {
    PH_IDS;
    for (int slot = bid; slot < 512; slot += gridDim.x) {
        int mx, bh, g; if (!scan_unit(slot, true, mx, bh, g)) continue;
        if (mx == 0) scan_stage1_unit<0>(kp, l, bh >> 2, bh & 3, g, tid); else scan_stage1_unit<1>(kp, l, bh >> 2, bh & 3, g, tid);
    }
}
__device__ __forceinline__ void d_scan_stage2(KP kp, int l, LAS unsigned char* lds) {
    PH_IDS;
    for (int slot = bid; slot < 512; slot += gridDim.x) {
        int mx, bh, g; if (!scan_unit(slot, l == 0, mx, bh, g)) continue;
        if (mx == 0) scan_stage2_unit<0>(kp, l, bh >> 2, bh & 3, g, lds, tid); else scan_stage2_unit<1>(kp, l, bh >> 2, bh & 3, g, lds, tid);
    }
}
namespace hfft {
typedef float f2 __attribute__((ext_vector_type(2)));
typedef float f4 __attribute__((ext_vector_type(4)));
constexpr int N = 8192;
__device__ __forceinline__ f2 cmul(f2 a, f2 b) { return (f2){a.x * b.x - a.y * b.y, a.x * b.y + a.y * b.x}; }
__device__ __forceinline__ f2 cmulc(f2 a, f2 b) { return (f2){a.x * b.x + a.y * b.y, a.y * b.x - a.x * b.y}; }
__device__ __forceinline__ f2 tw(float frac) { float sn, cs; sincosf(6.283185307179586f * frac, &sn, &cs); return (f2){cs, -sn}; }
constexpr int TWOFF = 131072 + 64;
__device__ __forceinline__ void tw_build(LAS unsigned char* lds, int tid) { LAS f2* T = (LAS f2*)(lds + TWOFF); for (int k = tid; k < 1024; k += NT) T[k] = tw((float)k * (1.f / 8192.f)); }
__device__ __forceinline__ f2 twk(const LAS f2* T, int k) {
    const f2 a = T[k & 1023]; const float r = 0.70710678118654752f;
    return (k & 1024) ? (f2){(a.x + a.y) * r, (a.y - a.x) * r} : a;
}
__device__ __forceinline__ f2 mul_mi(f2 a) { return (f2){a.y, -a.x}; }
__device__ __forceinline__ f2 mul_pi(f2 a) { return (f2){-a.y, a.x}; }
template <int LOGD> __device__ __forceinline__ void fwd_pass(LAS f2* buf, int tid) {
    constexpr int Dd = 1 << LOGD;
#pragma unroll
    for (int g = 0; g < 4; ++g) {
        const int u = tid + NT * g, pos = u & (Dd - 1), base = ((u - pos) << 2) + pos;
        const f2 wA = twk((const LAS f2*)((LAS unsigned char*)buf + TWOFF), pos << (11 - LOGD)), wB = cmul(wA, wA);
#pragma unroll
        for (int arr = 0; arr < 2; ++arr) {
            LAS f2* x = buf + arr * N + base;
            const f2 a0 = x[0], a1 = x[Dd], a2 = x[2 * Dd], a3 = x[3 * Dd];
            const f2 b0 = a0 + a2, b2 = cmul(a0 - a2, wA), b1 = a1 + a3, b3 = mul_mi(cmul(a1 - a3, wA));
            x[0] = b0 + b1; x[Dd] = cmul(b0 - b1, wB); x[2 * Dd] = b2 + b3; x[3 * Dd] = cmul(b2 - b3, wB);
        }
    }
    __syncthreads();
}
template <int LOGD> __device__ __forceinline__ void inv_pass(LAS f2* buf, int tid) {
    constexpr int Dd = 1 << LOGD;
#pragma unroll
    for (int g = 0; g < 4; ++g) {
        const int u = tid + NT * g, pos = u & (Dd - 1), base = ((u - pos) << 2) + pos;
        const f2 wA = twk((const LAS f2*)((LAS unsigned char*)buf + TWOFF), pos << (11 - LOGD)), wB = cmul(wA, wA);
#pragma unroll
        for (int arr = 0; arr < 2; ++arr) {
            LAS f2* x = buf + arr * N + base;
            const f2 c0 = x[0], c1 = cmulc(x[Dd], wB), c2 = x[2 * Dd], c3 = cmulc(x[3 * Dd], wB);
            const f2 b0 = c0 + c1, b1 = c0 - c1, b2 = cmulc(c2 + c3, wA), b3 = mul_pi(cmulc(c2 - c3, wA));
            x[0] = b0 + b2; x[2 * Dd] = b0 - b2; x[Dd] = b1 + b3; x[3 * Dd] = b1 - b3;
        }
    }
    __syncthreads();
}
__device__ __forceinline__ void fwd_all(LAS f2* buf, int tid) { fwd_pass<11>(buf, tid); fwd_pass<9>(buf, tid); fwd_pass<7>(buf, tid); fwd_pass<5>(buf, tid); fwd_pass<3>(buf, tid); fwd_pass<1>(buf, tid); }
__device__ __forceinline__ void inv_all(LAS f2* buf, int tid) { inv_pass<1>(buf, tid); inv_pass<3>(buf, tid); inv_pass<5>(buf, tid); inv_pass<7>(buf, tid); inv_pass<9>(buf, tid); inv_pass<11>(buf, tid); }
}
__device__ __forceinline__ void d_fspec(KP kp, LAS unsigned char* lds) {
    PH_IDS;
    using namespace hfft;
    LAS f2* buf = (LAS f2*)lds; LAS float* nrm = (LAS float*)(lds + 131072);
    tw_build(lds, tid);
    for (int u = bid; u < 256; u += gridDim.x) {
        const int l = u >> 7, c0 = (u & 127) * 2;
        const float* filt = WSP(float, WS_FILT) + (size_t)l * 8192 * 256;
        if (tid < 128) {
            const int arr = tid >> 6, ln = tid & 63; float a = 0.f;
#pragma unroll
            for (int q = 0; q < 4; ++q) a += WSP(float, WS_PS)[(size_t)(l * 256 + ln * 4 + q) * 256 + c0 + arr];
            a = wave_sum(a); if (ln == 0) nrm[arr] = a;
        }
        for (int i = tid; i < 2 * N; i += NT) { const int arr = i >> 13, tau = i & (N - 1); buf[i] = (f2){filt[(size_t)tau * 256 + c0 + arr], 0.f}; }
        __syncthreads();
        fwd_all(buf, tid);
        f4* fs = (f4*)(WSP(float, WS_FSPEC) + ((size_t)l * 256 + c0) * 2 * N);
        for (int i = tid; i < N; i += NT) {
            const int arr = i >> 12, j = i & 4095;
            const f4 v = *(const LAS f4*)(buf + arr * N + 2 * j);
            const float sc = 1.f / (8192.f * nrm[arr]), bs = p.hy_bias[l * 256 + c0 + arr] * (1.f / 8192.f);
            fs[(size_t)arr * (N / 2) + j] = (f4){(v.x + v.z) * sc + bs, (v.y + v.w) * sc, (v.x - v.z) * sc + bs, (v.y - v.w) * sc};
        }
        __syncthreads();
    }
}
__device__ __forceinline__ void d_hy_pre_fast(KP kp, int l, LAS unsigned char* lds) {
    PH_IDS;
    LAS float* zt = (LAS float*)lds;
    const bf16_t* PB = WSP(bf16_t, WS_PBUF);
    const int c = tid & 255, half = tid >> 8;
    const float* sw = p.hy_short_w + l * 3 * 768; const float* sb = p.hy_short_b + l * 768;
    float w0[3], w1[3], w2[3], bb[3];
#pragma unroll
    for (int g = 0; g < 3; ++g) { w0[g] = sw[g * 256 + c]; w1[g] = sw[768 + g * 256 + c]; w2[g] = sw[1536 + g * 256 + c]; bb[g] = sb[g * 256 + c]; }
    for (int u = bid; u < NLAT / 64; u += gridDim.x) {
        const int row0 = u * 64 + half * 32, t0 = (u * 64) & (SEQ - 1);
        const int tfirst = t0 + half * 32;
        float xin[3][34];
#pragma unroll
        for (int g = 0; g < 3; ++g) {
            const bf16_t* pp = PB + (size_t)row0 * PW + PC_HY + g * 256 + c;
#pragma unroll
            for (int i = 0; i < 34; ++i) { const int t = tfirst + i - 1, tc = t < 0 ? 0 : (t > SEQ - 1 ? SEQ - 1 : t); const float v = bf2f(pp[(ptrdiff_t)(tc - tfirst) * PW]); xin[g][i] = (t == tc) ? v : 0.f; }
        }
#pragma unroll
        for (int i = 0; i < 32; ++i) {
            float uu[3];
#pragma unroll
            for (int g = 0; g < 3; ++g) uu[g] = bb[g] + w0[g] * xin[g][i] + w1[g] * xin[g][i + 1] + w2[g] * xin[g][i + 2];
            WSP(bf16_t, WS_X0B)[(size_t)(row0 + i) * 256 + c] = f2bf(uu[0]);
            zt[c * 65 + half * 32 + i] = uu[1] * uu[2];
        }
        __syncthreads();
        const int b = (u * 64) >> 12;
        for (int i = tid; i < 256 * 64; i += NT) { const int cc = i >> 6, tl = i & 63; WSP(float, WS_ZT)[((size_t)cc * 4 + b) * SEQ + t0 + tl] = zt[cc * 65 + tl]; }
        __syncthreads();
    }
    if (l == 0) {
        GT_LOOP(idx, NCTX * 256) {
            const int r = idx >> 8, cc = idx & 255, t = r & (CTXL - 1);
            const bf16_t* pp = PB + (size_t)(NLAT + r) * PW + PC_HY + cc;
            float uu[3];
#pragma unroll
            for (int g = 0; g < 3; ++g) { float a = sb[g * 256 + cc] + sw[768 + g * 256 + cc] * bf2f(pp[g * 256]);
                const float pv = bf2f(pp[g * 256 - (t > 0 ? PW : 0)]), nv = bf2f(pp[g * 256 + (t < CTXL - 1 ? PW : 0)]);
                a += sw[g * 256 + cc] * (t > 0 ? pv : 0.f) + sw[1536 + g * 256 + cc] * (t < CTXL - 1 ? nv : 0.f); uu[g] = a; }
            WSP(float, WS_X0C)[idx] = uu[0]; WSP(float, WS_ZC)[idx] = uu[1] * uu[2];
        }
    }
}
__device__ __forceinline__ void d_hy_fft(KP kp, int l, LAS unsigned char* lds) {
    PH_IDS;
    using namespace hfft;
    LAS f2* buf = (LAS f2*)lds;
    tw_build(lds, tid);
    for (int c = bid; c < 256; c += gridDim.x) {
        const float* zt = WSP(float, WS_ZT) + (size_t)c * 4 * SEQ;
#pragma unroll
        for (int arr = 0; arr < 2; ++arr) {
            float re[8], im[8];
#pragma unroll
            for (int i = 0; i < 8; ++i) { re[i] = zt[(size_t)(2 * arr) * SEQ + tid + i * NT]; im[i] = zt[(size_t)(2 * arr + 1) * SEQ + tid + i * NT]; }
            f2 zz; { float zx_, zy_; asm volatile("v_mov_b32 %0, 0\n\tv_mov_b32 %1, 0" : "=v"(zx_), "=v"(zy_)); zz = (f2){zx_, zy_}; }
#pragma unroll
            for (int i = 0; i < 8; ++i) { buf[arr * N + tid + i * NT] = (f2){re[i], im[i]}; buf[arr * N + SEQ + tid + i * NT] = zz; }
        }
        __syncthreads();
        fwd_all(buf, tid);
        const f4* fs = (const f4*)(WSP(float, WS_FSPEC) + ((size_t)l * 256 + c) * 2 * N);
        for (int i = tid; i < N; i += NT) {
            const int arr = i >> 12, j = i & 4095;
            LAS f4* xp = (LAS f4*)(buf + arr * N + 2 * j);
            const f4 v = *xp; const f4 f = fs[j];
            const f2 s = cmul((f2){v.x + v.z, v.y + v.w}, (f2){f.x, f.y}), d = cmul((f2){v.x - v.z, v.y - v.w}, (f2){f.z, f.w});
            *xp = (f4){s.x + d.x, s.y + d.y, s.x - d.x, s.y - d.y};
        }
        __syncthreads();
        inv_all(buf, tid);
        float* yt = WSP(float, WS_YT) + (size_t)c * 4 * SEQ;
        for (int i = tid; i < 2 * SEQ; i += NT) { const int arr = i >> 12, t = i & (SEQ - 1); const f2 v = buf[arr * N + t];
            yt[(size_t)(2 * arr) * SEQ + t] = v.x; yt[(size_t)(2 * arr + 1) * SEQ + t] = v.y; }
        __syncthreads();
    }
}
__device__ __forceinline__ void d_hy_post(KP kp, int l, LAS unsigned char* lds) {
    PH_IDS;
    LAS float* yt = (LAS float*)lds;
    for (int u = bid; u < NLAT / 64; u += gridDim.x) {
        const int b = (u * 64) >> 12, t0 = (u * 64) & (SEQ - 1);
#pragma unroll 1
        for (int hb2 = 0; hb2 < 4; ++hb2) {
            float yv[8];
#pragma unroll
            for (int i = 0; i < 8; ++i) { const int idx = tid + (hb2 * 8 + i) * NT; yv[i] = WSP(float, WS_YT)[((size_t)(idx >> 6) * 4 + b) * SEQ + t0 + (idx & 63)]; }
#pragma unroll
            for (int i = 0; i < 8; ++i) { const int idx = tid + (hb2 * 8 + i) * NT; yt[(idx >> 6) * 65 + (idx & 63)] = yv[i]; }
            asm volatile("" ::: "memory");
        }
        __syncthreads();
        {
            const int c = tid & 255, th = tid >> 8;
#pragma unroll 1
            for (int hb2 = 0; hb2 < 4; ++hb2) {
                float x0v[8];
#pragma unroll
                for (int i = 0; i < 8; ++i) x0v[i] = bf2f(WSP(bf16_t, WS_X0B)[((size_t)u * 64 + 2 * (hb2 * 8 + i) + th) * 256 + c]);
#pragma unroll
                for (int i = 0; i < 8; ++i) { const int tl = 2 * (hb2 * 8 + i) + th; WSP(bf16_t, WS_CONCAT)[((size_t)u * 64 + tl) * D + 256 + c] = f2bf(x0v[i] * yt[c * 65 + tl]); }
                asm volatile("" ::: "memory");
            }
        }
        __syncthreads();
    }
    if (l == 0) {
        GT_LOOP(idx, NCTX * 256) {
            const int c = idx & 255, r = idx >> 8, t = r & (CTXL - 1), rb = r - t;
            const float* filt = WSP(float, WS_FILTC); const float* zc = WSP(float, WS_ZC);
            float nrm = 0.f;
#pragma unroll
            for (int q = 0; q < 16; ++q) nrm += WSP(float, WS_PS)[(size_t)(512 + q) * 256 + c];
            float y = 0.f;
#pragma unroll 32
            for (int s2 = 0; s2 < CTXL; ++s2) y += filt[(size_t)((t - s2) & (2 * CTXL - 1)) * 256 + c] * zc[(size_t)(rb + s2) * 256 + c];
            y = y / nrm + p.hy_bias[c] * zc[idx];
            WSP(bf16_t, WS_CONCAT)[(size_t)(NLAT + r) * D + 256 + c] = f2bf(WSP(float, WS_X0C)[idx] * y);
        }
    }
}
constexpr int CW_BAR = 32768;
__global__ void __launch_bounds__(NT, 2) mk_fwd(P kargs) {
    const KP kp0 = (KP)((unsigned long long)__builtin_amdgcn_kernarg_segment_ptr() | (unsigned long long)(unsigned)__builtin_amdgcn_readfirstlane(threadIdx.x >> 6));
    KP kp = kp0;
#define LP ({ KP k_ = kp0; asm volatile("" : "+s"(k_)); k_; })
    unsigned char* const lds = g_lds;
    volatile LAS unsigned* misc = (volatile LAS unsigned*)((LAS unsigned char*)lds + LDS_MISC);
    if (threadIdx.x < 16) misc[threadIdx.x] = 0u;
    __syncthreads();
    (void)xcd_barrier_post(WSP(unsigned, WS_CTL) + CW_BAR, misc);
#define GRID_BAR() do { XcdBarrier b_; bool t0_; { KP kp = LP; b_.bar = WSP(unsigned, WS_CTL) + CW_BAR; t0_ = ltid_kp(kp) == 0; } b_.x = xb_xcc_id(); b_.st = (volatile LAS unsigned*)((LAS unsigned char*)lds + LDS_MISC); xcd_barrier(b_, t0_); } while (0)
    d_pro0(LP, (LAS float*)((LAS unsigned char*)lds + 98304)); d_filter(LP, (LAS float*)((LAS unsigned char*)lds + 73728)); d_convert_a(LP, (LAS float*)lds);
    GRID_BAR();
    d_pro1(LP); d_convert_b(LP, (LAS float*)lds);
    GRID_BAR();
    d_fspec(LP, (LAS unsigned char*)lds); d_norm1(LP, 0);
    GRID_BAR();
#pragma unroll 1
    for (int l = 0; l < DEPTH; ++l) {
        d_gemm_in(LP, l, (LAS unsigned char*)lds);
        GRID_BAR();
        d_prep_scan(LP); d_prep_attn(LP); d_hy_pre_fast(LP, l, (LAS unsigned char*)lds);
        GRID_BAR();
        d_scan_stage1(LP, l);
        d_hy_fft(LP, l, (LAS unsigned char*)lds);
        d_attn_fast(LP, l, (LAS unsigned char*)lds);
        GRID_BAR();
        d_scan_stage2(LP, l, (LAS unsigned char*)lds);
        d_hy_post(LP, l, (LAS unsigned char*)lds);
        GRID_BAR();
        d_gemm_out(LP, l, (LAS unsigned char*)lds);
        GRID_BAR();
        d_router(LP, l, (LAS float*)lds);
        GRID_BAR();
        d_moe_up(LP, l, (LAS unsigned char*)lds);
        GRID_BAR();
        d_moe_down(LP, l, (LAS unsigned char*)lds);
        GRID_BAR();
        d_combine(LP, l, (LAS int*)lds);
        GRID_BAR();
    }
}

#undef p
extern "C" void kernel_launch(void* const* d_in, const int* in_sizes, int n_in, void* d_out, int out_size, void* d_ws, size_t ws_size, hipStream_t stream) {
    if (n_in != 31 || ws_size < WS_END || out_size != NLAT * D) { fprintf(stderr, "kernel_launch: unexpected shapes (n_in %d ws %zu out %d)\n", n_in, ws_size, out_size); return; }
    static int grid = 0;
    if (grid == 0) {
        int dev = 0, cus = 0, per_cu = 0;
        if (hipGetDevice(&dev) != hipSuccess || hipDeviceGetAttribute(&cus, hipDeviceAttributeMultiprocessorCount, dev) != hipSuccess) { grid = -1; return; }
        if (hipFuncSetAttribute((const void*)mk_fwd, hipFuncAttributeMaxDynamicSharedMemorySize, LDS_BYTES) != hipSuccess) { fprintf(stderr, "hipFuncSetAttribute failed\n"); grid = -1; return; }
        if (hipOccupancyMaxActiveBlocksPerMultiprocessor(&per_cu, (const void*)mk_fwd, NT, LDS_BYTES) != hipSuccess || per_cu < 1) { fprintf(stderr, "occupancy query says %d\n", per_cu); }
        (void)hipGetLastError();
        grid = cus;
    }
    if (grid < 0) return;
    P hp{};
    const float** pp = (const float**)&hp;
    for (int i = 0; i < 31; ++i) pp[i] = (const float*)d_in[i];
    hp.out = (float*)d_out; hp.ws = (unsigned char*)d_ws;
    (void)hipMemsetAsync((char*)d_ws + WS_CTL, 0, 1 * MiB, stream);
    hipLaunchKernelGGL(mk_fwd, dim3(grid), dim3(NT), LDS_BYTES, stream, hp);
}
```

```cpp
#include <hip/hip_runtime.h>
#include <stdint.h>
#include <stdio.h>
#include <math.h>

constexpr int D = 1024, BATCH = 4, SEQ = 4096, CTXL = 256, DEPTH = 2;
constexpr int NLAT = BATCH * SEQ, NCTX = BATCH * CTXL, MALL = NLAT + NCTX;
constexpr int INW = 3360, PW = 3584;
constexpr int NEXP = 32, TOPK = 4;
constexpr float EPS = 1e-6f;
constexpr int PC_AQ = 0, PC_AK = 256, PC_AV = 512, PC_HY = 768, PC_RQ = 1536, PC_RK = 1792, PC_RV = 2048, PC_RG = 2304,
              PC_GQ = 2560, PC_GK = 2688, PC_GV = 2816, PC_GR = 3072, PC_GD = 3328;
constexpr int ACT_ROWS = MALL * TOPK + NEXP * 256;

typedef unsigned short bf16_t;
typedef float cvt_f32x2_t __attribute__((ext_vector_type(2))); typedef __bf16 cvt_bf16x2_t __attribute__((ext_vector_type(2)));
__device__ __forceinline__ unsigned cvtpk_rne(float lo, float hi) { cvt_f32x2_t v = {lo, hi}; cvt_bf16x2_t b = __builtin_convertvector(v, cvt_bf16x2_t); return __builtin_bit_cast(unsigned, b); }
__device__ __forceinline__ bf16_t f2bf(float f) { unsigned u = __float_as_uint(f); return (bf16_t)((u + 0x7fffu + ((u >> 16) & 1u)) >> 16); }
__device__ __forceinline__ float bf2f(bf16_t b) { return __uint_as_float(((unsigned)b) << 16); }

typedef unsigned gv4u __attribute__((ext_vector_type(4))); typedef float gv4f __attribute__((ext_vector_type(4))); typedef unsigned gv2u __attribute__((ext_vector_type(2)));
__device__ __forceinline__ float gblo(unsigned w) { return __uint_as_float(w << 16); }
__device__ __forceinline__ float gbhi(unsigned w) { return __uint_as_float(w & 0xffff0000u); }
__device__ __forceinline__ unsigned pk4_fp8(float a, float b, float c, float d) { int r = __builtin_amdgcn_cvt_pk_fp8_f32(a, b, 0, false); r = __builtin_amdgcn_cvt_pk_fp8_f32(c, d, r, true); return (unsigned)r; }
constexpr float W8_SCALE = 64.f;
constexpr size_t MiB = 1u << 20;
constexpr size_t WS_CTL = 0;
constexpr size_t WS_MOD = 1 * MiB;
constexpr size_t WS_WEFF = 3 * MiB;
constexpr size_t WS_FILT = 6 * MiB;
constexpr size_t WS_FILTC = WS_FILT + 16 * MiB;
constexpr size_t WS_XRES = 24 * MiB;
constexpr size_t WS_HB = WS_XRES + 68 * MiB;
constexpr size_t WS_PBUF = WS_HB + 34 * MiB;
constexpr size_t WS_CONCAT = WS_PBUF + 120 * MiB;
constexpr size_t WS_YBUF = WS_CONCAT + 34 * MiB;
constexpr size_t WS_QA = WS_YBUF + 68 * MiB;
constexpr size_t WS_KA = WS_QA + 17 * MiB;
constexpr size_t WS_QR = WS_KA + 17 * MiB;
constexpr size_t WS_KR = WS_QR + 17 * MiB;
constexpr size_t WS_OA = WS_KR + 17 * MiB;
constexpr size_t WS_Z = WS_OA + 34 * MiB;
constexpr size_t WS_X0 = WS_Z + 17 * MiB;
constexpr size_t WS_LA = WS_X0 + 17 * MiB;
constexpr size_t WS_OD = WS_LA + 17 * MiB;
constexpr size_t WS_TOPI = WS_OD + 68 * MiB;
constexpr size_t WS_TOPW = WS_TOPI + 1 * MiB;
constexpr size_t WS_LIST = WS_TOPW + 1 * MiB;
constexpr size_t WS_ACT = WS_LIST + 3 * MiB;
constexpr size_t WS_YSLOT = WS_ACT + 160 * MiB;
constexpr size_t WS_WIN_T = WS_YSLOT + 160 * MiB;
constexpr size_t WS_WOUT_T = WS_WIN_T + 14 * MiB;
constexpr size_t WS_W1_T = WS_WOUT_T + 4 * MiB;
constexpr size_t WS_W2_T = WS_W1_T + 256 * MiB;
constexpr size_t WS_BIAS_IN = WS_W2_T + 128 * MiB;
constexpr size_t WS_QRP = WS_BIAS_IN + 1 * MiB;
constexpr size_t WS_KIMG = WS_QRP + 9 * MiB;
constexpr size_t WS_VIMG = WS_KIMG + 9 * MiB;
constexpr size_t WS_QF_R = WS_VIMG + 9 * MiB;
constexpr size_t WS_KF_R = WS_QF_R + 9 * MiB;
constexpr size_t WS_KT_R = WS_KF_R + 9 * MiB;
constexpr size_t WS_KT_G = WS_KT_R + 9 * MiB;
constexpr size_t WS_VT_R = WS_KT_G + 5 * MiB;
constexpr size_t WS_VT_G = WS_VT_R + 9 * MiB;
constexpr size_t WS_CUM_G = WS_VT_G + 9 * MiB;
constexpr size_t WS_CUMT_G = WS_CUM_G + 17 * MiB;
constexpr size_t WS_US_R = WS_CUMT_G + 17 * MiB;
constexpr size_t WS_US_G = WS_US_R + 34 * MiB;
constexpr size_t WS_UG_R = WS_US_G + 17 * MiB;
constexpr size_t WS_UG_G = WS_UG_R + 5 * MiB;
constexpr size_t WS_AG = WS_UG_G + 3 * MiB;
constexpr size_t WS_ROPE = WS_AG + 1 * MiB;
constexpr size_t WS_FSPEC = WS_ROPE + 1 * MiB;
constexpr size_t WS_ZT = WS_FSPEC + 32 * MiB;
constexpr size_t WS_YT = WS_ZT + 16 * MiB;
constexpr size_t WS_X0B = WS_YT + 16 * MiB;
constexpr size_t WS_MODP = WS_X0B + 8 * MiB;
constexpr size_t WS_PS = WS_MODP + 4 * MiB;
constexpr size_t WS_ZC = WS_PS + 1 * MiB;
constexpr size_t WS_X0C = WS_ZC + 1 * MiB;
constexpr size_t WS_HB8 = WS_X0C + 1 * MiB;
constexpr size_t WS_END = WS_HB8 + 17 * MiB;
constexpr int CW_CNT = 1024;
constexpr int CW_NORM = 2048;

struct P {
    const float *x, *c, *ctx, *c_ctx, *w_mod, *b_mod, *norm_g, *w_in, *w_out, *diff_lambda, *diff_subln_g, *hy_short_w, *hy_short_b,
        *hy_w1, *hy_b1, *hy_w2, *hy_b2, *hy_w3, *hy_freq, *hy_bias, *ret_decay, *ret_norm_g, *gla_gate_w, *gla_gate_b, *gla_norm_g,
        *router_w, *router_b, *exp_w1, *exp_b1, *exp_w2, *exp_b2;
    float* out; unsigned char* ws;
};
typedef const __attribute__((address_space(4))) P* KP;
#define KP_PTR(kp_) ((KP)((unsigned long long)(kp_) & ~7ull))
#define p (*KP_PTR(kp))
#define WSP(T, off) ((T*)(p.ws + (off)))

__device__ __forceinline__ float wave_sum(float v) {
#pragma unroll
    for (int o = 1; o < 64; o <<= 1) v += __shfl_xor(v, o);
    return v;
}
__device__ __forceinline__ float silu_f(float x) { return x / (1.f + expf(-x)); }
__host__ __device__ __forceinline__ int nrows_l(int l) { return l == 0 ? MALL : NLAT; }
__device__ __forceinline__ int mod_r(int row) { return row < NLAT ? row / SEQ : 4; }
__device__ __forceinline__ void seq_info(int row, int& base, int& n, int& t) {
    if (row < NLAT) { base = row & ~(SEQ - 1); n = SEQ; t = row - base; }
    else { int r = row - NLAT; base = NLAT + (r & ~(CTXL - 1)); n = CTXL; t = row - base; }
}

#define XB_TMO      128
#define XB_XCNT(j)  (256  + 64 * (j))
#define XB_XSUB(j)  (1280 + 64 * (j))
#define XB_XGEN(j)  (2304 + 64 * (j))
#define XB_TOP      3328
#define XB_TOPGEN   3392
#define XCD_BAR_WORDS 3456
#define XB_SPIN_CAP (1u << 22)
#define LAS __attribute__((address_space(3)))
__device__ __forceinline__ unsigned xb_ld(unsigned* ptr)            { return __hip_atomic_load(ptr, __ATOMIC_RELAXED, __HIP_MEMORY_SCOPE_AGENT); }
__device__ __forceinline__ unsigned xb_add(unsigned* ptr, unsigned v) { return __hip_atomic_fetch_add(ptr, v, __ATOMIC_RELAXED, __HIP_MEMORY_SCOPE_AGENT); }
__device__ __forceinline__ unsigned xb_xcc_id() { return (unsigned)__builtin_amdgcn_s_getreg((3 << 11) | 20) & 0xFu; }
#define XB_SPIN(cond, bar) do { unsigned _sp = 0; while (cond) { __builtin_amdgcn_s_sleep(1); \
    if ((++_sp & 255u) == 0u) { if (xb_ld(&(bar)[XB_TMO])) break; if (_sp > XB_SPIN_CAP) { atomicAdd(&(bar)[XB_TMO], 1u); break; } } } } while (0)
struct XcdBarrier { unsigned* bar; unsigned x; volatile LAS unsigned* st; };
__device__ __forceinline__ XcdBarrier xcd_barrier_post(unsigned* bar, volatile LAS unsigned* st) {
    XcdBarrier b; b.bar = bar; b.x = xb_xcc_id(); b.st = st;
    if (threadIdx.x == 0) (void)xb_add(&bar[XB_XCNT(b.x)], 1u);
    return b;
}
__device__ __forceinline__ void xcd_barrier_complete(unsigned* bar, unsigned x, unsigned& nloc, unsigned& nx) {
    const unsigned G = gridDim.x * gridDim.y * gridDim.z;
    unsigned sum, cnt, mine, sp = 0u;
    for (;;) {
        sum = 0u; cnt = 0u; mine = 0u;
#pragma unroll
        for (unsigned j = 0; j < 16; ++j) { const unsigned c = xb_ld(&bar[XB_XCNT(j)]); sum += c; cnt += (c > 0u) ? 1u : 0u; mine = (j == x) ? c : mine; }
        if (sum == G) break;
        __builtin_amdgcn_s_sleep(1);
        if ((++sp & 255u) == 0u) { if (xb_ld(&bar[XB_TMO])) break; if (sp > XB_SPIN_CAP) { atomicAdd(&bar[XB_TMO], 1u); break; } }
    }
    nloc = mine > 0u ? mine : 1u; nx = cnt > 0u ? cnt : 1u;
}
__device__ __forceinline__ void xcd_barrier(const XcdBarrier& b, bool thread0) {
    asm volatile("s_waitcnt vmcnt(0)" ::: "memory");
    __syncthreads();
    if (thread0) {
        unsigned* bar = b.bar;
        __builtin_amdgcn_s_waitcnt(0);
        unsigned nloc = b.st[0], nx = b.st[1];
        if (nloc == 0u) { xcd_barrier_complete(bar, b.x, nloc, nx); b.st[0] = nloc; b.st[1] = nx; }
        const unsigned old = xb_add(&bar[XB_XSUB(b.x)], 1u);
        const unsigned gen = old / nloc;
        if (old + 1u == (gen + 1u) * nloc) {
            __builtin_amdgcn_fence(__ATOMIC_RELEASE, "agent");
            asm volatile("s_waitcnt vmcnt(0)" ::: "memory");
            const unsigned og = xb_add(&bar[XB_TOP], 1u);
            const unsigned tg = og / nx;
            if (og + 1u == (tg + 1u) * nx) xb_add(&bar[XB_TOPGEN], 1u);
            else XB_SPIN(xb_ld(&bar[XB_TOPGEN]) == tg, bar);
            __builtin_amdgcn_fence(__ATOMIC_ACQUIRE, "agent");
            xb_add(&bar[XB_XGEN(b.x)], 1u);
            asm volatile("s_waitcnt vmcnt(0)" ::: "memory");
        } else {
            XB_SPIN(xb_ld(&bar[XB_XGEN(b.x)]) == gen, bar);
            __builtin_amdgcn_fence(__ATOMIC_ACQUIRE, "agent");
            asm volatile("s_waitcnt vmcnt(0)" ::: "memory");
        }
    }
    __syncthreads();
}

constexpr int NT = 512;
extern __shared__ __attribute__((aligned(16))) unsigned char g_lds[];
constexpr int LDS_BYTES = 147456;
constexpr int LDS_MISC = LDS_BYTES - 64;
__device__ __forceinline__ int ltid_kp(KP kp) {
    const int w = (int)((unsigned long long)kp & 7ull);
    unsigned ones = ~0u; asm volatile("" : "+s"(ones));
    int t = (w << 6) | (int)__builtin_amdgcn_mbcnt_hi(ones, __builtin_amdgcn_mbcnt_lo(ones, 0u));
    asm volatile("" : "+v"(t)); return t;
}
__device__ __forceinline__ int lbid() { int b = blockIdx.x; asm volatile("" : "+s"(b)); return b; }
#define PH_IDS const int tid = ltid_kp(kp), bid = lbid(); (void)tid; (void)bid
#define GT_LOOP(idx, total) for (int idx = bid * NT + tid; idx < (total); idx += gridDim.x * NT)
#define GW_LOOP(w, total) for (int w = bid * (NT / 64) + (tid >> 6); w < (total); w += gridDim.x * (NT / 64))

__device__ __forceinline__ const float* xin_row(KP kp, int l, int row) {
    (void)l; return row < NLAT ? p.x + (size_t)row * D : p.ctx + (size_t)(row - NLAT) * D;
}
__device__ __forceinline__ void d_pro0(KP kp, LAS float* sc) {
    PH_IDS;
    GT_LOOP(idx, 64 * 24) {
        const int pos = idx / 24, j = idx % 24; float ang; float* dst;
        if (j < 8) { ang = (float)pos * powf(10000.f, -(float)j / 8.f); dst = WSP(float, WS_ROPE) + (pos * 8 + j) * 2; }
        else { ang = (float)pos * powf(10000.f, -(float)(j - 8) / 16.f); dst = WSP(float, WS_ROPE) + 1024 + (pos * 16 + (j - 8)) * 2; }
        dst[0] = cosf(ang); dst[1] = sinf(ang);
    }
    GT_LOOP(idx, 2 * 1024 * 256) {
        int n = idx & 255, i = (idx >> 8) & 1023, l = idx >> 18, d = n >> 7, j = n & 127;
        float a = 0.f;
        for (int r = 0; r < 16; ++r) a += p.w_in[((size_t)l * D + i) * INW + 3328 + d * 16 + r] * p.gla_gate_w[((l * 2 + d) * 16 + r) * 128 + j];
        WSP(float, WS_WEFF)[idx] = a;
    }
    const int lane = tid & 63;
    for (int i = tid; i < 5 * D; i += NT) { const int r = i >> 10, ii = i & 1023; sc[i] = silu_f(r < 4 ? p.c[r * D + ii] : p.c_ctx[ii]); }
    __syncthreads();
    GW_LOOP(task, 2 * 96 * 16) {
        const int chunk = task & 15, jb = (task >> 4) % 96, l = task / (16 * 96), j = jb * 64 + lane;
        const float* w = p.w_mod + ((size_t)l * D + chunk * 64) * 6144 + j;
        float acc[5] = {0.f, 0.f, 0.f, 0.f, 0.f};
#pragma unroll 8
        for (int i = 0; i < 64; ++i) { const float wv = w[(size_t)i * 6144];
#pragma unroll
            for (int r = 0; r < 5; ++r) acc[r] += sc[r * D + chunk * 64 + i] * wv; }
#pragma unroll
        for (int r = 0; r < 5; ++r) WSP(float, WS_MODP)[((size_t)(chunk * 2 + l) * 5 + r) * 6144 + j] = acc[r];
    }
}
__device__ __forceinline__ void d_filter(KP kp, LAS float* sm) {
    PH_IDS;
    const int lane = tid & 63; LAS float* zf = sm + (tid >> 6) * 192; LAS float* h1 = zf + 64; LAS float* h2 = zf + 128;
    GW_LOOP(task, 2 * SEQ + CTXL) {
        const int which = task < SEQ ? 0 : task < 2 * SEQ ? 1 : 2, pos = task - (which == 2 ? 2 * SEQ : which * SEQ), l = which == 1 ? 1 : 0, n = which == 2 ? CTXL : SEQ;
        float* filt = which == 2 ? WSP(float, WS_FILTC) : WSP(float, WS_FILT) + (size_t)l * 8192 * 256;
        const float t = (float)pos / (float)(n - 1), w = (6.2831855f * (float)pos) / (float)n;
        if (lane < 33) { float v = t; if (lane >= 1) { const int q = (lane - 1) & 15; const float f = 1e-4f + (15.f - 1e-4f) * ((float)q / 15.f), a = w * f; v = lane < 17 ? cosf(a) : -sinf(a); } zf[lane] = v; }
        asm volatile("s_waitcnt lgkmcnt(0)" ::: "memory");
        float a = p.hy_b1[l * 64 + lane];
        for (int i = 0; i < 33; ++i) a += zf[i] * p.hy_w1[(l * 33 + i) * 64 + lane];
        h1[lane] = sinf(p.hy_freq[(l * 2 + 0) * 64 + lane] * a);
        asm volatile("s_waitcnt lgkmcnt(0)" ::: "memory");
        a = p.hy_b2[l * 64 + lane];
        for (int i = 0; i < 64; ++i) a += h1[i] * p.hy_w2[(l * 64 + i) * 64 + lane];
        h2[lane] = sinf(p.hy_freq[(l * 2 + 1) * 64 + lane] * a);
        asm volatile("s_waitcnt lgkmcnt(0)" ::: "memory");
        float raw[8];
#pragma unroll
        for (int q = 0; q < 8; ++q) raw[q] = 0.f;
        for (int j = 0; j < 64; ++j) { const float hj = h2[j]; const float* w3 = p.hy_w3 + (size_t)(l * 64 + j) * 512 + lane;
#pragma unroll
            for (int q = 0; q < 8; ++q) raw[q] += hj * w3[q * 64]; }
        const float mind = logf(1e-2f) / 1.5f, maxd = logf(1e-2f) / 0.3f;
#pragma unroll
        for (int q = 0; q < 8; ++q) {
            const int c = (q & 3) * 64 + lane;
            const float v = raw[q] * expf(-t * fabsf(mind + (maxd - mind) * ((float)c / 255.f)));
            if (q < 4) { filt[(size_t)pos * 256 + c] = v; if (pos == 0) filt[(size_t)n * 256 + c] = 0.f; }
            else if (pos >= 1) filt[(size_t)(2 * n - pos) * 256 + c] = v;
        }
        asm volatile("s_waitcnt lgkmcnt(0)" ::: "memory");
    }
}
__device__ __forceinline__ void d_pro1(KP kp) {
    PH_IDS;
    GT_LOOP(idx, 2 * 5 * 6144) {
        const int j = idx % 6144, r = (idx / 6144) % 5, l = idx / (6144 * 5);
        float a = p.b_mod[l * 6144 + j];
        for (int ch = 0; ch < 16; ++ch) a += WSP(float, WS_MODP)[((size_t)(ch * 2 + l) * 5 + r) * 6144 + j];
        WSP(float, WS_MOD)[idx] = a;
    }
    GT_LOOP(idx, 528 * 256) {
        const int vb = idx >> 8, c = idx & 255, which = vb < 256 ? 0 : vb < 512 ? 1 : 2, slab = vb - (which == 2 ? 512 : which * 256);
        const float* filt = which == 2 ? WSP(float, WS_FILTC) : WSP(float, WS_FILT) + (size_t)which * 8192 * 256;
        float a = 0.f;
#pragma unroll 8
        for (int i = 0; i < 32; ++i) a += fabsf(filt[(size_t)(slab * 32 + i) * 256 + c]);
        WSP(float, WS_PS)[(which * 256 + slab) * 256 + c] = a;
    }
}
__device__ __forceinline__ void d_norm1(KP kp, int l) {
    PH_IDS;
    const int lane = tid & 63;
    GW_LOOP(row, MALL) {
        const float* xr = xin_row(kp, l, row);
        const float* mod = WSP(float, WS_MOD) + (size_t)(l * 5 + mod_r(row)) * 6144;
        const float* g = p.norm_g + (l * 4 + 0) * D;
        gv4f v[4], gg[4], gs[4], gh[4]; float ss = 0.f;
#pragma unroll
        for (int j = 0; j < 4; ++j) { const int ci = j * 256 + lane * 4; v[j] = *(const gv4f*)(xr + ci); gg[j] = *(const gv4f*)(g + ci); gs[j] = *(const gv4f*)(mod + 1024 + ci); gh[j] = *(const gv4f*)(mod + ci); }
#pragma unroll
        for (int j = 0; j < 4; ++j)
#pragma unroll
            for (int q = 0; q < 4; ++q) ss += v[j][q] * v[j][q];
        const float rstd = rsqrtf(wave_sum(ss) * (1.f / D) + EPS);
        bf16_t* hb = WSP(bf16_t, WS_HB) + (size_t)row * D + lane * 4;
#pragma unroll
        for (int j = 0; j < 4; ++j) { float o[4];
#pragma unroll
            for (int q = 0; q < 4; ++q) o[q] = v[j][q] * rstd * gg[j][q] * (1.f + gs[j][q]) + gh[j][q];
            *(gv2u*)(hb + j * 256) = (gv2u){cvtpk_rne(o[0], o[1]), cvtpk_rne(o[2], o[3])}; }
    }
}
__device__ __forceinline__ void d_router(KP kp, int l, LAS float* sm) {
    PH_IDS;
    const int lane = tid & 63;
    for (int i = tid; i < D * 8; i += NT) { const int k = i >> 3, c = i & 7, r = (k >> 8) * 256 + (k & 3) * 64 + ((k >> 2) & 63);
        *(LAS gv4f*)((LAS unsigned char*)sm + r * 128 + 16 * (c ^ ((r >> 1) & 7))) = *(const gv4f*)(p.router_w + (size_t)l * D * NEXP + (size_t)k * 32 + c * 4); }
    LAS int* lcnt = (LAS int*)(sm + 32768); LAS int* lbase = lcnt + 32; LAS int* rec = lcnt + 64;
    LAS float* ws = (LAS float*)(rec + 512) + (tid >> 6) * 64;
    if (tid < 32) lcnt[tid] = 0;
    __syncthreads();
    int it = 0;
    GW_LOOP(row, nrows_l(l)) {
        const float* mod = WSP(float, WS_MOD) + (size_t)(l * 5 + mod_r(row)) * 6144 + lane * 4;
        const float* g1 = p.norm_g + (l * 4 + 1) * D + lane * 4; const float* g2 = p.norm_g + (l * 4 + 2) * D + lane * 4;
        float yv[16], xv[16], ss = 0.f;
        { const bf16_t* y = WSP(bf16_t, WS_YBUF) + (size_t)row * D + lane * 4;
#pragma unroll
          for (int j = 0; j < 4; ++j) { const gv2u w = *(const gv2u*)(y + j * 256); yv[4 * j] = gblo(w.x); yv[4 * j + 1] = gbhi(w.x); yv[4 * j + 2] = gblo(w.y); yv[4 * j + 3] = gbhi(w.y); } }
        if (l == 0) { const float* xs = (row < NLAT ? p.x + (size_t)row * D : p.ctx + (size_t)(row - NLAT) * D) + lane * 4;
#pragma unroll
            for (int j = 0; j < 4; ++j) { const gv4f t = *(const gv4f*)(xs + j * 256); xv[4 * j] = t[0]; xv[4 * j + 1] = t[1]; xv[4 * j + 2] = t[2]; xv[4 * j + 3] = t[3]; } }
        else { const bf16_t* xs = WSP(bf16_t, WS_XRES) + (size_t)row * D + lane * 4;
#pragma unroll
            for (int j = 0; j < 4; ++j) { const gv2u w = *(const gv2u*)(xs + j * 256); xv[4 * j] = gblo(w.x); xv[4 * j + 1] = gbhi(w.x); xv[4 * j + 2] = gblo(w.y); xv[4 * j + 3] = gbhi(w.y); } }
        gv4f ga[4], gn[4];
#pragma unroll
        for (int j = 0; j < 4; ++j) { ga[j] = *(const gv4f*)(mod + 2048 + j * 256); gn[j] = *(const gv4f*)(g1 + j * 256); }
#pragma unroll
        for (int j = 0; j < 16; ++j) ss += yv[j] * yv[j];
        float rstd = rsqrtf(wave_sum(ss) * (1.f / D) + EPS);
        ss = 0.f;
#pragma unroll
        for (int j = 0; j < 16; ++j) { xv[j] = xv[j] + ga[j >> 2][j & 3] * (yv[j] * rstd * gn[j >> 2][j & 3]); ss += xv[j] * xv[j]; }
        gv4f gsc[4], gsh[4];
#pragma unroll
        for (int j = 0; j < 4; ++j) { const gv4f a = *(const gv4f*)(g2 + j * 256), b = *(const gv4f*)(mod + 4096 + j * 256); gsh[j] = *(const gv4f*)(mod + 3072 + j * 256);
#pragma unroll
            for (int q = 0; q < 4; ++q) gsc[j][q] = a[q] * (1.f + b[q]); }
        { bf16_t* xr = WSP(bf16_t, WS_XRES) + (size_t)row * D + lane * 4;
#pragma unroll
          for (int j = 0; j < 4; ++j) *(gv2u*)(xr + j * 256) = (gv2u){cvtpk_rne(xv[4 * j], xv[4 * j + 1]), cvtpk_rne(xv[4 * j + 2], xv[4 * j + 3])}; }
        rstd = rsqrtf(wave_sum(ss) * (1.f / D) + EPS);
        unsigned char* hb = WSP(unsigned char, WS_HB8) + (size_t)row * D + lane * 4;
        float v[32];
#pragma unroll
        for (int e = 0; e < 32; ++e) v[e] = 0.f;
#pragma unroll
        for (int j = 0; j < 4; ++j) {
#pragma unroll
            for (int q = 0; q < 4; ++q) xv[4 * j + q] = xv[4 * j + q] * rstd * gsc[j][q] + gsh[j][q];
            *(unsigned*)(hb + j * 256) = pk4_fp8(xv[4 * j], xv[4 * j + 1], xv[4 * j + 2], xv[4 * j + 3]); }
        { const LAS unsigned char* wb = (const LAS unsigned char*)sm + lane * 128; const int sw = (lane >> 1) & 7;
#pragma unroll
          for (int jq = 0; jq < 16; ++jq) { const float hv = xv[jq];
#pragma unroll
            for (int c = 0; c < 8; ++c) { const gv4f w = *(const LAS gv4f*)(wb + ((jq >> 2) * 256 + (jq & 3) * 64) * 128 + 16 * (c ^ sw));
                v[4 * c] += hv * w[0]; v[4 * c + 1] += hv * w[1]; v[4 * c + 2] += hv * w[2]; v[4 * c + 3] += hv * w[3]; }
            asm volatile("" : "+v"(v[0]), "+v"(v[8]), "+v"(v[16]), "+v"(v[24])); } }
#pragma unroll
        for (int k = 0; k < 16; ++k) { const auto r_ = __builtin_amdgcn_permlane32_swap(__float_as_uint(v[k]), __float_as_uint(v[k + 16]), false, false); v[k] = __uint_as_float(r_[0]) + __uint_as_float(r_[1]); }
#pragma unroll
        for (int k = 0; k < 8; ++k) { const auto r_ = __builtin_amdgcn_permlane16_swap(__float_as_uint(v[k]), __float_as_uint(v[k + 8]), false, false); v[k] = __uint_as_float(r_[0]) + __uint_as_float(r_[1]); }
#pragma unroll
        for (int k = 0; k < 4; ++k) { const bool up = lane & 8; const float send = up ? v[k] : v[k + 4], keep = up ? v[k + 4] : v[k]; v[k] = keep + __shfl_xor(send, 8); }
#pragma unroll
        for (int k = 0; k < 2; ++k) { const bool up = lane & 4; const float send = up ? v[k] : v[k + 2], keep = up ? v[k + 2] : v[k]; v[k] = keep + __shfl_xor(send, 4); }
        { const bool up = lane & 2; const float send = up ? v[0] : v[1], keep = up ? v[1] : v[0]; v[0] = keep + __shfl_xor(send, 2); }
        const int myexp = lane >> 1;
        float mylogit = v[0] + __shfl_xor(v[0], 1) + p.router_b[l * NEXP + myexp];
        float tv[4]; int ti[4];
        { if (!(lane & 1)) ws[myexp] = mylogit;
          int rank = 0;
#pragma unroll
          for (int c = 0; c < 8; ++c) { const gv4f o = *(const LAS gv4f*)(ws + 4 * c);
#pragma unroll
              for (int q = 0; q < 4; ++q) rank += (o[q] > mylogit || (o[q] == mylogit && 4 * c + q < myexp)) ? 1 : 0; }
          if (!(lane & 1) && rank < 4) { ws[32 + rank] = mylogit; ((LAS int*)ws)[36 + rank] = myexp; }
          const gv4f wv = *(const LAS gv4f*)(ws + 32); const gv4u wi = *(const LAS gv4u*)(ws + 36);
#pragma unroll
          for (int k = 0; k < 4; ++k) { tv[k] = wv[k]; ti[k] = (int)wi[k]; } }
        float den = 0.f, w[4];
#pragma unroll
        for (int k = 0; k < 4; ++k) { w[k] = expf(tv[k] - tv[0]); den += w[k]; }
        if (lane < 4) {
            const int e = lane == 0 ? ti[0] : lane == 1 ? ti[1] : lane == 2 ? ti[2] : ti[3];
            const float ww = lane == 0 ? w[0] : lane == 1 ? w[1] : lane == 2 ? w[2] : w[3];
            const int lr = __hip_atomic_fetch_add(&lcnt[e], 1, __ATOMIC_RELAXED, __HIP_MEMORY_SCOPE_WORKGROUP);
            rec[(it * 8 + (tid >> 6)) * 4 + lane] = (e << 16) | lr;
            WSP(float, WS_TOPW)[row * 4 + lane] = ww / den;
            WSP(int, WS_TOPI)[row * 4 + lane] = e;
        }
        ++it;
    }
    asm volatile("s_waitcnt lgkmcnt(0)" ::: "memory");
    __syncthreads();
    if (tid < 32) lbase[tid] = (int)atomicAdd(WSP(unsigned, WS_CTL) + CW_CNT + (l * 32 + tid) * 64, (unsigned)lcnt[tid]);
    asm volatile("s_waitcnt vmcnt(0) lgkmcnt(0)" ::: "memory");
    __syncthreads();
    it = 0;
    GW_LOOP(row, nrows_l(l)) {
        if (lane < 4) { const int rc = rec[(it * 8 + (tid >> 6)) * 4 + lane], e = rc >> 16, pos = lbase[e] + (rc & 0xffff);
            WSP(int, WS_LIST)[(size_t)e * MALL + pos] = row * 4 + lane; WSP(int, WS_TOPI)[MALL * 4 + row * 4 + lane] = pos; }
        ++it;
    }
    __syncthreads();
}
__device__ __forceinline__ void d_combine(KP kp, int l, LAS int* aoffs) {
    PH_IDS;
    const int lane = tid & 63;
    const unsigned* cnt = WSP(unsigned, WS_CTL) + CW_CNT + l * 32 * 64;
    if (tid == 0) { int a = 0; for (int e = 0; e < 32; ++e) { aoffs[e] = a; a += ((int)cnt[e * 64] + 255) & ~255; } }
    __syncthreads();
    GW_LOOP(row, nrows_l(l)) {
        int ee[4], pp[4];
#pragma unroll
        for (int k = 0; k < 4; ++k) { ee[k] = WSP(int, WS_TOPI)[row * 4 + k]; pp[k] = WSP(int, WS_TOPI)[MALL * 4 + row * 4 + k]; }
        gv4u yv[4][2];
#pragma unroll
        for (int k = 0; k < 4; ++k) { const gv4u* ys = (const gv4u*)(WSP(bf16_t, WS_YSLOT) + (size_t)(aoffs[ee[k]] + pp[k]) * D) + lane; yv[k][0] = ys[0]; yv[k][1] = ys[64]; }
        float acc[16];
#pragma unroll
        for (int j = 0; j < 16; ++j) acc[j] = 0.f;
#pragma unroll
        for (int k = 0; k < 4; ++k)
#pragma unroll
            for (int hf = 0; hf < 2; ++hf)
#pragma unroll
                for (int q = 0; q < 4; ++q) { acc[hf * 8 + 2 * q] += gblo(yv[k][hf][q]); acc[hf * 8 + 2 * q + 1] += gbhi(yv[k][hf][q]); }
        float ss = 0.f;
#pragma unroll
        for (int j = 0; j < 16; ++j) ss += acc[j] * acc[j];
        float rstd = rsqrtf(wave_sum(ss) * (1.f / D) + EPS);
        bf16_t* xr = WSP(bf16_t, WS_XRES) + (size_t)row * D;
        const float* mod = WSP(float, WS_MOD) + (size_t)(l * 5 + mod_r(row)) * 6144;
        const float* g3 = p.norm_g + (l * 4 + 3) * D;
        ss = 0.f;
        gv4f xo[4], gm[4], gg[4];
        { const gv4u x0 = *(const gv4u*)(xr + lane * 8), x1 = *(const gv4u*)(xr + 512 + lane * 8);
          xo[0] = (gv4f){gblo(x0[0]), gbhi(x0[0]), gblo(x0[1]), gbhi(x0[1])}; xo[1] = (gv4f){gblo(x0[2]), gbhi(x0[2]), gblo(x0[3]), gbhi(x0[3])};
          xo[2] = (gv4f){gblo(x1[0]), gbhi(x1[0]), gblo(x1[1]), gbhi(x1[1])}; xo[3] = (gv4f){gblo(x1[2]), gbhi(x1[2]), gblo(x1[3]), gbhi(x1[3])}; }
#pragma unroll
        for (int q8 = 0; q8 < 4; ++q8) { const int ci = (q8 >> 1) * 512 + lane * 8 + (q8 & 1) * 4; gm[q8] = *(const gv4f*)(mod + 5120 + ci); gg[q8] = *(const gv4f*)(g3 + ci); }
        float n0[16], n1[16], n2[16];
        if (l < DEPTH - 1) {
            const float* mod2 = WSP(float, WS_MOD) + (size_t)((l + 1) * 5 + mod_r(row)) * 6144; const float* g0 = p.norm_g + ((l + 1) * 4 + 0) * D;
#pragma unroll
            for (int q8 = 0; q8 < 4; ++q8) { const int ci = (q8 >> 1) * 512 + lane * 8 + (q8 & 1) * 4; const gv4f a = *(const gv4f*)(g0 + ci), b2 = *(const gv4f*)(mod2 + 1024 + ci), c2 = *(const gv4f*)(mod2 + ci);
#pragma unroll
                for (int q = 0; q < 4; ++q) { n0[q8 * 4 + q] = a[q]; n1[q8 * 4 + q] = b2[q]; n2[q8 * 4 + q] = c2[q]; } }
        }
#pragma unroll
        for (int q8 = 0; q8 < 4; ++q8) {
            const int ci = (q8 >> 1) * 512 + lane * 8 + (q8 & 1) * 4;
            gv4f vv;
#pragma unroll
            for (int q = 0; q < 4; ++q) { const float v = xo[q8][q] + gm[q8][q] * (acc[q8 * 4 + q] * rstd * gg[q8][q]); vv[q] = v; acc[q8 * 4 + q] = v; ss += v * v; }
            if (l == DEPTH - 1) *(gv4f*)(p.out + (size_t)row * D + ci) = vv;
        }
        if (l < DEPTH - 1) {
#pragma unroll
            for (int hf = 0; hf < 2; ++hf) { gv4u o;
#pragma unroll
                for (int q = 0; q < 4; ++q) o[q] = cvtpk_rne(acc[hf * 8 + 2 * q], acc[hf * 8 + 2 * q + 1]);
                *(gv4u*)(xr + hf * 512 + lane * 8) = o; }
        }
        if (l < DEPTH - 1) {
            rstd = rsqrtf(wave_sum(ss) * (1.f / D) + EPS);
            bf16_t* hb = WSP(bf16_t, WS_HB) + (size_t)row * D;
#pragma unroll
            for (int hf = 0; hf < 2; ++hf) {
                gv4u o;
#pragma unroll
                for (int q = 0; q < 4; ++q) { const int i0 = hf * 8 + 2 * q; o[q] = cvtpk_rne(acc[i0] * rstd * n0[i0] * (1.f + n1[i0]) + n2[i0], acc[i0 + 1] * rstd * n0[i0 + 1] * (1.f + n1[i0 + 1]) + n2[i0 + 1]); }
                *(gv4u*)(hb + hf * 512 + lane * 8) = o;
            }
        }
    }
    __syncthreads();
}

namespace pg8 {
typedef short bf16x8 __attribute__((ext_vector_type(8)));
typedef float f32x4 __attribute__((ext_vector_type(4)));
typedef unsigned u32x4 __attribute__((ext_vector_type(4)));
typedef unsigned u32x2 __attribute__((ext_vector_type(2)));
constexpr int BM = 256, BK = 64, HALF = 128, HTB = HALF * BK * 2, STAGE_BYTES = 8 * HTB, NXCD = 8, WGM = 8, K = 1024;
__host__ __device__ __forceinline__ int lds_byte(int r, int c) { const int st = (r >> 4) * 2 + (c >> 5), rr = r & 15, cc = c & 31, ob = rr * 64 + cc * 2; return st * 1024 + (ob ^ (((ob >> 9) & 1) << 5)); }
__host__ __device__ __forceinline__ void stage_rc(int b, int& R, int& C) { const int st = b / 1024, sb = b % 1024, swz = sb ^ (((sb >> 9) & 1) << 5); R = (st >> 1) * 16 + swz / 64; C = (st & 1) * 32 + (swz % 64) / 2; }
__host__ __device__ __forceinline__ int perm32(int rho) { const int n = rho >> 4, i = rho & 15; return 8 * (i >> 2) + 4 * n + (i & 3); }
__device__ __forceinline__ unsigned cvt_pk_bf16(float lo, float hi) { return cvtpk_rne(lo, hi); }

struct Unit { int pm, pn; const char* A; const char* B; const int* gl; int gcnt; int e; int row0; };

struct DenseOrder {
    int nM, nN, nwg, G, c; const char* A; const char* Bt;
    __device__ __forceinline__ void init(int M, int N, int G_, int c_, const void* A_, const void* Bt_) { nM = M / BM; nN = N / BM; nwg = nM * nN; G = G_; c = c_; A = (const char*)A_; Bt = (const char*)Bt_; }
    __device__ __forceinline__ bool next(int i, Unit& u) const {
        const long L = (long)i * G + c; if (L >= nwg) return false;
        int wgid = (int)L; { const int q = nwg / NXCD, r = nwg % NXCD, xcd = wgid % NXCD, off = wgid / NXCD; wgid = (xcd < r ? xcd * (q + 1) : r * (q + 1) + (xcd - r) * q) + off; }
        const int nig = WGM * nN, gid = wgid / nig, fm = gid * WGM, gsz = (nM - fm) < WGM ? (nM - fm) : WGM;
        u.pm = fm + ((wgid % nig) % gsz); u.pn = (wgid % nig) / gsz;
        u.A = A + (size_t)u.pm * (BM * K * 2); u.B = Bt + (size_t)u.pn * (BM * K * 2); u.gl = nullptr; u.gcnt = BM; u.e = 0; u.row0 = u.pm * BM; return true;
    }
};
struct MoeOrder {
    const LAS int* tab; int G, c, NCT; const char* A; const char* W; size_t wstride; const int* list; const unsigned* cnt; bool gather; int rowb;
    __device__ __forceinline__ bool next(int i, Unit& u) const {
        const int xg = c & 7, L = (c >> 3) + (G >> 3) * i; const LAS int* gt = tab + 72 + xg * 5;
        if (L >= gt[4]) return false;
        int q = 0;
#pragma unroll
        for (int j = 1; j < 4; ++j) if (L >= gt[j]) q = j;
        const int e = __builtin_amdgcn_readfirstlane(xg + 8 * q);
        const int r = __builtin_amdgcn_readfirstlane(L - gt[q]), ce = __builtin_amdgcn_readfirstlane(tab[120 + e]), rte = (ce + 255) >> 8, ro = __builtin_amdgcn_readfirstlane(tab[33 + e]);
        const int ct = r / rte, rt = r - ct * rte;
        u.pm = rt; u.pn = ct; u.e = e; u.row0 = ro + rt * 256; u.gl = list + (size_t)e * MALL + rt * 256; u.gcnt = min(256, ce - rt * 256);
        u.A = gather ? A : A + (size_t)u.row0 * rowb; u.B = W + (size_t)e * wstride + (size_t)ct * BM * rowb; return true;
    }
};
__device__ __forceinline__ void moe_tab_build(LAS int* tab, const unsigned* cnt, int NCT, int tid) {
    if (tid < 32) tab[120 + tid] = (int)cnt[tid * 64];
    asm volatile("s_waitcnt vmcnt(0) lgkmcnt(0)" ::: "memory");
    __syncthreads();
    if (tid == 0) {
        int rs = 0; for (int e = 0; e < 32; ++e) { tab[33 + e] = rs; rs += ((tab[120 + e] + 255) >> 8) * 256; } tab[65] = rs;
        for (int g = 0; g < 8; ++g) { int us = 0; for (int q = 0; q < 4; ++q) { tab[72 + g * 5 + q] = us; us += ((tab[120 + g + 8 * q] + 255) >> 8) * NCT; } tab[72 + g * 5 + 4] = us; }
    }
    __syncthreads();
}

struct EpiBf16 {
    static constexpr bool PERM = true; bf16_t* O; int ldc; const float* bias;
    __device__ __forceinline__ void operator()(const f32x4 (&acc)[2][2][4][2], const Unit& u, int wr, int wc, int fr, int fq) const {
        const int row0 = u.row0 + wr * 64 + fr, col0 = u.pn * BM + wc * 32 + 8 * fq;
        f32x4 bv[2][2];
#pragma unroll
        for (int bj = 0; bj < 2; ++bj)
#pragma unroll
            for (int n = 0; n < 2; ++n) bv[bj][n] = bias ? *(const f32x4*)(bias + col0 + bj * HALF + 4 * n) : (f32x4){0.f, 0.f, 0.f, 0.f};
#pragma unroll
        for (int ai = 0; ai < 2; ++ai)
#pragma unroll
            for (int m = 0; m < 4; ++m) { bf16_t* rowp = O + (size_t)(row0 + ai * HALF + m * 16) * ldc + col0;
#pragma unroll
                for (int bj = 0; bj < 2; ++bj) { const f32x4 v0 = acc[ai][bj][m][0] + bv[bj][0], v1 = acc[ai][bj][m][1] + bv[bj][1];
                    u32x4 w; w.x = cvt_pk_bf16(v0[0], v0[1]); w.y = cvt_pk_bf16(v0[2], v0[3]); w.z = cvt_pk_bf16(v1[0], v1[1]); w.w = cvt_pk_bf16(v1[2], v1[3]);
                    *(u32x4*)(rowp + bj * HALF) = w; } }
    }
};
struct EpiF32 {
    static constexpr bool PERM = false; float* O; int ldc;
    __device__ __forceinline__ void operator()(const f32x4 (&acc)[2][2][4][2], const Unit& u, int wr, int wc, int fr, int fq) const {
        const int row0 = u.row0 + wr * 64 + fr, col0 = u.pn * BM + wc * 32 + 4 * fq;
#pragma unroll
        for (int ai = 0; ai < 2; ++ai)
#pragma unroll
            for (int m = 0; m < 4; ++m) { float* rowp = O + (size_t)(row0 + ai * HALF + m * 16) * ldc + col0;
#pragma unroll
                for (int bj = 0; bj < 2; ++bj)
#pragma unroll
                    for (int n = 0; n < 2; ++n) *(f32x4*)(rowp + bj * HALF + n * 16) = acc[ai][bj][m][n]; }
    }
};
struct EpiMoeUp {
    static constexpr bool PERM = true; unsigned char* ACT; const float* b1all;
    __device__ __forceinline__ void operator()(const f32x4 (&acc)[2][2][4][2], const Unit& u, int wr, int wc, int fr, int fq) const {
        const int col0 = u.pn * BM + wc * 32 + 8 * fq; const float* b1 = b1all + (size_t)u.e * 2048;
        f32x4 bv[2][2];
#pragma unroll
        for (int bj = 0; bj < 2; ++bj)
#pragma unroll
            for (int n = 0; n < 2; ++n) bv[bj][n] = *(const f32x4*)(b1 + col0 + bj * HALF + 4 * n);
#pragma unroll
        for (int ai = 0; ai < 2; ++ai)
#pragma unroll
            for (int m = 0; m < 4; ++m) { unsigned char* rowp = ACT + (size_t)(u.row0 + wr * 64 + fr + ai * HALF + m * 16) * 1024 + (col0 >> 1);
#pragma unroll
                for (int bj = 0; bj < 2; ++bj) { const f32x4 v0 = acc[ai][bj][m][0] * (1.f / W8_SCALE) + bv[bj][0], v1 = acc[ai][bj][m][1] * (1.f / W8_SCALE) + bv[bj][1];
                    float a[4];
#pragma unroll
                    for (int j = 0; j < 4; ++j) { const float gl = fminf(j < 2 ? v0[2 * j] : v1[2 * j - 4], 7.f), ln = fminf(fmaxf(j < 2 ? v0[2 * j + 1] : v1[2 * j - 3], -7.f), 7.f);
                        a[j] = gl * __builtin_amdgcn_rcpf(1.f + __builtin_amdgcn_exp2f(-1.702f * 1.4426950408889634f * gl)) * (ln + 1.f); }
                    *(unsigned*)(rowp + bj * 64) = pk4_fp8(a[0], a[1], a[2], a[3]); } }
    }
};
struct EpiMoeDown {
    static constexpr bool PERM = true; bf16_t* Y; const float* b2all; const float* topw;
    __device__ __forceinline__ void operator()(const f32x4 (&acc)[2][2][4][2], const Unit& u, int wr, int wc, int fr, int fq) const {
        const int col0 = u.pn * BM + wc * 32 + 8 * fq; const float* b2 = b2all + (size_t)u.e * 1024;
        f32x4 bv[2][2];
#pragma unroll
        for (int bj = 0; bj < 2; ++bj)
#pragma unroll
            for (int n = 0; n < 2; ++n) bv[bj][n] = *(const f32x4*)(b2 + col0 + bj * HALF + 4 * n);
#pragma unroll
        for (int ai = 0; ai < 2; ++ai)
#pragma unroll
            for (int m = 0; m < 4; ++m) { const int r = wr * 64 + fr + ai * HALF + m * 16; const int rc = r < u.gcnt ? r : u.gcnt - 1; const float twl = topw[u.gl[rc]]; const float tw = r < u.gcnt ? twl : 0.f;
                bf16_t* rowp = Y + (size_t)(u.row0 + r) * 1024 + col0;
#pragma unroll
                for (int bj = 0; bj < 2; ++bj) { const f32x4 v0 = (acc[ai][bj][m][0] * (1.f / W8_SCALE) + bv[bj][0]) * tw, v1 = (acc[ai][bj][m][1] * (1.f / W8_SCALE) + bv[bj][1]) * tw;
                    u32x4 w; w.x = cvt_pk_bf16(v0[0], v0[1]); w.y = cvt_pk_bf16(v0[2], v0[3]); w.z = cvt_pk_bf16(v1[0], v1[1]); w.w = cvt_pk_bf16(v1[2], v1[3]);
                    *(u32x4*)(rowp + bj * HALF) = w; } }
    }
};

typedef int v8i __attribute__((ext_vector_type(8)));
typedef int v4i __attribute__((ext_vector_type(4)));
template <class Epi, class Sched, bool GATHER, bool ALIGN_EPI, bool F8 = false>
__device__ __forceinline__ void gphase(LAS unsigned char* lds, const Sched& S, const Epi& E, const int tid) {
    const int wid = __builtin_amdgcn_readfirstlane(tid >> 6), lane = tid & 63, wr = wid >> 2, wc = wid & 3, fr = lane & 15, fq = lane >> 4;
    constexpr int ROWB = F8 ? K : K * 2, nt = ROWB / 128, KSTR = F8 ? 16 : 1024;
    unsigned voffB[2], CA2[2]; int RA[2];
#pragma unroll
    for (int i = 0; i < 2; ++i) { int R, C; stage_rc(tid * 16 + i * 8192, R, C); const int Rb = Epi::PERM ? ((R & ~31) + perm32(R & 31)) : R;
        RA[i] = R; CA2[i] = (unsigned)C * 2u; voffB[i] = (unsigned)(Rb * ROWB + C * 2); }
    constexpr size_t kstep = (size_t)(BK * 2), hstep = (size_t)HALF * ROWB;
    const unsigned ldsw = (unsigned)wid * 1024u;
    const int aoff = lds_byte(wr * 64 + fr, fq * 8), boff = lds_byte(wc * 32 + fr, fq * 8);
#define PG8_SA(b, h) (((b) * 2 + (h)) * HTB)
#define PG8_SB(b, h) ((4 + (b) * 2 + (h)) * HTB)
#define PG8_GL(gp, ldsoff) __builtin_amdgcn_global_load_lds((const unsigned*)(gp), (LAS unsigned*)(lds + (ldsoff)), 16, 0, 0)
#define PG8_STB(bufoff, gbase) do { PG8_GL((const char*)(gbase) + voffB[0], (bufoff) + ldsw); PG8_GL((const char*)(gbase) + voffB[1], (bufoff) + ldsw + 8192); } while (0)
#define PG8_STA(bufoff, gbase, o) do { PG8_GL((const char*)(gbase) + (o)[0], (bufoff) + ldsw); PG8_GL((const char*)(gbase) + (o)[1], (bufoff) + ldsw + 8192); } while (0)
#define PG8_LDA(dst, b, h) do { _Pragma("unroll") for (int m = 0; m < 4; ++m) { if constexpr (F8) { const v4i lo_ = *(const LAS v4i*)(lds + PG8_SA(b, h) + aoff + m * 2048), hi_ = *(const LAS v4i*)(lds + PG8_SA(b, h) + aoff + m * 2048 + 1024); dst##8[m] = __builtin_shufflevector(lo_, hi_, 0, 1, 2, 3, 4, 5, 6, 7); } else { _Pragma("unroll") for (int k = 0; k < 2; ++k) dst[m][k] = *(const LAS bf16x8*)(lds + PG8_SA(b, h) + aoff + m * 2048 + k * KSTR); } } } while (0)
#define PG8_LDB(dst, b, h) do { _Pragma("unroll") for (int n = 0; n < 2; ++n) { if constexpr (F8) { const v4i lo_ = *(const LAS v4i*)(lds + PG8_SB(b, h) + boff + n * 2048), hi_ = *(const LAS v4i*)(lds + PG8_SB(b, h) + boff + n * 2048 + 1024); dst##8[n] = __builtin_shufflevector(lo_, hi_, 0, 1, 2, 3, 4, 5, 6, 7); } else { _Pragma("unroll") for (int k = 0; k < 2; ++k) dst[n][k] = *(const LAS bf16x8*)(lds + PG8_SB(b, h) + boff + n * 2048 + k * KSTR); } } } while (0)
#define PG8_MMA(ai, bj, At, Bt) do { __builtin_amdgcn_s_setprio(1); _Pragma("unroll") for (int m = 0; m < 4; ++m) _Pragma("unroll") for (int n = 0; n < 2; ++n) { \
        if constexpr (F8) asm volatile("v_mfma_scale_f32_16x16x128_f8f6f4 %0, %1, %2, %0, %3, %3 op_sel_hi:[0,0,0]" : "+v"(acc[ai][bj][m][n]) : "v"(Bt##8[n]), "v"(At##8[m]), "v"(f8scale) : "memory"); \
        else { _Pragma("unroll") for (int k = 0; k < 2; ++k) acc[ai][bj][m][n] = __builtin_amdgcn_mfma_f32_16x16x32_bf16(Bt[n][k], At[m][k], acc[ai][bj][m][n], 0, 0, 0); } } \
        __builtin_amdgcn_s_setprio(0); } while (0)
#define PG8_WAIT_V(n) asm volatile("s_waitcnt vmcnt(" #n ")" ::: "memory")
#define PG8_WAIT_L(n) asm volatile("s_waitcnt lgkmcnt(" #n ")" ::: "memory")
#define PG8_BAR __builtin_amdgcn_s_barrier()
#define PG8_SCHED __builtin_amdgcn_sched_barrier(0)
#define PG8_AOFFS(u, o) do { _Pragma("unroll") for (int h_ = 0; h_ < 2; ++h_) _Pragma("unroll") for (int i_ = 0; i_ < 2; ++i_) { \
        if (GATHER) { const int r_ = h_ * 128 + RA[i_]; const int rc_ = r_ < (u).gcnt ? r_ : (u).gcnt - 1; const int tok_ = (u).gl[rc_] >> 2; o[h_][i_] = (unsigned)tok_ * (unsigned)ROWB + CA2[i_]; } \
        else o[h_][i_] = (unsigned)((h_ * 128 + RA[i_]) * ROWB) + CA2[i_]; } } while (0)
    Unit cur, nxt; int ui = 0;
    if (!S.next(0, cur)) return;
    f32x4 acc[2][2][4][2];
#pragma unroll
    for (int a = 0; a < 2; ++a)
#pragma unroll
        for (int b = 0; b < 2; ++b)
#pragma unroll
            for (int m = 0; m < 4; ++m)
#pragma unroll
                for (int n = 0; n < 2; ++n) acc[a][b][m][n] = (f32x4){0.f, 0.f, 0.f, 0.f};
    int f8scale = 0x7f7f7f7f; asm volatile("" : "+v"(f8scale));
    bf16x8 At[F8 ? 1 : 4][2], B0[F8 ? 1 : 2][2], B1[F8 ? 1 : 2][2]; v8i At8[F8 ? 4 : 1], B08[F8 ? 2 : 1], B18[F8 ? 2 : 1];
    (void)At; (void)B0; (void)B1; (void)At8; (void)B08; (void)B18;
    unsigned oAc[2][2], oAn[2][2];
    PG8_AOFFS(cur, oAc);
    const char* cA = cur.A; const char* cB = cur.B;
    PG8_STB(PG8_SB(0, 0), cB); PG8_STB(PG8_SB(0, 1), cB + hstep); PG8_STA(PG8_SA(0, 0), cA, oAc[0]); PG8_STA(PG8_SA(0, 1), cA, oAc[1]);
    if (wr == 1) PG8_BAR;
    PG8_WAIT_V(2); PG8_BAR;
    PG8_STB(PG8_SB(1, 0), cB + kstep); PG8_STA(PG8_SA(1, 0), cA + kstep, oAc[0]); PG8_STB(PG8_SB(1, 1), cB + hstep + kstep);
    PG8_WAIT_V(6); PG8_BAR;
    for (;;) {
        const bool has_next = S.next(ui + 1, nxt);
        const char* nA = has_next ? nxt.A : cA; const char* nB = has_next ? nxt.B : cB;
        if (has_next) { PG8_AOFFS(nxt, oAn); } else {
#pragma unroll
            for (int h = 0; h < 2; ++h) { oAn[h][0] = oAc[h][0]; oAn[h][1] = oAc[h][1]; } }
#pragma unroll 1
        for (int t = 0; t < nt; t += 2) {
            const bool last = (t == nt - 2);
            const char* a1 = cA + (size_t)(t + 1) * kstep;
            const char* a2 = last ? nA : cA + (size_t)(t + 2) * kstep; const char* b2 = last ? nB : cB + (size_t)(t + 2) * kstep;
            const char* a3 = a2 + kstep; const char* b3 = b2 + kstep;
            unsigned o2[2][2];
#pragma unroll
            for (int h = 0; h < 2; ++h) { o2[h][0] = last ? oAn[h][0] : oAc[h][0]; o2[h][1] = last ? oAn[h][1] : oAc[h][1]; }
            PG8_LDB(B0, 0, 0); PG8_LDB(B1, 0, 1); PG8_SCHED; PG8_LDA(At, 0, 0); PG8_STA(PG8_SA(1, 1), a1, oAc[1]);
            PG8_WAIT_V(8); PG8_WAIT_L(0); PG8_BAR; PG8_MMA(0, 0, At, B0); PG8_MMA(0, 1, At, B1); PG8_BAR; PG8_SCHED;
            PG8_LDA(At, 0, 1); PG8_STB(PG8_SB(0, 0), b2); PG8_STB(PG8_SB(0, 1), b2 + hstep); PG8_STA(PG8_SA(0, 0), a2, o2[0]);
            PG8_WAIT_V(8); PG8_WAIT_L(0); PG8_BAR; PG8_MMA(1, 0, At, B0); PG8_MMA(1, 1, At, B1); PG8_BAR; PG8_SCHED;
            PG8_LDB(B0, 1, 0); PG8_LDB(B1, 1, 1); PG8_SCHED; PG8_LDA(At, 1, 0); PG8_STA(PG8_SA(0, 1), a2, o2[1]);
            PG8_WAIT_V(8); PG8_WAIT_L(0); PG8_BAR; PG8_MMA(0, 0, At, B0); PG8_MMA(0, 1, At, B1); PG8_BAR; PG8_SCHED;
            PG8_LDA(At, 1, 1); PG8_STB(PG8_SB(1, 0), b3); PG8_STB(PG8_SB(1, 1), b3 + hstep); PG8_STA(PG8_SA(1, 0), a3, o2[0]);
            PG8_WAIT_V(8); PG8_WAIT_L(0); PG8_BAR; PG8_MMA(1, 0, At, B0); PG8_MMA(1, 1, At, B1); PG8_BAR; PG8_SCHED;
        }
        if constexpr (F8) asm volatile("s_nop 15\n\ts_nop 15" ::: "memory");
        if constexpr (ALIGN_EPI) { if (wr == 0) PG8_BAR; }
        E(acc, cur, wr, wc, fr, fq);
        if (!has_next) break;
#pragma unroll
        for (int a = 0; a < 2; ++a)
#pragma unroll
            for (int b = 0; b < 2; ++b)
#pragma unroll
                for (int m = 0; m < 4; ++m)
#pragma unroll
                    for (int n = 0; n < 2; ++n) acc[a][b][m][n] = (f32x4){0.f, 0.f, 0.f, 0.f};
        cur = nxt; cA = nA; cB = nB; ++ui;
#pragma unroll
        for (int h = 0; h < 2; ++h) { oAc[h][0] = oAn[h][0]; oAc[h][1] = oAn[h][1]; }
        if constexpr (ALIGN_EPI) { if (wr == 1) PG8_BAR; }
    }
    PG8_WAIT_V(0);
    if constexpr (!ALIGN_EPI) { if (wr == 0) PG8_BAR; }
    PG8_BAR;
#undef PG8_SA
#undef PG8_SB
#undef PG8_GL
#undef PG8_STA
#undef PG8_STB
#undef PG8_LDA
#undef PG8_LDB
#undef PG8_MMA
#undef PG8_WAIT_V
#undef PG8_WAIT_L
#undef PG8_BAR
#undef PG8_SCHED
#undef PG8_AOFFS
}
}

__device__ __forceinline__ unsigned pk2(float lo, float hi) { return (unsigned)f2bf(lo) | ((unsigned)f2bf(hi) << 16); }
__device__ __forceinline__ void transpose_item(const float* W, int ld, int nblk, bf16_t* WT, LAS float* scr, int item, int lane) {
    const int kb = item / nblk, nb = item - kb * nblk, k0 = 64 * kb, n0 = 32 * nb;
#pragma unroll 8
    for (int i = 0; i < 32; ++i) { const int kk = 2 * i + (lane >> 5); scr[kk * 33 + (lane & 31)] = W[(size_t)(k0 + kk) * ld + n0 + (lane & 31)]; }
    asm volatile("s_waitcnt lgkmcnt(0)" ::: "memory");
    const int c = lane & 7;
#pragma unroll
    for (int j = 0; j < 4; ++j) { const int n = (lane >> 3) + 8 * j; const LAS float* s = scr + (8 * c) * 33 + n;
        pg8::u32x4 o; o.x = pk2(s[0 * 33], s[1 * 33]); o.y = pk2(s[2 * 33], s[3 * 33]); o.z = pk2(s[4 * 33], s[5 * 33]); o.w = pk2(s[6 * 33], s[7 * 33]);
        *(pg8::u32x4*)(WT + (size_t)(n0 + n) * 1024 + k0 + 8 * c) = o; }
    asm volatile("s_waitcnt lgkmcnt(0)" ::: "memory");
}
__device__ __forceinline__ void transpose_item8(const float* W, int ld, int nblk, unsigned char* WT, LAS float* scr, int item, int lane) {
    const int kb = item / nblk, nb = item - kb * nblk, k0 = 64 * kb, n0 = 32 * nb;
#pragma unroll 8
    for (int i = 0; i < 32; ++i) { const int kk = 2 * i + (lane >> 5); scr[kk * 33 + (lane & 31)] = W[(size_t)(k0 + kk) * ld + n0 + (lane & 31)]; }
    asm volatile("s_waitcnt lgkmcnt(0)" ::: "memory");
    const int c = lane & 3;
#pragma unroll
    for (int j = 0; j < 2; ++j) { const int n = (lane >> 2) + 16 * j; const LAS float* sp = scr + (16 * c) * 33 + n;
        pg8::u32x4 o;
#pragma unroll
        for (int q = 0; q < 4; ++q) o[q] = pk4_fp8(sp[(4 * q) * 33] * W8_SCALE, sp[(4 * q + 1) * 33] * W8_SCALE, sp[(4 * q + 2) * 33] * W8_SCALE, sp[(4 * q + 3) * 33] * W8_SCALE);
        *(pg8::u32x4*)(WT + (size_t)(n0 + n) * 1024 + k0 + 16 * c) = o; }
    asm volatile("s_waitcnt lgkmcnt(0)" ::: "memory");
}
__device__ __forceinline__ void d_convert_a(KP kp, LAS float* scr_all) {
    PH_IDS;
    const int lane = tid & 63; LAS float* scr = scr_all + (tid >> 6) * (64 * 33);
    constexpr int I_IN = 16 * 104, I_OUT = 16 * 32, I_W1 = 16 * 64, I_W2 = 16 * 32, I_L = I_IN + I_OUT + 32 * I_W1 + 32 * I_W2;
    GW_LOOP(it, 2 * I_L) {
        const int l = it / I_L; int r = it - l * I_L;
        if (r < I_IN) { transpose_item(p.w_in + (size_t)l * D * INW, INW, 104, WSP(bf16_t, WS_WIN_T) + (size_t)l * PW * 1024, scr, r, lane); continue; } r -= I_IN;
        if (r < I_OUT) { transpose_item(p.w_out + (size_t)l * D * D, 1024, 32, WSP(bf16_t, WS_WOUT_T) + (size_t)l * 1024 * 1024, scr, r, lane); continue; } r -= I_OUT;
        if (r < 32 * I_W1) { const int e = r / I_W1; transpose_item8(p.exp_w1 + ((size_t)l * NEXP + e) * D * 2048, 2048, 64, WSP(unsigned char, WS_W1_T) + ((size_t)l * NEXP + e) * 2048 * 1024, scr, r - e * I_W1, lane); continue; } r -= 32 * I_W1;
        { const int e = r / I_W2; transpose_item8(p.exp_w2 + ((size_t)l * NEXP + e) * D * D, 1024, 32, WSP(unsigned char, WS_W2_T) + ((size_t)l * NEXP + e) * 1024 * 1024, scr, r - e * I_W2, lane); }
    }
    GT_LOOP(idx, 2 * PW) { const int l = idx / PW, n = idx - l * PW; WSP(float, WS_BIAS_IN)[idx] = n < 3328 ? 0.f : p.gla_gate_b[l * 256 + n - 3328]; }
}
__device__ __forceinline__ void d_convert_b(KP kp, LAS float* scr_all) {
    PH_IDS;
    const int lane = tid & 63; LAS float* scr = scr_all + (tid >> 6) * (64 * 33);
    GW_LOOP(it, 2 * 128) { const int l = it >> 7; transpose_item(WSP(float, WS_WEFF) + (size_t)l * D * 256, 256, 8, WSP(bf16_t, WS_WIN_T) + ((size_t)l * PW + 3328) * 1024, scr, it & 127, lane); }
}

__device__ __forceinline__ void d_gemm_in(KP kp, int l, LAS unsigned char* lds) {
    PH_IDS;
    pg8::DenseOrder S; S.init(MALL, PW, gridDim.x, bid, WSP(bf16_t, WS_HB), WSP(bf16_t, WS_WIN_T) + (size_t)l * PW * 1024);
    pg8::EpiBf16 E{WSP(bf16_t, WS_PBUF), PW, WSP(float, WS_BIAS_IN) + l * PW};
    pg8::gphase<pg8::EpiBf16, pg8::DenseOrder, false, true>(lds, S, E, tid);
}
__device__ __forceinline__ void d_gemm_out(KP kp, int l, LAS unsigned char* lds) {
    PH_IDS;
    pg8::DenseOrder S; S.init(nrows_l(l), 1024, gridDim.x, bid, WSP(bf16_t, WS_CONCAT), WSP(bf16_t, WS_WOUT_T) + (size_t)l * 1024 * 1024);
    pg8::EpiBf16 E{WSP(bf16_t, WS_YBUF), 1024, nullptr};
    pg8::gphase<pg8::EpiBf16, pg8::DenseOrder, false, true>(lds, S, E, tid);
}
__device__ __forceinline__ void d_moe_up(KP kp, int l, LAS unsigned char* lds) {
    PH_IDS;
    LAS int* tab = (LAS int*)(lds + pg8::STAGE_BYTES);
    const unsigned* cnt = WSP(unsigned, WS_CTL) + CW_CNT + l * 32 * 64;
    pg8::moe_tab_build(tab, cnt, 8, tid);
    pg8::MoeOrder S{tab, (int)gridDim.x, bid, 8, (const char*)WSP(unsigned char, WS_HB8), (const char*)(WSP(unsigned char, WS_W1_T) + (size_t)l * NEXP * 2048 * 1024), (size_t)2048 * 1024, WSP(int, WS_LIST), cnt, true, 1024};
    pg8::EpiMoeUp E{WSP(unsigned char, WS_ACT), p.exp_b1 + (size_t)l * NEXP * 2048};
    pg8::gphase<pg8::EpiMoeUp, pg8::MoeOrder, true, true, true>(lds, S, E, tid);
}
__device__ __forceinline__ void d_moe_down(KP kp, int l, LAS unsigned char* lds) {
    PH_IDS;
    LAS int* tab = (LAS int*)(lds + pg8::STAGE_BYTES);
    const unsigned* cnt = WSP(unsigned, WS_CTL) + CW_CNT + l * 32 * 64;
    pg8::moe_tab_build(tab, cnt, 4, tid);
    pg8::MoeOrder S{tab, (int)gridDim.x, bid, 4, (const char*)WSP(unsigned char, WS_ACT), (const char*)(WSP(unsigned char, WS_W2_T) + (size_t)l * NEXP * 1024 * 1024), (size_t)1024 * 1024, WSP(int, WS_LIST), cnt, false, 1024};
    pg8::EpiMoeDown E{WSP(bf16_t, WS_YSLOT), p.exp_b2 + (size_t)l * NEXP * 1024, WSP(float, WS_TOPW)};
    pg8::gphase<pg8::EpiMoeDown, pg8::MoeOrder, false, true, true>(lds, S, E, tid);
}

constexpr int ATT_NT = 68;
constexpr float ATT_QSCALE = 0.17677669529663687f * 1.4426950408889634f;
__device__ __forceinline__ void d_prep_attn(KP kp) {
    PH_IDS;
    const bf16_t* PB = WSP(bf16_t, WS_PBUF);
    GT_LOOP(idx, MALL * 16) {
        const int row = idx >> 4, hm = (idx >> 1) & 7, ks = idx & 1, h = hm >> 1, m = hm & 1;
        const bool lat = row < NLAT; const int t = row & (SEQ - 1);
        const int ipos = lat ? (ks == 0 ? (t >> 6) : (t & 63)) : 0;
        const int cb = h * 64 + m * 32 + ks * 16;
        const pg8::u32x4* qs = (const pg8::u32x4*)(PB + (size_t)row * PW + PC_AQ + cb);
        const pg8::u32x4* ksrc = (const pg8::u32x4*)(PB + (size_t)row * PW + PC_AK + cb);
        pg8::u32x4 qa = qs[0], qb = qs[1], ka = ksrc[0], kb = ksrc[1];
        float qv[16], kv[16];
#pragma unroll
        for (int j = 0; j < 4; ++j) { qv[2 * j] = bf2f((bf16_t)(qa[j] & 0xffff)); qv[2 * j + 1] = bf2f((bf16_t)(qa[j] >> 16)); qv[8 + 2 * j] = bf2f((bf16_t)(qb[j] & 0xffff)); qv[9 + 2 * j] = bf2f((bf16_t)(qb[j] >> 16));
                                      kv[2 * j] = bf2f((bf16_t)(ka[j] & 0xffff)); kv[2 * j + 1] = bf2f((bf16_t)(ka[j] >> 16)); kv[8 + 2 * j] = bf2f((bf16_t)(kb[j] & 0xffff)); kv[9 + 2 * j] = bf2f((bf16_t)(kb[j] >> 16)); }
        float qo[16], ko[16];
#pragma unroll
        for (int j = 0; j < 8; ++j) {
            const float* tb = WSP(float, WS_ROPE) + (ipos * 8 + j) * 2; const float cs = tb[0], sn = tb[1];
            qo[j] = qv[j] * cs - qv[j + 8] * sn; qo[j + 8] = qv[j + 8] * cs + qv[j] * sn;
            ko[j] = kv[j] * cs - kv[j + 8] * sn; ko[j + 8] = kv[j + 8] * cs + kv[j] * sn;
        }
        pg8::u32x4 o0, o1;
#pragma unroll
        for (int j = 0; j < 4; ++j) { o0[j] = pk2(qo[2 * j] * ATT_QSCALE, qo[2 * j + 1] * ATT_QSCALE); o1[j] = pk2(qo[8 + 2 * j] * ATT_QSCALE, qo[9 + 2 * j] * ATT_QSCALE); }
        pg8::u32x4* qd = (pg8::u32x4*)(WSP(bf16_t, WS_QRP) + (size_t)row * 256 + cb); qd[0] = o0; qd[1] = o1;
#pragma unroll
        for (int j = 0; j < 4; ++j) { o0[j] = pk2(ko[2 * j], ko[2 * j + 1]); o1[j] = pk2(ko[8 + 2 * j], ko[9 + 2 * j]); }
        int b, tile, key; if (lat) { b = row >> 12; tile = t >> 6; key = t & 63; } else { const int r = row - NLAT; b = r >> 8; tile = 64 + ((r & 255) >> 6); key = r & 63; }
        unsigned char* img = WSP(unsigned char, WS_KIMG) + ((size_t)(b * 4 + h) * ATT_NT + tile) * 8192 + key * 128;
        const int c0 = m * 4 + ks * 2, sw = (key >> 1) & 7;
        *(pg8::u32x4*)(img + 16 * (c0 ^ sw)) = o0; *(pg8::u32x4*)(img + 16 * ((c0 + 1) ^ sw)) = o1;
    }
    GT_LOOP(idx, 16 * ATT_NT * 2 * 64) {
        const int d = idx & 63, half = (idx >> 6) & 1, tile = (idx >> 7) % ATT_NT, bh = idx / (128 * ATT_NT), b = bh >> 2, h = bh & 3;
        const int row0 = (tile < 64 ? b * SEQ + tile * 64 : NLAT + b * CTXL + (tile - 64) * 64) + half * 32;
        const bf16_t* vp = PB + (size_t)row0 * PW + PC_AV + h * 64 + d;
        unsigned short vv[32];
#pragma unroll
        for (int j = 0; j < 32; ++j) vv[j] = vp[(size_t)j * PW];
        unsigned char* img = WSP(unsigned char, WS_VIMG) + ((size_t)bh * ATT_NT + tile) * 8192 + d * 128; const int x = (d >> 1) & 7;
#pragma unroll
        for (int s2 = 0; s2 < 2; ++s2)
#pragma unroll
            for (int hh = 0; hh < 2; ++hh) { const int j = 4 * s2 + hh, u = 4 * half + 2 * s2 + hh;
                *(pg8::u32x4*)(img + 16 * (u ^ x)) = (pg8::u32x4){(unsigned)vv[4 * j] | ((unsigned)vv[4 * j + 1] << 16), (unsigned)vv[4 * j + 2] | ((unsigned)vv[4 * j + 3] << 16),
                                                                   (unsigned)vv[4 * j + 8] | ((unsigned)vv[4 * j + 9] << 16), (unsigned)vv[4 * j + 10] | ((unsigned)vv[4 * j + 11] << 16)}; }
    }
}

namespace att {
typedef short bf16x8 __attribute__((ext_vector_type(8)));
typedef float f32x16 __attribute__((ext_vector_type(16)));
typedef unsigned u32x4 __attribute__((ext_vector_type(4)));
typedef unsigned u32x2 __attribute__((ext_vector_type(2)));
typedef float f32x2 __attribute__((ext_vector_type(2)));
constexpr int SLOT = 8192, NSLOT = 4, LDS_K = 0, LDS_V = NSLOT * SLOT, LDS_SCR = 2 * NSLOT * SLOT;
constexpr float THR = 8.f;
__device__ __forceinline__ int crow(int r, int hi) { return (r & 3) + 8 * (r >> 2) + 4 * hi; }
__device__ __forceinline__ unsigned cvtpk(float lo, float hi) { return cvtpk_rne(lo, hi); }
__device__ __forceinline__ float xhalf_max(float v) { return fmaxf(v, __shfl_xor(v, 32)); }
}
__device__ __forceinline__ void attn_unit(KP kp, int l, int b, int h, int qt, LAS unsigned char* lds, float lam, float lam_init, int tid) {
    using namespace att;
    const int lane = tid & 63, wid = __builtin_amdgcn_readfirstlane(tid >> 6), q32 = lane & 31, hi = lane >> 5;
    const int t0 = qt < 0 ? 64 : 0, t1 = ATT_NT;
    const int rowbase = (qt < 0 ? NLAT + b * CTXL : b * SEQ + qt * 256) + wid * 32;
    const unsigned char* kimg = WSP(unsigned char, WS_KIMG) + (size_t)(b * 4 + h) * ATT_NT * 8192 + wid * 1024 + lane * 16;
    const unsigned char* vimg = WSP(unsigned char, WS_VIMG) + (size_t)(b * 4 + h) * ATT_NT * 8192 + wid * 1024 + lane * 16;
    LAS float* scr = (LAS float*)(lds + LDS_SCR) + wid * 64;
#define ATT_DMA(t, slot) do { __builtin_amdgcn_global_load_lds((const unsigned*)(kimg + (size_t)(t) * 8192), (LAS unsigned*)(lds + LDS_K + (slot) * SLOT + wid * 1024), 16, 0, 0); \
                              __builtin_amdgcn_global_load_lds((const unsigned*)(vimg + (size_t)(t) * 8192), (LAS unsigned*)(lds + LDS_V + (slot) * SLOT + wid * 1024), 16, 0, 0); } while (0)
    bf16x8 qf[2][2];
    { const bf16_t* qp = WSP(bf16_t, WS_QRP) + (size_t)(rowbase + q32) * 256 + h * 64 + hi * 8;
#pragma unroll
      for (int m = 0; m < 2; ++m)
#pragma unroll
        for (int ks = 0; ks < 2; ++ks) qf[m][ks] = *(const bf16x8*)(qp + m * 32 + ks * 16); }
    asm volatile("s_waitcnt vmcnt(0)" ::: "memory");
    __builtin_amdgcn_s_barrier();
    ATT_DMA(t0, 0); ATT_DMA(t0 + 1, 1); ATT_DMA(t0 + 2, 2);
    asm volatile("s_waitcnt vmcnt(4)" ::: "memory");
    __builtin_amdgcn_s_barrier();
    f32x16 O[2][2];
#pragma unroll
    for (int m = 0; m < 2; ++m)
#pragma unroll
        for (int dh = 0; dh < 2; ++dh)
#pragma unroll
            for (int r = 0; r < 16; ++r) O[m][dh][r] = 0.f;
    float mref[2] = {0.f, 0.f}; f32x2 lsum[2] = {{0.f, 0.f}, {0.f, 0.f}};
    f32x16 negm[2];
#pragma unroll
    for (int m = 0; m < 2; ++m) {
#pragma unroll
        for (int r = 0; r < 16; ++r) negm[m][r] = 0.f;
        asm volatile("" : "+v"(negm[m])); }
    const int koff = q32 * 128, ksw = (q32 >> 1) & 7;
    int slot = 0;
    bf16x8 kf[2][2][2];
#define ATT_KLD(slot_) do { const LAS unsigned char* kb_ = lds + LDS_K + (slot_) * SLOT + koff; _Pragma("unroll") for (int m_ = 0; m_ < 2; ++m_) _Pragma("unroll") for (int kh_ = 0; kh_ < 2; ++kh_) \
        _Pragma("unroll") for (int ks_ = 0; ks_ < 2; ++ks_) kf[m_][kh_][ks_] = *(const LAS bf16x8*)(kb_ + kh_ * 4096 + 16 * ((m_ * 4 + ks_ * 2 + hi) ^ ksw)); } while (0)
    ATT_KLD(0);
#pragma unroll 1
    for (int t = t0; t < t1; ++t) {
        asm volatile("s_waitcnt vmcnt(2)" ::: "memory");
        __builtin_amdgcn_s_barrier();
        asm volatile("" ::: "memory");
        { const int s3 = (slot + 3) & 3; const int tn = t + 3 < t1 ? t + 3 : t1 - 1; ATT_DMA(tn, s3); }
        const LAS unsigned char* Vs = lds + LDS_V + slot * SLOT;
        u32x4 ppk[2][2][2];
        f32x16 S[2][2];
#pragma unroll
        for (int m = 0; m < 2; ++m)
#pragma unroll
            for (int kh = 0; kh < 2; ++kh)
#pragma unroll
                for (int ks = 0; ks < 2; ++ks) {
                    if (ks == 0) S[m][kh] = __builtin_amdgcn_mfma_f32_32x32x16_bf16(kf[m][kh][ks], qf[m][ks], negm[m], 0, 0, 0);
                    else S[m][kh] = __builtin_amdgcn_mfma_f32_32x32x16_bf16(kf[m][kh][ks], qf[m][ks], S[m][kh], 0, 0, 0);
                }
        float mx[2];
#pragma unroll
        for (int m = 0; m < 2; ++m) { mx[m] = __builtin_elementwise_maximum(S[m][0][0], S[m][1][0]);
#pragma unroll
            for (int r = 1; r < 16; ++r) mx[m] = __builtin_elementwise_maximum(__builtin_elementwise_maximum(mx[m], S[m][0][r]), S[m][1][r]); }
        mx[0] = xhalf_max(mx[0]); mx[1] = xhalf_max(mx[1]);
        const bool first = (t == t0);
        if (__any(first || mx[0] > THR || mx[1] > THR)) {
#pragma unroll
            for (int m = 0; m < 2; ++m) {
                const float dl = first ? mx[m] : fmaxf(mx[m], 0.f);
                mref[m] += dl;
                { const float nm = -mref[m];
#pragma unroll
                  for (int r = 0; r < 16; ++r) negm[m][r] = nm;
                  asm volatile("" : "+v"(negm[m])); }
#pragma unroll
                for (int r = 0; r < 16; ++r) { S[m][0][r] -= dl; S[m][1][r] -= dl; }
                const float f = __builtin_amdgcn_exp2f(-dl);
                lsum[m] *= f;
                if (!first) {
                    if (hi == 0) scr[q32] = f;
                    asm volatile("s_waitcnt lgkmcnt(0)" ::: "memory");
#pragma unroll
                    for (int r = 0; r < 16; ++r) { const float fr = scr[crow(r, hi)]; O[m][0][r] *= fr; O[m][1][r] *= fr; }
                    asm volatile("s_waitcnt lgkmcnt(0)" ::: "memory");
                }
            }
        }
        bf16x8 vf[2][2][2], vg[2][2];
#define ATT_VLD(dst, kh_) do { _Pragma("unroll") for (int sx_ = 0; sx_ < 2; ++sx_) _Pragma("unroll") for (int dh_ = 0; dh_ < 2; ++dh_) { const int d_ = dh_ * 32 + q32; \
            dst[sx_][dh_] = *(const LAS bf16x8*)(Vs + d_ * 128 + 16 * (((kh_) * 4 + sx_ * 2 + hi) ^ ((d_ >> 1) & 7))); } } while (0)
        ATT_VLD(vf[0], 0);
        __builtin_amdgcn_sched_barrier(0);
#pragma unroll
        for (int kh = 0; kh < 2; ++kh) {
#pragma unroll
            for (int r = 0; r < 16; r += 2) { S[0][kh][r] = __builtin_amdgcn_exp2f(S[0][kh][r]); S[0][kh][r + 1] = __builtin_amdgcn_exp2f(S[0][kh][r + 1]); lsum[0] += (f32x2){S[0][kh][r], S[0][kh][r + 1]}; }
#pragma unroll
            for (int sx = 0; sx < 2; ++sx)
#pragma unroll
                for (int j = 0; j < 4; ++j) ppk[0][kh][sx][j] = cvtpk(S[0][kh][8 * sx + 2 * j], S[0][kh][8 * sx + 2 * j + 1]);
        }
        __builtin_amdgcn_sched_barrier(0);
#pragma unroll
        for (int i = 0; i < 8; ++i) {
            { const int kh = i >> 2, sx = (i >> 1) & 1, dh = i & 1;
              O[0][dh] = __builtin_amdgcn_mfma_f32_32x32x16_bf16(__builtin_bit_cast(bf16x8, ppk[0][kh][sx]), vf[kh][sx][dh], O[0][dh], 0, 0, 0); }
            if (i == 1) ATT_VLD(vf[1], 1);
            if (i == 5) ATT_VLD(vg, 0);
            { const int kh = i >> 2, r0 = 4 * (i & 3), sx = r0 >> 3, j0 = (r0 & 7) >> 1;
#pragma unroll
              for (int r = r0; r < r0 + 4; r += 2) { S[1][kh][r] = __builtin_amdgcn_exp2f(S[1][kh][r]); S[1][kh][r + 1] = __builtin_amdgcn_exp2f(S[1][kh][r + 1]); lsum[1] += (f32x2){S[1][kh][r], S[1][kh][r + 1]}; }
              ppk[1][kh][sx][j0] = cvtpk(S[1][kh][r0], S[1][kh][r0 + 1]); ppk[1][kh][sx][j0 + 1] = cvtpk(S[1][kh][r0 + 2], S[1][kh][r0 + 3]); }
            __builtin_amdgcn_sched_barrier(0);
        }
        ATT_KLD((slot + 1) & 3);
#pragma unroll
        for (int i = 0; i < 8; ++i) { const int kh = i >> 2, sx = (i >> 1) & 1, dh = i & 1;
            O[1][dh] = __builtin_amdgcn_mfma_f32_32x32x16_bf16(__builtin_bit_cast(bf16x8, ppk[1][kh][sx]), kh == 0 ? vg[sx][dh] : vf[1][sx][dh], O[1][dh], 0, 0, 0); }
#undef ATT_VLD
        asm volatile("s_waitcnt lgkmcnt(0)" ::: "memory");
        slot = (slot + 1) & 3;
    }
    asm volatile("s_waitcnt vmcnt(0)" ::: "memory");
#undef ATT_DMA
#undef ATT_KLD
    float il[2][16];
#pragma unroll
    for (int m = 0; m < 2; ++m) { const float lh = lsum[m].x + lsum[m].y; const float lt = lh + __shfl_xor(lh, 32); if (hi == 0) scr[m * 32 + q32] = 1.f / lt; }
    asm volatile("s_waitcnt lgkmcnt(0)" ::: "memory");
#pragma unroll
    for (int m = 0; m < 2; ++m)
#pragma unroll
        for (int r = 0; r < 16; ++r) il[m][r] = scr[m * 32 + crow(r, hi)];
    asm volatile("s_waitcnt lgkmcnt(0)" ::: "memory");
    const float g0 = p.diff_subln_g[l * 64 + q32] * (1.f - lam_init), g1 = p.diff_subln_g[l * 64 + 32 + q32] * (1.f - lam_init);
    bf16_t* outp = WSP(bf16_t, WS_CONCAT) + (size_t)rowbase * D + h * 64 + q32;
#pragma unroll
    for (int r = 0; r < 16; ++r) {
        const float o0 = O[0][0][r] * il[0][r] - lam * O[1][0][r] * il[1][r], o1 = O[0][1][r] * il[0][r] - lam * O[1][1][r] * il[1][r];
        float ss = o0 * o0 + o1 * o1;
#pragma unroll
        for (int x = 1; x < 32; x <<= 1) ss += __shfl_xor(ss, x);
        const float rstd = rsqrtf(ss * (1.f / 64.f) + EPS);
        bf16_t* op = outp + (size_t)crow(r, hi) * D;
        op[0] = f2bf(o0 * rstd * g0); op[32] = f2bf(o1 * rstd * g1);
    }
}
__device__ __forceinline__ void d_attn_fast(KP kp, int l, LAS unsigned char* lds) {
    PH_IDS;
    const float* dl = p.diff_lambda + l * 4 * 32;
    float s1 = 0.f, s2 = 0.f;
    for (int i = 0; i < 32; ++i) { s1 += dl[i] * dl[32 + i]; s2 += dl[64 + i] * dl[96 + i]; }
    const float lam_init = 0.8f - 0.6f * expf(-0.3f * (float)l);
    const float lam = expf(s1) - expf(s2) + lam_init;
    const int G = gridDim.x, vb = (G % 8 == 0) ? (bid % 8) * (G / 8) + bid / 8 : bid;
    const int nunits = 256 + (l == 0 ? 16 : 0);
    for (int u = vb; u < nunits; u += G) {
        if (u < 256) attn_unit(kp, l, u >> 6, (u >> 4) & 3, u & 15, lds, lam, lam_init, tid);
        else attn_unit(kp, l, (u - 256) >> 2, (u - 256) & 3, -1, lds, lam, lam_init, tid);
    }
    __syncthreads();
}

constexpr int NCHUNK = MALL / 64;
__device__ __forceinline__ float logsig16(float x) { const float y = __builtin_amdgcn_exp2f(-fabsf(x) * 1.4426950408889634f); return (fminf(x, 0.f) - __builtin_amdgcn_logf(1.f + y) * 0.6931471805599453f) * (1.f / 16.f); }
__device__ __forceinline__ void d_prep_scan(KP kp) {
    PH_IDS;
    const bf16_t* PB = WSP(bf16_t, WS_PBUF);
    GT_LOOP(idx, 8 * MALL) {
        const int row = idx % MALL, hk = idx / MALL, h = hk >> 1, ks = hk & 1;
        const bool lat = row < NLAT; const int t = row & (SEQ - 1);
        const int ipos = lat ? (ks == 0 ? (t >> 6) : (t & 63)) : 0;
        const int cb = h * 64 + ks * 32;
        const pg8::u32x4* qs = (const pg8::u32x4*)(PB + (size_t)row * PW + PC_RQ + cb);
        const pg8::u32x4* ksrc = (const pg8::u32x4*)(PB + (size_t)row * PW + PC_RK + cb);
        float qv[32], kv[32];
#pragma unroll
        for (int c4 = 0; c4 < 4; ++c4) { const pg8::u32x4 a = qs[c4], b4 = ksrc[c4];
#pragma unroll
            for (int j = 0; j < 4; ++j) { qv[c4 * 8 + 2 * j] = bf2f((bf16_t)(a[j] & 0xffff)); qv[c4 * 8 + 2 * j + 1] = bf2f((bf16_t)(a[j] >> 16)); kv[c4 * 8 + 2 * j] = bf2f((bf16_t)(b4[j] & 0xffff)); kv[c4 * 8 + 2 * j + 1] = bf2f((bf16_t)(b4[j] >> 16)); } }
        float qo[32], ko[32];
#pragma unroll
        for (int j = 0; j < 16; ++j) {
            const float* tb = WSP(float, WS_ROPE) + 1024 + (ipos * 16 + j) * 2; const float cs = tb[0], sn = tb[1];
            qo[j] = qv[j] * cs - qv[j + 16] * sn; qo[j + 16] = qv[j + 16] * cs + qv[j] * sn;
            ko[j] = (kv[j] * cs - kv[j + 16] * sn) * 0.125f; ko[j + 16] = (kv[j + 16] * cs + kv[j] * sn) * 0.125f;
        }
        pg8::u32x4* qd = (pg8::u32x4*)(WSP(bf16_t, WS_QF_R) + (size_t)row * 256 + cb); pg8::u32x4* kd = (pg8::u32x4*)(WSP(bf16_t, WS_KF_R) + (size_t)row * 256 + cb);
#pragma unroll
        for (int c4 = 0; c4 < 4; ++c4) { pg8::u32x4 a, b4;
#pragma unroll
            for (int j = 0; j < 4; ++j) { a[j] = pk2(qo[c4 * 8 + 2 * j], qo[c4 * 8 + 2 * j + 1]); b4[j] = pk2(ko[c4 * 8 + 2 * j], ko[c4 * 8 + 2 * j + 1]); }
            qd[c4] = a; kd[c4] = b4; }
        bf16_t* kt = WSP(bf16_t, WS_KT_R) + ((size_t)((row >> 6) * 4 + h) * 64 + ks * 32) * 64 + (row & 63);
#pragma unroll
        for (int i = 0; i < 32; ++i) kt[(size_t)i * 64] = f2bf(ko[i]);
    }
    GT_LOOP(idx, 4 * MALL) {
        const int row = idx % MALL, h = idx / MALL;
        const pg8::u32x4* ksrc = (const pg8::u32x4*)(PB + (size_t)row * PW + PC_GK + h * 32);
        bf16_t* kt = WSP(bf16_t, WS_KT_G) + ((size_t)((row >> 6) * 4 + h) * 32) * 64 + (row & 63);
#pragma unroll
        for (int c4 = 0; c4 < 4; ++c4) { const pg8::u32x4 a = ksrc[c4];
#pragma unroll
            for (int j = 0; j < 4; ++j) { kt[(size_t)(c4 * 8 + 2 * j) * 64] = (bf16_t)(a[j] & 0xffff); kt[(size_t)(c4 * 8 + 2 * j + 1) * 64] = (bf16_t)(a[j] >> 16); } }
    }
    GT_LOOP(idx, NCHUNK * 2 * 128) {
        const int hk = idx & 127, dir = (idx >> 7) & 1, cid = idx >> 8;
        const bf16_t* src = PB + (size_t)(cid * 64) * PW + PC_GD + dir * 128 + hk;
        float* cum = WSP(float, WS_CUM_G) + ((size_t)dir * MALL + cid * 64) * 128 + hk;
        float* cumt = WSP(float, WS_CUMT_G) + (((size_t)dir * NCHUNK + cid) * 128 + hk) * 64;
        float v[64];
#pragma unroll
        for (int j = 0; j < 64; ++j) v[j] = bf2f(src[(size_t)j * PW]);
#pragma unroll
        for (int j = 0; j < 64; ++j) v[j] = logsig16(v[j]);
        if (dir == 0) {
#pragma unroll
            for (int j = 1; j < 64; ++j) v[j] += v[j - 1];
        } else {
#pragma unroll
            for (int j = 62; j >= 0; --j) v[j] += v[j + 1];
        }
#pragma unroll
        for (int j = 0; j < 64; ++j) cum[(size_t)j * 128] = v[j];
#pragma unroll
        for (int j = 0; j < 16; ++j) *(pg8::f32x4*)(cumt + 4 * j) = (pg8::f32x4){v[4 * j], v[4 * j + 1], v[4 * j + 2], v[4 * j + 3]};
    }
    GT_LOOP(idx, 2 * NCHUNK * 4 * 2 * 64) {
        const int d = idx & 63, half = (idx >> 6) & 1, ch = (idx >> 7) % (NCHUNK * 4), mx = idx / (128 * NCHUNK * 4), h = ch & 3, cid = ch >> 2;
        const bf16_t* vp = PB + (size_t)(cid * 64 + half * 32) * PW + (mx == 0 ? PC_RV : PC_GV) + h * 64 + d;
        unsigned short vv[32];
#pragma unroll
        for (int j = 0; j < 32; ++j) vv[j] = vp[(size_t)j * PW];
        unsigned char* img = WSP(unsigned char, mx == 0 ? WS_VT_R : WS_VT_G) + (size_t)ch * 8192 + d * 128; const int x = (d >> 1) & 15;
#pragma unroll
        for (int j = 0; j < 8; ++j) *(pg8::u32x2*)(img + 8 * ((half * 8 + j) ^ x)) = (pg8::u32x2){(unsigned)vv[4 * j] | ((unsigned)vv[4 * j + 1] << 16), (unsigned)vv[4 * j + 2] | ((unsigned)vv[4 * j + 3] << 16)};
    }
}

namespace scn {
typedef short bf16x8 __attribute__((ext_vector_type(8)));
typedef float f32x16 __attribute__((ext_vector_type(16)));
typedef float f32x4 __attribute__((ext_vector_type(4)));
typedef unsigned u32x4 __attribute__((ext_vector_type(4)));
typedef unsigned u32x2 __attribute__((ext_vector_type(2)));
__device__ __forceinline__ int crow(int r, int hi) { return (r & 3) + 8 * (r >> 2) + 4 * hi; }
__device__ __forceinline__ unsigned cvtpk(float lo, float hi) { return cvtpk_rne(lo, hi); }
__device__ __forceinline__ float blo(unsigned w) { return __uint_as_float(w << 16); }
__device__ __forceinline__ float bhi(unsigned w) { return __uint_as_float(w & 0xffff0000u); }
__device__ __forceinline__ bf16x8 scale8(u32x4 raw, const float (&f)[8]) {
    u32x4 o;
#pragma unroll
    for (int j = 0; j < 4; ++j) o[j] = cvtpk(blo(raw[j]) * f[2 * j], bhi(raw[j]) * f[2 * j + 1]);
    return __builtin_bit_cast(bf16x8, o);
}
template <int MX> struct Cfg;
template <> struct Cfg<0> { static constexpr int DK = 64; };
template <> struct Cfg<1> { static constexpr int DK = 32; };
}
#define SCN_EXP(x) __builtin_amdgcn_exp2f((x) * 1.4426950408889634f)
template <int MX> __device__ __forceinline__ void scan_stage1_unit(KP kp, int l, int b, int h, int g, int tid) {
    using namespace scn;
    constexpr int DK = Cfg<MX>::DK, NKT = DK / 32, NE = DK * 64 / NT;
    const int lane = tid & 63, wid = __builtin_amdgcn_readfirstlane(tid >> 6), q32 = lane & 31, hi = lane >> 5;
    const int nch = g == 8 ? 4 : 8, cid0 = g == 8 ? 256 + 4 * b : b * 64 + 8 * g;
    float* US = WSP(float, MX == 0 ? WS_US_R : WS_US_G);
    const float* CUMT = WSP(float, WS_CUMT_G);
    if (wid < nch) {
        const int cid = cid0 + wid;
        const unsigned char* vimg = WSP(unsigned char, MX == 0 ? WS_VT_R : WS_VT_G) + (size_t)(cid * 4 + h) * 8192;
        const bf16_t* ktimg = WSP(bf16_t, MX == 0 ? WS_KT_R : WS_KT_G) + (size_t)(cid * 4 + h) * DK * 64;
        bf16x8 vb[2][4];
#pragma unroll
        for (int dh = 0; dh < 2; ++dh)
#pragma unroll
            for (int s = 0; s < 4; ++s) { const int d = dh * 32 + q32, x = (d >> 1) & 15, kc = 4 * s + 2 * hi;
                u32x4 v = *(const u32x4*)(vimg + d * 128 + 16 * ((kc ^ x) >> 1));
                if (x & 1) v = (u32x4){v.z, v.w, v.x, v.y};
                vb[dh][s] = __builtin_bit_cast(bf16x8, v); }
#pragma unroll 1
        for (int dir = 0; dir < 2; ++dir) {
            float lg = 0.f; if (MX == 0) lg = -expf(p.ret_decay[(l * 2 + dir) * 4 + h]);
#pragma unroll 1
            for (int kt = 0; kt < NKT; ++kt) {
                f32x16 U[2];
#pragma unroll
                for (int dh = 0; dh < 2; ++dh)
#pragma unroll
                    for (int r = 0; r < 16; ++r) U[dh][r] = 0.f;
                const int k = kt * 32 + q32;
                const float* ct = CUMT + (((size_t)dir * NCHUNK + cid) * 128 + h * 32 + (k & 31)) * 64;
                float E = 0.f; if (MX == 1) E = ct[dir == 0 ? 63 : 0];
#pragma unroll
                for (int s = 0; s < 4; ++s) {
                    const int j0 = 16 * s + 8 * hi;
                    const u32x4 raw = *(const u32x4*)(ktimg + (size_t)k * 64 + j0);
                    float f[8];
                    if (MX == 0) {
#pragma unroll
                        for (int jj = 0; jj < 8; ++jj) f[jj] = SCN_EXP(lg * (float)(dir == 0 ? 63 - (j0 + jj) : j0 + jj));
                    } else {
                        const f32x4 c0 = *(const f32x4*)(ct + j0), c1 = *(const f32x4*)(ct + j0 + 4);
#pragma unroll
                        for (int jj = 0; jj < 4; ++jj) { f[jj] = SCN_EXP(E - c0[jj]); f[4 + jj] = SCN_EXP(E - c1[jj]); }
                    }
                    const bf16x8 af = scale8(raw, f);
#pragma unroll
                    for (int dh = 0; dh < 2; ++dh) U[dh] = __builtin_amdgcn_mfma_f32_32x32x16_bf16(af, vb[dh][s], U[dh], 0, 0, 0);
                }
                float* up = US + ((((size_t)dir * NCHUNK + cid) * 4 + h) * DK + kt * 32 + 4 * hi) * 64 + q32;
#pragma unroll
                for (int dh = 0; dh < 2; ++dh)
#pragma unroll
                    for (int r = 0; r < 16; ++r) up[((r & 3) + 8 * (r >> 2)) * 64 + dh * 32] = U[dh][r];
            }
        }
    }
    asm volatile("s_waitcnt vmcnt(0)" ::: "memory");
    __syncthreads();
    const int k = (tid * NE) >> 6, d0 = (tid * NE) & 63;
#pragma unroll 1
    for (int dir = 0; dir < 2; ++dir) {
        float S[NE], Ap = 1.f;
#pragma unroll
        for (int e = 0; e < NE; ++e) S[e] = 0.f;
        float lg = 0.f; if (MX == 0) lg = -expf(p.ret_decay[(l * 2 + dir) * 4 + h]);
        {
            float uc[8][NE], ac[8];
#pragma unroll
            for (int cc = 0; cc < 8; ++cc) { const bool on = cc < nch; const int c = dir == 0 ? cc : nch - 1 - cc, cid = cid0 + (on ? c : 0);
                if (MX == 0) ac[cc] = SCN_EXP(lg * 64.f); else ac[cc] = SCN_EXP(CUMT[(((size_t)dir * NCHUNK + cid) * 128 + h * 32 + k) * 64 + (dir == 0 ? 63 : 0)]);
                const float* up = US + ((((size_t)dir * NCHUNK + cid) * 4 + h) * DK + k) * 64 + d0;
#pragma unroll
                for (int e = 0; e < NE; ++e) uc[cc][e] = up[e]; }
#pragma unroll
            for (int cc = 0; cc < 8; ++cc) if (cc < nch) {
#pragma unroll
                for (int e = 0; e < NE; ++e) S[e] = ac[cc] * S[e] + uc[cc][e];
                Ap *= ac[cc]; }
        }
        float* ug = WSP(float, MX == 0 ? WS_UG_R : WS_UG_G) + (((((size_t)dir * 4 + b) * 4 + h) * 9 + g) * DK + k) * 64 + d0;
#pragma unroll
        for (int e = 0; e < NE; ++e) ug[e] = S[e];
        if (d0 == 0) WSP(float, WS_AG)[((((MX * 2 + dir) * 4 + b) * 4 + h) * 9 + g) * 64 + k] = Ap;
    }
}
template <int MX> __device__ __forceinline__ void scan_stage2_unit(KP kp, int l, int b, int h, int g, LAS unsigned char* lds, int tid) {
    using namespace scn;
    constexpr int DK = Cfg<MX>::DK, NKS = DK / 16, NE = DK * 64 / NT, NCH16 = DK / 8;
    const int lane = tid & 63, wid = __builtin_amdgcn_readfirstlane(tid >> 6), q32 = lane & 31, hi = lane >> 5;
    const int nch = g == 8 ? 4 : 8, cid0 = g == 8 ? 256 + 4 * b : b * 64 + 8 * g;
    const bool act = wid < nch;
    const int cid = cid0 + (act ? wid : 0), row0 = cid * 64;
    const bf16_t* PB = WSP(bf16_t, WS_PBUF);
    const float* US = WSP(float, MX == 0 ? WS_US_R : WS_US_G);
    const float* UG = WSP(float, MX == 0 ? WS_UG_R : WS_UG_G);
    const float* CUMT = WSP(float, WS_CUMT_G);
    f32x16 o[2][2];
#pragma unroll
    for (int it = 0; it < 2; ++it)
#pragma unroll
        for (int dh = 0; dh < 2; ++dh)
#pragma unroll
            for (int r = 0; r < 16; ++r) o[it][dh][r] = 0.f;
    LAS unsigned char* myv = lds + 65536 + wid * 8192;
    { const unsigned char* vimg = WSP(unsigned char, MX == 0 ? WS_VT_R : WS_VT_G) + (size_t)(cid * 4 + h) * 8192 + lane * 16;
      u32x4 tmp[8];
#pragma unroll
      for (int i = 0; i < 8; ++i) tmp[i] = *(const u32x4*)(vimg + i * 1024);
#pragma unroll
      for (int i = 0; i < 8; ++i) *(LAS u32x4*)(myv + i * 1024 + lane * 16) = tmp[i]; }
    const int fk = (tid * NE) >> 6, fd0 = (tid * NE) & 63;
#pragma unroll 1
    for (int dir = 0; dir < 2; ++dir) {
        float lg = 0.f; if (MX == 0) lg = -expf(p.ret_decay[(l * 2 + dir) * 4 + h]);
        float S[NE];
#pragma unroll
        for (int e = 0; e < NE; ++e) S[e] = 0.f;
        if (g != 8) {
            const float* ugb = UG + (((size_t)dir * 4 + b) * 4 + h) * 9 * DK * 64 + (size_t)fk * 64 + fd0;
            const float* agb = WSP(float, WS_AG) + (((MX * 2 + dir) * 4 + b) * 4 + h) * 9 * 64 + fk;
            const int ng = dir == 0 ? g : 7 - g;
            float ug[7][NE], ag[7];
#pragma unroll
            for (int e = 0; e < NE; ++e) S[e] = ugb[(size_t)8 * DK * 64 + e];
#pragma unroll
            for (int q = 0; q < 7; ++q) { const bool on = q < ng; const int qq = on ? q : 0, gg = dir == 0 ? qq : 7 - qq; const float av = agb[gg * 64]; ag[q] = on ? av : 1.f;
#pragma unroll
                for (int e = 0; e < NE; ++e) { const float uv = ugb[(size_t)gg * DK * 64 + e]; ug[q][e] = on ? uv : 0.f; } }
#pragma unroll
            for (int q = 0; q < 7; ++q)
#pragma unroll
                for (int e = 0; e < NE; ++e) S[e] = ag[q] * S[e] + ug[q][e];
        }
        {
            float uc[8][NE], ac[8];
#pragma unroll
            for (int cc = 0; cc < 8; ++cc) { const bool on = cc < nch; const int c = dir == 0 ? cc : nch - 1 - cc, ccid = cid0 + (on ? c : 0);
                if (MX == 0) ac[cc] = SCN_EXP(lg * 64.f); else ac[cc] = SCN_EXP(CUMT[(((size_t)dir * NCHUNK + ccid) * 128 + h * 32 + fk) * 64 + (dir == 0 ? 63 : 0)]);
                const float* up = US + ((((size_t)dir * NCHUNK + ccid) * 4 + h) * DK + fk) * 64 + fd0;
#pragma unroll
                for (int e = 0; e < NE; ++e) uc[cc][e] = up[e]; }
#pragma unroll
            for (int cc = 0; cc < 8; ++cc) if (cc < nch) {
                const int c = dir == 0 ? cc : nch - 1 - cc;
                LAS unsigned char* area = lds + c * 8192;
#pragma unroll
                for (int e = 0; e < NE; ++e) { const int d = fd0 + e; const int sw = DK == 64 ? ((d >> 1) & 7) : ((d >> 2) & 3);
                    *(LAS bf16_t*)(area + d * (DK * 2) + 16 * ((fk >> 3) ^ sw) + (fk & 7) * 2) = f2bf(S[e]); }
#pragma unroll
                for (int e = 0; e < NE; ++e) S[e] = ac[cc] * S[e] + uc[cc][e];
            }
        }
        asm volatile("s_waitcnt lgkmcnt(0)" ::: "memory");
        __syncthreads();
        if (act) {
#define SCN_GEN(dst, ISQ, T2) do { const int il_ = 32 * (T2) + q32, row_ = row0 + il_; \
                _Pragma("unroll") for (int ks = 0; ks < NKS; ++ks) { const int kc0 = 16 * ks + 8 * hi; u32x4 raw_; float f_[8]; \
                    if (MX == 0) { raw_ = *(const u32x4*)(WSP(bf16_t, (ISQ) ? WS_QF_R : WS_KF_R) + (size_t)row_ * 256 + h * 64 + kc0); \
                        const float cm_ = lg * (float)(dir == 0 ? il_ + 1 : 64 - il_), e_ = SCN_EXP((ISQ) ? cm_ : -cm_); \
                        _Pragma("unroll") for (int jj = 0; jj < 8; ++jj) f_[jj] = e_; \
                    } else { raw_ = *(const u32x4*)(PB + (size_t)row_ * PW + ((ISQ) ? PC_GQ : PC_GK) + h * 32 + kc0); \
                        const float* cp_ = WSP(float, WS_CUM_G) + ((size_t)dir * MALL + row_) * 128 + h * 32 + kc0; \
                        const f32x4 c0_ = *(const f32x4*)cp_, c1_ = *(const f32x4*)(cp_ + 4); \
                        _Pragma("unroll") for (int jj = 0; jj < 4; ++jj) { f_[jj] = (ISQ) ? SCN_EXP(c0_[jj]) * 0.17677669529663687f : SCN_EXP(-c0_[jj]); f_[4 + jj] = (ISQ) ? SCN_EXP(c1_[jj]) * 0.17677669529663687f : SCN_EXP(-c1_[jj]); } } \
                    dst[ks] = scale8(raw_, f_); } } while (0)
#define SCN_TILE(JT, IT, MASKED) do { bf16x8 kf_[NKS]; SCN_GEN(kf_, false, JT); f32x16 P; \
                _Pragma("unroll") for (int r = 0; r < 16; ++r) P[r] = 0.f; \
                _Pragma("unroll") for (int ks = 0; ks < NKS; ++ks) P = __builtin_amdgcn_mfma_f32_32x32x16_bf16(kf_[ks], qf[ks], P, 0, 0, 0); \
                if (MASKED) { _Pragma("unroll") for (int r = 0; r < 16; ++r) { const int j = crow(r, hi); const bool keep = dir == 0 ? (j <= q32) : (j >= q32); P[r] = keep ? P[r] : 0.f; } } \
                _Pragma("unroll") for (int s = 0; s < 2; ++s) { u32x4 pk; \
                    _Pragma("unroll") for (int j = 0; j < 4; ++j) pk[j] = cvtpk(P[8 * s + 2 * j], P[8 * s + 2 * j + 1]); \
                    _Pragma("unroll") for (int dh = 0; dh < 2; ++dh) { const int d = dh * 32 + q32, x = (d >> 1) & 15, kc = 8 * JT + 4 * s + hi; \
                        const u32x2 v0 = *(const LAS u32x2*)(myv + d * 128 + 8 * (kc ^ x)), v1 = *(const LAS u32x2*)(myv + d * 128 + 8 * ((kc + 2) ^ x)); \
                        o[IT][dh] = __builtin_amdgcn_mfma_f32_32x32x16_bf16(__builtin_bit_cast(bf16x8, pk), __builtin_bit_cast(bf16x8, (u32x4){v0.x, v0.y, v1.x, v1.y}), o[IT][dh], 0, 0, 0); } } } while (0)
#define SCN_INTER(IT) do { const LAS unsigned char* area = lds + wid * 8192; \
                _Pragma("unroll") for (int dh = 0; dh < 2; ++dh) _Pragma("unroll") for (int ks = 0; ks < NKS; ++ks) { \
                    const int d = dh * 32 + q32, sw = DK == 64 ? ((d >> 1) & 7) : ((d >> 2) & 3); \
                    const bf16x8 sf = *(const LAS bf16x8*)(area + d * (DK * 2) + 16 * ((2 * ks + hi) ^ sw)); \
                    o[IT][dh] = __builtin_amdgcn_mfma_f32_32x32x16_bf16(qf[ks], sf, o[IT][dh], 0, 0, 0); } } while (0)
            { bf16x8 qf[NKS]; SCN_GEN(qf, true, 0);
              SCN_TILE(0, 0, true); if (dir == 1) SCN_TILE(1, 0, false);
              SCN_INTER(0); }
            asm volatile("" ::: "memory");
            { bf16x8 qf[NKS]; SCN_GEN(qf, true, 1);
              if (dir == 0) SCN_TILE(0, 1, false);
              SCN_TILE(1, 1, true);
              SCN_INTER(1); }
#undef SCN_GEN
#undef SCN_TILE
#undef SCN_INTER
        }
        asm volatile("s_waitcnt lgkmcnt(0)" ::: "memory");
        __syncthreads();
    }
    if (act) {
        const int gcol = (MX == 0 ? PC_RG : PC_GR) + h * 64, ccol = (MX == 0 ? 512 : 768) + h * 64;
        const float g0 = MX == 0 ? p.ret_norm_g[l * 256 + h * 64 + q32] : p.gla_norm_g[l * 64 + q32], g1 = MX == 0 ? p.ret_norm_g[l * 256 + h * 64 + 32 + q32] : p.gla_norm_g[l * 64 + 32 + q32];
#pragma unroll
        for (int it = 0; it < 2; ++it)
#pragma unroll
            for (int r = 0; r < 16; ++r) {
                const int row = row0 + 32 * it + crow(r, hi);
                const float a0 = o[it][0][r], a1 = o[it][1][r];
                float ss = a0 * a0 + a1 * a1;
#pragma unroll
                for (int x = 1; x < 32; x <<= 1) ss += __shfl_xor(ss, x);
                const float rstd = rsqrtf(ss * (1.f / 64.f) + EPS);
                const float gt0 = bf2f(PB[(size_t)row * PW + gcol + q32]), gt1 = bf2f(PB[(size_t)row * PW + gcol + 32 + q32]);
                bf16_t* op = WSP(bf16_t, WS_CONCAT) + (size_t)row * D + ccol + q32;
                op[0] = f2bf(a0 * rstd * g0 * (gt0 / (1.f + SCN_EXP(-gt0)))); op[32] = f2bf(a1 * rstd * g1 * (gt1 / (1.f + SCN_EXP(-gt1))));
                if ((r & 3) == 3) asm volatile("" ::: "memory");
            }
    }
}
__device__ __forceinline__ bool scan_unit(int slot, bool with_ctx, int& mx, int& bh, int& g) {
    if (slot < 256) { mx = slot >> 7; const int r = slot & 127; bh = r >> 3; g = r & 7; return true; }
    if (!with_ctx) return false;
    const int j = slot - 256 - 128;
    if (j < 0 || j >= 32) return false;
    mx = j >> 4; bh = j & 15; g = 8; return true;
}
__device__ __forceinline__ void d_scan_stage1(KP kp, int l) {
    PH_IDS;
    for (int slot = bid; slot < 512; slot += gridDim.x) {
        int mx, bh, g; if (!scan_unit(slot, true, mx, bh, g)) continue;
        if (mx == 0) scan_stage1_unit<0>(kp, l, bh >> 2, bh & 3, g, tid); else scan_stage1_unit<1>(kp, l, bh >> 2, bh & 3, g, tid);
    }
}
__device__ __forceinline__ void d_scan_stage2(KP kp, int l, LAS unsigned char* lds) {
    PH_IDS;
    for (int slot = bid; slot < 512; slot += gridDim.x) {
        int mx, bh, g; if (!scan_unit(slot, l == 0, mx, bh, g)) continue;
        if (mx == 0) scan_stage2_unit<0>(kp, l, bh >> 2, bh & 3, g, lds, tid); else scan_stage2_unit<1>(kp, l, bh >> 2, bh & 3, g, lds, tid);
    }
}
namespace hfft {
typedef float f2 __attribute__((ext_vector_type(2)));
typedef float f4 __attribute__((ext_vector_type(4)));
constexpr int N = 8192;
__device__ __forceinline__ f2 cmul(f2 a, f2 b) { return (f2){a.x * b.x - a.y * b.y, a.x * b.y + a.y * b.x}; }
__device__ __forceinline__ f2 cmulc(f2 a, f2 b) { return (f2){a.x * b.x + a.y * b.y, a.y * b.x - a.x * b.y}; }
__device__ __forceinline__ f2 tw(float frac) { float sn, cs; sincosf(6.283185307179586f * frac, &sn, &cs); return (f2){cs, -sn}; }
constexpr int TWOFF = 131072 + 64;
__device__ __forceinline__ void tw_build(LAS unsigned char* lds, int tid) { LAS f2* T = (LAS f2*)(lds + TWOFF); for (int k = tid; k < 1024; k += NT) T[k] = tw((float)k * (1.f / 8192.f)); }
__device__ __forceinline__ f2 twk(const LAS f2* T, int k) {
    const f2 a = T[k & 1023]; const float r = 0.70710678118654752f;
    return (k & 1024) ? (f2){(a.x + a.y) * r, (a.y - a.x) * r} : a;
}
__device__ __forceinline__ f2 mul_mi(f2 a) { return (f2){a.y, -a.x}; }
__device__ __forceinline__ f2 mul_pi(f2 a) { return (f2){-a.y, a.x}; }
template <int LOGD> __device__ __forceinline__ void fwd_pass(LAS f2* buf, int tid) {
    constexpr int Dd = 1 << LOGD;
#pragma unroll
    for (int g = 0; g < 4; ++g) {
        const int u = tid + NT * g, pos = u & (Dd - 1), base = ((u - pos) << 2) + pos;
        const f2 wA = twk((const LAS f2*)((LAS unsigned char*)buf + TWOFF), pos << (11 - LOGD)), wB = cmul(wA, wA);
#pragma unroll
        for (int arr = 0; arr < 2; ++arr) {
            LAS f2* x = buf + arr * N + base;
            const f2 a0 = x[0], a1 = x[Dd], a2 = x[2 * Dd], a3 = x[3 * Dd];
            const f2 b0 = a0 + a2, b2 = cmul(a0 - a2, wA), b1 = a1 + a3, b3 = mul_mi(cmul(a1 - a3, wA));
            x[0] = b0 + b1; x[Dd] = cmul(b0 - b1, wB); x[2 * Dd] = b2 + b3; x[3 * Dd] = cmul(b2 - b3, wB);
        }
    }
    __syncthreads();
}
template <int LOGD> __device__ __forceinline__ void inv_pass(LAS f2* buf, int tid) {
    constexpr int Dd = 1 << LOGD;
#pragma unroll
    for (int g = 0; g < 4; ++g) {
        const int u = tid + NT * g, pos = u & (Dd - 1), base = ((u - pos) << 2) + pos;
        const f2 wA = twk((const LAS f2*)((LAS unsigned char*)buf + TWOFF), pos << (11 - LOGD)), wB = cmul(wA, wA);
#pragma unroll
        for (int arr = 0; arr < 2; ++arr) {
            LAS f2* x = buf + arr * N + base;
            const f2 c0 = x[0], c1 = cmulc(x[Dd], wB), c2 = x[2 * Dd], c3 = cmulc(x[3 * Dd], wB);
            const f2 b0 = c0 + c1, b1 = c0 - c1, b2 = cmulc(c2 + c3, wA), b3 = mul_pi(cmulc(c2 - c3, wA));
            x[0] = b0 + b2; x[2 * Dd] = b0 - b2; x[Dd] = b1 + b3; x[3 * Dd] = b1 - b3;
        }
    }
    __syncthreads();
}
__device__ __forceinline__ void fwd_all(LAS f2* buf, int tid) { fwd_pass<11>(buf, tid); fwd_pass<9>(buf, tid); fwd_pass<7>(buf, tid); fwd_pass<5>(buf, tid); fwd_pass<3>(buf, tid); fwd_pass<1>(buf, tid); }
__device__ __forceinline__ void inv_all(LAS f2* buf, int tid) { inv_pass<1>(buf, tid); inv_pass<3>(buf, tid); inv_pass<5>(buf, tid); inv_pass<7>(buf, tid); inv_pass<9>(buf, tid); inv_pass<11>(buf, tid); }
}
__device__ __forceinline__ void d_fspec(KP kp, LAS unsigned char* lds) {
    PH_IDS;
    using namespace hfft;
    LAS f2* buf = (LAS f2*)lds; LAS float* nrm = (LAS float*)(lds + 131072);
    tw_build(lds, tid);
    for (int u = bid; u < 256; u += gridDim.x) {
        const int l = u >> 7, c0 = (u & 127) * 2;
        const float* filt = WSP(float, WS_FILT) + (size_t)l * 8192 * 256;
        if (tid < 128) {
            const int arr = tid >> 6, ln = tid & 63; float a = 0.f;
#pragma unroll
            for (int q = 0; q < 4; ++q) a += WSP(float, WS_PS)[(size_t)(l * 256 + ln * 4 + q) * 256 + c0 + arr];
            a = wave_sum(a); if (ln == 0) nrm[arr] = a;
        }
        for (int i = tid; i < 2 * N; i += NT) { const int arr = i >> 13, tau = i & (N - 1); buf[i] = (f2){filt[(size_t)tau * 256 + c0 + arr], 0.f}; }
        __syncthreads();
        fwd_all(buf, tid);
        f4* fs = (f4*)(WSP(float, WS_FSPEC) + ((size_t)l * 256 + c0) * 2 * N);
        for (int i = tid; i < N; i += NT) {
            const int arr = i >> 12, j = i & 4095;
            const f4 v = *(const LAS f4*)(buf + arr * N + 2 * j);
            const float sc = 1.f / (8192.f * nrm[arr]), bs = p.hy_bias[l * 256 + c0 + arr] * (1.f / 8192.f);
            fs[(size_t)arr * (N / 2) + j] = (f4){(v.x + v.z) * sc + bs, (v.y + v.w) * sc, (v.x - v.z) * sc + bs, (v.y - v.w) * sc};
        }
        __syncthreads();
    }
}
__device__ __forceinline__ void d_hy_pre_fast(KP kp, int l, LAS unsigned char* lds) {
    PH_IDS;
    LAS float* zt = (LAS float*)lds;
    const bf16_t* PB = WSP(bf16_t, WS_PBUF);
    const int c = tid & 255, half = tid >> 8;
    const float* sw = p.hy_short_w + l * 3 * 768; const float* sb = p.hy_short_b + l * 768;
    float w0[3], w1[3], w2[3], bb[3];
#pragma unroll
    for (int g = 0; g < 3; ++g) { w0[g] = sw[g * 256 + c]; w1[g] = sw[768 + g * 256 + c]; w2[g] = sw[1536 + g * 256 + c]; bb[g] = sb[g * 256 + c]; }
    for (int u = bid; u < NLAT / 64; u += gridDim.x) {
        const int row0 = u * 64 + half * 32, t0 = (u * 64) & (SEQ - 1);
        const int tfirst = t0 + half * 32;
        float xin[3][34];
#pragma unroll
        for (int g = 0; g < 3; ++g) {
            const bf16_t* pp = PB + (size_t)row0 * PW + PC_HY + g * 256 + c;
#pragma unroll
            for (int i = 0; i < 34; ++i) { const int t = tfirst + i - 1, tc = t < 0 ? 0 : (t > SEQ - 1 ? SEQ - 1 : t); const float v = bf2f(pp[(ptrdiff_t)(tc - tfirst) * PW]); xin[g][i] = (t == tc) ? v : 0.f; }
        }
#pragma unroll
        for (int i = 0; i < 32; ++i) {
            float uu[3];
#pragma unroll
            for (int g = 0; g < 3; ++g) uu[g] = bb[g] + w0[g] * xin[g][i] + w1[g] * xin[g][i + 1] + w2[g] * xin[g][i + 2];
            WSP(bf16_t, WS_X0B)[(size_t)(row0 + i) * 256 + c] = f2bf(uu[0]);
            zt[c * 65 + half * 32 + i] = uu[1] * uu[2];
        }
        __syncthreads();
        const int b = (u * 64) >> 12;
        for (int i = tid; i < 256 * 64; i += NT) { const int cc = i >> 6, tl = i & 63; WSP(float, WS_ZT)[((size_t)cc * 4 + b) * SEQ + t0 + tl] = zt[cc * 65 + tl]; }
        __syncthreads();
    }
    if (l == 0) {
        GT_LOOP(idx, NCTX * 256) {
            const int r = idx >> 8, cc = idx & 255, t = r & (CTXL - 1);
            const bf16_t* pp = PB + (size_t)(NLAT + r) * PW + PC_HY + cc;
            float uu[3];
#pragma unroll
            for (int g = 0; g < 3; ++g) { float a = sb[g * 256 + cc] + sw[768 + g * 256 + cc] * bf2f(pp[g * 256]);
                const float pv = bf2f(pp[g * 256 - (t > 0 ? PW : 0)]), nv = bf2f(pp[g * 256 + (t < CTXL - 1 ? PW : 0)]);
                a += sw[g * 256 + cc] * (t > 0 ? pv : 0.f) + sw[1536 + g * 256 + cc] * (t < CTXL - 1 ? nv : 0.f); uu[g] = a; }
            WSP(float, WS_X0C)[idx] = uu[0]; WSP(float, WS_ZC)[idx] = uu[1] * uu[2];
        }
    }
}
__device__ __forceinline__ void d_hy_fft(KP kp, int l, LAS unsigned char* lds) {
    PH_IDS;
    using namespace hfft;
    LAS f2* buf = (LAS f2*)lds;
    tw_build(lds, tid);
    for (int c = bid; c < 256; c += gridDim.x) {
        const float* zt = WSP(float, WS_ZT) + (size_t)c * 4 * SEQ;
#pragma unroll
        for (int arr = 0; arr < 2; ++arr) {
            float re[8], im[8];
#pragma unroll
            for (int i = 0; i < 8; ++i) { re[i] = zt[(size_t)(2 * arr) * SEQ + tid + i * NT]; im[i] = zt[(size_t)(2 * arr + 1) * SEQ + tid + i * NT]; }
            f2 zz; { float zx_, zy_; asm volatile("v_mov_b32 %0, 0\n\tv_mov_b32 %1, 0" : "=v"(zx_), "=v"(zy_)); zz = (f2){zx_, zy_}; }
#pragma unroll
            for (int i = 0; i < 8; ++i) { buf[arr * N + tid + i * NT] = (f2){re[i], im[i]}; buf[arr * N + SEQ + tid + i * NT] = zz; }
        }
        __syncthreads();
        fwd_all(buf, tid);
        const f4* fs = (const f4*)(WSP(float, WS_FSPEC) + ((size_t)l * 256 + c) * 2 * N);
        for (int i = tid; i < N; i += NT) {
            const int arr = i >> 12, j = i & 4095;
            LAS f4* xp = (LAS f4*)(buf + arr * N + 2 * j);
            const f4 v = *xp; const f4 f = fs[j];
            const f2 s = cmul((f2){v.x + v.z, v.y + v.w}, (f2){f.x, f.y}), d = cmul((f2){v.x - v.z, v.y - v.w}, (f2){f.z, f.w});
            *xp = (f4){s.x + d.x, s.y + d.y, s.x - d.x, s.y - d.y};
        }
        __syncthreads();
        inv_all(buf, tid);
        float* yt = WSP(float, WS_YT) + (size_t)c * 4 * SEQ;
        for (int i = tid; i < 2 * SEQ; i += NT) { const int arr = i >> 12, t = i & (SEQ - 1); const f2 v = buf[arr * N + t];
            yt[(size_t)(2 * arr) * SEQ + t] = v.x; yt[(size_t)(2 * arr + 1) * SEQ + t] = v.y; }
        __syncthreads();
    }
}
__device__ __forceinline__ void d_hy_post(KP kp, int l, LAS unsigned char* lds) {
    PH_IDS;
    LAS float* yt = (LAS float*)lds;
    for (int u = bid; u < NLAT / 64; u += gridDim.x) {
        const int b = (u * 64) >> 12, t0 = (u * 64) & (SEQ - 1);
#pragma unroll 1
        for (int hb2 = 0; hb2 < 4; ++hb2) {
            float yv[8];
#pragma unroll
            for (int i = 0; i < 8; ++i) { const int idx = tid + (hb2 * 8 + i) * NT; yv[i] = WSP(float, WS_YT)[((size_t)(idx >> 6) * 4 + b) * SEQ + t0 + (idx & 63)]; }
#pragma unroll
            for (int i = 0; i < 8; ++i) { const int idx = tid + (hb2 * 8 + i) * NT; yt[(idx >> 6) * 65 + (idx & 63)] = yv[i]; }
            asm volatile("" ::: "memory");
        }
        __syncthreads();
        {
            const int c = tid & 255, th = tid >> 8;
#pragma unroll 1
            for (int hb2 = 0; hb2 < 4; ++hb2) {
                float x0v[8];
#pragma unroll
                for (int i = 0; i < 8; ++i) x0v[i] = bf2f(WSP(bf16_t, WS_X0B)[((size_t)u * 64 + 2 * (hb2 * 8 + i) + th) * 256 + c]);
#pragma unroll
                for (int i = 0; i < 8; ++i) { const int tl = 2 * (hb2 * 8 + i) + th; WSP(bf16_t, WS_CONCAT)[((size_t)u * 64 + tl) * D + 256 + c] = f2bf(x0v[i] * yt[c * 65 + tl]); }
                asm volatile("" ::: "memory");
            }
        }
        __syncthreads();
    }
    if (l == 0) {
        const int wv = __builtin_amdgcn_readfirstlane(tid >> 6), lane = tid & 63;
        LAS float* G = (LAS float*)lds + wv * 1024; LAS float* Z = G + 768;
        for (int pair = bid * (NT / 64) + wv; pair < 4 * 256; pair += gridDim.x * (NT / 64)) {
            const int b = pair >> 8, c = pair & 255;
            const float* filt = WSP(float, WS_FILTC) + c; const float* zc = WSP(float, WS_ZC) + (size_t)(b * CTXL) * 256 + c;
            float f[8], z[4], x0[4], nrm = 0.f;
#pragma unroll
            for (int k = 0; k < 8; ++k) f[k] = filt[(size_t)(lane + 64 * k) * 256];
#pragma unroll
            for (int k = 0; k < 4; ++k) { z[k] = zc[(size_t)(lane + 64 * k) * 256]; x0[k] = WSP(float, WS_X0C)[(size_t)(b * CTXL + lane + 64 * k) * 256 + c]; }
#pragma unroll
            for (int q = 0; q < 16; ++q) nrm += WSP(float, WS_PS)[(size_t)(512 + q) * 256 + c];
            const float bias = p.hy_bias[c];
#pragma unroll
            for (int k = 0; k < 8; ++k) { G[256 + lane + 64 * k] = f[k]; if (k >= 4) G[lane + 64 * (k - 4)] = f[k]; }
#pragma unroll
            for (int k = 0; k < 4; ++k) Z[lane + 64 * k] = z[k];
            float acc[4] = {0.f, 0.f, 0.f, 0.f};
            const LAS float* gb = G + lane + 1;
#pragma unroll 4
            for (int s4 = 0; s4 < 64; ++s4) {
                const gv4f zs = *(const LAS gv4f*)(Z + 4 * s4);
#pragma unroll
                for (int j = 0; j < 4; ++j)
#pragma unroll
                    for (int k = 0; k < 4; ++k) acc[k] += gb[64 * k + 255 - (4 * s4 + j)] * zs[j];
            }
            const float inrm = 1.f / nrm;
#pragma unroll
            for (int k = 0; k < 4; ++k) { const float y = acc[k] * inrm + bias * z[k];
                WSP(bf16_t, WS_CONCAT)[(size_t)(NLAT + b * CTXL + lane + 64 * k) * D + 256 + c] = f2bf(x0[k] * y); }
        }
    }
}
constexpr int CW_BAR = 32768;
__global__ void __launch_bounds__(NT, 2) mk_fwd(P kargs) {
    const KP kp0 = (KP)((unsigned long long)__builtin_amdgcn_kernarg_segment_ptr() | (unsigned long long)(unsigned)__builtin_amdgcn_readfirstlane(threadIdx.x >> 6));
    KP kp = kp0;
#define LP ({ KP k_ = kp0; asm volatile("" : "+s"(k_)); k_; })
    unsigned char* const lds = g_lds;
    volatile LAS unsigned* misc = (volatile LAS unsigned*)((LAS unsigned char*)lds + LDS_MISC);
    if (threadIdx.x < 16) misc[threadIdx.x] = 0u;
    __syncthreads();
    (void)xcd_barrier_post(WSP(unsigned, WS_CTL) + CW_BAR, misc);
#define GRID_BAR() do { XcdBarrier b_; bool t0_; { KP kp = LP; b_.bar = WSP(unsigned, WS_CTL) + CW_BAR; t0_ = ltid_kp(kp) == 0; } b_.x = xb_xcc_id(); b_.st = (volatile LAS unsigned*)((LAS unsigned char*)lds + LDS_MISC); xcd_barrier(b_, t0_); } while (0)
    d_pro0(LP, (LAS float*)((LAS unsigned char*)lds + 98304)); d_filter(LP, (LAS float*)((LAS unsigned char*)lds + 73728)); d_convert_a(LP, (LAS float*)lds);
    GRID_BAR();
    d_pro1(LP); d_convert_b(LP, (LAS float*)lds);
    GRID_BAR();
    d_fspec(LP, (LAS unsigned char*)lds); d_norm1(LP, 0);
    GRID_BAR();
#pragma unroll 1
    for (int l = 0; l < DEPTH; ++l) {
        d_gemm_in(LP, l, (LAS unsigned char*)lds);
        GRID_BAR();
        d_prep_scan(LP); d_prep_attn(LP); d_hy_pre_fast(LP, l, (LAS unsigned char*)lds);
        GRID_BAR();
        d_scan_stage1(LP, l);
        d_hy_fft(LP, l, (LAS unsigned char*)lds);
        d_attn_fast(LP, l, (LAS unsigned char*)lds);
        GRID_BAR();
        d_scan_stage2(LP, l, (LAS unsigned char*)lds);
        d_hy_post(LP, l, (LAS unsigned char*)lds);
        GRID_BAR();
        d_gemm_out(LP, l, (LAS unsigned char*)lds);
        GRID_BAR();
        d_router(LP, l, (LAS float*)lds);
        GRID_BAR();
        d_moe_up(LP, l, (LAS unsigned char*)lds);
        GRID_BAR();
        d_moe_down(LP, l, (LAS unsigned char*)lds);
        GRID_BAR();
        d_combine(LP, l, (LAS int*)lds);
        GRID_BAR();
    }
}

#undef p
extern "C" void kernel_launch(void* const* d_in, const int* in_sizes, int n_in, void* d_out, int out_size, void* d_ws, size_t ws_size, hipStream_t stream) {
    if (n_in != 31 || ws_size < WS_END || out_size != NLAT * D) { fprintf(stderr, "kernel_launch: unexpected shapes (n_in %d ws %zu out %d)\n", n_in, ws_size, out_size); return; }
    static int grid = 0;
    if (grid == 0) {
        int dev = 0, cus = 0, per_cu = 0;
        if (hipGetDevice(&dev) != hipSuccess || hipDeviceGetAttribute(&cus, hipDeviceAttributeMultiprocessorCount, dev) != hipSuccess) { grid = -1; return; }
        if (hipFuncSetAttribute((const void*)mk_fwd, hipFuncAttributeMaxDynamicSharedMemorySize, LDS_BYTES) != hipSuccess) { fprintf(stderr, "hipFuncSetAttribute failed\n"); grid = -1; return; }
        if (hipOccupancyMaxActiveBlocksPerMultiprocessor(&per_cu, (const void*)mk_fwd, NT, LDS_BYTES) != hipSuccess || per_cu < 1) { fprintf(stderr, "occupancy query says %d\n", per_cu); }
        (void)hipGetLastError();
        grid = cus;
    }
    if (grid < 0) return;
    P hp{};
    const float** pp = (const float**)&hp;
    for (int i = 0; i < 31; ++i) pp[i] = (const float*)d_in[i];
    hp.out = (float*)d_out; hp.ws = (unsigned char*)d_ws;
    (void)hipMemsetAsync((char*)d_ws + WS_CTL, 0, 1 * MiB, stream);
    hipLaunchKernelGGL(mk_fwd, dim3(grid), dim3(NT), LDS_BYTES, stream, hp);
}
```

```cpp
#include <hip/hip_runtime.h>
#include <stdint.h>
#include <stdio.h>
#include <math.h>

constexpr int D = 1024, BATCH = 4, SEQ = 4096, CTXL = 256, DEPTH = 2;
constexpr int NLAT = BATCH * SEQ, NCTX = BATCH * CTXL, MALL = NLAT + NCTX;
constexpr int INW = 3360, PW = 3584;
constexpr int NEXP = 32, TOPK = 4;
constexpr float EPS = 1e-6f;
constexpr int PC_AQ = 0, PC_AK = 256, PC_AV = 512, PC_HY = 768, PC_RQ = 1536, PC_RK = 1792, PC_RV = 2048, PC_RG = 2304,
              PC_GQ = 2560, PC_GK = 2688, PC_GV = 2816, PC_GR = 3072, PC_GD = 3328;
constexpr int ACT_ROWS = MALL * TOPK + NEXP * 256;

typedef unsigned short bf16_t;
typedef float cvt_f32x2_t __attribute__((ext_vector_type(2))); typedef __bf16 cvt_bf16x2_t __attribute__((ext_vector_type(2)));
__device__ __forceinline__ unsigned cvtpk_rne(float lo, float hi) { cvt_f32x2_t v = {lo, hi}; cvt_bf16x2_t b = __builtin_convertvector(v, cvt_bf16x2_t); return __builtin_bit_cast(unsigned, b); }
__device__ __forceinline__ bf16_t f2bf(float f) { unsigned u = __float_as_uint(f); return (bf16_t)((u + 0x7fffu + ((u >> 16) & 1u)) >> 16); }
__device__ __forceinline__ float bf2f(bf16_t b) { return __uint_as_float(((unsigned)b) << 16); }

typedef unsigned gv4u __attribute__((ext_vector_type(4))); typedef float gv4f __attribute__((ext_vector_type(4))); typedef unsigned gv2u __attribute__((ext_vector_type(2)));
__device__ __forceinline__ float gblo(unsigned w) { return __uint_as_float(w << 16); }
__device__ __forceinline__ float gbhi(unsigned w) { return __uint_as_float(w & 0xffff0000u); }
__device__ __forceinline__ unsigned pk4_fp8(float a, float b, float c, float d) { int r = __builtin_amdgcn_cvt_pk_fp8_f32(a, b, 0, false); r = __builtin_amdgcn_cvt_pk_fp8_f32(c, d, r, true); return (unsigned)r; }
constexpr float W8_SCALE = 64.f;
constexpr size_t MiB = 1u << 20;
constexpr size_t WS_CTL = 0;
constexpr size_t WS_MOD = 1 * MiB;
constexpr size_t WS_WEFF = 3 * MiB;
constexpr size_t WS_FILT = 6 * MiB;
constexpr size_t WS_FILTC = WS_FILT + 16 * MiB;
constexpr size_t WS_XRES = 24 * MiB;
constexpr size_t WS_HB = WS_XRES + 68 * MiB;
constexpr size_t WS_PBUF = WS_HB + 34 * MiB;
constexpr size_t WS_CONCAT = WS_PBUF + 120 * MiB;
constexpr size_t WS_YBUF = WS_CONCAT + 34 * MiB;
constexpr size_t WS_QA = WS_YBUF + 68 * MiB;
constexpr size_t WS_KA = WS_QA + 17 * MiB;
constexpr size_t WS_QR = WS_KA + 17 * MiB;
constexpr size_t WS_KR = WS_QR + 17 * MiB;
constexpr size_t WS_OA = WS_KR + 17 * MiB;
constexpr size_t WS_Z = WS_OA + 34 * MiB;
constexpr size_t WS_X0 = WS_Z + 17 * MiB;
constexpr size_t WS_LA = WS_X0 + 17 * MiB;
constexpr size_t WS_OD = WS_LA + 17 * MiB;
constexpr size_t WS_TOPI = WS_OD + 68 * MiB;
constexpr size_t WS_TOPW = WS_TOPI + 1 * MiB;
constexpr size_t WS_LIST = WS_TOPW + 1 * MiB;
constexpr size_t WS_ACT = WS_LIST + 3 * MiB;
constexpr size_t WS_YSLOT = WS_ACT + 160 * MiB;
constexpr size_t WS_WIN_T = WS_YSLOT + 160 * MiB;
constexpr size_t WS_WOUT_T = WS_WIN_T + 14 * MiB;
constexpr size_t WS_W1_T = WS_WOUT_T + 4 * MiB;
constexpr size_t WS_W2_T = WS_W1_T + 256 * MiB;
constexpr size_t WS_BIAS_IN = WS_W2_T + 128 * MiB;
constexpr size_t WS_QRP = WS_BIAS_IN + 1 * MiB;
constexpr size_t WS_KIMG = WS_QRP + 9 * MiB;
constexpr size_t WS_VIMG = WS_KIMG + 9 * MiB;
constexpr size_t WS_QF_R = WS_VIMG + 9 * MiB;
constexpr size_t WS_KF_R = WS_QF_R + 9 * MiB;
constexpr size_t WS_KT_R = WS_KF_R + 9 * MiB;
constexpr size_t WS_KT_G = WS_KT_R + 9 * MiB;
constexpr size_t WS_VT_R = WS_KT_G + 5 * MiB;
constexpr size_t WS_VT_G = WS_VT_R + 9 * MiB;
constexpr size_t WS_CUM_G = WS_VT_G + 9 * MiB;
constexpr size_t WS_CUMT_G = WS_CUM_G + 17 * MiB;
constexpr size_t WS_US_R = WS_CUMT_G + 17 * MiB;
constexpr size_t WS_US_G = WS_US_R + 34 * MiB;
constexpr size_t WS_UG_R = WS_US_G + 17 * MiB;
constexpr size_t WS_UG_G = WS_UG_R + 5 * MiB;
constexpr size_t WS_AG = WS_UG_G + 3 * MiB;
constexpr size_t WS_ROPE = WS_AG + 1 * MiB;
constexpr size_t WS_FSPEC = WS_ROPE + 1 * MiB;
constexpr size_t WS_ZT = WS_FSPEC + 32 * MiB;
constexpr size_t WS_YT = WS_ZT + 16 * MiB;
constexpr size_t WS_X0B = WS_YT + 16 * MiB;
constexpr size_t WS_MODP = WS_X0B + 8 * MiB;
constexpr size_t WS_PS = WS_MODP + 4 * MiB;
constexpr size_t WS_ZC = WS_PS + 1 * MiB;
constexpr size_t WS_X0C = WS_ZC + 1 * MiB;
constexpr size_t WS_HB8 = WS_X0C + 1 * MiB;
constexpr size_t WS_WLIST = WS_HB8 + 17 * MiB;
constexpr size_t WS_END = WS_WLIST + 3 * MiB;
constexpr int CW_CNT = 1024;
constexpr int CW_NORM = 2048;

struct P {
    const float *x, *c, *ctx, *c_ctx, *w_mod, *b_mod, *norm_g, *w_in, *w_out, *diff_lambda, *diff_subln_g, *hy_short_w, *hy_short_b,
        *hy_w1, *hy_b1, *hy_w2, *hy_b2, *hy_w3, *hy_freq, *hy_bias, *ret_decay, *ret_norm_g, *gla_gate_w, *gla_gate_b, *gla_norm_g,
        *router_w, *router_b, *exp_w1, *exp_b1, *exp_w2, *exp_b2;
    float* out; unsigned char* ws;
};
typedef const __attribute__((address_space(4))) P* KP;
#define KP_PTR(kp_) ((KP)((unsigned long long)(kp_) & ~7ull))
#define p (*KP_PTR(kp))
#define WSP(T, off) ((T*)(p.ws + (off)))

__device__ __forceinline__ float wave_sum(float v) {
#pragma unroll
    for (int o = 1; o < 64; o <<= 1) v += __shfl_xor(v, o);
    return v;
}
__device__ __forceinline__ float silu_f(float x) { return x / (1.f + expf(-x)); }
__host__ __device__ __forceinline__ int nrows_l(int l) { return l == 0 ? MALL : NLAT; }
__device__ __forceinline__ int mod_r(int row) { return row < NLAT ? row / SEQ : 4; }
__device__ __forceinline__ void seq_info(int row, int& base, int& n, int& t) {
    if (row < NLAT) { base = row & ~(SEQ - 1); n = SEQ; t = row - base; }
    else { int r = row - NLAT; base = NLAT + (r & ~(CTXL - 1)); n = CTXL; t = row - base; }
}

#define XB_TMO      128
#define XB_XCNT(j)  (256  + 64 * (j))
#define XB_XSUB(j)  (1280 + 64 * (j))
#define XB_XGEN(j)  (2304 + 64 * (j))
#define XB_TOP      3328
#define XB_TOPGEN   3392
#define XCD_BAR_WORDS 3456
#define XB_SPIN_CAP (1u << 22)
#define LAS __attribute__((address_space(3)))
__device__ __forceinline__ unsigned xb_ld(unsigned* ptr)            { return __hip_atomic_load(ptr, __ATOMIC_RELAXED, __HIP_MEMORY_SCOPE_AGENT); }
__device__ __forceinline__ unsigned xb_add(unsigned* ptr, unsigned v) { return __hip_atomic_fetch_add(ptr, v, __ATOMIC_RELAXED, __HIP_MEMORY_SCOPE_AGENT); }
__device__ __forceinline__ unsigned xb_xcc_id() { return (unsigned)__builtin_amdgcn_s_getreg((3 << 11) | 20) & 0xFu; }
#define XB_SPIN(cond, bar) do { unsigned _sp = 0; while (cond) { __builtin_amdgcn_s_sleep(1); \
    if ((++_sp & 255u) == 0u) { if (xb_ld(&(bar)[XB_TMO])) break; if (_sp > XB_SPIN_CAP) { atomicAdd(&(bar)[XB_TMO], 1u); break; } } } } while (0)
struct XcdBarrier { unsigned* bar; unsigned x; volatile LAS unsigned* st; };
__device__ __forceinline__ XcdBarrier xcd_barrier_post(unsigned* bar, volatile LAS unsigned* st) {
    XcdBarrier b; b.bar = bar; b.x = xb_xcc_id(); b.st = st;
    if (threadIdx.x == 0) (void)xb_add(&bar[XB_XCNT(b.x)], 1u);
    return b;
}
__device__ __forceinline__ void xcd_barrier_complete(unsigned* bar, unsigned x, unsigned& nloc, unsigned& nx) {
    const unsigned G = gridDim.x * gridDim.y * gridDim.z;
    unsigned sum, cnt, mine, sp = 0u;
    for (;;) {
        sum = 0u; cnt = 0u; mine = 0u;
#pragma unroll
        for (unsigned j = 0; j < 16; ++j) { const unsigned c = xb_ld(&bar[XB_XCNT(j)]); sum += c; cnt += (c > 0u) ? 1u : 0u; mine = (j == x) ? c : mine; }
        if (sum == G) break;
        __builtin_amdgcn_s_sleep(1);
        if ((++sp & 255u) == 0u) { if (xb_ld(&bar[XB_TMO])) break; if (sp > XB_SPIN_CAP) { atomicAdd(&bar[XB_TMO], 1u); break; } }
    }
    nloc = mine > 0u ? mine : 1u; nx = cnt > 0u ? cnt : 1u;
}
__device__ __forceinline__ void xcd_barrier(const XcdBarrier& b, bool thread0) {
    asm volatile("s_waitcnt vmcnt(0)" ::: "memory");
    __syncthreads();
    if (thread0) {
        unsigned* bar = b.bar;
        __builtin_amdgcn_s_waitcnt(0);
        unsigned nloc = b.st[0], nx = b.st[1];
        if (nloc == 0u) { xcd_barrier_complete(bar, b.x, nloc, nx); b.st[0] = nloc; b.st[1] = nx; }
        const unsigned old = xb_add(&bar[XB_XSUB(b.x)], 1u);
        const unsigned gen = old / nloc;
        if (old + 1u == (gen + 1u) * nloc) {
            __builtin_amdgcn_fence(__ATOMIC_RELEASE, "agent");
            asm volatile("s_waitcnt vmcnt(0)" ::: "memory");
            const unsigned og = xb_add(&bar[XB_TOP], 1u);
            const unsigned tg = og / nx;
            if (og + 1u == (tg + 1u) * nx) xb_add(&bar[XB_TOPGEN], 1u);
            else XB_SPIN(xb_ld(&bar[XB_TOPGEN]) == tg, bar);
            __builtin_amdgcn_fence(__ATOMIC_ACQUIRE, "agent");
            xb_add(&bar[XB_XGEN(b.x)], 1u);
            asm volatile("s_waitcnt vmcnt(0)" ::: "memory");
        } else {
            XB_SPIN(xb_ld(&bar[XB_XGEN(b.x)]) == gen, bar);
            __builtin_amdgcn_fence(__ATOMIC_ACQUIRE, "agent");
            asm volatile("s_waitcnt vmcnt(0)" ::: "memory");
        }
    }
    __syncthreads();
}

constexpr int NT = 512;
extern __shared__ __attribute__((aligned(16))) unsigned char g_lds[];
constexpr int LDS_BYTES = 147456;
constexpr int LDS_MISC = LDS_BYTES - 64;
__device__ __forceinline__ int ltid_kp(KP kp) {
    const int w = (int)((unsigned long long)kp & 7ull);
    unsigned ones = ~0u; asm volatile("" : "+s"(ones));
    int t = (w << 6) | (int)__builtin_amdgcn_mbcnt_hi(ones, __builtin_amdgcn_mbcnt_lo(ones, 0u));
    asm volatile("" : "+v"(t)); return t;
}
__device__ __forceinline__ int lbid() { int b = blockIdx.x; asm volatile("" : "+s"(b)); return b; }
#define PH_IDS const int tid = ltid_kp(kp), bid = lbid(); (void)tid; (void)bid
#define GT_LOOP(idx, total) for (int idx = bid * NT + tid; idx < (total); idx += gridDim.x * NT)
#define GW_LOOP(w, total) for (int w = bid * (NT / 64) + (tid >> 6); w < (total); w += gridDim.x * (NT / 64))

__device__ __forceinline__ const float* xin_row(KP kp, int l, int row) {
    (void)l; return row < NLAT ? p.x + (size_t)row * D : p.ctx + (size_t)(row - NLAT) * D;
}
__device__ __forceinline__ void d_pro0(KP kp, LAS float* sc) {
    PH_IDS;
    GT_LOOP(idx, 64 * 24) {
        const int pos = idx / 24, j = idx % 24; float ang; float* dst;
        if (j < 8) { ang = (float)pos * powf(10000.f, -(float)j / 8.f); dst = WSP(float, WS_ROPE) + (pos * 8 + j) * 2; }
        else { ang = (float)pos * powf(10000.f, -(float)(j - 8) / 16.f); dst = WSP(float, WS_ROPE) + 1024 + (pos * 16 + (j - 8)) * 2; }
        dst[0] = cosf(ang); dst[1] = sinf(ang);
    }
    GT_LOOP(idx, 2 * 1024 * 256) {
        int n = idx & 255, i = (idx >> 8) & 1023, l = idx >> 18, d = n >> 7, j = n & 127;
        float a = 0.f;
        for (int r = 0; r < 16; ++r) a += p.w_in[((size_t)l * D + i) * INW + 3328 + d * 16 + r] * p.gla_gate_w[((l * 2 + d) * 16 + r) * 128 + j];
        WSP(float, WS_WEFF)[idx] = a;
    }
    const int lane = tid & 63;
    for (int i = tid; i < 5 * D; i += NT) { const int r = i >> 10, ii = i & 1023; sc[i] = silu_f(r < 4 ? p.c[r * D + ii] : p.c_ctx[ii]); }
    __syncthreads();
    GW_LOOP(task, 2 * 96 * 16) {
        const int chunk = task & 15, jb = (task >> 4) % 96, l = task / (16 * 96), j = jb * 64 + lane;
        const float* w = p.w_mod + ((size_t)l * D + chunk * 64) * 6144 + j;
        float acc[5] = {0.f, 0.f, 0.f, 0.f, 0.f};
#pragma unroll 8
        for (int i = 0; i < 64; ++i) { const float wv = w[(size_t)i * 6144];
#pragma unroll
            for (int r = 0; r < 5; ++r) acc[r] += sc[r * D + chunk * 64 + i] * wv; }
#pragma unroll
        for (int r = 0; r < 5; ++r) WSP(float, WS_MODP)[((size_t)(chunk * 2 + l) * 5 + r) * 6144 + j] = acc[r];
    }
}
__device__ __forceinline__ void d_filter(KP kp, LAS float* sm) {
    PH_IDS;
    const int lane = tid & 63; LAS float* zf = sm + (tid >> 6) * 192; LAS float* h1 = zf + 64; LAS float* h2 = zf + 128;
    GW_LOOP(task, 2 * SEQ + CTXL) {
        const int which = task < SEQ ? 0 : task < 2 * SEQ ? 1 : 2, pos = task - (which == 2 ? 2 * SEQ : which * SEQ), l = which == 1 ? 1 : 0, n = which == 2 ? CTXL : SEQ;
        float* filt = which == 2 ? WSP(float, WS_FILTC) : WSP(float, WS_FILT) + (size_t)l * 8192 * 256;
        const float t = (float)pos / (float)(n - 1), w = (6.2831855f * (float)pos) / (float)n;
        if (lane < 33) { float v = t; if (lane >= 1) { const int q = (lane - 1) & 15; const float f = 1e-4f + (15.f - 1e-4f) * ((float)q / 15.f), a = w * f; v = lane < 17 ? cosf(a) : -sinf(a); } zf[lane] = v; }
        asm volatile("s_waitcnt lgkmcnt(0)" ::: "memory");
        float a = p.hy_b1[l * 64 + lane];
        for (int i = 0; i < 33; ++i) a += zf[i] * p.hy_w1[(l * 33 + i) * 64 + lane];
        h1[lane] = sinf(p.hy_freq[(l * 2 + 0) * 64 + lane] * a);
        asm volatile("s_waitcnt lgkmcnt(0)" ::: "memory");
        a = p.hy_b2[l * 64 + lane];
        for (int i = 0; i < 64; ++i) a += h1[i] * p.hy_w2[(l * 64 + i) * 64 + lane];
        h2[lane] = sinf(p.hy_freq[(l * 2 + 1) * 64 + lane] * a);
        asm volatile("s_waitcnt lgkmcnt(0)" ::: "memory");
        float raw[8];
#pragma unroll
        for (int q = 0; q < 8; ++q) raw[q] = 0.f;
        for (int j = 0; j < 64; ++j) { const float hj = h2[j]; const float* w3 = p.hy_w3 + (size_t)(l * 64 + j) * 512 + lane;
#pragma unroll
            for (int q = 0; q < 8; ++q) raw[q] += hj * w3[q * 64]; }
        const float mind = logf(1e-2f) / 1.5f, maxd = logf(1e-2f) / 0.3f;
#pragma unroll
        for (int q = 0; q < 8; ++q) {
            const int c = (q & 3) * 64 + lane;
            const float v = raw[q] * expf(-t * fabsf(mind + (maxd - mind) * ((float)c / 255.f)));
            if (q < 4) { filt[(size_t)pos * 256 + c] = v; if (pos == 0) filt[(size_t)n * 256 + c] = 0.f; }
            else if (pos >= 1) filt[(size_t)(2 * n - pos) * 256 + c] = v;
        }
        asm volatile("s_waitcnt lgkmcnt(0)" ::: "memory");
    }
}
__device__ __forceinline__ void d_pro1(KP kp) {
    PH_IDS;
    GT_LOOP(idx, 2 * 5 * 6144) {
        const int j = idx % 6144, r = (idx / 6144) % 5, l = idx / (6144 * 5);
        float a = p.b_mod[l * 6144 + j];
        for (int ch = 0; ch < 16; ++ch) a += WSP(float, WS_MODP)[((size_t)(ch * 2 + l) * 5 + r) * 6144 + j];
        WSP(float, WS_MOD)[idx] = a;
    }
    GT_LOOP(idx, 528 * 256) {
        const int vb = idx >> 8, c = idx & 255, which = vb < 256 ? 0 : vb < 512 ? 1 : 2, slab = vb - (which == 2 ? 512 : which * 256);
        const float* filt = which == 2 ? WSP(float, WS_FILTC) : WSP(float, WS_FILT) + (size_t)which * 8192 * 256;
        float a = 0.f;
#pragma unroll 8
        for (int i = 0; i < 32; ++i) a += fabsf(filt[(size_t)(slab * 32 + i) * 256 + c]);
        WSP(float, WS_PS)[(which * 256 + slab) * 256 + c] = a;
    }
}
__device__ __forceinline__ void d_norm1(KP kp, int l) {
    PH_IDS;
    const int lane = tid & 63;
    GW_LOOP(row, MALL) {
        const float* xr = xin_row(kp, l, row);
        const float* mod = WSP(float, WS_MOD) + (size_t)(l * 5 + mod_r(row)) * 6144;
        const float* g = p.norm_g + (l * 4 + 0) * D;
        gv4f v[4], gg[4], gs[4], gh[4]; float ss = 0.f;
#pragma unroll
        for (int j = 0; j < 4; ++j) { const int ci = j * 256 + lane * 4; v[j] = *(const gv4f*)(xr + ci); gg[j] = *(const gv4f*)(g + ci); gs[j] = *(const gv4f*)(mod + 1024 + ci); gh[j] = *(const gv4f*)(mod + ci); }
#pragma unroll
        for (int j = 0; j < 4; ++j)
#pragma unroll
            for (int q = 0; q < 4; ++q) ss += v[j][q] * v[j][q];
        const float rstd = rsqrtf(wave_sum(ss) * (1.f / D) + EPS);
        bf16_t* hb = WSP(bf16_t, WS_HB) + (size_t)row * D + lane * 4;
#pragma unroll
        for (int j = 0; j < 4; ++j) { float o[4];
#pragma unroll
            for (int q = 0; q < 4; ++q) o[q] = v[j][q] * rstd * gg[j][q] * (1.f + gs[j][q]) + gh[j][q];
            *(gv2u*)(hb + j * 256) = (gv2u){cvtpk_rne(o[0], o[1]), cvtpk_rne(o[2], o[3])}; }
    }
}
__device__ __forceinline__ void d_router(KP kp, int l, LAS float* sm) {
    PH_IDS;
    const int lane = tid & 63;
    for (int i = tid; i < D * 8; i += NT) { const int k = i >> 3, c = i & 7, r = (k >> 8) * 256 + (k & 3) * 64 + ((k >> 2) & 63);
        *(LAS gv4f*)((LAS unsigned char*)sm + r * 128 + 16 * (c ^ ((r >> 1) & 7))) = *(const gv4f*)(p.router_w + (size_t)l * D * NEXP + (size_t)k * 32 + c * 4); }
    LAS int* lcnt = (LAS int*)(sm + 32768); LAS int* lbase = lcnt + 32; LAS int* rec = lcnt + 64;
    LAS float* ws = (LAS float*)(rec + 512) + (tid >> 6) * 64;
    if (tid < 32) lcnt[tid] = 0;
    __syncthreads();
    int it = 0;
    GW_LOOP(row, nrows_l(l)) {
        const float* mod = WSP(float, WS_MOD) + (size_t)(l * 5 + mod_r(row)) * 6144 + lane * 4;
        const float* g1 = p.norm_g + (l * 4 + 1) * D + lane * 4; const float* g2 = p.norm_g + (l * 4 + 2) * D + lane * 4;
        float yv[16], xv[16], ss = 0.f;
        { const bf16_t* y = WSP(bf16_t, WS_YBUF) + (size_t)row * D + lane * 4;
#pragma unroll
          for (int j = 0; j < 4; ++j) { const gv2u w = *(const gv2u*)(y + j * 256); yv[4 * j] = gblo(w.x); yv[4 * j + 1] = gbhi(w.x); yv[4 * j + 2] = gblo(w.y); yv[4 * j + 3] = gbhi(w.y); } }
        if (l == 0) { const float* xs = (row < NLAT ? p.x + (size_t)row * D : p.ctx + (size_t)(row - NLAT) * D) + lane * 4;
#pragma unroll
            for (int j = 0; j < 4; ++j) { const gv4f t = *(const gv4f*)(xs + j * 256); xv[4 * j] = t[0]; xv[4 * j + 1] = t[1]; xv[4 * j + 2] = t[2]; xv[4 * j + 3] = t[3]; } }
        else { const bf16_t* xs = WSP(bf16_t, WS_XRES) + (size_t)row * D + lane * 4;
#pragma unroll
            for (int j = 0; j < 4; ++j) { const gv2u w = *(const gv2u*)(xs + j * 256); xv[4 * j] = gblo(w.x); xv[4 * j + 1] = gbhi(w.x); xv[4 * j + 2] = gblo(w.y); xv[4 * j + 3] = gbhi(w.y); } }
        gv4f ga[4], gn[4];
#pragma unroll
        for (int j = 0; j < 4; ++j) { ga[j] = *(const gv4f*)(mod + 2048 + j * 256); gn[j] = *(const gv4f*)(g1 + j * 256); }
#pragma unroll
        for (int j = 0; j < 16; ++j) ss += yv[j] * yv[j];
        float rstd = rsqrtf(wave_sum(ss) * (1.f / D) + EPS);
        ss = 0.f;
#pragma unroll
        for (int j = 0; j < 16; ++j) { xv[j] = xv[j] + ga[j >> 2][j & 3] * (yv[j] * rstd * gn[j >> 2][j & 3]); ss += xv[j] * xv[j]; }
        gv4f gsc[4], gsh[4];
#pragma unroll
        for (int j = 0; j < 4; ++j) { const gv4f a = *(const gv4f*)(g2 + j * 256), b = *(const gv4f*)(mod + 4096 + j * 256); gsh[j] = *(const gv4f*)(mod + 3072 + j * 256);
#pragma unroll
            for (int q = 0; q < 4; ++q) gsc[j][q] = a[q] * (1.f + b[q]); }
        { bf16_t* xr = WSP(bf16_t, WS_XRES) + (size_t)row * D + lane * 4;
#pragma unroll
          for (int j = 0; j < 4; ++j) *(gv2u*)(xr + j * 256) = (gv2u){cvtpk_rne(xv[4 * j], xv[4 * j + 1]), cvtpk_rne(xv[4 * j + 2], xv[4 * j + 3])}; }
        rstd = rsqrtf(wave_sum(ss) * (1.f / D) + EPS);
        unsigned char* hb = WSP(unsigned char, WS_HB8) + (size_t)row * D + lane * 4;
        float v[32];
#pragma unroll
        for (int e = 0; e < 32; ++e) v[e] = 0.f;
#pragma unroll
        for (int j = 0; j < 4; ++j) {
#pragma unroll
            for (int q = 0; q < 4; ++q) xv[4 * j + q] = xv[4 * j + q] * rstd * gsc[j][q] + gsh[j][q];
            *(unsigned*)(hb + j * 256) = pk4_fp8(xv[4 * j], xv[4 * j + 1], xv[4 * j + 2], xv[4 * j + 3]); }
        { const LAS unsigned char* wb = (const LAS unsigned char*)sm + lane * 128; const int sw = (lane >> 1) & 7;
#pragma unroll
          for (int jq = 0; jq < 16; ++jq) { const float hv = xv[jq];
#pragma unroll
            for (int c = 0; c < 8; ++c) { const gv4f w = *(const LAS gv4f*)(wb + ((jq >> 2) * 256 + (jq & 3) * 64) * 128 + 16 * (c ^ sw));
                v[4 * c] += hv * w[0]; v[4 * c + 1] += hv * w[1]; v[4 * c + 2] += hv * w[2]; v[4 * c + 3] += hv * w[3]; }
            asm volatile("" : "+v"(v[0]), "+v"(v[8]), "+v"(v[16]), "+v"(v[24])); } }
#pragma unroll
        for (int k = 0; k < 16; ++k) { const auto r_ = __builtin_amdgcn_permlane32_swap(__float_as_uint(v[k]), __float_as_uint(v[k + 16]), false, false); v[k] = __uint_as_float(r_[0]) + __uint_as_float(r_[1]); }
#pragma unroll
        for (int k = 0; k < 8; ++k) { const auto r_ = __builtin_amdgcn_permlane16_swap(__float_as_uint(v[k]), __float_as_uint(v[k + 8]), false, false); v[k] = __uint_as_float(r_[0]) + __uint_as_float(r_[1]); }
#pragma unroll
        for (int k = 0; k < 4; ++k) { const bool up = lane & 8; const float send = up ? v[k] : v[k + 4], keep = up ? v[k + 4] : v[k]; v[k] = keep + __shfl_xor(send, 8); }
#pragma unroll
        for (int k = 0; k < 2; ++k) { const bool up = lane & 4; const float send = up ? v[k] : v[k + 2], keep = up ? v[k + 2] : v[k]; v[k] = keep + __shfl_xor(send, 4); }
        { const bool up = lane & 2; const float send = up ? v[0] : v[1], keep = up ? v[1] : v[0]; v[0] = keep + __shfl_xor(send, 2); }
        const int myexp = lane >> 1;
        float mylogit = v[0] + __shfl_xor(v[0], 1) + p.router_b[l * NEXP + myexp];
        float tv[4]; int ti[4];
        { if (!(lane & 1)) ws[myexp] = mylogit;
          int rank = 0;
#pragma unroll
          for (int c = 0; c < 8; ++c) { const gv4f o = *(const LAS gv4f*)(ws + 4 * c);
#pragma unroll
              for (int q = 0; q < 4; ++q) rank += (o[q] > mylogit || (o[q] == mylogit && 4 * c + q < myexp)) ? 1 : 0; }
          if (!(lane & 1) && rank < 4) { ws[32 + rank] = mylogit; ((LAS int*)ws)[36 + rank] = myexp; }
          const gv4f wv = *(const LAS gv4f*)(ws + 32); const gv4u wi = *(const LAS gv4u*)(ws + 36);
#pragma unroll
          for (int k = 0; k < 4; ++k) { tv[k] = wv[k]; ti[k] = (int)wi[k]; } }
        float den = 0.f, w[4];
#pragma unroll
        for (int k = 0; k < 4; ++k) { w[k] = expf(tv[k] - tv[0]); den += w[k]; }
        if (lane < 4) {
            const int e = lane == 0 ? ti[0] : lane == 1 ? ti[1] : lane == 2 ? ti[2] : ti[3];
            const float ww = lane == 0 ? w[0] : lane == 1 ? w[1] : lane == 2 ? w[2] : w[3];
            const int lr = __hip_atomic_fetch_add(&lcnt[e], 1, __ATOMIC_RELAXED, __HIP_MEMORY_SCOPE_WORKGROUP);
            rec[(it * 8 + (tid >> 6)) * 4 + lane] = (e << 16) | lr;
            WSP(float, WS_TOPW)[row * 4 + lane] = ww / den;
            WSP(int, WS_TOPI)[row * 4 + lane] = e;
        }
        ++it;
    }
    asm volatile("s_waitcnt lgkmcnt(0)" ::: "memory");
    __syncthreads();
    if (tid < 32) lbase[tid] = (int)atomicAdd(WSP(unsigned, WS_CTL) + CW_CNT + (l * 32 + tid) * 64, (unsigned)lcnt[tid]);
    asm volatile("s_waitcnt vmcnt(0) lgkmcnt(0)" ::: "memory");
    __syncthreads();
    it = 0;
    GW_LOOP(row, nrows_l(l)) {
        if (lane < 4) { const int rc = rec[(it * 8 + (tid >> 6)) * 4 + lane], e = rc >> 16, pos = lbase[e] + (rc & 0xffff);
            WSP(int, WS_LIST)[(size_t)e * MALL + pos] = row * 4 + lane; WSP(int, WS_TOPI)[MALL * 4 + row * 4 + lane] = pos;
            WSP(float, WS_WLIST)[(size_t)e * MALL + pos] = WSP(float, WS_TOPW)[row * 4 + lane]; }
        ++it;
    }
    __syncthreads();
}
__device__ __forceinline__ void d_combine(KP kp, int l, LAS int* aoffs) {
    PH_IDS;
    const int lane = tid & 63;
    const unsigned* cnt = WSP(unsigned, WS_CTL) + CW_CNT + l * 32 * 64;
    if (tid == 0) { int a = 0; for (int e = 0; e < 32; ++e) { aoffs[e] = a; a += ((int)cnt[e * 64] + 255) & ~255; } }
    __syncthreads();
    GW_LOOP(row, nrows_l(l)) {
        int ee[4], pp[4];
#pragma unroll
        for (int k = 0; k < 4; ++k) { ee[k] = WSP(int, WS_TOPI)[row * 4 + k]; pp[k] = WSP(int, WS_TOPI)[MALL * 4 + row * 4 + k]; }
        gv4u yv[4][2];
#pragma unroll
        for (int k = 0; k < 4; ++k) { const gv4u* ys = (const gv4u*)(WSP(bf16_t, WS_YSLOT) + (size_t)(aoffs[ee[k]] + pp[k]) * D) + lane; yv[k][0] = ys[0]; yv[k][1] = ys[64]; }
        float acc[16];
#pragma unroll
        for (int j = 0; j < 16; ++j) acc[j] = 0.f;
#pragma unroll
        for (int k = 0; k < 4; ++k)
#pragma unroll
            for (int hf = 0; hf < 2; ++hf)
#pragma unroll
                for (int q = 0; q < 4; ++q) { acc[hf * 8 + 2 * q] += gblo(yv[k][hf][q]); acc[hf * 8 + 2 * q + 1] += gbhi(yv[k][hf][q]); }
        float ss = 0.f;
#pragma unroll
        for (int j = 0; j < 16; ++j) ss += acc[j] * acc[j];
        float rstd = rsqrtf(wave_sum(ss) * (1.f / D) + EPS);
        bf16_t* xr = WSP(bf16_t, WS_XRES) + (size_t)row * D;
        const float* mod = WSP(float, WS_MOD) + (size_t)(l * 5 + mod_r(row)) * 6144;
        const float* g3 = p.norm_g + (l * 4 + 3) * D;
        ss = 0.f;
        gv4f xo[4], gm[4], gg[4];
        { const gv4u x0 = *(const gv4u*)(xr + lane * 8), x1 = *(const gv4u*)(xr + 512 + lane * 8);
          xo[0] = (gv4f){gblo(x0[0]), gbhi(x0[0]), gblo(x0[1]), gbhi(x0[1])}; xo[1] = (gv4f){gblo(x0[2]), gbhi(x0[2]), gblo(x0[3]), gbhi(x0[3])};
          xo[2] = (gv4f){gblo(x1[0]), gbhi(x1[0]), gblo(x1[1]), gbhi(x1[1])}; xo[3] = (gv4f){gblo(x1[2]), gbhi(x1[2]), gblo(x1[3]), gbhi(x1[3])}; }
#pragma unroll
        for (int q8 = 0; q8 < 4; ++q8) { const int ci = (q8 >> 1) * 512 + lane * 8 + (q8 & 1) * 4; gm[q8] = *(const gv4f*)(mod + 5120 + ci); gg[q8] = *(const gv4f*)(g3 + ci); }
        float n0[16], n1[16], n2[16];
        if (l < DEPTH - 1) {
            const float* mod2 = WSP(float, WS_MOD) + (size_t)((l + 1) * 5 + mod_r(row)) * 6144; const float* g0 = p.norm_g + ((l + 1) * 4 + 0) * D;
#pragma unroll
            for (int q8 = 0; q8 < 4; ++q8) { const int ci = (q8 >> 1) * 512 + lane * 8 + (q8 & 1) * 4; const gv4f a = *(const gv4f*)(g0 + ci), b2 = *(const gv4f*)(mod2 + 1024 + ci), c2 = *(const gv4f*)(mod2 + ci);
#pragma unroll
                for (int q = 0; q < 4; ++q) { n0[q8 * 4 + q] = a[q]; n1[q8 * 4 + q] = b2[q]; n2[q8 * 4 + q] = c2[q]; } }
        }
#pragma unroll
        for (int q8 = 0; q8 < 4; ++q8) {
            const int ci = (q8 >> 1) * 512 + lane * 8 + (q8 & 1) * 4;
            gv4f vv;
#pragma unroll
            for (int q = 0; q < 4; ++q) { const float v = xo[q8][q] + gm[q8][q] * (acc[q8 * 4 + q] * rstd * gg[q8][q]); vv[q] = v; acc[q8 * 4 + q] = v; ss += v * v; }
            if (l == DEPTH - 1) *(gv4f*)(p.out + (size_t)row * D + ci) = vv;
        }
        if (l < DEPTH - 1) {
#pragma unroll
            for (int hf = 0; hf < 2; ++hf) { gv4u o;
#pragma unroll
                for (int q = 0; q < 4; ++q) o[q] = cvtpk_rne(acc[hf * 8 + 2 * q], acc[hf * 8 + 2 * q + 1]);
                *(gv4u*)(xr + hf * 512 + lane * 8) = o; }
        }
        if (l < DEPTH - 1) {
            rstd = rsqrtf(wave_sum(ss) * (1.f / D) + EPS);
            bf16_t* hb = WSP(bf16_t, WS_HB) + (size_t)row * D;
#pragma unroll
            for (int hf = 0; hf < 2; ++hf) {
                gv4u o;
#pragma unroll
                for (int q = 0; q < 4; ++q) { const int i0 = hf * 8 + 2 * q; o[q] = cvtpk_rne(acc[i0] * rstd * n0[i0] * (1.f + n1[i0]) + n2[i0], acc[i0 + 1] * rstd * n0[i0 + 1] * (1.f + n1[i0 + 1]) + n2[i0 + 1]); }
                *(gv4u*)(hb + hf * 512 + lane * 8) = o;
            }
        }
    }
    __syncthreads();
}

namespace pg8 {
typedef short bf16x8 __attribute__((ext_vector_type(8)));
typedef float f32x4 __attribute__((ext_vector_type(4)));
typedef unsigned u32x4 __attribute__((ext_vector_type(4)));
typedef unsigned u32x2 __attribute__((ext_vector_type(2)));
constexpr int BM = 256, BK = 64, HALF = 128, HTB = HALF * BK * 2, STAGE_BYTES = 8 * HTB, NXCD = 8, WGM = 8, K = 1024;
__host__ __device__ __forceinline__ int lds_byte(int r, int c) { const int st = (r >> 4) * 2 + (c >> 5), rr = r & 15, cc = c & 31, ob = rr * 64 + cc * 2; return st * 1024 + (ob ^ (((ob >> 9) & 1) << 5)); }
__host__ __device__ __forceinline__ void stage_rc(int b, int& R, int& C) { const int st = b / 1024, sb = b % 1024, swz = sb ^ (((sb >> 9) & 1) << 5); R = (st >> 1) * 16 + swz / 64; C = (st & 1) * 32 + (swz % 64) / 2; }
__host__ __device__ __forceinline__ int perm32(int rho) { const int n = rho >> 4, i = rho & 15; return 8 * (i >> 2) + 4 * n + (i & 3); }
__device__ __forceinline__ unsigned cvt_pk_bf16(float lo, float hi) { return cvtpk_rne(lo, hi); }

struct Unit { int pm, pn; const char* A; const char* B; const int* gl; int gcnt; int e; int row0; };

struct DenseOrder {
    int nM, nN, nwg, G, c; const char* A; const char* Bt;
    __device__ __forceinline__ void init(int M, int N, int G_, int c_, const void* A_, const void* Bt_) { nM = M / BM; nN = N / BM; nwg = nM * nN; G = G_; c = c_; A = (const char*)A_; Bt = (const char*)Bt_; }
    __device__ __forceinline__ bool next(int i, Unit& u) const {
        const long L = (long)i * G + c; if (L >= nwg) return false;
        int wgid = (int)L; { const int q = nwg / NXCD, r = nwg % NXCD, xcd = wgid % NXCD, off = wgid / NXCD; wgid = (xcd < r ? xcd * (q + 1) : r * (q + 1) + (xcd - r) * q) + off; }
        const int nig = WGM * nN, gid = wgid / nig, fm = gid * WGM, gsz = (nM - fm) < WGM ? (nM - fm) : WGM;
        u.pm = fm + ((wgid % nig) % gsz); u.pn = (wgid % nig) / gsz;
        u.A = A + (size_t)u.pm * (BM * K * 2); u.B = Bt + (size_t)u.pn * (BM * K * 2); u.gl = nullptr; u.gcnt = BM; u.e = 0; u.row0 = u.pm * BM; return true;
    }
};
struct MoeOrder {
    const LAS int* tab; int G, c, NCT; const char* A; const char* W; size_t wstride; const int* list; const unsigned* cnt; bool gather; int rowb;
    __device__ __forceinline__ bool next(int i, Unit& u) const {
        const LAS int* U = tab + 160;
        const int xg = c & 7, T = U[32], lo = (xg * T) >> 3, hi = ((xg + 1) * T) >> 3;
        const int L = __builtin_amdgcn_readfirstlane(lo + (c >> 3) + (G >> 3) * i);
        if (L >= hi) return false;
        int eb = 0;
#pragma unroll
        for (int st = 16; st >= 1; st >>= 1) if (L >= U[eb + st]) eb += st;
        const int e = __builtin_amdgcn_readfirstlane(eb);
        const int r = __builtin_amdgcn_readfirstlane(L - U[e]), ce = __builtin_amdgcn_readfirstlane(tab[120 + e]), rte = (ce + 255) >> 8, ro = __builtin_amdgcn_readfirstlane(tab[33 + e]);
        const int ct = r / rte, rt = r - ct * rte;
        u.pm = rt; u.pn = ct; u.e = e; u.row0 = ro + rt * 256; u.gl = list + (size_t)e * MALL + rt * 256; u.gcnt = min(256, ce - rt * 256);
        u.A = gather ? A : A + (size_t)u.row0 * rowb; u.B = W + (size_t)e * wstride + (size_t)ct * BM * rowb; return true;
    }
};
__device__ __forceinline__ void moe_tab_build(LAS int* tab, const unsigned* cnt, int NCT, int tid) {
    if (tid < 32) tab[120 + tid] = (int)cnt[tid * 64];
    asm volatile("s_waitcnt vmcnt(0) lgkmcnt(0)" ::: "memory");
    __syncthreads();
    if (tid == 0) {
        int rs = 0; for (int e = 0; e < 32; ++e) { tab[33 + e] = rs; rs += ((tab[120 + e] + 255) >> 8) * 256; } tab[65] = rs;
        int us = 0; for (int e = 0; e < 32; ++e) { tab[160 + e] = us; us += ((tab[120 + e] + 255) >> 8) * NCT; } tab[192] = us;
    }
    __syncthreads();
}

#define PG8_EPI_DMA(gp, lp) __builtin_amdgcn_global_load_lds((const unsigned*)(gp), (LAS unsigned*)(lp), 16, 0, 0)
struct EpiBf16 {
    static constexpr bool PERM = true; bf16_t* O; int ldc; const float* bias;
    __device__ __forceinline__ void stage(const Unit& u, LAS unsigned char* eb, int wid, int lane) const { if (bias && wid == 0) PG8_EPI_DMA(bias + u.pn * BM + lane * 4, eb); }
    __device__ __forceinline__ void operator()(const f32x4 (&acc)[2][2][4][2], const Unit& u, int wr, int wc, int fr, int fq, const LAS unsigned char* eb) const {
        const int row0 = u.row0 + wr * 64 + fr, col0 = u.pn * BM + wc * 32 + 8 * fq;
        f32x4 bv[2][2];
#pragma unroll
        for (int bj = 0; bj < 2; ++bj)
#pragma unroll
            for (int n = 0; n < 2; ++n) bv[bj][n] = bias ? *(const LAS f32x4*)(eb + (wc * 32 + 8 * fq + bj * HALF + 4 * n) * 4) : (f32x4){0.f, 0.f, 0.f, 0.f};
#pragma unroll
        for (int ai = 0; ai < 2; ++ai)
#pragma unroll
            for (int m = 0; m < 4; ++m) { bf16_t* rowp = O + (size_t)(row0 + ai * HALF + m * 16) * ldc + col0;
#pragma unroll
                for (int bj = 0; bj < 2; ++bj) { const f32x4 v0 = acc[ai][bj][m][0] + bv[bj][0], v1 = acc[ai][bj][m][1] + bv[bj][1];
                    u32x4 w; w.x = cvt_pk_bf16(v0[0], v0[1]); w.y = cvt_pk_bf16(v0[2], v0[3]); w.z = cvt_pk_bf16(v1[0], v1[1]); w.w = cvt_pk_bf16(v1[2], v1[3]);
                    *(u32x4*)(rowp + bj * HALF) = w; } }
    }
};
struct EpiF32 {
    static constexpr bool PERM = false; float* O; int ldc;
    __device__ __forceinline__ void stage(const Unit&, LAS unsigned char*, int, int) const { }
    __device__ __forceinline__ void operator()(const f32x4 (&acc)[2][2][4][2], const Unit& u, int wr, int wc, int fr, int fq, const LAS unsigned char*) const {
        const int row0 = u.row0 + wr * 64 + fr, col0 = u.pn * BM + wc * 32 + 4 * fq;
#pragma unroll
        for (int ai = 0; ai < 2; ++ai)
#pragma unroll
            for (int m = 0; m < 4; ++m) { float* rowp = O + (size_t)(row0 + ai * HALF + m * 16) * ldc + col0;
#pragma unroll
                for (int bj = 0; bj < 2; ++bj)
#pragma unroll
                    for (int n = 0; n < 2; ++n) *(f32x4*)(rowp + bj * HALF + n * 16) = acc[ai][bj][m][n]; }
    }
};
struct EpiMoeUp {
    static constexpr bool PERM = true; unsigned char* ACT; const float* b1all;
    __device__ __forceinline__ void stage(const Unit& u, LAS unsigned char* eb, int wid, int lane) const { if (wid == 0) PG8_EPI_DMA(b1all + (size_t)u.e * 2048 + u.pn * BM + lane * 4, eb); }
    __device__ __forceinline__ void operator()(const f32x4 (&acc)[2][2][4][2], const Unit& u, int wr, int wc, int fr, int fq, const LAS unsigned char* eb) const {
        const int col0 = u.pn * BM + wc * 32 + 8 * fq;
        f32x4 bv[2][2];
#pragma unroll
        for (int bj = 0; bj < 2; ++bj)
#pragma unroll
            for (int n = 0; n < 2; ++n) bv[bj][n] = *(const LAS f32x4*)(eb + (wc * 32 + 8 * fq + bj * HALF + 4 * n) * 4);
#pragma unroll
        for (int ai = 0; ai < 2; ++ai)
#pragma unroll
            for (int m = 0; m < 4; ++m) { unsigned char* rowp = ACT + (size_t)(u.row0 + wr * 64 + fr + ai * HALF + m * 16) * 1024 + (col0 >> 1);
#pragma unroll
                for (int bj = 0; bj < 2; ++bj) { const f32x4 v0 = acc[ai][bj][m][0] * (1.f / W8_SCALE) + bv[bj][0], v1 = acc[ai][bj][m][1] * (1.f / W8_SCALE) + bv[bj][1];
                    float a[4];
#pragma unroll
                    for (int j = 0; j < 4; ++j) { const float gl = fminf(j < 2 ? v0[2 * j] : v1[2 * j - 4], 7.f), ln = fminf(fmaxf(j < 2 ? v0[2 * j + 1] : v1[2 * j - 3], -7.f), 7.f);
                        a[j] = gl * __builtin_amdgcn_rcpf(1.f + __builtin_amdgcn_exp2f(-1.702f * 1.4426950408889634f * gl)) * (ln + 1.f); }
                    *(unsigned*)(rowp + bj * 64) = pk4_fp8(a[0], a[1], a[2], a[3]); } }
    }
};
struct EpiMoeDown {
    static constexpr bool PERM = true; bf16_t* Y; const float* b2all; const float* wlist; const int* list0;
    __device__ __forceinline__ void stage(const Unit& u, LAS unsigned char* eb, int wid, int lane) const {
        if (wid == 0) PG8_EPI_DMA(b2all + (size_t)u.e * 1024 + u.pn * BM + lane * 4, eb);
        if (wid == 1) PG8_EPI_DMA(wlist + (u.gl - list0) + lane * 4, eb + 1024); }
    __device__ __forceinline__ void operator()(const f32x4 (&acc)[2][2][4][2], const Unit& u, int wr, int wc, int fr, int fq, const LAS unsigned char* eb) const {
        const int col0 = u.pn * BM + wc * 32 + 8 * fq;
        f32x4 bv[2][2];
#pragma unroll
        for (int bj = 0; bj < 2; ++bj)
#pragma unroll
            for (int n = 0; n < 2; ++n) bv[bj][n] = *(const LAS f32x4*)(eb + (wc * 32 + 8 * fq + bj * HALF + 4 * n) * 4);
#pragma unroll
        for (int ai = 0; ai < 2; ++ai)
#pragma unroll
            for (int m = 0; m < 4; ++m) { const int r = wr * 64 + fr + ai * HALF + m * 16; const float twl = *(const LAS float*)(eb + 1024 + r * 4); const float tw = r < u.gcnt ? twl : 0.f;
                bf16_t* rowp = Y + (size_t)(u.row0 + r) * 1024 + col0;
#pragma unroll
                for (int bj = 0; bj < 2; ++bj) { const f32x4 v0 = (acc[ai][bj][m][0] * (1.f / W8_SCALE) + bv[bj][0]) * tw, v1 = (acc[ai][bj][m][1] * (1.f / W8_SCALE) + bv[bj][1]) * tw;
                    u32x4 w; w.x = cvt_pk_bf16(v0[0], v0[1]); w.y = cvt_pk_bf16(v0[2], v0[3]); w.z = cvt_pk_bf16(v1[0], v1[1]); w.w = cvt_pk_bf16(v1[2], v1[3]);
                    *(u32x4*)(rowp + bj * HALF) = w; } }
    }
};

typedef int v8i __attribute__((ext_vector_type(8)));
typedef int v4i __attribute__((ext_vector_type(4)));
template <class Epi, class Sched, bool GATHER, bool ALIGN_EPI, bool F8 = false>
__device__ __forceinline__ void gphase(LAS unsigned char* lds, const Sched& S, const Epi& E, const int tid) {
    const int wid = __builtin_amdgcn_readfirstlane(tid >> 6), lane = tid & 63, wr = wid >> 2, wc = wid & 3, fr = lane & 15, fq = lane >> 4;
    constexpr int ROWB = F8 ? K : K * 2, nt = ROWB / 128, KSTR = F8 ? 16 : 1024;
    unsigned voffB[2], CA2[2]; int RA[2];
#pragma unroll
    for (int i = 0; i < 2; ++i) { int R, C; stage_rc(tid * 16 + i * 8192, R, C); const int Rb = Epi::PERM ? ((R & ~31) + perm32(R & 31)) : R;
        RA[i] = R; CA2[i] = (unsigned)C * 2u; voffB[i] = (unsigned)(Rb * ROWB + C * 2); }
    constexpr size_t kstep = (size_t)(BK * 2), hstep = (size_t)HALF * ROWB;
    const unsigned ldsw = (unsigned)wid * 1024u;
    const int aoff = lds_byte(wr * 64 + fr, fq * 8), boff = lds_byte(wc * 32 + fr, fq * 8);
#define PG8_SA(b, h) (((b) * 2 + (h)) * HTB)
#define PG8_SB(b, h) ((4 + (b) * 2 + (h)) * HTB)
#define PG8_GL(gp, ldsoff) __builtin_amdgcn_global_load_lds((const unsigned*)(gp), (LAS unsigned*)(lds + (ldsoff)), 16, 0, 0)
#define PG8_STB(bufoff, gbase) do { PG8_GL((const char*)(gbase) + voffB[0], (bufoff) + ldsw); PG8_GL((const char*)(gbase) + voffB[1], (bufoff) + ldsw + 8192); } while (0)
#define PG8_STA(bufoff, gbase, o) do { PG8_GL((const char*)(gbase) + (o)[0], (bufoff) + ldsw); PG8_GL((const char*)(gbase) + (o)[1], (bufoff) + ldsw + 8192); } while (0)
#define PG8_LDA(dst, b, h) do { _Pragma("unroll") for (int m = 0; m < 4; ++m) { if constexpr (F8) { const v4i lo_ = *(const LAS v4i*)(lds + PG8_SA(b, h) + aoff + m * 2048), hi_ = *(const LAS v4i*)(lds + PG8_SA(b, h) + aoff + m * 2048 + 1024); dst##8[m] = __builtin_shufflevector(lo_, hi_, 0, 1, 2, 3, 4, 5, 6, 7); } else { _Pragma("unroll") for (int k = 0; k < 2; ++k) dst[m][k] = *(const LAS bf16x8*)(lds + PG8_SA(b, h) + aoff + m * 2048 + k * KSTR); } } } while (0)
#define PG8_LDB(dst, b, h) do { _Pragma("unroll") for (int n = 0; n < 2; ++n) { if constexpr (F8) { const v4i lo_ = *(const LAS v4i*)(lds + PG8_SB(b, h) + boff + n * 2048), hi_ = *(const LAS v4i*)(lds + PG8_SB(b, h) + boff + n * 2048 + 1024); dst##8[n] = __builtin_shufflevector(lo_, hi_, 0, 1, 2, 3, 4, 5, 6, 7); } else { _Pragma("unroll") for (int k = 0; k < 2; ++k) dst[n][k] = *(const LAS bf16x8*)(lds + PG8_SB(b, h) + boff + n * 2048 + k * KSTR); } } } while (0)
#define PG8_MMA(ai, bj, At, Bt) do { __builtin_amdgcn_s_setprio(1); _Pragma("unroll") for (int m = 0; m < 4; ++m) _Pragma("unroll") for (int n = 0; n < 2; ++n) { \
        if constexpr (F8) asm volatile("v_mfma_scale_f32_16x16x128_f8f6f4 %0, %1, %2, %0, %3, %3 op_sel_hi:[0,0,0]" : "+v"(acc[ai][bj][m][n]) : "v"(Bt##8[n]), "v"(At##8[m]), "v"(f8scale) : "memory"); \
        else { _Pragma("unroll") for (int k = 0; k < 2; ++k) acc[ai][bj][m][n] = __builtin_amdgcn_mfma_f32_16x16x32_bf16(Bt[n][k], At[m][k], acc[ai][bj][m][n], 0, 0, 0); } } \
        __builtin_amdgcn_s_setprio(0); } while (0)
#define PG8_WAIT_V(n) asm volatile("s_waitcnt vmcnt(" #n ")" ::: "memory")
#define PG8_WAIT_L(n) asm volatile("s_waitcnt lgkmcnt(" #n ")" ::: "memory")
#define PG8_BAR __builtin_amdgcn_s_barrier()
#define PG8_SCHED __builtin_amdgcn_sched_barrier(0)
#define PG8_AOFFS(u, o) do { _Pragma("unroll") for (int h_ = 0; h_ < 2; ++h_) _Pragma("unroll") for (int i_ = 0; i_ < 2; ++i_) { \
        if (GATHER) { const int r_ = h_ * 128 + RA[i_]; const int rc_ = r_ < (u).gcnt ? r_ : (u).gcnt - 1; const int tok_ = (u).gl[rc_] >> 2; o[h_][i_] = (unsigned)tok_ * (unsigned)ROWB + CA2[i_]; } \
        else o[h_][i_] = (unsigned)((h_ * 128 + RA[i_]) * ROWB) + CA2[i_]; } } while (0)
    Unit cur, nxt; int ui = 0;
    if (!S.next(0, cur)) return;
    f32x4 acc[2][2][4][2];
#pragma unroll
    for (int a = 0; a < 2; ++a)
#pragma unroll
        for (int b = 0; b < 2; ++b)
#pragma unroll
            for (int m = 0; m < 4; ++m)
#pragma unroll
                for (int n = 0; n < 2; ++n) acc[a][b][m][n] = (f32x4){0.f, 0.f, 0.f, 0.f};
    int f8scale = 0x7f7f7f7f; asm volatile("" : "+v"(f8scale));
    bf16x8 At[F8 ? 1 : 4][2], B0[F8 ? 1 : 2][2], B1[F8 ? 1 : 2][2]; v8i At8[F8 ? 4 : 1], B08[F8 ? 2 : 1], B18[F8 ? 2 : 1];
    (void)At; (void)B0; (void)B1; (void)At8; (void)B08; (void)B18;
    unsigned oAc[2][2], oAn[2][2];
    PG8_AOFFS(cur, oAc);
    const char* cA = cur.A; const char* cB = cur.B;
    PG8_STB(PG8_SB(0, 0), cB); PG8_STB(PG8_SB(0, 1), cB + hstep); PG8_STA(PG8_SA(0, 0), cA, oAc[0]); PG8_STA(PG8_SA(0, 1), cA, oAc[1]);
    if (wr == 1) PG8_BAR;
    PG8_WAIT_V(2); PG8_BAR;
    PG8_STB(PG8_SB(1, 0), cB + kstep); PG8_STA(PG8_SA(1, 0), cA + kstep, oAc[0]); PG8_STB(PG8_SB(1, 1), cB + hstep + kstep);
    PG8_WAIT_V(6); PG8_BAR;
    for (;;) {
        const bool has_next = S.next(ui + 1, nxt);
        LAS unsigned char* const ebuf = lds + STAGE_BYTES + 1024 + (ui & 1) * 2048;
        E.stage(cur, ebuf, wid, lane);
        const char* nA = has_next ? nxt.A : cA; const char* nB = has_next ? nxt.B : cB;
        if (has_next) { PG8_AOFFS(nxt, oAn); } else {
#pragma unroll
            for (int h = 0; h < 2; ++h) { oAn[h][0] = oAc[h][0]; oAn[h][1] = oAc[h][1]; } }
#pragma unroll 1
        for (int t = 0; t < nt; t += 2) {
            const bool last = (t == nt - 2);
            const char* a1 = cA + (size_t)(t + 1) * kstep;
            const char* a2 = last ? nA : cA + (size_t)(t + 2) * kstep; const char* b2 = last ? nB : cB + (size_t)(t + 2) * kstep;
            const char* a3 = a2 + kstep; const char* b3 = b2 + kstep;
            unsigned o2[2][2];
#pragma unroll
            for (int h = 0; h < 2; ++h) { o2[h][0] = oAc[h][0]; o2[h][1] = oAc[h][1]; }
            if (last) {
                asm volatile("" ::: "memory");
#pragma unroll
                for (int h = 0; h < 2; ++h) { o2[h][0] = oAn[h][0]; o2[h][1] = oAn[h][1]; }
            }
            PG8_LDB(B0, 0, 0); PG8_LDB(B1, 0, 1); PG8_SCHED; PG8_LDA(At, 0, 0); PG8_STA(PG8_SA(1, 1), a1, oAc[1]);
            PG8_WAIT_V(8); PG8_WAIT_L(0); PG8_BAR; PG8_MMA(0, 0, At, B0); PG8_MMA(0, 1, At, B1); PG8_BAR; PG8_SCHED;
            PG8_LDA(At, 0, 1); PG8_STB(PG8_SB(0, 0), b2); PG8_STB(PG8_SB(0, 1), b2 + hstep); PG8_STA(PG8_SA(0, 0), a2, o2[0]);
            PG8_WAIT_V(8); PG8_WAIT_L(0); PG8_BAR; PG8_MMA(1, 0, At, B0); PG8_MMA(1, 1, At, B1); PG8_BAR; PG8_SCHED;
            PG8_LDB(B0, 1, 0); PG8_LDB(B1, 1, 1); PG8_SCHED; PG8_LDA(At, 1, 0); PG8_STA(PG8_SA(0, 1), a2, o2[1]);
            PG8_WAIT_V(8); PG8_WAIT_L(0); PG8_BAR; PG8_MMA(0, 0, At, B0); PG8_MMA(0, 1, At, B1); PG8_BAR; PG8_SCHED;
            PG8_LDA(At, 1, 1); PG8_STB(PG8_SB(1, 0), b3); PG8_STB(PG8_SB(1, 1), b3 + hstep); PG8_STA(PG8_SA(1, 0), a3, o2[0]);
            PG8_WAIT_V(8); PG8_WAIT_L(0); PG8_BAR; PG8_MMA(1, 0, At, B0); PG8_MMA(1, 1, At, B1); PG8_BAR; PG8_SCHED;
        }
        if constexpr (F8) asm volatile("s_nop 15\n\ts_nop 15" ::: "memory");
        if constexpr (ALIGN_EPI) { if (wr == 0) PG8_BAR; }
        E(acc, cur, wr, wc, fr, fq, ebuf);
        if (!has_next) break;
#pragma unroll
        for (int a = 0; a < 2; ++a)
#pragma unroll
            for (int b = 0; b < 2; ++b)
#pragma unroll
                for (int m = 0; m < 4; ++m)
#pragma unroll
                    for (int n = 0; n < 2; ++n) acc[a][b][m][n] = (f32x4){0.f, 0.f, 0.f, 0.f};
        cur = nxt; cA = nA; cB = nB; ++ui;
#pragma unroll
        for (int h = 0; h < 2; ++h) { oAc[h][0] = oAn[h][0]; oAc[h][1] = oAn[h][1]; }
        if constexpr (ALIGN_EPI) { if (wr == 1) PG8_BAR; }
    }
    PG8_WAIT_V(0);
    if constexpr (!ALIGN_EPI) { if (wr == 0) PG8_BAR; }
    PG8_BAR;
#undef PG8_SA
#undef PG8_SB
#undef PG8_GL
#undef PG8_STA
#undef PG8_STB
#undef PG8_LDA
#undef PG8_LDB
#undef PG8_MMA
#undef PG8_WAIT_V
#undef PG8_WAIT_L
#undef PG8_BAR
#undef PG8_SCHED
#undef PG8_AOFFS
}
}

__device__ __forceinline__ unsigned pk2(float lo, float hi) { return (unsigned)f2bf(lo) | ((unsigned)f2bf(hi) << 16); }
__device__ __forceinline__ void transpose_item(const float* W, int ld, int nblk, bf16_t* WT, LAS float* scr, int item, int lane) {
    const int kb = item / nblk, nb = item - kb * nblk, k0 = 64 * kb, n0 = 32 * nb;
#pragma unroll 8
    for (int i = 0; i < 32; ++i) { const int kk = 2 * i + (lane >> 5); scr[kk * 33 + (lane & 31)] = W[(size_t)(k0 + kk) * ld + n0 + (lane & 31)]; }
    asm volatile("s_waitcnt lgkmcnt(0)" ::: "memory");
    const int c = lane & 7;
#pragma unroll
    for (int j = 0; j < 4; ++j) { const int n = (lane >> 3) + 8 * j; const LAS float* s = scr + (8 * c) * 33 + n;
        pg8::u32x4 o; o.x = pk2(s[0 * 33], s[1 * 33]); o.y = pk2(s[2 * 33], s[3 * 33]); o.z = pk2(s[4 * 33], s[5 * 33]); o.w = pk2(s[6 * 33], s[7 * 33]);
        *(pg8::u32x4*)(WT + (size_t)(n0 + n) * 1024 + k0 + 8 * c) = o; }
    asm volatile("s_waitcnt lgkmcnt(0)" ::: "memory");
}
__device__ __forceinline__ void transpose_item8(const float* W, int ld, int nblk, unsigned char* WT, LAS float* scr, int item, int lane) {
    const int kb = item / nblk, nb = item - kb * nblk, k0 = 64 * kb, n0 = 32 * nb;
#pragma unroll 8
    for (int i = 0; i < 32; ++i) { const int kk = 2 * i + (lane >> 5); scr[kk * 33 + (lane & 31)] = W[(size_t)(k0 + kk) * ld + n0 + (lane & 31)]; }
    asm volatile("s_waitcnt lgkmcnt(0)" ::: "memory");
    const int c = lane & 3;
#pragma unroll
    for (int j = 0; j < 2; ++j) { const int n = (lane >> 2) + 16 * j; const LAS float* sp = scr + (16 * c) * 33 + n;
        pg8::u32x4 o;
#pragma unroll
        for (int q = 0; q < 4; ++q) o[q] = pk4_fp8(sp[(4 * q) * 33] * W8_SCALE, sp[(4 * q + 1) * 33] * W8_SCALE, sp[(4 * q + 2) * 33] * W8_SCALE, sp[(4 * q + 3) * 33] * W8_SCALE);
        *(pg8::u32x4*)(WT + (size_t)(n0 + n) * 1024 + k0 + 16 * c) = o; }
    asm volatile("s_waitcnt lgkmcnt(0)" ::: "memory");
}
__device__ __forceinline__ void d_convert_a(KP kp, LAS float* scr_all) {
    PH_IDS;
    const int lane = tid & 63; LAS float* scr = scr_all + (tid >> 6) * (64 * 33);
    constexpr int I_IN = 16 * 104, I_OUT = 16 * 32, I_W1 = 16 * 64, I_W2 = 16 * 32, I_L = I_IN + I_OUT + 32 * I_W1 + 32 * I_W2;
    GW_LOOP(it, 2 * I_L) {
        const int l = it / I_L; int r = it - l * I_L;
        if (r < I_IN) { transpose_item(p.w_in + (size_t)l * D * INW, INW, 104, WSP(bf16_t, WS_WIN_T) + (size_t)l * PW * 1024, scr, r, lane); continue; } r -= I_IN;
        if (r < I_OUT) { transpose_item(p.w_out + (size_t)l * D * D, 1024, 32, WSP(bf16_t, WS_WOUT_T) + (size_t)l * 1024 * 1024, scr, r, lane); continue; } r -= I_OUT;
        if (r < 32 * I_W1) { const int e = r / I_W1; transpose_item8(p.exp_w1 + ((size_t)l * NEXP + e) * D * 2048, 2048, 64, WSP(unsigned char, WS_W1_T) + ((size_t)l * NEXP + e) * 2048 * 1024, scr, r - e * I_W1, lane); continue; } r -= 32 * I_W1;
        { const int e = r / I_W2; transpose_item8(p.exp_w2 + ((size_t)l * NEXP + e) * D * D, 1024, 32, WSP(unsigned char, WS_W2_T) + ((size_t)l * NEXP + e) * 1024 * 1024, scr, r - e * I_W2, lane); }
    }
    GT_LOOP(idx, 2 * PW) { const int l = idx / PW, n = idx - l * PW; WSP(float, WS_BIAS_IN)[idx] = n < 3328 ? 0.f : p.gla_gate_b[l * 256 + n - 3328]; }
}
__device__ __forceinline__ void d_convert_b(KP kp, LAS float* scr_all) {
    PH_IDS;
    const int lane = tid & 63; LAS float* scr = scr_all + (tid >> 6) * (64 * 33);
    GW_LOOP(it, 2 * 128) { const int l = it >> 7; transpose_item(WSP(float, WS_WEFF) + (size_t)l * D * 256, 256, 8, WSP(bf16_t, WS_WIN_T) + ((size_t)l * PW + 3328) * 1024, scr, it & 127, lane); }
}

__device__ __forceinline__ void d_gemm_in(KP kp, int l, LAS unsigned char* lds) {
    PH_IDS;
    pg8::DenseOrder S; S.init(MALL, PW, gridDim.x, bid, WSP(bf16_t, WS_HB), WSP(bf16_t, WS_WIN_T) + (size_t)l * PW * 1024);
    pg8::EpiBf16 E{WSP(bf16_t, WS_PBUF), PW, WSP(float, WS_BIAS_IN) + l * PW};
    pg8::gphase<pg8::EpiBf16, pg8::DenseOrder, false, true>(lds, S, E, tid);
}
__device__ __forceinline__ void d_gemm_out(KP kp, int l, LAS unsigned char* lds) {
    PH_IDS;
    pg8::DenseOrder S; S.init(nrows_l(l), 1024, gridDim.x, bid, WSP(bf16_t, WS_CONCAT), WSP(bf16_t, WS_WOUT_T) + (size_t)l * 1024 * 1024);
    pg8::EpiBf16 E{WSP(bf16_t, WS_YBUF), 1024, nullptr};
    pg8::gphase<pg8::EpiBf16, pg8::DenseOrder, false, true>(lds, S, E, tid);
}
__device__ __forceinline__ void d_moe_up(KP kp, int l, LAS unsigned char* lds) {
    PH_IDS;
    LAS int* tab = (LAS int*)(lds + pg8::STAGE_BYTES);
    const unsigned* cnt = WSP(unsigned, WS_CTL) + CW_CNT + l * 32 * 64;
    pg8::moe_tab_build(tab, cnt, 8, tid);
    pg8::MoeOrder S{tab, (int)gridDim.x, bid, 8, (const char*)WSP(unsigned char, WS_HB8), (const char*)(WSP(unsigned char, WS_W1_T) + (size_t)l * NEXP * 2048 * 1024), (size_t)2048 * 1024, WSP(int, WS_LIST), cnt, true, 1024};
    pg8::EpiMoeUp E{WSP(unsigned char, WS_ACT), p.exp_b1 + (size_t)l * NEXP * 2048};
    pg8::gphase<pg8::EpiMoeUp, pg8::MoeOrder, true, true, true>(lds, S, E, tid);
}
__device__ __forceinline__ void d_moe_down(KP kp, int l, LAS unsigned char* lds) {
    PH_IDS;
    LAS int* tab = (LAS int*)(lds + pg8::STAGE_BYTES);
    const unsigned* cnt = WSP(unsigned, WS_CTL) + CW_CNT + l * 32 * 64;
    pg8::moe_tab_build(tab, cnt, 4, tid);
    pg8::MoeOrder S{tab, (int)gridDim.x, bid, 4, (const char*)WSP(unsigned char, WS_ACT), (const char*)(WSP(unsigned char, WS_W2_T) + (size_t)l * NEXP * 1024 * 1024), (size_t)1024 * 1024, WSP(int, WS_LIST), cnt, false, 1024};
    pg8::EpiMoeDown E{WSP(bf16_t, WS_YSLOT), p.exp_b2 + (size_t)l * NEXP * 1024, WSP(float, WS_WLIST), WSP(int, WS_LIST)};
    pg8::gphase<pg8::EpiMoeDown, pg8::MoeOrder, false, true, true>(lds, S, E, tid);
}

constexpr int ATT_NT = 68;
constexpr float ATT_QSCALE = 0.17677669529663687f * 1.4426950408889634f;
__device__ __forceinline__ void d_prep_attn(KP kp) {
    PH_IDS;
    const bf16_t* PB = WSP(bf16_t, WS_PBUF);
    GT_LOOP(idx, MALL * 16) {
        const int row = idx >> 4, hm = (idx >> 1) & 7, ks = idx & 1, h = hm >> 1, m = hm & 1;
        const bool lat = row < NLAT; const int t = row & (SEQ - 1);
        const int ipos = lat ? (ks == 0 ? (t >> 6) : (t & 63)) : 0;
        const int cb = h * 64 + m * 32 + ks * 16;
        const pg8::u32x4* qs = (const pg8::u32x4*)(PB + (size_t)row * PW + PC_AQ + cb);
        const pg8::u32x4* ksrc = (const pg8::u32x4*)(PB + (size_t)row * PW + PC_AK + cb);
        pg8::u32x4 qa = qs[0], qb = qs[1], ka = ksrc[0], kb = ksrc[1];
        float qv[16], kv[16];
#pragma unroll
        for (int j = 0; j < 4; ++j) { qv[2 * j] = bf2f((bf16_t)(qa[j] & 0xffff)); qv[2 * j + 1] = bf2f((bf16_t)(qa[j] >> 16)); qv[8 + 2 * j] = bf2f((bf16_t)(qb[j] & 0xffff)); qv[9 + 2 * j] = bf2f((bf16_t)(qb[j] >> 16));
                                      kv[2 * j] = bf2f((bf16_t)(ka[j] & 0xffff)); kv[2 * j + 1] = bf2f((bf16_t)(ka[j] >> 16)); kv[8 + 2 * j] = bf2f((bf16_t)(kb[j] & 0xffff)); kv[9 + 2 * j] = bf2f((bf16_t)(kb[j] >> 16)); }
        float qo[16], ko[16];
#pragma unroll
        for (int j = 0; j < 8; ++j) {
            const float* tb = WSP(float, WS_ROPE) + (ipos * 8 + j) * 2; const float cs = tb[0], sn = tb[1];
            qo[j] = qv[j] * cs - qv[j + 8] * sn; qo[j + 8] = qv[j + 8] * cs + qv[j] * sn;
            ko[j] = kv[j] * cs - kv[j + 8] * sn; ko[j + 8] = kv[j + 8] * cs + kv[j] * sn;
        }
        pg8::u32x4 o0, o1;
#pragma unroll
        for (int j = 0; j < 4; ++j) { o0[j] = pk2(qo[2 * j] * ATT_QSCALE, qo[2 * j + 1] * ATT_QSCALE); o1[j] = pk2(qo[8 + 2 * j] * ATT_QSCALE, qo[9 + 2 * j] * ATT_QSCALE); }
        pg8::u32x4* qd = (pg8::u32x4*)(WSP(bf16_t, WS_QRP) + (size_t)row * 256 + cb); qd[0] = o0; qd[1] = o1;
#pragma unroll
        for (int j = 0; j < 4; ++j) { o0[j] = pk2(ko[2 * j], ko[2 * j + 1]); o1[j] = pk2(ko[8 + 2 * j], ko[9 + 2 * j]); }
        int b, tile, key; if (lat) { b = row >> 12; tile = t >> 6; key = t & 63; } else { const int r = row - NLAT; b = r >> 8; tile = 64 + ((r & 255) >> 6); key = r & 63; }
        unsigned char* img = WSP(unsigned char, WS_KIMG) + ((size_t)(b * 4 + h) * ATT_NT + tile) * 8192 + key * 128;
        const int c0 = m * 4 + ks * 2, sw = (key >> 1) & 7;
        *(pg8::u32x4*)(img + 16 * (c0 ^ sw)) = o0; *(pg8::u32x4*)(img + 16 * ((c0 + 1) ^ sw)) = o1;
    }
    GT_LOOP(idx, 16 * ATT_NT * 2 * 64) {
        const int d = idx & 63, half = (idx >> 6) & 1, tile = (idx >> 7) % ATT_NT, bh = idx / (128 * ATT_NT), b = bh >> 2, h = bh & 3;
        const int row0 = (tile < 64 ? b * SEQ + tile * 64 : NLAT + b * CTXL + (tile - 64) * 64) + half * 32;
        const bf16_t* vp = PB + (size_t)row0 * PW + PC_AV + h * 64 + d;
        unsigned short vv[32];
#pragma unroll
        for (int j = 0; j < 32; ++j) vv[j] = vp[(size_t)j * PW];
        unsigned char* img = WSP(unsigned char, WS_VIMG) + ((size_t)bh * ATT_NT + tile) * 8192 + d * 128; const int x = (d >> 1) & 7;
#pragma unroll
        for (int s2 = 0; s2 < 2; ++s2)
#pragma unroll
            for (int hh = 0; hh < 2; ++hh) { const int j = 4 * s2 + hh, u = 4 * half + 2 * s2 + hh;
                *(pg8::u32x4*)(img + 16 * (u ^ x)) = (pg8::u32x4){(unsigned)vv[4 * j] | ((unsigned)vv[4 * j + 1] << 16), (unsigned)vv[4 * j + 2] | ((unsigned)vv[4 * j + 3] << 16),
                                                                   (unsigned)vv[4 * j + 8] | ((unsigned)vv[4 * j + 9] << 16), (unsigned)vv[4 * j + 10] | ((unsigned)vv[4 * j + 11] << 16)}; }
    }
}

namespace att {
typedef short bf16x8 __attribute__((ext_vector_type(8)));
typedef float f32x16 __attribute__((ext_vector_type(16)));
typedef unsigned u32x4 __attribute__((ext_vector_type(4)));
typedef unsigned u32x2 __attribute__((ext_vector_type(2)));
typedef float f32x2 __attribute__((ext_vector_type(2)));
constexpr int SLOT = 8192, NSLOT = 4, LDS_K = 0, LDS_V = NSLOT * SLOT, LDS_SCR = 2 * NSLOT * SLOT;
constexpr float THR = 8.f;
__device__ __forceinline__ int crow(int r, int hi) { return (r & 3) + 8 * (r >> 2) + 4 * hi; }
__device__ __forceinline__ unsigned cvtpk(float lo, float hi) { return cvtpk_rne(lo, hi); }
__device__ __forceinline__ float xhalf_max(float v) { return fmaxf(v, __shfl_xor(v, 32)); }
}
__device__ __forceinline__ void attn_unit(KP kp, int l, int b, int h, int qt, LAS unsigned char* lds, float lam, float lam_init, int tid) {
    using namespace att;
    const int lane = tid & 63, wid = __builtin_amdgcn_readfirstlane(tid >> 6), q32 = lane & 31, hi = lane >> 5;
    const int t0 = qt < 0 ? 64 : 0, t1 = ATT_NT;
    const int rowbase = (qt < 0 ? NLAT + b * CTXL : b * SEQ + qt * 256) + wid * 32;
    const unsigned char* kimg = WSP(unsigned char, WS_KIMG) + (size_t)(b * 4 + h) * ATT_NT * 8192 + wid * 1024 + lane * 16;
    const unsigned char* vimg = WSP(unsigned char, WS_VIMG) + (size_t)(b * 4 + h) * ATT_NT * 8192 + wid * 1024 + lane * 16;
    LAS float* scr = (LAS float*)(lds + LDS_SCR) + wid * 64;
#define ATT_DMA(t, slot) do { __builtin_amdgcn_global_load_lds((const unsigned*)(kimg + (size_t)(t) * 8192), (LAS unsigned*)(lds + LDS_K + (slot) * SLOT + wid * 1024), 16, 0, 0); \
                              __builtin_amdgcn_global_load_lds((const unsigned*)(vimg + (size_t)(t) * 8192), (LAS unsigned*)(lds + LDS_V + (slot) * SLOT + wid * 1024), 16, 0, 0); } while (0)
    bf16x8 qf[2][2];
    { const bf16_t* qp = WSP(bf16_t, WS_QRP) + (size_t)(rowbase + q32) * 256 + h * 64 + hi * 8;
#pragma unroll
      for (int m = 0; m < 2; ++m)
#pragma unroll
        for (int ks = 0; ks < 2; ++ks) qf[m][ks] = *(const bf16x8*)(qp + m * 32 + ks * 16); }
    asm volatile("s_waitcnt vmcnt(0)" ::: "memory");
    __builtin_amdgcn_s_barrier();
    ATT_DMA(t0, 0); ATT_DMA(t0 + 1, 1); ATT_DMA(t0 + 2, 2);
    asm volatile("s_waitcnt vmcnt(4)" ::: "memory");
    __builtin_amdgcn_s_barrier();
    f32x16 O[2][2];
#pragma unroll
    for (int m = 0; m < 2; ++m)
#pragma unroll
        for (int dh = 0; dh < 2; ++dh)
#pragma unroll
            for (int r = 0; r < 16; ++r) O[m][dh][r] = 0.f;
    float mref[2] = {0.f, 0.f}; f32x2 lsum[2] = {{0.f, 0.f}, {0.f, 0.f}};
    f32x16 negm[2];
#pragma unroll
    for (int m = 0; m < 2; ++m) {
#pragma unroll
        for (int r = 0; r < 16; ++r) negm[m][r] = 0.f;
        asm volatile("" : "+v"(negm[m])); }
    const int koff = q32 * 128, ksw = (q32 >> 1) & 7;
    int slot = 0;
    bf16x8 kf[2][2][2];
#define ATT_KLD(slot_) do { const LAS unsigned char* kb_ = lds + LDS_K + (slot_) * SLOT + koff; _Pragma("unroll") for (int m_ = 0; m_ < 2; ++m_) _Pragma("unroll") for (int kh_ = 0; kh_ < 2; ++kh_) \
        _Pragma("unroll") for (int ks_ = 0; ks_ < 2; ++ks_) kf[m_][kh_][ks_] = *(const LAS bf16x8*)(kb_ + kh_ * 4096 + 16 * ((m_ * 4 + ks_ * 2 + hi) ^ ksw)); } while (0)
    ATT_KLD(0);
#pragma unroll 1
    for (int t = t0; t < t1; ++t) {
        asm volatile("s_waitcnt vmcnt(2)" ::: "memory");
        __builtin_amdgcn_s_barrier();
        asm volatile("" ::: "memory");
        { const int s3 = (slot + 3) & 3; const int tn = t + 3 < t1 ? t + 3 : t1 - 1; ATT_DMA(tn, s3); }
        const LAS unsigned char* Vs = lds + LDS_V + slot * SLOT;
        u32x4 ppk[2][2][2];
        f32x16 S[2][2];
#pragma unroll
        for (int m = 0; m < 2; ++m)
#pragma unroll
            for (int kh = 0; kh < 2; ++kh)
#pragma unroll
                for (int ks = 0; ks < 2; ++ks) {
                    if (ks == 0) S[m][kh] = __builtin_amdgcn_mfma_f32_32x32x16_bf16(kf[m][kh][ks], qf[m][ks], negm[m], 0, 0, 0);
                    else S[m][kh] = __builtin_amdgcn_mfma_f32_32x32x16_bf16(kf[m][kh][ks], qf[m][ks], S[m][kh], 0, 0, 0);
                }
        float mx[2];
#pragma unroll
        for (int m = 0; m < 2; ++m) { mx[m] = __builtin_elementwise_maximum(S[m][0][0], S[m][1][0]);
#pragma unroll
            for (int r = 1; r < 16; ++r) mx[m] = __builtin_elementwise_maximum(__builtin_elementwise_maximum(mx[m], S[m][0][r]), S[m][1][r]); }
        mx[0] = xhalf_max(mx[0]); mx[1] = xhalf_max(mx[1]);
        const bool first = (t == t0);
        if (__any(first || mx[0] > THR || mx[1] > THR)) {
#pragma unroll
            for (int m = 0; m < 2; ++m) {
                const float dl = first ? mx[m] : fmaxf(mx[m], 0.f);
                mref[m] += dl;
                { const float nm = -mref[m];
#pragma unroll
                  for (int r = 0; r < 16; ++r) negm[m][r] = nm;
                  asm volatile("" : "+v"(negm[m])); }
#pragma unroll
                for (int r = 0; r < 16; ++r) { S[m][0][r] -= dl; S[m][1][r] -= dl; }
                const float f = __builtin_amdgcn_exp2f(-dl);
                lsum[m] *= f;
                if (!first) {
                    if (hi == 0) scr[q32] = f;
                    asm volatile("s_waitcnt lgkmcnt(0)" ::: "memory");
#pragma unroll
                    for (int r = 0; r < 16; ++r) { const float fr = scr[crow(r, hi)]; O[m][0][r] *= fr; O[m][1][r] *= fr; }
                    asm volatile("s_waitcnt lgkmcnt(0)" ::: "memory");
                }
            }
        }
        bf16x8 vf[2][2][2], vg[2][2];
#define ATT_VLD(dst, kh_) do { _Pragma("unroll") for (int sx_ = 0; sx_ < 2; ++sx_) _Pragma("unroll") for (int dh_ = 0; dh_ < 2; ++dh_) { const int d_ = dh_ * 32 + q32; \
            dst[sx_][dh_] = *(const LAS bf16x8*)(Vs + d_ * 128 + 16 * (((kh_) * 4 + sx_ * 2 + hi) ^ ((d_ >> 1) & 7))); } } while (0)
        ATT_VLD(vf[0], 0);
        __builtin_amdgcn_sched_barrier(0);
#pragma unroll
        for (int kh = 0; kh < 2; ++kh) {
#pragma unroll
            for (int r = 0; r < 16; r += 2) { S[0][kh][r] = __builtin_amdgcn_exp2f(S[0][kh][r]); S[0][kh][r + 1] = __builtin_amdgcn_exp2f(S[0][kh][r + 1]); lsum[0] += (f32x2){S[0][kh][r], S[0][kh][r + 1]}; }
#pragma unroll
            for (int sx = 0; sx < 2; ++sx)
#pragma unroll
                for (int j = 0; j < 4; ++j) ppk[0][kh][sx][j] = cvtpk(S[0][kh][8 * sx + 2 * j], S[0][kh][8 * sx + 2 * j + 1]);
        }
        __builtin_amdgcn_sched_barrier(0);
#pragma unroll
        for (int i = 0; i < 8; ++i) {
            { const int kh = i >> 2, sx = (i >> 1) & 1, dh = i & 1;
              O[0][dh] = __builtin_amdgcn_mfma_f32_32x32x16_bf16(__builtin_bit_cast(bf16x8, ppk[0][kh][sx]), vf[kh][sx][dh], O[0][dh], 0, 0, 0); }
            if (i == 1) ATT_VLD(vf[1], 1);
            if (i == 5) ATT_VLD(vg, 0);
            { const int kh = i >> 2, r0 = 4 * (i & 3), sx = r0 >> 3, j0 = (r0 & 7) >> 1;
#pragma unroll
              for (int r = r0; r < r0 + 4; r += 2) { S[1][kh][r] = __builtin_amdgcn_exp2f(S[1][kh][r]); S[1][kh][r + 1] = __builtin_amdgcn_exp2f(S[1][kh][r + 1]); lsum[1] += (f32x2){S[1][kh][r], S[1][kh][r + 1]}; }
              ppk[1][kh][sx][j0] = cvtpk(S[1][kh][r0], S[1][kh][r0 + 1]); ppk[1][kh][sx][j0 + 1] = cvtpk(S[1][kh][r0 + 2], S[1][kh][r0 + 3]); }
            __builtin_amdgcn_sched_barrier(0);
        }
        ATT_KLD((slot + 1) & 3);
#pragma unroll
        for (int i = 0; i < 8; ++i) { const int kh = i >> 2, sx = (i >> 1) & 1, dh = i & 1;
            O[1][dh] = __builtin_amdgcn_mfma_f32_32x32x16_bf16(__builtin_bit_cast(bf16x8, ppk[1][kh][sx]), kh == 0 ? vg[sx][dh] : vf[1][sx][dh], O[1][dh], 0, 0, 0); }
#undef ATT_VLD
        asm volatile("s_waitcnt lgkmcnt(0)" ::: "memory");
        slot = (slot + 1) & 3;
    }
    asm volatile("s_waitcnt vmcnt(0)" ::: "memory");
#undef ATT_DMA
#undef ATT_KLD
    float il[2][16];
#pragma unroll
    for (int m = 0; m < 2; ++m) { const float lh = lsum[m].x + lsum[m].y; const float lt = lh + __shfl_xor(lh, 32); if (hi == 0) scr[m * 32 + q32] = 1.f / lt; }
    asm volatile("s_waitcnt lgkmcnt(0)" ::: "memory");
#pragma unroll
    for (int m = 0; m < 2; ++m)
#pragma unroll
        for (int r = 0; r < 16; ++r) il[m][r] = scr[m * 32 + crow(r, hi)];
    asm volatile("s_waitcnt lgkmcnt(0)" ::: "memory");
    const float g0 = p.diff_subln_g[l * 64 + q32] * (1.f - lam_init), g1 = p.diff_subln_g[l * 64 + 32 + q32] * (1.f - lam_init);
    bf16_t* outp = WSP(bf16_t, WS_CONCAT) + (size_t)rowbase * D + h * 64 + q32;
#pragma unroll
    for (int r = 0; r < 16; ++r) {
        const float o0 = O[0][0][r] * il[0][r] - lam * O[1][0][r] * il[1][r], o1 = O[0][1][r] * il[0][r] - lam * O[1][1][r] * il[1][r];
        float ss = o0 * o0 + o1 * o1;
#pragma unroll
        for (int x = 1; x < 32; x <<= 1) ss += __shfl_xor(ss, x);
        const float rstd = rsqrtf(ss * (1.f / 64.f) + EPS);
        bf16_t* op = outp + (size_t)crow(r, hi) * D;
        op[0] = f2bf(o0 * rstd * g0); op[32] = f2bf(o1 * rstd * g1);
    }
}
__device__ __forceinline__ void d_attn_fast(KP kp, int l, LAS unsigned char* lds) {
    PH_IDS;
    const float* dl = p.diff_lambda + l * 4 * 32;
    float s1 = 0.f, s2 = 0.f;
    for (int i = 0; i < 32; ++i) { s1 += dl[i] * dl[32 + i]; s2 += dl[64 + i] * dl[96 + i]; }
    const float lam_init = 0.8f - 0.6f * expf(-0.3f * (float)l);
    const float lam = expf(s1) - expf(s2) + lam_init;
    const int G = gridDim.x, vb = (G % 8 == 0) ? (bid % 8) * (G / 8) + bid / 8 : bid;
    const int nunits = 256 + (l == 0 ? 16 : 0);
    for (int u = vb; u < nunits; u += G) {
        if (u < 256) attn_unit(kp, l, u >> 6, (u >> 4) & 3, u & 15, lds, lam, lam_init, tid);
        else attn_unit(kp, l, (u - 256) >> 2, (u - 256) & 3, -1, lds, lam, lam_init, tid);
    }
    __syncthreads();
}

constexpr int NCHUNK = MALL / 64;
__device__ __forceinline__ float logsig16(float x) { const float y = __builtin_amdgcn_exp2f(-fabsf(x) * 1.4426950408889634f); return (fminf(x, 0.f) - __builtin_amdgcn_logf(1.f + y) * 0.6931471805599453f) * (1.f / 16.f); }
__device__ __forceinline__ void d_prep_scan(KP kp) {
    PH_IDS;
    const bf16_t* PB = WSP(bf16_t, WS_PBUF);
    GT_LOOP(idx, 8 * MALL) {
        const int row = idx % MALL, hk = idx / MALL, h = hk >> 1, ks = hk & 1;
        const bool lat = row < NLAT; const int t = row & (SEQ - 1);
        const int ipos = lat ? (ks == 0 ? (t >> 6) : (t & 63)) : 0;
        const int cb = h * 64 + ks * 32;
        const pg8::u32x4* qs = (const pg8::u32x4*)(PB + (size_t)row * PW + PC_RQ + cb);
        const pg8::u32x4* ksrc = (const pg8::u32x4*)(PB + (size_t)row * PW + PC_RK + cb);
        float qv[32], kv[32];
#pragma unroll
        for (int c4 = 0; c4 < 4; ++c4) { const pg8::u32x4 a = qs[c4], b4 = ksrc[c4];
#pragma unroll
            for (int j = 0; j < 4; ++j) { qv[c4 * 8 + 2 * j] = bf2f((bf16_t)(a[j] & 0xffff)); qv[c4 * 8 + 2 * j + 1] = bf2f((bf16_t)(a[j] >> 16)); kv[c4 * 8 + 2 * j] = bf2f((bf16_t)(b4[j] & 0xffff)); kv[c4 * 8 + 2 * j + 1] = bf2f((bf16_t)(b4[j] >> 16)); } }
        float qo[32], ko[32];
#pragma unroll
        for (int j = 0; j < 16; ++j) {
            const float* tb = WSP(float, WS_ROPE) + 1024 + (ipos * 16 + j) * 2; const float cs = tb[0], sn = tb[1];
            qo[j] = qv[j] * cs - qv[j + 16] * sn; qo[j + 16] = qv[j + 16] * cs + qv[j] * sn;
            ko[j] = (kv[j] * cs - kv[j + 16] * sn) * 0.125f; ko[j + 16] = (kv[j + 16] * cs + kv[j] * sn) * 0.125f;
        }
        pg8::u32x4* qd = (pg8::u32x4*)(WSP(bf16_t, WS_QF_R) + (size_t)row * 256 + cb); pg8::u32x4* kd = (pg8::u32x4*)(WSP(bf16_t, WS_KF_R) + (size_t)row * 256 + cb);
#pragma unroll
        for (int c4 = 0; c4 < 4; ++c4) { pg8::u32x4 a, b4;
#pragma unroll
            for (int j = 0; j < 4; ++j) { a[j] = pk2(qo[c4 * 8 + 2 * j], qo[c4 * 8 + 2 * j + 1]); b4[j] = pk2(ko[c4 * 8 + 2 * j], ko[c4 * 8 + 2 * j + 1]); }
            qd[c4] = a; kd[c4] = b4; }
        bf16_t* kt = WSP(bf16_t, WS_KT_R) + ((size_t)((row >> 6) * 4 + h) * 64 + ks * 32) * 64 + (row & 63);
#pragma unroll
        for (int i = 0; i < 32; ++i) kt[(size_t)i * 64] = f2bf(ko[i]);
    }
    GT_LOOP(idx, 4 * MALL) {
        const int row = idx % MALL, h = idx / MALL;
        const pg8::u32x4* ksrc = (const pg8::u32x4*)(PB + (size_t)row * PW + PC_GK + h * 32);
        bf16_t* kt = WSP(bf16_t, WS_KT_G) + ((size_t)((row >> 6) * 4 + h) * 32) * 64 + (row & 63);
#pragma unroll
        for (int c4 = 0; c4 < 4; ++c4) { const pg8::u32x4 a = ksrc[c4];
#pragma unroll
            for (int j = 0; j < 4; ++j) { kt[(size_t)(c4 * 8 + 2 * j) * 64] = (bf16_t)(a[j] & 0xffff); kt[(size_t)(c4 * 8 + 2 * j + 1) * 64] = (bf16_t)(a[j] >> 16); } }
    }
    GT_LOOP(idx, NCHUNK * 2 * 128) {
        const int hk = idx & 127, dir = (idx >> 7) & 1, cid = idx >> 8;
        const bf16_t* src = PB + (size_t)(cid * 64) * PW + PC_GD + dir * 128 + hk;
        float* cum = WSP(float, WS_CUM_G) + ((size_t)dir * MALL + cid * 64) * 128 + hk;
        float* cumt = WSP(float, WS_CUMT_G) + (((size_t)dir * NCHUNK + cid) * 128 + hk) * 64;
        float v[64];
#pragma unroll
        for (int j = 0; j < 64; ++j) v[j] = bf2f(src[(size_t)j * PW]);
#pragma unroll
        for (int j = 0; j < 64; ++j) v[j] = logsig16(v[j]);
        if (dir == 0) {
#pragma unroll
            for (int j = 1; j < 64; ++j) v[j] += v[j - 1];
        } else {
#pragma unroll
            for (int j = 62; j >= 0; --j) v[j] += v[j + 1];
        }
#pragma unroll
        for (int j = 0; j < 64; ++j) cum[(size_t)j * 128] = v[j];
#pragma unroll
        for (int j = 0; j < 16; ++j) *(pg8::f32x4*)(cumt + 4 * j) = (pg8::f32x4){v[4 * j], v[4 * j + 1], v[4 * j + 2], v[4 * j + 3]};
    }
    GT_LOOP(idx, 2 * NCHUNK * 4 * 2 * 64) {
        const int d = idx & 63, half = (idx >> 6) & 1, ch = (idx >> 7) % (NCHUNK * 4), mx = idx / (128 * NCHUNK * 4), h = ch & 3, cid = ch >> 2;
        const bf16_t* vp = PB + (size_t)(cid * 64 + half * 32) * PW + (mx == 0 ? PC_RV : PC_GV) + h * 64 + d;
        unsigned short vv[32];
#pragma unroll
        for (int j = 0; j < 32; ++j) vv[j] = vp[(size_t)j * PW];
        unsigned char* img = WSP(unsigned char, mx == 0 ? WS_VT_R : WS_VT_G) + (size_t)ch * 8192 + d * 128; const int x = (d >> 1) & 15;
#pragma unroll
        for (int j = 0; j < 8; ++j) *(pg8::u32x2*)(img + 8 * ((half * 8 + j) ^ x)) = (pg8::u32x2){(unsigned)vv[4 * j] | ((unsigned)vv[4 * j + 1] << 16), (unsigned)vv[4 * j + 2] | ((unsigned)vv[4 * j + 3] << 16)};
    }
}

namespace scn {
typedef short bf16x8 __attribute__((ext_vector_type(8)));
typedef float f32x16 __attribute__((ext_vector_type(16)));
typedef float f32x4 __attribute__((ext_vector_type(4)));
typedef unsigned u32x4 __attribute__((ext_vector_type(4)));
typedef unsigned u32x2 __attribute__((ext_vector_type(2)));
__device__ __forceinline__ int crow(int r, int hi) { return (r & 3) + 8 * (r >> 2) + 4 * hi; }
__device__ __forceinline__ unsigned cvtpk(float lo, float hi) { return cvtpk_rne(lo, hi); }
__device__ __forceinline__ float blo(unsigned w) { return __uint_as_float(w << 16); }
__device__ __forceinline__ float bhi(unsigned w) { return __uint_as_float(w & 0xffff0000u); }
__device__ __forceinline__ bf16x8 scale8(u32x4 raw, const float (&f)[8]) {
    u32x4 o;
#pragma unroll
    for (int j = 0; j < 4; ++j) o[j] = cvtpk(blo(raw[j]) * f[2 * j], bhi(raw[j]) * f[2 * j + 1]);
    return __builtin_bit_cast(bf16x8, o);
}
template <int MX> struct Cfg;
template <> struct Cfg<0> { static constexpr int DK = 64; };
template <> struct Cfg<1> { static constexpr int DK = 32; };
}
#define SCN_EXP(x) __builtin_amdgcn_exp2f((x) * 1.4426950408889634f)
template <int MX> __device__ __forceinline__ void scan_stage1_unit(KP kp, int l, int b, int h, int g, int tid) {
    using namespace scn;
    constexpr int DK = Cfg<MX>::DK, NKT = DK / 32, NE = DK * 64 / NT;
    const int lane = tid & 63, wid = __builtin_amdgcn_readfirstlane(tid >> 6), q32 = lane & 31, hi = lane >> 5;
    const int nch = g == 8 ? 4 : 8, cid0 = g == 8 ? 256 + 4 * b : b * 64 + 8 * g;
    float* US = WSP(float, MX == 0 ? WS_US_R : WS_US_G);
    const float* CUMT = WSP(float, WS_CUMT_G);
    if (wid < nch) {
        const int cid = cid0 + wid;
        const unsigned char* vimg = WSP(unsigned char, MX == 0 ? WS_VT_R : WS_VT_G) + (size_t)(cid * 4 + h) * 8192;
        const bf16_t* ktimg = WSP(bf16_t, MX == 0 ? WS_KT_R : WS_KT_G) + (size_t)(cid * 4 + h) * DK * 64;
        bf16x8 vb[2][4];
#pragma unroll
        for (int dh = 0; dh < 2; ++dh)
#pragma unroll
            for (int s = 0; s < 4; ++s) { const int d = dh * 32 + q32, x = (d >> 1) & 15, kc = 4 * s + 2 * hi;
                u32x4 v = *(const u32x4*)(vimg + d * 128 + 16 * ((kc ^ x) >> 1));
                if (x & 1) v = (u32x4){v.z, v.w, v.x, v.y};
                vb[dh][s] = __builtin_bit_cast(bf16x8, v); }
#pragma unroll 1
        for (int dir = 0; dir < 2; ++dir) {
            float lg = 0.f; if (MX == 0) lg = -expf(p.ret_decay[(l * 2 + dir) * 4 + h]);
#pragma unroll 1
            for (int kt = 0; kt < NKT; ++kt) {
                f32x16 U[2];
#pragma unroll
                for (int dh = 0; dh < 2; ++dh)
#pragma unroll
                    for (int r = 0; r < 16; ++r) U[dh][r] = 0.f;
                const int k = kt * 32 + q32;
                const float* ct = CUMT + (((size_t)dir * NCHUNK + cid) * 128 + h * 32 + (k & 31)) * 64;
                float E = 0.f; if (MX == 1) E = ct[dir == 0 ? 63 : 0];
#pragma unroll
                for (int s = 0; s < 4; ++s) {
                    const int j0 = 16 * s + 8 * hi;
                    const u32x4 raw = *(const u32x4*)(ktimg + (size_t)k * 64 + j0);
                    float f[8];
                    if (MX == 0) {
#pragma unroll
                        for (int jj = 0; jj < 8; ++jj) f[jj] = SCN_EXP(lg * (float)(dir == 0 ? 63 - (j0 + jj) : j0 + jj));
                    } else {
                        const f32x4 c0 = *(const f32x4*)(ct + j0), c1 = *(const f32x4*)(ct + j0 + 4);
#pragma unroll
                        for (int jj = 0; jj < 4; ++jj) { f[jj] = SCN_EXP(E - c0[jj]); f[4 + jj] = SCN_EXP(E - c1[jj]); }
                    }
                    const bf16x8 af = scale8(raw, f);
#pragma unroll
                    for (int dh = 0; dh < 2; ++dh) U[dh] = __builtin_amdgcn_mfma_f32_32x32x16_bf16(af, vb[dh][s], U[dh], 0, 0, 0);
                }
                float* up = US + ((((size_t)dir * NCHUNK + cid) * 4 + h) * DK + kt * 32 + 4 * hi) * 64 + q32;
#pragma unroll
                for (int dh = 0; dh < 2; ++dh)
#pragma unroll
                    for (int r = 0; r < 16; ++r) up[((r & 3) + 8 * (r >> 2)) * 64 + dh * 32] = U[dh][r];
            }
        }
    }
    asm volatile("s_waitcnt vmcnt(0)" ::: "memory");
    __syncthreads();
    const int k = (tid * NE) >> 6, d0 = (tid * NE) & 63;
#pragma unroll 1
    for (int dir = 0; dir < 2; ++dir) {
        float S[NE], Ap = 1.f;
#pragma unroll
        for (int e = 0; e < NE; ++e) S[e] = 0.f;
        float lg = 0.f; if (MX == 0) lg = -expf(p.ret_decay[(l * 2 + dir) * 4 + h]);
        {
            float uc[8][NE], ac[8];
#pragma unroll
            for (int cc = 0; cc < 8; ++cc) { const bool on = cc < nch; const int c = dir == 0 ? cc : nch - 1 - cc, cid = cid0 + (on ? c : 0);
                if (MX == 0) ac[cc] = SCN_EXP(lg * 64.f); else ac[cc] = SCN_EXP(CUMT[(((size_t)dir * NCHUNK + cid) * 128 + h * 32 + k) * 64 + (dir == 0 ? 63 : 0)]);
                const float* up = US + ((((size_t)dir * NCHUNK + cid) * 4 + h) * DK + k) * 64 + d0;
#pragma unroll
                for (int e = 0; e < NE; ++e) uc[cc][e] = up[e]; }
#pragma unroll
            for (int cc = 0; cc < 8; ++cc) if (cc < nch) {
#pragma unroll
                for (int e = 0; e < NE; ++e) S[e] = ac[cc] * S[e] + uc[cc][e];
                Ap *= ac[cc]; }
        }
        float* ug = WSP(float, MX == 0 ? WS_UG_R : WS_UG_G) + (((((size_t)dir * 4 + b) * 4 + h) * 9 + g) * DK + k) * 64 + d0;
#pragma unroll
        for (int e = 0; e < NE; ++e) ug[e] = S[e];
        if (d0 == 0) WSP(float, WS_AG)[((((MX * 2 + dir) * 4 + b) * 4 + h) * 9 + g) * 64 + k] = Ap;
    }
}
template <int MX> __device__ __forceinline__ void scan_stage2_unit(KP kp, int l, int b, int h, int g, LAS unsigned char* lds, int tid) {
    using namespace scn;
    constexpr int DK = Cfg<MX>::DK, NKS = DK / 16, NE = DK * 64 / NT, NCH16 = DK / 8;
    const int lane = tid & 63, wid = __builtin_amdgcn_readfirstlane(tid >> 6), q32 = lane & 31, hi = lane >> 5;
    const int nch = g == 8 ? 4 : 8, cid0 = g == 8 ? 256 + 4 * b : b * 64 + 8 * g;
    const bool act = wid < nch;
    const int cid = cid0 + (act ? wid : 0), row0 = cid * 64;
    const bf16_t* PB = WSP(bf16_t, WS_PBUF);
    const float* US = WSP(float, MX == 0 ? WS_US_R : WS_US_G);
    const float* UG = WSP(float, MX == 0 ? WS_UG_R : WS_UG_G);
    const float* CUMT = WSP(float, WS_CUMT_G);
    f32x16 o[2][2];
#pragma unroll
    for (int it = 0; it < 2; ++it)
#pragma unroll
        for (int dh = 0; dh < 2; ++dh)
#pragma unroll
            for (int r = 0; r < 16; ++r) o[it][dh][r] = 0.f;
    LAS unsigned char* myv = lds + 65536 + wid * 8192;
    { const unsigned char* vimg = WSP(unsigned char, MX == 0 ? WS_VT_R : WS_VT_G) + (size_t)(cid * 4 + h) * 8192 + lane * 16;
      u32x4 tmp[8];
#pragma unroll
      for (int i = 0; i < 8; ++i) tmp[i] = *(const u32x4*)(vimg + i * 1024);
#pragma unroll
      for (int i = 0; i < 8; ++i) *(LAS u32x4*)(myv + i * 1024 + lane * 16) = tmp[i]; }
    const int fk = (tid * NE) >> 6, fd0 = (tid * NE) & 63;
#pragma unroll 1
    for (int dir = 0; dir < 2; ++dir) {
        float lg = 0.f; if (MX == 0) lg = -expf(p.ret_decay[(l * 2 + dir) * 4 + h]);
        float S[NE];
#pragma unroll
        for (int e = 0; e < NE; ++e) S[e] = 0.f;
        if (g != 8) {
            const float* ugb = UG + (((size_t)dir * 4 + b) * 4 + h) * 9 * DK * 64 + (size_t)fk * 64 + fd0;
            const float* agb = WSP(float, WS_AG) + (((MX * 2 + dir) * 4 + b) * 4 + h) * 9 * 64 + fk;
            const int ng = dir == 0 ? g : 7 - g;
            float ug[7][NE], ag[7];
#pragma unroll
            for (int e = 0; e < NE; ++e) S[e] = ugb[(size_t)8 * DK * 64 + e];
#pragma unroll
            for (int q = 0; q < 7; ++q) { const bool on = q < ng; const int qq = on ? q : 0, gg = dir == 0 ? qq : 7 - qq; const float av = agb[gg * 64]; ag[q] = on ? av : 1.f;
#pragma unroll
                for (int e = 0; e < NE; ++e) { const float uv = ugb[(size_t)gg * DK * 64 + e]; ug[q][e] = on ? uv : 0.f; } }
#pragma unroll
            for (int q = 0; q < 7; ++q)
#pragma unroll
                for (int e = 0; e < NE; ++e) S[e] = ag[q] * S[e] + ug[q][e];
        }
        {
            float uc[8][NE], ac[8];
#pragma unroll
            for (int cc = 0; cc < 8; ++cc) { const bool on = cc < nch; const int c = dir == 0 ? cc : nch - 1 - cc, ccid = cid0 + (on ? c : 0);
                if (MX == 0) ac[cc] = SCN_EXP(lg * 64.f); else ac[cc] = SCN_EXP(CUMT[(((size_t)dir * NCHUNK + ccid) * 128 + h * 32 + fk) * 64 + (dir == 0 ? 63 : 0)]);
                const float* up = US + ((((size_t)dir * NCHUNK + ccid) * 4 + h) * DK + fk) * 64 + fd0;
#pragma unroll
                for (int e = 0; e < NE; ++e) uc[cc][e] = up[e]; }
#pragma unroll
            for (int cc = 0; cc < 8; ++cc) if (cc < nch) {
                const int c = dir == 0 ? cc : nch - 1 - cc;
                LAS unsigned char* area = lds + c * 8192;
#pragma unroll
                for (int e = 0; e < NE; ++e) { const int d = fd0 + e; const int sw = DK == 64 ? ((d >> 1) & 7) : ((d >> 2) & 3);
                    *(LAS bf16_t*)(area + d * (DK * 2) + 16 * ((fk >> 3) ^ sw) + (fk & 7) * 2) = f2bf(S[e]); }
#pragma unroll
                for (int e = 0; e < NE; ++e) S[e] = ac[cc] * S[e] + uc[cc][e];
            }
        }
        asm volatile("s_waitcnt lgkmcnt(0)" ::: "memory");
        __syncthreads();
        if (act) {
#define SCN_GEN(dst, ISQ, T2) do { const int il_ = 32 * (T2) + q32, row_ = row0 + il_; \
                _Pragma("unroll") for (int ks = 0; ks < NKS; ++ks) { const int kc0 = 16 * ks + 8 * hi; u32x4 raw_; float f_[8]; \
                    if (MX == 0) { raw_ = *(const u32x4*)(WSP(bf16_t, (ISQ) ? WS_QF_R : WS_KF_R) + (size_t)row_ * 256 + h * 64 + kc0); \
                        const float cm_ = lg * (float)(dir == 0 ? il_ + 1 : 64 - il_), e_ = SCN_EXP((ISQ) ? cm_ : -cm_); \
                        _Pragma("unroll") for (int jj = 0; jj < 8; ++jj) f_[jj] = e_; \
                    } else { raw_ = *(const u32x4*)(PB + (size_t)row_ * PW + ((ISQ) ? PC_GQ : PC_GK) + h * 32 + kc0); \
                        const float* cp_ = WSP(float, WS_CUM_G) + ((size_t)dir * MALL + row_) * 128 + h * 32 + kc0; \
                        const f32x4 c0_ = *(const f32x4*)cp_, c1_ = *(const f32x4*)(cp_ + 4); \
                        _Pragma("unroll") for (int jj = 0; jj < 4; ++jj) { f_[jj] = (ISQ) ? SCN_EXP(c0_[jj]) * 0.17677669529663687f : SCN_EXP(-c0_[jj]); f_[4 + jj] = (ISQ) ? SCN_EXP(c1_[jj]) * 0.17677669529663687f : SCN_EXP(-c1_[jj]); } } \
                    dst[ks] = scale8(raw_, f_); } } while (0)
#define SCN_TILE(JT, IT, MASKED) do { bf16x8 kf_[NKS]; SCN_GEN(kf_, false, JT); f32x16 P; \
                _Pragma("unroll") for (int r = 0; r < 16; ++r) P[r] = 0.f; \
                _Pragma("unroll") for (int ks = 0; ks < NKS; ++ks) P = __builtin_amdgcn_mfma_f32_32x32x16_bf16(kf_[ks], qf[ks], P, 0, 0, 0); \
                if (MASKED) { _Pragma("unroll") for (int r = 0; r < 16; ++r) { const int j = crow(r, hi); const bool keep = dir == 0 ? (j <= q32) : (j >= q32); P[r] = keep ? P[r] : 0.f; } } \
                _Pragma("unroll") for (int s = 0; s < 2; ++s) { u32x4 pk; \
                    _Pragma("unroll") for (int j = 0; j < 4; ++j) pk[j] = cvtpk(P[8 * s + 2 * j], P[8 * s + 2 * j + 1]); \
                    _Pragma("unroll") for (int dh = 0; dh < 2; ++dh) { const int d = dh * 32 + q32, x = (d >> 1) & 15, kc = 8 * JT + 4 * s + hi; \
                        const u32x2 v0 = *(const LAS u32x2*)(myv + d * 128 + 8 * (kc ^ x)), v1 = *(const LAS u32x2*)(myv + d * 128 + 8 * ((kc + 2) ^ x)); \
                        o[IT][dh] = __builtin_amdgcn_mfma_f32_32x32x16_bf16(__builtin_bit_cast(bf16x8, pk), __builtin_bit_cast(bf16x8, (u32x4){v0.x, v0.y, v1.x, v1.y}), o[IT][dh], 0, 0, 0); } } } while (0)
#define SCN_INTER(IT) do { const LAS unsigned char* area = lds + wid * 8192; \
                _Pragma("unroll") for (int dh = 0; dh < 2; ++dh) _Pragma("unroll") for (int ks = 0; ks < NKS; ++ks) { \
                    const int d = dh * 32 + q32, sw = DK == 64 ? ((d >> 1) & 7) : ((d >> 2) & 3); \
                    const bf16x8 sf = *(const LAS bf16x8*)(area + d * (DK * 2) + 16 * ((2 * ks + hi) ^ sw)); \
                    o[IT][dh] = __builtin_amdgcn_mfma_f32_32x32x16_bf16(qf[ks], sf, o[IT][dh], 0, 0, 0); } } while (0)
            { bf16x8 qf[NKS]; SCN_GEN(qf, true, 0);
              SCN_TILE(0, 0, true); if (dir == 1) SCN_TILE(1, 0, false);
              SCN_INTER(0); }
            asm volatile("" ::: "memory");
            { bf16x8 qf[NKS]; SCN_GEN(qf, true, 1);
              if (dir == 0) SCN_TILE(0, 1, false);
              SCN_TILE(1, 1, true);
              SCN_INTER(1); }
#undef SCN_GEN
#undef SCN_TILE
#undef SCN_INTER
        }
        asm volatile("s_waitcnt lgkmcnt(0)" ::: "memory");
        __syncthreads();
    }
    if (act) {
        const int gcol = (MX == 0 ? PC_RG : PC_GR) + h * 64, ccol = (MX == 0 ? 512 : 768) + h * 64;
        const float g0 = MX == 0 ? p.ret_norm_g[l * 256 + h * 64 + q32] : p.gla_norm_g[l * 64 + q32], g1 = MX == 0 ? p.ret_norm_g[l * 256 + h * 64 + 32 + q32] : p.gla_norm_g[l * 64 + 32 + q32];
#pragma unroll
        for (int it = 0; it < 2; ++it)
#pragma unroll
            for (int r = 0; r < 16; ++r) {
                const int row = row0 + 32 * it + crow(r, hi);
                const float a0 = o[it][0][r], a1 = o[it][1][r];
                float ss = a0 * a0 + a1 * a1;
#pragma unroll
                for (int x = 1; x < 32; x <<= 1) ss += __shfl_xor(ss, x);
                const float rstd = rsqrtf(ss * (1.f / 64.f) + EPS);
                const float gt0 = bf2f(PB[(size_t)row * PW + gcol + q32]), gt1 = bf2f(PB[(size_t)row * PW + gcol + 32 + q32]);
                bf16_t* op = WSP(bf16_t, WS_CONCAT) + (size_t)row * D + ccol + q32;
                op[0] = f2bf(a0 * rstd * g0 * (gt0 / (1.f + SCN_EXP(-gt0)))); op[32] = f2bf(a1 * rstd * g1 * (gt1 / (1.f + SCN_EXP(-gt1))));
                if ((r & 3) == 3) asm volatile("" ::: "memory");
            }
    }
}
__device__ __forceinline__ bool scan_unit(int slot, bool with_ctx, int& mx, int& bh, int& g) {
    if (slot < 256) { mx = slot >> 7; const int r = slot & 127; bh = r >> 3; g = r & 7; return true; }
    if (!with_ctx) return false;
    const int j = slot - 256 - 128;
    if (j < 0 || j >= 32) return false;
    mx = j >> 4; bh = j & 15; g = 8; return true;
}
__device__ __forceinline__ void d_scan_stage1(KP kp, int l) {
    PH_IDS;
    for (int slot = bid; slot < 512; slot += gridDim.x) {
        int mx, bh, g; if (!scan_unit(slot, true, mx, bh, g)) continue;
        if (mx == 0) scan_stage1_unit<0>(kp, l, bh >> 2, bh & 3, g, tid); else scan_stage1_unit<1>(kp, l, bh >> 2, bh & 3, g, tid);
    }
}
__device__ __forceinline__ void d_scan_stage2(KP kp, int l, LAS unsigned char* lds) {
    PH_IDS;
    for (int slot = bid; slot < 512; slot += gridDim.x) {
        int mx, bh, g; if (!scan_unit(slot, l == 0, mx, bh, g)) continue;
        if (mx == 0) scan_stage2_unit<0>(kp, l, bh >> 2, bh & 3, g, lds, tid); else scan_stage2_unit<1>(kp, l, bh >> 2, bh & 3, g, lds, tid);
    }
}
namespace hfft {
typedef float f2 __attribute__((ext_vector_type(2)));
typedef float f4 __attribute__((ext_vector_type(4)));
constexpr int N = 8192;
__device__ __forceinline__ f2 cmul(f2 a, f2 b) { return (f2){a.x * b.x - a.y * b.y, a.x * b.y + a.y * b.x}; }
__device__ __forceinline__ f2 cmulc(f2 a, f2 b) { return (f2){a.x * b.x + a.y * b.y, a.y * b.x - a.x * b.y}; }
__device__ __forceinline__ f2 tw(float frac) { float sn, cs; sincosf(6.283185307179586f * frac, &sn, &cs); return (f2){cs, -sn}; }
constexpr int TWOFF = 131072 + 64;
__device__ __forceinline__ void tw_build(LAS unsigned char* lds, int tid) { LAS f2* T = (LAS f2*)(lds + TWOFF); for (int k = tid; k < 1024; k += NT) T[k] = tw((float)k * (1.f / 8192.f)); }
__device__ __forceinline__ f2 twk(const LAS f2* T, int k) {
    const f2 a = T[k & 1023]; const float r = 0.70710678118654752f;
    return (k & 1024) ? (f2){(a.x + a.y) * r, (a.y - a.x) * r} : a;
}
__device__ __forceinline__ f2 mul_mi(f2 a) { return (f2){a.y, -a.x}; }
__device__ __forceinline__ f2 mul_pi(f2 a) { return (f2){-a.y, a.x}; }
template <int LOGD> __device__ __forceinline__ void fwd_pass(LAS f2* buf, int tid) {
    constexpr int Dd = 1 << LOGD;
#pragma unroll
    for (int g = 0; g < 4; ++g) {
        const int u = tid + NT * g, pos = u & (Dd - 1), base = ((u - pos) << 2) + pos;
        const f2 wA = twk((const LAS f2*)((LAS unsigned char*)buf + TWOFF), pos << (11 - LOGD)), wB = cmul(wA, wA);
#pragma unroll
        for (int arr = 0; arr < 2; ++arr) {
            LAS f2* x = buf + arr * N + base;
            const f2 a0 = x[0], a1 = x[Dd], a2 = x[2 * Dd], a3 = x[3 * Dd];
            const f2 b0 = a0 + a2, b2 = cmul(a0 - a2, wA), b1 = a1 + a3, b3 = mul_mi(cmul(a1 - a3, wA));
            x[0] = b0 + b1; x[Dd] = cmul(b0 - b1, wB); x[2 * Dd] = b2 + b3; x[3 * Dd] = cmul(b2 - b3, wB);
        }
    }
    __syncthreads();
}
template <int LOGD> __device__ __forceinline__ void inv_pass(LAS f2* buf, int tid) {
    constexpr int Dd = 1 << LOGD;
#pragma unroll
    for (int g = 0; g < 4; ++g) {
        const int u = tid + NT * g, pos = u & (Dd - 1), base = ((u - pos) << 2) + pos;
        const f2 wA = twk((const LAS f2*)((LAS unsigned char*)buf + TWOFF), pos << (11 - LOGD)), wB = cmul(wA, wA);
#pragma unroll
        for (int arr = 0; arr < 2; ++arr) {
            LAS f2* x = buf + arr * N + base;
            const f2 c0 = x[0], c1 = cmulc(x[Dd], wB), c2 = x[2 * Dd], c3 = cmulc(x[3 * Dd], wB);
            const f2 b0 = c0 + c1, b1 = c0 - c1, b2 = cmulc(c2 + c3, wA), b3 = mul_pi(cmulc(c2 - c3, wA));
            x[0] = b0 + b2; x[2 * Dd] = b0 - b2; x[Dd] = b1 + b3; x[3 * Dd] = b1 - b3;
        }
    }
    __syncthreads();
}
__device__ __forceinline__ void fwd_all(LAS f2* buf, int tid) { fwd_pass<11>(buf, tid); fwd_pass<9>(buf, tid); fwd_pass<7>(buf, tid); fwd_pass<5>(buf, tid); fwd_pass<3>(buf, tid); fwd_pass<1>(buf, tid); }
__device__ __forceinline__ void inv_all(LAS f2* buf, int tid) { inv_pass<1>(buf, tid); inv_pass<3>(buf, tid); inv_pass<5>(buf, tid); inv_pass<7>(buf, tid); inv_pass<9>(buf, tid); inv_pass<11>(buf, tid); }
}
__device__ __forceinline__ void d_fspec(KP kp, LAS unsigned char* lds) {
    PH_IDS;
    using namespace hfft;
    LAS f2* buf = (LAS f2*)lds; LAS float* nrm = (LAS float*)(lds + 131072);
    tw_build(lds, tid);
    for (int u = bid; u < 256; u += gridDim.x) {
        const int l = u >> 7, c0 = (u & 127) * 2;
        const float* filt = WSP(float, WS_FILT) + (size_t)l * 8192 * 256;
        if (tid < 128) {
            const int arr = tid >> 6, ln = tid & 63; float a = 0.f;
#pragma unroll
            for (int q = 0; q < 4; ++q) a += WSP(float, WS_PS)[(size_t)(l * 256 + ln * 4 + q) * 256 + c0 + arr];
            a = wave_sum(a); if (ln == 0) nrm[arr] = a;
        }
        for (int i = tid; i < 2 * N; i += NT) { const int arr = i >> 13, tau = i & (N - 1); buf[i] = (f2){filt[(size_t)tau * 256 + c0 + arr], 0.f}; }
        __syncthreads();
        fwd_all(buf, tid);
        f4* fs = (f4*)(WSP(float, WS_FSPEC) + ((size_t)l * 256 + c0) * 2 * N);
        for (int i = tid; i < N; i += NT) {
            const int arr = i >> 12, j = i & 4095;
            const f4 v = *(const LAS f4*)(buf + arr * N + 2 * j);
            const float sc = 1.f / (8192.f * nrm[arr]), bs = p.hy_bias[l * 256 + c0 + arr] * (1.f / 8192.f);
            fs[(size_t)arr * (N / 2) + j] = (f4){(v.x + v.z) * sc + bs, (v.y + v.w) * sc, (v.x - v.z) * sc + bs, (v.y - v.w) * sc};
        }
        __syncthreads();
    }
}
__device__ __forceinline__ void d_hy_pre_fast(KP kp, int l, LAS unsigned char* lds) {
    PH_IDS;
    LAS float* zt = (LAS float*)lds;
    const bf16_t* PB = WSP(bf16_t, WS_PBUF);
    const int c = tid & 255, half = tid >> 8;
    const float* sw = p.hy_short_w + l * 3 * 768; const float* sb = p.hy_short_b + l * 768;
    float w0[3], w1[3], w2[3], bb[3];
#pragma unroll
    for (int g = 0; g < 3; ++g) { w0[g] = sw[g * 256 + c]; w1[g] = sw[768 + g * 256 + c]; w2[g] = sw[1536 + g * 256 + c]; bb[g] = sb[g * 256 + c]; }
    for (int u = bid; u < NLAT / 64; u += gridDim.x) {
        const int row0 = u * 64 + half * 32, t0 = (u * 64) & (SEQ - 1);
        const int tfirst = t0 + half * 32;
        float xin[3][34];
#pragma unroll
        for (int g = 0; g < 3; ++g) {
            const bf16_t* pp = PB + (size_t)row0 * PW + PC_HY + g * 256 + c;
#pragma unroll
            for (int i = 0; i < 34; ++i) { const int t = tfirst + i - 1, tc = t < 0 ? 0 : (t > SEQ - 1 ? SEQ - 1 : t); const float v = bf2f(pp[(ptrdiff_t)(tc - tfirst) * PW]); xin[g][i] = (t == tc) ? v : 0.f; }
        }
#pragma unroll
        for (int i = 0; i < 32; ++i) {
            float uu[3];
#pragma unroll
            for (int g = 0; g < 3; ++g) uu[g] = bb[g] + w0[g] * xin[g][i] + w1[g] * xin[g][i + 1] + w2[g] * xin[g][i + 2];
            WSP(bf16_t, WS_X0B)[(size_t)(row0 + i) * 256 + c] = f2bf(uu[0]);
            zt[c * 65 + half * 32 + i] = uu[1] * uu[2];
        }
        __syncthreads();
        const int b = (u * 64) >> 12;
        for (int i = tid; i < 256 * 64; i += NT) { const int cc = i >> 6, tl = i & 63; WSP(float, WS_ZT)[((size_t)cc * 4 + b) * SEQ + t0 + tl] = zt[cc * 65 + tl]; }
        __syncthreads();
    }
    if (l == 0) {
        GT_LOOP(idx, NCTX * 256) {
            const int r = idx >> 8, cc = idx & 255, t = r & (CTXL - 1);
            const bf16_t* pp = PB + (size_t)(NLAT + r) * PW + PC_HY + cc;
            float uu[3];
#pragma unroll
            for (int g = 0; g < 3; ++g) { float a = sb[g * 256 + cc] + sw[768 + g * 256 + cc] * bf2f(pp[g * 256]);
                const float pv = bf2f(pp[g * 256 - (t > 0 ? PW : 0)]), nv = bf2f(pp[g * 256 + (t < CTXL - 1 ? PW : 0)]);
                a += sw[g * 256 + cc] * (t > 0 ? pv : 0.f) + sw[1536 + g * 256 + cc] * (t < CTXL - 1 ? nv : 0.f); uu[g] = a; }
            WSP(float, WS_X0C)[idx] = uu[0]; WSP(float, WS_ZC)[idx] = uu[1] * uu[2];
        }
    }
}
__device__ __forceinline__ void d_hy_fft(KP kp, int l, LAS unsigned char* lds) {
    PH_IDS;
    using namespace hfft;
    LAS f2* buf = (LAS f2*)lds;
    tw_build(lds, tid);
    for (int c = bid; c < 256; c += gridDim.x) {
        const float* zt = WSP(float, WS_ZT) + (size_t)c * 4 * SEQ;
#pragma unroll
        for (int arr = 0; arr < 2; ++arr) {
            float re[8], im[8];
#pragma unroll
            for (int i = 0; i < 8; ++i) { re[i] = zt[(size_t)(2 * arr) * SEQ + tid + i * NT]; im[i] = zt[(size_t)(2 * arr + 1) * SEQ + tid + i * NT]; }
            f2 zz; { float zx_, zy_; asm volatile("v_mov_b32 %0, 0\n\tv_mov_b32 %1, 0" : "=v"(zx_), "=v"(zy_)); zz = (f2){zx_, zy_}; }
#pragma unroll
            for (int i = 0; i < 8; ++i) { buf[arr * N + tid + i * NT] = (f2){re[i], im[i]}; buf[arr * N + SEQ + tid + i * NT] = zz; }
        }
        __syncthreads();
        fwd_all(buf, tid);
        const f4* fs = (const f4*)(WSP(float, WS_FSPEC) + ((size_t)l * 256 + c) * 2 * N);
        for (int i = tid; i < N; i += NT) {
            const int arr = i >> 12, j = i & 4095;
            LAS f4* xp = (LAS f4*)(buf + arr * N + 2 * j);
            const f4 v = *xp; const f4 f = fs[j];
            const f2 s = cmul((f2){v.x + v.z, v.y + v.w}, (f2){f.x, f.y}), d = cmul((f2){v.x - v.z, v.y - v.w}, (f2){f.z, f.w});
            *xp = (f4){s.x + d.x, s.y + d.y, s.x - d.x, s.y - d.y};
        }
        __syncthreads();
        inv_all(buf, tid);
        float* yt = WSP(float, WS_YT) + (size_t)c * 4 * SEQ;
        for (int i = tid; i < 2 * SEQ; i += NT) { const int arr = i >> 12, t = i & (SEQ - 1); const f2 v = buf[arr * N + t];
            yt[(size_t)(2 * arr) * SEQ + t] = v.x; yt[(size_t)(2 * arr + 1) * SEQ + t] = v.y; }
        __syncthreads();
    }
}
__device__ __forceinline__ void d_hy_post(KP kp, int l, LAS unsigned char* lds) {
    PH_IDS;
    LAS float* yt = (LAS float*)lds;
    for (int u = bid; u < NLAT / 64; u += gridDim.x) {
        const int b = (u * 64) >> 12, t0 = (u * 64) & (SEQ - 1);
#pragma unroll 1
        for (int hb2 = 0; hb2 < 4; ++hb2) {
            float yv[8];
#pragma unroll
            for (int i = 0; i < 8; ++i) { const int idx = tid + (hb2 * 8 + i) * NT; yv[i] = WSP(float, WS_YT)[((size_t)(idx >> 6) * 4 + b) * SEQ + t0 + (idx & 63)]; }
#pragma unroll
            for (int i = 0; i < 8; ++i) { const int idx = tid + (hb2 * 8 + i) * NT; yt[(idx >> 6) * 65 + (idx & 63)] = yv[i]; }
            asm volatile("" ::: "memory");
        }
        __syncthreads();
        {
            const int c = tid & 255, th = tid >> 8;
#pragma unroll 1
            for (int hb2 = 0; hb2 < 4; ++hb2) {
                float x0v[8];
#pragma unroll
                for (int i = 0; i < 8; ++i) x0v[i] = bf2f(WSP(bf16_t, WS_X0B)[((size_t)u * 64 + 2 * (hb2 * 8 + i) + th) * 256 + c]);
#pragma unroll
                for (int i = 0; i < 8; ++i) { const int tl = 2 * (hb2 * 8 + i) + th; WSP(bf16_t, WS_CONCAT)[((size_t)u * 64 + tl) * D + 256 + c] = f2bf(x0v[i] * yt[c * 65 + tl]); }
                asm volatile("" ::: "memory");
            }
        }
        __syncthreads();
    }
    if (l == 0) {
        const int wv = __builtin_amdgcn_readfirstlane(tid >> 6), lane = tid & 63;
        LAS float* G = (LAS float*)lds + wv * 1024; LAS float* Z = G + 768;
        for (int pair = bid * (NT / 64) + wv; pair < 4 * 256; pair += gridDim.x * (NT / 64)) {
            const int b = pair >> 8, c = pair & 255;
            const float* filt = WSP(float, WS_FILTC) + c; const float* zc = WSP(float, WS_ZC) + (size_t)(b * CTXL) * 256 + c;
            float f[8], z[4], x0[4], nrm = 0.f;
#pragma unroll
            for (int k = 0; k < 8; ++k) f[k] = filt[(size_t)(lane + 64 * k) * 256];
#pragma unroll
            for (int k = 0; k < 4; ++k) { z[k] = zc[(size_t)(lane + 64 * k) * 256]; x0[k] = WSP(float, WS_X0C)[(size_t)(b * CTXL + lane + 64 * k) * 256 + c]; }
#pragma unroll
            for (int q = 0; q < 16; ++q) nrm += WSP(float, WS_PS)[(size_t)(512 + q) * 256 + c];
            const float bias = p.hy_bias[c];
#pragma unroll
            for (int k = 0; k < 8; ++k) { G[256 + lane + 64 * k] = f[k]; if (k >= 4) G[lane + 64 * (k - 4)] = f[k]; }
#pragma unroll
            for (int k = 0; k < 4; ++k) Z[lane + 64 * k] = z[k];
            float acc[4] = {0.f, 0.f, 0.f, 0.f};
            const LAS float* gb = G + lane + 1;
#pragma unroll 4
            for (int s4 = 0; s4 < 64; ++s4) {
                const gv4f zs = *(const LAS gv4f*)(Z + 4 * s4);
#pragma unroll
                for (int j = 0; j < 4; ++j)
#pragma unroll
                    for (int k = 0; k < 4; ++k) acc[k] += gb[64 * k + 255 - (4 * s4 + j)] * zs[j];
            }
            const float inrm = 1.f / nrm;
#pragma unroll
            for (int k = 0; k < 4; ++k) { const float y = acc[k] * inrm + bias * z[k];
                WSP(bf16_t, WS_CONCAT)[(size_t)(NLAT + b * CTXL + lane + 64 * k) * D + 256 + c] = f2bf(x0[k] * y); }
        }
    }
}
constexpr int CW_BAR = 32768;
__global__ void __launch_bounds__(NT, 2) mk_fwd(P kargs) {
    const KP kp0 = (KP)((unsigned long long)__builtin_amdgcn_kernarg_segment_ptr() | (unsigned long long)(unsigned)__builtin_amdgcn_readfirstlane(threadIdx.x >> 6));
    KP kp = kp0;
#define LP ({ KP k_ = kp0; asm volatile("" : "+s"(k_)); k_; })
    unsigned char* const lds = g_lds;
    volatile LAS unsigned* misc = (volatile LAS unsigned*)((LAS unsigned char*)lds + LDS_MISC);
    if (threadIdx.x < 16) misc[threadIdx.x] = 0u;
    __syncthreads();
    (void)xcd_barrier_post(WSP(unsigned, WS_CTL) + CW_BAR, misc);
#define GRID_BAR() do { XcdBarrier b_; bool t0_; { KP kp = LP; b_.bar = WSP(unsigned, WS_CTL) + CW_BAR; t0_ = ltid_kp(kp) == 0; } b_.x = xb_xcc_id(); b_.st = (volatile LAS unsigned*)((LAS unsigned char*)lds + LDS_MISC); xcd_barrier(b_, t0_); } while (0)
    d_pro0(LP, (LAS float*)((LAS unsigned char*)lds + 98304)); d_filter(LP, (LAS float*)((LAS unsigned char*)lds + 73728)); d_convert_a(LP, (LAS float*)lds);
    GRID_BAR();
    d_pro1(LP); d_convert_b(LP, (LAS float*)lds);
    GRID_BAR();
    d_fspec(LP, (LAS unsigned char*)lds); d_norm1(LP, 0);
    GRID_BAR();
#pragma unroll 1
    for (int l = 0; l < DEPTH; ++l) {
        d_gemm_in(LP, l, (LAS unsigned char*)lds);
        GRID_BAR();
        d_prep_scan(LP); d_prep_attn(LP); d_hy_pre_fast(LP, l, (LAS unsigned char*)lds);
        GRID_BAR();
        d_scan_stage1(LP, l);
        d_hy_fft(LP, l, (LAS unsigned char*)lds);
        d_attn_fast(LP, l, (LAS unsigned char*)lds);
        GRID_BAR();
        d_scan_stage2(LP, l, (LAS unsigned char*)lds);
        d_hy_post(LP, l, (LAS unsigned char*)lds);
        GRID_BAR();
        d_gemm_out(LP, l, (LAS unsigned char*)lds);
        GRID_BAR();
        d_router(LP, l, (LAS float*)lds);
        GRID_BAR();
        d_moe_up(LP, l, (LAS unsigned char*)lds);
        GRID_BAR();
        d_moe_down(LP, l, (LAS unsigned char*)lds);
        GRID_BAR();
        d_combine(LP, l, (LAS int*)lds);
        GRID_BAR();
    }
}

#undef p
extern "C" void kernel_launch(void* const* d_in, const int* in_sizes, int n_in, void* d_out, int out_size, void* d_ws, size_t ws_size, hipStream_t stream) {
    if (n_in != 31 || ws_size < WS_END || out_size != NLAT * D) { fprintf(stderr, "kernel_launch: unexpected shapes (n_in %d ws %zu out %d)\n", n_in, ws_size, out_size); return; }
    static int grid = 0;
    if (grid == 0) {
        int dev = 0, cus = 0, per_cu = 0;
        if (hipGetDevice(&dev) != hipSuccess || hipDeviceGetAttribute(&cus, hipDeviceAttributeMultiprocessorCount, dev) != hipSuccess) { grid = -1; return; }
        if (hipFuncSetAttribute((const void*)mk_fwd, hipFuncAttributeMaxDynamicSharedMemorySize, LDS_BYTES) != hipSuccess) { fprintf(stderr, "hipFuncSetAttribute failed\n"); grid = -1; return; }
        if (hipOccupancyMaxActiveBlocksPerMultiprocessor(&per_cu, (const void*)mk_fwd, NT, LDS_BYTES) != hipSuccess || per_cu < 1) { fprintf(stderr, "occupancy query says %d\n", per_cu); }
        (void)hipGetLastError();
        grid = cus;
    }
    if (grid < 0) return;
    P hp{};
    const float** pp = (const float**)&hp;
    for (int i = 0; i < 31; ++i) pp[i] = (const float*)d_in[i];
    hp.out = (float*)d_out; hp.ws = (unsigned char*)d_ws;
    (void)hipMemsetAsync((char*)d_ws + WS_CTL, 0, 1 * MiB, stream);
    hipLaunchKernelGGL(mk_fwd, dim3(grid), dim3(NT), LDS_BYTES, stream, hp);
}
```

```cpp
#include <hip/hip_runtime.h>
#include <stdint.h>
#include <stdio.h>
#include <math.h>

constexpr int D = 1024, BATCH = 4, SEQ = 4096, CTXL = 256, DEPTH = 2;
constexpr int NLAT = BATCH * SEQ, NCTX = BATCH * CTXL, MALL = NLAT + NCTX;
constexpr int INW = 3360, PW = 3584;
constexpr int NEXP = 32, TOPK = 4;
constexpr float EPS = 1e-6f;
constexpr int PC_AQ = 0, PC_AK = 256, PC_AV = 512, PC_HY = 768, PC_RQ = 1536, PC_RK = 1792, PC_RV = 2048, PC_RG = 2304,
              PC_GQ = 2560, PC_GK = 2688, PC_GV = 2816, PC_GR = 3072, PC_GD = 3328;
constexpr int ACT_ROWS = MALL * TOPK + NEXP * 256;

typedef unsigned short bf16_t;
typedef float cvt_f32x2_t __attribute__((ext_vector_type(2))); typedef __bf16 cvt_bf16x2_t __attribute__((ext_vector_type(2)));
__device__ __forceinline__ unsigned cvtpk_rne(float lo, float hi) { cvt_f32x2_t v = {lo, hi}; cvt_bf16x2_t b = __builtin_convertvector(v, cvt_bf16x2_t); return __builtin_bit_cast(unsigned, b); }
__device__ __forceinline__ bf16_t f2bf(float f) { unsigned u = __float_as_uint(f); return (bf16_t)((u + 0x7fffu + ((u >> 16) & 1u)) >> 16); }
__device__ __forceinline__ float bf2f(bf16_t b) { return __uint_as_float(((unsigned)b) << 16); }

typedef unsigned gv4u __attribute__((ext_vector_type(4))); typedef float gv4f __attribute__((ext_vector_type(4))); typedef unsigned gv2u __attribute__((ext_vector_type(2)));
__device__ __forceinline__ float gblo(unsigned w) { return __uint_as_float(w << 16); }
__device__ __forceinline__ float gbhi(unsigned w) { return __uint_as_float(w & 0xffff0000u); }
__device__ __forceinline__ unsigned char f2fp8(float a) { return (unsigned char)(__builtin_amdgcn_cvt_pk_fp8_f32(a, a, 0, false) & 0xff); }
__device__ __forceinline__ unsigned pk4_fp8(float a, float b, float c, float d) { int r = __builtin_amdgcn_cvt_pk_fp8_f32(a, b, 0, false); r = __builtin_amdgcn_cvt_pk_fp8_f32(c, d, r, true); return (unsigned)r; }
constexpr float W8_SCALE = 64.f;
constexpr size_t MiB = 1u << 20;
constexpr size_t WS_CTL = 0;
constexpr size_t WS_MOD = 1 * MiB;
constexpr size_t WS_WEFF = 3 * MiB;
constexpr size_t WS_FILT = 6 * MiB;
constexpr size_t WS_FILTC = WS_FILT + 16 * MiB;
constexpr size_t WS_XRES = 24 * MiB;
constexpr size_t WS_HB = WS_XRES + 68 * MiB;
constexpr size_t WS_PBUF = WS_HB + 34 * MiB;
constexpr size_t WS_CONCAT = WS_PBUF + 120 * MiB;
constexpr size_t WS_YBUF = WS_CONCAT + 34 * MiB;
constexpr size_t WS_QA = WS_YBUF + 68 * MiB;
constexpr size_t WS_KA = WS_QA + 17 * MiB;
constexpr size_t WS_QR = WS_KA + 17 * MiB;
constexpr size_t WS_KR = WS_QR + 17 * MiB;
constexpr size_t WS_OA = WS_KR + 17 * MiB;
constexpr size_t WS_Z = WS_OA + 34 * MiB;
constexpr size_t WS_X0 = WS_Z + 17 * MiB;
constexpr size_t WS_LA = WS_X0 + 17 * MiB;
constexpr size_t WS_OD = WS_LA + 17 * MiB;
constexpr size_t WS_TOPI = WS_OD + 68 * MiB;
constexpr size_t WS_TOPW = WS_TOPI + 1 * MiB;
constexpr size_t WS_LIST = WS_TOPW + 1 * MiB;
constexpr size_t WS_ACT = WS_LIST + 3 * MiB;
constexpr size_t WS_YSLOT = WS_ACT + 160 * MiB;
constexpr size_t WS_WIN_T = WS_YSLOT + 160 * MiB;
constexpr size_t WS_WOUT_T = WS_WIN_T + 14 * MiB;
constexpr size_t WS_W1_T = WS_WOUT_T + 4 * MiB;
constexpr size_t WS_W2_T = WS_W1_T + 256 * MiB;
constexpr size_t WS_BIAS_IN = WS_W2_T + 128 * MiB;
constexpr size_t WS_QRP = WS_BIAS_IN + 1 * MiB;
constexpr size_t WS_KIMG = WS_QRP + 9 * MiB;
constexpr size_t WS_VIMG = WS_KIMG + 9 * MiB;
constexpr size_t WS_QF_R = WS_VIMG + 9 * MiB;
constexpr size_t WS_KF_R = WS_QF_R + 9 * MiB;
constexpr size_t WS_KT_R = WS_KF_R + 9 * MiB;
constexpr size_t WS_KT_G = WS_KT_R + 9 * MiB;
constexpr size_t WS_VT_R = WS_KT_G + 5 * MiB;
constexpr size_t WS_VT_G = WS_VT_R + 9 * MiB;
constexpr size_t WS_CUM_G = WS_VT_G + 9 * MiB;
constexpr size_t WS_CUMT_G = WS_CUM_G + 17 * MiB;
constexpr size_t WS_US_R = WS_CUMT_G + 17 * MiB;
constexpr size_t WS_US_G = WS_US_R + 34 * MiB;
constexpr size_t WS_UG_R = WS_US_G + 17 * MiB;
constexpr size_t WS_UG_G = WS_UG_R + 5 * MiB;
constexpr size_t WS_AG = WS_UG_G + 3 * MiB;
constexpr size_t WS_ROPE = WS_AG + 1 * MiB;
constexpr size_t WS_FSPEC = WS_ROPE + 1 * MiB;
constexpr size_t WS_ZT = WS_FSPEC + 32 * MiB;
constexpr size_t WS_YT = WS_ZT + 16 * MiB;
constexpr size_t WS_X0B = WS_YT + 16 * MiB;
constexpr size_t WS_MODP = WS_X0B + 8 * MiB;
constexpr size_t WS_PS = WS_MODP + 4 * MiB;
constexpr size_t WS_ZC = WS_PS + 1 * MiB;
constexpr size_t WS_X0C = WS_ZC + 1 * MiB;
constexpr size_t WS_HB8 = WS_X0C + 1 * MiB;
constexpr size_t WS_WLIST = WS_HB8 + 17 * MiB;
constexpr size_t WS_END = WS_WLIST + 3 * MiB;
constexpr int CW_CNT = 1024;
constexpr int CW_NORM = 2048;

struct P {
    const float *x, *c, *ctx, *c_ctx, *w_mod, *b_mod, *norm_g, *w_in, *w_out, *diff_lambda, *diff_subln_g, *hy_short_w, *hy_short_b,
        *hy_w1, *hy_b1, *hy_w2, *hy_b2, *hy_w3, *hy_freq, *hy_bias, *ret_decay, *ret_norm_g, *gla_gate_w, *gla_gate_b, *gla_norm_g,
        *router_w, *router_b, *exp_w1, *exp_b1, *exp_w2, *exp_b2;
    float* out; unsigned char* ws;
};
typedef const __attribute__((address_space(4))) P* KP;
#define KP_PTR(kp_) ((KP)((unsigned long long)(kp_) & ~7ull))
#define p (*KP_PTR(kp))
#define WSP(T, off) ((T*)(p.ws + (off)))

__device__ __forceinline__ float wave_sum(float v) {
#pragma unroll
    for (int o = 1; o < 64; o <<= 1) v += __shfl_xor(v, o);
    return v;
}
__device__ __forceinline__ float silu_f(float x) { return x / (1.f + expf(-x)); }
__host__ __device__ __forceinline__ int nrows_l(int l) { return l == 0 ? MALL : NLAT; }
__device__ __forceinline__ int mod_r(int row) { return row < NLAT ? row / SEQ : 4; }
__device__ __forceinline__ void seq_info(int row, int& base, int& n, int& t) {
    if (row < NLAT) { base = row & ~(SEQ - 1); n = SEQ; t = row - base; }
    else { int r = row - NLAT; base = NLAT + (r & ~(CTXL - 1)); n = CTXL; t = row - base; }
}

#define XB_TMO      128
#define XB_XCNT(j)  (256  + 64 * (j))
#define XB_XSUB(j)  (1280 + 64 * (j))
#define XB_XGEN(j)  (2304 + 64 * (j))
#define XB_TOP      3328
#define XB_TOPGEN   3392
#define XCD_BAR_WORDS 3456
#define XB_SPIN_CAP (1u << 22)
#define LAS __attribute__((address_space(3)))
__device__ __forceinline__ unsigned xb_ld(unsigned* ptr)            { return __hip_atomic_load(ptr, __ATOMIC_RELAXED, __HIP_MEMORY_SCOPE_AGENT); }
__device__ __forceinline__ unsigned xb_add(unsigned* ptr, unsigned v) { return __hip_atomic_fetch_add(ptr, v, __ATOMIC_RELAXED, __HIP_MEMORY_SCOPE_AGENT); }
__device__ __forceinline__ unsigned xb_xcc_id() { return (unsigned)__builtin_amdgcn_s_getreg((3 << 11) | 20) & 0xFu; }
#define XB_SPIN(cond, bar) do { unsigned _sp = 0; while (cond) { __builtin_amdgcn_s_sleep(1); \
    if ((++_sp & 255u) == 0u) { if (xb_ld(&(bar)[XB_TMO])) break; if (_sp > XB_SPIN_CAP) { atomicAdd(&(bar)[XB_TMO], 1u); break; } } } } while (0)
struct XcdBarrier { unsigned* bar; unsigned x; volatile LAS unsigned* st; };
__device__ __forceinline__ XcdBarrier xcd_barrier_post(unsigned* bar, volatile LAS unsigned* st) {
    XcdBarrier b; b.bar = bar; b.x = xb_xcc_id(); b.st = st;
    if (threadIdx.x == 0) (void)xb_add(&bar[XB_XCNT(b.x)], 1u);
    return b;
}
__device__ __forceinline__ void xcd_barrier_complete(unsigned* bar, unsigned x, unsigned& nloc, unsigned& nx) {
    const unsigned G = gridDim.x * gridDim.y * gridDim.z;
    unsigned sum, cnt, mine, sp = 0u;
    for (;;) {
        sum = 0u; cnt = 0u; mine = 0u;
#pragma unroll
        for (unsigned j = 0; j < 16; ++j) { const unsigned c = xb_ld(&bar[XB_XCNT(j)]); sum += c; cnt += (c > 0u) ? 1u : 0u; mine = (j == x) ? c : mine; }
        if (sum == G) break;
        __builtin_amdgcn_s_sleep(1);
        if ((++sp & 255u) == 0u) { if (xb_ld(&bar[XB_TMO])) break; if (sp > XB_SPIN_CAP) { atomicAdd(&bar[XB_TMO], 1u); break; } }
    }
    nloc = mine > 0u ? mine : 1u; nx = cnt > 0u ? cnt : 1u;
}
__device__ __forceinline__ void xcd_barrier(const XcdBarrier& b, bool thread0) {
    asm volatile("s_waitcnt vmcnt(0)" ::: "memory");
    __syncthreads();
    if (thread0) {
        unsigned* bar = b.bar;
        __builtin_amdgcn_s_waitcnt(0);
        unsigned nloc = b.st[0], nx = b.st[1];
        if (nloc == 0u) { xcd_barrier_complete(bar, b.x, nloc, nx); b.st[0] = nloc; b.st[1] = nx; }
        const unsigned old = xb_add(&bar[XB_XSUB(b.x)], 1u);
        const unsigned gen = old / nloc;
        if (old + 1u == (gen + 1u) * nloc) {
            __builtin_amdgcn_fence(__ATOMIC_RELEASE, "agent");
            asm volatile("s_waitcnt vmcnt(0)" ::: "memory");
            const unsigned og = xb_add(&bar[XB_TOP], 1u);
            const unsigned tg = og / nx;
            if (og + 1u == (tg + 1u) * nx) xb_add(&bar[XB_TOPGEN], 1u);
            else XB_SPIN(xb_ld(&bar[XB_TOPGEN]) == tg, bar);
            __builtin_amdgcn_fence(__ATOMIC_ACQUIRE, "agent");
            xb_add(&bar[XB_XGEN(b.x)], 1u);
            asm volatile("s_waitcnt vmcnt(0)" ::: "memory");
        } else {
            XB_SPIN(xb_ld(&bar[XB_XGEN(b.x)]) == gen, bar);
            __builtin_amdgcn_fence(__ATOMIC_ACQUIRE, "agent");
            asm volatile("s_waitcnt vmcnt(0)" ::: "memory");
        }
    }
    __syncthreads();
}

constexpr int NT = 512;
extern __shared__ __attribute__((aligned(16))) unsigned char g_lds[];
constexpr int LDS_BYTES = 147456;
constexpr int LDS_MISC = LDS_BYTES - 64;
__device__ __forceinline__ int ltid_kp(KP kp) {
    const int w = (int)((unsigned long long)kp & 7ull);
    unsigned ones = ~0u; asm volatile("" : "+s"(ones));
    int t = (w << 6) | (int)__builtin_amdgcn_mbcnt_hi(ones, __builtin_amdgcn_mbcnt_lo(ones, 0u));
    asm volatile("" : "+v"(t)); return t;
}
__device__ __forceinline__ int lbid() { int b = blockIdx.x; asm volatile("" : "+s"(b)); return b; }
#define PH_IDS const int tid = ltid_kp(kp), bid = lbid(); (void)tid; (void)bid
#define GT_LOOP(idx, total) for (int idx = bid * NT + tid; idx < (total); idx += gridDim.x * NT)
#define GW_LOOP(w, total) for (int w = bid * (NT / 64) + (tid >> 6); w < (total); w += gridDim.x * (NT / 64))

__device__ __forceinline__ const float* xin_row(KP kp, int l, int row) {
    (void)l; return row < NLAT ? p.x + (size_t)row * D : p.ctx + (size_t)(row - NLAT) * D;
}
__device__ __forceinline__ void d_pro0(KP kp, LAS float* sc) {
    PH_IDS;
    GT_LOOP(idx, 64 * 24) {
        const int pos = idx / 24, j = idx % 24; float ang; float* dst;
        if (j < 8) { ang = (float)pos * powf(10000.f, -(float)j / 8.f); dst = WSP(float, WS_ROPE) + (pos * 8 + j) * 2; }
        else { ang = (float)pos * powf(10000.f, -(float)(j - 8) / 16.f); dst = WSP(float, WS_ROPE) + 1024 + (pos * 16 + (j - 8)) * 2; }
        dst[0] = cosf(ang); dst[1] = sinf(ang);
    }
    GT_LOOP(idx, 2 * 1024 * 256) {
        int n = idx & 255, i = (idx >> 8) & 1023, l = idx >> 18, d = n >> 7, j = n & 127;
        float a = 0.f;
        for (int r = 0; r < 16; ++r) a += p.w_in[((size_t)l * D + i) * INW + 3328 + d * 16 + r] * p.gla_gate_w[((l * 2 + d) * 16 + r) * 128 + j];
        WSP(float, WS_WEFF)[idx] = a;
    }
    const int lane = tid & 63;
    for (int i = tid; i < 5 * D; i += NT) { const int r = i >> 10, ii = i & 1023; sc[i] = silu_f(r < 4 ? p.c[r * D + ii] : p.c_ctx[ii]); }
    __syncthreads();
    GW_LOOP(task, 2 * 96 * 16) {
        const int chunk = task & 15, jb = (task >> 4) % 96, l = task / (16 * 96), j = jb * 64 + lane;
        const float* w = p.w_mod + ((size_t)l * D + chunk * 64) * 6144 + j;
        float acc[5] = {0.f, 0.f, 0.f, 0.f, 0.f};
#pragma unroll 32
        for (int i = 0; i < 64; ++i) { const float wv = w[(size_t)i * 6144];
#pragma unroll
            for (int r = 0; r < 5; ++r) acc[r] += sc[r * D + chunk * 64 + i] * wv; }
#pragma unroll
        for (int r = 0; r < 5; ++r) WSP(float, WS_MODP)[((size_t)(chunk * 2 + l) * 5 + r) * 6144 + j] = acc[r];
    }
}
__device__ __forceinline__ void d_filter(KP kp, LAS float* sm) {
    PH_IDS;
    const int lane = tid & 63; LAS float* zf = sm + (tid >> 6) * 768; LAS float* h1 = zf + 256; LAS float* h2 = zf + 512;
    GW_LOOP(tg, (2 * SEQ + CTXL) / 4) {
        const int task0 = 4 * tg;
        const int which = task0 < SEQ ? 0 : task0 < 2 * SEQ ? 1 : 2, pos0 = task0 - (which == 2 ? 2 * SEQ : which * SEQ), l = which == 1 ? 1 : 0, n = which == 2 ? CTXL : SEQ;
        float tt[4];
#pragma unroll
        for (int pp = 0; pp < 4; ++pp) { const int pos = pos0 + pp; const float t = (float)pos / (float)(n - 1), w = (6.2831855f * (float)pos) / (float)n; tt[pp] = t;
            if (lane < 33) { float v = t; if (lane >= 1) { const int q = (lane - 1) & 15; const float f = 1e-4f + (15.f - 1e-4f) * ((float)q / 15.f), a = w * f; v = lane < 17 ? cosf(a) : -sinf(a); } zf[pp * 64 + lane] = v; } }
        asm volatile("s_waitcnt lgkmcnt(0)" ::: "memory");
        float a[4];
        { const float b = p.hy_b1[l * 64 + lane];
#pragma unroll
          for (int pp = 0; pp < 4; ++pp) a[pp] = b; }
#pragma unroll 3
        for (int i = 0; i < 33; ++i) { const float wv = p.hy_w1[(l * 33 + i) * 64 + lane];
#pragma unroll
            for (int pp = 0; pp < 4; ++pp) a[pp] += zf[pp * 64 + i] * wv; }
        { const float fr = p.hy_freq[(l * 2 + 0) * 64 + lane];
#pragma unroll
          for (int pp = 0; pp < 4; ++pp) h1[pp * 64 + lane] = sinf(fr * a[pp]); }
        asm volatile("s_waitcnt lgkmcnt(0)" ::: "memory");
        { const float b = p.hy_b2[l * 64 + lane];
#pragma unroll
          for (int pp = 0; pp < 4; ++pp) a[pp] = b; }
#pragma unroll 4
        for (int i = 0; i < 64; ++i) { const float wv = p.hy_w2[(l * 64 + i) * 64 + lane];
#pragma unroll
            for (int pp = 0; pp < 4; ++pp) a[pp] += h1[pp * 64 + i] * wv; }
        { const float fr = p.hy_freq[(l * 2 + 1) * 64 + lane];
#pragma unroll
          for (int pp = 0; pp < 4; ++pp) h2[pp * 64 + lane] = sinf(fr * a[pp]); }
        asm volatile("s_waitcnt lgkmcnt(0)" ::: "memory");
        float raw[4][8];
#pragma unroll
        for (int pp = 0; pp < 4; ++pp)
#pragma unroll
            for (int q = 0; q < 8; ++q) raw[pp][q] = 0.f;
#pragma unroll 2
        for (int j = 0; j < 64; ++j) { const float* w3 = p.hy_w3 + (size_t)(l * 64 + j) * 512 + lane; float wv[8];
#pragma unroll
            for (int q = 0; q < 8; ++q) wv[q] = w3[q * 64];
#pragma unroll
            for (int pp = 0; pp < 4; ++pp) { const float hj = h2[pp * 64 + j];
#pragma unroll
                for (int q = 0; q < 8; ++q) raw[pp][q] += hj * wv[q]; } }
        const float mind = logf(1e-2f) / 1.5f, maxd = logf(1e-2f) / 0.3f;
#pragma unroll
        for (int q = 0; q < 8; ++q) {
            const int c = (q & 3) * 64 + lane;
            float v[4];
#pragma unroll
            for (int pp = 0; pp < 4; ++pp) v[pp] = raw[pp][q] * expf(-tt[pp] * fabsf(mind + (maxd - mind) * ((float)c / 255.f)));
            if (which == 2) {
                float* filt = WSP(float, WS_FILTC);
#pragma unroll
                for (int pp = 0; pp < 4; ++pp) { const int pos = pos0 + pp;
                    if (q < 4) { filt[(size_t)pos * 256 + c] = v[pp]; if (pos == 0) filt[(size_t)n * 256 + c] = 0.f; }
                    else if (pos >= 1) filt[(size_t)(2 * n - pos) * 256 + c] = v[pp]; }
            } else {
                float* fc = WSP(float, WS_FILT) + ((size_t)l * 256 + c) * 8192;
                if (q < 4) { *(gv4f*)(fc + pos0) = (gv4f){v[0], v[1], v[2], v[3]}; if (pos0 == 0) fc[n] = 0.f; }
                else {
#pragma unroll
                    for (int pp = 0; pp < 4; ++pp) { const int pos = pos0 + pp; if (pos >= 1) fc[2 * n - pos] = v[pp]; } }
            }
        }
        asm volatile("s_waitcnt lgkmcnt(0)" ::: "memory");
    }
}
__device__ __forceinline__ void d_pro1(KP kp) {
    PH_IDS;
    GT_LOOP(idx, 2 * 5 * 6144) {
        const int j = idx % 6144, r = (idx / 6144) % 5, l = idx / (6144 * 5);
        float a = p.b_mod[l * 6144 + j];
#pragma unroll
        for (int ch = 0; ch < 16; ++ch) a += WSP(float, WS_MODP)[((size_t)(ch * 2 + l) * 5 + r) * 6144 + j];
        WSP(float, WS_MOD)[idx] = a;
    }
    GT_LOOP(idx, 512 * 256) {
        const int slab = idx & 255, c = (idx >> 8) & 255, which = idx >> 16;
        const float* fc = WSP(float, WS_FILT) + ((size_t)which * 256 + c) * 8192 + slab * 32;
        float a = 0.f;
#pragma unroll 8
        for (int i = 0; i < 32; ++i) a += fabsf(fc[i]);
        WSP(float, WS_PS)[(which * 256 + slab) * 256 + c] = a;
    }
    GT_LOOP(idx, 16 * 256) {
        const int slab = idx >> 8, c = idx & 255;
        const float* filt = WSP(float, WS_FILTC);
        float a = 0.f;
#pragma unroll 8
        for (int i = 0; i < 32; ++i) a += fabsf(filt[(size_t)(slab * 32 + i) * 256 + c]);
        WSP(float, WS_PS)[(2 * 256 + slab) * 256 + c] = a;
    }
}
__device__ __forceinline__ void d_norm1(KP kp, int l) {
    PH_IDS;
    const int lane = tid & 63;
    GW_LOOP(qd, MALL >> 2) {
        const int row0 = 4 * qd;
        const float* mod = WSP(float, WS_MOD) + (size_t)(l * 5 + mod_r(row0)) * 6144;
        const float* g = p.norm_g + (l * 4 + 0) * D;
        gv4f v[4][4], gg[4], gs[4], gh[4]; float ss[4];
#pragma unroll
        for (int rr = 0; rr < 4; ++rr) { const float* xr = xin_row(kp, l, row0 + rr);
#pragma unroll
            for (int j = 0; j < 4; ++j) v[rr][j] = *(const gv4f*)(xr + j * 256 + lane * 4); }
#pragma unroll
        for (int j = 0; j < 4; ++j) { const int ci = j * 256 + lane * 4; gg[j] = *(const gv4f*)(g + ci); gs[j] = *(const gv4f*)(mod + 1024 + ci); gh[j] = *(const gv4f*)(mod + ci); }
#pragma unroll
        for (int rr = 0; rr < 4; ++rr) { ss[rr] = 0.f;
#pragma unroll
            for (int j = 0; j < 4; ++j)
#pragma unroll
                for (int q = 0; q < 4; ++q) ss[rr] += v[rr][j][q] * v[rr][j][q]; }
        float rstd[4];
#pragma unroll
        for (int rr = 0; rr < 4; ++rr) rstd[rr] = rsqrtf(wave_sum(ss[rr]) * (1.f / D) + EPS);
#pragma unroll
        for (int rr = 0; rr < 4; ++rr) { unsigned char* hb = WSP(unsigned char, WS_HB) + (size_t)(row0 + rr) * D + lane * 4;
#pragma unroll
            for (int j = 0; j < 4; ++j) { float o[4];
#pragma unroll
                for (int q = 0; q < 4; ++q) o[q] = v[rr][j][q] * rstd[rr] * gg[j][q] * (1.f + gs[j][q]) + gh[j][q];
                *(unsigned*)(hb + j * 256) = pk4_fp8(o[0], o[1], o[2], o[3]); } }
    }
}
__device__ __forceinline__ void d_router(KP kp, int l, LAS float* sm) {
    PH_IDS;
    const int lane = tid & 63;
    { gv4f wt[16];
#pragma unroll
      for (int q = 0; q < 16; ++q) wt[q] = *(const gv4f*)(p.router_w + (size_t)l * D * NEXP + (size_t)(tid + q * NT) * 4);
#pragma unroll
      for (int q = 0; q < 16; ++q) { const int i = tid + q * NT, k = i >> 3, c = i & 7, r = (k >> 8) * 256 + (k & 3) * 64 + ((k >> 2) & 63);
          *(LAS gv4f*)((LAS unsigned char*)sm + r * 128 + 16 * (c ^ ((r >> 1) & 7))) = wt[q]; } }
    LAS int* lcnt = (LAS int*)(sm + 32768); LAS int* lbase = lcnt + 32; LAS int* rec = lcnt + 64;
    LAS float* ws = (LAS float*)(rec + 512) + (tid >> 6) * 128;
    LAS float* recw = (LAS float*)(rec + 512) + 8 * 128;
    if (tid < 32) lcnt[tid] = 0;
    __syncthreads();
    typedef float gv2f __attribute__((ext_vector_type(2)));
    int it = 0;
    GW_LOOP(pr, nrows_l(l) >> 1) {
        const int row0 = 2 * pr;
        const float* mod = WSP(float, WS_MOD) + (size_t)(l * 5 + mod_r(row0)) * 6144 + lane * 4;
        const float* g1 = p.norm_g + (l * 4 + 1) * D + lane * 4; const float* g2 = p.norm_g + (l * 4 + 2) * D + lane * 4;
        float xv[2][16];
#pragma unroll
        for (int rr = 0; rr < 2; ++rr) {
            const int row = row0 + rr;
            float yv[16], ss = 0.f;
            { const bf16_t* y = WSP(bf16_t, WS_YBUF) + (size_t)row * D + lane * 4;
#pragma unroll
              for (int j = 0; j < 4; ++j) { const gv2u w = *(const gv2u*)(y + j * 256); yv[4 * j] = gblo(w.x); yv[4 * j + 1] = gbhi(w.x); yv[4 * j + 2] = gblo(w.y); yv[4 * j + 3] = gbhi(w.y); } }
            if (l == 0) { const float* xs = (row < NLAT ? p.x + (size_t)row * D : p.ctx + (size_t)(row - NLAT) * D) + lane * 4;
#pragma unroll
                for (int j = 0; j < 4; ++j) { const gv4f t = *(const gv4f*)(xs + j * 256); xv[rr][4 * j] = t[0]; xv[rr][4 * j + 1] = t[1]; xv[rr][4 * j + 2] = t[2]; xv[rr][4 * j + 3] = t[3]; } }
            else { const bf16_t* xs = WSP(bf16_t, WS_XRES) + (size_t)row * D + lane * 4;
#pragma unroll
                for (int j = 0; j < 4; ++j) { const gv2u w = *(const gv2u*)(xs + j * 256); xv[rr][4 * j] = gblo(w.x); xv[rr][4 * j + 1] = gbhi(w.x); xv[rr][4 * j + 2] = gblo(w.y); xv[rr][4 * j + 3] = gbhi(w.y); } }
            gv4f ga[4], gn[4];
#pragma unroll
            for (int j = 0; j < 4; ++j) { ga[j] = *(const gv4f*)(mod + 2048 + j * 256); gn[j] = *(const gv4f*)(g1 + j * 256); }
#pragma unroll
            for (int j = 0; j < 16; ++j) ss += yv[j] * yv[j];
            float rstd = rsqrtf(wave_sum(ss) * (1.f / D) + EPS);
            ss = 0.f;
#pragma unroll
            for (int j = 0; j < 16; ++j) { xv[rr][j] = xv[rr][j] + ga[j >> 2][j & 3] * (yv[j] * rstd * gn[j >> 2][j & 3]); ss += xv[rr][j] * xv[rr][j]; }
            gv4f gsc[4], gsh[4];
#pragma unroll
            for (int j = 0; j < 4; ++j) { const gv4f a = *(const gv4f*)(g2 + j * 256), b = *(const gv4f*)(mod + 4096 + j * 256); gsh[j] = *(const gv4f*)(mod + 3072 + j * 256);
#pragma unroll
                for (int q = 0; q < 4; ++q) gsc[j][q] = a[q] * (1.f + b[q]); }
            { bf16_t* xr = WSP(bf16_t, WS_XRES) + (size_t)row * D + lane * 4;
#pragma unroll
              for (int j = 0; j < 4; ++j) *(gv2u*)(xr + j * 256) = (gv2u){cvtpk_rne(xv[rr][4 * j], xv[rr][4 * j + 1]), cvtpk_rne(xv[rr][4 * j + 2], xv[rr][4 * j + 3])}; }
            rstd = rsqrtf(wave_sum(ss) * (1.f / D) + EPS);
            unsigned char* hb = WSP(unsigned char, WS_HB8) + (size_t)row * D + lane * 4;
#pragma unroll
            for (int j = 0; j < 4; ++j) {
#pragma unroll
                for (int q = 0; q < 4; ++q) xv[rr][4 * j + q] = xv[rr][4 * j + q] * rstd * gsc[j][q] + gsh[j][q];
                *(unsigned*)(hb + j * 256) = pk4_fp8(xv[rr][4 * j], xv[rr][4 * j + 1], xv[rr][4 * j + 2], xv[rr][4 * j + 3]); }
        }
        __builtin_amdgcn_sched_barrier(0);
        gv2f v2[2][16];
#pragma unroll
        for (int rr = 0; rr < 2; ++rr)
#pragma unroll
            for (int e = 0; e < 16; ++e) v2[rr][e] = (gv2f){0.f, 0.f};
        { const LAS unsigned char* wb = (const LAS unsigned char*)sm + lane * 128; const int sw = (lane >> 1) & 7;
#define RT_PKFMA(acc, hp, wp, HI) asm("v_pk_fma_f32 %0, %1, %2, %0 op_sel:[" HI ",0,0] op_sel_hi:[" HI ",1,1]" : "+v"(acc) : "v"(hp), "v"(wp))
          gv2f xp[2][8];
#pragma unroll
          for (int rr = 0; rr < 2; ++rr)
#pragma unroll
            for (int m = 0; m < 8; ++m) xp[rr][m] = (gv2f){xv[rr][2 * m], xv[rr][2 * m + 1]};
          gv4f wbuf[2][8];
#define RT_WLD(dst, jq_) do { _Pragma("unroll") for (int c_ = 0; c_ < 8; ++c_) dst[c_] = *(const LAS gv4f*)(wb + (((jq_) >> 2) * 256 + ((jq_) & 3) * 64) * 128 + 16 * (c_ ^ sw)); } while (0)
          RT_WLD(wbuf[0], 0);
#pragma unroll
          for (int jq = 0; jq < 16; ++jq) {
            if (jq + 1 < 16) RT_WLD(wbuf[(jq + 1) & 1], jq + 1);
            __builtin_amdgcn_sched_barrier(0);
#pragma unroll
            for (int c = 0; c < 8; ++c) { const gv4f w = wbuf[jq & 1][c];
                const gv2f wl = (gv2f){w[0], w[1]}, wh = (gv2f){w[2], w[3]};
                if (jq & 1) { RT_PKFMA(v2[0][2 * c], xp[0][jq >> 1], wl, "1"); RT_PKFMA(v2[0][2 * c + 1], xp[0][jq >> 1], wh, "1"); RT_PKFMA(v2[1][2 * c], xp[1][jq >> 1], wl, "1"); RT_PKFMA(v2[1][2 * c + 1], xp[1][jq >> 1], wh, "1"); }
                else { RT_PKFMA(v2[0][2 * c], xp[0][jq >> 1], wl, "0"); RT_PKFMA(v2[0][2 * c + 1], xp[0][jq >> 1], wh, "0"); RT_PKFMA(v2[1][2 * c], xp[1][jq >> 1], wl, "0"); RT_PKFMA(v2[1][2 * c + 1], xp[1][jq >> 1], wh, "0"); } }
            __builtin_amdgcn_sched_barrier(0); } }
#undef RT_WLD
#undef RT_PKFMA
        float tvv[2][4]; int tii[2][4];
        __builtin_amdgcn_sched_barrier(0);
#pragma unroll
        for (int rr = 0; rr < 2; ++rr) {
            float v[32];
#pragma unroll
            for (int e = 0; e < 16; ++e) { v[2 * e] = v2[rr][e][0]; v[2 * e + 1] = v2[rr][e][1]; }
#pragma unroll
            for (int k = 0; k < 16; ++k) { const auto r_ = __builtin_amdgcn_permlane32_swap(__float_as_uint(v[k]), __float_as_uint(v[k + 16]), false, false); v[k] = __uint_as_float(r_[0]) + __uint_as_float(r_[1]); }
#pragma unroll
            for (int k = 0; k < 8; ++k) { const auto r_ = __builtin_amdgcn_permlane16_swap(__float_as_uint(v[k]), __float_as_uint(v[k + 8]), false, false); v[k] = __uint_as_float(r_[0]) + __uint_as_float(r_[1]); }
#pragma unroll
            for (int k = 0; k < 4; ++k) { const bool up = lane & 8; const float send = up ? v[k] : v[k + 4], keep = up ? v[k + 4] : v[k]; v[k] = keep + __shfl_xor(send, 8); }
#pragma unroll
            for (int k = 0; k < 2; ++k) { const bool up = lane & 4; const float send = up ? v[k] : v[k + 2], keep = up ? v[k + 2] : v[k]; v[k] = keep + __shfl_xor(send, 4); }
            { const bool up = lane & 2; const float send = up ? v[0] : v[1], keep = up ? v[1] : v[0]; v[0] = keep + __shfl_xor(send, 2); }
            const int myexp = lane >> 1;
            const float mylogit = v[0] + __shfl_xor(v[0], 1) + p.router_b[l * NEXP + myexp];
            LAS float* wsr = ws + rr * 64;
            if (!(lane & 1)) wsr[myexp] = mylogit;
            int rank = 0;
#pragma unroll
            for (int c = 0; c < 8; ++c) { const gv4f o = *(const LAS gv4f*)(wsr + 4 * c);
#pragma unroll
                for (int q = 0; q < 4; ++q) rank += (int)(o[q] > mylogit) | ((int)(o[q] == mylogit) & (int)(4 * c + q < myexp)); }
            if (!(lane & 1) && rank < 4) { wsr[32 + rank] = mylogit; ((LAS int*)wsr)[36 + rank] = myexp; }
            const gv4f wv = *(const LAS gv4f*)(wsr + 32); const gv4u wi = *(const LAS gv4u*)(wsr + 36);
#pragma unroll
            for (int k = 0; k < 4; ++k) { tvv[rr][k] = wv[k]; tii[rr][k] = (int)wi[k]; }
        }
#pragma unroll
        for (int rr = 0; rr < 2; ++rr) {
            const int row = row0 + rr;
            float den = 0.f, w[4];
#pragma unroll
            for (int k = 0; k < 4; ++k) { w[k] = expf(tvv[rr][k] - tvv[rr][0]); den += w[k]; }
            if (lane < 4) {
                const int e = lane == 0 ? tii[rr][0] : lane == 1 ? tii[rr][1] : lane == 2 ? tii[rr][2] : tii[rr][3];
                const float ww = (lane == 0 ? w[0] : lane == 1 ? w[1] : lane == 2 ? w[2] : w[3]) / den;
                const int lr = __hip_atomic_fetch_add(&lcnt[e], 1, __ATOMIC_RELAXED, __HIP_MEMORY_SCOPE_WORKGROUP);
                const int ri = ((it * 8 + (tid >> 6)) * 2 + rr) * 4 + lane;
                rec[ri] = (e << 16) | lr; recw[ri] = ww;
                WSP(float, WS_TOPW)[row * 4 + lane] = ww;
                WSP(int, WS_TOPI)[row * 4 + lane] = e;
            }
        }
        ++it;
    }
    asm volatile("s_waitcnt lgkmcnt(0)" ::: "memory");
    __syncthreads();
    if (tid < 32) lbase[tid] = (int)atomicAdd(WSP(unsigned, WS_CTL) + CW_CNT + (l * 32 + tid) * 64, (unsigned)lcnt[tid]);
    asm volatile("s_waitcnt vmcnt(0) lgkmcnt(0)" ::: "memory");
    __syncthreads();
    it = 0;
    GW_LOOP(pr, nrows_l(l) >> 1) {
        if (lane < 8) { const int rr = lane >> 2, k = lane & 3, row = 2 * pr + rr, ri = ((it * 8 + (tid >> 6)) * 2 + rr) * 4 + k; const int rc = rec[ri], e = rc >> 16, pos = lbase[e] + (rc & 0xffff);
            WSP(int, WS_LIST)[(size_t)e * MALL + pos] = row * 4 + k; WSP(int, WS_TOPI)[MALL * 4 + row * 4 + k] = pos;
            WSP(float, WS_WLIST)[(size_t)e * MALL + pos] = recw[ri]; }
        ++it;
    }
    __syncthreads();
}
__device__ __forceinline__ void d_combine(KP kp, int l, LAS int* aoffs) {
    PH_IDS;
    const int lane = tid & 63;
    const unsigned* cnt = WSP(unsigned, WS_CTL) + CW_CNT + l * 32 * 64;
    if (tid == 0) { int a = 0; for (int e = 0; e < 32; ++e) { aoffs[e] = a; a += ((int)cnt[e * 64] + 255) & ~255; } }
    __syncthreads();
    const int npair = nrows_l(l) >> 1, pr0 = bid * (NT / 64) + (tid >> 6), pstep = gridDim.x * (NT / 64);
    int een[2][4], ppn[2][4];
#define CMB_REC(pr_) do { _Pragma("unroll") for (int rr_ = 0; rr_ < 2; ++rr_) _Pragma("unroll") for (int k_ = 0; k_ < 4; ++k_) { \
        een[rr_][k_] = WSP(int, WS_TOPI)[(2 * (pr_) + rr_) * 4 + k_]; ppn[rr_][k_] = WSP(int, WS_TOPI)[MALL * 4 + (2 * (pr_) + rr_) * 4 + k_]; } } while (0)
    if (pr0 < npair) CMB_REC(pr0);
#pragma unroll 1
    for (int pr = pr0; pr < npair; pr += pstep) {
        const int row0 = 2 * pr;
        int ee[2][4], pp[2][4];
#pragma unroll
        for (int rr = 0; rr < 2; ++rr)
#pragma unroll
            for (int k = 0; k < 4; ++k) { ee[rr][k] = een[rr][k]; pp[rr][k] = ppn[rr][k]; }
        gv4u yv[2][4][2];
#pragma unroll
        for (int rr = 0; rr < 2; ++rr)
#pragma unroll
            for (int k = 0; k < 4; ++k) { const gv4u* ys = (const gv4u*)(WSP(bf16_t, WS_YSLOT) + (size_t)(aoffs[ee[rr][k]] + pp[rr][k]) * D) + lane; yv[rr][k][0] = ys[0]; yv[rr][k][1] = ys[64]; }
        { const int prn = pr + pstep < npair ? pr + pstep : pr; CMB_REC(prn); }
        const float* mod = WSP(float, WS_MOD) + (size_t)(l * 5 + mod_r(row0)) * 6144;
        const float* g3 = p.norm_g + (l * 4 + 3) * D;
        gv4f xo[2][4], gm[4], gg[4];
#pragma unroll
        for (int rr = 0; rr < 2; ++rr) { const bf16_t* xr = WSP(bf16_t, WS_XRES) + (size_t)(row0 + rr) * D;
          const gv4u x0 = *(const gv4u*)(xr + lane * 8), x1 = *(const gv4u*)(xr + 512 + lane * 8);
          xo[rr][0] = (gv4f){gblo(x0[0]), gbhi(x0[0]), gblo(x0[1]), gbhi(x0[1])}; xo[rr][1] = (gv4f){gblo(x0[2]), gbhi(x0[2]), gblo(x0[3]), gbhi(x0[3])};
          xo[rr][2] = (gv4f){gblo(x1[0]), gbhi(x1[0]), gblo(x1[1]), gbhi(x1[1])}; xo[rr][3] = (gv4f){gblo(x1[2]), gbhi(x1[2]), gblo(x1[3]), gbhi(x1[3])}; }
#pragma unroll
        for (int q8 = 0; q8 < 4; ++q8) { const int ci = (q8 >> 1) * 512 + lane * 8 + (q8 & 1) * 4; gm[q8] = *(const gv4f*)(mod + 5120 + ci); gg[q8] = *(const gv4f*)(g3 + ci); }
        float n0[16], n1[16], n2[16];
        if (l < DEPTH - 1) {
            const float* mod2 = WSP(float, WS_MOD) + (size_t)((l + 1) * 5 + mod_r(row0)) * 6144; const float* g0 = p.norm_g + ((l + 1) * 4 + 0) * D;
#pragma unroll
            for (int q8 = 0; q8 < 4; ++q8) { const int ci = (q8 >> 1) * 512 + lane * 8 + (q8 & 1) * 4; const gv4f a = *(const gv4f*)(g0 + ci), b2 = *(const gv4f*)(mod2 + 1024 + ci), c2 = *(const gv4f*)(mod2 + ci);
#pragma unroll
                for (int q = 0; q < 4; ++q) { n0[q8 * 4 + q] = a[q]; n1[q8 * 4 + q] = b2[q]; n2[q8 * 4 + q] = c2[q]; } }
        }
        float acc[2][16], ss[2];
#pragma unroll
        for (int rr = 0; rr < 2; ++rr) {
#pragma unroll
            for (int j = 0; j < 16; ++j) acc[rr][j] = 0.f;
#pragma unroll
            for (int k = 0; k < 4; ++k)
#pragma unroll
                for (int hf = 0; hf < 2; ++hf)
#pragma unroll
                    for (int q = 0; q < 4; ++q) { acc[rr][hf * 8 + 2 * q] += gblo(yv[rr][k][hf][q]); acc[rr][hf * 8 + 2 * q + 1] += gbhi(yv[rr][k][hf][q]); }
            ss[rr] = 0.f;
#pragma unroll
            for (int j = 0; j < 16; ++j) ss[rr] += acc[rr][j] * acc[rr][j];
        }
        float rstd[2] = {rsqrtf(wave_sum(ss[0]) * (1.f / D) + EPS), rsqrtf(wave_sum(ss[1]) * (1.f / D) + EPS)};
#pragma unroll
        for (int rr = 0; rr < 2; ++rr) {
            ss[rr] = 0.f;
#pragma unroll
            for (int q8 = 0; q8 < 4; ++q8) {
                const int ci = (q8 >> 1) * 512 + lane * 8 + (q8 & 1) * 4;
                gv4f vv;
#pragma unroll
                for (int q = 0; q < 4; ++q) { const float v = xo[rr][q8][q] + gm[q8][q] * (acc[rr][q8 * 4 + q] * rstd[rr] * gg[q8][q]); vv[q] = v; acc[rr][q8 * 4 + q] = v; ss[rr] += v * v; }
                if (l == DEPTH - 1) *(gv4f*)(p.out + (size_t)(row0 + rr) * D + ci) = vv;
            }
            if (l < DEPTH - 1) { bf16_t* xr = WSP(bf16_t, WS_XRES) + (size_t)(row0 + rr) * D;
#pragma unroll
                for (int hf = 0; hf < 2; ++hf) { gv4u o;
#pragma unroll
                    for (int q = 0; q < 4; ++q) o[q] = cvtpk_rne(acc[rr][hf * 8 + 2 * q], acc[rr][hf * 8 + 2 * q + 1]);
                    *(gv4u*)(xr + hf * 512 + lane * 8) = o; }
            }
        }
        if (l < DEPTH - 1) {
            rstd[0] = rsqrtf(wave_sum(ss[0]) * (1.f / D) + EPS); rstd[1] = rsqrtf(wave_sum(ss[1]) * (1.f / D) + EPS);
#pragma unroll
            for (int rr = 0; rr < 2; ++rr) { unsigned char* hb = WSP(unsigned char, WS_HB) + (size_t)(row0 + rr) * D;
#pragma unroll
                for (int hf = 0; hf < 2; ++hf) {
                    float o[8];
#pragma unroll
                    for (int q = 0; q < 8; ++q) { const int i0 = hf * 8 + q; o[q] = acc[rr][i0] * rstd[rr] * n0[i0] * (1.f + n1[i0]) + n2[i0]; }
                    *(gv2u*)(hb + hf * 512 + lane * 8) = (gv2u){pk4_fp8(o[0], o[1], o[2], o[3]), pk4_fp8(o[4], o[5], o[6], o[7])};
                } }
        }
    }
#undef CMB_REC
    __syncthreads();
}

namespace pg8 {
typedef short bf16x8 __attribute__((ext_vector_type(8)));
typedef float f32x4 __attribute__((ext_vector_type(4)));
typedef unsigned u32x4 __attribute__((ext_vector_type(4)));
typedef unsigned u32x2 __attribute__((ext_vector_type(2)));
constexpr int BM = 256, BK = 64, HALF = 128, HTB = HALF * BK * 2, STAGE_BYTES = 8 * HTB, NXCD = 8, WGM = 8, K = 1024;
__host__ __device__ __forceinline__ int lds_byte(int r, int c) { const int st = (r >> 4) * 2 + (c >> 5), rr = r & 15, cc = c & 31, ob = rr * 64 + cc * 2; return st * 1024 + (ob ^ (((ob >> 9) & 1) << 5)); }
__host__ __device__ __forceinline__ void stage_rc(int b, int& R, int& C) { const int st = b / 1024, sb = b % 1024, swz = sb ^ (((sb >> 9) & 1) << 5); R = (st >> 1) * 16 + swz / 64; C = (st & 1) * 32 + (swz % 64) / 2; }
__host__ __device__ __forceinline__ int perm32(int rho) { const int n = rho >> 4, i = rho & 15; return 8 * (i >> 2) + 4 * n + (i & 3); }
__device__ __forceinline__ unsigned cvt_pk_bf16(float lo, float hi) { return cvtpk_rne(lo, hi); }

struct Unit { int pm, pn; const char* A; const char* B; const int* gl; int gcnt; int e; int row0; };

struct DenseOrder {
    int nM, nN, nwg, G, c, rb; const char* A; const char* Bt;
    __device__ __forceinline__ void init(int M, int N, int G_, int c_, const void* A_, const void* Bt_, int rb_ = K * 2) { nM = M / BM; nN = N / BM; nwg = nM * nN; G = G_; c = c_; rb = rb_; A = (const char*)A_; Bt = (const char*)Bt_; }
    __device__ __forceinline__ bool next(int i, Unit& u) const {
        const long L = (long)i * G + c; if (L >= nwg) return false;
        int wgid = (int)L; { const int q = nwg / NXCD, r = nwg % NXCD, xcd = wgid % NXCD, off = wgid / NXCD; wgid = (xcd < r ? xcd * (q + 1) : r * (q + 1) + (xcd - r) * q) + off; }
        const int nig = WGM * nN, gid = wgid / nig, fm = gid * WGM, gsz = (nM - fm) < WGM ? (nM - fm) : WGM;
        u.pm = fm + ((wgid % nig) % gsz); u.pn = (wgid % nig) / gsz;
        u.A = A + (size_t)u.pm * (BM * rb); u.B = Bt + (size_t)u.pn * (BM * rb); u.gl = nullptr; u.gcnt = BM; u.e = 0; u.row0 = u.pm * BM; return true;
    }
};
struct MoeOrder {
    const LAS int* tab; int G, c, NCT; const char* A; const char* W; size_t wstride; const int* list; const unsigned* cnt; bool gather; int rowb;
    __device__ __forceinline__ bool next(int i, Unit& u) const {
        const LAS int* U = tab + 160;
        const int xg = c & 7, T = U[32], lo = (xg * T) >> 3, hi = ((xg + 1) * T) >> 3;
        const int L = __builtin_amdgcn_readfirstlane(lo + (c >> 3) + (G >> 3) * i);
        if (L >= hi) return false;
        int eb = 0;
#pragma unroll
        for (int st = 16; st >= 1; st >>= 1) if (L >= U[eb + st]) eb += st;
        const int e = __builtin_amdgcn_readfirstlane(eb);
        const int r = __builtin_amdgcn_readfirstlane(L - U[e]), ce = __builtin_amdgcn_readfirstlane(tab[120 + e]), rte = (ce + 255) >> 8, ro = __builtin_amdgcn_readfirstlane(tab[33 + e]);
        const int ct = r / rte, rt = r - ct * rte;
        u.pm = rt; u.pn = ct; u.e = e; u.row0 = ro + rt * 256; u.gl = list + (size_t)e * MALL + rt * 256; u.gcnt = min(256, ce - rt * 256);
        u.A = gather ? A : A + (size_t)u.row0 * rowb; u.B = W + (size_t)e * wstride + (size_t)ct * BM * rowb; return true;
    }
};
__device__ __forceinline__ void moe_tab_build(LAS int* tab, const unsigned* cnt, int NCT, int tid) {
    if (tid < 32) tab[120 + tid] = (int)cnt[tid * 64];
    asm volatile("s_waitcnt vmcnt(0) lgkmcnt(0)" ::: "memory");
    __syncthreads();
    if (tid == 0) {
        int rs = 0; for (int e = 0; e < 32; ++e) { tab[33 + e] = rs; rs += ((tab[120 + e] + 255) >> 8) * 256; } tab[65] = rs;
        int us = 0; for (int e = 0; e < 32; ++e) { tab[160 + e] = us; us += ((tab[120 + e] + 255) >> 8) * NCT; } tab[192] = us;
    }
    __syncthreads();
}

#define PG8_EPI_DMA(gp, lp) __builtin_amdgcn_global_load_lds((const unsigned*)(gp), (LAS unsigned*)(lp), 16, 0, 0)
struct EpiBf16 {
    static constexpr bool PERM = true; bf16_t* O; int ldc; const float* bias; float scale;
    __device__ __forceinline__ void stage(const Unit& u, LAS unsigned char* eb, int wid, int lane) const { if (bias && wid == 0) PG8_EPI_DMA(bias + u.pn * BM + lane * 4, eb); }
    __device__ __forceinline__ void operator()(const f32x4 (&acc)[2][2][4][2], const Unit& u, int wr, int wc, int fr, int fq, const LAS unsigned char* eb) const {
        const int row0 = u.row0 + wr * 64 + fr, col0 = u.pn * BM + wc * 32 + 8 * fq;
        f32x4 bv[2][2];
#pragma unroll
        for (int bj = 0; bj < 2; ++bj)
#pragma unroll
            for (int n = 0; n < 2; ++n) bv[bj][n] = bias ? *(const LAS f32x4*)(eb + (wc * 32 + 8 * fq + bj * HALF + 4 * n) * 4) : (f32x4){0.f, 0.f, 0.f, 0.f};
#pragma unroll
        for (int ai = 0; ai < 2; ++ai)
#pragma unroll
            for (int m = 0; m < 4; ++m) { bf16_t* rowp = O + (size_t)(row0 + ai * HALF + m * 16) * ldc + col0;
#pragma unroll
                for (int bj = 0; bj < 2; ++bj) { const f32x4 v0 = acc[ai][bj][m][0] * scale + bv[bj][0], v1 = acc[ai][bj][m][1] * scale + bv[bj][1];
                    u32x4 w; w.x = cvt_pk_bf16(v0[0], v0[1]); w.y = cvt_pk_bf16(v0[2], v0[3]); w.z = cvt_pk_bf16(v1[0], v1[1]); w.w = cvt_pk_bf16(v1[2], v1[3]);
                    *(u32x4*)(rowp + bj * HALF) = w; } }
    }
};
struct EpiF32 {
    static constexpr bool PERM = false; float* O; int ldc;
    __device__ __forceinline__ void stage(const Unit&, LAS unsigned char*, int, int) const { }
    __device__ __forceinline__ void operator()(const f32x4 (&acc)[2][2][4][2], const Unit& u, int wr, int wc, int fr, int fq, const LAS unsigned char*) const {
        const int row0 = u.row0 + wr * 64 + fr, col0 = u.pn * BM + wc * 32 + 4 * fq;
#pragma unroll
        for (int ai = 0; ai < 2; ++ai)
#pragma unroll
            for (int m = 0; m < 4; ++m) { float* rowp = O + (size_t)(row0 + ai * HALF + m * 16) * ldc + col0;
#pragma unroll
                for (int bj = 0; bj < 2; ++bj)
#pragma unroll
                    for (int n = 0; n < 2; ++n) *(f32x4*)(rowp + bj * HALF + n * 16) = acc[ai][bj][m][n]; }
    }
};
struct EpiMoeUp {
    static constexpr bool PERM = true; unsigned char* ACT; const float* b1all;
    __device__ __forceinline__ void stage(const Unit& u, LAS unsigned char* eb, int wid, int lane) const { if (wid == 0) PG8_EPI_DMA(b1all + (size_t)u.e * 2048 + u.pn * BM + lane * 4, eb); }
    __device__ __forceinline__ void operator()(const f32x4 (&acc)[2][2][4][2], const Unit& u, int wr, int wc, int fr, int fq, const LAS unsigned char* eb) const {
        const int col0 = u.pn * BM + wc * 32 + 8 * fq;
        f32x4 bv[2][2];
#pragma unroll
        for (int bj = 0; bj < 2; ++bj)
#pragma unroll
            for (int n = 0; n < 2; ++n) bv[bj][n] = *(const LAS f32x4*)(eb + (wc * 32 + 8 * fq + bj * HALF + 4 * n) * 4);
#pragma unroll
        for (int ai = 0; ai < 2; ++ai)
#pragma unroll
            for (int m = 0; m < 4; ++m) { unsigned char* rowp = ACT + (size_t)(u.row0 + wr * 64 + fr + ai * HALF + m * 16) * 1024 + (col0 >> 1);
#pragma unroll
                for (int bj = 0; bj < 2; ++bj) { const f32x4 v0 = acc[ai][bj][m][0] * (1.f / W8_SCALE) + bv[bj][0], v1 = acc[ai][bj][m][1] * (1.f / W8_SCALE) + bv[bj][1];
                    float a[4];
#pragma unroll
                    for (int j = 0; j < 4; ++j) { const float gl = fminf(j < 2 ? v0[2 * j] : v1[2 * j - 4], 7.f), ln = fminf(fmaxf(j < 2 ? v0[2 * j + 1] : v1[2 * j - 3], -7.f), 7.f);
                        a[j] = gl * __builtin_amdgcn_rcpf(1.f + __builtin_amdgcn_exp2f(-1.702f * 1.4426950408889634f * gl)) * (ln + 1.f); }
                    *(unsigned*)(rowp + bj * 64) = pk4_fp8(a[0], a[1], a[2], a[3]); } }
    }
};
struct EpiMoeDown {
    static constexpr bool PERM = true; bf16_t* Y; const float* b2all; const float* wlist; const int* list0;
    __device__ __forceinline__ void stage(const Unit& u, LAS unsigned char* eb, int wid, int lane) const {
        if (wid == 0) PG8_EPI_DMA(b2all + (size_t)u.e * 1024 + u.pn * BM + lane * 4, eb);
        if (wid == 1) PG8_EPI_DMA(wlist + (u.gl - list0) + lane * 4, eb + 1024); }
    __device__ __forceinline__ void operator()(const f32x4 (&acc)[2][2][4][2], const Unit& u, int wr, int wc, int fr, int fq, const LAS unsigned char* eb) const {
        const int col0 = u.pn * BM + wc * 32 + 8 * fq;
        f32x4 bv[2][2];
#pragma unroll
        for (int bj = 0; bj < 2; ++bj)
#pragma unroll
            for (int n = 0; n < 2; ++n) bv[bj][n] = *(const LAS f32x4*)(eb + (wc * 32 + 8 * fq + bj * HALF + 4 * n) * 4);
#pragma unroll
        for (int ai = 0; ai < 2; ++ai)
#pragma unroll
            for (int m = 0; m < 4; ++m) { const int r = wr * 64 + fr + ai * HALF + m * 16; const float twl = *(const LAS float*)(eb + 1024 + r * 4); const float tw = r < u.gcnt ? twl : 0.f;
                bf16_t* rowp = Y + (size_t)(u.row0 + r) * 1024 + col0;
#pragma unroll
                for (int bj = 0; bj < 2; ++bj) { const f32x4 v0 = (acc[ai][bj][m][0] * (1.f / W8_SCALE) + bv[bj][0]) * tw, v1 = (acc[ai][bj][m][1] * (1.f / W8_SCALE) + bv[bj][1]) * tw;
                    u32x4 w; w.x = cvt_pk_bf16(v0[0], v0[1]); w.y = cvt_pk_bf16(v0[2], v0[3]); w.z = cvt_pk_bf16(v1[0], v1[1]); w.w = cvt_pk_bf16(v1[2], v1[3]);
                    *(u32x4*)(rowp + bj * HALF) = w; } }
    }
};

typedef int v8i __attribute__((ext_vector_type(8)));
typedef int v4i __attribute__((ext_vector_type(4)));
template <class Epi, class Sched, bool GATHER, bool ALIGN_EPI, bool F8 = false>
__device__ __forceinline__ void gphase(LAS unsigned char* lds, const Sched& S, const Epi& E, const int tid) {
    const int wid = __builtin_amdgcn_readfirstlane(tid >> 6), lane = tid & 63, wr = wid >> 2, wc = wid & 3, fr = lane & 15, fq = lane >> 4;
    constexpr int ROWB = F8 ? K : K * 2, nt = ROWB / 128, KSTR = F8 ? 16 : 1024;
    unsigned voffB[2], CA2[2]; int RA[2];
#pragma unroll
    for (int i = 0; i < 2; ++i) { int R, C; stage_rc(tid * 16 + i * 8192, R, C); const int Rb = Epi::PERM ? ((R & ~31) + perm32(R & 31)) : R;
        RA[i] = R; CA2[i] = (unsigned)C * 2u; voffB[i] = (unsigned)(Rb * ROWB + C * 2); }
    constexpr size_t kstep = (size_t)(BK * 2), hstep = (size_t)HALF * ROWB;
    const unsigned ldsw = (unsigned)wid * 1024u;
    const int aoff = lds_byte(wr * 64 + fr, fq * 8), boff = lds_byte(wc * 32 + fr, fq * 8);
#define PG8_SA(b, h) (((b) * 2 + (h)) * HTB)
#define PG8_SB(b, h) ((4 + (b) * 2 + (h)) * HTB)
#define PG8_GL(gp, ldsoff) __builtin_amdgcn_global_load_lds((const unsigned*)(gp), (LAS unsigned*)(lds + (ldsoff)), 16, 0, 0)
#define PG8_STB(bufoff, gbase) do { PG8_GL((const char*)(gbase) + voffB[0], (bufoff) + ldsw); PG8_GL((const char*)(gbase) + voffB[1], (bufoff) + ldsw + 8192); } while (0)
#define PG8_STA(bufoff, gbase, o) do { PG8_GL((const char*)(gbase) + (o)[0], (bufoff) + ldsw); PG8_GL((const char*)(gbase) + (o)[1], (bufoff) + ldsw + 8192); } while (0)
#define PG8_LDA(dst, b, h) do { _Pragma("unroll") for (int m = 0; m < 4; ++m) { if constexpr (F8) { const v4i lo_ = *(const LAS v4i*)(lds + PG8_SA(b, h) + aoff + m * 2048), hi_ = *(const LAS v4i*)(lds + PG8_SA(b, h) + aoff + m * 2048 + 1024); dst##8[m] = __builtin_shufflevector(lo_, hi_, 0, 1, 2, 3, 4, 5, 6, 7); } else { _Pragma("unroll") for (int k = 0; k < 2; ++k) dst[m][k] = *(const LAS bf16x8*)(lds + PG8_SA(b, h) + aoff + m * 2048 + k * KSTR); } } } while (0)
#define PG8_LDB(dst, b, h) do { _Pragma("unroll") for (int n = 0; n < 2; ++n) { if constexpr (F8) { const v4i lo_ = *(const LAS v4i*)(lds + PG8_SB(b, h) + boff + n * 2048), hi_ = *(const LAS v4i*)(lds + PG8_SB(b, h) + boff + n * 2048 + 1024); dst##8[n] = __builtin_shufflevector(lo_, hi_, 0, 1, 2, 3, 4, 5, 6, 7); } else { _Pragma("unroll") for (int k = 0; k < 2; ++k) dst[n][k] = *(const LAS bf16x8*)(lds + PG8_SB(b, h) + boff + n * 2048 + k * KSTR); } } } while (0)
#define PG8_MMA(ai, bj, At, Bt) do { __builtin_amdgcn_s_setprio(1); _Pragma("unroll") for (int m = 0; m < 4; ++m) _Pragma("unroll") for (int n = 0; n < 2; ++n) { \
        if constexpr (F8) asm volatile("v_mfma_scale_f32_16x16x128_f8f6f4 %0, %1, %2, %0, %3, %3 op_sel_hi:[0,0,0]" : "+v"(acc[ai][bj][m][n]) : "v"(Bt##8[n]), "v"(At##8[m]), "v"(f8scale) : "memory"); \
        else { _Pragma("unroll") for (int k = 0; k < 2; ++k) acc[ai][bj][m][n] = __builtin_amdgcn_mfma_f32_16x16x32_bf16(Bt[n][k], At[m][k], acc[ai][bj][m][n], 0, 0, 0); } } \
        __builtin_amdgcn_s_setprio(0); } while (0)
#define PG8_WAIT_V(n) asm volatile("s_waitcnt vmcnt(" #n ")" ::: "memory")
#define PG8_WAIT_L(n) asm volatile("s_waitcnt lgkmcnt(" #n ")" ::: "memory")
#define PG8_BAR __builtin_amdgcn_s_barrier()
#define PG8_SCHED __builtin_amdgcn_sched_barrier(0)
#define PG8_AOFFS(u, o) do { _Pragma("unroll") for (int h_ = 0; h_ < 2; ++h_) _Pragma("unroll") for (int i_ = 0; i_ < 2; ++i_) { \
        if (GATHER) { const int r_ = h_ * 128 + RA[i_]; const int rc_ = r_ < (u).gcnt ? r_ : (u).gcnt - 1; const int tok_ = (u).gl[rc_] >> 2; o[h_][i_] = (unsigned)tok_ * (unsigned)ROWB + CA2[i_]; } \
        else o[h_][i_] = (unsigned)((h_ * 128 + RA[i_]) * ROWB) + CA2[i_]; } } while (0)
    Unit cur, nxt; int ui = 0;
    if (!S.next(0, cur)) return;
    f32x4 acc[2][2][4][2];
#pragma unroll
    for (int a = 0; a < 2; ++a)
#pragma unroll
        for (int b = 0; b < 2; ++b)
#pragma unroll
            for (int m = 0; m < 4; ++m)
#pragma unroll
                for (int n = 0; n < 2; ++n) acc[a][b][m][n] = (f32x4){0.f, 0.f, 0.f, 0.f};
    int f8scale = 0x7f7f7f7f; asm volatile("" : "+v"(f8scale));
    bf16x8 At[F8 ? 1 : 4][2], B0[F8 ? 1 : 2][2], B1[F8 ? 1 : 2][2]; v8i At8[F8 ? 4 : 1], B08[F8 ? 2 : 1], B18[F8 ? 2 : 1];
    (void)At; (void)B0; (void)B1; (void)At8; (void)B08; (void)B18;
    unsigned oAc[2][2], oAn[2][2];
    PG8_AOFFS(cur, oAc);
    const char* cA = cur.A; const char* cB = cur.B;
    PG8_STB(PG8_SB(0, 0), cB); PG8_STB(PG8_SB(0, 1), cB + hstep); PG8_STA(PG8_SA(0, 0), cA, oAc[0]); PG8_STA(PG8_SA(0, 1), cA, oAc[1]);
    if (wr == 1) PG8_BAR;
    PG8_WAIT_V(2); PG8_BAR;
    PG8_STB(PG8_SB(1, 0), cB + kstep); PG8_STA(PG8_SA(1, 0), cA + kstep, oAc[0]); PG8_STB(PG8_SB(1, 1), cB + hstep + kstep);
    PG8_WAIT_V(6); PG8_BAR;
    for (;;) {
        const bool has_next = S.next(ui + 1, nxt);
        LAS unsigned char* const ebuf = lds + STAGE_BYTES + 1024 + (ui & 1) * 2048;
        E.stage(cur, ebuf, wid, lane);
        const char* nA = has_next ? nxt.A : cA; const char* nB = has_next ? nxt.B : cB;
        if (has_next) { PG8_AOFFS(nxt, oAn); } else {
#pragma unroll
            for (int h = 0; h < 2; ++h) { oAn[h][0] = oAc[h][0]; oAn[h][1] = oAc[h][1]; } }
#pragma unroll 1
        for (int t = 0; t < nt; t += 2) {
            const bool last = (t == nt - 2);
            const char* a1 = cA + (size_t)(t + 1) * kstep;
            const char* a2 = last ? nA : cA + (size_t)(t + 2) * kstep; const char* b2 = last ? nB : cB + (size_t)(t + 2) * kstep;
            const char* a3 = a2 + kstep; const char* b3 = b2 + kstep;
            unsigned o2[2][2];
#pragma unroll
            for (int h = 0; h < 2; ++h) { o2[h][0] = oAc[h][0]; o2[h][1] = oAc[h][1]; }
            if (last) {
                asm volatile("" ::: "memory");
#pragma unroll
                for (int h = 0; h < 2; ++h) { o2[h][0] = oAn[h][0]; o2[h][1] = oAn[h][1]; }
            }
            PG8_LDB(B0, 0, 0); PG8_LDB(B1, 0, 1); PG8_SCHED; PG8_LDA(At, 0, 0); PG8_STA(PG8_SA(1, 1), a1, oAc[1]);
            PG8_WAIT_V(8); PG8_WAIT_L(0); PG8_BAR; PG8_MMA(0, 0, At, B0); PG8_MMA(0, 1, At, B1); PG8_BAR; PG8_SCHED;
            PG8_LDA(At, 0, 1); PG8_STB(PG8_SB(0, 0), b2); PG8_STB(PG8_SB(0, 1), b2 + hstep); PG8_STA(PG8_SA(0, 0), a2, o2[0]);
            PG8_WAIT_V(8); PG8_WAIT_L(0); PG8_BAR; PG8_MMA(1, 0, At, B0); PG8_MMA(1, 1, At, B1); PG8_BAR; PG8_SCHED;
            PG8_LDB(B0, 1, 0); PG8_LDB(B1, 1, 1); PG8_SCHED; PG8_LDA(At, 1, 0); PG8_STA(PG8_SA(0, 1), a2, o2[1]);
            PG8_WAIT_V(8); PG8_WAIT_L(0); PG8_BAR; PG8_MMA(0, 0, At, B0); PG8_MMA(0, 1, At, B1); PG8_BAR; PG8_SCHED;
            PG8_LDA(At, 1, 1); PG8_STB(PG8_SB(1, 0), b3); PG8_STB(PG8_SB(1, 1), b3 + hstep); PG8_STA(PG8_SA(1, 0), a3, o2[0]);
            PG8_WAIT_V(8); PG8_WAIT_L(0); PG8_BAR; PG8_MMA(1, 0, At, B0); PG8_MMA(1, 1, At, B1); PG8_BAR; PG8_SCHED;
        }
        if constexpr (F8) asm volatile("s_nop 15\n\ts_nop 15" ::: "memory");
        if constexpr (ALIGN_EPI) { if (wr == 0) PG8_BAR; }
        E(acc, cur, wr, wc, fr, fq, ebuf);
        if (!has_next) break;
#pragma unroll
        for (int a = 0; a < 2; ++a)
#pragma unroll
            for (int b = 0; b < 2; ++b)
#pragma unroll
                for (int m = 0; m < 4; ++m)
#pragma unroll
                    for (int n = 0; n < 2; ++n) acc[a][b][m][n] = (f32x4){0.f, 0.f, 0.f, 0.f};
        cur = nxt; cA = nA; cB = nB; ++ui;
#pragma unroll
        for (int h = 0; h < 2; ++h) { oAc[h][0] = oAn[h][0]; oAc[h][1] = oAn[h][1]; }
        if constexpr (ALIGN_EPI) { if (wr == 1) PG8_BAR; }
    }
    PG8_WAIT_V(0);
    if constexpr (!ALIGN_EPI) { if (wr == 0) PG8_BAR; }
    PG8_BAR;
#undef PG8_SA
#undef PG8_SB
#undef PG8_GL
#undef PG8_STA
#undef PG8_STB
#undef PG8_LDA
#undef PG8_LDB
#undef PG8_MMA
#undef PG8_WAIT_V
#undef PG8_WAIT_L
#undef PG8_BAR
#undef PG8_SCHED
#undef PG8_AOFFS
}
}

__device__ __forceinline__ unsigned pk2(float lo, float hi) { return (unsigned)f2bf(lo) | ((unsigned)f2bf(hi) << 16); }
__device__ __forceinline__ void transpose_item(const float* W, int ld, int nblk, bf16_t* WT, LAS float* scr, int item, int lane) {
    const int kb = item / nblk, nb = item - kb * nblk, k0 = 64 * kb, n0 = 32 * nb;
#pragma unroll 8
    for (int i = 0; i < 32; ++i) { const int kk = 2 * i + (lane >> 5); scr[kk * 33 + (lane & 31)] = W[(size_t)(k0 + kk) * ld + n0 + (lane & 31)]; }
    asm volatile("s_waitcnt lgkmcnt(0)" ::: "memory");
    const int c = lane & 7;
#pragma unroll
    for (int j = 0; j < 4; ++j) { const int n = (lane >> 3) + 8 * j; const LAS float* s = scr + (8 * c) * 33 + n;
        pg8::u32x4 o; o.x = pk2(s[0 * 33], s[1 * 33]); o.y = pk2(s[2 * 33], s[3 * 33]); o.z = pk2(s[4 * 33], s[5 * 33]); o.w = pk2(s[6 * 33], s[7 * 33]);
        *(pg8::u32x4*)(WT + (size_t)(n0 + n) * 1024 + k0 + 8 * c) = o; }
    asm volatile("s_waitcnt lgkmcnt(0)" ::: "memory");
}
__device__ __forceinline__ void transpose_item8(const float* W, int ld, int nblk, unsigned char* WT, LAS float* scr, int item, int lane) {
    const int kb = item / nblk, nb = item - kb * nblk, k0 = 64 * kb, n0 = 32 * nb;
#pragma unroll 8
    for (int i = 0; i < 32; ++i) { const int kk = 2 * i + (lane >> 5); scr[kk * 33 + (lane & 31)] = W[(size_t)(k0 + kk) * ld + n0 + (lane & 31)]; }
    asm volatile("s_waitcnt lgkmcnt(0)" ::: "memory");
    const int c = lane & 3;
#pragma unroll
    for (int j = 0; j < 2; ++j) { const int n = (lane >> 2) + 16 * j; const LAS float* sp = scr + (16 * c) * 33 + n;
        pg8::u32x4 o;
#pragma unroll
        for (int q = 0; q < 4; ++q) o[q] = pk4_fp8(sp[(4 * q) * 33] * W8_SCALE, sp[(4 * q + 1) * 33] * W8_SCALE, sp[(4 * q + 2) * 33] * W8_SCALE, sp[(4 * q + 3) * 33] * W8_SCALE);
        *(pg8::u32x4*)(WT + (size_t)(n0 + n) * 1024 + k0 + 16 * c) = o; }
    asm volatile("s_waitcnt lgkmcnt(0)" ::: "memory");
}
__device__ __forceinline__ void d_convert_a(KP kp, LAS float* scr_all) {
    PH_IDS;
    const int lane = tid & 63; LAS float* scr = scr_all + (tid >> 6) * (64 * 33);
    constexpr int I_IN = 16 * 104, I_OUT = 16 * 32, I_W1 = 16 * 64, I_W2 = 16 * 32, I_L = I_IN + I_OUT + 32 * I_W1 + 32 * I_W2;
    GW_LOOP(it, 2 * I_L) {
        const int l = it / I_L; int r = it - l * I_L;
        if (r < I_IN) { transpose_item8(p.w_in + (size_t)l * D * INW, INW, 104, WSP(unsigned char, WS_WIN_T) + (size_t)l * PW * 1024, scr, r, lane); continue; } r -= I_IN;
        if (r < I_OUT) { transpose_item8(p.w_out + (size_t)l * D * D, 1024, 32, WSP(unsigned char, WS_WOUT_T) + (size_t)l * 1024 * 1024, scr, r, lane); continue; } r -= I_OUT;
        if (r < 32 * I_W1) { const int e = r / I_W1; transpose_item8(p.exp_w1 + ((size_t)l * NEXP + e) * D * 2048, 2048, 64, WSP(unsigned char, WS_W1_T) + ((size_t)l * NEXP + e) * 2048 * 1024, scr, r - e * I_W1, lane); continue; } r -= 32 * I_W1;
        { const int e = r / I_W2; transpose_item8(p.exp_w2 + ((size_t)l * NEXP + e) * D * D, 1024, 32, WSP(unsigned char, WS_W2_T) + ((size_t)l * NEXP + e) * 1024 * 1024, scr, r - e * I_W2, lane); }
    }
    GT_LOOP(idx, 2 * PW) { const int l = idx / PW, n = idx - l * PW; WSP(float, WS_BIAS_IN)[idx] = n < 3328 ? 0.f : p.gla_gate_b[l * 256 + n - 3328]; }
}
__device__ __forceinline__ void d_convert_b(KP kp, LAS float* scr_all) {
    PH_IDS;
    const int lane = tid & 63; LAS float* scr = scr_all + (tid >> 6) * (64 * 33);
    GW_LOOP(it, 2 * 128) { const int l = it >> 7; transpose_item8(WSP(float, WS_WEFF) + (size_t)l * D * 256, 256, 8, WSP(unsigned char, WS_WIN_T) + ((size_t)l * PW + 3328) * 1024, scr, it & 127, lane); }
}

__device__ __forceinline__ void d_gemm_in(KP kp, int l, LAS unsigned char* lds) {
    PH_IDS;
    pg8::DenseOrder S; S.init(MALL, PW, gridDim.x, bid, WSP(unsigned char, WS_HB), WSP(unsigned char, WS_WIN_T) + (size_t)l * PW * 1024, pg8::K);
    pg8::EpiBf16 E{WSP(bf16_t, WS_PBUF), PW, WSP(float, WS_BIAS_IN) + l * PW, 1.f / W8_SCALE};
    pg8::gphase<pg8::EpiBf16, pg8::DenseOrder, false, true, true>(lds, S, E, tid);
}
__device__ __forceinline__ void d_gemm_out(KP kp, int l, LAS unsigned char* lds) {
    PH_IDS;
    pg8::DenseOrder S; S.init(nrows_l(l), 1024, gridDim.x, bid, WSP(unsigned char, WS_CONCAT), WSP(unsigned char, WS_WOUT_T) + (size_t)l * 1024 * 1024, pg8::K);
    pg8::EpiBf16 E{WSP(bf16_t, WS_YBUF), 1024, nullptr, 1.f / W8_SCALE};
    pg8::gphase<pg8::EpiBf16, pg8::DenseOrder, false, true, true>(lds, S, E, tid);
}
__device__ __forceinline__ void d_moe_up(KP kp, int l, LAS unsigned char* lds) {
    PH_IDS;
    LAS int* tab = (LAS int*)(lds + pg8::STAGE_BYTES);
    const unsigned* cnt = WSP(unsigned, WS_CTL) + CW_CNT + l * 32 * 64;
    pg8::moe_tab_build(tab, cnt, 8, tid);
    pg8::MoeOrder S{tab, (int)gridDim.x, bid, 8, (const char*)WSP(unsigned char, WS_HB8), (const char*)(WSP(unsigned char, WS_W1_T) + (size_t)l * NEXP * 2048 * 1024), (size_t)2048 * 1024, WSP(int, WS_LIST), cnt, true, 1024};
    pg8::EpiMoeUp E{WSP(unsigned char, WS_ACT), p.exp_b1 + (size_t)l * NEXP * 2048};
    pg8::gphase<pg8::EpiMoeUp, pg8::MoeOrder, true, true, true>(lds, S, E, tid);
}
__device__ __forceinline__ void d_moe_down(KP kp, int l, LAS unsigned char* lds) {
    PH_IDS;
    LAS int* tab = (LAS int*)(lds + pg8::STAGE_BYTES);
    const unsigned* cnt = WSP(unsigned, WS_CTL) + CW_CNT + l * 32 * 64;
    pg8::moe_tab_build(tab, cnt, 4, tid);
    pg8::MoeOrder S{tab, (int)gridDim.x, bid, 4, (const char*)WSP(unsigned char, WS_ACT), (const char*)(WSP(unsigned char, WS_W2_T) + (size_t)l * NEXP * 1024 * 1024), (size_t)1024 * 1024, WSP(int, WS_LIST), cnt, false, 1024};
    pg8::EpiMoeDown E{WSP(bf16_t, WS_YSLOT), p.exp_b2 + (size_t)l * NEXP * 1024, WSP(float, WS_WLIST), WSP(int, WS_LIST)};
    pg8::gphase<pg8::EpiMoeDown, pg8::MoeOrder, false, true, true>(lds, S, E, tid);
}

constexpr int ATT_NT = 68;
constexpr float ATT_QSCALE = 0.17677669529663687f * 1.4426950408889634f;
__device__ __forceinline__ void d_prep_attn(KP kp) {
    PH_IDS;
    const bf16_t* PB = WSP(bf16_t, WS_PBUF);
    GT_LOOP(idx, MALL * 16) {
        const int row = idx >> 4, hm = (idx >> 1) & 7, ks = idx & 1, h = hm >> 1, m = hm & 1;
        const bool lat = row < NLAT; const int t = row & (SEQ - 1);
        const int ipos = lat ? (ks == 0 ? (t >> 6) : (t & 63)) : 0;
        const int cb = h * 64 + m * 32 + ks * 16;
        const pg8::u32x4* qs = (const pg8::u32x4*)(PB + (size_t)row * PW + PC_AQ + cb);
        const pg8::u32x4* ksrc = (const pg8::u32x4*)(PB + (size_t)row * PW + PC_AK + cb);
        pg8::u32x4 qa = qs[0], qb = qs[1], ka = ksrc[0], kb = ksrc[1];
        float qv[16], kv[16];
#pragma unroll
        for (int j = 0; j < 4; ++j) { qv[2 * j] = bf2f((bf16_t)(qa[j] & 0xffff)); qv[2 * j + 1] = bf2f((bf16_t)(qa[j] >> 16)); qv[8 + 2 * j] = bf2f((bf16_t)(qb[j] & 0xffff)); qv[9 + 2 * j] = bf2f((bf16_t)(qb[j] >> 16));
                                      kv[2 * j] = bf2f((bf16_t)(ka[j] & 0xffff)); kv[2 * j + 1] = bf2f((bf16_t)(ka[j] >> 16)); kv[8 + 2 * j] = bf2f((bf16_t)(kb[j] & 0xffff)); kv[9 + 2 * j] = bf2f((bf16_t)(kb[j] >> 16)); }
        float qo[16], ko[16];
#pragma unroll
        for (int j = 0; j < 8; ++j) {
            const float* tb = WSP(float, WS_ROPE) + (ipos * 8 + j) * 2; const float cs = tb[0], sn = tb[1];
            qo[j] = qv[j] * cs - qv[j + 8] * sn; qo[j + 8] = qv[j + 8] * cs + qv[j] * sn;
            ko[j] = kv[j] * cs - kv[j + 8] * sn; ko[j + 8] = kv[j + 8] * cs + kv[j] * sn;
        }
        pg8::u32x4 o0, o1;
#pragma unroll
        for (int j = 0; j < 4; ++j) { o0[j] = pk2(qo[2 * j] * ATT_QSCALE, qo[2 * j + 1] * ATT_QSCALE); o1[j] = pk2(qo[8 + 2 * j] * ATT_QSCALE, qo[9 + 2 * j] * ATT_QSCALE); }
        pg8::u32x4* qd = (pg8::u32x4*)(WSP(bf16_t, WS_QRP) + (size_t)row * 256 + cb); qd[0] = o0; qd[1] = o1;
#pragma unroll
        for (int j = 0; j < 4; ++j) { o0[j] = pk2(ko[2 * j], ko[2 * j + 1]); o1[j] = pk2(ko[8 + 2 * j], ko[9 + 2 * j]); }
        int b, tile, key; if (lat) { b = row >> 12; tile = t >> 6; key = t & 63; } else { const int r = row - NLAT; b = r >> 8; tile = 64 + ((r & 255) >> 6); key = r & 63; }
        unsigned char* img = WSP(unsigned char, WS_KIMG) + ((size_t)(b * 4 + h) * ATT_NT + tile) * 8192 + key * 128;
        const int c0 = m * 4 + ks * 2, sw = (key >> 1) & 7;
        *(pg8::u32x4*)(img + 16 * (c0 ^ sw)) = o0; *(pg8::u32x4*)(img + 16 * ((c0 + 1) ^ sw)) = o1;
    }
    GW_LOOP(itemv, 16 * ATT_NT * 2) {
        const int item = __builtin_amdgcn_readfirstlane(itemv), d = tid & 63, half = item & 1, tile = (item >> 1) % ATT_NT, bh = item / (2 * ATT_NT), b = bh >> 2, h = bh & 3;
        const int row0 = (tile < 64 ? b * SEQ + tile * 64 : NLAT + b * CTXL + (tile - 64) * 64) + half * 32;
        const bf16_t* vp = PB + (size_t)row0 * PW + PC_AV + h * 64;
        unsigned short vv[32];
#pragma unroll
        for (int j = 0; j < 32; ++j) vv[j] = vp[(size_t)j * PW + d];
        __builtin_amdgcn_sched_barrier(0);
        unsigned char* img = WSP(unsigned char, WS_VIMG) + ((size_t)bh * ATT_NT + tile) * 8192 + d * 128; const int x = (d >> 1) & 7;
#pragma unroll
        for (int s2 = 0; s2 < 2; ++s2)
#pragma unroll
            for (int hh = 0; hh < 2; ++hh) { const int j = 4 * s2 + hh, u = 4 * half + 2 * s2 + hh;
                *(pg8::u32x4*)(img + 16 * (u ^ x)) = (pg8::u32x4){(unsigned)vv[4 * j] | ((unsigned)vv[4 * j + 1] << 16), (unsigned)vv[4 * j + 2] | ((unsigned)vv[4 * j + 3] << 16),
                                                                   (unsigned)vv[4 * j + 8] | ((unsigned)vv[4 * j + 9] << 16), (unsigned)vv[4 * j + 10] | ((unsigned)vv[4 * j + 11] << 16)}; }
    }
}

namespace att {
typedef short bf16x8 __attribute__((ext_vector_type(8)));
typedef float f32x16 __attribute__((ext_vector_type(16)));
typedef unsigned u32x4 __attribute__((ext_vector_type(4)));
typedef unsigned u32x2 __attribute__((ext_vector_type(2)));
typedef float f32x2 __attribute__((ext_vector_type(2)));
constexpr int SLOT = 8192, NSLOT = 4, LDS_K = 0, LDS_V = NSLOT * SLOT, LDS_SCR = 2 * NSLOT * SLOT;
constexpr float THR = 8.f;
__device__ __forceinline__ int crow(int r, int hi) { return (r & 3) + 8 * (r >> 2) + 4 * hi; }
__device__ __forceinline__ unsigned cvtpk(float lo, float hi) { return cvtpk_rne(lo, hi); }
__device__ __forceinline__ float xhalf_max(float v) { return fmaxf(v, __shfl_xor(v, 32)); }
}
__device__ __forceinline__ void attn_unit(KP kp, int l, int b, int h, int qt, LAS unsigned char* lds) {
    using namespace att;
    const int tid = ltid_kp(kp);
    const int lane = tid & 63, wid = __builtin_amdgcn_readfirstlane(tid >> 6), q32 = lane & 31, hi = lane >> 5;
    const int t0 = qt < 0 ? 64 : 0, t1 = ATT_NT;
    const int rowbase = (qt < 0 ? NLAT + b * CTXL : b * SEQ + qt * 256) + wid * 32;
    const unsigned char* kimg = WSP(unsigned char, WS_KIMG) + (size_t)(b * 4 + h) * ATT_NT * 8192 + wid * 1024 + lane * 16;
    const unsigned char* vimg = WSP(unsigned char, WS_VIMG) + (size_t)(b * 4 + h) * ATT_NT * 8192 + wid * 1024 + lane * 16;
    LAS float* scr = (LAS float*)(lds + LDS_SCR) + wid * 64;
#define ATT_DMA(t, slot) do { __builtin_amdgcn_global_load_lds((const unsigned*)(kimg + (size_t)(t) * 8192), (LAS unsigned*)(lds + LDS_K + (slot) * SLOT + wid * 1024), 16, 0, 0); \
                              __builtin_amdgcn_global_load_lds((const unsigned*)(vimg + (size_t)(t) * 8192), (LAS unsigned*)(lds + LDS_V + (slot) * SLOT + wid * 1024), 16, 0, 0); } while (0)
    bf16x8 qf[2][2];
    { const bf16_t* qp = WSP(bf16_t, WS_QRP) + (size_t)(rowbase + q32) * 256 + h * 64 + hi * 8;
#pragma unroll
      for (int m = 0; m < 2; ++m)
#pragma unroll
        for (int ks = 0; ks < 2; ++ks) qf[m][ks] = *(const bf16x8*)(qp + m * 32 + ks * 16); }
    asm volatile("s_waitcnt vmcnt(0)" ::: "memory");
    __builtin_amdgcn_s_barrier();
    ATT_DMA(t0, 0); ATT_DMA(t0 + 1, 1); ATT_DMA(t0 + 2, 2);
    asm volatile("s_waitcnt vmcnt(4)" ::: "memory");
    __builtin_amdgcn_s_barrier();
    f32x16 O[2][2];
#pragma unroll
    for (int m = 0; m < 2; ++m)
#pragma unroll
        for (int dh = 0; dh < 2; ++dh)
#pragma unroll
            for (int r = 0; r < 16; ++r) O[m][dh][r] = 0.f;
    float mref[2] = {0.f, 0.f}; f32x2 lsum[2] = {{0.f, 0.f}, {0.f, 0.f}};
    f32x16 negm[2];
#pragma unroll
    for (int m = 0; m < 2; ++m) {
#pragma unroll
        for (int r = 0; r < 16; ++r) negm[m][r] = 0.f;
        asm volatile("" : "+v"(negm[m])); }
    const int koff = q32 * 128, ksw = (q32 >> 1) & 7;
    int slot = 0;
    bf16x8 kf[2][2][2];
#define ATT_KLD(slot_) do { const LAS unsigned char* kb_ = lds + LDS_K + (slot_) * SLOT + koff; _Pragma("unroll") for (int m_ = 0; m_ < 2; ++m_) _Pragma("unroll") for (int kh_ = 0; kh_ < 2; ++kh_) \
        _Pragma("unroll") for (int ks_ = 0; ks_ < 2; ++ks_) kf[m_][kh_][ks_] = *(const LAS bf16x8*)(kb_ + kh_ * 4096 + 16 * ((m_ * 4 + ks_ * 2 + hi) ^ ksw)); } while (0)
    ATT_KLD(0);
#pragma unroll 1
    for (int t = t0; t < t1; ++t) {
        asm volatile("s_waitcnt vmcnt(2)" ::: "memory");
        __builtin_amdgcn_s_barrier();
        asm volatile("" ::: "memory");
        { const int s3 = (slot + 3) & 3; const int tn = t + 3 < t1 ? t + 3 : t1 - 1; ATT_DMA(tn, s3); }
        const LAS unsigned char* Vs = lds + LDS_V + slot * SLOT;
        f32x16 S[2][2];
#pragma unroll
        for (int m = 0; m < 2; ++m)
#pragma unroll
            for (int kh = 0; kh < 2; ++kh)
#pragma unroll
                for (int ks = 0; ks < 2; ++ks) {
                    if (ks == 0) S[m][kh] = __builtin_amdgcn_mfma_f32_32x32x16_bf16(kf[m][kh][ks], qf[m][ks], negm[m], 0, 0, 0);
                    else S[m][kh] = __builtin_amdgcn_mfma_f32_32x32x16_bf16(kf[m][kh][ks], qf[m][ks], S[m][kh], 0, 0, 0);
                }
        float mx[2];
#pragma unroll
        for (int m = 0; m < 2; ++m) { mx[m] = __builtin_elementwise_maximum(S[m][0][0], S[m][1][0]);
#pragma unroll
            for (int r = 1; r < 16; ++r) mx[m] = __builtin_elementwise_maximum(__builtin_elementwise_maximum(mx[m], S[m][0][r]), S[m][1][r]); }
        mx[0] = xhalf_max(mx[0]); mx[1] = xhalf_max(mx[1]);
        const bool first = (t == t0);
        if (__any(first || mx[0] > THR || mx[1] > THR)) {
#pragma unroll
            for (int m = 0; m < 2; ++m) {
                const float dl = first ? mx[m] : fmaxf(mx[m], 0.f);
                mref[m] += dl;
                { const float nm = -mref[m];
#pragma unroll
                  for (int r = 0; r < 16; ++r) negm[m][r] = nm;
                  asm volatile("" : "+v"(negm[m])); }
#pragma unroll
                for (int r = 0; r < 16; ++r) { S[m][0][r] -= dl; S[m][1][r] -= dl; }
                const float f = __builtin_amdgcn_exp2f(-dl);
                lsum[m] *= f;
                if (!first) {
                    if (hi == 0) scr[q32] = f;
                    asm volatile("s_waitcnt lgkmcnt(0)" ::: "memory");
#pragma unroll
                    for (int r = 0; r < 16; ++r) { const float fr = scr[crow(r, hi)]; O[m][0][r] *= fr; O[m][1][r] *= fr; }
                    asm volatile("s_waitcnt lgkmcnt(0)" ::: "memory");
                }
            }
        }
        bf16x8 vf[2][2][2];
#define ATT_VLD(dst, kh_) do { _Pragma("unroll") for (int sx_ = 0; sx_ < 2; ++sx_) _Pragma("unroll") for (int dh_ = 0; dh_ < 2; ++dh_) { const int d_ = dh_ * 32 + q32; \
            dst[sx_][dh_] = *(const LAS bf16x8*)(Vs + d_ * 128 + 16 * (((kh_) * 4 + sx_ * 2 + hi) ^ ((d_ >> 1) & 7))); } } while (0)
        ATT_VLD(vf[0], 0);
        __builtin_amdgcn_sched_barrier(0);
#pragma unroll
        for (int m = 0; m < 2; ++m)
#pragma unroll
            for (int c = 0; c < 4; ++c) {
                const int kh = c >> 1, sx = c & 1;
                if (m == 0 && c == 0) ATT_VLD(vf[1], 1);
                if (m == 1 && c == 3) ATT_KLD((slot + 1) & 3);
                u32x4 pk;
#pragma unroll
                for (int j = 0; j < 4; ++j) { const int r = 8 * sx + 2 * j;
                    S[m][kh][r] = __builtin_amdgcn_exp2f(S[m][kh][r]); S[m][kh][r + 1] = __builtin_amdgcn_exp2f(S[m][kh][r + 1]); lsum[m] += (f32x2){S[m][kh][r], S[m][kh][r + 1]};
                    pk[j] = cvtpk(S[m][kh][r], S[m][kh][r + 1]); }
                __builtin_amdgcn_sched_barrier(0);
#pragma unroll
                for (int dh = 0; dh < 2; ++dh) O[m][dh] = __builtin_amdgcn_mfma_f32_32x32x16_bf16(__builtin_bit_cast(bf16x8, pk), vf[kh][sx][dh], O[m][dh], 0, 0, 0);
                __builtin_amdgcn_sched_barrier(0);
            }
#undef ATT_VLD
        asm volatile("s_waitcnt lgkmcnt(0)" ::: "memory");
        slot = (slot + 1) & 3;
    }
    asm volatile("s_waitcnt vmcnt(0)" ::: "memory");
#undef ATT_DMA
#undef ATT_KLD
    float il[2][16];
    const int etid = ltid_kp(kp), elane = etid & 63, ewid = __builtin_amdgcn_readfirstlane(etid >> 6), eq32 = elane & 31, ehi = elane >> 5;
    LAS float* escr = (LAS float*)(lds + LDS_SCR) + ewid * 64;
    const float lam = *(const LAS float*)(lds + LDS_SCR + 2048), lam_init = *(const LAS float*)(lds + LDS_SCR + 2052);
    const int erowbase = (qt < 0 ? NLAT + b * CTXL : b * SEQ + qt * 256) + ewid * 32;
#pragma unroll
    for (int m = 0; m < 2; ++m) { const float lh = lsum[m].x + lsum[m].y; const float lt = lh + __shfl_xor(lh, 32); if (ehi == 0) escr[m * 32 + eq32] = 1.f / lt; }
    asm volatile("s_waitcnt lgkmcnt(0)" ::: "memory");
#pragma unroll
    for (int m = 0; m < 2; ++m)
#pragma unroll
        for (int r = 0; r < 16; ++r) il[m][r] = escr[m * 32 + crow(r, ehi)];
    asm volatile("s_waitcnt lgkmcnt(0)" ::: "memory");
    const float g0 = p.diff_subln_g[l * 64 + eq32] * (1.f - lam_init), g1 = p.diff_subln_g[l * 64 + 32 + eq32] * (1.f - lam_init);
    unsigned char* outp = WSP(unsigned char, WS_CONCAT) + (size_t)erowbase * D + h * 64 + eq32;
    float o0r[16], o1r[16], ssr[16];
#pragma unroll
    for (int r = 0; r < 16; ++r) { o0r[r] = O[0][0][r] * il[0][r] - lam * O[1][0][r] * il[1][r]; o1r[r] = O[0][1][r] * il[0][r] - lam * O[1][1][r] * il[1][r]; ssr[r] = o0r[r] * o0r[r] + o1r[r] * o1r[r]; }
#pragma unroll
    for (int x = 1; x < 32; x <<= 1)
#pragma unroll
        for (int r = 0; r < 16; ++r) ssr[r] += __shfl_xor(ssr[r], x);
#pragma unroll
    for (int r = 0; r < 16; ++r) {
        const float o0 = o0r[r], o1 = o1r[r];
        const float rstd = rsqrtf(ssr[r] * (1.f / 64.f) + EPS);
        unsigned char* op = outp + (size_t)crow(r, ehi) * D;
        op[0] = f2fp8(o0 * rstd * g0); op[32] = f2fp8(o1 * rstd * g1);
    }
}
__device__ __forceinline__ void d_attn_fast(KP kp, int l, LAS unsigned char* lds) {
    PH_IDS;
    const float* dl = p.diff_lambda + l * 4 * 32;
    float s1 = 0.f, s2 = 0.f;
    for (int i = 0; i < 32; ++i) { s1 += dl[i] * dl[32 + i]; s2 += dl[64 + i] * dl[96 + i]; }
    const float lam_init = 0.8f - 0.6f * expf(-0.3f * (float)l);
    const float lam = expf(s1) - expf(s2) + lam_init;
    if (tid == 0) { *(LAS float*)(lds + att::LDS_SCR + 2048) = lam; *(LAS float*)(lds + att::LDS_SCR + 2052) = lam_init; }
    const int G = gridDim.x, vb = (G % 8 == 0) ? (bid % 8) * (G / 8) + bid / 8 : bid;
    const int nunits = 256 + (l == 0 ? 16 : 0);
    for (int u = vb; u < nunits; u += G) {
        const bool lat_u = u < 256;
        attn_unit(kp, l, lat_u ? u >> 6 : (u - 256) >> 2, lat_u ? (u >> 4) & 3 : (u - 256) & 3, lat_u ? (u & 15) : -1, lds);
    }
    __syncthreads();
}

constexpr int NCHUNK = MALL / 64;
__device__ __forceinline__ float logsig16(float x) { const float y = __builtin_amdgcn_exp2f(-fabsf(x) * 1.4426950408889634f); return (fminf(x, 0.f) - __builtin_amdgcn_logf(1.f + y) * 0.6931471805599453f) * (1.f / 16.f); }
__device__ __forceinline__ void d_prep_scan(KP kp) {
    PH_IDS;
    const bf16_t* PB = WSP(bf16_t, WS_PBUF);
    GT_LOOP(idx, 8 * MALL) {
        const int row = idx % MALL, hk = idx / MALL, h = hk >> 1, ks = hk & 1;
        const bool lat = row < NLAT; const int t = row & (SEQ - 1);
        const int ipos = lat ? (ks == 0 ? (t >> 6) : (t & 63)) : 0;
        const int cb = h * 64 + ks * 32;
        const pg8::u32x4* qs = (const pg8::u32x4*)(PB + (size_t)row * PW + PC_RQ + cb);
        const pg8::u32x4* ksrc = (const pg8::u32x4*)(PB + (size_t)row * PW + PC_RK + cb);
        float qv[32], kv[32];
#pragma unroll
        for (int c4 = 0; c4 < 4; ++c4) { const pg8::u32x4 a = qs[c4], b4 = ksrc[c4];
#pragma unroll
            for (int j = 0; j < 4; ++j) { qv[c4 * 8 + 2 * j] = bf2f((bf16_t)(a[j] & 0xffff)); qv[c4 * 8 + 2 * j + 1] = bf2f((bf16_t)(a[j] >> 16)); kv[c4 * 8 + 2 * j] = bf2f((bf16_t)(b4[j] & 0xffff)); kv[c4 * 8 + 2 * j + 1] = bf2f((bf16_t)(b4[j] >> 16)); } }
        float qo[32], ko[32];
#pragma unroll
        for (int j = 0; j < 16; ++j) {
            const float* tb = WSP(float, WS_ROPE) + 1024 + (ipos * 16 + j) * 2; const float cs = tb[0], sn = tb[1];
            qo[j] = qv[j] * cs - qv[j + 16] * sn; qo[j + 16] = qv[j + 16] * cs + qv[j] * sn;
            ko[j] = (kv[j] * cs - kv[j + 16] * sn) * 0.125f; ko[j + 16] = (kv[j + 16] * cs + kv[j] * sn) * 0.125f;
        }
        pg8::u32x4* qd = (pg8::u32x4*)(WSP(bf16_t, WS_QF_R) + (size_t)row * 256 + cb); pg8::u32x4* kd = (pg8::u32x4*)(WSP(bf16_t, WS_KF_R) + (size_t)row * 256 + cb);
#pragma unroll
        for (int c4 = 0; c4 < 4; ++c4) { pg8::u32x4 a, b4;
#pragma unroll
            for (int j = 0; j < 4; ++j) { a[j] = pk2(qo[c4 * 8 + 2 * j], qo[c4 * 8 + 2 * j + 1]); b4[j] = pk2(ko[c4 * 8 + 2 * j], ko[c4 * 8 + 2 * j + 1]); }
            qd[c4] = a; kd[c4] = b4; }
        bf16_t* kt = WSP(bf16_t, WS_KT_R) + ((size_t)((row >> 6) * 4 + h) * 64 + ks * 32) * 64 + (row & 63);
#pragma unroll
        for (int i = 0; i < 32; ++i) kt[(size_t)i * 64] = f2bf(ko[i]);
    }
    GT_LOOP(idx, 4 * MALL) {
        const int row = idx % MALL, h = idx / MALL;
        const pg8::u32x4* ksrc = (const pg8::u32x4*)(PB + (size_t)row * PW + PC_GK + h * 32);
        bf16_t* kt = WSP(bf16_t, WS_KT_G) + ((size_t)((row >> 6) * 4 + h) * 32) * 64 + (row & 63);
#pragma unroll
        for (int c4 = 0; c4 < 4; ++c4) { const pg8::u32x4 a = ksrc[c4];
#pragma unroll
            for (int j = 0; j < 4; ++j) { kt[(size_t)(c4 * 8 + 2 * j) * 64] = (bf16_t)(a[j] & 0xffff); kt[(size_t)(c4 * 8 + 2 * j + 1) * 64] = (bf16_t)(a[j] >> 16); } }
    }
    GT_LOOP(idx, NCHUNK * 2 * 128) {
        const int hk = idx & 127, dir = (idx >> 7) & 1, cid = idx >> 8;
        const bf16_t* src = PB + (size_t)(cid * 64) * PW + PC_GD + dir * 128 + hk;
        float* cum = WSP(float, WS_CUM_G) + ((size_t)dir * MALL + cid * 64) * 128 + hk;
        float* cumt = WSP(float, WS_CUMT_G) + (((size_t)dir * NCHUNK + cid) * 128 + hk) * 64;
        float v[64];
#pragma unroll
        for (int j = 0; j < 64; ++j) v[j] = bf2f(src[(size_t)j * PW]);
#pragma unroll
        for (int j = 0; j < 64; ++j) v[j] = logsig16(v[j]);
        if (dir == 0) {
#pragma unroll
            for (int j = 1; j < 64; ++j) v[j] += v[j - 1];
        } else {
#pragma unroll
            for (int j = 62; j >= 0; --j) v[j] += v[j + 1];
        }
#pragma unroll
        for (int j = 0; j < 64; ++j) cum[(size_t)j * 128] = v[j];
#pragma unroll
        for (int j = 0; j < 16; ++j) *(pg8::f32x4*)(cumt + 4 * j) = (pg8::f32x4){v[4 * j], v[4 * j + 1], v[4 * j + 2], v[4 * j + 3]};
    }
    GW_LOOP(itemv, 2 * NCHUNK * 4 * 2) {
        const int item = __builtin_amdgcn_readfirstlane(itemv), d = tid & 63, half = item & 1, ch = (item >> 1) % (NCHUNK * 4), mx = item / (2 * NCHUNK * 4), h = ch & 3, cid = ch >> 2;
        const bf16_t* vp = PB + (size_t)(cid * 64 + half * 32) * PW + (mx == 0 ? PC_RV : PC_GV) + h * 64;
        unsigned short vv[32];
#pragma unroll
        for (int j = 0; j < 32; ++j) vv[j] = vp[(size_t)j * PW + d];
        __builtin_amdgcn_sched_barrier(0);
        unsigned char* img = WSP(unsigned char, mx == 0 ? WS_VT_R : WS_VT_G) + (size_t)ch * 8192 + d * 128; const int x = (d >> 1) & 15;
#pragma unroll
        for (int j = 0; j < 8; ++j) *(pg8::u32x2*)(img + 8 * ((half * 8 + j) ^ x)) = (pg8::u32x2){(unsigned)vv[4 * j] | ((unsigned)vv[4 * j + 1] << 16), (unsigned)vv[4 * j + 2] | ((unsigned)vv[4 * j + 3] << 16)};
    }
}

namespace scn {
typedef short bf16x8 __attribute__((ext_vector_type(8)));
typedef float f32x16 __attribute__((ext_vector_type(16)));
typedef float f32x4 __attribute__((ext_vector_type(4)));
typedef unsigned u32x4 __attribute__((ext_vector_type(4)));
typedef unsigned u32x2 __attribute__((ext_vector_type(2)));
__device__ __forceinline__ int crow(int r, int hi) { return (r & 3) + 8 * (r >> 2) + 4 * hi; }
__device__ __forceinline__ unsigned cvtpk(float lo, float hi) { return cvtpk_rne(lo, hi); }
__device__ __forceinline__ float blo(unsigned w) { return __uint_as_float(w << 16); }
__device__ __forceinline__ float bhi(unsigned w) { return __uint_as_float(w & 0xffff0000u); }
__device__ __forceinline__ bf16x8 scale8(u32x4 raw, const float (&f)[8]) {
    u32x4 o;
#pragma unroll
    for (int j = 0; j < 4; ++j) o[j] = cvtpk(blo(raw[j]) * f[2 * j], bhi(raw[j]) * f[2 * j + 1]);
    return __builtin_bit_cast(bf16x8, o);
}
template <int MX> struct Cfg;
template <> struct Cfg<0> { static constexpr int DK = 64; };
template <> struct Cfg<1> { static constexpr int DK = 32; };
}
#define SCN_EXP(x) __builtin_amdgcn_exp2f((x) * 1.4426950408889634f)
template <int MX> __device__ __forceinline__ void scan_stage1_unit(KP kp, int l, int b, int h, int g, int tid) {
    using namespace scn;
    constexpr int DK = Cfg<MX>::DK, NKT = DK / 32, NE = DK * 64 / NT;
    const int lane = tid & 63, wid = __builtin_amdgcn_readfirstlane(tid >> 6), q32 = lane & 31, hi = lane >> 5;
    const int nch = g == 8 ? 4 : 8, cid0 = g == 8 ? 256 + 4 * b : b * 64 + 8 * g;
    float* US = WSP(float, MX == 0 ? WS_US_R : WS_US_G);
    const float* CUMT = WSP(float, WS_CUMT_G);
    if (wid < nch) {
        const int cid = cid0 + wid;
        const unsigned char* vimg = WSP(unsigned char, MX == 0 ? WS_VT_R : WS_VT_G) + (size_t)(cid * 4 + h) * 8192;
        const bf16_t* ktimg = WSP(bf16_t, MX == 0 ? WS_KT_R : WS_KT_G) + (size_t)(cid * 4 + h) * DK * 64;
        bf16x8 vb[2][4];
#pragma unroll
        for (int dh = 0; dh < 2; ++dh)
#pragma unroll
            for (int s = 0; s < 4; ++s) { const int d = dh * 32 + q32, x = (d >> 1) & 15, kc = 4 * s + 2 * hi;
                u32x4 v = *(const u32x4*)(vimg + d * 128 + 16 * ((kc ^ x) >> 1));
                if (x & 1) v = (u32x4){v.z, v.w, v.x, v.y};
                vb[dh][s] = __builtin_bit_cast(bf16x8, v); }
        u32x4 raws[NKT][4];
#pragma unroll
        for (int kt = 0; kt < NKT; ++kt)
#pragma unroll
            for (int s = 0; s < 4; ++s) raws[kt][s] = *(const u32x4*)(ktimg + (size_t)(kt * 32 + q32) * 64 + 16 * s + 8 * hi);
#pragma unroll 1
        for (int dir = 0; dir < 2; ++dir) {
            float lg = 0.f; if (MX == 0) lg = -expf(p.ret_decay[(l * 2 + dir) * 4 + h]);
#pragma unroll
            for (int kt = 0; kt < NKT; ++kt) {
                f32x16 U[2];
#pragma unroll
                for (int dh = 0; dh < 2; ++dh)
#pragma unroll
                    for (int r = 0; r < 16; ++r) U[dh][r] = 0.f;
                const int k = kt * 32 + q32;
                const float* ct = CUMT + (((size_t)dir * NCHUNK + cid) * 128 + h * 32 + (k & 31)) * 64;
                float E = 0.f; if (MX == 1) E = ct[dir == 0 ? 63 : 0];
#pragma unroll
                for (int s = 0; s < 4; ++s) {
                    const int j0 = 16 * s + 8 * hi;
                    const u32x4 raw = raws[kt][s];
                    float f[8];
                    if (MX == 0) {
#pragma unroll
                        for (int jj = 0; jj < 8; ++jj) f[jj] = SCN_EXP(lg * (float)(dir == 0 ? 63 - (j0 + jj) : j0 + jj));
                    } else {
                        const f32x4 c0 = *(const f32x4*)(ct + j0), c1 = *(const f32x4*)(ct + j0 + 4);
#pragma unroll
                        for (int jj = 0; jj < 4; ++jj) { f[jj] = SCN_EXP(E - c0[jj]); f[4 + jj] = SCN_EXP(E - c1[jj]); }
                    }
                    const bf16x8 af = scale8(raw, f);
#pragma unroll
                    for (int dh = 0; dh < 2; ++dh) U[dh] = __builtin_amdgcn_mfma_f32_32x32x16_bf16(af, vb[dh][s], U[dh], 0, 0, 0);
                }
                float* up = US + ((((size_t)dir * NCHUNK + cid) * 4 + h) * DK + kt * 32 + 4 * hi) * 64 + q32;
#pragma unroll
                for (int dh = 0; dh < 2; ++dh)
#pragma unroll
                    for (int r = 0; r < 16; ++r) up[((r & 3) + 8 * (r >> 2)) * 64 + dh * 32] = U[dh][r];
            }
        }
    }
    asm volatile("s_waitcnt vmcnt(0)" ::: "memory");
    __syncthreads();
    const int k = (tid * NE) >> 6, d0 = (tid * NE) & 63;
#pragma unroll 1
    for (int dir = 0; dir < 2; ++dir) {
        float S[NE], Ap = 1.f;
#pragma unroll
        for (int e = 0; e < NE; ++e) S[e] = 0.f;
        float lg = 0.f; if (MX == 0) lg = -expf(p.ret_decay[(l * 2 + dir) * 4 + h]);
        {
            float uc[8][NE], ac[8];
#pragma unroll
            for (int cc = 0; cc < 8; ++cc) { const bool on = cc < nch; const int c = dir == 0 ? cc : nch - 1 - cc, cid = cid0 + (on ? c : 0);
                if (MX == 0) ac[cc] = SCN_EXP(lg * 64.f); else ac[cc] = SCN_EXP(CUMT[(((size_t)dir * NCHUNK + cid) * 128 + h * 32 + k) * 64 + (dir == 0 ? 63 : 0)]);
                const float* up = US + ((((size_t)dir * NCHUNK + cid) * 4 + h) * DK + k) * 64 + d0;
#pragma unroll
                for (int e = 0; e < NE; ++e) uc[cc][e] = up[e]; }
#pragma unroll
            for (int cc = 0; cc < 8; ++cc) if (cc < nch) {
#pragma unroll
                for (int e = 0; e < NE; ++e) S[e] = ac[cc] * S[e] + uc[cc][e];
                Ap *= ac[cc]; }
        }
        float* ug = WSP(float, MX == 0 ? WS_UG_R : WS_UG_G) + (((((size_t)dir * 4 + b) * 4 + h) * 9 + g) * DK + k) * 64 + d0;
#pragma unroll
        for (int e = 0; e < NE; ++e) ug[e] = S[e];
        if (d0 == 0) WSP(float, WS_AG)[((((MX * 2 + dir) * 4 + b) * 4 + h) * 9 + g) * 64 + k] = Ap;
    }
}
template <int MX> __device__ __forceinline__ void scan_stage2_unit(KP kp, int l, int b, int h, int g, LAS unsigned char* lds, int tid) {
    using namespace scn;
    constexpr int DK = Cfg<MX>::DK, NKS = DK / 16, NE = DK * 64 / NT, NCH16 = DK / 8;
    const int lane = tid & 63, wid = __builtin_amdgcn_readfirstlane(tid >> 6), q32 = lane & 31, hi = lane >> 5;
    const int nch = g == 8 ? 4 : 8, cid0 = g == 8 ? 256 + 4 * b : b * 64 + 8 * g;
    const bool act = wid < nch;
    const int cid = cid0 + (act ? wid : 0), row0 = cid * 64;
    const bf16_t* PB = WSP(bf16_t, WS_PBUF);
    const float* US = WSP(float, MX == 0 ? WS_US_R : WS_US_G);
    const float* UG = WSP(float, MX == 0 ? WS_UG_R : WS_UG_G);
    const float* CUMT = WSP(float, WS_CUMT_G);
    f32x16 o[2][2];
#pragma unroll
    for (int it = 0; it < 2; ++it)
#pragma unroll
        for (int dh = 0; dh < 2; ++dh)
#pragma unroll
            for (int r = 0; r < 16; ++r) o[it][dh][r] = 0.f;
    LAS unsigned char* myv = lds + 65536 + wid * 8192;
    { const unsigned char* vimg = WSP(unsigned char, MX == 0 ? WS_VT_R : WS_VT_G) + (size_t)(cid * 4 + h) * 8192 + lane * 16;
      u32x4 tmp[8];
#pragma unroll
      for (int i = 0; i < 8; ++i) tmp[i] = *(const u32x4*)(vimg + i * 1024);
#pragma unroll
      for (int i = 0; i < 8; ++i) *(LAS u32x4*)(myv + i * 1024 + lane * 16) = tmp[i]; }
    const int fk = (tid * NE) >> 6, fd0 = (tid * NE) & 63;
#pragma unroll 1
    for (int dir = 0; dir < 2; ++dir) {
        float lg = 0.f; if (MX == 0) lg = -expf(p.ret_decay[(l * 2 + dir) * 4 + h]);
        float S[NE];
#pragma unroll
        for (int e = 0; e < NE; ++e) S[e] = 0.f;
        if (g != 8) {
            const float* ugb = UG + (((size_t)dir * 4 + b) * 4 + h) * 9 * DK * 64 + (size_t)fk * 64 + fd0;
            const float* agb = WSP(float, WS_AG) + (((MX * 2 + dir) * 4 + b) * 4 + h) * 9 * 64 + fk;
            const int ng = dir == 0 ? g : 7 - g;
            float ug[7][NE], ag[7];
#pragma unroll
            for (int e = 0; e < NE; ++e) S[e] = ugb[(size_t)8 * DK * 64 + e];
#pragma unroll
            for (int q = 0; q < 7; ++q) { const bool on = q < ng; const int qq = on ? q : 0, gg = dir == 0 ? qq : 7 - qq; const float av = agb[gg * 64]; ag[q] = on ? av : 1.f;
#pragma unroll
                for (int e = 0; e < NE; ++e) { const float uv = ugb[(size_t)gg * DK * 64 + e]; ug[q][e] = on ? uv : 0.f; } }
#pragma unroll
            for (int q = 0; q < 7; ++q)
#pragma unroll
                for (int e = 0; e < NE; ++e) S[e] = ag[q] * S[e] + ug[q][e];
        }
        {
            float uc[8][NE], ac[8];
#pragma unroll
            for (int cc = 0; cc < 8; ++cc) { const bool on = cc < nch; const int c = dir == 0 ? cc : nch - 1 - cc, ccid = cid0 + (on ? c : 0);
                if (MX == 0) ac[cc] = SCN_EXP(lg * 64.f); else ac[cc] = SCN_EXP(CUMT[(((size_t)dir * NCHUNK + ccid) * 128 + h * 32 + fk) * 64 + (dir == 0 ? 63 : 0)]);
                const float* up = US + ((((size_t)dir * NCHUNK + ccid) * 4 + h) * DK + fk) * 64 + fd0;
#pragma unroll
                for (int e = 0; e < NE; ++e) uc[cc][e] = up[e]; }
#pragma unroll
            for (int cc = 0; cc < 8; ++cc) if (cc < nch) {
                const int c = dir == 0 ? cc : nch - 1 - cc;
                LAS unsigned char* area = lds + c * 8192;
#pragma unroll
                for (int e = 0; e < NE; ++e) { const int d = fd0 + e; const int sw = DK == 64 ? ((d >> 1) & 7) : ((d >> 2) & 3);
                    *(LAS bf16_t*)(area + d * (DK * 2) + 16 * ((fk >> 3) ^ sw) + (fk & 7) * 2) = f2bf(S[e]); }
#pragma unroll
                for (int e = 0; e < NE; ++e) S[e] = ac[cc] * S[e] + uc[cc][e];
            }
        }
        asm volatile("s_waitcnt lgkmcnt(0)" ::: "memory");
        __syncthreads();
        if (act) {
#define SCN_GEN(dst, ISQ, T2) do { const int il_ = 32 * (T2) + q32, row_ = row0 + il_; \
                _Pragma("unroll") for (int ks = 0; ks < NKS; ++ks) { const int kc0 = 16 * ks + 8 * hi; u32x4 raw_; float f_[8]; \
                    if (MX == 0) { raw_ = *(const u32x4*)(WSP(bf16_t, (ISQ) ? WS_QF_R : WS_KF_R) + (size_t)row_ * 256 + h * 64 + kc0); \
                        const float cm_ = lg * (float)(dir == 0 ? il_ + 1 : 64 - il_), e_ = SCN_EXP((ISQ) ? cm_ : -cm_); \
                        _Pragma("unroll") for (int jj = 0; jj < 8; ++jj) f_[jj] = e_; \
                    } else { raw_ = *(const u32x4*)(PB + (size_t)row_ * PW + ((ISQ) ? PC_GQ : PC_GK) + h * 32 + kc0); \
                        const float* cp_ = WSP(float, WS_CUM_G) + ((size_t)dir * MALL + row_) * 128 + h * 32 + kc0; \
                        const f32x4 c0_ = *(const f32x4*)cp_, c1_ = *(const f32x4*)(cp_ + 4); \
                        _Pragma("unroll") for (int jj = 0; jj < 4; ++jj) { f_[jj] = (ISQ) ? SCN_EXP(c0_[jj]) * 0.17677669529663687f : SCN_EXP(-c0_[jj]); f_[4 + jj] = (ISQ) ? SCN_EXP(c1_[jj]) * 0.17677669529663687f : SCN_EXP(-c1_[jj]); } } \
                    dst[ks] = scale8(raw_, f_); } } while (0)
#define SCN_TILE(JT, IT, MASKED) do { bf16x8 kf_[NKS]; SCN_GEN(kf_, false, JT); f32x16 P; \
                _Pragma("unroll") for (int r = 0; r < 16; ++r) P[r] = 0.f; \
                _Pragma("unroll") for (int ks = 0; ks < NKS; ++ks) P = __builtin_amdgcn_mfma_f32_32x32x16_bf16(kf_[ks], qf[ks], P, 0, 0, 0); \
                if (MASKED) { _Pragma("unroll") for (int r = 0; r < 16; ++r) { const int j = crow(r, hi); const bool keep = dir == 0 ? (j <= q32) : (j >= q32); P[r] = keep ? P[r] : 0.f; } } \
                _Pragma("unroll") for (int s = 0; s < 2; ++s) { u32x4 pk; \
                    _Pragma("unroll") for (int j = 0; j < 4; ++j) pk[j] = cvtpk(P[8 * s + 2 * j], P[8 * s + 2 * j + 1]); \
                    _Pragma("unroll") for (int dh = 0; dh < 2; ++dh) { const int d = dh * 32 + q32, x = (d >> 1) & 15, kc = 8 * JT + 4 * s + hi; \
                        const u32x2 v0 = *(const LAS u32x2*)(myv + d * 128 + 8 * (kc ^ x)), v1 = *(const LAS u32x2*)(myv + d * 128 + 8 * ((kc + 2) ^ x)); \
                        o[IT][dh] = __builtin_amdgcn_mfma_f32_32x32x16_bf16(__builtin_bit_cast(bf16x8, pk), __builtin_bit_cast(bf16x8, (u32x4){v0.x, v0.y, v1.x, v1.y}), o[IT][dh], 0, 0, 0); } } } while (0)
#define SCN_INTER(IT) do { const LAS unsigned char* area = lds + wid * 8192; \
                _Pragma("unroll") for (int dh = 0; dh < 2; ++dh) _Pragma("unroll") for (int ks = 0; ks < NKS; ++ks) { \
                    const int d = dh * 32 + q32, sw = DK == 64 ? ((d >> 1) & 7) : ((d >> 2) & 3); \
                    const bf16x8 sf = *(const LAS bf16x8*)(area + d * (DK * 2) + 16 * ((2 * ks + hi) ^ sw)); \
                    o[IT][dh] = __builtin_amdgcn_mfma_f32_32x32x16_bf16(qf[ks], sf, o[IT][dh], 0, 0, 0); } } while (0)
            { bf16x8 qf[NKS]; SCN_GEN(qf, true, 0);
              SCN_TILE(0, 0, true); if (dir == 1) SCN_TILE(1, 0, false);
              SCN_INTER(0); }
            asm volatile("" ::: "memory");
            { bf16x8 qf[NKS]; SCN_GEN(qf, true, 1);
              if (dir == 0) SCN_TILE(0, 1, false);
              SCN_TILE(1, 1, true);
              SCN_INTER(1); }
#undef SCN_GEN
#undef SCN_TILE
#undef SCN_INTER
        }
        asm volatile("s_waitcnt lgkmcnt(0)" ::: "memory");
        __syncthreads();
    }
    if (act) {
        const int gcol = (MX == 0 ? PC_RG : PC_GR) + h * 64, ccol = (MX == 0 ? 512 : 768) + h * 64;
        const float g0 = MX == 0 ? p.ret_norm_g[l * 256 + h * 64 + q32] : p.gla_norm_g[l * 64 + q32], g1 = MX == 0 ? p.ret_norm_g[l * 256 + h * 64 + 32 + q32] : p.gla_norm_g[l * 64 + 32 + q32];
#pragma unroll
        for (int it = 0; it < 2; ++it) {
            unsigned short gv0[16], gv1[16];
#pragma unroll
            for (int r = 0; r < 16; ++r) { const int row = row0 + 32 * it + crow(r, hi); gv0[r] = PB[(size_t)row * PW + gcol + q32]; gv1[r] = PB[(size_t)row * PW + gcol + 32 + q32]; }
#pragma unroll
            for (int r = 0; r < 16; ++r) {
                const int row = row0 + 32 * it + crow(r, hi);
                const float a0 = o[it][0][r], a1 = o[it][1][r];
                float ss = a0 * a0 + a1 * a1;
#pragma unroll
                for (int x = 1; x < 32; x <<= 1) ss += __shfl_xor(ss, x);
                const float rstd = rsqrtf(ss * (1.f / 64.f) + EPS);
                const float gt0 = bf2f(gv0[r]), gt1 = bf2f(gv1[r]);
                unsigned char* op = WSP(unsigned char, WS_CONCAT) + (size_t)row * D + ccol + q32;
                op[0] = f2fp8(a0 * rstd * g0 * (gt0 / (1.f + SCN_EXP(-gt0)))); op[32] = f2fp8(a1 * rstd * g1 * (gt1 / (1.f + SCN_EXP(-gt1))));
            }
        }
    }
}
__device__ __forceinline__ bool scan_unit(int slot, bool with_ctx, int& mx, int& bh, int& g) {
    if (slot < 256) { mx = slot >> 7; const int r = slot & 127; bh = r >> 3; g = r & 7; return true; }
    if (!with_ctx) return false;
    const int j = slot - 256 - 128;
    if (j < 0 || j >= 32) return false;
    mx = j >> 4; bh = j & 15; g = 8; return true;
}
__device__ __forceinline__ void d_scan_stage1(KP kp, int l) {
    PH_IDS;
    for (int slot = bid; slot < 512; slot += gridDim.x) {
        int mx, bh, g; if (!scan_unit(slot, true, mx, bh, g)) continue;
        if (mx == 0) scan_stage1_unit<0>(kp, l, bh >> 2, bh & 3, g, tid); else scan_stage1_unit<1>(kp, l, bh >> 2, bh & 3, g, tid);
    }
}
__device__ __forceinline__ void d_scan_stage2(KP kp, int l, LAS unsigned char* lds) {
    PH_IDS;
    for (int slot = bid; slot < 512; slot += gridDim.x) {
        int mx, bh, g; if (!scan_unit(slot, l == 0, mx, bh, g)) continue;
        if (mx == 0) scan_stage2_unit<0>(kp, l, bh >> 2, bh & 3, g, lds, tid); else scan_stage2_unit<1>(kp, l, bh >> 2, bh & 3, g, lds, tid);
    }
}
namespace hfft {
typedef float f2 __attribute__((ext_vector_type(2)));
typedef float f4 __attribute__((ext_vector_type(4)));
constexpr int N = 8192;
__device__ __forceinline__ f2 cmul(f2 a, f2 b) { return (f2){a.x * b.x - a.y * b.y, a.x * b.y + a.y * b.x}; }
__device__ __forceinline__ f2 cmulc(f2 a, f2 b) { return (f2){a.x * b.x + a.y * b.y, a.y * b.x - a.x * b.y}; }
__device__ __forceinline__ f2 tw(float frac) { float sn, cs; sincosf(6.283185307179586f * frac, &sn, &cs); return (f2){cs, -sn}; }
constexpr int TWOFF = 131072 + 64;
__device__ __forceinline__ void tw_build(LAS unsigned char* lds, int tid) { LAS f2* T = (LAS f2*)(lds + TWOFF); for (int k = tid; k < 1024; k += NT) T[k] = tw((float)k * (1.f / 8192.f)); }
__device__ __forceinline__ f2 twk(const LAS f2* T, int k) {
    const f2 a = T[k & 1023]; const float r = 0.70710678118654752f;
    return (k & 1024) ? (f2){(a.x + a.y) * r, (a.y - a.x) * r} : a;
}
__device__ __forceinline__ f2 mul_mi(f2 a) { return (f2){a.y, -a.x}; }
__device__ __forceinline__ f2 mul_pi(f2 a) { return (f2){-a.y, a.x}; }
template <int LOGD> __device__ __forceinline__ void fwd_pass(LAS f2* buf, int tid) {
    constexpr int Dd = 1 << LOGD;
    f2 xin[4][2][4], wAq[4];
#pragma unroll
    for (int g = 0; g < 4; ++g) {
        const int u = tid + NT * g, pos = u & (Dd - 1), base = ((u - pos) << 2) + pos;
        wAq[g] = twk((const LAS f2*)((LAS unsigned char*)buf + TWOFF), pos << (11 - LOGD));
#pragma unroll
        for (int arr = 0; arr < 2; ++arr) { const LAS f2* x = buf + arr * N + base; xin[g][arr][0] = x[0]; xin[g][arr][1] = x[Dd]; xin[g][arr][2] = x[2 * Dd]; xin[g][arr][3] = x[3 * Dd]; }
    }
    __builtin_amdgcn_sched_barrier(0);
#pragma unroll
    for (int g = 0; g < 4; ++g) {
        const int u = tid + NT * g, pos = u & (Dd - 1), base = ((u - pos) << 2) + pos;
        const f2 wA = wAq[g], wB = cmul(wA, wA);
#pragma unroll
        for (int arr = 0; arr < 2; ++arr) {
            LAS f2* x = buf + arr * N + base;
            const f2 a0 = xin[g][arr][0], a1 = xin[g][arr][1], a2 = xin[g][arr][2], a3 = xin[g][arr][3];
            const f2 b0 = a0 + a2, b2 = cmul(a0 - a2, wA), b1 = a1 + a3, b3 = mul_mi(cmul(a1 - a3, wA));
            x[0] = b0 + b1; x[Dd] = cmul(b0 - b1, wB); x[2 * Dd] = b2 + b3; x[3 * Dd] = cmul(b2 - b3, wB);
        }
    }
    __syncthreads();
}
template <int LOGD> __device__ __forceinline__ void inv_pass(LAS f2* buf, int tid) {
    constexpr int Dd = 1 << LOGD;
    f2 xin[4][2][4], wAq[4];
#pragma unroll
    for (int g = 0; g < 4; ++g) {
        const int u = tid + NT * g, pos = u & (Dd - 1), base = ((u - pos) << 2) + pos;
        wAq[g] = twk((const LAS f2*)((LAS unsigned char*)buf + TWOFF), pos << (11 - LOGD));
#pragma unroll
        for (int arr = 0; arr < 2; ++arr) { const LAS f2* x = buf + arr * N + base; xin[g][arr][0] = x[0]; xin[g][arr][1] = x[Dd]; xin[g][arr][2] = x[2 * Dd]; xin[g][arr][3] = x[3 * Dd]; }
    }
    __builtin_amdgcn_sched_barrier(0);
#pragma unroll
    for (int g = 0; g < 4; ++g) {
        const int u = tid + NT * g, pos = u & (Dd - 1), base = ((u - pos) << 2) + pos;
        const f2 wA = wAq[g], wB = cmul(wA, wA);
#pragma unroll
        for (int arr = 0; arr < 2; ++arr) {
            LAS f2* x = buf + arr * N + base;
            const f2 c0 = xin[g][arr][0], c1 = cmulc(xin[g][arr][1], wB), c2 = xin[g][arr][2], c3 = cmulc(xin[g][arr][3], wB);
            const f2 b0 = c0 + c1, b1 = c0 - c1, b2 = cmulc(c2 + c3, wA), b3 = mul_pi(cmulc(c2 - c3, wA));
            x[0] = b0 + b2; x[2 * Dd] = b0 - b2; x[Dd] = b1 + b3; x[3 * Dd] = b1 - b3;
        }
    }
    __syncthreads();
}
__device__ __forceinline__ void fwd_all(LAS f2* buf, int tid) { fwd_pass<11>(buf, tid); fwd_pass<9>(buf, tid); fwd_pass<7>(buf, tid); fwd_pass<5>(buf, tid); fwd_pass<3>(buf, tid); fwd_pass<1>(buf, tid); }
__device__ __forceinline__ void inv_all(LAS f2* buf, int tid) { inv_pass<1>(buf, tid); inv_pass<3>(buf, tid); inv_pass<5>(buf, tid); inv_pass<7>(buf, tid); inv_pass<9>(buf, tid); inv_pass<11>(buf, tid); }
}
__device__ __forceinline__ void d_fspec(KP kp, LAS unsigned char* lds) {
    PH_IDS;
    using namespace hfft;
    LAS f2* buf = (LAS f2*)lds; LAS float* nrm = (LAS float*)(lds + 131072);
    tw_build(lds, tid);
    for (int u = bid; u < 256; u += gridDim.x) {
        const int l = u >> 7, c0 = (u & 127) * 2;
        const float* filt = WSP(float, WS_FILT) + ((size_t)l * 256 + c0) * 8192;
        if (tid < 128) {
            const int arr = tid >> 6, ln = tid & 63; float a = 0.f;
#pragma unroll
            for (int q = 0; q < 4; ++q) a += WSP(float, WS_PS)[(size_t)(l * 256 + ln * 4 + q) * 256 + c0 + arr];
            a = wave_sum(a); if (ln == 0) nrm[arr] = a;
        }
        for (int i = tid; i < 2 * N; i += NT) buf[i] = (f2){filt[i], 0.f};
        __syncthreads();
        fwd_all(buf, tid);
        f4* fs = (f4*)(WSP(float, WS_FSPEC) + ((size_t)l * 256 + c0) * 2 * N);
#pragma unroll
        for (int arr = 0; arr < 2; ++arr) {
            const float sc = 1.f / (8192.f * nrm[arr]), bs = p.hy_bias[l * 256 + c0 + arr] * (1.f / 8192.f);
#pragma unroll
            for (int k = 0; k < 8; ++k) { const int j = tid + k * NT;
                const f4 v = *(const LAS f4*)(buf + arr * N + 2 * j);
                fs[(size_t)arr * (N / 2) + j] = (f4){(v.x + v.z) * sc + bs, (v.y + v.w) * sc, (v.x - v.z) * sc + bs, (v.y - v.w) * sc}; }
        }
        __syncthreads();
    }
}
__device__ __forceinline__ void d_hy_pre_fast(KP kp, int l, LAS unsigned char* lds) {
    PH_IDS;
    LAS float* zt = (LAS float*)lds;
    const bf16_t* PB = WSP(bf16_t, WS_PBUF);
    const int c = tid & 255, half = tid >> 8;
    const float* sw = p.hy_short_w + l * 3 * 768; const float* sb = p.hy_short_b + l * 768;
    float w0[3], w1[3], w2[3], bb[3];
#pragma unroll
    for (int g = 0; g < 3; ++g) { w0[g] = sw[g * 256 + c]; w1[g] = sw[768 + g * 256 + c]; w2[g] = sw[1536 + g * 256 + c]; bb[g] = sb[g * 256 + c]; }
    for (int u = bid; u < NLAT / 64; u += gridDim.x) {
        const int row0 = u * 64 + half * 32, t0 = (u * 64) & (SEQ - 1);
        const int tfirst = t0 + half * 32;
        float xin[3][34];
#pragma unroll
        for (int g = 0; g < 3; ++g) {
            const bf16_t* pp = PB + (size_t)row0 * PW + PC_HY + g * 256 + c;
#pragma unroll
            for (int i = 0; i < 34; ++i) { const int t = tfirst + i - 1, tc = t < 0 ? 0 : (t > SEQ - 1 ? SEQ - 1 : t); const float v = bf2f(pp[(ptrdiff_t)(tc - tfirst) * PW]); xin[g][i] = (t == tc) ? v : 0.f; }
        }
#pragma unroll
        for (int i = 0; i < 32; ++i) {
            float uu[3];
#pragma unroll
            for (int g = 0; g < 3; ++g) uu[g] = bb[g] + w0[g] * xin[g][i] + w1[g] * xin[g][i + 1] + w2[g] * xin[g][i + 2];
            WSP(bf16_t, WS_X0B)[(size_t)(row0 + i) * 256 + c] = f2bf(uu[0]);
            zt[c * 65 + half * 32 + i] = uu[1] * uu[2];
        }
        __syncthreads();
        const int b = (u * 64) >> 12;
        for (int i = tid; i < 256 * 64; i += NT) { const int cc = i >> 6, tl = i & 63; WSP(float, WS_ZT)[((size_t)cc * 4 + b) * SEQ + t0 + tl] = zt[cc * 65 + tl]; }
        __syncthreads();
    }
    if (l == 0) {
        GT_LOOP(idx, NCTX * 256) {
            const int r = idx >> 8, cc = idx & 255, t = r & (CTXL - 1);
            const bf16_t* pp = PB + (size_t)(NLAT + r) * PW + PC_HY + cc;
            float uu[3];
#pragma unroll
            for (int g = 0; g < 3; ++g) { float a = sb[g * 256 + cc] + sw[768 + g * 256 + cc] * bf2f(pp[g * 256]);
                const float pv = bf2f(pp[g * 256 - (t > 0 ? PW : 0)]), nv = bf2f(pp[g * 256 + (t < CTXL - 1 ? PW : 0)]);
                a += sw[g * 256 + cc] * (t > 0 ? pv : 0.f) + sw[1536 + g * 256 + cc] * (t < CTXL - 1 ? nv : 0.f); uu[g] = a; }
            WSP(float, WS_X0C)[idx] = uu[0]; WSP(float, WS_ZC)[idx] = uu[1] * uu[2];
        }
    }
}
__device__ __forceinline__ void d_hy_fft(KP kp, int l, LAS unsigned char* lds) {
    PH_IDS;
    using namespace hfft;
    LAS f2* buf = (LAS f2*)lds;
    tw_build(lds, tid);
    for (int c = bid; c < 256; c += gridDim.x) {
        const float* zt = WSP(float, WS_ZT) + (size_t)c * 4 * SEQ;
#pragma unroll
        for (int arr = 0; arr < 2; ++arr) {
            float re[8], im[8];
#pragma unroll
            for (int i = 0; i < 8; ++i) { re[i] = zt[(size_t)(2 * arr) * SEQ + tid + i * NT]; im[i] = zt[(size_t)(2 * arr + 1) * SEQ + tid + i * NT]; }
            f2 zz; { float zx_, zy_; asm volatile("v_mov_b32 %0, 0\n\tv_mov_b32 %1, 0" : "=v"(zx_), "=v"(zy_)); zz = (f2){zx_, zy_}; }
#pragma unroll
            for (int i = 0; i < 8; ++i) { buf[arr * N + tid + i * NT] = (f2){re[i], im[i]}; buf[arr * N + SEQ + tid + i * NT] = zz; }
        }
        const f4* fs = (const f4*)(WSP(float, WS_FSPEC) + ((size_t)l * 256 + c) * 2 * N);
        f4 fsp[8];
#pragma unroll
        for (int k = 0; k < 8; ++k) fsp[k] = fs[tid + k * NT];
        __syncthreads();
        fwd_all(buf, tid);
#pragma unroll
        for (int arr = 0; arr < 2; ++arr)
#pragma unroll
            for (int k = 0; k < 8; ++k) {
                const int j = tid + k * NT;
                LAS f4* xp = (LAS f4*)(buf + arr * N + 2 * j);
                const f4 v = *xp; const f4 f = fsp[k];
                const f2 s = cmul((f2){v.x + v.z, v.y + v.w}, (f2){f.x, f.y}), d = cmul((f2){v.x - v.z, v.y - v.w}, (f2){f.z, f.w});
                *xp = (f4){s.x + d.x, s.y + d.y, s.x - d.x, s.y - d.y};
            }
        __syncthreads();
        inv_all(buf, tid);
        float* yt = WSP(float, WS_YT) + (size_t)c * 4 * SEQ;
        for (int i = tid; i < 2 * SEQ; i += NT) { const int arr = i >> 12, t = i & (SEQ - 1); const f2 v = buf[arr * N + t];
            yt[(size_t)(2 * arr) * SEQ + t] = v.x; yt[(size_t)(2 * arr + 1) * SEQ + t] = v.y; }
        __syncthreads();
    }
}
__device__ __forceinline__ void d_hy_post(KP kp, int l, LAS unsigned char* lds) {
    PH_IDS;
    LAS float* yt = (LAS float*)lds;
    for (int u = bid; u < NLAT / 64; u += gridDim.x) {
        const int b = (u * 64) >> 12, t0 = (u * 64) & (SEQ - 1);
        {
            float yv[32];
#pragma unroll
            for (int i = 0; i < 32; ++i) { const int idx = tid + i * NT; yv[i] = WSP(float, WS_YT)[((size_t)(idx >> 6) * 4 + b) * SEQ + t0 + (idx & 63)]; }
            __builtin_amdgcn_sched_barrier(0);
#pragma unroll
            for (int i = 0; i < 32; ++i) { const int idx = tid + i * NT; yt[(idx >> 6) * 65 + (idx & 63)] = yv[i]; }
        }
        __syncthreads();
        {
            const int c = tid & 255, th = tid >> 8;
            {
                unsigned short x0v[32];
#pragma unroll
                for (int i = 0; i < 32; ++i) x0v[i] = WSP(bf16_t, WS_X0B)[((size_t)u * 64 + 2 * i + th) * 256 + c];
                __builtin_amdgcn_sched_barrier(0);
#pragma unroll
                for (int i = 0; i < 32; ++i) { const int tl = 2 * i + th; WSP(unsigned char, WS_CONCAT)[((size_t)u * 64 + tl) * D + 256 + c] = f2fp8(bf2f(x0v[i]) * yt[c * 65 + tl]); }
            }
        }
        __syncthreads();
    }
    if (l == 0) {
        const int wv = __builtin_amdgcn_readfirstlane(tid >> 6), lane = tid & 63;
        LAS float* G = (LAS float*)lds + wv * 1024; LAS float* Z = G + 768;
        for (int pair = bid * (NT / 64) + wv; pair < 4 * 256; pair += gridDim.x * (NT / 64)) {
            const int b = pair >> 8, c = pair & 255;
            const float* filt = WSP(float, WS_FILTC) + c; const float* zc = WSP(float, WS_ZC) + (size_t)(b * CTXL) * 256 + c;
            float f[8], z[4], x0[4], nrm = 0.f;
#pragma unroll
            for (int k = 0; k < 8; ++k) f[k] = filt[(size_t)(lane + 64 * k) * 256];
#pragma unroll
            for (int k = 0; k < 4; ++k) { z[k] = zc[(size_t)(lane + 64 * k) * 256]; x0[k] = WSP(float, WS_X0C)[(size_t)(b * CTXL + lane + 64 * k) * 256 + c]; }
#pragma unroll
            for (int q = 0; q < 16; ++q) nrm += WSP(float, WS_PS)[(size_t)(512 + q) * 256 + c];
            const float bias = p.hy_bias[c];
#pragma unroll
            for (int k = 0; k < 8; ++k) { G[256 + lane + 64 * k] = f[k]; if (k >= 4) G[lane + 64 * (k - 4)] = f[k]; }
#pragma unroll
            for (int k = 0; k < 4; ++k) Z[lane + 64 * k] = z[k];
            float acc[4] = {0.f, 0.f, 0.f, 0.f};
            const LAS float* gb = G + lane + 1;
#pragma unroll 4
            for (int s4 = 0; s4 < 64; ++s4) {
                const gv4f zs = *(const LAS gv4f*)(Z + 4 * s4);
#pragma unroll
                for (int j = 0; j < 4; ++j)
#pragma unroll
                    for (int k = 0; k < 4; ++k) acc[k] += gb[64 * k + 255 - (4 * s4 + j)] * zs[j];
            }
            const float inrm = 1.f / nrm;
#pragma unroll
            for (int k = 0; k < 4; ++k) { const float y = acc[k] * inrm + bias * z[k];
                WSP(unsigned char, WS_CONCAT)[(size_t)(NLAT + b * CTXL + lane + 64 * k) * D + 256 + c] = f2fp8(x0[k] * y); }
        }
    }
}
constexpr int CW_BAR = 32768;
__global__ void __launch_bounds__(NT, 2) mk_fwd(P kargs) {
    const KP kp0 = (KP)((unsigned long long)__builtin_amdgcn_kernarg_segment_ptr() | (unsigned long long)(unsigned)__builtin_amdgcn_readfirstlane(threadIdx.x >> 6));
    KP kp = kp0;
#define LP ({ KP k_ = kp0; asm volatile("" : "+s"(k_)); k_; })
    unsigned char* const lds = g_lds;
    volatile LAS unsigned* misc = (volatile LAS unsigned*)((LAS unsigned char*)lds + LDS_MISC);
    if (threadIdx.x < 16) misc[threadIdx.x] = 0u;
    __syncthreads();
    (void)xcd_barrier_post(WSP(unsigned, WS_CTL) + CW_BAR, misc);
#define GRID_BAR() do { XcdBarrier b_; bool t0_; { KP kp = LP; b_.bar = WSP(unsigned, WS_CTL) + CW_BAR; t0_ = ltid_kp(kp) == 0; } b_.x = xb_xcc_id(); b_.st = (volatile LAS unsigned*)((LAS unsigned char*)lds + LDS_MISC); xcd_barrier(b_, t0_); } while (0)
    if (lbid() & 1) { d_convert_a(LP, (LAS float*)lds); d_pro0(LP, (LAS float*)((LAS unsigned char*)lds + 98304)); d_filter(LP, (LAS float*)((LAS unsigned char*)lds + 73728)); }
    else { d_pro0(LP, (LAS float*)((LAS unsigned char*)lds + 98304)); d_filter(LP, (LAS float*)((LAS unsigned char*)lds + 73728)); d_convert_a(LP, (LAS float*)lds); }
    GRID_BAR();
    d_pro1(LP); d_convert_b(LP, (LAS float*)lds);
    GRID_BAR();
    if (lbid() & 1) { d_norm1(LP, 0); d_fspec(LP, (LAS unsigned char*)lds); } else { d_fspec(LP, (LAS unsigned char*)lds); d_norm1(LP, 0); }
    GRID_BAR();
#pragma unroll 1
    for (int l = 0; l < DEPTH; ++l) {
        d_gemm_in(LP, l, (LAS unsigned char*)lds);
        GRID_BAR();
        d_prep_scan(LP); d_prep_attn(LP); d_hy_pre_fast(LP, l, (LAS unsigned char*)lds);
        GRID_BAR();
        d_scan_stage1(LP, l);
        d_hy_fft(LP, l, (LAS unsigned char*)lds);
        d_attn_fast(LP, l, (LAS unsigned char*)lds);
        GRID_BAR();
        d_scan_stage2(LP, l, (LAS unsigned char*)lds);
        d_hy_post(LP, l, (LAS unsigned char*)lds);
        GRID_BAR();
        d_gemm_out(LP, l, (LAS unsigned char*)lds);
        GRID_BAR();
        d_router(LP, l, (LAS float*)lds);
        GRID_BAR();
        d_moe_up(LP, l, (LAS unsigned char*)lds);
        GRID_BAR();
        d_moe_down(LP, l, (LAS unsigned char*)lds);
        GRID_BAR();
        d_combine(LP, l, (LAS int*)lds);
        if (l < DEPTH - 1) GRID_BAR();
    }
}

#undef p
extern "C" void kernel_launch(void* const* d_in, const int* in_sizes, int n_in, void* d_out, int out_size, void* d_ws, size_t ws_size, hipStream_t stream) {
    if (n_in != 31 || ws_size < WS_END || out_size != NLAT * D) { fprintf(stderr, "kernel_launch: unexpected shapes (n_in %d ws %zu out %d)\n", n_in, ws_size, out_size); return; }
    static int grid = 0;
    if (grid == 0) {
        int dev = 0, cus = 0, per_cu = 0;
        if (hipGetDevice(&dev) != hipSuccess || hipDeviceGetAttribute(&cus, hipDeviceAttributeMultiprocessorCount, dev) != hipSuccess) { grid = -1; return; }
        if (hipFuncSetAttribute((const void*)mk_fwd, hipFuncAttributeMaxDynamicSharedMemorySize, LDS_BYTES) != hipSuccess) { fprintf(stderr, "hipFuncSetAttribute failed\n"); grid = -1; return; }
        if (hipOccupancyMaxActiveBlocksPerMultiprocessor(&per_cu, (const void*)mk_fwd, NT, LDS_BYTES) != hipSuccess || per_cu < 1) { fprintf(stderr, "occupancy query says %d\n", per_cu); }
        (void)hipGetLastError();
        grid = cus;
    }
    if (grid < 0) return;
    P hp{};
    const float** pp = (const float**)&hp;
    for (int i = 0; i < 31; ++i) pp[i] = (const float*)d_in[i];
    hp.out = (float*)d_out; hp.ws = (unsigned char*)d_ws;
    (void)hipMemsetAsync((char*)d_ws + WS_CTL, 0, 1 * MiB, stream);
    hipLaunchKernelGGL(mk_fwd, dim3(grid), dim3(NT), LDS_BYTES, stream, hp);
}
```
